# Optimizing an MI355X kernel written in HIP

```python
import jax, jax.numpy as jnp
from jax import lax
import numpy as np

D_MODEL = 1024
BATCH = 16
SEQ = 2048
DEPTH = 1

CHUNK = 64
N_META = 16
Q_BLOCK = 128
C_CONV = D_MODEL // 2
CONV_K = 31
N_HEADS = D_MODEL // 128
QK_NOPE = 64
QK_ROPE = 32
V_DIM = 64
Q_LORA = 3 * D_MODEL // 8
KV_LORA = D_MODEL // 4
ROPE_THETA = 10000.0
D_ATTN = N_HEADS * V_DIM
D_MIX = C_CONV + D_ATTN
N_IN = 2 * C_CONV + Q_LORA + KV_LORA + QK_ROPE
N_GROUPS = 4
EXPERTS_PER_GROUP = 8
N_EXPERTS = N_GROUPS * EXPERTS_PER_GROUP
TOP_K = 2
D_EXPERT = D_MODEL // 4
MOE_BLOCK = 128
DEEPNORM_ALPHA = (2.0 * DEPTH) ** 0.25
DEEPNORM_BETA = (8.0 * DEPTH) ** -0.25
EPS = 1e-5
NEG_INF = -1e30

kernel_name = 'hybrid_conv_mla_hmoe_deepnorm'


def _layer_norm(x, g, b):
    xf = x.astype(jnp.float32)
    mu = jnp.mean(xf, axis=-1, keepdims=True)
    var = jnp.mean(jnp.square(xf - mu), axis=-1, keepdims=True)
    return ((xf - mu) * lax.rsqrt(var + EPS)).astype(x.dtype) * g + b


def _rms_norm(x, g):
    xf = x.astype(jnp.float32)
    return (xf * lax.rsqrt(jnp.mean(xf * xf, axis=-1, keepdims=True) + EPS)).astype(x.dtype) * g


def _chunk_id(pos):
    return jnp.where(pos < N_META, 0, (pos - N_META) // CHUNK + 1)


def _rope_tables(length, dtype):
    half = QK_ROPE // 2
    inv_freq = ROPE_THETA ** (-jnp.arange(half, dtype=jnp.float32) / half)
    ang = jnp.arange(length, dtype=jnp.float32)[:, None] * inv_freq[None, :]
    return jnp.cos(ang).astype(dtype), jnp.sin(ang).astype(dtype)


def _apply_rope(x, cos, sin):
    x1, x2 = jnp.split(x, 2, axis=-1)
    return jnp.concatenate([x1 * cos - x2 * sin, x1 * sin + x2 * cos], axis=-1)


def _causal_depthwise_conv(u, w, b):
    y = lax.conv_general_dilated(u, w[:, None, :], window_strides=(1,), padding=[(CONV_K - 1, 0)],
                                 dimension_numbers=('NWC', 'WIO', 'NWC'), feature_group_count=u.shape[-1])
    return y + b


def _chunk_causal_mla(q_nope, q_rope, k_nope, k_rope, v):
    B, L, H, _ = q_nope.shape
    n_blk = -(-L // Q_BLOCK)
    lp = n_blk * Q_BLOCK

    def to_blocks(t):
        t = jnp.pad(t, [(0, 0), (0, lp - L)] + [(0, 0)] * (t.ndim - 2))
        return jnp.swapaxes(t.reshape((B, n_blk, Q_BLOCK) + t.shape[2:]), 0, 1)

    qn_b, qr_b = to_blocks(q_nope), to_blocks(q_rope)
    q_pos = jnp.arange(lp, dtype=jnp.int32).reshape(n_blk, Q_BLOCK)
    k_chunk = _chunk_id(jnp.arange(L, dtype=jnp.int32))
    scale = (QK_NOPE + QK_ROPE) ** -0.5

    def attend(args):
        qn, qr, qp = args
        s = (jnp.einsum('bqhd,bkhd->bhqk', qn, k_nope)
             + jnp.einsum('bqhd,bkd->bhqk', qr, k_rope)).astype(jnp.float32) * scale
        visible = k_chunk[None, :] <= _chunk_id(qp)[:, None]
        p = jax.nn.softmax(jnp.where(visible, s, NEG_INF), axis=-1).astype(v.dtype)
        return jnp.einsum('bhqk,bkhd->bqhd', p, v)

    o = lax.map(attend, (qn_b, qr_b, q_pos))
    return jnp.swapaxes(o, 0, 1).reshape(B, lp, H, V_DIM)[:, :L]


def _mixer(h, cos, sin, w_in, conv_w, conv_b, conv_ln_g, conv_ln_b, q_norm_g, w_uq,
           kv_norm_g, w_ukv, conv_out_g, attn_out_g, w_o):
    B, L, _ = h.shape
    z = h @ w_in
    c1 = C_CONV
    c2 = 2 * C_CONV
    c3 = c2 + Q_LORA
    c4 = c3 + KV_LORA
    a, gate, cq, ckv, kr = jnp.split(z, [c1, c2, c3, c4], axis=-1)
    u = a * jax.nn.sigmoid(gate)
    c = jax.nn.silu(_layer_norm(_causal_depthwise_conv(u, conv_w, conv_b), conv_ln_g, conv_ln_b))
    q = (_rms_norm(cq, q_norm_g) @ w_uq).reshape(B, L, N_HEADS, QK_NOPE + QK_ROPE)
    q_nope = q[..., :QK_NOPE]
    q_rope = _apply_rope(q[..., QK_NOPE:], cos[:, None, :], sin[:, None, :])
    kv = (_rms_norm(ckv, kv_norm_g) @ w_ukv).reshape(B, L, N_HEADS, QK_NOPE + V_DIM)
    k_nope, v = kv[..., :QK_NOPE], kv[..., QK_NOPE:]
    k_rope = _apply_rope(kr, cos, sin)
    o = _chunk_causal_mla(q_nope, q_rope, k_nope, k_rope, v).reshape(B, L, D_ATTN)
    merged = jnp.concatenate([_rms_norm(c, conv_out_g), _rms_norm(o, attn_out_g)], axis=-1)
    return merged @ w_o


def _hier_moe(h, w_rg, b_rg, w_re, b_re, w_gate, w_up, w_down):
    B, L, D = h.shape
    T = B * L
    xt = h.reshape(T, D)
    g_logits = (xt @ w_rg).astype(jnp.float32) + b_rg.astype(jnp.float32)
    g_prob = jax.nn.softmax(g_logits, axis=-1)
    g_idx = jnp.argmax(g_logits, axis=-1).astype(jnp.int32)
    g_w = jnp.take_along_axis(g_prob, g_idx[:, None], axis=1)[:, 0]
    e_logits = ((xt @ w_re).astype(jnp.float32) + b_re.astype(jnp.float32)).reshape(T, N_GROUPS, EXPERTS_PER_GROUP)
    e_in = jnp.take_along_axis(e_logits, g_idx[:, None, None], axis=1)[:, 0]
    top_v, top_i = lax.top_k(e_in, TOP_K)
    comb = g_w[:, None] * jax.nn.softmax(top_v, axis=-1)
    eid = (g_idx[:, None] * EXPERTS_PER_GROUP + top_i).reshape(-1).astype(jnp.int32)
    A = T * TOP_K
    tok = jnp.repeat(jnp.arange(T, dtype=jnp.int32), TOP_K)
    order = jnp.argsort(eid)
    e_sorted = eid[order]
    counts = jnp.bincount(eid, length=N_EXPERTS).astype(jnp.int32)
    padded = (counts + MOE_BLOCK - 1) // MOE_BLOCK * MOE_BLOCK
    pad_end = jnp.cumsum(padded)
    pad_start = pad_end - padded
    start = jnp.cumsum(counts) - counts
    dest = pad_start[e_sorted] + (jnp.arange(A, dtype=jnp.int32) - start[e_sorted])
    n_blocks = -(-A // MOE_BLOCK) + N_EXPERTS
    R = n_blocks * MOE_BLOCK
    tok_buf = jnp.zeros((R,), jnp.int32).at[dest].set(tok[order])
    w_buf = jnp.zeros((R,), h.dtype).at[dest].set(comb.reshape(-1)[order].astype(h.dtype))
    blk_e = jnp.clip(jnp.searchsorted(pad_end, jnp.arange(n_blocks, dtype=jnp.int32) * MOE_BLOCK, side='right'),
                     0, N_EXPERTS - 1)
    x_buf = xt[tok_buf].reshape(n_blocks, MOE_BLOCK, D)

    def expert_block(args):
        xb, e = args
        act = jax.nn.silu(xb @ w_gate[e]) * (xb @ w_up[e])
        return act @ w_down[e]

    y_buf = lax.map(expert_block, (x_buf, blk_e)).reshape(R, D)
    out = jnp.zeros((T, D), h.dtype).at[tok_buf].add(y_buf * w_buf[:, None])
    return out.reshape(B, L, D)


def setup_inputs(seed: int = 0) -> dict:
    key = jax.random.key(seed)
    ks = jax.random.split(key, 32)
    f32 = jnp.float32

    def nrm(k, shape, scale):
        return jax.random.normal(k, shape, f32) * scale

    def gain(k, shape):
        return 1.0 + 0.05 * jax.random.normal(k, shape, f32)

    beta = DEEPNORM_BETA
    in_scale = jnp.concatenate([jnp.full((C_CONV,), beta, f32), jnp.ones((N_IN - C_CONV,), f32)])
    kv_scale = jnp.tile(jnp.concatenate([jnp.ones((QK_NOPE,), f32), jnp.full((V_DIM,), beta, f32)]), N_HEADS)
    return {
        'x': nrm(ks[0], (BATCH, SEQ, D_MODEL), 1.0),
        'meta_tokens': nrm(ks[1], (N_META, D_MODEL), 1.0),
        'ln_in_g': gain(ks[2], (D_MODEL,)),
        'ln_in_b': nrm(ks[3], (D_MODEL,), 0.01),
        'w_in': nrm(ks[4], (DEPTH, D_MODEL, N_IN), D_MODEL ** -0.5) * in_scale,
        'conv_w': nrm(ks[5], (DEPTH, CONV_K, C_CONV), CONV_K ** -0.5),
        'conv_b': nrm(ks[6], (DEPTH, C_CONV), 0.01),
        'conv_ln_g': gain(ks[7], (DEPTH, C_CONV)),
        'conv_ln_b': nrm(ks[8], (DEPTH, C_CONV), 0.01),
        'q_norm_g': gain(ks[9], (DEPTH, Q_LORA)),
        'w_uq': nrm(ks[10], (DEPTH, Q_LORA, N_HEADS * (QK_NOPE + QK_ROPE)), Q_LORA ** -0.5),
        'kv_norm_g': gain(ks[11], (DEPTH, KV_LORA)),
        'w_ukv': nrm(ks[12], (DEPTH, KV_LORA, N_HEADS * (QK_NOPE + V_DIM)), KV_LORA ** -0.5) * kv_scale,
        'conv_out_g': gain(ks[13], (DEPTH, C_CONV)),
        'attn_out_g': gain(ks[14], (DEPTH, D_ATTN)),
        'w_o': nrm(ks[15], (DEPTH, D_MIX, D_MODEL), D_MIX ** -0.5 * beta),
        'ln1_g': gain(ks[16], (DEPTH, D_MODEL)),
        'ln1_b': nrm(ks[17], (DEPTH, D_MODEL), 0.01),
        'w_rg': nrm(ks[18], (DEPTH, D_MODEL, N_GROUPS), D_MODEL ** -0.5),
        'b_rg': nrm(ks[19], (DEPTH, N_GROUPS), 0.01),
        'w_re': nrm(ks[20], (DEPTH, D_MODEL, N_EXPERTS), D_MODEL ** -0.5),
        'b_re': nrm(ks[21], (DEPTH, N_EXPERTS), 0.01),
        'w_gate': nrm(ks[22], (DEPTH, N_EXPERTS, D_MODEL, D_EXPERT), D_MODEL ** -0.5),
        'w_up': nrm(ks[23], (DEPTH, N_EXPERTS, D_MODEL, D_EXPERT), D_MODEL ** -0.5 * beta),
        'w_down': nrm(ks[24], (DEPTH, N_EXPERTS, D_EXPERT, D_MODEL), D_EXPERT ** -0.5 * beta),
        'ln2_g': gain(ks[25], (DEPTH, D_MODEL)),
        'ln2_b': nrm(ks[26], (DEPTH, D_MODEL), 0.01),
    }


def reference(x, meta_tokens, ln_in_g, ln_in_b, w_in, conv_w, conv_b, conv_ln_g, conv_ln_b,
              q_norm_g, w_uq, kv_norm_g, w_ukv, conv_out_g, attn_out_g, w_o, ln1_g, ln1_b,
              w_rg, b_rg, w_re, b_re, w_gate, w_up, w_down, ln2_g, ln2_b):
    B = x.shape[0]
    meta = jnp.broadcast_to(meta_tokens.astype(x.dtype)[None], (B, N_META, x.shape[-1]))
    h = _layer_norm(jnp.concatenate([meta, x], axis=1), ln_in_g, ln_in_b)
    cos, sin = _rope_tables(h.shape[1], h.dtype)
    for l in range(DEPTH):
        y = _mixer(h, cos, sin, w_in[l], conv_w[l], conv_b[l], conv_ln_g[l], conv_ln_b[l],
                   q_norm_g[l], w_uq[l], kv_norm_g[l], w_ukv[l], conv_out_g[l], attn_out_g[l], w_o[l])
        h = _layer_norm(DEEPNORM_ALPHA * h + y, ln1_g[l], ln1_b[l])
        y = _hier_moe(h, w_rg[l], b_rg[l], w_re[l], b_re[l], w_gate[l], w_up[l], w_down[l])
        h = _layer_norm(DEEPNORM_ALPHA * h + y, ln2_g[l], ln2_b[l])
    return h[:, N_META:]
```

```cpp
#include <hip/hip_runtime.h>
#include <cstdio>
#include <cstdint>

#ifndef MK_N_LAUNCHES
#define MK_N_LAUNCHES 9
#endif

#define DEV __device__ __forceinline__
#define LAS __attribute__((address_space(3)))
#define GAS __attribute__((address_space(1)))
typedef unsigned short bf16_t;
typedef short bf16x8 __attribute__((ext_vector_type(8)));
typedef short s16x4 __attribute__((ext_vector_type(4)));
typedef float f32x4 __attribute__((ext_vector_type(4)));
typedef float f32x16 __attribute__((ext_vector_type(16)));
typedef unsigned u32x4 __attribute__((ext_vector_type(4)));
typedef unsigned u32x2 __attribute__((ext_vector_type(2)));

constexpr int NB = 16, SEQ = 2048, NMETA = 16, L = SEQ + NMETA;
constexpr int T = NB * L;
constexpr int TR = NB * SEQ;
constexpr int D = 1024, NIN = 1696, CC = 512, QL = 384, KVL = 256, NH = 8, DQK = 96, DV = 64;
constexpr int NQ = NH * DQK;
constexpr int NKV = NH * (64 + DV);
constexpr int NE = 32, DE = 256, CONVK = 31;
constexpr float EPS = 1e-5f;
constexpr float ALPHA = 1.189207115002721f;
constexpr float QSCALE = 0.10206207261596577f * 1.4426950408889634f;
constexpr int NPH = 9;

constexpr size_t MiB = 1u << 20;
constexpr size_t WS_CTL = 0, CTL_ZERO_BYTES = 64 * 1024;
constexpr int CW_CNT = 64;
constexpr int CW_BAR = 4096;
constexpr size_t WS_LIST = 1 * MiB;
constexpr size_t WS_COMBW = 5 * MiB;
constexpr size_t WS_ROPE = 5 * MiB + 512 * 1024;
constexpr size_t WS_WIN = 6 * MiB;
constexpr size_t WS_WUQ = 10 * MiB;
constexpr size_t WS_WUKV = 11 * MiB;
constexpr size_t WS_WO = 12 * MiB;
constexpr size_t WS_WR = 14 * MiB;
constexpr size_t WS_WGU = 16 * MiB;
constexpr size_t WS_WD = 48 * MiB;
constexpr size_t WS_H0 = 64 * MiB;
constexpr size_t WS_U = 130 * MiB;
constexpr size_t WS_CQ = 163 * MiB;
constexpr size_t WS_CKV = 188 * MiB;
constexpr size_t WS_KR = 205 * MiB;
constexpr size_t WS_Q = 208 * MiB;
constexpr size_t WS_KV = 257 * MiB;
constexpr size_t WS_R1 = 208 * MiB;
constexpr size_t WS_Y = 208 * MiB;
constexpr size_t WS_MG = 336 * MiB;
constexpr size_t WS_ACT = 336 * MiB;
constexpr size_t WS_END = 400 * MiB;

constexpr int LDS_BYTES = 73728;
constexpr int MISC_OFF = LDS_BYTES - 256;
constexpr int RS_OFF = 65536;
constexpr int TBL_OFF = 66048;
constexpr int EXP_OFF = 66560;

DEV unsigned cvtpk(float lo, float hi) { unsigned r; asm("v_cvt_pk_bf16_f32 %0, %1, %2" : "=v"(r) : "v"(lo), "v"(hi)); return r; }
DEV float bflo(unsigned w) { return __uint_as_float(w << 16); }
DEV float bfhi(unsigned w) { return __uint_as_float(w & 0xffff0000u); }
DEV float wave_sum(float v) {
#pragma unroll
    for (int o = 1; o < 64; o <<= 1) v += __shfl_xor(v, o);
    return v;
}
DEV void st_bf4(bf16_t* p, f32x4 v) { u32x2 w = {cvtpk(v[0], v[1]), cvtpk(v[2], v[3])}; *(u32x2*)p = w; }
DEV float fast_exp2(float x) { return __builtin_amdgcn_exp2f(x); }
DEV float fast_rcp(float x) { return __builtin_amdgcn_rcpf(x); }
DEV float sigmoidf_(float g) { return fast_rcp(1.f + fast_exp2(-1.4426950408889634f * g)); }
#define LDS_WAIT() asm volatile("s_waitcnt lgkmcnt(0)" ::: "memory")
#define VM_WAIT() asm volatile("s_waitcnt vmcnt(0)" ::: "memory")

#define XB_TMO      128
#define XB_XCNT(j)  (256  + 64 * (j))
#define XB_XSUB(j)  (1280 + 64 * (j))
#define XB_XGEN(j)  (2304 + 64 * (j))
#define XB_TOP      3328
#define XB_TOPGEN   3392
#define XCD_BAR_WORDS 3456
#define XB_SPIN_CAP (1u << 22)
DEV unsigned xb_ld(unsigned* p)              { return __hip_atomic_load(p, __ATOMIC_RELAXED, __HIP_MEMORY_SCOPE_AGENT); }
DEV unsigned xb_add(unsigned* p, unsigned v) { return __hip_atomic_fetch_add(p, v, __ATOMIC_RELAXED, __HIP_MEMORY_SCOPE_AGENT); }
DEV unsigned xb_xcc_id() { return (unsigned)__builtin_amdgcn_s_getreg((3 << 11) | 20) & 0xFu; }
#define XB_SPIN(cond, bar) do { unsigned _sp = 0; while (cond) { __builtin_amdgcn_s_sleep(1); \
    if ((++_sp & 255u) == 0u) { if (xb_ld(&(bar)[XB_TMO])) break; if (_sp > XB_SPIN_CAP) { atomicAdd(&(bar)[XB_TMO], 1u); break; } } } } while (0)
struct XcdBarrier { unsigned* bar; unsigned x; volatile LAS unsigned* st; };
DEV XcdBarrier xcd_barrier_post(unsigned* bar, volatile LAS unsigned* st) {
    XcdBarrier b; b.bar = bar; b.x = xb_xcc_id(); b.st = st;
    if (threadIdx.x == 0) (void)xb_add(&bar[XB_XCNT(b.x)], 1u);
    return b;
}
DEV void xcd_barrier_complete(unsigned* bar, unsigned x, unsigned& nloc, unsigned& nx) {
    const unsigned G = gridDim.x * gridDim.y * gridDim.z;
    unsigned sum, cnt, mine, sp = 0u;
    for (;;) {
        sum = 0u; cnt = 0u; mine = 0u;
#pragma unroll
        for (unsigned j = 0; j < 16; ++j) { const unsigned c = xb_ld(&bar[XB_XCNT(j)]); sum += c; cnt += (c > 0u) ? 1u : 0u; mine = (j == x) ? c : mine; }
        if (sum == G) break;
        __builtin_amdgcn_s_sleep(1);
        if ((++sp & 255u) == 0u) { if (xb_ld(&bar[XB_TMO])) break; if (sp > XB_SPIN_CAP) { atomicAdd(&bar[XB_TMO], 1u); break; } }
    }
    nloc = mine > 0u ? mine : 1u; nx = cnt > 0u ? cnt : 1u;
}
DEV void xcd_barrier(const XcdBarrier& b) {
    asm volatile("s_waitcnt vmcnt(0)" ::: "memory");
    __syncthreads();
    if (threadIdx.x == 0) {
        unsigned* bar = b.bar;
        __builtin_amdgcn_s_waitcnt(0);
        unsigned nloc = b.st[0], nx = b.st[1];
        if (nloc == 0u) { xcd_barrier_complete(bar, b.x, nloc, nx); b.st[0] = nloc; b.st[1] = nx; }
        const unsigned old = xb_add(&bar[XB_XSUB(b.x)], 1u);
        const unsigned gen = old / nloc;
        if (old + 1u == (gen + 1u) * nloc) {
            __builtin_amdgcn_fence(__ATOMIC_RELEASE, "agent");
            asm volatile("s_waitcnt vmcnt(0)" ::: "memory");
            const unsigned og = xb_add(&bar[XB_TOP], 1u);
            const unsigned tg = og / nx;
            if (og + 1u == (tg + 1u) * nx) xb_add(&bar[XB_TOPGEN], 1u);
            else XB_SPIN(xb_ld(&bar[XB_TOPGEN]) == tg, bar);
            __builtin_amdgcn_fence(__ATOMIC_ACQUIRE, "agent");
            xb_add(&bar[XB_XGEN(b.x)], 1u);
            asm volatile("s_waitcnt vmcnt(0)" ::: "memory");
        } else {
            XB_SPIN(xb_ld(&bar[XB_XGEN(b.x)]) == gen, bar);
            __builtin_amdgcn_fence(__ATOMIC_ACQUIRE, "agent");
            asm volatile("s_waitcnt vmcnt(0)" ::: "memory");
        }
    }
    __syncthreads();
}

struct Args { const float* in[27]; float* out; unsigned char* ws; int ph_lo, ph_hi; };
struct Ctx {
    const float* const* in; float* out; unsigned char* ws; unsigned char* lds;
    int tid, lane, wid, vcu, G;
};
enum { I_X = 0, I_META, I_LNIN_G, I_LNIN_B, I_WIN, I_CONVW, I_CONVB, I_CLN_G, I_CLN_B, I_QNG, I_WUQ, I_KVNG, I_WUKV, I_COUT_G, I_AOUT_G, I_WO,
       I_LN1G, I_LN1B, I_WRG, I_BRG, I_WRE, I_BRE, I_WGATE, I_WUP, I_WDOWN, I_LN2G, I_LN2B };

DEV int nmap(int mode, int n) {
    if (mode == 1) { if (n < 512) return ((n >> 4) << 5) + (n & 15); if (n < 1024) return (((n - 512) >> 4) << 5) + 16 + (n & 15); return n; }
    if (mode == 2) return ((n >> 4) << 5) + (n & 15);
    if (mode == 3) return ((n >> 4) << 5) + 16 + (n & 15);
    return n;
}
DEV void p0_transpose_item(const float* __restrict__ W, int N, int k0, int n0, const float* __restrict__ kscale, bf16_t* WT, int ldt, int kout0, int mode,
                           float* scr, int lane) {
#pragma unroll 8
    for (int i = 0; i < 32; ++i) {
        const int kk = 2 * i + (lane >> 5);
        float v = W[(size_t)(k0 + kk) * N + n0 + (lane & 31)];
        if (kscale) v *= kscale[k0 + kk];
        scr[kk * 33 + (lane & 31)] = v;
    }
    LDS_WAIT(); asm volatile("" ::: "memory");
    const int c = lane & 7;
#pragma unroll
    for (int j = 0; j < 4; ++j) {
        const int n = (lane >> 3) + 8 * j; const float* s = scr + (8 * c) * 33 + n;
        u32x4 o; o.x = cvtpk(s[0 * 33], s[1 * 33]); o.y = cvtpk(s[2 * 33], s[3 * 33]); o.z = cvtpk(s[4 * 33], s[5 * 33]); o.w = cvtpk(s[6 * 33], s[7 * 33]);
        *(u32x4*)(WT + (size_t)nmap(mode, n0 + n) * ldt + kout0 + 8 * c) = o;
    }
    LDS_WAIT(); asm volatile("" ::: "memory");
}
DEV void ln_row_bf16(const float* xrow, const float* g, const float* bta, bf16_t* orow, unsigned char* ldsrow, int lane, float pre_scale = 1.f) {
    f32x4 v[4]; float s = 0.f;
#pragma unroll
    for (int j = 0; j < 4; ++j) { v[j] = ((const f32x4*)xrow)[64 * j + lane]; v[j] = v[j] * pre_scale; s += (v[j].x + v[j].y) + (v[j].z + v[j].w); }
    const float mean = wave_sum(s) * (1.f / 1024.f); float s2 = 0.f;
#pragma unroll
    for (int j = 0; j < 4; ++j) { v[j] = v[j] - mean; s2 += (v[j].x * v[j].x + v[j].y * v[j].y) + (v[j].z * v[j].z + v[j].w * v[j].w); }
    const float rstd = 1.f / sqrtf(wave_sum(s2) * (1.f / 1024.f) + EPS);
#pragma unroll
    for (int j = 0; j < 4; ++j) {
        const f32x4 gg = ((const f32x4*)g)[64 * j + lane], bb = ((const f32x4*)bta)[64 * j + lane];
        f32x4 o = v[j] * rstd * gg + bb;
        u32x2 w = {cvtpk(o.x, o.y), cvtpk(o.z, o.w)};
        ((u32x2*)orow)[64 * j + lane] = w;
        if (ldsrow) ((u32x2*)ldsrow)[64 * j + lane] = w;
    }
}
__device__ const float INVF[16] = {1.0f, 0.5623413251903491f, 0.31622776601683794f, 0.1778279410038923f, 0.1f, 0.05623413251903491f, 0.031622776601683794f,
    0.01778279410038923f, 0.01f, 0.005623413251903491f, 0.0031622776601683794f, 0.001778279410038923f, 0.001f, 0.0005623413251903491f, 0.00031622776601683794f, 0.0001778279410038923f};
DEV void sincos_d(double a, float& sn, float& cs) {
    const double TWO_PI = 6.283185307179586476925286766559;
    const double k = __builtin_rint(a / TWO_PI);
    const double r = a - k * TWO_PI;
    const double r2 = r * r;
    double st = r, ct = 1.0, ssum = r, csum = 1.0;
#pragma unroll 1
    for (int i = 1; i <= 14; ++i) {
        ct = -ct * r2 / (double)((2 * i - 1) * (2 * i));  csum += ct;
        st = -st * r2 / (double)((2 * i) * (2 * i + 1));  ssum += st;
    }
    sn = (float)ssum; cs = (float)csum;
}
DEV void phase0(const Ctx& c) {
    float* scr = (float*)(c.lds + c.wid * 8448);
    const int gw = c.vcu * 4 + c.wid, NGW = c.G * 4;
    constexpr int I_IN = 16 * 53, I_UQ = 6 * 24, I_UKV = 4 * 32, I_O = 16 * 32, I_G = 32 * 128, I_U = I_G, I_D = 32 * 128;
    constexpr int NITEMS = I_IN + I_UQ + I_UKV + I_O + I_G + I_U + I_D;
    bf16_t* WinT = (bf16_t*)(c.ws + WS_WIN); bf16_t* WuqT = (bf16_t*)(c.ws + WS_WUQ); bf16_t* WukvT = (bf16_t*)(c.ws + WS_WUKV);
    bf16_t* WoT = (bf16_t*)(c.ws + WS_WO); bf16_t* WguT = (bf16_t*)(c.ws + WS_WGU); bf16_t* WdT = (bf16_t*)(c.ws + WS_WD);
    for (int it = gw; it < NITEMS; it += NGW) {
        int r = it;
        if (r < I_IN) { const int kb = r / 53, nb = r % 53; p0_transpose_item(c.in[I_WIN], NIN, 64 * kb, 32 * nb, nullptr, WinT, 1024, 64 * kb, 1, scr, c.lane); continue; } r -= I_IN;
        if (r < I_UQ) { const int kb = r / 24, nb = r % 24; p0_transpose_item(c.in[I_WUQ], NQ, 64 * kb, 32 * nb, c.in[I_QNG], WuqT, QL, 64 * kb, 0, scr, c.lane); continue; } r -= I_UQ;
        if (r < I_UKV) { const int kb = r / 32, nb = r % 32; p0_transpose_item(c.in[I_WUKV], NKV, 64 * kb, 32 * nb, c.in[I_KVNG], WukvT, KVL, 64 * kb, 0, scr, c.lane); continue; } r -= I_UKV;
        if (r < I_O) { const int kb = r / 32, nb = r % 32;
            if (kb < 8) p0_transpose_item(c.in[I_WO], D, 64 * kb, 32 * nb, nullptr, WoT, 1024, 64 * kb + 512, 0, scr, c.lane);
            else        p0_transpose_item(c.in[I_WO], D, 64 * kb, 32 * nb, c.in[I_AOUT_G] - 512, WoT, 1024, 64 * kb - 512, 0, scr, c.lane);
            continue; } r -= I_O;
        if (r < I_G) { const int e = r >> 7, q = r & 127, kb = q >> 3, nb = q & 7;
            p0_transpose_item(c.in[I_WGATE] + (size_t)e * D * DE, DE, 64 * kb, 32 * nb, nullptr, WguT + (size_t)e * 512 * 1024, 1024, 64 * kb, 2, scr, c.lane); continue; } r -= I_G;
        if (r < I_U) { const int e = r >> 7, q = r & 127, kb = q >> 3, nb = q & 7;
            p0_transpose_item(c.in[I_WUP] + (size_t)e * D * DE, DE, 64 * kb, 32 * nb, nullptr, WguT + (size_t)e * 512 * 1024, 1024, 64 * kb, 3, scr, c.lane); continue; } r -= I_U;
        { const int e = r >> 7, q = r & 127, kb = q >> 5, nb = q & 31;
            p0_transpose_item(c.in[I_WDOWN] + (size_t)e * DE * D, D, 64 * kb, 32 * nb, nullptr, WdT + (size_t)e * 1024 * 256, 256, 64 * kb, 0, scr, c.lane); }
    }
    const int gt = c.vcu * 256 + c.tid, NGT = c.G * 256;
    bf16_t* WrT = (bf16_t*)(c.ws + WS_WR);
    for (int i = gt; i < 48 * 1024; i += NGT) {
        const int n = i >> 10, k = i & 1023; float v = 0.f;
        if (n < 4) v = c.in[I_WRG][k * 4 + n]; else if (n < 36) v = c.in[I_WRE][k * 32 + (n - 4)];
        WrT[i] = (bf16_t)(cvtpk(v, 0.f) & 0xffffu);
    }
    float* rc = (float*)(c.ws + WS_ROPE); float* rs = rc + L * 16;
    for (int i = gt; i < L * 16; i += NGT) {
        const int p = i >> 4, f = i & 15; const float ang = (float)p * INVF[f];
        float sn, cs; sincos_d((double)ang, sn, cs); rc[i] = cs; rs[i] = sn;
    }
    bf16_t* h0 = (bf16_t*)(c.ws + WS_H0);
    for (int t = gw; t < T; t += NGW) {
        const int b = t / L, p = t - b * L;
        const float* src = (p < NMETA) ? c.in[I_META] + (size_t)p * D : c.in[I_X] + ((size_t)b * SEQ + (p - NMETA)) * D;
        ln_row_bf16(src, c.in[I_LNIN_G], c.in[I_LNIN_B], h0 + (size_t)t * D, nullptr, c.lane);
    }
}

struct StageGeo { int r[4]; int c; };
DEV StageGeo stage_geo(int tid) {
    const int lane = tid & 63, wid = tid >> 6; StageGeo g;
    const int rl = lane >> 2, cl = ((lane & 3) * 8) ^ ((lane >> 5) << 4);
#pragma unroll
    for (int i = 0; i < 4; ++i) g.r[i] = (((wid + 4 * i) >> 1) << 4) + rl;
    g.c = ((wid & 1) << 5) + cl;
    return g;
}
template <bool SSQ>
DEV void gemm_mainloop(f32x4 (&acc)[4][4], const bf16_t* ap0, const bf16_t* ap1, const bf16_t* ap2, const bf16_t* ap3,
                       const bf16_t* bp0, const bf16_t* bp1, const bf16_t* bp2, const bf16_t* bp3,
                       int nk, unsigned char* lds, int ssq_steps, float ssq_inv_dim) {
    const int tid = threadIdx.x, lane = tid & 63, wid = tid >> 6, wr = wid >> 1, wc = wid & 1, fr = lane & 15, fq = lane >> 4;
    const int lo = ((fr * 64 + fq * 16) ^ ((fr >> 3) << 5));
    const int a_off = (wr * 4) * 2048 + lo, b_off = 16384 + (wc * 4) * 2048 + lo;
    const int dst = tid * 16;
    float ssq = 0.f;
#pragma unroll
    for (int m = 0; m < 4; ++m)
#pragma unroll
        for (int n = 0; n < 4; ++n) acc[m][n] = (f32x4){0.f, 0.f, 0.f, 0.f};
    __syncthreads();
#define GLDS(src, off) __builtin_amdgcn_global_load_lds((const unsigned*)(src), (unsigned LAS*)(lds + (off)), 16, 0, 0)
#define STAGE(kt, b) do { const int _k = (kt) * 64; \
        GLDS(ap0 + _k, (b) * 32768 + dst);          GLDS(ap1 + _k, (b) * 32768 + dst + 4096); \
        GLDS(ap2 + _k, (b) * 32768 + dst + 8192);   GLDS(ap3 + _k, (b) * 32768 + dst + 12288); \
        GLDS(bp0 + _k, (b) * 32768 + 16384 + dst);  GLDS(bp1 + _k, (b) * 32768 + 16384 + dst + 4096); \
        GLDS(bp2 + _k, (b) * 32768 + 16384 + dst + 8192); GLDS(bp3 + _k, (b) * 32768 + 16384 + dst + 12288); } while (0)
    STAGE(0, 0);
    for (int kt = 0; kt < nk; ++kt) {
        VM_WAIT();
        __syncthreads();
        const int b = kt & 1;
        if (SSQ && kt == ssq_steps) {
            const float* rsl = (const float*)(lds + RS_OFF);
#pragma unroll
            for (int m = 0; m < 4; ++m) { const float r = rsl[wr * 64 + m * 16 + fr];
#pragma unroll
                for (int n = 0; n < 4; ++n) acc[m][n] = acc[m][n] * r; }
        }
        if (kt + 1 < nk) { if (b) STAGE(kt + 1, 0); else STAGE(kt + 1, 1); }
        const unsigned char* base = lds + b * 32768;
#pragma unroll
        for (int ks = 0; ks < 2; ++ks) {
            bf16x8 af[4], bf[4];
#pragma unroll
            for (int m = 0; m < 4; ++m) af[m] = *(const bf16x8*)(base + a_off + m * 2048 + ks * 1024);
#pragma unroll
            for (int n = 0; n < 4; ++n) bf[n] = *(const bf16x8*)(base + b_off + n * 2048 + ks * 1024);
#pragma unroll
            for (int m = 0; m < 4; ++m)
#pragma unroll
                for (int n = 0; n < 4; ++n) acc[m][n] = __builtin_amdgcn_mfma_f32_16x16x32_bf16(bf[n], af[m], acc[m][n], 0, 0, 0);
        }
        if (SSQ && kt < ssq_steps) {
            const int row = tid >> 1, hf = tid & 1;
            const int rb = ((row >> 4) * 2 + hf) * 1024 + (row & 15) * 64, sw = ((row & 15) >> 3) << 5;
#pragma unroll
            for (int j = 0; j < 4; ++j) {
                const u32x4 w = *(const u32x4*)(base + rb + ((j * 16) ^ sw));
#pragma unroll
                for (int q = 0; q < 4; ++q) { const float a = bflo(w[q]), bb = bfhi(w[q]); ssq += a * a + bb * bb; }
            }
            if (kt == ssq_steps - 1) {
                const float tot = ssq + __shfl_xor(ssq, 1);
                if (hf == 0) ((float*)(lds + RS_OFF))[row] = 1.f / sqrtf(tot * ssq_inv_dim + EPS);
            }
        }
    }
    if (SSQ && ssq_steps == nk) {
        __syncthreads();
        const float* rsl = (const float*)(lds + RS_OFF);
#pragma unroll
        for (int m = 0; m < 4; ++m) { const float r = rsl[wr * 64 + m * 16 + fr];
#pragma unroll
            for (int n = 0; n < 4; ++n) acc[m][n] = acc[m][n] * r; }
    }
#undef STAGE
#undef GLDS
}

DEV void phase1(const Ctx& c) {
    const bf16_t* h0 = (const bf16_t*)(c.ws + WS_H0); const bf16_t* WinT = (const bf16_t*)(c.ws + WS_WIN);
    bf16_t* U = (bf16_t*)(c.ws + WS_U); bf16_t* CQ = (bf16_t*)(c.ws + WS_CQ); bf16_t* CKV = (bf16_t*)(c.ws + WS_CKV); bf16_t* KR = (bf16_t*)(c.ws + WS_KR);
    const float* rc = (const float*)(c.ws + WS_ROPE); const float* rs = rc + L * 16;
    const StageGeo g = stage_geo(c.tid);
    const int lane = c.lane, wr = c.wid >> 1, wc = c.wid & 1, fr = lane & 15, fq = lane >> 4;
    constexpr int NT = 14, NU = (T / 128) * NT;
    for (int u = c.vcu; u < NU; u += c.G) {
        const int mt = u / NT, nt = u - mt * NT;
        const bf16_t* A = h0 + (size_t)(mt * 128) * D + g.c; const bf16_t* B = WinT + (size_t)(nt * 128) * D + g.c;
        f32x4 acc[4][4];
        gemm_mainloop<false>(acc, A + (size_t)g.r[0] * D, A + (size_t)g.r[1] * D, A + (size_t)g.r[2] * D, A + (size_t)g.r[3] * D,
                             B + (size_t)g.r[0] * D, B + (size_t)g.r[1] * D, B + (size_t)g.r[2] * D, B + (size_t)g.r[3] * D, 16, c.lds, 0, 0.f);
        const int row0 = mt * 128 + wr * 64 + fr;
        if (nt < 8) {
#pragma unroll
            for (int m = 0; m < 4; ++m) { const size_t row = row0 + m * 16;
#pragma unroll
                for (int i = 0; i < 2; ++i) {
                    f32x4 a = acc[m][2 * i], gt = acc[m][2 * i + 1], o;
#pragma unroll
                    for (int j = 0; j < 4; ++j) o[j] = a[j] * sigmoidf_(gt[j]);
                    st_bf4(U + row * CC + nt * 64 + wc * 32 + i * 16 + fq * 4, o);
                } }
        } else if (nt < 11) {
#pragma unroll
            for (int m = 0; m < 4; ++m) { const size_t row = row0 + m * 16;
#pragma unroll
                for (int n = 0; n < 4; ++n) st_bf4(CQ + row * QL + (nt - 8) * 128 + wc * 64 + n * 16 + fq * 4, acc[m][n]); }
        } else if (nt < 13) {
#pragma unroll
            for (int m = 0; m < 4; ++m) { const size_t row = row0 + m * 16;
#pragma unroll
                for (int n = 0; n < 4; ++n) st_bf4(CKV + row * KVL + (nt - 11) * 128 + wc * 64 + n * 16 + fq * 4, acc[m][n]); }
        } else if (wc == 0) {
#pragma unroll
            for (int m = 0; m < 4; ++m) { const int row = row0 + m * 16; const int p = row % L;
                const f32x4 cs = *(const f32x4*)(rc + p * 16 + fq * 4), sn = *(const f32x4*)(rs + p * 16 + fq * 4);
                const f32x4 x1 = acc[m][0], x2 = acc[m][1];
                st_bf4(KR + (size_t)row * 32 + fq * 4, x1 * cs - x2 * sn);
                st_bf4(KR + (size_t)row * 32 + 16 + fq * 4, x1 * sn + x2 * cs); }
        }
    }
}

DEV void conv_unit(const Ctx& c, int b, int j) {
    const bf16_t* U = (const bf16_t*)(c.ws + WS_U);
    bf16_t* MG = (bf16_t*)(c.ws + WS_MG);
    const float* cw = c.in[I_CONVW]; const float* cb = c.in[I_CONVB];
    const int p0 = j * 32;
    float* ytile = (float*)c.lds;
    __syncthreads();
#pragma unroll 1
    for (int pass = 0; pass < 2; ++pass) {
        const int ch = c.tid + 256 * pass;
        float win[62];
#pragma unroll
        for (int i = 0; i < 62; ++i) { const int p = p0 - 30 + i; win[i] = (p >= 0 && p < L) ? __uint_as_float((unsigned)U[((size_t)b * L + p) * CC + ch] << 16) : 0.f; }
        float w[31];
#pragma unroll
        for (int k = 0; k < 31; ++k) w[k] = cw[k * CC + ch];
        const float bias = cb[ch];
#pragma unroll
        for (int tt = 0; tt < 32; ++tt) {
            float a0 = bias;
#pragma unroll
            for (int k = 0; k < 31; ++k) a0 += w[k] * win[tt + k];
            ytile[tt * 512 + ch] = a0;
        }
    }
    __syncthreads();
    const float* g1 = c.in[I_CLN_G]; const float* b1 = c.in[I_CLN_B]; const float* g2 = c.in[I_COUT_G];
    for (int i = 0; i < 8; ++i) {
        const int tt = c.wid * 8 + i, p = p0 + tt;
        if (p < NMETA || p >= L) continue;
        const f32x4 ya = *(const f32x4*)(ytile + tt * 512 + c.lane * 8), yb = *(const f32x4*)(ytile + tt * 512 + c.lane * 8 + 4);
        float v[8] = {ya.x, ya.y, ya.z, ya.w, yb.x, yb.y, yb.z, yb.w};
        float s = 0.f;
#pragma unroll
        for (int q = 0; q < 8; ++q) s += v[q];
        const float mean = wave_sum(s) * (1.f / 512.f); float s2 = 0.f;
#pragma unroll
        for (int q = 0; q < 8; ++q) { v[q] -= mean; s2 += v[q] * v[q]; }
        const float rstd = 1.f / sqrtf(wave_sum(s2) * (1.f / 512.f) + EPS);
        float s3 = 0.f;
#pragma unroll
        for (int q = 0; q < 8; ++q) { const float x = v[q] * rstd * g1[c.lane * 8 + q] + b1[c.lane * 8 + q]; const float y = x * sigmoidf_(x); v[q] = y; s3 += y * y; }
        const float r2 = 1.f / sqrtf(wave_sum(s3) * (1.f / 512.f) + EPS);
        u32x4 o;
        o.x = cvtpk(v[0] * r2 * g2[c.lane * 8 + 0], v[1] * r2 * g2[c.lane * 8 + 1]); o.y = cvtpk(v[2] * r2 * g2[c.lane * 8 + 2], v[3] * r2 * g2[c.lane * 8 + 3]);
        o.z = cvtpk(v[4] * r2 * g2[c.lane * 8 + 4], v[5] * r2 * g2[c.lane * 8 + 5]); o.w = cvtpk(v[6] * r2 * g2[c.lane * 8 + 6], v[7] * r2 * g2[c.lane * 8 + 7]);
        const size_t tok = (size_t)b * SEQ + (p - NMETA);
        *(u32x4*)(MG + tok * D + 512 + c.lane * 8) = o;
    }
}
DEV void rope4(f32x4& x1, f32x4& x2, const float* rc, const float* rs, int p, int fq) {
    const f32x4 cs = *(const f32x4*)(rc + p * 16 + fq * 4), sn = *(const f32x4*)(rs + p * 16 + fq * 4);
    const f32x4 a = x1 * cs - x2 * sn, bb = x1 * sn + x2 * cs; x1 = a; x2 = bb;
}
DEV void phase2(const Ctx& c) {
    const bf16_t* CQ = (const bf16_t*)(c.ws + WS_CQ); const bf16_t* CKV = (const bf16_t*)(c.ws + WS_CKV);
    const bf16_t* WuqT = (const bf16_t*)(c.ws + WS_WUQ); const bf16_t* WukvT = (const bf16_t*)(c.ws + WS_WUKV);
    bf16_t* Q = (bf16_t*)(c.ws + WS_Q); bf16_t* KV = (bf16_t*)(c.ws + WS_KV);
    const float* rc = (const float*)(c.ws + WS_ROPE); const float* rs = rc + L * 16;
    const StageGeo g = stage_geo(c.tid);
    const int lane = c.lane, wr = c.wid >> 1, wc = c.wid & 1, fr = lane & 15, fq = lane >> 4;
    constexpr int MT = T / 128, NUQ = MT * 6, NUKV = MT * 8, NUC = NB * 65, NU = NUQ + NUKV + NUC;
    for (int u = c.vcu; u < NU; u += c.G) {
        if (u < NUKV) {
            const int mt = u >> 3, nt = u & 7;
            const bf16_t* A = CKV + (size_t)(mt * 128) * KVL + g.c; const bf16_t* B = WukvT + (size_t)(nt * 128) * KVL + g.c;
            f32x4 acc[4][4];
            gemm_mainloop<true>(acc, A + (size_t)g.r[0] * KVL, A + (size_t)g.r[1] * KVL, A + (size_t)g.r[2] * KVL, A + (size_t)g.r[3] * KVL,
                                B + (size_t)g.r[0] * KVL, B + (size_t)g.r[1] * KVL, B + (size_t)g.r[2] * KVL, B + (size_t)g.r[3] * KVL, 4, c.lds, 4, 1.f / 256.f);
            const int row0 = mt * 128 + wr * 64 + fr;
#pragma unroll
            for (int m = 0; m < 4; ++m) { const size_t row = row0 + m * 16;
#pragma unroll
                for (int n = 0; n < 4; ++n) st_bf4(KV + row * NKV + nt * 128 + wc * 64 + n * 16 + fq * 4, acc[m][n]); }
        } else if (u < NUKV + NUQ) {
            const int v = u - NUKV, mt = v / 6, nt = v - mt * 6;
            const bf16_t* A = CQ + (size_t)(mt * 128) * QL + g.c; const bf16_t* B = WuqT + (size_t)(nt * 128) * QL + g.c;
            f32x4 acc[4][4];
            gemm_mainloop<true>(acc, A + (size_t)g.r[0] * QL, A + (size_t)g.r[1] * QL, A + (size_t)g.r[2] * QL, A + (size_t)g.r[3] * QL,
                                B + (size_t)g.r[0] * QL, B + (size_t)g.r[1] * QL, B + (size_t)g.r[2] * QL, B + (size_t)g.r[3] * QL, 6, c.lds, 6, 1.f / 384.f);
            const int row0 = mt * 128 + wr * 64 + fr;
            const int t16 = (nt * 8 + wc * 4) % 6;
#pragma unroll
            for (int m = 0; m < 4; ++m) { const int row = row0 + m * 16; const int p = row % L;
#pragma unroll
                for (int n = 0; n < 4; ++n) acc[m][n] = acc[m][n] * QSCALE;
                if (t16 == 4) rope4(acc[m][0], acc[m][1], rc, rs, p, fq);
                if (t16 == 2) rope4(acc[m][2], acc[m][3], rc, rs, p, fq);
#pragma unroll
                for (int n = 0; n < 4; ++n) st_bf4(Q + (size_t)row * NQ + nt * 128 + wc * 64 + n * 16 + fq * 4, acc[m][n]); }
        } else {
            const int v = u - NUKV - NUQ; conv_unit(c, v / 65, v % 65);
        }
    }
}

DEV int crow(int r, int hi) { return (r & 3) + 8 * (r >> 2) + 4 * hi; }
#define KSWZ(row, colB) ((row) * 256 + ((colB) ^ (((row) & 7) << 4)))
#define SBAR() __builtin_amdgcn_sched_barrier(0)
DEV int v_st(int k, int cc) { const int kk = (k & ~0xC) | ((k & 4) << 1) | ((k & 8) >> 1); return ((kk >> 3) * 4 + (cc >> 5)) * 512 + ((kk & 7) * 32 + (cc & 31)) * 2; }
DEV int v_rd_base(int lane) { return ((lane & 3) << 3) | (((lane >> 2) & 3) << 6) | (((lane >> 4) & 1) << 5) | (((lane >> 5) & 1) << 8); }
constexpr int v_rd_off(int d0, int ks, int half) { return d0 * 512 + ks * 4096 + half * 2048; }
template <int OFF> DEV s16x4 tr_read(int vb) { s16x4 r; asm volatile("ds_read_b64_tr_b16 %0, %1 offset:%2" : "=&v"(r) : "v"(vb), "i"(OFF) : "memory"); return r; }
template <int D0> DEV void pv_one(f32x16& od, int vb, bf16x8 pa0, bf16x8 pa1, bf16x8 pa2, bf16x8 pa3) {
    const s16x4 l0 = tr_read<v_rd_off(D0, 0, 0)>(vb), h0 = tr_read<v_rd_off(D0, 0, 1)>(vb), l1 = tr_read<v_rd_off(D0, 1, 0)>(vb), h1 = tr_read<v_rd_off(D0, 1, 1)>(vb);
    const s16x4 l2 = tr_read<v_rd_off(D0, 2, 0)>(vb), h2 = tr_read<v_rd_off(D0, 2, 1)>(vb), l3 = tr_read<v_rd_off(D0, 3, 0)>(vb), h3 = tr_read<v_rd_off(D0, 3, 1)>(vb);
    asm volatile("s_waitcnt lgkmcnt(0)" ::: "memory"); SBAR();
#define PK(Lo, Hi) (bf16x8){Lo[0], Lo[1], Lo[2], Lo[3], Hi[0], Hi[1], Hi[2], Hi[3]}
    od = __builtin_amdgcn_mfma_f32_32x32x16_bf16(pa0, PK(l0, h0), od, 0, 0, 0);
    od = __builtin_amdgcn_mfma_f32_32x32x16_bf16(pa1, PK(l1, h1), od, 0, 0, 0);
    od = __builtin_amdgcn_mfma_f32_32x32x16_bf16(pa2, PK(l2, h2), od, 0, 0, 0);
    od = __builtin_amdgcn_mfma_f32_32x32x16_bf16(pa3, PK(l3, h3), od, 0, 0, 0);
#undef PK
}
constexpr int AT_V = 0, AT_K = 32768, AT_WS = 65536;
DEV void attn_unit(const Ctx& c, int b, int h, int qb) {
    const bf16_t* Q = (const bf16_t*)(c.ws + WS_Q); const bf16_t* KV = (const bf16_t*)(c.ws + WS_KV); const bf16_t* KR = (const bf16_t*)(c.ws + WS_KR);
    bf16_t* MG = (bf16_t*)(c.ws + WS_MG);
    unsigned char* lds = c.lds;
    const int tid = c.tid, wid = c.wid, lane = c.lane, r32 = lane & 31, hi = lane >> 5;
    float* wsf = (float*)(lds + AT_WS) + wid * 64; float* li_l = wsf; float* al_l = wsf + 32;
    const int NT = 2 * qb + 3;
    const int my_last = 2 * qb + (wid >> 1) + 1;
    bf16x8 qr[6];
    { const size_t t = (size_t)b * L + NMETA + qb * 128 + wid * 32 + r32;
      const bf16_t* Qw = Q + t * NQ + h * DQK + hi * 8;
#pragma unroll
      for (int d0 = 0; d0 < 6; ++d0) qr[d0] = *(const bf16x8*)(Qw + d0 * 16); }
    const int srow = tid >> 2, sq = tid & 3;
    const int vst0 = v_st(srow, sq * 16), vst1 = v_st(srow, sq * 16 + 8);
    const int kst0 = KSWZ(srow, sq * 32), kst1 = KSWZ(srow, sq * 32 + 16), kst2 = KSWZ(srow, 128 + sq * 16);
    const int vb0 = (int)(uintptr_t)(lds + AT_V) + v_rd_base(lane);
    u32x4 sk0, sk1, sk2, sv0, sv1;
#define SLOAD(j) do { int pos = (j) * 64 + srow - 48; pos = pos < 0 ? 0 : pos; const size_t tk = (size_t)b * L + pos; \
        const bf16_t* kvp = KV + tk * NKV + h * 128 + sq * 16; \
        sk0 = *(const u32x4*)(kvp); sk1 = *(const u32x4*)(kvp + 8); sv0 = *(const u32x4*)(kvp + 64); sv1 = *(const u32x4*)(kvp + 72); \
        sk2 = *(const u32x4*)(KR + tk * 32 + sq * 8); } while (0)
#define SWRITE(bb) do { unsigned char* kb = lds + AT_K + (bb) * 16384; unsigned char* vbp = lds + AT_V + (bb) * 16384; \
        *(u32x4*)(kb + kst0) = sk0; *(u32x4*)(kb + kst1) = sk1; *(u32x4*)(kb + kst2) = sk2; *(u32x4*)(vbp + vst0) = sv0; *(u32x4*)(vbp + vst1) = sv1; } while (0)
    float m_reg = -1e30f, l_reg = 0.f; f32x16 o[2] = {};
    __syncthreads();
    SLOAD(0); SWRITE(0); __syncthreads();
    for (int j = 0; j < NT; ++j) {
        const int bsel = j & 1;
        if (j + 1 < NT) SLOAD(j + 1);
        if (j <= my_last) {
            const unsigned char* Ks = lds + AT_K + bsel * 16384;
            f32x16 p0 = {}, p1 = {};
#pragma unroll
            for (int d0 = 0; d0 < 6; ++d0) { const int cb = (d0 * 16 + hi * 8) * 2;
                const bf16x8 k0 = *(const bf16x8*)(Ks + KSWZ(r32, cb)); const bf16x8 k1 = *(const bf16x8*)(Ks + KSWZ(32 + r32, cb));
                p0 = __builtin_amdgcn_mfma_f32_32x32x16_bf16(k0, qr[d0], p0, 0, 0, 0);
                p1 = __builtin_amdgcn_mfma_f32_32x32x16_bf16(k1, qr[d0], p1, 0, 0, 0); }
            if (j == 0) {
#pragma unroll
                for (int r = 0; r < 16; ++r) p0[r] = -1e30f;
#pragma unroll
                for (int r = 0; r < 8; ++r) p1[r] = -1e30f;
            }
            float pmax = p0[0];
#pragma unroll
            for (int r = 1; r < 16; ++r) pmax = fmaxf(pmax, p0[r]);
#pragma unroll
            for (int r = 0; r < 16; ++r) pmax = fmaxf(pmax, p1[r]);
            { auto rr = __builtin_amdgcn_permlane32_swap(__float_as_uint(pmax), __float_as_uint(pmax), false, false);
              pmax = fmaxf(__uint_as_float(rr[0]), __uint_as_float(rr[1])); }
            const float mn = fmaxf(m_reg, pmax);
            const float alpha = fast_exp2(m_reg - mn); m_reg = mn;
            float ps = 0.f;
#pragma unroll
            for (int r = 0; r < 16; ++r) { p0[r] = fast_exp2(p0[r] - mn); ps += p0[r]; }
#pragma unroll
            for (int r = 0; r < 16; ++r) { p1[r] = fast_exp2(p1[r] - mn); ps += p1[r]; }
            { auto rr = __builtin_amdgcn_permlane32_swap(__float_as_uint(ps), __float_as_uint(ps), false, false);
              ps = __uint_as_float(rr[0]) + __uint_as_float(rr[1]); }
            l_reg = l_reg * alpha + ps;
            bf16x8 pa0, pa1, pa2, pa3;
#define PK4(P, BASE, OUT) do { unsigned a0 = cvtpk(P[BASE + 0], P[BASE + 1]), a1 = cvtpk(P[BASE + 2], P[BASE + 3]);   \
    unsigned b0 = cvtpk(P[BASE + 4], P[BASE + 5]), b1 = cvtpk(P[BASE + 6], P[BASE + 7]);                              \
    auto r0 = __builtin_amdgcn_permlane32_swap(a0, b0, false, false); auto r1 = __builtin_amdgcn_permlane32_swap(a1, b1, false, false); \
    u32x4 w = {r0[0], r1[0], r0[1], r1[1]}; OUT = *reinterpret_cast<bf16x8*>(&w); } while (0)
            PK4(p0, 0, pa0); PK4(p0, 8, pa1); PK4(p1, 0, pa2); PK4(p1, 8, pa3);
#undef PK4
            if (__any(alpha < 1.f)) {
                if (hi == 0) al_l[r32] = alpha;
                asm volatile("s_waitcnt lgkmcnt(0)" ::: "memory");
#pragma unroll
                for (int r = 0; r < 16; ++r) { const float a = al_l[crow(r, hi)]; o[0][r] *= a; o[1][r] *= a; }
            }
            const int vb = vb0 + bsel * 16384;
            pv_one<0>(o[0], vb, pa0, pa1, pa2, pa3); pv_one<1>(o[1], vb, pa0, pa1, pa2, pa3);
        }
        if (j + 1 < NT) { if (bsel) SWRITE(0); else SWRITE(1); }
        __syncthreads();
    }
    if (hi == 0) li_l[r32] = l_reg;
    asm volatile("s_waitcnt lgkmcnt(0)" ::: "memory");
    const size_t tok0 = (size_t)b * SEQ + qb * 128 + wid * 32;
#pragma unroll
    for (int r = 0; r < 16; ++r) {
        const int orow = crow(r, hi); const float rl = fast_rcp(li_l[orow]);
        bf16_t* dst = MG + (tok0 + orow) * D + h * DV + r32;
        dst[0]  = (bf16_t)(cvtpk(o[0][r] * rl, 0.f) & 0xffffu);
        dst[32] = (bf16_t)(cvtpk(o[1][r] * rl, 0.f) & 0xffffu);
    }
#undef SLOAD
#undef SWRITE
}
DEV void phase3(const Ctx& c) {
    const int nslots = NB * NH * 4;
    for (int v = c.vcu; v < nslots; v += c.G) {
        const int bh = v >> 2, s = v & 3, b = bh >> 3, h = bh & 7;
        attn_unit(c, b, h, 15 - s); attn_unit(c, b, h, s); attn_unit(c, b, h, 11 - s); attn_unit(c, b, h, 4 + s);
    }
}

DEV void phase4(const Ctx& c) {
    const bf16_t* MG = (const bf16_t*)(c.ws + WS_MG); const bf16_t* WoT = (const bf16_t*)(c.ws + WS_WO); const bf16_t* h0 = (const bf16_t*)(c.ws + WS_H0);
    float* R1 = (float*)(c.ws + WS_R1);
    const StageGeo g = stage_geo(c.tid);
    const int lane = c.lane, wr = c.wid >> 1, wc = c.wid & 1, fr = lane & 15, fq = lane >> 4;
    constexpr int NU = (TR / 128) * 8;
    for (int u = c.vcu; u < NU; u += c.G) {
        const int mt = u >> 3, nt = u & 7;
        const bf16_t* A = MG + (size_t)(mt * 128) * D + g.c; const bf16_t* B = WoT + (size_t)(nt * 128) * D + g.c;
        f32x4 acc[4][4];
        gemm_mainloop<true>(acc, A + (size_t)g.r[0] * D, A + (size_t)g.r[1] * D, A + (size_t)g.r[2] * D, A + (size_t)g.r[3] * D,
                            B + (size_t)g.r[0] * D, B + (size_t)g.r[1] * D, B + (size_t)g.r[2] * D, B + (size_t)g.r[3] * D, 16, c.lds, 8, 1.f / 512.f);
#pragma unroll
        for (int m = 0; m < 4; ++m) {
            const int tok = mt * 128 + wr * 64 + m * 16 + fr;
            const size_t t = (size_t)(tok >> 11) * L + NMETA + (tok & 2047);
#pragma unroll
            for (int n = 0; n < 4; ++n) {
                const int col = nt * 128 + wc * 64 + n * 16 + fq * 4;
                const u32x2 hw = *(const u32x2*)(h0 + t * D + col);
                f32x4 o; o[0] = ALPHA * bflo(hw.x) + acc[m][n][0]; o[1] = ALPHA * bfhi(hw.x) + acc[m][n][1];
                o[2] = ALPHA * bflo(hw.y) + acc[m][n][2]; o[3] = ALPHA * bfhi(hw.y) + acc[m][n][3];
                *(f32x4*)(R1 + (size_t)tok * D + col) = o;
            }
        }
    }
}

constexpr int P5_ROWB = 2064, P5_PART = 33280;
DEV void phase5(const Ctx& c) {
    const float* R1 = (const float*)(c.ws + WS_R1); bf16_t* H1 = (bf16_t*)(c.ws + WS_H0);
    const bf16_t* WrT = (const bf16_t*)(c.ws + WS_WR);
    unsigned* cnt = (unsigned*)(c.ws + WS_CTL) + CW_CNT; unsigned* list = (unsigned*)(c.ws + WS_LIST); float* combw = (float*)(c.ws + WS_COMBW);
    const int lane = c.lane, wid = c.wid, fr = lane & 15, fq = lane >> 4;
    float* part = (float*)(c.lds + P5_PART);
    for (int u = c.vcu; u < TR / 16; u += c.G) {
        const int tok0 = u * 16;
        __syncthreads();
#pragma unroll 1
        for (int i = 0; i < 4; ++i) { const int tl = wid * 4 + i; const size_t tok = tok0 + tl;
            ln_row_bf16(R1 + tok * D, c.in[I_LN1G], c.in[I_LN1B], H1 + tok * D, c.lds + tl * P5_ROWB, lane); }
        __syncthreads();
        f32x4 acc[3] = {};
#pragma unroll
        for (int ks = 0; ks < 8; ++ks) {
            const int k = wid * 256 + ks * 32 + fq * 8;
            const bf16x8 a = *(const bf16x8*)(c.lds + fr * P5_ROWB + k * 2);
#pragma unroll
            for (int n = 0; n < 3; ++n) { const bf16x8 w = *(const bf16x8*)(WrT + (size_t)(n * 16 + fr) * D + k);
                acc[n] = __builtin_amdgcn_mfma_f32_16x16x32_bf16(w, a, acc[n], 0, 0, 0); }
        }
#pragma unroll
        for (int n = 0; n < 3; ++n) *(f32x4*)(part + (wid * 16 + fr) * 48 + n * 16 + fq * 4) = acc[n];
        __syncthreads();
        if (c.tid < 16) {
            float* lg = part + c.tid * 48;
            const float* brg = c.in[I_BRG]; const float* bre = c.in[I_BRE];
#pragma unroll 4
            for (int i = 0; i < 36; ++i) { const float bias = (i < 4) ? brg[i] : bre[i - 4];
                lg[i] = ((lg[i] + part[(16 + c.tid) * 48 + i]) + (part[(32 + c.tid) * 48 + i] + part[(48 + c.tid) * 48 + i])) + bias; }
            int gi = 0; float gm = lg[0];
#pragma unroll
            for (int i = 1; i < 4; ++i) { const float v = lg[i]; if (v > gm) { gm = v; gi = i; } }
            float gs = 0.f;
#pragma unroll
            for (int i = 0; i < 4; ++i) gs += __expf(lg[i] - gm);
            const float gw = 1.f / gs;
            const float* le = lg + 4 + gi * 8;
            float v0 = le[0], v1 = -3.0e38f; int i0 = 0, i1 = 0;
#pragma unroll
            for (int i = 1; i < 8; ++i) { const float v = le[i];
                if (v > v0) { v1 = v0; i1 = i0; v0 = v; i0 = i; } else if (v > v1) { v1 = v; i1 = i; } }
            const float ex = __expf(v1 - v0), inv = 1.f / (1.f + ex);
            const int tok = tok0 + c.tid; const int e0 = gi * 8 + i0, e1 = gi * 8 + i1;
            combw[tok * 2] = gw * inv; combw[tok * 2 + 1] = gw * ex * inv;
            const unsigned s0 = atomicAdd(&cnt[e0], 1u); list[(size_t)e0 * TR + s0] = (unsigned)(tok * 2);
            const unsigned s1 = atomicAdd(&cnt[e1], 1u); list[(size_t)e1 * TR + s1] = (unsigned)(tok * 2 + 1);
        }
    }
}

DEV void moe_tiles(const Ctx& c) {
    const unsigned* cnt = (const unsigned*)(c.ws + WS_CTL) + CW_CNT; int* ts = (int*)(c.lds + EXP_OFF);
    __syncthreads();
    if (c.tid == 0) { int s = 0; for (int e = 0; e < NE; ++e) { ts[e] = s; s += (int)((__hip_atomic_load(&cnt[e], __ATOMIC_RELAXED, __HIP_MEMORY_SCOPE_AGENT) + 127u) >> 7); } ts[NE] = s; }
    __syncthreads();
}
DEV int moe_find(const int* ts, int rt) { int e = 0;
#pragma unroll 1
    for (int i = 1; i < NE; ++i) if (ts[i] <= rt) e = i;
    return e; }
DEV void phase6a(const Ctx& c) {
    const bf16_t* H1 = (const bf16_t*)(c.ws + WS_H0); const bf16_t* WguT = (const bf16_t*)(c.ws + WS_WGU); bf16_t* ACT = (bf16_t*)(c.ws + WS_ACT);
    const unsigned* cnt = (const unsigned*)(c.ws + WS_CTL) + CW_CNT; const unsigned* list = (const unsigned*)(c.ws + WS_LIST);
    moe_tiles(c);
    const int* ts = (const int*)(c.lds + EXP_OFF); unsigned* tbl = (unsigned*)(c.lds + TBL_OFF);
    const StageGeo g = stage_geo(c.tid);
    const int lane = c.lane, wr = c.wid >> 1, wc = c.wid & 1, fr = lane & 15, fq = lane >> 4;
    const int NU = ts[NE] * 4;
    for (int u = c.vcu; u < NU; u += c.G) {
        const int rt = u >> 2, nt = u & 3; const int e = moe_find(ts, rt);
        const int j0 = (rt - ts[e]) * 128; const int ne = (int)cnt[e];
        __syncthreads();
        if (c.tid < 128) { const int j = j0 + c.tid; tbl[c.tid] = (j < ne) ? list[(size_t)e * TR + j] : 0xffffffffu; }
        __syncthreads();
        size_t ro[4];
#pragma unroll
        for (int i = 0; i < 4; ++i) { const unsigned en = tbl[g.r[i]]; ro[i] = (en == 0xffffffffu) ? 0 : (size_t)(en >> 1) * D; }
        const bf16_t* A = H1 + g.c; const bf16_t* B = WguT + ((size_t)e * 512 + nt * 128) * D + g.c;
        f32x4 acc[4][4];
        gemm_mainloop<false>(acc, A + ro[0], A + ro[1], A + ro[2], A + ro[3],
                             B + (size_t)g.r[0] * D, B + (size_t)g.r[1] * D, B + (size_t)g.r[2] * D, B + (size_t)g.r[3] * D, 16, c.lds, 0, 0.f);
#pragma unroll
        for (int m = 0; m < 4; ++m) { const size_t row = (size_t)rt * 128 + wr * 64 + m * 16 + fr;
#pragma unroll
            for (int i = 0; i < 2; ++i) {
                const f32x4 gt = acc[m][2 * i], up = acc[m][2 * i + 1]; f32x4 o;
#pragma unroll
                for (int j = 0; j < 4; ++j) o[j] = gt[j] * sigmoidf_(gt[j]) * up[j];
                st_bf4(ACT + row * DE + nt * 64 + wc * 32 + i * 16 + fq * 4, o);
            } }
    }
}
DEV void phase6b(const Ctx& c) {
    const bf16_t* ACT = (const bf16_t*)(c.ws + WS_ACT); const bf16_t* WdT = (const bf16_t*)(c.ws + WS_WD); bf16_t* Y = (bf16_t*)(c.ws + WS_Y);
    const unsigned* cnt = (const unsigned*)(c.ws + WS_CTL) + CW_CNT; const unsigned* list = (const unsigned*)(c.ws + WS_LIST); const float* combw = (const float*)(c.ws + WS_COMBW);
    moe_tiles(c);
    const int* ts = (const int*)(c.lds + EXP_OFF); unsigned* tbl = (unsigned*)(c.lds + TBL_OFF);
    const StageGeo g = stage_geo(c.tid);
    const int lane = c.lane, wr = c.wid >> 1, wc = c.wid & 1, fr = lane & 15, fq = lane >> 4;
    const int NU = ts[NE] * 8;
    for (int u = c.vcu; u < NU; u += c.G) {
        const int rt = u >> 3, nt = u & 7; const int e = moe_find(ts, rt);
        const int j0 = (rt - ts[e]) * 128; const int ne = (int)cnt[e];
        __syncthreads();
        if (c.tid < 128) { const int j = j0 + c.tid; tbl[c.tid] = (j < ne) ? list[(size_t)e * TR + j] : 0xffffffffu; }
        const bf16_t* A = ACT + (size_t)(rt * 128) * DE + g.c; const bf16_t* B = WdT + ((size_t)e * 1024 + nt * 128) * DE + g.c;
        f32x4 acc[4][4];
        gemm_mainloop<false>(acc, A + (size_t)g.r[0] * DE, A + (size_t)g.r[1] * DE, A + (size_t)g.r[2] * DE, A + (size_t)g.r[3] * DE,
                             B + (size_t)g.r[0] * DE, B + (size_t)g.r[1] * DE, B + (size_t)g.r[2] * DE, B + (size_t)g.r[3] * DE, 4, c.lds, 0, 0.f);
#pragma unroll
        for (int m = 0; m < 4; ++m) {
            const unsigned en = tbl[wr * 64 + m * 16 + fr];
            if (en != 0xffffffffu) {
                const float w = combw[en]; bf16_t* dst = Y + ((size_t)(en & 1u) * TR + (en >> 1)) * D + nt * 128 + wc * 64 + fq * 4;
#pragma unroll
                for (int n = 0; n < 4; ++n) st_bf4(dst + n * 16, acc[m][n] * w);
            }
        }
    }
}

DEV void phase7(const Ctx& c) {
    const bf16_t* H1 = (const bf16_t*)(c.ws + WS_H0); const bf16_t* Y = (const bf16_t*)(c.ws + WS_Y);
    const float* g = c.in[I_LN2G]; const float* bt = c.in[I_LN2B];
    const int gw = c.vcu * 4 + c.wid, NGW = c.G * 4, lane = c.lane;
    for (int tok = gw; tok < TR; tok += NGW) {
        float v[16]; float s = 0.f;
#pragma unroll
        for (int i = 0; i < 2; ++i) {
            const u32x4 hw = *(const u32x4*)(H1 + (size_t)tok * D + i * 512 + lane * 8);
            const u32x4 y0 = *(const u32x4*)(Y + (size_t)tok * D + i * 512 + lane * 8);
            const u32x4 y1 = *(const u32x4*)(Y + ((size_t)TR + tok) * D + i * 512 + lane * 8);
#pragma unroll
            for (int q = 0; q < 4; ++q) {
                v[i * 8 + 2 * q]     = ALPHA * bflo(hw[q]) + (bflo(y0[q]) + bflo(y1[q]));
                v[i * 8 + 2 * q + 1] = ALPHA * bfhi(hw[q]) + (bfhi(y0[q]) + bfhi(y1[q]));
            }
        }
#pragma unroll
        for (int q = 0; q < 16; ++q) s += v[q];
        const float mean = wave_sum(s) * (1.f / 1024.f); float s2 = 0.f;
#pragma unroll
        for (int q = 0; q < 16; ++q) { v[q] -= mean; s2 += v[q] * v[q]; }
        const float rstd = 1.f / sqrtf(wave_sum(s2) * (1.f / 1024.f) + EPS);
#pragma unroll
        for (int i = 0; i < 2; ++i)
#pragma unroll
            for (int q = 0; q < 2; ++q) {
                const int col = i * 512 + lane * 8 + q * 4;
                const f32x4 gg = *(const f32x4*)(g + col), bb = *(const f32x4*)(bt + col);
                f32x4 o; o[0] = v[i * 8 + q * 4] * rstd * gg[0] + bb[0]; o[1] = v[i * 8 + q * 4 + 1] * rstd * gg[1] + bb[1];
                o[2] = v[i * 8 + q * 4 + 2] * rstd * gg[2] + bb[2]; o[3] = v[i * 8 + q * 4 + 3] * rstd * gg[3] + bb[3];
                *(f32x4*)(c.out + (size_t)tok * D + col) = o;
            }
    }
}

__global__ void __launch_bounds__(256, 2) fwd_kernel(Args a) {
    extern __shared__ __attribute__((aligned(16))) unsigned char lds[];
    Ctx c; c.in = a.in; c.out = a.out; c.ws = a.ws; c.lds = lds;
    c.tid = threadIdx.x; c.lane = c.tid & 63; c.wid = __builtin_amdgcn_readfirstlane(c.tid >> 6);
    c.G = gridDim.x; { const int bx = blockIdx.x; c.vcu = (c.G % 8 == 0) ? (bx % 8) * (c.G / 8) + bx / 8 : bx; }
    if (c.tid < 64) ((unsigned*)(lds + MISC_OFF))[c.tid] = 0u;
    __syncthreads();
    unsigned* ctl = (unsigned*)(a.ws + WS_CTL);
    XcdBarrier bar = xcd_barrier_post(ctl + CW_BAR, (volatile LAS unsigned*)(lds + MISC_OFF));
#ifdef ONLY_PH
#define PH_ON(k) ((k) == ONLY_PH)
#else
#define PH_ON(k) 1
#endif
    const int lo = a.ph_lo, hi = a.ph_hi;
#define RUN_PHASE(k, fn) if (PH_ON(k) && lo <= (k) && (k) < hi) { \
        int _t = threadIdx.x; asm volatile("" : "+v"(_t)); c.tid = _t; c.lane = _t & 63; c.wid = __builtin_amdgcn_readfirstlane(_t >> 6); \
        fn(c); if ((k) + 1 < hi) xcd_barrier(bar); }
    RUN_PHASE(0, phase0)
    RUN_PHASE(1, phase1)
    RUN_PHASE(2, phase2)
    RUN_PHASE(3, phase3)
    RUN_PHASE(4, phase4)
    RUN_PHASE(5, phase5)
    RUN_PHASE(6, phase6a)
    RUN_PHASE(7, phase6b)
    RUN_PHASE(8, phase7)
}

extern "C" void kernel_launch(void* const* d_in, const int* in_sizes, int n_in, void* d_out, int out_size, void* d_ws, size_t ws_size, hipStream_t stream) {
    static int grid = 0;
    if (grid == 0) {
        if (n_in != 27 || in_sizes[0] != NB * SEQ * D || out_size != TR * D || ws_size < WS_END) {
            fprintf(stderr, "kernel_launch: shape mismatch n_in %d in0 %d out %d ws %zu\n", n_in, n_in > 0 ? in_sizes[0] : -1, out_size, ws_size); grid = -1; return; }
        int dev = 0, cus = 0, per_cu = 0;
        if (hipGetDevice(&dev) != hipSuccess || hipDeviceGetAttribute(&cus, hipDeviceAttributeMultiprocessorCount, dev) != hipSuccess) { grid = -1; return; }
        if (hipFuncSetAttribute((const void*)fwd_kernel, hipFuncAttributeMaxDynamicSharedMemorySize, LDS_BYTES) != hipSuccess) { grid = -1; return; }
        if (hipOccupancyMaxActiveBlocksPerMultiprocessor(&per_cu, (const void*)fwd_kernel, 256, LDS_BYTES) != hipSuccess || per_cu < 1) per_cu = 1;
        (void)hipGetLastError();
        if (per_cu > 2) per_cu = 2;
        grid = cus * per_cu;
        fprintf(stderr, "kernel_launch: grid %d (%d per CU)\n", grid, per_cu);
    }
    if (grid < 0) return;
    (void)hipMemsetAsync((char*)d_ws + WS_CTL, 0, CTL_ZERO_BYTES, stream);
    Args a{};
    for (int i = 0; i < 27; ++i) a.in[i] = (const float*)d_in[i];
    a.out = (float*)d_out; a.ws = (unsigned char*)d_ws;
    if (MK_N_LAUNCHES == 1) {
        a.ph_lo = 0; a.ph_hi = NPH;
        hipLaunchKernelGGL(fwd_kernel, dim3(grid), dim3(256), LDS_BYTES, stream, a);
    } else {
        for (int ph = 0; ph < NPH; ++ph) { a.ph_lo = ph; a.ph_hi = ph + 1; hipLaunchKernelGGL(fwd_kernel, dim3(grid), dim3(256), LDS_BYTES, stream, a); }
    }
}
```

```cpp
#include <hip/hip_runtime.h>
#include <cstdio>
#include <cstdint>

#ifndef MK_N_LAUNCHES
#define MK_N_LAUNCHES 1
#endif

#define DEV __device__ __forceinline__
#define LAS __attribute__((address_space(3)))
#define GAS __attribute__((address_space(1)))
typedef unsigned short bf16_t;
typedef short bf16x8 __attribute__((ext_vector_type(8)));
typedef short s16x4 __attribute__((ext_vector_type(4)));
typedef float f32x4 __attribute__((ext_vector_type(4)));
typedef float f32x16 __attribute__((ext_vector_type(16)));
typedef unsigned u32x4 __attribute__((ext_vector_type(4)));
typedef unsigned u32x2 __attribute__((ext_vector_type(2)));

constexpr int NB = 16, SEQ = 2048, NMETA = 16, L = SEQ + NMETA;
constexpr int T = NB * L;
constexpr int TR = NB * SEQ;
constexpr int D = 1024, NIN = 1696, CC = 512, QL = 384, KVL = 256, NH = 8, DQK = 96, DV = 64;
constexpr int NQ = NH * DQK;
constexpr int NKV = NH * (64 + DV);
constexpr int NE = 32, DE = 256, CONVK = 31;
constexpr float EPS = 1e-5f;
constexpr float ALPHA = 1.189207115002721f;
constexpr float QSCALE = 0.10206207261596577f * 1.4426950408889634f;
constexpr int NPH = 9;

constexpr size_t MiB = 1u << 20;
constexpr size_t WS_CTL = 0, CTL_ZERO_BYTES = 64 * 1024;
constexpr int CW_CNT = 64;
constexpr int CW_BAR = 4096;
constexpr size_t WS_LIST = 1 * MiB;
constexpr size_t WS_COMBW = 5 * MiB;
constexpr size_t WS_ROPE = 5 * MiB + 512 * 1024;
constexpr size_t WS_WIN = 6 * MiB;
constexpr size_t WS_WUQ = 10 * MiB;
constexpr size_t WS_WUKV = 11 * MiB;
constexpr size_t WS_WO = 12 * MiB;
constexpr size_t WS_WR = 14 * MiB;
constexpr size_t WS_WGU = 16 * MiB;
constexpr size_t WS_WD = 48 * MiB;
constexpr size_t WS_H0 = 64 * MiB;
constexpr size_t WS_U = 130 * MiB;
constexpr size_t WS_CQ = 163 * MiB;
constexpr size_t WS_CKV = 188 * MiB;
constexpr size_t WS_KR = 205 * MiB;
constexpr size_t WS_Q = 208 * MiB;
constexpr size_t WS_KV = 257 * MiB;
constexpr size_t WS_R1 = 208 * MiB;
constexpr size_t WS_Y = 208 * MiB;
constexpr size_t WS_MG = 336 * MiB;
constexpr size_t WS_ACT = 336 * MiB;
constexpr size_t WS_END = 400 * MiB;

constexpr int LDS_BYTES = 73728;
constexpr int MISC_OFF = LDS_BYTES - 256;
constexpr int RS_OFF = 65536;
constexpr int TBL_OFF = 66048;
constexpr int EXP_OFF = 66560;

DEV unsigned cvtpk(float lo, float hi) { unsigned r; asm("v_cvt_pk_bf16_f32 %0, %1, %2" : "=v"(r) : "v"(lo), "v"(hi)); return r; }
DEV float bflo(unsigned w) { return __uint_as_float(w << 16); }
DEV float bfhi(unsigned w) { return __uint_as_float(w & 0xffff0000u); }
DEV float wave_sum(float v) {
#pragma unroll
    for (int o = 1; o < 64; o <<= 1) v += __shfl_xor(v, o);
    return v;
}
DEV void st_bf4(bf16_t* p, f32x4 v) { u32x2 w = {cvtpk(v[0], v[1]), cvtpk(v[2], v[3])}; *(u32x2*)p = w; }
DEV float fast_exp2(float x) { return __builtin_amdgcn_exp2f(x); }
DEV float fast_rcp(float x) { return __builtin_amdgcn_rcpf(x); }
DEV float sigmoidf_(float g) { return fast_rcp(1.f + fast_exp2(-1.4426950408889634f * g)); }
#define LDS_WAIT() asm volatile("s_waitcnt lgkmcnt(0)" ::: "memory")
#define VM_WAIT() asm volatile("s_waitcnt vmcnt(0)" ::: "memory")

#define XB_TMO      128
#define XB_XCNT(j)  (256  + 64 * (j))
#define XB_XSUB(j)  (1280 + 64 * (j))
#define XB_XGEN(j)  (2304 + 64 * (j))
#define XB_TOP      3328
#define XB_TOPGEN   3392
#define XCD_BAR_WORDS 3456
#define XB_SPIN_CAP (1u << 22)
DEV unsigned xb_ld(unsigned* p)              { return __hip_atomic_load(p, __ATOMIC_RELAXED, __HIP_MEMORY_SCOPE_AGENT); }
DEV unsigned xb_add(unsigned* p, unsigned v) { return __hip_atomic_fetch_add(p, v, __ATOMIC_RELAXED, __HIP_MEMORY_SCOPE_AGENT); }
DEV unsigned xb_xcc_id() { return (unsigned)__builtin_amdgcn_s_getreg((3 << 11) | 20) & 0xFu; }
#define XB_SPIN(cond, bar) do { unsigned _sp = 0; while (cond) { __builtin_amdgcn_s_sleep(1); \
    if ((++_sp & 255u) == 0u) { if (xb_ld(&(bar)[XB_TMO])) break; if (_sp > XB_SPIN_CAP) { atomicAdd(&(bar)[XB_TMO], 1u); break; } } } } while (0)
struct XcdBarrier { unsigned* bar; unsigned x; volatile LAS unsigned* st; };
DEV XcdBarrier xcd_barrier_post(unsigned* bar, volatile LAS unsigned* st) {
    XcdBarrier b; b.bar = bar; b.x = xb_xcc_id(); b.st = st;
    if (threadIdx.x == 0) (void)xb_add(&bar[XB_XCNT(b.x)], 1u);
    return b;
}
DEV void xcd_barrier_complete(unsigned* bar, unsigned x, unsigned& nloc, unsigned& nx) {
    const unsigned G = gridDim.x * gridDim.y * gridDim.z;
    unsigned sum, cnt, mine, sp = 0u;
    for (;;) {
        sum = 0u; cnt = 0u; mine = 0u;
#pragma unroll
        for (unsigned j = 0; j < 16; ++j) { const unsigned c = xb_ld(&bar[XB_XCNT(j)]); sum += c; cnt += (c > 0u) ? 1u : 0u; mine = (j == x) ? c : mine; }
        if (sum == G) break;
        __builtin_amdgcn_s_sleep(1);
        if ((++sp & 255u) == 0u) { if (xb_ld(&bar[XB_TMO])) break; if (sp > XB_SPIN_CAP) { atomicAdd(&bar[XB_TMO], 1u); break; } }
    }
    nloc = mine > 0u ? mine : 1u; nx = cnt > 0u ? cnt : 1u;
}
DEV void xcd_barrier(const XcdBarrier& b) {
    asm volatile("s_waitcnt vmcnt(0)" ::: "memory");
    __syncthreads();
    if (threadIdx.x == 0) {
        unsigned* bar = b.bar;
        __builtin_amdgcn_s_waitcnt(0);
        unsigned nloc = b.st[0], nx = b.st[1];
        if (nloc == 0u) { xcd_barrier_complete(bar, b.x, nloc, nx); b.st[0] = nloc; b.st[1] = nx; }
        const unsigned old = xb_add(&bar[XB_XSUB(b.x)], 1u);
        const unsigned gen = old / nloc;
        if (old + 1u == (gen + 1u) * nloc) {
            __builtin_amdgcn_fence(__ATOMIC_RELEASE, "agent");
            asm volatile("s_waitcnt vmcnt(0)" ::: "memory");
            const unsigned og = xb_add(&bar[XB_TOP], 1u);
            const unsigned tg = og / nx;
            if (og + 1u == (tg + 1u) * nx) xb_add(&bar[XB_TOPGEN], 1u);
            else XB_SPIN(xb_ld(&bar[XB_TOPGEN]) == tg, bar);
            __builtin_amdgcn_fence(__ATOMIC_ACQUIRE, "agent");
            xb_add(&bar[XB_XGEN(b.x)], 1u);
            asm volatile("s_waitcnt vmcnt(0)" ::: "memory");
        } else {
            XB_SPIN(xb_ld(&bar[XB_XGEN(b.x)]) == gen, bar);
            __builtin_amdgcn_fence(__ATOMIC_ACQUIRE, "agent");
            asm volatile("s_waitcnt vmcnt(0)" ::: "memory");
        }
    }
    __syncthreads();
}

struct Args { const float* in[27]; float* out; unsigned char* ws; int ph_lo, ph_hi; };
struct Ctx {
    const float* const* in; float* out; unsigned char* ws; unsigned char* lds;
    int tid, lane, wid, vcu, G;
};
enum { I_X = 0, I_META, I_LNIN_G, I_LNIN_B, I_WIN, I_CONVW, I_CONVB, I_CLN_G, I_CLN_B, I_QNG, I_WUQ, I_KVNG, I_WUKV, I_COUT_G, I_AOUT_G, I_WO,
       I_LN1G, I_LN1B, I_WRG, I_BRG, I_WRE, I_BRE, I_WGATE, I_WUP, I_WDOWN, I_LN2G, I_LN2B };

DEV int nmap(int mode, int n) {
    if (mode == 1) { if (n < 512) return ((n >> 4) << 5) + (n & 15); if (n < 1024) return (((n - 512) >> 4) << 5) + 16 + (n & 15); return n; }
    if (mode == 2) return ((n >> 4) << 5) + (n & 15);
    if (mode == 3) return ((n >> 4) << 5) + 16 + (n & 15);
    return n;
}
DEV void p0_transpose_item(const float* __restrict__ W, int N, int k0, int n0, const float* __restrict__ kscale, bf16_t* WT, int ldt, int kout0, int mode,
                           float* scr, int lane) {
#pragma unroll 8
    for (int i = 0; i < 32; ++i) {
        const int kk = 2 * i + (lane >> 5);
        float v = W[(size_t)(k0 + kk) * N + n0 + (lane & 31)];
        if (kscale) v *= kscale[k0 + kk];
        scr[kk * 33 + (lane & 31)] = v;
    }
    LDS_WAIT(); asm volatile("" ::: "memory");
    const int c = lane & 7;
#pragma unroll
    for (int j = 0; j < 4; ++j) {
        const int n = (lane >> 3) + 8 * j; const float* s = scr + (8 * c) * 33 + n;
        u32x4 o; o.x = cvtpk(s[0 * 33], s[1 * 33]); o.y = cvtpk(s[2 * 33], s[3 * 33]); o.z = cvtpk(s[4 * 33], s[5 * 33]); o.w = cvtpk(s[6 * 33], s[7 * 33]);
        *(u32x4*)(WT + (size_t)nmap(mode, n0 + n) * ldt + kout0 + 8 * c) = o;
    }
    LDS_WAIT(); asm volatile("" ::: "memory");
}
DEV void ln_row_bf16(const float* xrow, const float* g, const float* bta, bf16_t* orow, unsigned char* ldsrow, int lane, float pre_scale = 1.f) {
    f32x4 v[4]; float s = 0.f;
#pragma unroll
    for (int j = 0; j < 4; ++j) { v[j] = ((const f32x4*)xrow)[64 * j + lane]; v[j] = v[j] * pre_scale; s += (v[j].x + v[j].y) + (v[j].z + v[j].w); }
    const float mean = wave_sum(s) * (1.f / 1024.f); float s2 = 0.f;
#pragma unroll
    for (int j = 0; j < 4; ++j) { v[j] = v[j] - mean; s2 += (v[j].x * v[j].x + v[j].y * v[j].y) + (v[j].z * v[j].z + v[j].w * v[j].w); }
    const float rstd = 1.f / sqrtf(wave_sum(s2) * (1.f / 1024.f) + EPS);
#pragma unroll
    for (int j = 0; j < 4; ++j) {
        const f32x4 gg = ((const f32x4*)g)[64 * j + lane], bb = ((const f32x4*)bta)[64 * j + lane];
        f32x4 o = v[j] * rstd * gg + bb;
        u32x2 w = {cvtpk(o.x, o.y), cvtpk(o.z, o.w)};
        ((u32x2*)orow)[64 * j + lane] = w;
        if (ldsrow) ((u32x2*)ldsrow)[64 * j + lane] = w;
    }
}
__device__ const float INVF[16] = {1.0f, 0.5623413251903491f, 0.31622776601683794f, 0.1778279410038923f, 0.1f, 0.05623413251903491f, 0.031622776601683794f,
    0.01778279410038923f, 0.01f, 0.005623413251903491f, 0.0031622776601683794f, 0.001778279410038923f, 0.001f, 0.0005623413251903491f, 0.00031622776601683794f, 0.0001778279410038923f};
DEV void sincos_d(double a, float& sn, float& cs) {
    const double TWO_PI = 6.283185307179586476925286766559;
    const double k = __builtin_rint(a / TWO_PI);
    const double r = a - k * TWO_PI;
    const double r2 = r * r;
    double st = r, ct = 1.0, ssum = r, csum = 1.0;
#pragma unroll 1
    for (int i = 1; i <= 14; ++i) {
        ct = -ct * r2 / (double)((2 * i - 1) * (2 * i));  csum += ct;
        st = -st * r2 / (double)((2 * i) * (2 * i + 1));  ssum += st;
    }
    sn = (float)ssum; cs = (float)csum;
}
DEV void phase0(const Ctx& c) {
    float* scr = (float*)(c.lds + c.wid * 8448);
    const int gw = c.vcu * 4 + c.wid, NGW = c.G * 4;
    constexpr int I_IN = 16 * 53, I_UQ = 6 * 24, I_UKV = 4 * 32, I_O = 16 * 32, I_G = 32 * 128, I_U = I_G, I_D = 32 * 128;
    constexpr int NITEMS = I_IN + I_UQ + I_UKV + I_O + I_G + I_U + I_D;
    bf16_t* WinT = (bf16_t*)(c.ws + WS_WIN); bf16_t* WuqT = (bf16_t*)(c.ws + WS_WUQ); bf16_t* WukvT = (bf16_t*)(c.ws + WS_WUKV);
    bf16_t* WoT = (bf16_t*)(c.ws + WS_WO); bf16_t* WguT = (bf16_t*)(c.ws + WS_WGU); bf16_t* WdT = (bf16_t*)(c.ws + WS_WD);
    for (int it = gw; it < NITEMS; it += NGW) {
        int r = it;
        if (r < I_IN) { const int kb = r / 53, nb = r % 53; p0_transpose_item(c.in[I_WIN], NIN, 64 * kb, 32 * nb, nullptr, WinT, 1024, 64 * kb, 1, scr, c.lane); continue; } r -= I_IN;
        if (r < I_UQ) { const int kb = r / 24, nb = r % 24; p0_transpose_item(c.in[I_WUQ], NQ, 64 * kb, 32 * nb, c.in[I_QNG], WuqT, QL, 64 * kb, 0, scr, c.lane); continue; } r -= I_UQ;
        if (r < I_UKV) { const int kb = r / 32, nb = r % 32; p0_transpose_item(c.in[I_WUKV], NKV, 64 * kb, 32 * nb, c.in[I_KVNG], WukvT, KVL, 64 * kb, 0, scr, c.lane); continue; } r -= I_UKV;
        if (r < I_O) { const int kb = r / 32, nb = r % 32;
            if (kb < 8) p0_transpose_item(c.in[I_WO], D, 64 * kb, 32 * nb, nullptr, WoT, 1024, 64 * kb + 512, 0, scr, c.lane);
            else        p0_transpose_item(c.in[I_WO], D, 64 * kb, 32 * nb, c.in[I_AOUT_G] - 512, WoT, 1024, 64 * kb - 512, 0, scr, c.lane);
            continue; } r -= I_O;
        if (r < I_G) { const int e = r >> 7, q = r & 127, kb = q >> 3, nb = q & 7;
            p0_transpose_item(c.in[I_WGATE] + (size_t)e * D * DE, DE, 64 * kb, 32 * nb, nullptr, WguT + (size_t)e * 512 * 1024, 1024, 64 * kb, 2, scr, c.lane); continue; } r -= I_G;
        if (r < I_U) { const int e = r >> 7, q = r & 127, kb = q >> 3, nb = q & 7;
            p0_transpose_item(c.in[I_WUP] + (size_t)e * D * DE, DE, 64 * kb, 32 * nb, nullptr, WguT + (size_t)e * 512 * 1024, 1024, 64 * kb, 3, scr, c.lane); continue; } r -= I_U;
        { const int e = r >> 7, q = r & 127, kb = q >> 5, nb = q & 31;
            p0_transpose_item(c.in[I_WDOWN] + (size_t)e * DE * D, D, 64 * kb, 32 * nb, nullptr, WdT + (size_t)e * 1024 * 256, 256, 64 * kb, 0, scr, c.lane); }
    }
    const int gt = c.vcu * 256 + c.tid, NGT = c.G * 256;
    bf16_t* WrT = (bf16_t*)(c.ws + WS_WR);
    for (int i = gt; i < 48 * 1024; i += NGT) {
        const int n = i >> 10, k = i & 1023; float v = 0.f;
        if (n < 4) v = c.in[I_WRG][k * 4 + n]; else if (n < 36) v = c.in[I_WRE][k * 32 + (n - 4)];
        WrT[i] = (bf16_t)(cvtpk(v, 0.f) & 0xffffu);
    }
    float* rc = (float*)(c.ws + WS_ROPE); float* rs = rc + L * 16;
    for (int i = gt; i < L * 16; i += NGT) {
        const int p = i >> 4, f = i & 15; const float ang = (float)p * INVF[f];
        float sn, cs; sincos_d((double)ang, sn, cs); rc[i] = cs; rs[i] = sn;
    }
    bf16_t* h0 = (bf16_t*)(c.ws + WS_H0);
    for (int t = gw; t < T; t += NGW) {
        const int b = t / L, p = t - b * L;
        const float* src = (p < NMETA) ? c.in[I_META] + (size_t)p * D : c.in[I_X] + ((size_t)b * SEQ + (p - NMETA)) * D;
        ln_row_bf16(src, c.in[I_LNIN_G], c.in[I_LNIN_B], h0 + (size_t)t * D, nullptr, c.lane);
    }
}

struct StageGeo { int r[4]; int c; };
DEV StageGeo stage_geo(int tid) {
    const int lane = tid & 63, wid = tid >> 6; StageGeo g;
    const int rl = lane >> 2, cl = ((lane & 3) * 8) ^ ((lane >> 5) << 4);
#pragma unroll
    for (int i = 0; i < 4; ++i) g.r[i] = (((wid + 4 * i) >> 1) << 4) + rl;
    g.c = ((wid & 1) << 5) + cl;
    return g;
}
template <bool SSQ>
DEV void gemm_mainloop(f32x4 (&acc)[4][4], const bf16_t* ap0, const bf16_t* ap1, const bf16_t* ap2, const bf16_t* ap3,
                       const bf16_t* bp0, const bf16_t* bp1, const bf16_t* bp2, const bf16_t* bp3,
                       int nk, unsigned char* lds, int ssq_steps, float ssq_inv_dim) {
    const int tid = threadIdx.x, lane = tid & 63, wid = tid >> 6, wr = wid >> 1, wc = wid & 1, fr = lane & 15, fq = lane >> 4;
    const int lo = ((fr * 64 + fq * 16) ^ ((fr >> 3) << 5));
    const int a_off = (wr * 4) * 2048 + lo, b_off = 16384 + (wc * 4) * 2048 + lo;
    const int dst = tid * 16;
    float ssq = 0.f;
#pragma unroll
    for (int m = 0; m < 4; ++m)
#pragma unroll
        for (int n = 0; n < 4; ++n) acc[m][n] = (f32x4){0.f, 0.f, 0.f, 0.f};
    __syncthreads();
#define GLDS(src, off) __builtin_amdgcn_global_load_lds((const unsigned*)(src), (unsigned LAS*)(lds + (off)), 16, 0, 0)
#define STAGE(kt, b) do { const int _k = (kt) * 64; \
        GLDS(ap0 + _k, (b) * 32768 + dst);          GLDS(ap1 + _k, (b) * 32768 + dst + 4096); \
        GLDS(ap2 + _k, (b) * 32768 + dst + 8192);   GLDS(ap3 + _k, (b) * 32768 + dst + 12288); \
        GLDS(bp0 + _k, (b) * 32768 + 16384 + dst);  GLDS(bp1 + _k, (b) * 32768 + 16384 + dst + 4096); \
        GLDS(bp2 + _k, (b) * 32768 + 16384 + dst + 8192); GLDS(bp3 + _k, (b) * 32768 + 16384 + dst + 12288); } while (0)
    STAGE(0, 0);
    for (int kt = 0; kt < nk; ++kt) {
        VM_WAIT();
        __syncthreads();
        const int b = kt & 1;
        if (SSQ && kt == ssq_steps) {
            const float* rsl = (const float*)(lds + RS_OFF);
#pragma unroll
            for (int m = 0; m < 4; ++m) { const float r = rsl[wr * 64 + m * 16 + fr];
#pragma unroll
                for (int n = 0; n < 4; ++n) acc[m][n] = acc[m][n] * r; }
        }
        if (kt + 1 < nk) { if (b) STAGE(kt + 1, 0); else STAGE(kt + 1, 1); }
        const unsigned char* base = lds + b * 32768;
#pragma unroll
        for (int ks = 0; ks < 2; ++ks) {
            bf16x8 af[4], bf[4];
#pragma unroll
            for (int m = 0; m < 4; ++m) af[m] = *(const bf16x8*)(base + a_off + m * 2048 + ks * 1024);
#pragma unroll
            for (int n = 0; n < 4; ++n) bf[n] = *(const bf16x8*)(base + b_off + n * 2048 + ks * 1024);
#pragma unroll
            for (int m = 0; m < 4; ++m)
#pragma unroll
                for (int n = 0; n < 4; ++n) acc[m][n] = __builtin_amdgcn_mfma_f32_16x16x32_bf16(bf[n], af[m], acc[m][n], 0, 0, 0);
        }
        if (SSQ && kt < ssq_steps) {
            const int row = tid >> 1, hf = tid & 1;
            const int rb = ((row >> 4) * 2 + hf) * 1024 + (row & 15) * 64, sw = ((row & 15) >> 3) << 5;
#pragma unroll
            for (int j = 0; j < 4; ++j) {
                const u32x4 w = *(const u32x4*)(base + rb + ((j * 16) ^ sw));
#pragma unroll
                for (int q = 0; q < 4; ++q) { const float a = bflo(w[q]), bb = bfhi(w[q]); ssq += a * a + bb * bb; }
            }
            if (kt == ssq_steps - 1) {
                const float tot = ssq + __shfl_xor(ssq, 1);
                if (hf == 0) ((float*)(lds + RS_OFF))[row] = 1.f / sqrtf(tot * ssq_inv_dim + EPS);
            }
        }
    }
    if (SSQ && ssq_steps == nk) {
        __syncthreads();
        const float* rsl = (const float*)(lds + RS_OFF);
#pragma unroll
        for (int m = 0; m < 4; ++m) { const float r = rsl[wr * 64 + m * 16 + fr];
#pragma unroll
            for (int n = 0; n < 4; ++n) acc[m][n] = acc[m][n] * r; }
    }
#undef STAGE
#undef GLDS
}

DEV void phase1(const Ctx& c) {
    const bf16_t* h0 = (const bf16_t*)(c.ws + WS_H0); const bf16_t* WinT = (const bf16_t*)(c.ws + WS_WIN);
    bf16_t* U = (bf16_t*)(c.ws + WS_U); bf16_t* CQ = (bf16_t*)(c.ws + WS_CQ); bf16_t* CKV = (bf16_t*)(c.ws + WS_CKV); bf16_t* KR = (bf16_t*)(c.ws + WS_KR);
    const float* rc = (const float*)(c.ws + WS_ROPE); const float* rs = rc + L * 16;
    const StageGeo g = stage_geo(c.tid);
    const int lane = c.lane, wr = c.wid >> 1, wc = c.wid & 1, fr = lane & 15, fq = lane >> 4;
    constexpr int NT = 14, NU = (T / 128) * NT;
    for (int u = c.vcu; u < NU; u += c.G) {
        const int mt = u / NT, nt = u - mt * NT;
        const bf16_t* A = h0 + (size_t)(mt * 128) * D + g.c; const bf16_t* B = WinT + (size_t)(nt * 128) * D + g.c;
        f32x4 acc[4][4];
        gemm_mainloop<false>(acc, A + (size_t)g.r[0] * D, A + (size_t)g.r[1] * D, A + (size_t)g.r[2] * D, A + (size_t)g.r[3] * D,
                             B + (size_t)g.r[0] * D, B + (size_t)g.r[1] * D, B + (size_t)g.r[2] * D, B + (size_t)g.r[3] * D, 16, c.lds, 0, 0.f);
        const int row0 = mt * 128 + wr * 64 + fr;
        if (nt < 8) {
#pragma unroll
            for (int m = 0; m < 4; ++m) { const size_t row = row0 + m * 16;
#pragma unroll
                for (int i = 0; i < 2; ++i) {
                    f32x4 a = acc[m][2 * i], gt = acc[m][2 * i + 1], o;
#pragma unroll
                    for (int j = 0; j < 4; ++j) o[j] = a[j] * sigmoidf_(gt[j]);
                    st_bf4(U + row * CC + nt * 64 + wc * 32 + i * 16 + fq * 4, o);
                } }
        } else if (nt < 11) {
#pragma unroll
            for (int m = 0; m < 4; ++m) { const size_t row = row0 + m * 16;
#pragma unroll
                for (int n = 0; n < 4; ++n) st_bf4(CQ + row * QL + (nt - 8) * 128 + wc * 64 + n * 16 + fq * 4, acc[m][n]); }
        } else if (nt < 13) {
#pragma unroll
            for (int m = 0; m < 4; ++m) { const size_t row = row0 + m * 16;
#pragma unroll
                for (int n = 0; n < 4; ++n) st_bf4(CKV + row * KVL + (nt - 11) * 128 + wc * 64 + n * 16 + fq * 4, acc[m][n]); }
        } else if (wc == 0) {
#pragma unroll
            for (int m = 0; m < 4; ++m) { const int row = row0 + m * 16; const int p = row % L;
                const f32x4 cs = *(const f32x4*)(rc + p * 16 + fq * 4), sn = *(const f32x4*)(rs + p * 16 + fq * 4);
                const f32x4 x1 = acc[m][0], x2 = acc[m][1];
                st_bf4(KR + (size_t)row * 32 + fq * 4, x1 * cs - x2 * sn);
                st_bf4(KR + (size_t)row * 32 + 16 + fq * 4, x1 * sn + x2 * cs); }
        }
    }
}

DEV void conv_unit(const Ctx& c, int b, int j) {
    const bf16_t* U = (const bf16_t*)(c.ws + WS_U);
    bf16_t* MG = (bf16_t*)(c.ws + WS_MG);
    const float* cw = c.in[I_CONVW]; const float* cb = c.in[I_CONVB];
    const int p0 = j * 32;
    float* ytile = (float*)c.lds;
    __syncthreads();
#pragma unroll 1
    for (int pass = 0; pass < 2; ++pass) {
        const int ch = c.tid + 256 * pass;
        float win[62];
#pragma unroll
        for (int i = 0; i < 62; ++i) { const int p = p0 - 30 + i; win[i] = (p >= 0 && p < L) ? __uint_as_float((unsigned)U[((size_t)b * L + p) * CC + ch] << 16) : 0.f; }
        float w[31];
#pragma unroll
        for (int k = 0; k < 31; ++k) w[k] = cw[k * CC + ch];
        const float bias = cb[ch];
#pragma unroll
        for (int tt = 0; tt < 32; ++tt) {
            float a0 = bias;
#pragma unroll
            for (int k = 0; k < 31; ++k) a0 += w[k] * win[tt + k];
            ytile[tt * 512 + ch] = a0;
        }
    }
    __syncthreads();
    const float* g1 = c.in[I_CLN_G]; const float* b1 = c.in[I_CLN_B]; const float* g2 = c.in[I_COUT_G];
    for (int i = 0; i < 8; ++i) {
        const int tt = c.wid * 8 + i, p = p0 + tt;
        if (p < NMETA || p >= L) continue;
        const f32x4 ya = *(const f32x4*)(ytile + tt * 512 + c.lane * 8), yb = *(const f32x4*)(ytile + tt * 512 + c.lane * 8 + 4);
        float v[8] = {ya.x, ya.y, ya.z, ya.w, yb.x, yb.y, yb.z, yb.w};
        float s = 0.f;
#pragma unroll
        for (int q = 0; q < 8; ++q) s += v[q];
        const float mean = wave_sum(s) * (1.f / 512.f); float s2 = 0.f;
#pragma unroll
        for (int q = 0; q < 8; ++q) { v[q] -= mean; s2 += v[q] * v[q]; }
        const float rstd = 1.f / sqrtf(wave_sum(s2) * (1.f / 512.f) + EPS);
        float s3 = 0.f;
#pragma unroll
        for (int q = 0; q < 8; ++q) { const float x = v[q] * rstd * g1[c.lane * 8 + q] + b1[c.lane * 8 + q]; const float y = x * sigmoidf_(x); v[q] = y; s3 += y * y; }
        const float r2 = 1.f / sqrtf(wave_sum(s3) * (1.f / 512.f) + EPS);
        u32x4 o;
        o.x = cvtpk(v[0] * r2 * g2[c.lane * 8 + 0], v[1] * r2 * g2[c.lane * 8 + 1]); o.y = cvtpk(v[2] * r2 * g2[c.lane * 8 + 2], v[3] * r2 * g2[c.lane * 8 + 3]);
        o.z = cvtpk(v[4] * r2 * g2[c.lane * 8 + 4], v[5] * r2 * g2[c.lane * 8 + 5]); o.w = cvtpk(v[6] * r2 * g2[c.lane * 8 + 6], v[7] * r2 * g2[c.lane * 8 + 7]);
        const size_t tok = (size_t)b * SEQ + (p - NMETA);
        *(u32x4*)(MG + tok * D + 512 + c.lane * 8) = o;
    }
}
DEV void rope4(f32x4& x1, f32x4& x2, const float* rc, const float* rs, int p, int fq) {
    const f32x4 cs = *(const f32x4*)(rc + p * 16 + fq * 4), sn = *(const f32x4*)(rs + p * 16 + fq * 4);
    const f32x4 a = x1 * cs - x2 * sn, bb = x1 * sn + x2 * cs; x1 = a; x2 = bb;
}
DEV void phase2(const Ctx& c) {
    const bf16_t* CQ = (const bf16_t*)(c.ws + WS_CQ); const bf16_t* CKV = (const bf16_t*)(c.ws + WS_CKV);
    const bf16_t* WuqT = (const bf16_t*)(c.ws + WS_WUQ); const bf16_t* WukvT = (const bf16_t*)(c.ws + WS_WUKV);
    bf16_t* Q = (bf16_t*)(c.ws + WS_Q); bf16_t* KV = (bf16_t*)(c.ws + WS_KV);
    const float* rc = (const float*)(c.ws + WS_ROPE); const float* rs = rc + L * 16;
    const StageGeo g = stage_geo(c.tid);
    const int lane = c.lane, wr = c.wid >> 1, wc = c.wid & 1, fr = lane & 15, fq = lane >> 4;
    constexpr int MT = T / 128, NUQ = MT * 6, NUKV = MT * 8, NUC = NB * 65, NU = NUQ + NUKV + NUC;
    for (int u = c.vcu; u < NU; u += c.G) {
        if (u < NUKV) {
            const int mt = u >> 3, nt = u & 7;
            const bf16_t* A = CKV + (size_t)(mt * 128) * KVL + g.c; const bf16_t* B = WukvT + (size_t)(nt * 128) * KVL + g.c;
            f32x4 acc[4][4];
            gemm_mainloop<true>(acc, A + (size_t)g.r[0] * KVL, A + (size_t)g.r[1] * KVL, A + (size_t)g.r[2] * KVL, A + (size_t)g.r[3] * KVL,
                                B + (size_t)g.r[0] * KVL, B + (size_t)g.r[1] * KVL, B + (size_t)g.r[2] * KVL, B + (size_t)g.r[3] * KVL, 4, c.lds, 4, 1.f / 256.f);
            const int row0 = mt * 128 + wr * 64 + fr;
#pragma unroll
            for (int m = 0; m < 4; ++m) { const size_t row = row0 + m * 16;
#pragma unroll
                for (int n = 0; n < 4; ++n) st_bf4(KV + row * NKV + nt * 128 + wc * 64 + n * 16 + fq * 4, acc[m][n]); }
        } else if (u < NUKV + NUQ) {
            const int v = u - NUKV, mt = v / 6, nt = v - mt * 6;
            const bf16_t* A = CQ + (size_t)(mt * 128) * QL + g.c; const bf16_t* B = WuqT + (size_t)(nt * 128) * QL + g.c;
            f32x4 acc[4][4];
            gemm_mainloop<true>(acc, A + (size_t)g.r[0] * QL, A + (size_t)g.r[1] * QL, A + (size_t)g.r[2] * QL, A + (size_t)g.r[3] * QL,
                                B + (size_t)g.r[0] * QL, B + (size_t)g.r[1] * QL, B + (size_t)g.r[2] * QL, B + (size_t)g.r[3] * QL, 6, c.lds, 6, 1.f / 384.f);
            const int row0 = mt * 128 + wr * 64 + fr;
            const int t16 = (nt * 8 + wc * 4) % 6;
#pragma unroll
            for (int m = 0; m < 4; ++m) { const int row = row0 + m * 16; const int p = row % L;
#pragma unroll
                for (int n = 0; n < 4; ++n) acc[m][n] = acc[m][n] * QSCALE;
                if (t16 == 4) rope4(acc[m][0], acc[m][1], rc, rs, p, fq);
                if (t16 == 2) rope4(acc[m][2], acc[m][3], rc, rs, p, fq);
#pragma unroll
                for (int n = 0; n < 4; ++n) st_bf4(Q + (size_t)row * NQ + nt * 128 + wc * 64 + n * 16 + fq * 4, acc[m][n]); }
        } else {
            const int v = u - NUKV - NUQ; conv_unit(c, v / 65, v % 65);
        }
    }
}

DEV int crow(int r, int hi) { return (r & 3) + 8 * (r >> 2) + 4 * hi; }
#define KSWZ(row, colB) ((row) * 256 + ((colB) ^ (((row) & 7) << 4)))
#define SBAR() __builtin_amdgcn_sched_barrier(0)
DEV int v_st(int k, int cc) { const int kk = (k & ~0xC) | ((k & 4) << 1) | ((k & 8) >> 1); return ((kk >> 3) * 4 + (cc >> 5)) * 512 + ((kk & 7) * 32 + (cc & 31)) * 2; }
DEV int v_rd_base(int lane) { return ((lane & 3) << 3) | (((lane >> 2) & 3) << 6) | (((lane >> 4) & 1) << 5) | (((lane >> 5) & 1) << 8); }
constexpr int v_rd_off(int d0, int ks, int half) { return d0 * 512 + ks * 4096 + half * 2048; }
template <int OFF> DEV s16x4 tr_read(int vb) { s16x4 r; asm volatile("ds_read_b64_tr_b16 %0, %1 offset:%2" : "=&v"(r) : "v"(vb), "i"(OFF) : "memory"); return r; }
template <int D0> DEV void pv_one(f32x16& od, int vb, bf16x8 pa0, bf16x8 pa1, bf16x8 pa2, bf16x8 pa3) {
    const s16x4 l0 = tr_read<v_rd_off(D0, 0, 0)>(vb), h0 = tr_read<v_rd_off(D0, 0, 1)>(vb), l1 = tr_read<v_rd_off(D0, 1, 0)>(vb), h1 = tr_read<v_rd_off(D0, 1, 1)>(vb);
    const s16x4 l2 = tr_read<v_rd_off(D0, 2, 0)>(vb), h2 = tr_read<v_rd_off(D0, 2, 1)>(vb), l3 = tr_read<v_rd_off(D0, 3, 0)>(vb), h3 = tr_read<v_rd_off(D0, 3, 1)>(vb);
    asm volatile("s_waitcnt lgkmcnt(0)" ::: "memory"); SBAR();
#define PK(Lo, Hi) (bf16x8){Lo[0], Lo[1], Lo[2], Lo[3], Hi[0], Hi[1], Hi[2], Hi[3]}
    od = __builtin_amdgcn_mfma_f32_32x32x16_bf16(pa0, PK(l0, h0), od, 0, 0, 0);
    od = __builtin_amdgcn_mfma_f32_32x32x16_bf16(pa1, PK(l1, h1), od, 0, 0, 0);
    od = __builtin_amdgcn_mfma_f32_32x32x16_bf16(pa2, PK(l2, h2), od, 0, 0, 0);
    od = __builtin_amdgcn_mfma_f32_32x32x16_bf16(pa3, PK(l3, h3), od, 0, 0, 0);
#undef PK
}
constexpr int AT_V = 0, AT_K = 32768, AT_WS = 65536;
DEV void attn_unit(const Ctx& c, int b, int h, int qb) {
    const bf16_t* Q = (const bf16_t*)(c.ws + WS_Q); const bf16_t* KV = (const bf16_t*)(c.ws + WS_KV); const bf16_t* KR = (const bf16_t*)(c.ws + WS_KR);
    bf16_t* MG = (bf16_t*)(c.ws + WS_MG);
    unsigned char* lds = c.lds;
    const int tid = c.tid, wid = c.wid, lane = c.lane, r32 = lane & 31, hi = lane >> 5;
    float* wsf = (float*)(lds + AT_WS) + wid * 64; float* li_l = wsf; float* al_l = wsf + 32;
    const int NT = 2 * qb + 3;
    const int my_last = 2 * qb + (wid >> 1) + 1;
    bf16x8 qr[6];
    { const size_t t = (size_t)b * L + NMETA + qb * 128 + wid * 32 + r32;
      const bf16_t* Qw = Q + t * NQ + h * DQK + hi * 8;
#pragma unroll
      for (int d0 = 0; d0 < 6; ++d0) qr[d0] = *(const bf16x8*)(Qw + d0 * 16); }
    const int srow = tid >> 2, sq = tid & 3;
    const int vst0 = v_st(srow, sq * 16), vst1 = v_st(srow, sq * 16 + 8);
    const int kst0 = KSWZ(srow, sq * 32), kst1 = KSWZ(srow, sq * 32 + 16), kst2 = KSWZ(srow, 128 + sq * 16);
    const int vb0 = (int)(uintptr_t)(lds + AT_V) + v_rd_base(lane);
    u32x4 sk0, sk1, sk2, sv0, sv1;
#define SLOAD(j) do { int pos = (j) * 64 + srow - 48; pos = pos < 0 ? 0 : pos; const size_t tk = (size_t)b * L + pos; \
        const bf16_t* kvp = KV + tk * NKV + h * 128 + sq * 16; \
        sk0 = *(const u32x4*)(kvp); sk1 = *(const u32x4*)(kvp + 8); sv0 = *(const u32x4*)(kvp + 64); sv1 = *(const u32x4*)(kvp + 72); \
        sk2 = *(const u32x4*)(KR + tk * 32 + sq * 8); } while (0)
#define SWRITE(bb) do { unsigned char* kb = lds + AT_K + (bb) * 16384; unsigned char* vbp = lds + AT_V + (bb) * 16384; \
        *(u32x4*)(kb + kst0) = sk0; *(u32x4*)(kb + kst1) = sk1; *(u32x4*)(kb + kst2) = sk2; *(u32x4*)(vbp + vst0) = sv0; *(u32x4*)(vbp + vst1) = sv1; } while (0)
    float m_reg = -1e30f, l_reg = 0.f; f32x16 o[2] = {};
    __syncthreads();
    SLOAD(0); SWRITE(0); __syncthreads();
    for (int j = 0; j < NT; ++j) {
        const int bsel = j & 1;
        if (j + 1 < NT) SLOAD(j + 1);
        if (j <= my_last) {
            const unsigned char* Ks = lds + AT_K + bsel * 16384;
            f32x16 p0 = {}, p1 = {};
#pragma unroll
            for (int d0 = 0; d0 < 6; ++d0) { const int cb = (d0 * 16 + hi * 8) * 2;
                const bf16x8 k0 = *(const bf16x8*)(Ks + KSWZ(r32, cb)); const bf16x8 k1 = *(const bf16x8*)(Ks + KSWZ(32 + r32, cb));
                p0 = __builtin_amdgcn_mfma_f32_32x32x16_bf16(k0, qr[d0], p0, 0, 0, 0);
                p1 = __builtin_amdgcn_mfma_f32_32x32x16_bf16(k1, qr[d0], p1, 0, 0, 0); }
            if (j == 0) {
#pragma unroll
                for (int r = 0; r < 16; ++r) p0[r] = -1e30f;
#pragma unroll
                for (int r = 0; r < 8; ++r) p1[r] = -1e30f;
            }
            float pmax = p0[0];
#pragma unroll
            for (int r = 1; r < 16; ++r) pmax = fmaxf(pmax, p0[r]);
#pragma unroll
            for (int r = 0; r < 16; ++r) pmax = fmaxf(pmax, p1[r]);
            { auto rr = __builtin_amdgcn_permlane32_swap(__float_as_uint(pmax), __float_as_uint(pmax), false, false);
              pmax = fmaxf(__uint_as_float(rr[0]), __uint_as_float(rr[1])); }
            const float mn = fmaxf(m_reg, pmax);
            const float alpha = fast_exp2(m_reg - mn); m_reg = mn;
            float ps = 0.f;
#pragma unroll
            for (int r = 0; r < 16; ++r) { p0[r] = fast_exp2(p0[r] - mn); ps += p0[r]; }
#pragma unroll
            for (int r = 0; r < 16; ++r) { p1[r] = fast_exp2(p1[r] - mn); ps += p1[r]; }
            { auto rr = __builtin_amdgcn_permlane32_swap(__float_as_uint(ps), __float_as_uint(ps), false, false);
              ps = __uint_as_float(rr[0]) + __uint_as_float(rr[1]); }
            l_reg = l_reg * alpha + ps;
            bf16x8 pa0, pa1, pa2, pa3;
#define PK4(P, BASE, OUT) do { unsigned a0 = cvtpk(P[BASE + 0], P[BASE + 1]), a1 = cvtpk(P[BASE + 2], P[BASE + 3]);   \
    unsigned b0 = cvtpk(P[BASE + 4], P[BASE + 5]), b1 = cvtpk(P[BASE + 6], P[BASE + 7]);                              \
    auto r0 = __builtin_amdgcn_permlane32_swap(a0, b0, false, false); auto r1 = __builtin_amdgcn_permlane32_swap(a1, b1, false, false); \
    u32x4 w = {r0[0], r1[0], r0[1], r1[1]}; OUT = *reinterpret_cast<bf16x8*>(&w); } while (0)
            PK4(p0, 0, pa0); PK4(p0, 8, pa1); PK4(p1, 0, pa2); PK4(p1, 8, pa3);
#undef PK4
            if (__any(alpha < 1.f)) {
                if (hi == 0) al_l[r32] = alpha;
                asm volatile("s_waitcnt lgkmcnt(0)" ::: "memory");
#pragma unroll
                for (int r = 0; r < 16; ++r) { const float a = al_l[crow(r, hi)]; o[0][r] *= a; o[1][r] *= a; }
            }
            const int vb = vb0 + bsel * 16384;
            pv_one<0>(o[0], vb, pa0, pa1, pa2, pa3); pv_one<1>(o[1], vb, pa0, pa1, pa2, pa3);
        }
        if (j + 1 < NT) { if (bsel) SWRITE(0); else SWRITE(1); }
        __syncthreads();
    }
    if (hi == 0) li_l[r32] = l_reg;
    asm volatile("s_waitcnt lgkmcnt(0)" ::: "memory");
    const size_t tok0 = (size_t)b * SEQ + qb * 128 + wid * 32;
#pragma unroll
    for (int r = 0; r < 16; ++r) {
        const int orow = crow(r, hi); const float rl = fast_rcp(li_l[orow]);
        bf16_t* dst = MG + (tok0 + orow) * D + h * DV + r32;
        dst[0]  = (bf16_t)(cvtpk(o[0][r] * rl, 0.f) & 0xffffu);
        dst[32] = (bf16_t)(cvtpk(o[1][r] * rl, 0.f) & 0xffffu);
    }
#undef SLOAD
#undef SWRITE
}
DEV void phase3(const Ctx& c) {
    const int nslots = NB * NH * 4;
    for (int v = c.vcu; v < nslots; v += c.G) {
        const int bh = v >> 2, s = v & 3, b = bh >> 3, h = bh & 7;
        attn_unit(c, b, h, 15 - s); attn_unit(c, b, h, s); attn_unit(c, b, h, 11 - s); attn_unit(c, b, h, 4 + s);
    }
}

DEV void phase4(const Ctx& c) {
    const bf16_t* MG = (const bf16_t*)(c.ws + WS_MG); const bf16_t* WoT = (const bf16_t*)(c.ws + WS_WO); const bf16_t* h0 = (const bf16_t*)(c.ws + WS_H0);
    float* R1 = (float*)(c.ws + WS_R1);
    const StageGeo g = stage_geo(c.tid);
    const int lane = c.lane, wr = c.wid >> 1, wc = c.wid & 1, fr = lane & 15, fq = lane >> 4;
    constexpr int NU = (TR / 128) * 8;
    for (int u = c.vcu; u < NU; u += c.G) {
        const int mt = u >> 3, nt = u & 7;
        const bf16_t* A = MG + (size_t)(mt * 128) * D + g.c; const bf16_t* B = WoT + (size_t)(nt * 128) * D + g.c;
        f32x4 acc[4][4];
        gemm_mainloop<true>(acc, A + (size_t)g.r[0] * D, A + (size_t)g.r[1] * D, A + (size_t)g.r[2] * D, A + (size_t)g.r[3] * D,
                            B + (size_t)g.r[0] * D, B + (size_t)g.r[1] * D, B + (size_t)g.r[2] * D, B + (size_t)g.r[3] * D, 16, c.lds, 8, 1.f / 512.f);
#pragma unroll
        for (int m = 0; m < 4; ++m) {
            const int tok = mt * 128 + wr * 64 + m * 16 + fr;
            const size_t t = (size_t)(tok >> 11) * L + NMETA + (tok & 2047);
#pragma unroll
            for (int n = 0; n < 4; ++n) {
                const int col = nt * 128 + wc * 64 + n * 16 + fq * 4;
                const u32x2 hw = *(const u32x2*)(h0 + t * D + col);
                f32x4 o; o[0] = ALPHA * bflo(hw.x) + acc[m][n][0]; o[1] = ALPHA * bfhi(hw.x) + acc[m][n][1];
                o[2] = ALPHA * bflo(hw.y) + acc[m][n][2]; o[3] = ALPHA * bfhi(hw.y) + acc[m][n][3];
                *(f32x4*)(R1 + (size_t)tok * D + col) = o;
            }
        }
    }
}

constexpr int P5_ROWB = 2064, P5_PART = 33280;
DEV void phase5(const Ctx& c) {
    const float* R1 = (const float*)(c.ws + WS_R1); bf16_t* H1 = (bf16_t*)(c.ws + WS_H0);
    const bf16_t* WrT = (const bf16_t*)(c.ws + WS_WR);
    unsigned* cnt = (unsigned*)(c.ws + WS_CTL) + CW_CNT; unsigned* list = (unsigned*)(c.ws + WS_LIST); float* combw = (float*)(c.ws + WS_COMBW);
    const int lane = c.lane, wid = c.wid, fr = lane & 15, fq = lane >> 4;
    float* part = (float*)(c.lds + P5_PART);
    for (int u = c.vcu; u < TR / 16; u += c.G) {
        const int tok0 = u * 16;
        __syncthreads();
#pragma unroll 1
        for (int i = 0; i < 4; ++i) { const int tl = wid * 4 + i; const size_t tok = tok0 + tl;
            ln_row_bf16(R1 + tok * D, c.in[I_LN1G], c.in[I_LN1B], H1 + tok * D, c.lds + tl * P5_ROWB, lane); }
        __syncthreads();
        f32x4 acc[3] = {};
#pragma unroll
        for (int ks = 0; ks < 8; ++ks) {
            const int k = wid * 256 + ks * 32 + fq * 8;
            const bf16x8 a = *(const bf16x8*)(c.lds + fr * P5_ROWB + k * 2);
#pragma unroll
            for (int n = 0; n < 3; ++n) { const bf16x8 w = *(const bf16x8*)(WrT + (size_t)(n * 16 + fr) * D + k);
                acc[n] = __builtin_amdgcn_mfma_f32_16x16x32_bf16(w, a, acc[n], 0, 0, 0); }
        }
#pragma unroll
        for (int n = 0; n < 3; ++n) *(f32x4*)(part + (wid * 16 + fr) * 48 + n * 16 + fq * 4) = acc[n];
        __syncthreads();
        if (c.tid < 16) {
            float* lg = part + c.tid * 48;
            const float* brg = c.in[I_BRG]; const float* bre = c.in[I_BRE];
#pragma unroll 4
            for (int i = 0; i < 36; ++i) { const float bias = (i < 4) ? brg[i] : bre[i - 4];
                lg[i] = ((lg[i] + part[(16 + c.tid) * 48 + i]) + (part[(32 + c.tid) * 48 + i] + part[(48 + c.tid) * 48 + i])) + bias; }
            int gi = 0; float gm = lg[0];
#pragma unroll
            for (int i = 1; i < 4; ++i) { const float v = lg[i]; if (v > gm) { gm = v; gi = i; } }
            float gs = 0.f;
#pragma unroll
            for (int i = 0; i < 4; ++i) gs += __expf(lg[i] - gm);
            const float gw = 1.f / gs;
            const float* le = lg + 4 + gi * 8;
            float v0 = le[0], v1 = -3.0e38f; int i0 = 0, i1 = 0;
#pragma unroll
            for (int i = 1; i < 8; ++i) { const float v = le[i];
                if (v > v0) { v1 = v0; i1 = i0; v0 = v; i0 = i; } else if (v > v1) { v1 = v; i1 = i; } }
            const float ex = __expf(v1 - v0), inv = 1.f / (1.f + ex);
            const int tok = tok0 + c.tid; const int e0 = gi * 8 + i0, e1 = gi * 8 + i1;
            combw[tok * 2] = gw * inv; combw[tok * 2 + 1] = gw * ex * inv;
            const unsigned s0 = atomicAdd(&cnt[e0], 1u); list[(size_t)e0 * TR + s0] = (unsigned)(tok * 2);
            const unsigned s1 = atomicAdd(&cnt[e1], 1u); list[(size_t)e1 * TR + s1] = (unsigned)(tok * 2 + 1);
        }
    }
}

DEV void moe_tiles(const Ctx& c) {
    const unsigned* cnt = (const unsigned*)(c.ws + WS_CTL) + CW_CNT; int* ts = (int*)(c.lds + EXP_OFF);
    __syncthreads();
    if (c.tid == 0) { int s = 0; for (int e = 0; e < NE; ++e) { ts[e] = s; s += (int)((__hip_atomic_load(&cnt[e], __ATOMIC_RELAXED, __HIP_MEMORY_SCOPE_AGENT) + 127u) >> 7); } ts[NE] = s; }
    __syncthreads();
}
DEV int moe_find(const int* ts, int rt) { int e = 0;
#pragma unroll 1
    for (int i = 1; i < NE; ++i) if (ts[i] <= rt) e = i;
    return e; }
DEV void phase6a(const Ctx& c) {
    const bf16_t* H1 = (const bf16_t*)(c.ws + WS_H0); const bf16_t* WguT = (const bf16_t*)(c.ws + WS_WGU); bf16_t* ACT = (bf16_t*)(c.ws + WS_ACT);
    const unsigned* cnt = (const unsigned*)(c.ws + WS_CTL) + CW_CNT; const unsigned* list = (const unsigned*)(c.ws + WS_LIST);
    moe_tiles(c);
    const int* ts = (const int*)(c.lds + EXP_OFF); unsigned* tbl = (unsigned*)(c.lds + TBL_OFF);
    const StageGeo g = stage_geo(c.tid);
    const int lane = c.lane, wr = c.wid >> 1, wc = c.wid & 1, fr = lane & 15, fq = lane >> 4;
    const int NU = ts[NE] * 4;
    for (int u = c.vcu; u < NU; u += c.G) {
        const int rt = u >> 2, nt = u & 3; const int e = moe_find(ts, rt);
        const int j0 = (rt - ts[e]) * 128; const int ne = (int)cnt[e];
        __syncthreads();
        if (c.tid < 128) { const int j = j0 + c.tid; tbl[c.tid] = (j < ne) ? list[(size_t)e * TR + j] : 0xffffffffu; }
        __syncthreads();
        size_t ro[4];
#pragma unroll
        for (int i = 0; i < 4; ++i) { const unsigned en = tbl[g.r[i]]; ro[i] = (en == 0xffffffffu) ? 0 : (size_t)(en >> 1) * D; }
        const bf16_t* A = H1 + g.c; const bf16_t* B = WguT + ((size_t)e * 512 + nt * 128) * D + g.c;
        f32x4 acc[4][4];
        gemm_mainloop<false>(acc, A + ro[0], A + ro[1], A + ro[2], A + ro[3],
                             B + (size_t)g.r[0] * D, B + (size_t)g.r[1] * D, B + (size_t)g.r[2] * D, B + (size_t)g.r[3] * D, 16, c.lds, 0, 0.f);
#pragma unroll
        for (int m = 0; m < 4; ++m) { const size_t row = (size_t)rt * 128 + wr * 64 + m * 16 + fr;
#pragma unroll
            for (int i = 0; i < 2; ++i) {
                const f32x4 gt = acc[m][2 * i], up = acc[m][2 * i + 1]; f32x4 o;
#pragma unroll
                for (int j = 0; j < 4; ++j) o[j] = gt[j] * sigmoidf_(gt[j]) * up[j];
                st_bf4(ACT + row * DE + nt * 64 + wc * 32 + i * 16 + fq * 4, o);
            } }
    }
}
DEV void phase6b(const Ctx& c) {
    const bf16_t* ACT = (const bf16_t*)(c.ws + WS_ACT); const bf16_t* WdT = (const bf16_t*)(c.ws + WS_WD); bf16_t* Y = (bf16_t*)(c.ws + WS_Y);
    const unsigned* cnt = (const unsigned*)(c.ws + WS_CTL) + CW_CNT; const unsigned* list = (const unsigned*)(c.ws + WS_LIST); const float* combw = (const float*)(c.ws + WS_COMBW);
    moe_tiles(c);
    const int* ts = (const int*)(c.lds + EXP_OFF); unsigned* tbl = (unsigned*)(c.lds + TBL_OFF);
    const StageGeo g = stage_geo(c.tid);
    const int lane = c.lane, wr = c.wid >> 1, wc = c.wid & 1, fr = lane & 15, fq = lane >> 4;
    const int NU = ts[NE] * 8;
    for (int u = c.vcu; u < NU; u += c.G) {
        const int rt = u >> 3, nt = u & 7; const int e = moe_find(ts, rt);
        const int j0 = (rt - ts[e]) * 128; const int ne = (int)cnt[e];
        __syncthreads();
        if (c.tid < 128) { const int j = j0 + c.tid; tbl[c.tid] = (j < ne) ? list[(size_t)e * TR + j] : 0xffffffffu; }
        const bf16_t* A = ACT + (size_t)(rt * 128) * DE + g.c; const bf16_t* B = WdT + ((size_t)e * 1024 + nt * 128) * DE + g.c;
        f32x4 acc[4][4];
        gemm_mainloop<false>(acc, A + (size_t)g.r[0] * DE, A + (size_t)g.r[1] * DE, A + (size_t)g.r[2] * DE, A + (size_t)g.r[3] * DE,
                             B + (size_t)g.r[0] * DE, B + (size_t)g.r[1] * DE, B + (size_t)g.r[2] * DE, B + (size_t)g.r[3] * DE, 4, c.lds, 0, 0.f);
#pragma unroll
        for (int m = 0; m < 4; ++m) {
            const unsigned en = tbl[wr * 64 + m * 16 + fr];
            if (en != 0xffffffffu) {
                const float w = combw[en]; bf16_t* dst = Y + ((size_t)(en & 1u) * TR + (en >> 1)) * D + nt * 128 + wc * 64 + fq * 4;
#pragma unroll
                for (int n = 0; n < 4; ++n) st_bf4(dst + n * 16, acc[m][n] * w);
            }
        }
    }
}

DEV void phase7(const Ctx& c) {
    const bf16_t* H1 = (const bf16_t*)(c.ws + WS_H0); const bf16_t* Y = (const bf16_t*)(c.ws + WS_Y);
    const float* g = c.in[I_LN2G]; const float* bt = c.in[I_LN2B];
    const int gw = c.vcu * 4 + c.wid, NGW = c.G * 4, lane = c.lane;
    for (int tok = gw; tok < TR; tok += NGW) {
        float v[16]; float s = 0.f;
#pragma unroll
        for (int i = 0; i < 2; ++i) {
            const u32x4 hw = *(const u32x4*)(H1 + (size_t)tok * D + i * 512 + lane * 8);
            const u32x4 y0 = *(const u32x4*)(Y + (size_t)tok * D + i * 512 + lane * 8);
            const u32x4 y1 = *(const u32x4*)(Y + ((size_t)TR + tok) * D + i * 512 + lane * 8);
#pragma unroll
            for (int q = 0; q < 4; ++q) {
                v[i * 8 + 2 * q]     = ALPHA * bflo(hw[q]) + (bflo(y0[q]) + bflo(y1[q]));
                v[i * 8 + 2 * q + 1] = ALPHA * bfhi(hw[q]) + (bfhi(y0[q]) + bfhi(y1[q]));
            }
        }
#pragma unroll
        for (int q = 0; q < 16; ++q) s += v[q];
        const float mean = wave_sum(s) * (1.f / 1024.f); float s2 = 0.f;
#pragma unroll
        for (int q = 0; q < 16; ++q) { v[q] -= mean; s2 += v[q] * v[q]; }
        const float rstd = 1.f / sqrtf(wave_sum(s2) * (1.f / 1024.f) + EPS);
#pragma unroll
        for (int i = 0; i < 2; ++i)
#pragma unroll
            for (int q = 0; q < 2; ++q) {
                const int col = i * 512 + lane * 8 + q * 4;
                const f32x4 gg = *(const f32x4*)(g + col), bb = *(const f32x4*)(bt + col);
                f32x4 o; o[0] = v[i * 8 + q * 4] * rstd * gg[0] + bb[0]; o[1] = v[i * 8 + q * 4 + 1] * rstd * gg[1] + bb[1];
                o[2] = v[i * 8 + q * 4 + 2] * rstd * gg[2] + bb[2]; o[3] = v[i * 8 + q * 4 + 3] * rstd * gg[3] + bb[3];
                *(f32x4*)(c.out + (size_t)tok * D + col) = o;
            }
    }
}

__global__ void __launch_bounds__(256, 2) fwd_kernel(Args a) {
    extern __shared__ __attribute__((aligned(16))) unsigned char lds[];
    Ctx c; c.in = a.in; c.out = a.out; c.ws = a.ws; c.lds = lds;
    c.tid = threadIdx.x; c.lane = c.tid & 63; c.wid = __builtin_amdgcn_readfirstlane(c.tid >> 6);
    c.G = gridDim.x; { const int bx = blockIdx.x; c.vcu = (c.G % 8 == 0) ? (bx % 8) * (c.G / 8) + bx / 8 : bx; }
    if (c.tid < 64) ((unsigned*)(lds + MISC_OFF))[c.tid] = 0u;
    __syncthreads();
    unsigned* ctl = (unsigned*)(a.ws + WS_CTL);
    XcdBarrier bar = xcd_barrier_post(ctl + CW_BAR, (volatile LAS unsigned*)(lds + MISC_OFF));
#ifdef ONLY_PH
#define PH_ON(k) ((k) == ONLY_PH)
#else
#define PH_ON(k) 1
#endif
    const int lo = a.ph_lo, hi = a.ph_hi;
#define RUN_PHASE(k, fn) if (PH_ON(k) && lo <= (k) && (k) < hi) { \
        int _t = threadIdx.x; asm volatile("" : "+v"(_t)); c.tid = _t; c.lane = _t & 63; c.wid = __builtin_amdgcn_readfirstlane(_t >> 6); \
        fn(c); if ((k) + 1 < hi) xcd_barrier(bar); }
    RUN_PHASE(0, phase0)
    RUN_PHASE(1, phase1)
    RUN_PHASE(2, phase2)
    RUN_PHASE(3, phase3)
    RUN_PHASE(4, phase4)
    RUN_PHASE(5, phase5)
    RUN_PHASE(6, phase6a)
    RUN_PHASE(7, phase6b)
    RUN_PHASE(8, phase7)
}

extern "C" void kernel_launch(void* const* d_in, const int* in_sizes, int n_in, void* d_out, int out_size, void* d_ws, size_t ws_size, hipStream_t stream) {
    static int grid = 0;
    if (grid == 0) {
        if (n_in != 27 || in_sizes[0] != NB * SEQ * D || out_size != TR * D || ws_size < WS_END) {
            fprintf(stderr, "kernel_launch: shape mismatch n_in %d in0 %d out %d ws %zu\n", n_in, n_in > 0 ? in_sizes[0] : -1, out_size, ws_size); grid = -1; return; }
        int dev = 0, cus = 0, per_cu = 0;
        if (hipGetDevice(&dev) != hipSuccess || hipDeviceGetAttribute(&cus, hipDeviceAttributeMultiprocessorCount, dev) != hipSuccess) { grid = -1; return; }
        if (hipFuncSetAttribute((const void*)fwd_kernel, hipFuncAttributeMaxDynamicSharedMemorySize, LDS_BYTES) != hipSuccess) { grid = -1; return; }
        if (hipOccupancyMaxActiveBlocksPerMultiprocessor(&per_cu, (const void*)fwd_kernel, 256, LDS_BYTES) != hipSuccess || per_cu < 1) per_cu = 1;
        (void)hipGetLastError();
        if (per_cu > 2) per_cu = 2;
        grid = cus * per_cu;
        fprintf(stderr, "kernel_launch: grid %d (%d per CU)\n", grid, per_cu);
    }
    if (grid < 0) return;
    (void)hipMemsetAsync((char*)d_ws + WS_CTL, 0, CTL_ZERO_BYTES, stream);
    Args a{};
    for (int i = 0; i < 27; ++i) a.in[i] = (const float*)d_in[i];
    a.out = (float*)d_out; a.ws = (unsigned char*)d_ws;
    if (MK_N_LAUNCHES == 1) {
        a.ph_lo = 0; a.ph_hi = NPH;
        hipLaunchKernelGGL(fwd_kernel, dim3(grid), dim3(256), LDS_BYTES, stream, a);
    } else {
        for (int ph = 0; ph < NPH; ++ph) { a.ph_lo = ph; a.ph_hi = ph + 1; hipLaunchKernelGGL(fwd_kernel, dim3(grid), dim3(256), LDS_BYTES, stream, a); }
    }
}
```

```cpp
#include <hip/hip_runtime.h>
#include <cstdio>
#include <cstdint>

#ifndef REPEAT_PH
#define REPEAT_PH -1
#endif
#ifndef MK_N_LAUNCHES
#define MK_N_LAUNCHES 1
#endif

#define DEV __device__ __forceinline__
#define LAS __attribute__((address_space(3)))
#define GAS __attribute__((address_space(1)))
typedef unsigned short bf16_t;
typedef short bf16x8 __attribute__((ext_vector_type(8)));
typedef short s16x4 __attribute__((ext_vector_type(4)));
typedef float f32x4 __attribute__((ext_vector_type(4)));
typedef float f32x16 __attribute__((ext_vector_type(16)));
typedef unsigned u32x4 __attribute__((ext_vector_type(4)));
typedef unsigned u32x2 __attribute__((ext_vector_type(2)));

constexpr int NB = 16, SEQ = 2048, NMETA = 16, L = SEQ + NMETA;
constexpr int T = NB * L;
constexpr int TR = NB * SEQ;
constexpr int D = 1024, NIN = 1696, CC = 512, QL = 384, KVL = 256, NH = 8, DQK = 96, DV = 64;
constexpr int NQ = NH * DQK;
constexpr int NKV = NH * (64 + DV);
constexpr int NE = 32, DE = 256, CONVK = 31;
constexpr float EPS = 1e-5f;
constexpr float ALPHA = 1.189207115002721f;
constexpr float QSCALE = 0.10206207261596577f * 1.4426950408889634f;
constexpr int NPH = 9;

constexpr size_t MiB = 1u << 20;
constexpr size_t WS_CTL = 0, CTL_ZERO_BYTES = 64 * 1024;
constexpr int CW_CNT = 1024, CNT_STRIDE = 64;
constexpr int CW_BAR = 4096;
constexpr size_t WS_LIST = 1 * MiB;
constexpr size_t WS_COMBW = 5 * MiB;
constexpr size_t WS_ROPE = 5 * MiB + 512 * 1024;
constexpr size_t WS_WIN = 6 * MiB;
constexpr size_t WS_WUQ = 10 * MiB;
constexpr size_t WS_WUKV = 11 * MiB;
constexpr size_t WS_WO = 12 * MiB;
constexpr size_t WS_WR = 14 * MiB;
constexpr size_t WS_WGU = 16 * MiB;
constexpr size_t WS_WD = 48 * MiB;
constexpr size_t WS_H0 = 64 * MiB;
constexpr size_t WS_U = 130 * MiB;
constexpr size_t WS_CQ = 163 * MiB;
constexpr size_t WS_CKV = 188 * MiB;
constexpr size_t WS_KR = 205 * MiB;
constexpr size_t WS_Q = 208 * MiB;
constexpr size_t WS_KV = 257 * MiB;
constexpr size_t WS_R1 = 208 * MiB;
constexpr size_t WS_Y = 208 * MiB;
constexpr size_t WS_MG = 336 * MiB;
constexpr size_t WS_ACT = 336 * MiB;
constexpr size_t WS_DUMMY = 400 * MiB;
constexpr size_t WS_END = 401 * MiB;

constexpr int LDS_BYTES = 73728;
constexpr int MISC_OFF = LDS_BYTES - 256;
constexpr int RS_OFF = 65536;
constexpr int TBL_OFF = 66048;
constexpr int EXP_OFF = 66560;

DEV unsigned cvtpk(float lo, float hi) { unsigned r; asm("v_cvt_pk_bf16_f32 %0, %1, %2" : "=v"(r) : "v"(lo), "v"(hi)); return r; }
DEV float bflo(unsigned w) { return __uint_as_float(w << 16); }
DEV float bfhi(unsigned w) { return __uint_as_float(w & 0xffff0000u); }
DEV float wave_sum(float v) {
#pragma unroll
    for (int o = 1; o < 64; o <<= 1) v += __shfl_xor(v, o);
    return v;
}
DEV void st_bf4(bf16_t* p, f32x4 v) { u32x2 w = {cvtpk(v[0], v[1]), cvtpk(v[2], v[3])}; *(u32x2*)p = w; }
DEV float fast_exp2(float x) { return __builtin_amdgcn_exp2f(x); }
DEV float fast_rcp(float x) { return __builtin_amdgcn_rcpf(x); }
DEV float sigmoidf_(float g) { return fast_rcp(1.f + fast_exp2(-1.4426950408889634f * g)); }
#define LDS_WAIT() asm volatile("s_waitcnt lgkmcnt(0)" ::: "memory")
#define VM_WAIT() asm volatile("s_waitcnt vmcnt(0)" ::: "memory")

#define XB_TMO      128
#define XB_XCNT(j)  (256  + 64 * (j))
#define XB_XSUB(j)  (1280 + 64 * (j))
#define XB_XGEN(j)  (2304 + 64 * (j))
#define XB_TOP      3328
#define XB_TOPGEN   3392
#define XCD_BAR_WORDS 3456
#define XB_SPIN_CAP (1u << 22)
DEV unsigned xb_ld(unsigned* p)              { return __hip_atomic_load(p, __ATOMIC_RELAXED, __HIP_MEMORY_SCOPE_AGENT); }
DEV unsigned xb_add(unsigned* p, unsigned v) { return __hip_atomic_fetch_add(p, v, __ATOMIC_RELAXED, __HIP_MEMORY_SCOPE_AGENT); }
DEV unsigned xb_xcc_id() { return (unsigned)__builtin_amdgcn_s_getreg((3 << 11) | 20) & 0xFu; }
#define XB_SPIN(cond, bar) do { unsigned _sp = 0; while (cond) { __builtin_amdgcn_s_sleep(1); \
    if ((++_sp & 255u) == 0u) { if (xb_ld(&(bar)[XB_TMO])) break; if (_sp > XB_SPIN_CAP) { atomicAdd(&(bar)[XB_TMO], 1u); break; } } } } while (0)
struct XcdBarrier { unsigned* bar; unsigned x; volatile LAS unsigned* st; };
DEV XcdBarrier xcd_barrier_post(unsigned* bar, volatile LAS unsigned* st) {
    XcdBarrier b; b.bar = bar; b.x = xb_xcc_id(); b.st = st;
    if (threadIdx.x == 0) (void)xb_add(&bar[XB_XCNT(b.x)], 1u);
    return b;
}
DEV void xcd_barrier_complete(unsigned* bar, unsigned x, unsigned& nloc, unsigned& nx) {
    const unsigned G = gridDim.x * gridDim.y * gridDim.z;
    unsigned sum, cnt, mine, sp = 0u;
    for (;;) {
        sum = 0u; cnt = 0u; mine = 0u;
#pragma unroll
        for (unsigned j = 0; j < 16; ++j) { const unsigned c = xb_ld(&bar[XB_XCNT(j)]); sum += c; cnt += (c > 0u) ? 1u : 0u; mine = (j == x) ? c : mine; }
        if (sum == G) break;
        __builtin_amdgcn_s_sleep(1);
        if ((++sp & 255u) == 0u) { if (xb_ld(&bar[XB_TMO])) break; if (sp > XB_SPIN_CAP) { atomicAdd(&bar[XB_TMO], 1u); break; } }
    }
    nloc = mine > 0u ? mine : 1u; nx = cnt > 0u ? cnt : 1u;
}
DEV void xcd_barrier(const XcdBarrier& b) {
    asm volatile("s_waitcnt vmcnt(0)" ::: "memory");
    __syncthreads();
    if (threadIdx.x == 0) {
        unsigned* bar = b.bar;
        __builtin_amdgcn_s_waitcnt(0);
        unsigned nloc = b.st[0], nx = b.st[1];
        if (nloc == 0u) { xcd_barrier_complete(bar, b.x, nloc, nx); b.st[0] = nloc; b.st[1] = nx; }
        const unsigned old = xb_add(&bar[XB_XSUB(b.x)], 1u);
        const unsigned gen = old / nloc;
        if (old + 1u == (gen + 1u) * nloc) {
            __builtin_amdgcn_fence(__ATOMIC_RELEASE, "agent");
            asm volatile("s_waitcnt vmcnt(0)" ::: "memory");
            const unsigned og = xb_add(&bar[XB_TOP], 1u);
            const unsigned tg = og / nx;
            if (og + 1u == (tg + 1u) * nx) xb_add(&bar[XB_TOPGEN], 1u);
            else XB_SPIN(xb_ld(&bar[XB_TOPGEN]) == tg, bar);
            __builtin_amdgcn_fence(__ATOMIC_ACQUIRE, "agent");
            xb_add(&bar[XB_XGEN(b.x)], 1u);
            asm volatile("s_waitcnt vmcnt(0)" ::: "memory");
        } else {
            XB_SPIN(xb_ld(&bar[XB_XGEN(b.x)]) == gen, bar);
            __builtin_amdgcn_fence(__ATOMIC_ACQUIRE, "agent");
            asm volatile("s_waitcnt vmcnt(0)" ::: "memory");
        }
    }
    __syncthreads();
}

struct Args { const float* in[27]; float* out; unsigned char* ws; int ph_lo, ph_hi; };
struct Ctx {
    const float* const* in; float* out; unsigned char* ws; unsigned char* lds;
    int tid, lane, wid, vcu, G;
};
enum { I_X = 0, I_META, I_LNIN_G, I_LNIN_B, I_WIN, I_CONVW, I_CONVB, I_CLN_G, I_CLN_B, I_QNG, I_WUQ, I_KVNG, I_WUKV, I_COUT_G, I_AOUT_G, I_WO,
       I_LN1G, I_LN1B, I_WRG, I_BRG, I_WRE, I_BRE, I_WGATE, I_WUP, I_WDOWN, I_LN2G, I_LN2B };

DEV int nmap(int mode, int n) {
    if (mode == 1) { if (n < 512) return ((n >> 4) << 5) + (n & 15); if (n < 1024) return (((n - 512) >> 4) << 5) + 16 + (n & 15); return n; }
    if (mode == 2) return ((n >> 4) << 5) + (n & 15);
    if (mode == 3) return ((n >> 4) << 5) + 16 + (n & 15);
    return n;
}
DEV void p0_transpose_item(const float* __restrict__ W, int N, int k0, int n0, const float* __restrict__ kscale, bf16_t* WT, int ldt, int kout0, int mode,
                           float* scr, int lane) {
#pragma unroll 8
    for (int i = 0; i < 32; ++i) {
        const int kk = 2 * i + (lane >> 5);
        float v = W[(size_t)(k0 + kk) * N + n0 + (lane & 31)];
        if (kscale) v *= kscale[k0 + kk];
        scr[kk * 33 + (lane & 31)] = v;
    }
    LDS_WAIT(); asm volatile("" ::: "memory");
    const int c = lane & 7;
#pragma unroll
    for (int j = 0; j < 4; ++j) {
        const int n = (lane >> 3) + 8 * j; const float* s = scr + (8 * c) * 33 + n;
        u32x4 o; o.x = cvtpk(s[0 * 33], s[1 * 33]); o.y = cvtpk(s[2 * 33], s[3 * 33]); o.z = cvtpk(s[4 * 33], s[5 * 33]); o.w = cvtpk(s[6 * 33], s[7 * 33]);
        *(u32x4*)(WT + (size_t)nmap(mode, n0 + n) * ldt + kout0 + 8 * c) = o;
    }
    LDS_WAIT(); asm volatile("" ::: "memory");
}
template <int N> DEV void wave_sum_n(float (&v)[N]) {
#pragma unroll
    for (int o = 1; o < 64; o <<= 1) {
#pragma unroll
        for (int i = 0; i < N; ++i) v[i] += __shfl_xor(v[i], o);
    }
}
template <int NR> DEV void ln_rows_bf16(const float* const (&xrow)[NR], const float* g, const float* bta, bf16_t* const (&orow)[NR], unsigned char* const (&ldsrow)[NR], int lane) {
    f32x4 v[NR][4]; float s[NR];
#pragma unroll
    for (int r = 0; r < NR; ++r)
#pragma unroll
        for (int j = 0; j < 4; ++j) v[r][j] = ((const f32x4*)xrow[r])[64 * j + lane];
#pragma unroll
    for (int r = 0; r < NR; ++r) { s[r] = 0.f;
#pragma unroll
        for (int j = 0; j < 4; ++j) s[r] += (v[r][j].x + v[r][j].y) + (v[r][j].z + v[r][j].w); }
    wave_sum_n<NR>(s);
    float s2[NR];
#pragma unroll
    for (int r = 0; r < NR; ++r) { const float mean = s[r] * (1.f / 1024.f); s2[r] = 0.f;
#pragma unroll
        for (int j = 0; j < 4; ++j) { v[r][j] = v[r][j] - mean; s2[r] += (v[r][j].x * v[r][j].x + v[r][j].y * v[r][j].y) + (v[r][j].z * v[r][j].z + v[r][j].w * v[r][j].w); } }
    wave_sum_n<NR>(s2);
#pragma unroll
    for (int j = 0; j < 4; ++j) {
        const f32x4 gg = ((const f32x4*)g)[64 * j + lane], bb = ((const f32x4*)bta)[64 * j + lane];
#pragma unroll
        for (int r = 0; r < NR; ++r) {
            const float rstd = 1.f / sqrtf(s2[r] * (1.f / 1024.f) + EPS);
            const f32x4 o = v[r][j] * rstd * gg + bb;
            const u32x2 w = {cvtpk(o.x, o.y), cvtpk(o.z, o.w)};
            ((u32x2*)orow[r])[64 * j + lane] = w;
            if (ldsrow[r]) ((u32x2*)ldsrow[r])[64 * j + lane] = w;
        }
    }
}
__device__ const float INVF[16] = {1.0f, 0.5623413251903491f, 0.31622776601683794f, 0.1778279410038923f, 0.1f, 0.05623413251903491f, 0.031622776601683794f,
    0.01778279410038923f, 0.01f, 0.005623413251903491f, 0.0031622776601683794f, 0.001778279410038923f, 0.001f, 0.0005623413251903491f, 0.00031622776601683794f, 0.0001778279410038923f};
DEV void sincos_d(double a, float& sn, float& cs) {
    const double TWO_PI = 6.283185307179586476925286766559;
    const double k = __builtin_rint(a / TWO_PI);
    const double r = a - k * TWO_PI;
    const double r2 = r * r;
    double st = r, ct = 1.0, ssum = r, csum = 1.0;
#pragma unroll 1
    for (int i = 1; i <= 14; ++i) {
        ct = -ct * r2 / (double)((2 * i - 1) * (2 * i));  csum += ct;
        st = -st * r2 / (double)((2 * i) * (2 * i + 1));  ssum += st;
    }
    sn = (float)ssum; cs = (float)csum;
}
DEV void phase0(const Ctx& c) {
    float* scr = (float*)(c.lds + c.wid * 8448);
    const int gw = c.vcu * 4 + c.wid, NGW = c.G * 4;
    constexpr int I_IN = 16 * 53, I_UQ = 6 * 24, I_UKV = 4 * 32, I_O = 16 * 32, I_G = 32 * 128, I_U = I_G, I_D = 32 * 128;
    constexpr int NITEMS = I_IN + I_UQ + I_UKV + I_O + I_G + I_U + I_D;
    bf16_t* WinT = (bf16_t*)(c.ws + WS_WIN); bf16_t* WuqT = (bf16_t*)(c.ws + WS_WUQ); bf16_t* WukvT = (bf16_t*)(c.ws + WS_WUKV);
    bf16_t* WoT = (bf16_t*)(c.ws + WS_WO); bf16_t* WguT = (bf16_t*)(c.ws + WS_WGU); bf16_t* WdT = (bf16_t*)(c.ws + WS_WD);
    for (int it = gw; it < NITEMS; it += NGW) {
        int r = it;
        if (r < I_IN) { const int kb = r / 53, nb = r % 53; p0_transpose_item(c.in[I_WIN], NIN, 64 * kb, 32 * nb, nullptr, WinT, 1024, 64 * kb, 1, scr, c.lane); continue; } r -= I_IN;
        if (r < I_UQ) { const int kb = r / 24, nb = r % 24; p0_transpose_item(c.in[I_WUQ], NQ, 64 * kb, 32 * nb, c.in[I_QNG], WuqT, QL, 64 * kb, 0, scr, c.lane); continue; } r -= I_UQ;
        if (r < I_UKV) { const int kb = r / 32, nb = r % 32; p0_transpose_item(c.in[I_WUKV], NKV, 64 * kb, 32 * nb, c.in[I_KVNG], WukvT, KVL, 64 * kb, 0, scr, c.lane); continue; } r -= I_UKV;
        if (r < I_O) { const int kb = r / 32, nb = r % 32;
            if (kb < 8) p0_transpose_item(c.in[I_WO], D, 64 * kb, 32 * nb, nullptr, WoT, 1024, 64 * kb + 512, 0, scr, c.lane);
            else        p0_transpose_item(c.in[I_WO], D, 64 * kb, 32 * nb, c.in[I_AOUT_G] - 512, WoT, 1024, 64 * kb - 512, 0, scr, c.lane);
            continue; } r -= I_O;
        if (r < I_G) { const int e = r >> 7, q = r & 127, kb = q >> 3, nb = q & 7;
            p0_transpose_item(c.in[I_WGATE] + (size_t)e * D * DE, DE, 64 * kb, 32 * nb, nullptr, WguT + (size_t)e * 512 * 1024, 1024, 64 * kb, 2, scr, c.lane); continue; } r -= I_G;
        if (r < I_U) { const int e = r >> 7, q = r & 127, kb = q >> 3, nb = q & 7;
            p0_transpose_item(c.in[I_WUP] + (size_t)e * D * DE, DE, 64 * kb, 32 * nb, nullptr, WguT + (size_t)e * 512 * 1024, 1024, 64 * kb, 3, scr, c.lane); continue; } r -= I_U;
        { const int e = r >> 7, q = r & 127, kb = q >> 5, nb = q & 31;
            p0_transpose_item(c.in[I_WDOWN] + (size_t)e * DE * D, D, 64 * kb, 32 * nb, nullptr, WdT + (size_t)e * 1024 * 256, 256, 64 * kb, 0, scr, c.lane); }
    }
    const int gt = c.vcu * 256 + c.tid, NGT = c.G * 256;
    bf16_t* WrT = (bf16_t*)(c.ws + WS_WR);
    for (int i = gt; i < 48 * 1024; i += NGT) {
        const int n = i >> 10, k = i & 1023; float v = 0.f;
        if (n < 4) v = c.in[I_WRG][k * 4 + n]; else if (n < 36) v = c.in[I_WRE][k * 32 + (n - 4)];
        WrT[i] = (bf16_t)(cvtpk(v, 0.f) & 0xffffu);
    }
    float* rc = (float*)(c.ws + WS_ROPE); float* rs = rc + L * 16;
    for (int i = gt; i < L * 16; i += NGT) {
        const int p = i >> 4, f = i & 15; const float ang = (float)p * INVF[f];
        float sn, cs; sincos_d((double)ang, sn, cs); rc[i] = cs; rs[i] = sn;
    }
    bf16_t* h0 = (bf16_t*)(c.ws + WS_H0);
    for (int t = gw; t < T; t += 2 * NGW) {
        const float* src[2]; bf16_t* dst[2]; unsigned char* ldsn[2] = {nullptr, nullptr};
#pragma unroll
        for (int r = 0; r < 2; ++r) { int tt = t + r * NGW; if (tt >= T) tt = t;
            const int b = tt / L, p = tt - b * L;
            src[r] = (p < NMETA) ? c.in[I_META] + (size_t)p * D : c.in[I_X] + ((size_t)b * SEQ + (p - NMETA)) * D;
            dst[r] = h0 + (size_t)tt * D; }
        ln_rows_bf16<2>(src, c.in[I_LNIN_G], c.in[I_LNIN_B], dst, ldsn, c.lane);
    }
}

struct StageGeo { int r[4]; int c; };
DEV StageGeo stage_geo(int tid) {
    const int lane = tid & 63, wid = tid >> 6; StageGeo g;
    const int rl = lane >> 2, cl = ((lane & 3) * 8) ^ ((lane >> 5) << 4);
#pragma unroll
    for (int i = 0; i < 4; ++i) g.r[i] = (((wid + 4 * i) >> 1) << 4) + rl;
    g.c = ((wid & 1) << 5) + cl;
    return g;
}
template <bool SSQ>
DEV void gemm_mainloop(f32x4 (&acc)[4][4], const bf16_t* ap0, const bf16_t* ap1, const bf16_t* ap2, const bf16_t* ap3,
                       const bf16_t* bp0, const bf16_t* bp1, const bf16_t* bp2, const bf16_t* bp3,
                       int nk, unsigned char* lds, int ssq_steps, float ssq_inv_dim) {
    const int tid = threadIdx.x, lane = tid & 63, wid = tid >> 6, wr = wid >> 1, wc = wid & 1, fr = lane & 15, fq = lane >> 4;
    const int lo = ((fr * 64 + fq * 16) ^ ((fr >> 3) << 5));
    const int a_off = (wr * 4) * 2048 + lo, b_off = 16384 + (wc * 4) * 2048 + lo;
    const int dst = tid * 16;
    float ssq = 0.f;
#pragma unroll
    for (int m = 0; m < 4; ++m)
#pragma unroll
        for (int n = 0; n < 4; ++n) acc[m][n] = (f32x4){0.f, 0.f, 0.f, 0.f};
    __syncthreads();
#define GLDS(src, off) __builtin_amdgcn_global_load_lds((const unsigned*)(src), (unsigned LAS*)(lds + (off)), 16, 0, 0)
#define STAGE(kt, b) do { const int _k = (kt) * 64; \
        GLDS(ap0 + _k, (b) * 32768 + dst);          GLDS(ap1 + _k, (b) * 32768 + dst + 4096); \
        GLDS(ap2 + _k, (b) * 32768 + dst + 8192);   GLDS(ap3 + _k, (b) * 32768 + dst + 12288); \
        GLDS(bp0 + _k, (b) * 32768 + 16384 + dst);  GLDS(bp1 + _k, (b) * 32768 + 16384 + dst + 4096); \
        GLDS(bp2 + _k, (b) * 32768 + 16384 + dst + 8192); GLDS(bp3 + _k, (b) * 32768 + 16384 + dst + 12288); } while (0)
    STAGE(0, 0);
    for (int kt = 0; kt < nk; ++kt) {
        VM_WAIT();
        __syncthreads();
        const int b = kt & 1;
        if (SSQ && kt == ssq_steps) {
            const float* rsl = (const float*)(lds + RS_OFF);
#pragma unroll
            for (int m = 0; m < 4; ++m) { const float r = rsl[wr * 64 + m * 16 + fr];
#pragma unroll
                for (int n = 0; n < 4; ++n) acc[m][n] = acc[m][n] * r; }
        }
        if (kt + 1 < nk) { if (b) STAGE(kt + 1, 0); else STAGE(kt + 1, 1); }
        const unsigned char* base = lds + b * 32768;
#pragma unroll
        for (int ks = 0; ks < 2; ++ks) {
            bf16x8 af[4], bf[4];
#pragma unroll
            for (int m = 0; m < 4; ++m) af[m] = *(const bf16x8*)(base + a_off + m * 2048 + ks * 1024);
#pragma unroll
            for (int n = 0; n < 4; ++n) bf[n] = *(const bf16x8*)(base + b_off + n * 2048 + ks * 1024);
#pragma unroll
            for (int m = 0; m < 4; ++m)
#pragma unroll
                for (int n = 0; n < 4; ++n) acc[m][n] = __builtin_amdgcn_mfma_f32_16x16x32_bf16(bf[n], af[m], acc[m][n], 0, 0, 0);
        }
        if (SSQ && kt < ssq_steps) {
            const int row = tid >> 1, hf = tid & 1;
            const int rb = ((row >> 4) * 2 + hf) * 1024 + (row & 15) * 64, sw = ((row & 15) >> 3) << 5;
#pragma unroll
            for (int j = 0; j < 4; ++j) {
                const u32x4 w = *(const u32x4*)(base + rb + ((j * 16) ^ sw));
#pragma unroll
                for (int q = 0; q < 4; ++q) { const float a = bflo(w[q]), bb = bfhi(w[q]); ssq += a * a + bb * bb; }
            }
            if (kt == ssq_steps - 1) {
                const float tot = ssq + __shfl_xor(ssq, 1);
                if (hf == 0) ((float*)(lds + RS_OFF))[row] = 1.f / sqrtf(tot * ssq_inv_dim + EPS);
            }
        }
    }
    if (SSQ && ssq_steps == nk) {
        __syncthreads();
        const float* rsl = (const float*)(lds + RS_OFF);
#pragma unroll
        for (int m = 0; m < 4; ++m) { const float r = rsl[wr * 64 + m * 16 + fr];
#pragma unroll
            for (int n = 0; n < 4; ++n) acc[m][n] = acc[m][n] * r; }
    }
#undef STAGE
#undef GLDS
}

DEV void phase1(const Ctx& c) {
    const bf16_t* h0 = (const bf16_t*)(c.ws + WS_H0); const bf16_t* WinT = (const bf16_t*)(c.ws + WS_WIN);
    bf16_t* U = (bf16_t*)(c.ws + WS_U); bf16_t* CQ = (bf16_t*)(c.ws + WS_CQ); bf16_t* CKV = (bf16_t*)(c.ws + WS_CKV); bf16_t* KR = (bf16_t*)(c.ws + WS_KR);
    const float* rc = (const float*)(c.ws + WS_ROPE); const float* rs = rc + L * 16;
    const StageGeo g = stage_geo(c.tid);
    const int lane = c.lane, wr = c.wid >> 1, wc = c.wid & 1, fr = lane & 15, fq = lane >> 4;
    constexpr int NT = 14, NU = (T / 128) * NT;
    for (int u = c.vcu; u < NU; u += c.G) {
        const int mt = u / NT, nt = u - mt * NT;
        const bf16_t* A = h0 + (size_t)(mt * 128) * D + g.c; const bf16_t* B = WinT + (size_t)(nt * 128) * D + g.c;
        f32x4 acc[4][4];
        gemm_mainloop<false>(acc, A + (size_t)g.r[0] * D, A + (size_t)g.r[1] * D, A + (size_t)g.r[2] * D, A + (size_t)g.r[3] * D,
                             B + (size_t)g.r[0] * D, B + (size_t)g.r[1] * D, B + (size_t)g.r[2] * D, B + (size_t)g.r[3] * D, 16, c.lds, 0, 0.f);
        const int row0 = mt * 128 + wr * 64 + fr;
        if (nt < 8) {
#pragma unroll
            for (int m = 0; m < 4; ++m) { const size_t row = row0 + m * 16;
#pragma unroll
                for (int i = 0; i < 2; ++i) {
                    f32x4 a = acc[m][2 * i], gt = acc[m][2 * i + 1], o;
#pragma unroll
                    for (int j = 0; j < 4; ++j) o[j] = a[j] * sigmoidf_(gt[j]);
                    st_bf4(U + row * CC + nt * 64 + wc * 32 + i * 16 + fq * 4, o);
                } }
        } else if (nt < 11) {
#pragma unroll
            for (int m = 0; m < 4; ++m) { const size_t row = row0 + m * 16;
#pragma unroll
                for (int n = 0; n < 4; ++n) st_bf4(CQ + row * QL + (nt - 8) * 128 + wc * 64 + n * 16 + fq * 4, acc[m][n]); }
        } else if (nt < 13) {
#pragma unroll
            for (int m = 0; m < 4; ++m) { const size_t row = row0 + m * 16;
#pragma unroll
                for (int n = 0; n < 4; ++n) st_bf4(CKV + row * KVL + (nt - 11) * 128 + wc * 64 + n * 16 + fq * 4, acc[m][n]); }
        } else if (wc == 0) {
#pragma unroll
            for (int m = 0; m < 4; ++m) { const int row = row0 + m * 16; const int p = row % L;
                const f32x4 cs = *(const f32x4*)(rc + p * 16 + fq * 4), sn = *(const f32x4*)(rs + p * 16 + fq * 4);
                const f32x4 x1 = acc[m][0], x2 = acc[m][1];
                st_bf4(KR + (size_t)row * 32 + fq * 4, x1 * cs - x2 * sn);
                st_bf4(KR + (size_t)row * 32 + 16 + fq * 4, x1 * sn + x2 * cs); }
        }
    }
}

DEV void conv_unit(const Ctx& c, int b, int j) {
    const bf16_t* U = (const bf16_t*)(c.ws + WS_U);
    bf16_t* MG = (bf16_t*)(c.ws + WS_MG);
    const float* cw = c.in[I_CONVW]; const float* cb = c.in[I_CONVB];
    const int p0 = j * 32;
    float* ytile = (float*)c.lds;
    __syncthreads();
#pragma unroll 1
    for (int pass = 0; pass < 2; ++pass) {
        const int ch = c.tid + 256 * pass;
        float win[62]; unsigned raw[62];
        const bf16_t* ub = U + (size_t)b * L * CC + ch;
#pragma unroll
        for (int i = 0; i < 62; ++i) { const int p = p0 - 30 + i; const int pc = p < 0 ? 0 : (p >= L ? L - 1 : p); raw[i] = ub[(size_t)pc * CC]; }
        float w[31];
#pragma unroll
        for (int k = 0; k < 31; ++k) w[k] = cw[k * CC + ch];
        const float bias = cb[ch];
        __builtin_amdgcn_sched_barrier(0);
#pragma unroll
        for (int i = 0; i < 62; ++i) { const int p = p0 - 30 + i; win[i] = (p >= 0 && p < L) ? __uint_as_float(raw[i] << 16) : 0.f; }
#pragma unroll
        for (int tt = 0; tt < 32; ++tt) {
            float a0 = bias;
#pragma unroll
            for (int k = 0; k < 31; ++k) a0 += w[k] * win[tt + k];
            ytile[tt * 512 + ch] = a0;
        }
    }
    __syncthreads();
    const float* g1 = c.in[I_CLN_G]; const float* b1 = c.in[I_CLN_B]; const float* g2 = c.in[I_COUT_G];
    float G1[8], B1[8], G2[8];
    { const f32x4 a = *(const f32x4*)(g1 + c.lane * 8), bq = *(const f32x4*)(g1 + c.lane * 8 + 4); G1[0]=a.x;G1[1]=a.y;G1[2]=a.z;G1[3]=a.w;G1[4]=bq.x;G1[5]=bq.y;G1[6]=bq.z;G1[7]=bq.w; }
    { const f32x4 a = *(const f32x4*)(b1 + c.lane * 8), bq = *(const f32x4*)(b1 + c.lane * 8 + 4); B1[0]=a.x;B1[1]=a.y;B1[2]=a.z;B1[3]=a.w;B1[4]=bq.x;B1[5]=bq.y;B1[6]=bq.z;B1[7]=bq.w; }
    { const f32x4 a = *(const f32x4*)(g2 + c.lane * 8), bq = *(const f32x4*)(g2 + c.lane * 8 + 4); G2[0]=a.x;G2[1]=a.y;G2[2]=a.z;G2[3]=a.w;G2[4]=bq.x;G2[5]=bq.y;G2[6]=bq.z;G2[7]=bq.w; }
    float v[8][8]; float st[8];
#pragma unroll
    for (int i = 0; i < 8; ++i) { const int tt = c.wid * 8 + i;
        const f32x4 ya = *(const f32x4*)(ytile + tt * 512 + c.lane * 8), yb = *(const f32x4*)(ytile + tt * 512 + c.lane * 8 + 4);
        v[i][0]=ya.x;v[i][1]=ya.y;v[i][2]=ya.z;v[i][3]=ya.w;v[i][4]=yb.x;v[i][5]=yb.y;v[i][6]=yb.z;v[i][7]=yb.w;
        st[i] = ((v[i][0] + v[i][1]) + (v[i][2] + v[i][3])) + ((v[i][4] + v[i][5]) + (v[i][6] + v[i][7])); }
    wave_sum_n<8>(st);
#pragma unroll
    for (int i = 0; i < 8; ++i) { const float mean = st[i] * (1.f / 512.f); float a = 0.f;
#pragma unroll
        for (int q = 0; q < 8; ++q) { v[i][q] -= mean; a += v[i][q] * v[i][q]; }
        st[i] = a; }
    wave_sum_n<8>(st);
#pragma unroll
    for (int i = 0; i < 8; ++i) { const float rstd = 1.f / sqrtf(st[i] * (1.f / 512.f) + EPS); float a = 0.f;
#pragma unroll
        for (int q = 0; q < 8; ++q) { const float x = v[i][q] * rstd * G1[q] + B1[q]; const float y = x * sigmoidf_(x); v[i][q] = y; a += y * y; }
        st[i] = a; }
    wave_sum_n<8>(st);
#pragma unroll
    for (int i = 0; i < 8; ++i) {
        const int p = p0 + c.wid * 8 + i;
        {
            const float r2 = 1.f / sqrtf(st[i] * (1.f / 512.f) + EPS);
            u32x4 o;
            o.x = cvtpk(v[i][0] * r2 * G2[0], v[i][1] * r2 * G2[1]); o.y = cvtpk(v[i][2] * r2 * G2[2], v[i][3] * r2 * G2[3]);
            o.z = cvtpk(v[i][4] * r2 * G2[4], v[i][5] * r2 * G2[5]); o.w = cvtpk(v[i][6] * r2 * G2[6], v[i][7] * r2 * G2[7]);
            const size_t tok = (size_t)b * SEQ + (p - NMETA);
            bf16_t* dstp = (p >= NMETA && p < L) ? MG + tok * D + 512 + c.lane * 8 : (bf16_t*)(c.ws + WS_DUMMY) + c.lane * 8;
            *(u32x4*)dstp = o;
        }
    }
}
DEV void rope4(f32x4& x1, f32x4& x2, const float* rc, const float* rs, int p, int fq) {
    const f32x4 cs = *(const f32x4*)(rc + p * 16 + fq * 4), sn = *(const f32x4*)(rs + p * 16 + fq * 4);
    const f32x4 a = x1 * cs - x2 * sn, bb = x1 * sn + x2 * cs; x1 = a; x2 = bb;
}
template <int SEL> DEV void phase2_t(const Ctx& c) {
    const bf16_t* CQ = (const bf16_t*)(c.ws + WS_CQ); const bf16_t* CKV = (const bf16_t*)(c.ws + WS_CKV);
    const bf16_t* WuqT = (const bf16_t*)(c.ws + WS_WUQ); const bf16_t* WukvT = (const bf16_t*)(c.ws + WS_WUKV);
    bf16_t* Q = (bf16_t*)(c.ws + WS_Q); bf16_t* KV = (bf16_t*)(c.ws + WS_KV);
    const float* rc = (const float*)(c.ws + WS_ROPE); const float* rs = rc + L * 16;
    const StageGeo g = stage_geo(c.tid);
    const int lane = c.lane, wr = c.wid >> 1, wc = c.wid & 1, fr = lane & 15, fq = lane >> 4;
    constexpr int MT = T / 128, NUQ = MT * 6, NUKV = MT * 8, NUC = NB * 65, NU = NUQ + NUKV + NUC;
    for (int u = c.vcu; u < NU; u += c.G) {
        if (SEL == 1 && u >= NUKV + NUQ) continue;
        if (SEL == 2 && u < NUKV + NUQ) continue;
        if (u < NUKV) {
            const int mt = u >> 3, nt = u & 7;
            const bf16_t* A = CKV + (size_t)(mt * 128) * KVL + g.c; const bf16_t* B = WukvT + (size_t)(nt * 128) * KVL + g.c;
            f32x4 acc[4][4];
            gemm_mainloop<true>(acc, A + (size_t)g.r[0] * KVL, A + (size_t)g.r[1] * KVL, A + (size_t)g.r[2] * KVL, A + (size_t)g.r[3] * KVL,
                                B + (size_t)g.r[0] * KVL, B + (size_t)g.r[1] * KVL, B + (size_t)g.r[2] * KVL, B + (size_t)g.r[3] * KVL, 4, c.lds, 4, 1.f / 256.f);
            const int row0 = mt * 128 + wr * 64 + fr;
#pragma unroll
            for (int m = 0; m < 4; ++m) { const size_t row = row0 + m * 16;
#pragma unroll
                for (int n = 0; n < 4; ++n) st_bf4(KV + row * NKV + nt * 128 + wc * 64 + n * 16 + fq * 4, acc[m][n]); }
        } else if (u < NUKV + NUQ) {
            const int v = u - NUKV, mt = v / 6, nt = v - mt * 6;
            const bf16_t* A = CQ + (size_t)(mt * 128) * QL + g.c; const bf16_t* B = WuqT + (size_t)(nt * 128) * QL + g.c;
            f32x4 acc[4][4];
            gemm_mainloop<true>(acc, A + (size_t)g.r[0] * QL, A + (size_t)g.r[1] * QL, A + (size_t)g.r[2] * QL, A + (size_t)g.r[3] * QL,
                                B + (size_t)g.r[0] * QL, B + (size_t)g.r[1] * QL, B + (size_t)g.r[2] * QL, B + (size_t)g.r[3] * QL, 6, c.lds, 6, 1.f / 384.f);
            const int row0 = mt * 128 + wr * 64 + fr;
            const int t16 = (nt * 8 + wc * 4) % 6;
#pragma unroll
            for (int m = 0; m < 4; ++m) { const int row = row0 + m * 16; const int p = row % L;
#pragma unroll
                for (int n = 0; n < 4; ++n) acc[m][n] = acc[m][n] * QSCALE;
                if (t16 == 4) rope4(acc[m][0], acc[m][1], rc, rs, p, fq);
                if (t16 == 2) rope4(acc[m][2], acc[m][3], rc, rs, p, fq);
#pragma unroll
                for (int n = 0; n < 4; ++n) st_bf4(Q + (size_t)row * NQ + nt * 128 + wc * 64 + n * 16 + fq * 4, acc[m][n]); }
        } else {
            const int v = u - NUKV - NUQ; conv_unit(c, v / 65, v % 65);
        }
    }
}

DEV void phase2(const Ctx& c) { phase2_t<0>(c); }
DEV void phase2g(const Ctx& c) { phase2_t<1>(c); }
DEV void phase2c(const Ctx& c) { phase2_t<2>(c); }
DEV int crow(int r, int hi) { return (r & 3) + 8 * (r >> 2) + 4 * hi; }
#define KSWZ(row, colB) ((row) * 256 + ((colB) ^ (((row) & 7) << 4)))
#define SBAR() __builtin_amdgcn_sched_barrier(0)
DEV int v_st(int k, int cc) { const int kk = (k & ~0xC) | ((k & 4) << 1) | ((k & 8) >> 1); return ((kk >> 3) * 4 + (cc >> 5)) * 512 + ((kk & 7) * 32 + (cc & 31)) * 2; }
DEV int v_rd_base(int lane) { return ((lane & 3) << 3) | (((lane >> 2) & 3) << 6) | (((lane >> 4) & 1) << 5) | (((lane >> 5) & 1) << 8); }
constexpr int v_rd_off(int d0, int ks, int half) { return d0 * 512 + ks * 4096 + half * 2048; }
template <int OFF> DEV s16x4 tr_read(int vb) { s16x4 r; asm volatile("ds_read_b64_tr_b16 %0, %1 offset:%2" : "=&v"(r) : "v"(vb), "i"(OFF) : "memory"); return r; }
template <int D0> DEV void pv_one(f32x16& od, int vb, bf16x8 pa0, bf16x8 pa1, bf16x8 pa2, bf16x8 pa3) {
    const s16x4 l0 = tr_read<v_rd_off(D0, 0, 0)>(vb), h0 = tr_read<v_rd_off(D0, 0, 1)>(vb), l1 = tr_read<v_rd_off(D0, 1, 0)>(vb), h1 = tr_read<v_rd_off(D0, 1, 1)>(vb);
    const s16x4 l2 = tr_read<v_rd_off(D0, 2, 0)>(vb), h2 = tr_read<v_rd_off(D0, 2, 1)>(vb), l3 = tr_read<v_rd_off(D0, 3, 0)>(vb), h3 = tr_read<v_rd_off(D0, 3, 1)>(vb);
    asm volatile("s_waitcnt lgkmcnt(0)" ::: "memory"); SBAR();
#define PK(Lo, Hi) (bf16x8){Lo[0], Lo[1], Lo[2], Lo[3], Hi[0], Hi[1], Hi[2], Hi[3]}
    od = __builtin_amdgcn_mfma_f32_32x32x16_bf16(pa0, PK(l0, h0), od, 0, 0, 0);
    od = __builtin_amdgcn_mfma_f32_32x32x16_bf16(pa1, PK(l1, h1), od, 0, 0, 0);
    od = __builtin_amdgcn_mfma_f32_32x32x16_bf16(pa2, PK(l2, h2), od, 0, 0, 0);
    od = __builtin_amdgcn_mfma_f32_32x32x16_bf16(pa3, PK(l3, h3), od, 0, 0, 0);
#undef PK
}
constexpr int AT_V = 0, AT_K = 32768, AT_WS = 65536;
DEV void attn_unit(const Ctx& c, int b, int h, int qb) {
    const bf16_t* Q = (const bf16_t*)(c.ws + WS_Q); const bf16_t* KV = (const bf16_t*)(c.ws + WS_KV); const bf16_t* KR = (const bf16_t*)(c.ws + WS_KR);
    bf16_t* MG = (bf16_t*)(c.ws + WS_MG);
    unsigned char* lds = c.lds;
    const int tid = c.tid, wid = c.wid, lane = c.lane, r32 = lane & 31, hi = lane >> 5;
    float* wsf = (float*)(lds + AT_WS) + wid * 64; float* li_l = wsf; float* al_l = wsf + 32;
    const int NT = 2 * qb + 3;
    const int my_last = 2 * qb + (wid >> 1) + 1;
    bf16x8 qr[6];
    { const size_t t = (size_t)b * L + NMETA + qb * 128 + wid * 32 + r32;
      const bf16_t* Qw = Q + t * NQ + h * DQK + hi * 8;
#pragma unroll
      for (int d0 = 0; d0 < 6; ++d0) qr[d0] = *(const bf16x8*)(Qw + d0 * 16); }
    const int srow = tid >> 2, sq = tid & 3;
    const int vst0 = v_st(srow, sq * 16), vst1 = v_st(srow, sq * 16 + 8);
    const int kst0 = KSWZ(srow, sq * 32), kst1 = KSWZ(srow, sq * 32 + 16), kst2 = KSWZ(srow, 128 + sq * 16);
    const int vb0 = (int)(uintptr_t)(lds + AT_V) + v_rd_base(lane);
    u32x4 sk0, sk1, sk2, sv0, sv1;
#define SLOAD(j) do { int pos = (j) * 64 + srow - 48; pos = pos < 0 ? 0 : pos; const size_t tk = (size_t)b * L + pos; \
        const bf16_t* kvp = KV + tk * NKV + h * 128 + sq * 16; \
        sk0 = *(const u32x4*)(kvp); sk1 = *(const u32x4*)(kvp + 8); sv0 = *(const u32x4*)(kvp + 64); sv1 = *(const u32x4*)(kvp + 72); \
        sk2 = *(const u32x4*)(KR + tk * 32 + sq * 8); } while (0)
#define SWRITE(bb) do { unsigned char* kb = lds + AT_K + (bb) * 16384; unsigned char* vbp = lds + AT_V + (bb) * 16384; \
        *(u32x4*)(kb + kst0) = sk0; *(u32x4*)(kb + kst1) = sk1; *(u32x4*)(kb + kst2) = sk2; *(u32x4*)(vbp + vst0) = sv0; *(u32x4*)(vbp + vst1) = sv1; } while (0)
    float m_reg = -1e30f, l_reg = 0.f; f32x16 o[2] = {};
    __syncthreads();
    SLOAD(0); SWRITE(0); __syncthreads();
    for (int j = 0; j < NT; ++j) {
        const int bsel = j & 1;
        if (j + 1 < NT) SLOAD(j + 1);
        if (j <= my_last) {
            const unsigned char* Ks = lds + AT_K + bsel * 16384;
            f32x16 p0 = {}, p1 = {};
#pragma unroll
            for (int d0 = 0; d0 < 6; ++d0) { const int cb = (d0 * 16 + hi * 8) * 2;
                const bf16x8 k0 = *(const bf16x8*)(Ks + KSWZ(r32, cb)); const bf16x8 k1 = *(const bf16x8*)(Ks + KSWZ(32 + r32, cb));
                p0 = __builtin_amdgcn_mfma_f32_32x32x16_bf16(k0, qr[d0], p0, 0, 0, 0);
                p1 = __builtin_amdgcn_mfma_f32_32x32x16_bf16(k1, qr[d0], p1, 0, 0, 0); }
            if (j == 0) {
#pragma unroll
                for (int r = 0; r < 16; ++r) p0[r] = -1e30f;
#pragma unroll
                for (int r = 0; r < 8; ++r) p1[r] = -1e30f;
            }
            float pmax = p0[0];
#pragma unroll
            for (int r = 1; r < 16; ++r) pmax = fmaxf(pmax, p0[r]);
#pragma unroll
            for (int r = 0; r < 16; ++r) pmax = fmaxf(pmax, p1[r]);
            { auto rr = __builtin_amdgcn_permlane32_swap(__float_as_uint(pmax), __float_as_uint(pmax), false, false);
              pmax = fmaxf(__uint_as_float(rr[0]), __uint_as_float(rr[1])); }
            const float mn = fmaxf(m_reg, pmax);
            const float alpha = fast_exp2(m_reg - mn); m_reg = mn;
            float ps = 0.f;
#pragma unroll
            for (int r = 0; r < 16; ++r) { p0[r] = fast_exp2(p0[r] - mn); ps += p0[r]; }
#pragma unroll
            for (int r = 0; r < 16; ++r) { p1[r] = fast_exp2(p1[r] - mn); ps += p1[r]; }
            { auto rr = __builtin_amdgcn_permlane32_swap(__float_as_uint(ps), __float_as_uint(ps), false, false);
              ps = __uint_as_float(rr[0]) + __uint_as_float(rr[1]); }
            l_reg = l_reg * alpha + ps;
            bf16x8 pa0, pa1, pa2, pa3;
#define PK4(P, BASE, OUT) do { unsigned a0 = cvtpk(P[BASE + 0], P[BASE + 1]), a1 = cvtpk(P[BASE + 2], P[BASE + 3]);   \
    unsigned b0 = cvtpk(P[BASE + 4], P[BASE + 5]), b1 = cvtpk(P[BASE + 6], P[BASE + 7]);                              \
    auto r0 = __builtin_amdgcn_permlane32_swap(a0, b0, false, false); auto r1 = __builtin_amdgcn_permlane32_swap(a1, b1, false, false); \
    u32x4 w = {r0[0], r1[0], r0[1], r1[1]}; OUT = *reinterpret_cast<bf16x8*>(&w); } while (0)
            PK4(p0, 0, pa0); PK4(p0, 8, pa1); PK4(p1, 0, pa2); PK4(p1, 8, pa3);
#undef PK4
            if (__any(alpha < 1.f)) {
                if (hi == 0) al_l[r32] = alpha;
                asm volatile("s_waitcnt lgkmcnt(0)" ::: "memory");
#pragma unroll
                for (int r = 0; r < 16; ++r) { const float a = al_l[crow(r, hi)]; o[0][r] *= a; o[1][r] *= a; }
            }
            const int vb = vb0 + bsel * 16384;
            pv_one<0>(o[0], vb, pa0, pa1, pa2, pa3); pv_one<1>(o[1], vb, pa0, pa1, pa2, pa3);
        }
        if (j + 1 < NT) { if (bsel) SWRITE(0); else SWRITE(1); }
        __syncthreads();
    }
    if (hi == 0) li_l[r32] = l_reg;
    asm volatile("s_waitcnt lgkmcnt(0)" ::: "memory");
    const size_t tok0 = (size_t)b * SEQ + qb * 128 + wid * 32;
#pragma unroll
    for (int r = 0; r < 16; ++r) {
        const int orow = crow(r, hi); const float rl = fast_rcp(li_l[orow]);
        bf16_t* dst = MG + (tok0 + orow) * D + h * DV + r32;
        dst[0]  = (bf16_t)(cvtpk(o[0][r] * rl, 0.f) & 0xffffu);
        dst[32] = (bf16_t)(cvtpk(o[1][r] * rl, 0.f) & 0xffffu);
    }
#undef SLOAD
#undef SWRITE
}
DEV void phase3(const Ctx& c) {
    const int nslots = NB * NH * 4;
    for (int v = c.vcu; v < nslots; v += c.G) {
        const int bh = v >> 2, s = v & 3, b = bh >> 3, h = bh & 7;
        attn_unit(c, b, h, 15 - s); attn_unit(c, b, h, s); attn_unit(c, b, h, 11 - s); attn_unit(c, b, h, 4 + s);
    }
}

DEV void phase4(const Ctx& c) {
    const bf16_t* MG = (const bf16_t*)(c.ws + WS_MG); const bf16_t* WoT = (const bf16_t*)(c.ws + WS_WO); const bf16_t* h0 = (const bf16_t*)(c.ws + WS_H0);
    float* R1 = (float*)(c.ws + WS_R1);
    const StageGeo g = stage_geo(c.tid);
    const int lane = c.lane, wr = c.wid >> 1, wc = c.wid & 1, fr = lane & 15, fq = lane >> 4;
    constexpr int NU = (TR / 128) * 8;
    for (int u = c.vcu; u < NU; u += c.G) {
        const int mt = u >> 3, nt = u & 7;
        const bf16_t* A = MG + (size_t)(mt * 128) * D + g.c; const bf16_t* B = WoT + (size_t)(nt * 128) * D + g.c;
        f32x4 acc[4][4];
        gemm_mainloop<true>(acc, A + (size_t)g.r[0] * D, A + (size_t)g.r[1] * D, A + (size_t)g.r[2] * D, A + (size_t)g.r[3] * D,
                            B + (size_t)g.r[0] * D, B + (size_t)g.r[1] * D, B + (size_t)g.r[2] * D, B + (size_t)g.r[3] * D, 16, c.lds, 8, 1.f / 512.f);
#pragma unroll
        for (int m = 0; m < 4; ++m) {
            const int tok = mt * 128 + wr * 64 + m * 16 + fr;
            const size_t t = (size_t)(tok >> 11) * L + NMETA + (tok & 2047);
#pragma unroll
            for (int n = 0; n < 4; ++n) {
                const int col = nt * 128 + wc * 64 + n * 16 + fq * 4;
                const u32x2 hw = *(const u32x2*)(h0 + t * D + col);
                f32x4 o; o[0] = ALPHA * bflo(hw.x) + acc[m][n][0]; o[1] = ALPHA * bfhi(hw.x) + acc[m][n][1];
                o[2] = ALPHA * bflo(hw.y) + acc[m][n][2]; o[3] = ALPHA * bfhi(hw.y) + acc[m][n][3];
                *(f32x4*)(R1 + (size_t)tok * D + col) = o;
            }
        }
    }
}

constexpr int P5_ROWB = 2064, P5_PART = 33280, P5_LG = 45568, P5_BIAS = 48128, P5_AGG = 48384;
DEV void phase5(const Ctx& c, int ALT = 0) {
    const float* R1 = (const float*)(c.ws + WS_R1); bf16_t* H1 = (bf16_t*)(c.ws + WS_H0);
    const bf16_t* WrT = (const bf16_t*)(c.ws + WS_WR);
    unsigned* cnt = (unsigned*)(c.ws + WS_CTL) + CW_CNT + ALT * 32; unsigned* list = (unsigned*)(c.ws + (ALT ? 404 * MiB : WS_LIST)); float* combw = (float*)(c.ws + WS_COMBW);
    const int lane = c.lane, wid = c.wid, fr = lane & 15, fq = lane >> 4;
    float* part = (float*)(c.lds + P5_PART); float* lgs = (float*)(c.lds + P5_LG); float* biasl = (float*)(c.lds + P5_BIAS);
    __syncthreads();
    if (c.tid < 36) biasl[c.tid] = (c.tid < 4) ? c.in[I_BRG][c.tid] : c.in[I_BRE][c.tid - 4];
    bf16x8 wf[8][3];
#pragma unroll
    for (int ks = 0; ks < 8; ++ks)
#pragma unroll
        for (int n = 0; n < 3; ++n) wf[ks][n] = *(const bf16x8*)(WrT + (size_t)(n * 16 + fr) * D + wid * 256 + ks * 32 + fq * 8);
    unsigned* lcnt = (unsigned*)(c.lds + P5_AGG); unsigned* lbase = lcnt + 32; unsigned* ent = lcnt + 64;
    if (c.tid < 32) lcnt[c.tid] = 0u;
    int nent = 0;
    for (int u = c.vcu; u < TR / 16; u += c.G) {
        const int tok0 = u * 16;
        { const float* src[4]; bf16_t* dst[4]; unsigned char* ldsn[4];
#pragma unroll
          for (int i = 0; i < 4; ++i) { const int tl = wid * 4 + i; const size_t tok = tok0 + tl; src[i] = R1 + tok * D; dst[i] = H1 + tok * D; ldsn[i] = c.lds + tl * P5_ROWB; }
          ln_rows_bf16<4>(src, c.in[I_LN1G], c.in[I_LN1B], dst, ldsn, lane); }
        __syncthreads();
        f32x4 acc[3] = {};
#pragma unroll
        for (int ks = 0; ks < 8; ++ks) {
            const int k = wid * 256 + ks * 32 + fq * 8;
            const bf16x8 a = *(const bf16x8*)(c.lds + fr * P5_ROWB + k * 2);
#pragma unroll
            for (int n = 0; n < 3; ++n) acc[n] = __builtin_amdgcn_mfma_f32_16x16x32_bf16(wf[ks][n], a, acc[n], 0, 0, 0);
        }
#pragma unroll
        for (int n = 0; n < 3; ++n) *(f32x4*)(part + (wid * 16 + fr) * 48 + n * 16 + fq * 4) = acc[n];
        __syncthreads();
#pragma unroll
        for (int i = 0; i < 3; ++i) { const int idx = c.tid + 256 * i;
            if (idx < 576) { const int tk = idx / 36, l = idx - tk * 36;
                lgs[tk * 40 + l] = ((part[tk * 48 + l] + part[(16 + tk) * 48 + l]) + (part[(32 + tk) * 48 + l] + part[(48 + tk) * 48 + l])) + biasl[l]; } }
        __syncthreads();
        if (c.tid < 16) {
            const float* lg = lgs + c.tid * 40;
            int gi = 0; float gm = lg[0];
#pragma unroll
            for (int i = 1; i < 4; ++i) { const float v = lg[i]; if (v > gm) { gm = v; gi = i; } }
            float gs = 0.f;
#pragma unroll
            for (int i = 0; i < 4; ++i) gs += __expf(lg[i] - gm);
            const float gw = 1.f / gs;
            const float* le = lg + 4 + gi * 8;
            float v0 = le[0], v1 = -3.0e38f; int i0 = 0, i1 = 0;
#pragma unroll
            for (int i = 1; i < 8; ++i) { const float v = le[i];
                if (v > v0) { v1 = v0; i1 = i0; v0 = v; i0 = i; } else if (v > v1) { v1 = v; i1 = i; } }
            const float ex = __expf(v1 - v0), inv = 1.f / (1.f + ex);
            const int tok = tok0 + c.tid; const unsigned e0 = gi * 8 + i0, e1 = gi * 8 + i1;
            combw[tok * 2] = gw * inv; combw[tok * 2 + 1] = gw * ex * inv;
            const unsigned r0 = atomicAdd(&lcnt[e0], 1u), r1 = atomicAdd(&lcnt[e1], 1u);
            const int ei = nent * 32 + c.tid * 2;
            ent[2 * ei] = (unsigned)(tok * 2);         ent[2 * ei + 1] = (e0 << 16) | r0;
            ent[2 * ei + 2] = (unsigned)(tok * 2 + 1); ent[2 * ei + 3] = (e1 << 16) | r1;
        }
        ++nent;
    }
    __syncthreads();
    if (c.tid < 32) { const unsigned n = lcnt[c.tid]; lbase[c.tid] = n ? atomicAdd(&cnt[c.tid * CNT_STRIDE], n) : 0u; }
    __syncthreads();
    for (int i = c.tid; i < nent * 32; i += 256) { const unsigned t2 = ent[2 * i], er = ent[2 * i + 1]; const unsigned e = er >> 16;
        list[(size_t)e * TR + lbase[e] + (er & 0xffffu)] = t2; }
}
DEV void bar20(const Ctx& c) {}
DEV void moe_tiles(const Ctx& c) {
    const unsigned* cnt = (const unsigned*)(c.ws + WS_CTL) + CW_CNT; int* ts = (int*)(c.lds + EXP_OFF);
    __syncthreads();
    if (c.tid == 0) { int s = 0; for (int e = 0; e < NE; ++e) { ts[e] = s; s += (int)((__hip_atomic_load(&cnt[e * CNT_STRIDE], __ATOMIC_RELAXED, __HIP_MEMORY_SCOPE_AGENT) + 127u) >> 7); } ts[NE] = s; }
    __syncthreads();
}
DEV int moe_find(const int* ts, int rt) { int e = 0;
#pragma unroll 1
    for (int i = 1; i < NE; ++i) if (ts[i] <= rt) e = i;
    return e; }
DEV void phase6a(const Ctx& c) {
    const bf16_t* H1 = (const bf16_t*)(c.ws + WS_H0); const bf16_t* WguT = (const bf16_t*)(c.ws + WS_WGU); bf16_t* ACT = (bf16_t*)(c.ws + WS_ACT);
    const unsigned* cnt = (const unsigned*)(c.ws + WS_CTL) + CW_CNT; const unsigned* list = (const unsigned*)(c.ws + WS_LIST);
    moe_tiles(c);
    const int* ts = (const int*)(c.lds + EXP_OFF); unsigned* tbl = (unsigned*)(c.lds + TBL_OFF);
    const StageGeo g = stage_geo(c.tid);
    const int lane = c.lane, wr = c.wid >> 1, wc = c.wid & 1, fr = lane & 15, fq = lane >> 4;
    const int NU = ts[NE] * 4;
    for (int u = c.vcu; u < NU; u += c.G) {
        const int rt = u >> 2, nt = u & 3; const int e = moe_find(ts, rt);
        const int j0 = (rt - ts[e]) * 128; const int ne = (int)cnt[e * CNT_STRIDE];
        __syncthreads();
        if (c.tid < 128) { const int j = j0 + c.tid; tbl[c.tid] = (j < ne) ? list[(size_t)e * TR + j] : 0xffffffffu; }
        __syncthreads();
        size_t ro[4];
#pragma unroll
        for (int i = 0; i < 4; ++i) { const unsigned en = tbl[g.r[i]]; ro[i] = (en == 0xffffffffu) ? 0 : (size_t)(en >> 1) * D; }
        const bf16_t* A = H1 + g.c; const bf16_t* B = WguT + ((size_t)e * 512 + nt * 128) * D + g.c;
        f32x4 acc[4][4];
        gemm_mainloop<false>(acc, A + ro[0], A + ro[1], A + ro[2], A + ro[3],
                             B + (size_t)g.r[0] * D, B + (size_t)g.r[1] * D, B + (size_t)g.r[2] * D, B + (size_t)g.r[3] * D, 16, c.lds, 0, 0.f);
#pragma unroll
        for (int m = 0; m < 4; ++m) { const size_t row = (size_t)rt * 128 + wr * 64 + m * 16 + fr;
#pragma unroll
            for (int i = 0; i < 2; ++i) {
                const f32x4 gt = acc[m][2 * i], up = acc[m][2 * i + 1]; f32x4 o;
#pragma unroll
                for (int j = 0; j < 4; ++j) o[j] = gt[j] * sigmoidf_(gt[j]) * up[j];
                st_bf4(ACT + row * DE + nt * 64 + wc * 32 + i * 16 + fq * 4, o);
            } }
    }
}
DEV void phase6b(const Ctx& c) {
    const bf16_t* ACT = (const bf16_t*)(c.ws + WS_ACT); const bf16_t* WdT = (const bf16_t*)(c.ws + WS_WD); bf16_t* Y = (bf16_t*)(c.ws + WS_Y);
    const unsigned* cnt = (const unsigned*)(c.ws + WS_CTL) + CW_CNT; const unsigned* list = (const unsigned*)(c.ws + WS_LIST); const float* combw = (const float*)(c.ws + WS_COMBW);
    moe_tiles(c);
    const int* ts = (const int*)(c.lds + EXP_OFF); unsigned* tbl = (unsigned*)(c.lds + TBL_OFF);
    const StageGeo g = stage_geo(c.tid);
    const int lane = c.lane, wr = c.wid >> 1, wc = c.wid & 1, fr = lane & 15, fq = lane >> 4;
    const int NU = ts[NE] * 8;
    for (int u = c.vcu; u < NU; u += c.G) {
        const int rt = u >> 3, nt = u & 7; const int e = moe_find(ts, rt);
        const int j0 = (rt - ts[e]) * 128; const int ne = (int)cnt[e * CNT_STRIDE];
        __syncthreads();
        if (c.tid < 128) { const int j = j0 + c.tid; tbl[c.tid] = (j < ne) ? list[(size_t)e * TR + j] : 0xffffffffu; }
        const bf16_t* A = ACT + (size_t)(rt * 128) * DE + g.c; const bf16_t* B = WdT + ((size_t)e * 1024 + nt * 128) * DE + g.c;
        f32x4 acc[4][4];
        gemm_mainloop<false>(acc, A + (size_t)g.r[0] * DE, A + (size_t)g.r[1] * DE, A + (size_t)g.r[2] * DE, A + (size_t)g.r[3] * DE,
                             B + (size_t)g.r[0] * DE, B + (size_t)g.r[1] * DE, B + (size_t)g.r[2] * DE, B + (size_t)g.r[3] * DE, 4, c.lds, 0, 0.f);
#pragma unroll
        for (int m = 0; m < 4; ++m) {
            const unsigned en = tbl[wr * 64 + m * 16 + fr];
            if (en != 0xffffffffu) {
                const float w = combw[en]; bf16_t* dst = Y + ((size_t)(en & 1u) * TR + (en >> 1)) * D + nt * 128 + wc * 64 + fq * 4;
#pragma unroll
                for (int n = 0; n < 4; ++n) st_bf4(dst + n * 16, acc[m][n] * w);
            }
        }
    }
}

DEV void phase7(const Ctx& c) {
    const bf16_t* H1 = (const bf16_t*)(c.ws + WS_H0); const bf16_t* Y = (const bf16_t*)(c.ws + WS_Y);
    const float* g = c.in[I_LN2G]; const float* bt = c.in[I_LN2B];
    const int gw = c.vcu * 4 + c.wid, NGW = c.G * 4, lane = c.lane;
    for (int tok0 = gw; tok0 < TR; tok0 += 2 * NGW) {
        float v[2][16]; float st[2]; int tk[2];
#pragma unroll
        for (int r = 0; r < 2; ++r) {
            int tok = tok0 + r * NGW; if (tok >= TR) tok = tok0; tk[r] = tok;
#pragma unroll
            for (int i = 0; i < 2; ++i) {
                const u32x4 hw = *(const u32x4*)(H1 + (size_t)tok * D + i * 512 + lane * 8);
                const u32x4 y0 = *(const u32x4*)(Y + (size_t)tok * D + i * 512 + lane * 8);
                const u32x4 y1 = *(const u32x4*)(Y + ((size_t)TR + tok) * D + i * 512 + lane * 8);
#pragma unroll
                for (int q = 0; q < 4; ++q) {
                    v[r][i * 8 + 2 * q]     = ALPHA * bflo(hw[q]) + (bflo(y0[q]) + bflo(y1[q]));
                    v[r][i * 8 + 2 * q + 1] = ALPHA * bfhi(hw[q]) + (bfhi(y0[q]) + bfhi(y1[q]));
                }
            }
        }
#pragma unroll
        for (int r = 0; r < 2; ++r) { float a = 0.f;
#pragma unroll
            for (int q = 0; q < 16; ++q) a += v[r][q];
            st[r] = a; }
        wave_sum_n<2>(st);
#pragma unroll
        for (int r = 0; r < 2; ++r) { const float mean = st[r] * (1.f / 1024.f); float a = 0.f;
#pragma unroll
            for (int q = 0; q < 16; ++q) { v[r][q] -= mean; a += v[r][q] * v[r][q]; }
            st[r] = a; }
        wave_sum_n<2>(st);
#pragma unroll
        for (int i = 0; i < 2; ++i)
#pragma unroll
            for (int q = 0; q < 2; ++q) {
                const int col = i * 512 + lane * 8 + q * 4;
                const f32x4 gg = *(const f32x4*)(g + col), bb = *(const f32x4*)(bt + col);
#pragma unroll
                for (int r = 0; r < 2; ++r) {
                    if (r == 1 && tok0 + NGW >= TR) continue;
                    const float rstd = 1.f / sqrtf(st[r] * (1.f / 1024.f) + EPS);
                    f32x4 o; o[0] = v[r][i * 8 + q * 4] * rstd * gg[0] + bb[0]; o[1] = v[r][i * 8 + q * 4 + 1] * rstd * gg[1] + bb[1];
                    o[2] = v[r][i * 8 + q * 4 + 2] * rstd * gg[2] + bb[2]; o[3] = v[r][i * 8 + q * 4 + 3] * rstd * gg[3] + bb[3];
                    *(f32x4*)(c.out + (size_t)tk[r] * D + col) = o;
                }
            }
    }
}

__global__ void __launch_bounds__(256, 2) fwd_kernel(Args a) {
    extern __shared__ __attribute__((aligned(16))) unsigned char lds[];
    Ctx c; c.in = a.in; c.out = a.out; c.ws = a.ws; c.lds = lds;
    c.tid = threadIdx.x; c.lane = c.tid & 63; c.wid = __builtin_amdgcn_readfirstlane(c.tid >> 6);
    c.G = gridDim.x; { const int bx = blockIdx.x; c.vcu = (c.G % 8 == 0) ? (bx % 8) * (c.G / 8) + bx / 8 : bx; }
    if (c.tid < 64) ((unsigned*)(lds + MISC_OFF))[c.tid] = 0u;
    __syncthreads();
    unsigned* ctl = (unsigned*)(a.ws + WS_CTL);
    XcdBarrier bar = xcd_barrier_post(ctl + CW_BAR, (volatile LAS unsigned*)(lds + MISC_OFF));
#ifdef ONLY_PH
#define PH_ON(k) ((k) == ONLY_PH)
#else
#define PH_ON(k) 1
#endif
    const int lo = a.ph_lo, hi = a.ph_hi;
#define RUN_PHASE(k, fn) if (PH_ON(k) && lo <= (k) && (k) < hi) { \
        for (int _rep = 0; _rep < ((REPEAT_PH == (k)) ? 2 : 1); ++_rep) { \
            int _t = threadIdx.x; asm volatile("" : "+v"(_t)); c.tid = _t; c.lane = _t & 63; c.wid = __builtin_amdgcn_readfirstlane(_t >> 6); \
            if ((k) == 5) phase5(c, _rep); else fn(c); \
            if (_rep == 0 && REPEAT_PH == (k)) xcd_barrier(bar); } \
        if ((k) + 1 < hi) xcd_barrier(bar); }
    RUN_PHASE(0, phase0)
    RUN_PHASE(1, phase1)
    RUN_PHASE(2, phase2)
    RUN_PHASE(3, phase3)
    RUN_PHASE(4, phase4)
    RUN_PHASE(5, phase0)
    RUN_PHASE(6, phase6a)
    RUN_PHASE(7, phase6b)
    RUN_PHASE(8, phase7)
}

extern "C" void kernel_launch(void* const* d_in, const int* in_sizes, int n_in, void* d_out, int out_size, void* d_ws, size_t ws_size, hipStream_t stream) {
    static int grid = 0;
    if (grid == 0) {
        if (n_in != 27 || in_sizes[0] != NB * SEQ * D || out_size != TR * D || ws_size < WS_END) {
            fprintf(stderr, "kernel_launch: shape mismatch n_in %d in0 %d out %d ws %zu\n", n_in, n_in > 0 ? in_sizes[0] : -1, out_size, ws_size); grid = -1; return; }
        int dev = 0, cus = 0, per_cu = 0;
        if (hipGetDevice(&dev) != hipSuccess || hipDeviceGetAttribute(&cus, hipDeviceAttributeMultiprocessorCount, dev) != hipSuccess) { grid = -1; return; }
        if (hipFuncSetAttribute((const void*)fwd_kernel, hipFuncAttributeMaxDynamicSharedMemorySize, LDS_BYTES) != hipSuccess) { grid = -1; return; }
        if (hipOccupancyMaxActiveBlocksPerMultiprocessor(&per_cu, (const void*)fwd_kernel, 256, LDS_BYTES) != hipSuccess || per_cu < 1) per_cu = 1;
        (void)hipGetLastError();
        if (per_cu > 2) per_cu = 2;
        grid = cus * per_cu;
        fprintf(stderr, "kernel_launch: grid %d (%d per CU)\n", grid, per_cu);
    }
    if (grid < 0) return;
    (void)hipMemsetAsync((char*)d_ws + WS_CTL, 0, CTL_ZERO_BYTES, stream);
    Args a{};
    for (int i = 0; i < 27; ++i) a.in[i] = (const float*)d_in[i];
    a.out = (float*)d_out; a.ws = (unsigned char*)d_ws;
    if (MK_N_LAUNCHES == 1) {
        a.ph_lo = 0; a.ph_hi = NPH;
        hipLaunchKernelGGL(fwd_kernel, dim3(grid), dim3(256), LDS_BYTES, stream, a);
    } else {
        for (int ph = 0; ph < NPH; ++ph) { a.ph_lo = ph; a.ph_hi = ph + 1; hipLaunchKernelGGL(fwd_kernel, dim3(grid), dim3(256), LDS_BYTES, stream, a); }
    }
}
```

```cpp
#include <hip/hip_runtime.h>
#include <cstdio>
#include <cstdint>

#ifndef REPEAT_PH
#define REPEAT_PH -1
#endif
#ifndef MK_N_LAUNCHES
#define MK_N_LAUNCHES 1
#endif

#define DEV __device__ __forceinline__
#define LAS __attribute__((address_space(3)))
#define GAS __attribute__((address_space(1)))
typedef unsigned short bf16_t;
typedef short bf16x8 __attribute__((ext_vector_type(8)));
typedef short s16x4 __attribute__((ext_vector_type(4)));
typedef float f32x4 __attribute__((ext_vector_type(4)));
typedef float f32x16 __attribute__((ext_vector_type(16)));
typedef unsigned u32x4 __attribute__((ext_vector_type(4)));
typedef unsigned u32x2 __attribute__((ext_vector_type(2)));
typedef long i64x2 __attribute__((ext_vector_type(2)));

constexpr int NB = 16, SEQ = 2048, NMETA = 16, L = SEQ + NMETA;
constexpr int T = NB * L;
constexpr int TR = NB * SEQ;
constexpr int D = 1024, NIN = 1696, CC = 512, QL = 384, KVL = 256, NH = 8, DQK = 96, DV = 64;
constexpr int NQ = NH * DQK;
constexpr int NKV = NH * (64 + DV);
constexpr int NE = 32, DE = 256, CONVK = 31;
constexpr float EPS = 1e-5f;
constexpr float ALPHA = 1.189207115002721f;
constexpr float QSCALE = 0.10206207261596577f * 1.4426950408889634f;
constexpr int NPH = 9;
constexpr float WSCALE = 16.f, WUNSCALE = 1.f / 16.f;

constexpr size_t MiB = 1u << 20;
constexpr size_t WS_CTL = 0, CTL_ZERO_BYTES = 64 * 1024;
constexpr int CW_CNT = 1024, CNT_STRIDE = 64;
constexpr int CW_BAR = 4096;
constexpr size_t WS_LIST = 1 * MiB;
constexpr size_t WS_COMBW = 5 * MiB;
constexpr size_t WS_ROPE = 5 * MiB + 512 * 1024;
constexpr size_t WS_WIN = 6 * MiB;
constexpr size_t WS_WUQ = 10 * MiB;
constexpr size_t WS_WUKV = 11 * MiB;
constexpr size_t WS_WO = 12 * MiB;
constexpr size_t WS_WR = 14 * MiB;
constexpr size_t WS_WGU = 16 * MiB;
constexpr size_t WS_WD = 48 * MiB;
constexpr size_t WS_H1F8 = 130 * MiB;
constexpr size_t WS_H0 = 64 * MiB;
constexpr size_t WS_U = 130 * MiB;
constexpr size_t WS_CQ = 163 * MiB;
constexpr size_t WS_CKV = 188 * MiB;
constexpr size_t WS_KR = 205 * MiB;
constexpr size_t WS_Q = 208 * MiB;
constexpr size_t WS_KV = 257 * MiB;
constexpr size_t WS_R1 = 208 * MiB;
constexpr size_t WS_Y = 208 * MiB;
constexpr size_t WS_MG = 336 * MiB;
constexpr size_t WS_ACT = 336 * MiB;
constexpr size_t WS_DUMMY = 400 * MiB;
constexpr size_t WS_END = 401 * MiB;

constexpr int LDS_BYTES = 73728;
constexpr int MISC_OFF = LDS_BYTES - 256;
constexpr int RS_OFF = 65536;
constexpr int TBL_OFF = 66048;
constexpr int EXP_OFF = 66560;

DEV unsigned cvtpk(float lo, float hi) { unsigned r; asm("v_cvt_pk_bf16_f32 %0, %1, %2" : "=v"(r) : "v"(lo), "v"(hi)); return r; }
DEV float bflo(unsigned w) { return __uint_as_float(w << 16); }
DEV float bfhi(unsigned w) { return __uint_as_float(w & 0xffff0000u); }
DEV float wave_sum(float v) {
#pragma unroll
    for (int o = 1; o < 64; o <<= 1) v += __shfl_xor(v, o);
    return v;
}
DEV void st_bf4(bf16_t* p, f32x4 v) { u32x2 w = {cvtpk(v[0], v[1]), cvtpk(v[2], v[3])}; *(u32x2*)p = w; }
DEV unsigned pk_fp8x4(float a, float b, float c, float d) {
    int w = __builtin_amdgcn_cvt_pk_fp8_f32(a, b, 0, false); w = __builtin_amdgcn_cvt_pk_fp8_f32(c, d, w, true); return (unsigned)w; }
DEV float fast_exp2(float x) { return __builtin_amdgcn_exp2f(x); }
DEV float fast_rcp(float x) { return __builtin_amdgcn_rcpf(x); }
DEV float sigmoidf_(float g) { return fast_rcp(1.f + fast_exp2(-1.4426950408889634f * g)); }
#define LDS_WAIT() asm volatile("s_waitcnt lgkmcnt(0)" ::: "memory")
#define VM_WAIT() asm volatile("s_waitcnt vmcnt(0)" ::: "memory")

#define XB_TMO      128
#define XB_XCNT(j)  (256  + 64 * (j))
#define XB_XSUB(j)  (1280 + 64 * (j))
#define XB_XGEN(j)  (2304 + 64 * (j))
#define XB_TOP      3328
#define XB_TOPGEN   3392
#define XCD_BAR_WORDS 3456
#define XB_SPIN_CAP (1u << 22)
DEV unsigned xb_ld(unsigned* p)              { return __hip_atomic_load(p, __ATOMIC_RELAXED, __HIP_MEMORY_SCOPE_AGENT); }
DEV unsigned xb_add(unsigned* p, unsigned v) { return __hip_atomic_fetch_add(p, v, __ATOMIC_RELAXED, __HIP_MEMORY_SCOPE_AGENT); }
DEV unsigned xb_xcc_id() { return (unsigned)__builtin_amdgcn_s_getreg((3 << 11) | 20) & 0xFu; }
#define XB_SPIN(cond, bar) do { unsigned _sp = 0; while (cond) { __builtin_amdgcn_s_sleep(1); \
    if ((++_sp & 255u) == 0u) { if (xb_ld(&(bar)[XB_TMO])) break; if (_sp > XB_SPIN_CAP) { atomicAdd(&(bar)[XB_TMO], 1u); break; } } } } while (0)
struct XcdBarrier { unsigned* bar; unsigned x; volatile LAS unsigned* st; };
DEV XcdBarrier xcd_barrier_post(unsigned* bar, volatile LAS unsigned* st) {
    XcdBarrier b; b.bar = bar; b.x = xb_xcc_id(); b.st = st;
    if (threadIdx.x == 0) (void)xb_add(&bar[XB_XCNT(b.x)], 1u);
    return b;
}
DEV void xcd_barrier_complete(unsigned* bar, unsigned x, unsigned& nloc, unsigned& nx) {
    const unsigned G = gridDim.x * gridDim.y * gridDim.z;
    unsigned sum, cnt, mine, sp = 0u;
    for (;;) {
        sum = 0u; cnt = 0u; mine = 0u;
#pragma unroll
        for (unsigned j = 0; j < 16; ++j) { const unsigned c = xb_ld(&bar[XB_XCNT(j)]); sum += c; cnt += (c > 0u) ? 1u : 0u; mine = (j == x) ? c : mine; }
        if (sum == G) break;
        __builtin_amdgcn_s_sleep(1);
        if ((++sp & 255u) == 0u) { if (xb_ld(&bar[XB_TMO])) break; if (sp > XB_SPIN_CAP) { atomicAdd(&bar[XB_TMO], 1u); break; } }
    }
    nloc = mine > 0u ? mine : 1u; nx = cnt > 0u ? cnt : 1u;
}
DEV void xcd_barrier(const XcdBarrier& b) {
    asm volatile("s_waitcnt vmcnt(0)" ::: "memory");
    __syncthreads();
    if (threadIdx.x == 0) {
        unsigned* bar = b.bar;
        __builtin_amdgcn_s_waitcnt(0);
        unsigned nloc = b.st[0], nx = b.st[1];
        if (nloc == 0u) { xcd_barrier_complete(bar, b.x, nloc, nx); b.st[0] = nloc; b.st[1] = nx; }
        const unsigned old = xb_add(&bar[XB_XSUB(b.x)], 1u);
        const unsigned gen = old / nloc;
        if (old + 1u == (gen + 1u) * nloc) {
            __builtin_amdgcn_fence(__ATOMIC_RELEASE, "agent");
            asm volatile("s_waitcnt vmcnt(0)" ::: "memory");
            const unsigned og = xb_add(&bar[XB_TOP], 1u);
            const unsigned tg = og / nx;
            if (og + 1u == (tg + 1u) * nx) xb_add(&bar[XB_TOPGEN], 1u);
            else XB_SPIN(xb_ld(&bar[XB_TOPGEN]) == tg, bar);
            __builtin_amdgcn_fence(__ATOMIC_ACQUIRE, "agent");
            xb_add(&bar[XB_XGEN(b.x)], 1u);
            asm volatile("s_waitcnt vmcnt(0)" ::: "memory");
        } else {
            XB_SPIN(xb_ld(&bar[XB_XGEN(b.x)]) == gen, bar);
            __builtin_amdgcn_fence(__ATOMIC_ACQUIRE, "agent");
            asm volatile("s_waitcnt vmcnt(0)" ::: "memory");
        }
    }
    __syncthreads();
}

struct Args { const float* in[27]; float* out; unsigned char* ws; int ph_lo, ph_hi; };
struct Ctx {
    const float* const* in; float* out; unsigned char* ws; unsigned char* lds;
    int tid, lane, wid, vcu, G;
};
enum { I_X = 0, I_META, I_LNIN_G, I_LNIN_B, I_WIN, I_CONVW, I_CONVB, I_CLN_G, I_CLN_B, I_QNG, I_WUQ, I_KVNG, I_WUKV, I_COUT_G, I_AOUT_G, I_WO,
       I_LN1G, I_LN1B, I_WRG, I_BRG, I_WRE, I_BRE, I_WGATE, I_WUP, I_WDOWN, I_LN2G, I_LN2B };

DEV int nmap(int mode, int n) {
    if (mode == 1) { if (n < 512) return ((n >> 4) << 5) + (n & 15); if (n < 1024) return (((n - 512) >> 4) << 5) + 16 + (n & 15); return n; }
    if (mode == 2) return ((n >> 4) << 5) + (n & 15);
    if (mode == 3) return ((n >> 4) << 5) + 16 + (n & 15);
    return n;
}
DEV void p0_transpose_item(const float* __restrict__ W, int N, int k0, int n0, const float* __restrict__ kscale, bf16_t* WT, int ldt, int kout0, int mode,
                           float* scr, int lane) {
#pragma unroll 8
    for (int i = 0; i < 32; ++i) {
        const int kk = 2 * i + (lane >> 5);
        float v = W[(size_t)(k0 + kk) * N + n0 + (lane & 31)];
        if (kscale) v *= kscale[k0 + kk];
        scr[kk * 33 + (lane & 31)] = v;
    }
    LDS_WAIT(); asm volatile("" ::: "memory");
    const int c = lane & 7;
#pragma unroll
    for (int j = 0; j < 4; ++j) {
        const int n = (lane >> 3) + 8 * j; const float* s = scr + (8 * c) * 33 + n;
        u32x4 o; o.x = cvtpk(s[0 * 33], s[1 * 33]); o.y = cvtpk(s[2 * 33], s[3 * 33]); o.z = cvtpk(s[4 * 33], s[5 * 33]); o.w = cvtpk(s[6 * 33], s[7 * 33]);
        *(u32x4*)(WT + (size_t)nmap(mode, n0 + n) * ldt + kout0 + 8 * c) = o;
    }
    LDS_WAIT(); asm volatile("" ::: "memory");
}
DEV void p0_transpose_item_f8(const float* __restrict__ W, int N, int k0, int n0, float scale, unsigned char* W8, int ldt, int kout0, int mode, float* scr, int lane) {
#pragma unroll 8
    for (int i = 0; i < 32; ++i) { const int kk = 2 * i + (lane >> 5); scr[kk * 33 + (lane & 31)] = W[(size_t)(k0 + kk) * N + n0 + (lane & 31)] * scale; }
    LDS_WAIT(); asm volatile("" ::: "memory");
    const int c = lane & 7;
#pragma unroll
    for (int j = 0; j < 4; ++j) {
        const int n = (lane >> 3) + 8 * j; const float* sp = scr + (8 * c) * 33 + n;
        u32x2 o; o.x = pk_fp8x4(sp[0 * 33], sp[1 * 33], sp[2 * 33], sp[3 * 33]); o.y = pk_fp8x4(sp[4 * 33], sp[5 * 33], sp[6 * 33], sp[7 * 33]);
        *(u32x2*)(W8 + (size_t)nmap(mode, n0 + n) * ldt + kout0 + 8 * c) = o;
    }
    LDS_WAIT(); asm volatile("" ::: "memory");
}
template <int N> DEV void wave_sum_n(float (&v)[N]) {
#pragma unroll
    for (int o = 1; o < 64; o <<= 1) {
#pragma unroll
        for (int i = 0; i < N; ++i) v[i] += __shfl_xor(v[i], o);
    }
}
template <int NR, bool F8 = false> DEV void ln_rows_bf16(const float* const (&xrow)[NR], const float* g, const float* bta, bf16_t* const (&orow)[NR], unsigned char* const (&ldsrow)[NR], int lane, unsigned char* const* f8row = nullptr) {
    f32x4 v[NR][4]; float s[NR];
#pragma unroll
    for (int r = 0; r < NR; ++r)
#pragma unroll
        for (int j = 0; j < 4; ++j) v[r][j] = ((const f32x4*)xrow[r])[64 * j + lane];
#pragma unroll
    for (int r = 0; r < NR; ++r) { s[r] = 0.f;
#pragma unroll
        for (int j = 0; j < 4; ++j) s[r] += (v[r][j].x + v[r][j].y) + (v[r][j].z + v[r][j].w); }
    wave_sum_n<NR>(s);
    float s2[NR];
#pragma unroll
    for (int r = 0; r < NR; ++r) { const float mean = s[r] * (1.f / 1024.f); s2[r] = 0.f;
#pragma unroll
        for (int j = 0; j < 4; ++j) { v[r][j] = v[r][j] - mean; s2[r] += (v[r][j].x * v[r][j].x + v[r][j].y * v[r][j].y) + (v[r][j].z * v[r][j].z + v[r][j].w * v[r][j].w); } }
    wave_sum_n<NR>(s2);
#pragma unroll
    for (int j = 0; j < 4; ++j) {
        const f32x4 gg = ((const f32x4*)g)[64 * j + lane], bb = ((const f32x4*)bta)[64 * j + lane];
#pragma unroll
        for (int r = 0; r < NR; ++r) {
            const float rstd = 1.f / sqrtf(s2[r] * (1.f / 1024.f) + EPS);
            const f32x4 o = v[r][j] * rstd * gg + bb;
            const u32x2 w = {cvtpk(o.x, o.y), cvtpk(o.z, o.w)};
            ((u32x2*)orow[r])[64 * j + lane] = w;
            if (ldsrow[r]) ((u32x2*)ldsrow[r])[64 * j + lane] = w;
            if (F8) ((unsigned*)f8row[r])[64 * j + lane] = pk_fp8x4(o.x, o.y, o.z, o.w);
        }
    }
}
__device__ const float INVF[16] = {1.0f, 0.5623413251903491f, 0.31622776601683794f, 0.1778279410038923f, 0.1f, 0.05623413251903491f, 0.031622776601683794f,
    0.01778279410038923f, 0.01f, 0.005623413251903491f, 0.0031622776601683794f, 0.001778279410038923f, 0.001f, 0.0005623413251903491f, 0.00031622776601683794f, 0.0001778279410038923f};
DEV void sincos_d(double a, float& sn, float& cs) {
    const double TWO_PI = 6.283185307179586476925286766559;
    const double k = __builtin_rint(a / TWO_PI);
    const double r = a - k * TWO_PI;
    const double r2 = r * r;
    double st = r, ct = 1.0, ssum = r, csum = 1.0;
#pragma unroll 1
    for (int i = 1; i <= 14; ++i) {
        ct = -ct * r2 / (double)((2 * i - 1) * (2 * i));  csum += ct;
        st = -st * r2 / (double)((2 * i) * (2 * i + 1));  ssum += st;
    }
    sn = (float)ssum; cs = (float)csum;
}
DEV void phase0(const Ctx& c) {
    float* scr = (float*)(c.lds + c.wid * 8448);
    const int gw = c.vcu * 4 + c.wid, NGW = c.G * 4;
    constexpr int I_IN = 16 * 53, I_UQ = 6 * 24, I_UKV = 4 * 32, I_O = 16 * 32, I_G = 32 * 128, I_U = I_G, I_D = 32 * 128;
    constexpr int NITEMS = I_IN + I_UQ + I_UKV + I_O + I_G + I_U + I_D;
    bf16_t* WinT = (bf16_t*)(c.ws + WS_WIN); bf16_t* WuqT = (bf16_t*)(c.ws + WS_WUQ); bf16_t* WukvT = (bf16_t*)(c.ws + WS_WUKV);
    bf16_t* WoT = (bf16_t*)(c.ws + WS_WO); unsigned char* Wgu8 = c.ws + WS_WGU; unsigned char* Wd8 = c.ws + WS_WD;
    for (int it = gw; it < NITEMS; it += NGW) {
        int r = it;
        if (r < I_IN) { const int kb = r / 53, nb = r % 53; p0_transpose_item(c.in[I_WIN], NIN, 64 * kb, 32 * nb, nullptr, WinT, 1024, 64 * kb, 1, scr, c.lane); continue; } r -= I_IN;
        if (r < I_UQ) { const int kb = r / 24, nb = r % 24; p0_transpose_item(c.in[I_WUQ], NQ, 64 * kb, 32 * nb, c.in[I_QNG], WuqT, QL, 64 * kb, 0, scr, c.lane); continue; } r -= I_UQ;
        if (r < I_UKV) { const int kb = r / 32, nb = r % 32; p0_transpose_item(c.in[I_WUKV], NKV, 64 * kb, 32 * nb, c.in[I_KVNG], WukvT, KVL, 64 * kb, 0, scr, c.lane); continue; } r -= I_UKV;
        if (r < I_O) { const int kb = r / 32, nb = r % 32;
            if (kb < 8) p0_transpose_item(c.in[I_WO], D, 64 * kb, 32 * nb, nullptr, WoT, 1024, 64 * kb + 512, 0, scr, c.lane);
            else        p0_transpose_item(c.in[I_WO], D, 64 * kb, 32 * nb, c.in[I_AOUT_G] - 512, WoT, 1024, 64 * kb - 512, 0, scr, c.lane);
            continue; } r -= I_O;
        if (r < I_G) { const int e = r >> 7, q = r & 127, kb = q >> 3, nb = q & 7;
            p0_transpose_item_f8(c.in[I_WGATE] + (size_t)e * D * DE, DE, 64 * kb, 32 * nb, WSCALE, Wgu8 + (size_t)e * 512 * 1024, 1024, 64 * kb, 2, scr, c.lane); continue; } r -= I_G;
        if (r < I_U) { const int e = r >> 7, q = r & 127, kb = q >> 3, nb = q & 7;
            p0_transpose_item_f8(c.in[I_WUP] + (size_t)e * D * DE, DE, 64 * kb, 32 * nb, WSCALE, Wgu8 + (size_t)e * 512 * 1024, 1024, 64 * kb, 3, scr, c.lane); continue; } r -= I_U;
        { const int e = r >> 7, q = r & 127, kb = q >> 5, nb = q & 31;
            p0_transpose_item_f8(c.in[I_WDOWN] + (size_t)e * DE * D, D, 64 * kb, 32 * nb, WSCALE, Wd8 + (size_t)e * 1024 * 256, 256, 64 * kb, 0, scr, c.lane); }
    }
    const int gt = c.vcu * 256 + c.tid, NGT = c.G * 256;
    bf16_t* WrT = (bf16_t*)(c.ws + WS_WR);
    for (int i = gt; i < 48 * 1024; i += NGT) {
        const int n = i >> 10, k = i & 1023; float v = 0.f;
        if (n < 4) v = c.in[I_WRG][k * 4 + n]; else if (n < 36) v = c.in[I_WRE][k * 32 + (n - 4)];
        WrT[i] = (bf16_t)(cvtpk(v, 0.f) & 0xffffu);
    }
    float* rc = (float*)(c.ws + WS_ROPE); float* rs = rc + L * 16;
    for (int i = gt; i < L * 16; i += NGT) {
        const int p = i >> 4, f = i & 15; const float ang = (float)p * INVF[f];
        float sn, cs; sincos_d((double)ang, sn, cs); rc[i] = cs; rs[i] = sn;
    }
    bf16_t* h0 = (bf16_t*)(c.ws + WS_H0);
    for (int t = gw; t < T; t += 2 * NGW) {
        const float* src[2]; bf16_t* dst[2]; unsigned char* ldsn[2] = {nullptr, nullptr};
#pragma unroll
        for (int r = 0; r < 2; ++r) { int tt = t + r * NGW; if (tt >= T) tt = t;
            const int b = tt / L, p = tt - b * L;
            src[r] = (p < NMETA) ? c.in[I_META] + (size_t)p * D : c.in[I_X] + ((size_t)b * SEQ + (p - NMETA)) * D;
            dst[r] = h0 + (size_t)tt * D; }
        ln_rows_bf16<2>(src, c.in[I_LNIN_G], c.in[I_LNIN_B], dst, ldsn, c.lane);
    }
}

struct StageGeo { int r[4]; int c; };
DEV StageGeo stage_geo(int tid) {
    const int lane = tid & 63, wid = tid >> 6; StageGeo g;
    const int f = ((wid & 1) << 2) | (lane >> 4);
#pragma unroll
    for (int i = 0; i < 4; ++i) g.r[i] = (wid + 4 * i) * 8 + (lane >> 3);
    g.c = ((lane & 7) ^ f) * 8;
    return g;
}
template <bool SSQ, bool FP8 = false>
DEV void gemm_mainloop(f32x4 (&acc)[4][4], const bf16_t* ap0, const bf16_t* ap1, const bf16_t* ap2, const bf16_t* ap3,
                       const bf16_t* bp0, const bf16_t* bp1, const bf16_t* bp2, const bf16_t* bp3,
                       int nk, unsigned char* lds, int ssq_steps, float ssq_inv_dim) {
    const int tid = threadIdx.x, lane = tid & 63, wid = tid >> 6, wr = wid >> 1, wc = wid & 1, fr = lane & 15, fq = lane >> 4;
    const int xs = (fr >> 1) & 7;
    const int lo0 = fr * 128 + ((fq ^ xs) << 4), lo1 = fr * 128 + (((fq ^ xs) ^ 4) << 4);
    const int a_off = wr * 8192, b_off = 16384 + wc * 8192;
    const int dst = tid * 16;
    float ssq = 0.f;
#pragma unroll
    for (int m = 0; m < 4; ++m)
#pragma unroll
        for (int n = 0; n < 4; ++n) acc[m][n] = (f32x4){0.f, 0.f, 0.f, 0.f};
    __syncthreads();
#define GLDS(src, off) __builtin_amdgcn_global_load_lds((const unsigned*)(src), (unsigned LAS*)(lds + (off)), 16, 0, 0)
#define STAGE(kt, b) do { const int _k = (kt) * 64; \
        GLDS(ap0 + _k, (b) * 32768 + dst);          GLDS(ap1 + _k, (b) * 32768 + dst + 4096); \
        GLDS(ap2 + _k, (b) * 32768 + dst + 8192);   GLDS(ap3 + _k, (b) * 32768 + dst + 12288); \
        GLDS(bp0 + _k, (b) * 32768 + 16384 + dst);  GLDS(bp1 + _k, (b) * 32768 + 16384 + dst + 4096); \
        GLDS(bp2 + _k, (b) * 32768 + 16384 + dst + 8192); GLDS(bp3 + _k, (b) * 32768 + 16384 + dst + 12288); } while (0)
    STAGE(0, 0);
    for (int kt = 0; kt < nk; ++kt) {
        VM_WAIT();
        __syncthreads();
        const int b = kt & 1;
        if (SSQ && kt == ssq_steps) {
            const float* rsl = (const float*)(lds + RS_OFF);
#pragma unroll
            for (int m = 0; m < 4; ++m) { const float r = rsl[wr * 64 + m * 16 + fr];
#pragma unroll
                for (int n = 0; n < 4; ++n) acc[m][n] = acc[m][n] * r; }
        }
        if (kt + 1 < nk) { if (b) STAGE(kt + 1, 0); else STAGE(kt + 1, 1); }
        const unsigned char* base = lds + b * 32768;
#pragma unroll
        for (int ks = 0; ks < 2; ++ks) {
            bf16x8 af[4], bf[4];
#pragma unroll
            for (int m = 0; m < 4; ++m) af[m] = *(const bf16x8*)(base + a_off + m * 2048 + (ks ? lo1 : lo0));
#pragma unroll
            for (int n = 0; n < 4; ++n) bf[n] = *(const bf16x8*)(base + b_off + n * 2048 + (ks ? lo1 : lo0));
            if (FP8) {
#pragma unroll
                for (int m = 0; m < 4; ++m) { const i64x2 a2 = __builtin_bit_cast(i64x2, af[m]);
#pragma unroll
                    for (int n = 0; n < 4; ++n) { const i64x2 b2 = __builtin_bit_cast(i64x2, bf[n]);
                        acc[m][n] = __builtin_amdgcn_mfma_f32_16x16x32_fp8_fp8(b2[0], a2[0], acc[m][n], 0, 0, 0);
                        acc[m][n] = __builtin_amdgcn_mfma_f32_16x16x32_fp8_fp8(b2[1], a2[1], acc[m][n], 0, 0, 0); } }
            } else {
#pragma unroll
            for (int m = 0; m < 4; ++m)
#pragma unroll
                for (int n = 0; n < 4; ++n) acc[m][n] = __builtin_amdgcn_mfma_f32_16x16x32_bf16(bf[n], af[m], acc[m][n], 0, 0, 0);
            }
        }
        if (SSQ && kt < ssq_steps) {
            const int row = tid >> 1, hf = tid & 1;
            const int rb = row * 128, sw = (row >> 1) & 7;
#pragma unroll
            for (int j = 0; j < 4; ++j) {
                const u32x4 w = *(const u32x4*)(base + rb + (((hf * 4 + j) ^ sw) << 4));
#pragma unroll
                for (int q = 0; q < 4; ++q) { const float a = bflo(w[q]), bb = bfhi(w[q]); ssq += a * a + bb * bb; }
            }
            if (kt == ssq_steps - 1) {
                const float tot = ssq + __shfl_xor(ssq, 1);
                if (hf == 0) ((float*)(lds + RS_OFF))[row] = 1.f / sqrtf(tot * ssq_inv_dim + EPS);
            }
        }
    }
    if (SSQ && ssq_steps == nk) {
        __syncthreads();
        const float* rsl = (const float*)(lds + RS_OFF);
#pragma unroll
        for (int m = 0; m < 4; ++m) { const float r = rsl[wr * 64 + m * 16 + fr];
#pragma unroll
            for (int n = 0; n < 4; ++n) acc[m][n] = acc[m][n] * r; }
    }
#undef STAGE
#undef GLDS
}

DEV void phase1(const Ctx& c) {
    const bf16_t* h0 = (const bf16_t*)(c.ws + WS_H0); const bf16_t* WinT = (const bf16_t*)(c.ws + WS_WIN);
    bf16_t* U = (bf16_t*)(c.ws + WS_U); bf16_t* CQ = (bf16_t*)(c.ws + WS_CQ); bf16_t* CKV = (bf16_t*)(c.ws + WS_CKV); bf16_t* KR = (bf16_t*)(c.ws + WS_KR);
    const float* rc = (const float*)(c.ws + WS_ROPE); const float* rs = rc + L * 16;
    const StageGeo g = stage_geo(c.tid);
    const int lane = c.lane, wr = c.wid >> 1, wc = c.wid & 1, fr = lane & 15, fq = lane >> 4;
    constexpr int NT = 14, NU = (T / 128) * NT;
    for (int u = c.vcu; u < NU; u += c.G) {
        const int mt = u / NT, nt = u - mt * NT;
        const bf16_t* A = h0 + (size_t)(mt * 128) * D + g.c; const bf16_t* B = WinT + (size_t)(nt * 128) * D + g.c;
        f32x4 acc[4][4];
        gemm_mainloop<false>(acc, A + (size_t)g.r[0] * D, A + (size_t)g.r[1] * D, A + (size_t)g.r[2] * D, A + (size_t)g.r[3] * D,
                             B + (size_t)g.r[0] * D, B + (size_t)g.r[1] * D, B + (size_t)g.r[2] * D, B + (size_t)g.r[3] * D, 16, c.lds, 0, 0.f);
        const int row0 = mt * 128 + wr * 64 + fr;
        if (nt < 8) {
#pragma unroll
            for (int m = 0; m < 4; ++m) { const size_t row = row0 + m * 16;
#pragma unroll
                for (int i = 0; i < 2; ++i) {
                    f32x4 a = acc[m][2 * i], gt = acc[m][2 * i + 1], o;
#pragma unroll
                    for (int j = 0; j < 4; ++j) o[j] = a[j] * sigmoidf_(gt[j]);
                    st_bf4(U + row * CC + nt * 64 + wc * 32 + i * 16 + fq * 4, o);
                } }
        } else if (nt < 11) {
#pragma unroll
            for (int m = 0; m < 4; ++m) { const size_t row = row0 + m * 16;
#pragma unroll
                for (int n = 0; n < 4; ++n) st_bf4(CQ + row * QL + (nt - 8) * 128 + wc * 64 + n * 16 + fq * 4, acc[m][n]); }
        } else if (nt < 13) {
#pragma unroll
            for (int m = 0; m < 4; ++m) { const size_t row = row0 + m * 16;
#pragma unroll
                for (int n = 0; n < 4; ++n) st_bf4(CKV + row * KVL + (nt - 11) * 128 + wc * 64 + n * 16 + fq * 4, acc[m][n]); }
        } else if (wc == 0) {
#pragma unroll
            for (int m = 0; m < 4; ++m) { const int row = row0 + m * 16; const int p = row % L;
                const f32x4 cs = *(const f32x4*)(rc + p * 16 + fq * 4), sn = *(const f32x4*)(rs + p * 16 + fq * 4);
                const f32x4 x1 = acc[m][0], x2 = acc[m][1];
                st_bf4(KR + (size_t)row * 32 + fq * 4, x1 * cs - x2 * sn);
                st_bf4(KR + (size_t)row * 32 + 16 + fq * 4, x1 * sn + x2 * cs); }
        }
    }
}

DEV void conv_unit(const Ctx& c, int b, int j) {
    const bf16_t* U = (const bf16_t*)(c.ws + WS_U);
    bf16_t* MG = (bf16_t*)(c.ws + WS_MG);
    const float* cw = c.in[I_CONVW]; const float* cb = c.in[I_CONVB];
    const int p0 = j * 32;
    float* ytile = (float*)c.lds;
    __syncthreads();
#pragma unroll 1
    for (int pass = 0; pass < 2; ++pass) {
        const int ch = c.tid + 256 * pass;
        float win[62]; unsigned raw[62];
        const bf16_t* ub = U + (size_t)b * L * CC + ch;
#pragma unroll
        for (int i = 0; i < 62; ++i) { const int p = p0 - 30 + i; const int pc = p < 0 ? 0 : (p >= L ? L - 1 : p); raw[i] = ub[(size_t)pc * CC]; }
        float w[31];
#pragma unroll
        for (int k = 0; k < 31; ++k) w[k] = cw[k * CC + ch];
        const float bias = cb[ch];
        __builtin_amdgcn_sched_barrier(0);
#pragma unroll
        for (int i = 0; i < 62; ++i) { const int p = p0 - 30 + i; win[i] = (p >= 0 && p < L) ? __uint_as_float(raw[i] << 16) : 0.f; }
#pragma unroll
        for (int tt = 0; tt < 32; ++tt) {
            float a0 = bias;
#pragma unroll
            for (int k = 0; k < 31; ++k) a0 += w[k] * win[tt + k];
            ytile[tt * 512 + ch] = a0;
        }
    }
    __syncthreads();
    const float* g1 = c.in[I_CLN_G]; const float* b1 = c.in[I_CLN_B]; const float* g2 = c.in[I_COUT_G];
    float G1[8], B1[8], G2[8];
    { const f32x4 a = *(const f32x4*)(g1 + c.lane * 8), bq = *(const f32x4*)(g1 + c.lane * 8 + 4); G1[0]=a.x;G1[1]=a.y;G1[2]=a.z;G1[3]=a.w;G1[4]=bq.x;G1[5]=bq.y;G1[6]=bq.z;G1[7]=bq.w; }
    { const f32x4 a = *(const f32x4*)(b1 + c.lane * 8), bq = *(const f32x4*)(b1 + c.lane * 8 + 4); B1[0]=a.x;B1[1]=a.y;B1[2]=a.z;B1[3]=a.w;B1[4]=bq.x;B1[5]=bq.y;B1[6]=bq.z;B1[7]=bq.w; }
    { const f32x4 a = *(const f32x4*)(g2 + c.lane * 8), bq = *(const f32x4*)(g2 + c.lane * 8 + 4); G2[0]=a.x;G2[1]=a.y;G2[2]=a.z;G2[3]=a.w;G2[4]=bq.x;G2[5]=bq.y;G2[6]=bq.z;G2[7]=bq.w; }
    float v[8][8]; float st[8];
#pragma unroll
    for (int i = 0; i < 8; ++i) { const int tt = c.wid * 8 + i;
        const f32x4 ya = *(const f32x4*)(ytile + tt * 512 + c.lane * 8), yb = *(const f32x4*)(ytile + tt * 512 + c.lane * 8 + 4);
        v[i][0]=ya.x;v[i][1]=ya.y;v[i][2]=ya.z;v[i][3]=ya.w;v[i][4]=yb.x;v[i][5]=yb.y;v[i][6]=yb.z;v[i][7]=yb.w;
        st[i] = ((v[i][0] + v[i][1]) + (v[i][2] + v[i][3])) + ((v[i][4] + v[i][5]) + (v[i][6] + v[i][7])); }
    wave_sum_n<8>(st);
#pragma unroll
    for (int i = 0; i < 8; ++i) { const float mean = st[i] * (1.f / 512.f); float a = 0.f;
#pragma unroll
        for (int q = 0; q < 8; ++q) { v[i][q] -= mean; a += v[i][q] * v[i][q]; }
        st[i] = a; }
    wave_sum_n<8>(st);
#pragma unroll
    for (int i = 0; i < 8; ++i) { const float rstd = 1.f / sqrtf(st[i] * (1.f / 512.f) + EPS); float a = 0.f;
#pragma unroll
        for (int q = 0; q < 8; ++q) { const float x = v[i][q] * rstd * G1[q] + B1[q]; const float y = x * sigmoidf_(x); v[i][q] = y; a += y * y; }
        st[i] = a; }
    wave_sum_n<8>(st);
#pragma unroll
    for (int i = 0; i < 8; ++i) {
        const int p = p0 + c.wid * 8 + i;
        {
            const float r2 = 1.f / sqrtf(st[i] * (1.f / 512.f) + EPS);
            u32x4 o;
            o.x = cvtpk(v[i][0] * r2 * G2[0], v[i][1] * r2 * G2[1]); o.y = cvtpk(v[i][2] * r2 * G2[2], v[i][3] * r2 * G2[3]);
            o.z = cvtpk(v[i][4] * r2 * G2[4], v[i][5] * r2 * G2[5]); o.w = cvtpk(v[i][6] * r2 * G2[6], v[i][7] * r2 * G2[7]);
            const size_t tok = (size_t)b * SEQ + (p - NMETA);
            bf16_t* dstp = (p >= NMETA && p < L) ? MG + tok * D + 512 + c.lane * 8 : (bf16_t*)(c.ws + WS_DUMMY) + c.lane * 8;
            *(u32x4*)dstp = o;
        }
    }
}
DEV void rope4(f32x4& x1, f32x4& x2, const float* rc, const float* rs, int p, int fq) {
    const f32x4 cs = *(const f32x4*)(rc + p * 16 + fq * 4), sn = *(const f32x4*)(rs + p * 16 + fq * 4);
    const f32x4 a = x1 * cs - x2 * sn, bb = x1 * sn + x2 * cs; x1 = a; x2 = bb;
}
template <int SEL> DEV void phase2_t(const Ctx& c) {
    const bf16_t* CQ = (const bf16_t*)(c.ws + WS_CQ); const bf16_t* CKV = (const bf16_t*)(c.ws + WS_CKV);
    const bf16_t* WuqT = (const bf16_t*)(c.ws + WS_WUQ); const bf16_t* WukvT = (const bf16_t*)(c.ws + WS_WUKV);
    bf16_t* Q = (bf16_t*)(c.ws + WS_Q); bf16_t* KV = (bf16_t*)(c.ws + WS_KV);
    const float* rc = (const float*)(c.ws + WS_ROPE); const float* rs = rc + L * 16;
    const StageGeo g = stage_geo(c.tid);
    const int lane = c.lane, wr = c.wid >> 1, wc = c.wid & 1, fr = lane & 15, fq = lane >> 4;
    constexpr int MT = T / 128, NUQ = MT * 6, NUKV = MT * 8, NUC = NB * 65, NU = NUQ + NUKV + NUC;
    for (int u = c.vcu; u < NU; u += c.G) {
        if (SEL == 1 && u >= NUKV + NUQ) continue;
        if (SEL == 2 && u < NUKV + NUQ) continue;
        if (u < NUKV) {
            const int mt = u >> 3, nt = u & 7;
            const bf16_t* A = CKV + (size_t)(mt * 128) * KVL + g.c; const bf16_t* B = WukvT + (size_t)(nt * 128) * KVL + g.c;
            f32x4 acc[4][4];
            gemm_mainloop<true>(acc, A + (size_t)g.r[0] * KVL, A + (size_t)g.r[1] * KVL, A + (size_t)g.r[2] * KVL, A + (size_t)g.r[3] * KVL,
                                B + (size_t)g.r[0] * KVL, B + (size_t)g.r[1] * KVL, B + (size_t)g.r[2] * KVL, B + (size_t)g.r[3] * KVL, 4, c.lds, 4, 1.f / 256.f);
            const int row0 = mt * 128 + wr * 64 + fr;
#pragma unroll
            for (int m = 0; m < 4; ++m) { const size_t row = row0 + m * 16;
#pragma unroll
                for (int n = 0; n < 4; ++n) st_bf4(KV + row * NKV + nt * 128 + wc * 64 + n * 16 + fq * 4, acc[m][n]); }
        } else if (u < NUKV + NUQ) {
            const int v = u - NUKV, mt = v / 6, nt = v - mt * 6;
            const bf16_t* A = CQ + (size_t)(mt * 128) * QL + g.c; const bf16_t* B = WuqT + (size_t)(nt * 128) * QL + g.c;
            f32x4 acc[4][4];
            gemm_mainloop<true>(acc, A + (size_t)g.r[0] * QL, A + (size_t)g.r[1] * QL, A + (size_t)g.r[2] * QL, A + (size_t)g.r[3] * QL,
                                B + (size_t)g.r[0] * QL, B + (size_t)g.r[1] * QL, B + (size_t)g.r[2] * QL, B + (size_t)g.r[3] * QL, 6, c.lds, 6, 1.f / 384.f);
            const int row0 = mt * 128 + wr * 64 + fr;
            const int t16 = (nt * 8 + wc * 4) % 6;
#pragma unroll
            for (int m = 0; m < 4; ++m) { const int row = row0 + m * 16; const int p = row % L;
#pragma unroll
                for (int n = 0; n < 4; ++n) acc[m][n] = acc[m][n] * QSCALE;
                if (t16 == 4) rope4(acc[m][0], acc[m][1], rc, rs, p, fq);
                if (t16 == 2) rope4(acc[m][2], acc[m][3], rc, rs, p, fq);
#pragma unroll
                for (int n = 0; n < 4; ++n) st_bf4(Q + (size_t)row * NQ + nt * 128 + wc * 64 + n * 16 + fq * 4, acc[m][n]); }
        } else {
            const int v = u - NUKV - NUQ; conv_unit(c, v / 65, v % 65);
        }
    }
}

DEV void phase2(const Ctx& c) { phase2_t<0>(c); }
DEV void phase2g(const Ctx& c) { phase2_t<1>(c); }
DEV void phase2c(const Ctx& c) { phase2_t<2>(c); }
DEV int crow(int r, int hi) { return (r & 3) + 8 * (r >> 2) + 4 * hi; }
#define KSWZ(row, colB) ((row) * 256 + ((colB) ^ (((row) & 7) << 4)))
#define SBAR() __builtin_amdgcn_sched_barrier(0)
DEV int v_st(int k, int cc) { const int kk = (k & ~0xC) | ((k & 4) << 1) | ((k & 8) >> 1); return ((kk >> 3) * 4 + (cc >> 5)) * 512 + ((kk & 7) * 32 + (cc & 31)) * 2; }
DEV int v_rd_base(int lane) { return ((lane & 3) << 3) | (((lane >> 2) & 3) << 6) | (((lane >> 4) & 1) << 5) | (((lane >> 5) & 1) << 8); }
constexpr int v_rd_off(int d0, int ks, int half) { return d0 * 512 + ks * 4096 + half * 2048; }
template <int OFF> DEV s16x4 tr_read(int vb) { s16x4 r; asm volatile("ds_read_b64_tr_b16 %0, %1 offset:%2" : "=&v"(r) : "v"(vb), "i"(OFF) : "memory"); return r; }
template <int D0> DEV void pv_one(f32x16& od, int vb, bf16x8 pa0, bf16x8 pa1, bf16x8 pa2, bf16x8 pa3) {
    const s16x4 l0 = tr_read<v_rd_off(D0, 0, 0)>(vb), h0 = tr_read<v_rd_off(D0, 0, 1)>(vb), l1 = tr_read<v_rd_off(D0, 1, 0)>(vb), h1 = tr_read<v_rd_off(D0, 1, 1)>(vb);
    const s16x4 l2 = tr_read<v_rd_off(D0, 2, 0)>(vb), h2 = tr_read<v_rd_off(D0, 2, 1)>(vb), l3 = tr_read<v_rd_off(D0, 3, 0)>(vb), h3 = tr_read<v_rd_off(D0, 3, 1)>(vb);
    asm volatile("s_waitcnt lgkmcnt(0)" ::: "memory"); SBAR();
#define PK(Lo, Hi) (bf16x8){Lo[0], Lo[1], Lo[2], Lo[3], Hi[0], Hi[1], Hi[2], Hi[3]}
    od = __builtin_amdgcn_mfma_f32_32x32x16_bf16(pa0, PK(l0, h0), od, 0, 0, 0);
    od = __builtin_amdgcn_mfma_f32_32x32x16_bf16(pa1, PK(l1, h1), od, 0, 0, 0);
    od = __builtin_amdgcn_mfma_f32_32x32x16_bf16(pa2, PK(l2, h2), od, 0, 0, 0);
    od = __builtin_amdgcn_mfma_f32_32x32x16_bf16(pa3, PK(l3, h3), od, 0, 0, 0);
#undef PK
}
constexpr int AT_V = 0, AT_K = 32768, AT_WS = 65536;
DEV void attn_unit(const Ctx& c, int b, int h, int qb) {
    const bf16_t* Q = (const bf16_t*)(c.ws + WS_Q); const bf16_t* KV = (const bf16_t*)(c.ws + WS_KV); const bf16_t* KR = (const bf16_t*)(c.ws + WS_KR);
    bf16_t* MG = (bf16_t*)(c.ws + WS_MG);
    unsigned char* lds = c.lds;
    const int tid = c.tid, wid = c.wid, lane = c.lane, r32 = lane & 31, hi = lane >> 5;
    float* wsf = (float*)(lds + AT_WS) + wid * 64; float* li_l = wsf; float* al_l = wsf + 32;
    const int NT = 2 * qb + 3;
    const int my_last = 2 * qb + (wid >> 1) + 1;
    bf16x8 qr[6];
    { const size_t t = (size_t)b * L + NMETA + qb * 128 + wid * 32 + r32;
      const bf16_t* Qw = Q + t * NQ + h * DQK + hi * 8;
#pragma unroll
      for (int d0 = 0; d0 < 6; ++d0) qr[d0] = *(const bf16x8*)(Qw + d0 * 16); }
    const int srow = tid >> 2, sq = tid & 3;
    const int vst0 = v_st(srow, sq * 16), vst1 = v_st(srow, sq * 16 + 8);
    const int kst0 = KSWZ(srow, sq * 32), kst1 = KSWZ(srow, sq * 32 + 16), kst2 = KSWZ(srow, 128 + sq * 16);
    const int vb0 = (int)(uintptr_t)(lds + AT_V) + v_rd_base(lane);
    u32x4 sk0, sk1, sk2, sv0, sv1;
#define SLOAD(j) do { int pos = (j) * 64 + srow - 48; pos = pos < 0 ? 0 : pos; const size_t tk = (size_t)b * L + pos; \
        const bf16_t* kvp = KV + tk * NKV + h * 128 + sq * 16; \
        sk0 = *(const u32x4*)(kvp); sk1 = *(const u32x4*)(kvp + 8); sv0 = *(const u32x4*)(kvp + 64); sv1 = *(const u32x4*)(kvp + 72); \
        sk2 = *(const u32x4*)(KR + tk * 32 + sq * 8); } while (0)
#define SWRITE(bb) do { unsigned char* kb = lds + AT_K + (bb) * 16384; unsigned char* vbp = lds + AT_V + (bb) * 16384; \
        *(u32x4*)(kb + kst0) = sk0; *(u32x4*)(kb + kst1) = sk1; *(u32x4*)(kb + kst2) = sk2; *(u32x4*)(vbp + vst0) = sv0; *(u32x4*)(vbp + vst1) = sv1; } while (0)
    float m_reg = -1e30f, l_reg = 0.f; f32x16 o[2] = {};
    __syncthreads();
    SLOAD(0); SWRITE(0); __syncthreads();
    for (int j = 0; j < NT; ++j) {
        const int bsel = j & 1;
        if (j + 1 < NT) SLOAD(j + 1);
        if (j <= my_last) {
            const unsigned char* Ks = lds + AT_K + bsel * 16384;
            f32x16 p0 = {}, p1 = {};
#pragma unroll
            for (int d0 = 0; d0 < 6; ++d0) { const int cb = (d0 * 16 + hi * 8) * 2;
                const bf16x8 k0 = *(const bf16x8*)(Ks + KSWZ(r32, cb)); const bf16x8 k1 = *(const bf16x8*)(Ks + KSWZ(32 + r32, cb));
                p0 = __builtin_amdgcn_mfma_f32_32x32x16_bf16(k0, qr[d0], p0, 0, 0, 0);
                p1 = __builtin_amdgcn_mfma_f32_32x32x16_bf16(k1, qr[d0], p1, 0, 0, 0); }
            if (j == 0) {
#pragma unroll
                for (int r = 0; r < 16; ++r) p0[r] = -1e30f;
#pragma unroll
                for (int r = 0; r < 8; ++r) p1[r] = -1e30f;
            }
            float pmax = p0[0];
#pragma unroll
            for (int r = 1; r < 16; ++r) pmax = fmaxf(pmax, p0[r]);
#pragma unroll
            for (int r = 0; r < 16; ++r) pmax = fmaxf(pmax, p1[r]);
            { auto rr = __builtin_amdgcn_permlane32_swap(__float_as_uint(pmax), __float_as_uint(pmax), false, false);
              pmax = fmaxf(__uint_as_float(rr[0]), __uint_as_float(rr[1])); }
            const float mn = fmaxf(m_reg, pmax);
            const float alpha = fast_exp2(m_reg - mn); m_reg = mn;
            float ps = 0.f;
#pragma unroll
            for (int r = 0; r < 16; ++r) { p0[r] = fast_exp2(p0[r] - mn); ps += p0[r]; }
#pragma unroll
            for (int r = 0; r < 16; ++r) { p1[r] = fast_exp2(p1[r] - mn); ps += p1[r]; }
            { auto rr = __builtin_amdgcn_permlane32_swap(__float_as_uint(ps), __float_as_uint(ps), false, false);
              ps = __uint_as_float(rr[0]) + __uint_as_float(rr[1]); }
            l_reg = l_reg * alpha + ps;
            bf16x8 pa0, pa1, pa2, pa3;
#define PK4(P, BASE, OUT) do { unsigned a0 = cvtpk(P[BASE + 0], P[BASE + 1]), a1 = cvtpk(P[BASE + 2], P[BASE + 3]);   \
    unsigned b0 = cvtpk(P[BASE + 4], P[BASE + 5]), b1 = cvtpk(P[BASE + 6], P[BASE + 7]);                              \
    auto r0 = __builtin_amdgcn_permlane32_swap(a0, b0, false, false); auto r1 = __builtin_amdgcn_permlane32_swap(a1, b1, false, false); \
    u32x4 w = {r0[0], r1[0], r0[1], r1[1]}; OUT = *reinterpret_cast<bf16x8*>(&w); } while (0)
            PK4(p0, 0, pa0); PK4(p0, 8, pa1); PK4(p1, 0, pa2); PK4(p1, 8, pa3);
#undef PK4
            if (__any(alpha < 1.f)) {
                if (hi == 0) al_l[r32] = alpha;
                asm volatile("s_waitcnt lgkmcnt(0)" ::: "memory");
#pragma unroll
                for (int r = 0; r < 16; ++r) { const float a = al_l[crow(r, hi)]; o[0][r] *= a; o[1][r] *= a; }
            }
            const int vb = vb0 + bsel * 16384;
            pv_one<0>(o[0], vb, pa0, pa1, pa2, pa3); pv_one<1>(o[1], vb, pa0, pa1, pa2, pa3);
        }
        if (j + 1 < NT) { if (bsel) SWRITE(0); else SWRITE(1); }
        __syncthreads();
    }
    if (hi == 0) li_l[r32] = l_reg;
    asm volatile("s_waitcnt lgkmcnt(0)" ::: "memory");
    const size_t tok0 = (size_t)b * SEQ + qb * 128 + wid * 32;
#pragma unroll
    for (int r = 0; r < 16; ++r) {
        const int orow = crow(r, hi); const float rl = fast_rcp(li_l[orow]);
        bf16_t* dst = MG + (tok0 + orow) * D + h * DV + r32;
        dst[0]  = (bf16_t)(cvtpk(o[0][r] * rl, 0.f) & 0xffffu);
        dst[32] = (bf16_t)(cvtpk(o[1][r] * rl, 0.f) & 0xffffu);
    }
#undef SLOAD
#undef SWRITE
}
DEV void phase3(const Ctx& c) {
    const int nslots = NB * NH * 4;
    for (int v = c.vcu; v < nslots; v += c.G) {
        const int bh = v >> 2, s = v & 3, b = bh >> 3, h = bh & 7;
        attn_unit(c, b, h, 15 - s); attn_unit(c, b, h, s); attn_unit(c, b, h, 11 - s); attn_unit(c, b, h, 4 + s);
    }
}

DEV void phase4(const Ctx& c) {
    const bf16_t* MG = (const bf16_t*)(c.ws + WS_MG); const bf16_t* WoT = (const bf16_t*)(c.ws + WS_WO); const bf16_t* h0 = (const bf16_t*)(c.ws + WS_H0);
    float* R1 = (float*)(c.ws + WS_R1);
    const StageGeo g = stage_geo(c.tid);
    const int lane = c.lane, wr = c.wid >> 1, wc = c.wid & 1, fr = lane & 15, fq = lane >> 4;
    constexpr int NU = (TR / 128) * 8;
    for (int u = c.vcu; u < NU; u += c.G) {
        const int mt = u >> 3, nt = u & 7;
        const bf16_t* A = MG + (size_t)(mt * 128) * D + g.c; const bf16_t* B = WoT + (size_t)(nt * 128) * D + g.c;
        f32x4 acc[4][4];
        gemm_mainloop<true>(acc, A + (size_t)g.r[0] * D, A + (size_t)g.r[1] * D, A + (size_t)g.r[2] * D, A + (size_t)g.r[3] * D,
                            B + (size_t)g.r[0] * D, B + (size_t)g.r[1] * D, B + (size_t)g.r[2] * D, B + (size_t)g.r[3] * D, 16, c.lds, 8, 1.f / 512.f);
#pragma unroll
        for (int m = 0; m < 4; ++m) {
            const int tok = mt * 128 + wr * 64 + m * 16 + fr;
            const size_t t = (size_t)(tok >> 11) * L + NMETA + (tok & 2047);
#pragma unroll
            for (int n = 0; n < 4; ++n) {
                const int col = nt * 128 + wc * 64 + n * 16 + fq * 4;
                const u32x2 hw = *(const u32x2*)(h0 + t * D + col);
                f32x4 o; o[0] = ALPHA * bflo(hw.x) + acc[m][n][0]; o[1] = ALPHA * bfhi(hw.x) + acc[m][n][1];
                o[2] = ALPHA * bflo(hw.y) + acc[m][n][2]; o[3] = ALPHA * bfhi(hw.y) + acc[m][n][3];
                *(f32x4*)(R1 + (size_t)tok * D + col) = o;
            }
        }
    }
}

constexpr int P5_ROWB = 2064, P5_PART = 33280, P5_LG = 45568, P5_BIAS = 48128, P5_AGG = 48384;
DEV void phase5(const Ctx& c, int ALT = 0) {
    const float* R1 = (const float*)(c.ws + WS_R1); bf16_t* H1 = (bf16_t*)(c.ws + WS_H0);
    const bf16_t* WrT = (const bf16_t*)(c.ws + WS_WR);
    unsigned* cnt = (unsigned*)(c.ws + WS_CTL) + CW_CNT + ALT * 32; unsigned* list = (unsigned*)(c.ws + (ALT ? 404 * MiB : WS_LIST)); float* combw = (float*)(c.ws + WS_COMBW);
    const int lane = c.lane, wid = c.wid, fr = lane & 15, fq = lane >> 4;
    float* part = (float*)(c.lds + P5_PART); float* lgs = (float*)(c.lds + P5_LG); float* biasl = (float*)(c.lds + P5_BIAS);
    __syncthreads();
    if (c.tid < 36) biasl[c.tid] = (c.tid < 4) ? c.in[I_BRG][c.tid] : c.in[I_BRE][c.tid - 4];
    bf16x8 wf[8][3];
#pragma unroll
    for (int ks = 0; ks < 8; ++ks)
#pragma unroll
        for (int n = 0; n < 3; ++n) wf[ks][n] = *(const bf16x8*)(WrT + (size_t)(n * 16 + fr) * D + wid * 256 + ks * 32 + fq * 8);
    unsigned* lcnt = (unsigned*)(c.lds + P5_AGG); unsigned* lbase = lcnt + 32; unsigned* ent = lcnt + 64;
    if (c.tid < 32) lcnt[c.tid] = 0u;
    int nent = 0;
    for (int u = c.vcu; u < TR / 16; u += c.G) {
        const int tok0 = u * 16;
        { const float* src[4]; bf16_t* dst[4]; unsigned char* ldsn[4]; unsigned char* f8n[4];
#pragma unroll
          for (int i = 0; i < 4; ++i) { const int tl = wid * 4 + i; const size_t tok = tok0 + tl; src[i] = R1 + tok * D; dst[i] = H1 + tok * D; ldsn[i] = c.lds + tl * P5_ROWB; f8n[i] = c.ws + WS_H1F8 + tok * D; }
          ln_rows_bf16<4, true>(src, c.in[I_LN1G], c.in[I_LN1B], dst, ldsn, lane, f8n); }
        __syncthreads();
        f32x4 acc[3] = {};
#pragma unroll
        for (int ks = 0; ks < 8; ++ks) {
            const int k = wid * 256 + ks * 32 + fq * 8;
            const bf16x8 a = *(const bf16x8*)(c.lds + fr * P5_ROWB + k * 2);
#pragma unroll
            for (int n = 0; n < 3; ++n) acc[n] = __builtin_amdgcn_mfma_f32_16x16x32_bf16(wf[ks][n], a, acc[n], 0, 0, 0);
        }
#pragma unroll
        for (int n = 0; n < 3; ++n) *(f32x4*)(part + (wid * 16 + fr) * 48 + n * 16 + fq * 4) = acc[n];
        __syncthreads();
#pragma unroll
        for (int i = 0; i < 3; ++i) { const int idx = c.tid + 256 * i;
            if (idx < 576) { const int tk = idx / 36, l = idx - tk * 36;
                lgs[tk * 40 + l] = ((part[tk * 48 + l] + part[(16 + tk) * 48 + l]) + (part[(32 + tk) * 48 + l] + part[(48 + tk) * 48 + l])) + biasl[l]; } }
        __syncthreads();
        if (c.tid < 16) {
            const float* lg = lgs + c.tid * 40;
            int gi = 0; float gm = lg[0];
#pragma unroll
            for (int i = 1; i < 4; ++i) { const float v = lg[i]; if (v > gm) { gm = v; gi = i; } }
            float gs = 0.f;
#pragma unroll
            for (int i = 0; i < 4; ++i) gs += __expf(lg[i] - gm);
            const float gw = 1.f / gs;
            const float* le = lg + 4 + gi * 8;
            float v0 = le[0], v1 = -3.0e38f; int i0 = 0, i1 = 0;
#pragma unroll
            for (int i = 1; i < 8; ++i) { const float v = le[i];
                if (v > v0) { v1 = v0; i1 = i0; v0 = v; i0 = i; } else if (v > v1) { v1 = v; i1 = i; } }
            const float ex = __expf(v1 - v0), inv = 1.f / (1.f + ex);
            const int tok = tok0 + c.tid; const unsigned e0 = gi * 8 + i0, e1 = gi * 8 + i1;
            combw[tok * 2] = gw * inv; combw[tok * 2 + 1] = gw * ex * inv;
            const unsigned r0 = atomicAdd(&lcnt[e0], 1u), r1 = atomicAdd(&lcnt[e1], 1u);
            const int ei = nent * 32 + c.tid * 2;
            ent[2 * ei] = (unsigned)(tok * 2);         ent[2 * ei + 1] = (e0 << 16) | r0;
            ent[2 * ei + 2] = (unsigned)(tok * 2 + 1); ent[2 * ei + 3] = (e1 << 16) | r1;
        }
        ++nent;
    }
    __syncthreads();
    if (c.tid < 32) { const unsigned n = lcnt[c.tid]; lbase[c.tid] = n ? atomicAdd(&cnt[c.tid * CNT_STRIDE], n) : 0u; }
    __syncthreads();
    for (int i = c.tid; i < nent * 32; i += 256) { const unsigned t2 = ent[2 * i], er = ent[2 * i + 1]; const unsigned e = er >> 16;
        list[(size_t)e * TR + lbase[e] + (er & 0xffffu)] = t2; }
}
DEV void bar20(const Ctx& c) {}
DEV void moe_tiles(const Ctx& c) {
    const unsigned* cnt = (const unsigned*)(c.ws + WS_CTL) + CW_CNT; int* ts = (int*)(c.lds + EXP_OFF);
    __syncthreads();
    if (c.tid == 0) { int s = 0; for (int e = 0; e < NE; ++e) { ts[e] = s; s += (int)((__hip_atomic_load(&cnt[e * CNT_STRIDE], __ATOMIC_RELAXED, __HIP_MEMORY_SCOPE_AGENT) + 127u) >> 7); } ts[NE] = s; }
    __syncthreads();
}
DEV int moe_find(const int* ts, int rt) { int e = 0;
#pragma unroll 1
    for (int i = 1; i < NE; ++i) if (ts[i] <= rt) e = i;
    return e; }
DEV void phase6a(const Ctx& c) {
    const bf16_t* H18 = (const bf16_t*)(c.ws + WS_H1F8); const bf16_t* Wgu8 = (const bf16_t*)(c.ws + WS_WGU); unsigned char* ACT8 = c.ws + WS_ACT;
    const unsigned* cnt = (const unsigned*)(c.ws + WS_CTL) + CW_CNT; const unsigned* list = (const unsigned*)(c.ws + WS_LIST);
    moe_tiles(c);
    const int* ts = (const int*)(c.lds + EXP_OFF); unsigned* tbl = (unsigned*)(c.lds + TBL_OFF);
    const StageGeo g = stage_geo(c.tid);
    const int lane = c.lane, wr = c.wid >> 1, wc = c.wid & 1, fr = lane & 15, fq = lane >> 4;
    const int NU = ts[NE] * 4;
    for (int u = c.vcu; u < NU; u += c.G) {
        const int rt = u >> 2, nt = u & 3; const int e = moe_find(ts, rt);
        const int j0 = (rt - ts[e]) * 128; const int ne = (int)cnt[e * CNT_STRIDE];
        __syncthreads();
        if (c.tid < 128) { const int j = j0 + c.tid; tbl[c.tid] = (j < ne) ? list[(size_t)e * TR + j] : 0xffffffffu; }
        __syncthreads();
        size_t ro[4];
#pragma unroll
        for (int i = 0; i < 4; ++i) { const unsigned en = tbl[g.r[i]]; ro[i] = (en == 0xffffffffu) ? 0 : (size_t)(en >> 1) * (D / 2); }
        const bf16_t* A = H18 + g.c; const bf16_t* B = Wgu8 + ((size_t)e * 512 + nt * 128) * (D / 2) + g.c;
        f32x4 acc[4][4];
        gemm_mainloop<false, true>(acc, A + ro[0], A + ro[1], A + ro[2], A + ro[3],
                             B + (size_t)g.r[0] * (D / 2), B + (size_t)g.r[1] * (D / 2), B + (size_t)g.r[2] * (D / 2), B + (size_t)g.r[3] * (D / 2), 8, c.lds, 0, 0.f);
#pragma unroll
        for (int m = 0; m < 4; ++m) { const size_t row = (size_t)rt * 128 + wr * 64 + m * 16 + fr;
#pragma unroll
            for (int i = 0; i < 2; ++i) {
                const f32x4 gt = acc[m][2 * i], up = acc[m][2 * i + 1]; f32x4 o;
#pragma unroll
                for (int j = 0; j < 4; ++j) { const float gv = gt[j] * WUNSCALE; o[j] = gv * sigmoidf_(gv) * (up[j] * WUNSCALE); }
                *(unsigned*)(ACT8 + row * DE + nt * 64 + wc * 32 + i * 16 + fq * 4) = pk_fp8x4(o[0], o[1], o[2], o[3]);
            } }
    }
}
DEV void phase6b(const Ctx& c) {
    const bf16_t* ACT8 = (const bf16_t*)(c.ws + WS_ACT); const bf16_t* Wd8 = (const bf16_t*)(c.ws + WS_WD); bf16_t* Y = (bf16_t*)(c.ws + WS_Y);
    const unsigned* cnt = (const unsigned*)(c.ws + WS_CTL) + CW_CNT; const unsigned* list = (const unsigned*)(c.ws + WS_LIST); const float* combw = (const float*)(c.ws + WS_COMBW);
    moe_tiles(c);
    const int* ts = (const int*)(c.lds + EXP_OFF); unsigned* tbl = (unsigned*)(c.lds + TBL_OFF);
    const StageGeo g = stage_geo(c.tid);
    const int lane = c.lane, wr = c.wid >> 1, wc = c.wid & 1, fr = lane & 15, fq = lane >> 4;
    const int NU = ts[NE] * 8;
    for (int u = c.vcu; u < NU; u += c.G) {
        const int rt = u >> 3, nt = u & 7; const int e = moe_find(ts, rt);
        const int j0 = (rt - ts[e]) * 128; const int ne = (int)cnt[e * CNT_STRIDE];
        __syncthreads();
        if (c.tid < 128) { const int j = j0 + c.tid; tbl[c.tid] = (j < ne) ? list[(size_t)e * TR + j] : 0xffffffffu; }
        const bf16_t* A = ACT8 + (size_t)(rt * 128) * (DE / 2) + g.c; const bf16_t* B = Wd8 + ((size_t)e * 1024 + nt * 128) * (DE / 2) + g.c;
        f32x4 acc[4][4];
        gemm_mainloop<false, true>(acc, A + (size_t)g.r[0] * (DE / 2), A + (size_t)g.r[1] * (DE / 2), A + (size_t)g.r[2] * (DE / 2), A + (size_t)g.r[3] * (DE / 2),
                             B + (size_t)g.r[0] * (DE / 2), B + (size_t)g.r[1] * (DE / 2), B + (size_t)g.r[2] * (DE / 2), B + (size_t)g.r[3] * (DE / 2), 2, c.lds, 0, 0.f);
#pragma unroll
        for (int m = 0; m < 4; ++m) {
            const unsigned en = tbl[wr * 64 + m * 16 + fr];
            if (en != 0xffffffffu) {
                const float w = combw[en] * WUNSCALE; bf16_t* dst = Y + ((size_t)(en & 1u) * TR + (en >> 1)) * D + nt * 128 + wc * 64 + fq * 4;
#pragma unroll
                for (int n = 0; n < 4; ++n) st_bf4(dst + n * 16, acc[m][n] * w);
            }
        }
    }
}

DEV void phase7(const Ctx& c) {
    const bf16_t* H1 = (const bf16_t*)(c.ws + WS_H0); const bf16_t* Y = (const bf16_t*)(c.ws + WS_Y);
    const float* g = c.in[I_LN2G]; const float* bt = c.in[I_LN2B];
    const int gw = c.vcu * 4 + c.wid, NGW = c.G * 4, lane = c.lane;
    for (int tok0 = gw; tok0 < TR; tok0 += 2 * NGW) {
        float v[2][16]; float st[2]; int tk[2];
#pragma unroll
        for (int r = 0; r < 2; ++r) {
            int tok = tok0 + r * NGW; if (tok >= TR) tok = tok0; tk[r] = tok;
#pragma unroll
            for (int i = 0; i < 2; ++i) {
                const u32x4 hw = *(const u32x4*)(H1 + (size_t)tok * D + i * 512 + lane * 8);
                const u32x4 y0 = *(const u32x4*)(Y + (size_t)tok * D + i * 512 + lane * 8);
                const u32x4 y1 = *(const u32x4*)(Y + ((size_t)TR + tok) * D + i * 512 + lane * 8);
#pragma unroll
                for (int q = 0; q < 4; ++q) {
                    v[r][i * 8 + 2 * q]     = ALPHA * bflo(hw[q]) + (bflo(y0[q]) + bflo(y1[q]));
                    v[r][i * 8 + 2 * q + 1] = ALPHA * bfhi(hw[q]) + (bfhi(y0[q]) + bfhi(y1[q]));
                }
            }
        }
#pragma unroll
        for (int r = 0; r < 2; ++r) { float a = 0.f;
#pragma unroll
            for (int q = 0; q < 16; ++q) a += v[r][q];
            st[r] = a; }
        wave_sum_n<2>(st);
#pragma unroll
        for (int r = 0; r < 2; ++r) { const float mean = st[r] * (1.f / 1024.f); float a = 0.f;
#pragma unroll
            for (int q = 0; q < 16; ++q) { v[r][q] -= mean; a += v[r][q] * v[r][q]; }
            st[r] = a; }
        wave_sum_n<2>(st);
#pragma unroll
        for (int i = 0; i < 2; ++i)
#pragma unroll
            for (int q = 0; q < 2; ++q) {
                const int col = i * 512 + lane * 8 + q * 4;
                const f32x4 gg = *(const f32x4*)(g + col), bb = *(const f32x4*)(bt + col);
#pragma unroll
                for (int r = 0; r < 2; ++r) {
                    if (r == 1 && tok0 + NGW >= TR) continue;
                    const float rstd = 1.f / sqrtf(st[r] * (1.f / 1024.f) + EPS);
                    f32x4 o; o[0] = v[r][i * 8 + q * 4] * rstd * gg[0] + bb[0]; o[1] = v[r][i * 8 + q * 4 + 1] * rstd * gg[1] + bb[1];
                    o[2] = v[r][i * 8 + q * 4 + 2] * rstd * gg[2] + bb[2]; o[3] = v[r][i * 8 + q * 4 + 3] * rstd * gg[3] + bb[3];
                    *(f32x4*)(c.out + (size_t)tk[r] * D + col) = o;
                }
            }
    }
}

__global__ void __launch_bounds__(256, 2) fwd_kernel(Args a) {
    extern __shared__ __attribute__((aligned(16))) unsigned char lds[];
    Ctx c; c.in = a.in; c.out = a.out; c.ws = a.ws; c.lds = lds;
    c.tid = threadIdx.x; c.lane = c.tid & 63; c.wid = __builtin_amdgcn_readfirstlane(c.tid >> 6);
    c.G = gridDim.x; { const int bx = blockIdx.x; c.vcu = (c.G % 8 == 0) ? (bx % 8) * (c.G / 8) + bx / 8 : bx; }
    if (c.tid < 64) ((unsigned*)(lds + MISC_OFF))[c.tid] = 0u;
    __syncthreads();
    unsigned* ctl = (unsigned*)(a.ws + WS_CTL);
    XcdBarrier bar = xcd_barrier_post(ctl + CW_BAR, (volatile LAS unsigned*)(lds + MISC_OFF));
#ifdef ONLY_PH
#define PH_ON(k) ((k) == ONLY_PH)
#else
#define PH_ON(k) 1
#endif
    const int lo = a.ph_lo, hi = a.ph_hi;
#define RUN_PHASE(k, fn) if (PH_ON(k) && lo <= (k) && (k) < hi) { \
        for (int _rep = 0; _rep < ((REPEAT_PH == (k)) ? 2 : 1); ++_rep) { \
            int _t = threadIdx.x; asm volatile("" : "+v"(_t)); c.tid = _t; c.lane = _t & 63; c.wid = __builtin_amdgcn_readfirstlane(_t >> 6); \
            if ((k) == 5) phase5(c, _rep); else fn(c); \
            if (_rep == 0 && REPEAT_PH == (k)) xcd_barrier(bar); } \
        if ((k) + 1 < hi) xcd_barrier(bar); }
    RUN_PHASE(0, phase0)
    RUN_PHASE(1, phase1)
    RUN_PHASE(2, phase2)
    RUN_PHASE(3, phase3)
    RUN_PHASE(4, phase4)
    RUN_PHASE(5, phase0)
    RUN_PHASE(6, phase6a)
    RUN_PHASE(7, phase6b)
    RUN_PHASE(8, phase7)
}

extern "C" void kernel_launch(void* const* d_in, const int* in_sizes, int n_in, void* d_out, int out_size, void* d_ws, size_t ws_size, hipStream_t stream) {
    static int grid = 0;
    if (grid == 0) {
        if (n_in != 27 || in_sizes[0] != NB * SEQ * D || out_size != TR * D || ws_size < WS_END) {
            fprintf(stderr, "kernel_launch: shape mismatch n_in %d in0 %d out %d ws %zu\n", n_in, n_in > 0 ? in_sizes[0] : -1, out_size, ws_size); grid = -1; return; }
        int dev = 0, cus = 0, per_cu = 0;
        if (hipGetDevice(&dev) != hipSuccess || hipDeviceGetAttribute(&cus, hipDeviceAttributeMultiprocessorCount, dev) != hipSuccess) { grid = -1; return; }
        if (hipFuncSetAttribute((const void*)fwd_kernel, hipFuncAttributeMaxDynamicSharedMemorySize, LDS_BYTES) != hipSuccess) { grid = -1; return; }
        if (hipOccupancyMaxActiveBlocksPerMultiprocessor(&per_cu, (const void*)fwd_kernel, 256, LDS_BYTES) != hipSuccess || per_cu < 1) per_cu = 1;
        (void)hipGetLastError();
        if (per_cu > 2) per_cu = 2;
        grid = cus * per_cu;
        fprintf(stderr, "kernel_launch: grid %d (%d per CU)\n", grid, per_cu);
    }
    if (grid < 0) return;
    (void)hipMemsetAsync((char*)d_ws + WS_CTL, 0, CTL_ZERO_BYTES, stream);
    Args a{};
    for (int i = 0; i < 27; ++i) a.in[i] = (const float*)d_in[i];
    a.out = (float*)d_out; a.ws = (unsigned char*)d_ws;
    if (MK_N_LAUNCHES == 1) {
        a.ph_lo = 0; a.ph_hi = NPH;
        hipLaunchKernelGGL(fwd_kernel, dim3(grid), dim3(256), LDS_BYTES, stream, a);
    } else {
        for (int ph = 0; ph < NPH; ++ph) { a.ph_lo = ph; a.ph_hi = ph + 1; hipLaunchKernelGGL(fwd_kernel, dim3(grid), dim3(256), LDS_BYTES, stream, a); }
    }
}
```

```cpp
#include <hip/hip_runtime.h>
#include <cstdio>
#include <cstdint>

#ifndef REPEAT_PH
#define REPEAT_PH -1
#endif
#ifndef CONV_REPB
#define CONV_REPB 1
#endif
#ifndef CONV_REPC
#define CONV_REPC 1
#endif
#ifndef CONV_REPA
#define CONV_REPA 1
#endif
#ifndef MK_N_LAUNCHES
#define MK_N_LAUNCHES 1
#endif

#define DEV __device__ __forceinline__
#define LAS __attribute__((address_space(3)))
#define GAS __attribute__((address_space(1)))
typedef unsigned short bf16_t;
typedef short bf16x8 __attribute__((ext_vector_type(8)));
typedef short s16x4 __attribute__((ext_vector_type(4)));
typedef float f32x4 __attribute__((ext_vector_type(4)));
typedef float f32x16 __attribute__((ext_vector_type(16)));
typedef unsigned u32x4 __attribute__((ext_vector_type(4)));
typedef unsigned u32x2 __attribute__((ext_vector_type(2)));
typedef long i64x2 __attribute__((ext_vector_type(2)));

constexpr int NB = 16, SEQ = 2048, NMETA = 16, L = SEQ + NMETA;
constexpr int T = NB * L;
constexpr int TR = NB * SEQ;
constexpr int D = 1024, NIN = 1696, CC = 512, QL = 384, KVL = 256, NH = 8, DQK = 96, DV = 64;
constexpr int NQ = NH * DQK;
constexpr int NKV = NH * (64 + DV);
constexpr int NE = 32, DE = 256, CONVK = 31;
constexpr float EPS = 1e-5f;
constexpr float ALPHA = 1.189207115002721f;
constexpr float QSCALE = 0.10206207261596577f * 1.4426950408889634f;
constexpr int NPH = 9;
constexpr float WSCALE = 16.f, WUNSCALE = 1.f / 16.f;
constexpr float YSCALE = 64.f, YUNSCALE = 1.f / 64.f;

constexpr size_t MiB = 1u << 20;
constexpr size_t WS_CTL = 0, CTL_ZERO_BYTES = 64 * 1024;
constexpr int CW_CNT = 1024, CNT_STRIDE = 64;
constexpr int CW_BAR = 4096;
constexpr size_t WS_LIST = 1 * MiB;
constexpr size_t WS_COMBW = 5 * MiB;
constexpr size_t WS_ROPE = 5 * MiB + 512 * 1024;
constexpr size_t WS_WIN = 6 * MiB;
constexpr size_t WS_WUQ = 10 * MiB;
constexpr size_t WS_WUKV = 11 * MiB;
constexpr size_t WS_WO = 12 * MiB;
constexpr size_t WS_WR = 14 * MiB;
constexpr size_t WS_WGU = 16 * MiB;
constexpr size_t WS_WD = 48 * MiB;
constexpr size_t WS_H1F8 = 130 * MiB;
constexpr size_t WS_H0 = 64 * MiB;
constexpr size_t WS_U = 130 * MiB;
constexpr size_t WS_CQ = 163 * MiB;
constexpr size_t WS_CKV = 188 * MiB;
constexpr size_t WS_KR = 205 * MiB;
constexpr size_t WS_Q = 208 * MiB;
constexpr size_t WS_KV = 257 * MiB;
constexpr size_t WS_R1 = 208 * MiB;
constexpr size_t WS_Y = 208 * MiB;
constexpr size_t WS_MG = 336 * MiB;
constexpr size_t WS_ACT = 336 * MiB;
constexpr size_t WS_DUMMY = 400 * MiB;
constexpr size_t WS_END = 401 * MiB;

constexpr int LDS_BYTES = 73728;
constexpr int MISC_OFF = LDS_BYTES - 256;
constexpr int RS_OFF = 65536;
constexpr int TBL_OFF = 66048;
constexpr int EXP_OFF = 66560;

DEV unsigned cvtpk(float lo, float hi) { unsigned r; asm("v_cvt_pk_bf16_f32 %0, %1, %2" : "=v"(r) : "v"(lo), "v"(hi)); return r; }
DEV float bflo(unsigned w) { return __uint_as_float(w << 16); }
DEV float bfhi(unsigned w) { return __uint_as_float(w & 0xffff0000u); }
DEV float dpp_add_qp(float v, int) { return v; }
template <int CTRL> DEV float dpp_mov(float v) { return __builtin_bit_cast(float, __builtin_amdgcn_update_dpp(0, __builtin_bit_cast(int, v), CTRL, 0xf, 0xf, false)); }
DEV float wave_sum(float v) {
    v += dpp_mov<0xB1>(v);
    v += dpp_mov<0x4E>(v);
    v += dpp_mov<0x141>(v);
    v += dpp_mov<0x140>(v);
    const int iv = __builtin_bit_cast(int, v);
    const float a = __builtin_bit_cast(float, __builtin_amdgcn_readlane(iv, 0)), b = __builtin_bit_cast(float, __builtin_amdgcn_readlane(iv, 16));
    const float c = __builtin_bit_cast(float, __builtin_amdgcn_readlane(iv, 32)), d = __builtin_bit_cast(float, __builtin_amdgcn_readlane(iv, 48));
    return (a + b) + (c + d);
}
DEV float rsqrt_(float x) { return __builtin_amdgcn_rsqf(x); }
DEV void st_bf4(bf16_t* p, f32x4 v) { u32x2 w = {cvtpk(v[0], v[1]), cvtpk(v[2], v[3])}; *(u32x2*)p = w; }
DEV unsigned pk_fp8x4(float a, float b, float c, float d) {
    int w = __builtin_amdgcn_cvt_pk_fp8_f32(a, b, 0, false); w = __builtin_amdgcn_cvt_pk_fp8_f32(c, d, w, true); return (unsigned)w; }
DEV float fast_exp2(float x) { return __builtin_amdgcn_exp2f(x); }
DEV float fast_rcp(float x) { return __builtin_amdgcn_rcpf(x); }
DEV float sigmoidf_(float g) { return fast_rcp(1.f + fast_exp2(-1.4426950408889634f * g)); }
#define LDS_WAIT() asm volatile("s_waitcnt lgkmcnt(0)" ::: "memory")
#define VM_WAIT() asm volatile("s_waitcnt vmcnt(0)" ::: "memory")

#define XB_TMO      128
#define XB_XCNT(j)  (256  + 64 * (j))
#define XB_XSUB(j)  (1280 + 64 * (j))
#define XB_XGEN(j)  (2304 + 64 * (j))
#define XB_TOP      3328
#define XB_TOPGEN   3392
#define XCD_BAR_WORDS 3456
#define XB_SPIN_CAP (1u << 22)
DEV unsigned xb_ld(unsigned* p)              { return __hip_atomic_load(p, __ATOMIC_RELAXED, __HIP_MEMORY_SCOPE_AGENT); }
DEV unsigned xb_add(unsigned* p, unsigned v) { return __hip_atomic_fetch_add(p, v, __ATOMIC_RELAXED, __HIP_MEMORY_SCOPE_AGENT); }
DEV unsigned xb_xcc_id() { return (unsigned)__builtin_amdgcn_s_getreg((3 << 11) | 20) & 0xFu; }
#define XB_SPIN(cond, bar) do { unsigned _sp = 0; while (cond) { __builtin_amdgcn_s_sleep(1); \
    if ((++_sp & 255u) == 0u) { if (xb_ld(&(bar)[XB_TMO])) break; if (_sp > XB_SPIN_CAP) { atomicAdd(&(bar)[XB_TMO], 1u); break; } } } } while (0)
struct XcdBarrier { unsigned* bar; unsigned x; volatile LAS unsigned* st; };
DEV XcdBarrier xcd_barrier_post(unsigned* bar, volatile LAS unsigned* st) {
    XcdBarrier b; b.bar = bar; b.x = xb_xcc_id(); b.st = st;
    if (threadIdx.x == 0) (void)xb_add(&bar[XB_XCNT(b.x)], 1u);
    return b;
}
DEV void xcd_barrier_complete(unsigned* bar, unsigned x, unsigned& nloc, unsigned& nx) {
    const unsigned G = gridDim.x * gridDim.y * gridDim.z;
    unsigned sum, cnt, mine, sp = 0u;
    for (;;) {
        sum = 0u; cnt = 0u; mine = 0u;
#pragma unroll
        for (unsigned j = 0; j < 16; ++j) { const unsigned c = xb_ld(&bar[XB_XCNT(j)]); sum += c; cnt += (c > 0u) ? 1u : 0u; mine = (j == x) ? c : mine; }
        if (sum == G) break;
        __builtin_amdgcn_s_sleep(1);
        if ((++sp & 255u) == 0u) { if (xb_ld(&bar[XB_TMO])) break; if (sp > XB_SPIN_CAP) { atomicAdd(&bar[XB_TMO], 1u); break; } }
    }
    nloc = mine > 0u ? mine : 1u; nx = cnt > 0u ? cnt : 1u;
}
DEV void xcd_barrier(const XcdBarrier& b) {
    asm volatile("s_waitcnt vmcnt(0)" ::: "memory");
    __syncthreads();
    if (threadIdx.x == 0) {
        unsigned* bar = b.bar;
        __builtin_amdgcn_s_waitcnt(0);
        unsigned nloc = b.st[0], nx = b.st[1];
        if (nloc == 0u) { xcd_barrier_complete(bar, b.x, nloc, nx); b.st[0] = nloc; b.st[1] = nx; }
        const unsigned old = xb_add(&bar[XB_XSUB(b.x)], 1u);
        const unsigned gen = old / nloc;
        if (old + 1u == (gen + 1u) * nloc) {
            __builtin_amdgcn_fence(__ATOMIC_RELEASE, "agent");
            asm volatile("s_waitcnt vmcnt(0)" ::: "memory");
            const unsigned og = xb_add(&bar[XB_TOP], 1u);
            const unsigned tg = og / nx;
            if (og + 1u == (tg + 1u) * nx) xb_add(&bar[XB_TOPGEN], 1u);
            else XB_SPIN(xb_ld(&bar[XB_TOPGEN]) == tg, bar);
            __builtin_amdgcn_fence(__ATOMIC_ACQUIRE, "agent");
            xb_add(&bar[XB_XGEN(b.x)], 1u);
            asm volatile("s_waitcnt vmcnt(0)" ::: "memory");
        } else {
            XB_SPIN(xb_ld(&bar[XB_XGEN(b.x)]) == gen, bar);
            __builtin_amdgcn_fence(__ATOMIC_ACQUIRE, "agent");
            asm volatile("s_waitcnt vmcnt(0)" ::: "memory");
        }
    }
    __syncthreads();
}

struct Args { const float* in[27]; float* out; unsigned char* ws; int ph_lo, ph_hi; };
struct Ctx {
    const float* const* in; float* out; unsigned char* ws; unsigned char* lds;
    int tid, lane, wid, vcu, G;
};
enum { I_X = 0, I_META, I_LNIN_G, I_LNIN_B, I_WIN, I_CONVW, I_CONVB, I_CLN_G, I_CLN_B, I_QNG, I_WUQ, I_KVNG, I_WUKV, I_COUT_G, I_AOUT_G, I_WO,
       I_LN1G, I_LN1B, I_WRG, I_BRG, I_WRE, I_BRE, I_WGATE, I_WUP, I_WDOWN, I_LN2G, I_LN2B };

DEV int nmap(int mode, int n) {
    if (mode == 1) { if (n < 512) return ((n >> 4) << 5) + (n & 15); if (n < 1024) return (((n - 512) >> 4) << 5) + 16 + (n & 15); return n; }
    if (mode == 2) return ((n >> 4) << 5) + (n & 15);
    if (mode == 3) return ((n >> 4) << 5) + 16 + (n & 15);
    return n;
}
DEV void p0_transpose_item(const float* __restrict__ W, int N, int k0, int n0, const float* __restrict__ kscale, bf16_t* WT, int ldt, int kout0, int mode,
                           float* scr, int lane) {
#pragma unroll 8
    for (int i = 0; i < 32; ++i) {
        const int kk = 2 * i + (lane >> 5);
        float v = W[(size_t)(k0 + kk) * N + n0 + (lane & 31)];
        if (kscale) v *= kscale[k0 + kk];
        scr[kk * 33 + (lane & 31)] = v;
    }
    LDS_WAIT(); asm volatile("" ::: "memory");
    const int c = lane & 7;
#pragma unroll
    for (int j = 0; j < 4; ++j) {
        const int n = (lane >> 3) + 8 * j; const float* s = scr + (8 * c) * 33 + n;
        u32x4 o; o.x = cvtpk(s[0 * 33], s[1 * 33]); o.y = cvtpk(s[2 * 33], s[3 * 33]); o.z = cvtpk(s[4 * 33], s[5 * 33]); o.w = cvtpk(s[6 * 33], s[7 * 33]);
        *(u32x4*)(WT + (size_t)nmap(mode, n0 + n) * ldt + kout0 + 8 * c) = o;
    }
    LDS_WAIT(); asm volatile("" ::: "memory");
}
DEV void p0_transpose_item_f8(const float* __restrict__ W, int N, int k0, int n0, float scale, unsigned char* W8, int ldt, int kout0, int mode, float* scr, int lane) {
#pragma unroll 8
    for (int i = 0; i < 32; ++i) { const int kk = 2 * i + (lane >> 5); scr[kk * 33 + (lane & 31)] = W[(size_t)(k0 + kk) * N + n0 + (lane & 31)] * scale; }
    LDS_WAIT(); asm volatile("" ::: "memory");
    const int c = lane & 7;
#pragma unroll
    for (int j = 0; j < 4; ++j) {
        const int n = (lane >> 3) + 8 * j; const float* sp = scr + (8 * c) * 33 + n;
        u32x2 o; o.x = pk_fp8x4(sp[0 * 33], sp[1 * 33], sp[2 * 33], sp[3 * 33]); o.y = pk_fp8x4(sp[4 * 33], sp[5 * 33], sp[6 * 33], sp[7 * 33]);
        *(u32x2*)(W8 + (size_t)nmap(mode, n0 + n) * ldt + kout0 + 8 * c) = o;
    }
    LDS_WAIT(); asm volatile("" ::: "memory");
}
template <int N> DEV void wave_sum_n(float (&v)[N]) {
#pragma unroll
    for (int i = 0; i < N; ++i) v[i] = wave_sum(v[i]);
}
template <int NR, bool F8 = false, bool BFIN = false> DEV void ln_rows_bf16(const float* const (&xrow)[NR], const float* g, const float* bta, bf16_t* const (&orow)[NR], unsigned char* const (&ldsrow)[NR], int lane, unsigned char* const* f8row = nullptr) {
    f32x4 v[NR][4]; float s[NR];
#pragma unroll
    for (int r = 0; r < NR; ++r)
#pragma unroll
        for (int j = 0; j < 4; ++j) {
            if (BFIN) { const u32x2 w = ((const u32x2*)xrow[r])[64 * j + lane]; v[r][j] = (f32x4){bflo(w.x), bfhi(w.x), bflo(w.y), bfhi(w.y)}; }
            else v[r][j] = ((const f32x4*)xrow[r])[64 * j + lane]; }
#pragma unroll
    for (int r = 0; r < NR; ++r) { s[r] = 0.f;
#pragma unroll
        for (int j = 0; j < 4; ++j) s[r] += (v[r][j].x + v[r][j].y) + (v[r][j].z + v[r][j].w); }
    wave_sum_n<NR>(s);
    float s2[NR];
#pragma unroll
    for (int r = 0; r < NR; ++r) { const float mean = s[r] * (1.f / 1024.f); s2[r] = 0.f;
#pragma unroll
        for (int j = 0; j < 4; ++j) { v[r][j] = v[r][j] - mean; s2[r] += (v[r][j].x * v[r][j].x + v[r][j].y * v[r][j].y) + (v[r][j].z * v[r][j].z + v[r][j].w * v[r][j].w); } }
    wave_sum_n<NR>(s2);
#pragma unroll
    for (int j = 0; j < 4; ++j) {
        const f32x4 gg = ((const f32x4*)g)[64 * j + lane], bb = ((const f32x4*)bta)[64 * j + lane];
#pragma unroll
        for (int r = 0; r < NR; ++r) {
            const float rstd = rsqrt_(s2[r] * (1.f / 1024.f) + EPS);
            const f32x4 o = v[r][j] * rstd * gg + bb;
            const u32x2 w = {cvtpk(o.x, o.y), cvtpk(o.z, o.w)};
            ((u32x2*)orow[r])[64 * j + lane] = w;
            if (ldsrow[r]) ((u32x2*)ldsrow[r])[64 * j + lane] = w;
            if (F8) ((unsigned*)f8row[r])[64 * j + lane] = pk_fp8x4(o.x, o.y, o.z, o.w);
        }
    }
}
__device__ const float INVF[16] = {1.0f, 0.5623413251903491f, 0.31622776601683794f, 0.1778279410038923f, 0.1f, 0.05623413251903491f, 0.031622776601683794f,
    0.01778279410038923f, 0.01f, 0.005623413251903491f, 0.0031622776601683794f, 0.001778279410038923f, 0.001f, 0.0005623413251903491f, 0.00031622776601683794f, 0.0001778279410038923f};
DEV void sincos_d(double a, float& sn, float& cs) {
    const double TWO_PI = 6.283185307179586476925286766559;
    const double k = __builtin_rint(a / TWO_PI);
    const double r = a - k * TWO_PI;
    const double r2 = r * r;
    double st = r, ct = 1.0, ssum = r, csum = 1.0;
#pragma unroll 1
    for (int i = 1; i <= 14; ++i) {
        ct = -ct * r2 / (double)((2 * i - 1) * (2 * i));  csum += ct;
        st = -st * r2 / (double)((2 * i) * (2 * i + 1));  ssum += st;
    }
    sn = (float)ssum; cs = (float)csum;
}
DEV void expert_weight_item(const Ctx& c, int r, float* scr) {
    constexpr int I_G = 32 * 128;
    unsigned char* Wgu8 = c.ws + WS_WGU; unsigned char* Wd8 = c.ws + WS_WD;
    if (r < I_G) { const int e = r >> 7, q = r & 127, kb = q >> 3, nb = q & 7;
        p0_transpose_item_f8(c.in[I_WGATE] + (size_t)e * D * DE, DE, 64 * kb, 32 * nb, WSCALE, Wgu8 + (size_t)e * 512 * 1024, 1024, 64 * kb, 2, scr, c.lane); return; } r -= I_G;
    if (r < I_G) { const int e = r >> 7, q = r & 127, kb = q >> 3, nb = q & 7;
        p0_transpose_item_f8(c.in[I_WUP] + (size_t)e * D * DE, DE, 64 * kb, 32 * nb, WSCALE, Wgu8 + (size_t)e * 512 * 1024, 1024, 64 * kb, 3, scr, c.lane); return; } r -= I_G;
    { const int e = r >> 7, q = r & 127, kb = q >> 5, nb = q & 31;
        p0_transpose_item_f8(c.in[I_WDOWN] + (size_t)e * DE * D, D, 64 * kb, 32 * nb, WSCALE, Wd8 + (size_t)e * 1024 * 256, 256, 64 * kb, 0, scr, c.lane); }
}
DEV void phase0(const Ctx& c) {
    float* scr = (float*)(c.lds + c.wid * 8448);
    const int gw = c.vcu * 4 + c.wid, NGW = c.G * 4;
    constexpr int I_IN = 16 * 53, I_UQ = 6 * 24, I_UKV = 4 * 32, I_O = 16 * 32;
    bf16_t* WinT = (bf16_t*)(c.ws + WS_WIN); bf16_t* WuqT = (bf16_t*)(c.ws + WS_WUQ); bf16_t* WukvT = (bf16_t*)(c.ws + WS_WUKV);
    bf16_t* WoT = (bf16_t*)(c.ws + WS_WO);
    constexpr int NITEMS0 = I_IN + I_UQ + I_UKV + I_O;
    for (int it = gw; it < NITEMS0; it += NGW) {
        int r = it;
        if (r < I_IN) { const int kb = r / 53, nb = r % 53; p0_transpose_item(c.in[I_WIN], NIN, 64 * kb, 32 * nb, nullptr, WinT, 1024, 64 * kb, 1, scr, c.lane); continue; } r -= I_IN;
        if (r < I_UQ) { const int kb = r / 24, nb = r % 24; p0_transpose_item(c.in[I_WUQ], NQ, 64 * kb, 32 * nb, c.in[I_QNG], WuqT, QL, 64 * kb, 0, scr, c.lane); continue; } r -= I_UQ;
        if (r < I_UKV) { const int kb = r / 32, nb = r % 32; p0_transpose_item(c.in[I_WUKV], NKV, 64 * kb, 32 * nb, c.in[I_KVNG], WukvT, KVL, 64 * kb, 0, scr, c.lane); continue; } r -= I_UKV;
        { const int kb = r / 32, nb = r % 32;
            if (kb < 8) p0_transpose_item(c.in[I_WO], D, 64 * kb, 32 * nb, nullptr, WoT, 1024, 64 * kb + 512, 0, scr, c.lane);
            else        p0_transpose_item(c.in[I_WO], D, 64 * kb, 32 * nb, c.in[I_AOUT_G] - 512, WoT, 1024, 64 * kb - 512, 0, scr, c.lane); }
    }
    const int gt = c.vcu * 256 + c.tid, NGT = c.G * 256;
    bf16_t* WrT = (bf16_t*)(c.ws + WS_WR);
    for (int i = gt; i < 48 * 1024; i += NGT) {
        const int n = i >> 10, k = i & 1023; float v = 0.f;
        if (n < 4) v = c.in[I_WRG][k * 4 + n]; else if (n < 36) v = c.in[I_WRE][k * 32 + (n - 4)];
        WrT[i] = (bf16_t)(cvtpk(v, 0.f) & 0xffffu);
    }
    float* rc = (float*)(c.ws + WS_ROPE); float* rs = rc + L * 16;
    for (int i = gt; i < L * 16; i += NGT) {
        const int p = i >> 4, f = i & 15; const float ang = (float)p * INVF[f];
        float sn, cs; sincos_d((double)ang, sn, cs); rc[i] = cs; rs[i] = sn;
    }
    bf16_t* h0 = (bf16_t*)(c.ws + WS_H0);
    for (int t = gw; t < T; t += 2 * NGW) {
        const float* src[2]; bf16_t* dst[2]; unsigned char* ldsn[2] = {nullptr, nullptr};
#pragma unroll
        for (int r = 0; r < 2; ++r) { int tt = t + r * NGW; if (tt >= T) tt = t;
            const int b = tt / L, p = tt - b * L;
            src[r] = (p < NMETA) ? c.in[I_META] + (size_t)p * D : c.in[I_X] + ((size_t)b * SEQ + (p - NMETA)) * D;
            dst[r] = h0 + (size_t)tt * D; }
        ln_rows_bf16<2>(src, c.in[I_LNIN_G], c.in[I_LNIN_B], dst, ldsn, c.lane);
    }
}

struct StageGeo { int r[4]; int c; };
DEV StageGeo stage_geo(int tid) {
    const int lane = tid & 63, wid = tid >> 6; StageGeo g;
    const int f = ((wid & 1) << 2) | (lane >> 4);
#pragma unroll
    for (int i = 0; i < 4; ++i) g.r[i] = (wid + 4 * i) * 8 + (lane >> 3);
    g.c = ((lane & 7) ^ f) * 8;
    return g;
}
template <bool SSQ, bool FP8 = false>
DEV void gemm_mainloop(f32x4 (&acc)[4][4], const bf16_t* ap0, const bf16_t* ap1, const bf16_t* ap2, const bf16_t* ap3,
                       const bf16_t* bp0, const bf16_t* bp1, const bf16_t* bp2, const bf16_t* bp3,
                       int nk, unsigned char* lds, int ssq_steps, float ssq_inv_dim) {
    const int tid = threadIdx.x, lane = tid & 63, wid = tid >> 6, wr = wid >> 1, wc = wid & 1, fr = lane & 15, fq = lane >> 4;
    const int xs = (fr >> 1) & 7;
    const int lo0 = fr * 128 + ((fq ^ xs) << 4), lo1 = fr * 128 + (((fq ^ xs) ^ 4) << 4);
    const int a_off = wr * 8192, b_off = 16384 + wc * 8192;
    const int dst = tid * 16;
    float ssq = 0.f;
#pragma unroll
    for (int m = 0; m < 4; ++m)
#pragma unroll
        for (int n = 0; n < 4; ++n) acc[m][n] = (f32x4){0.f, 0.f, 0.f, 0.f};
    __syncthreads();
#define GLDS(src, off) __builtin_amdgcn_global_load_lds((const unsigned*)(src), (unsigned LAS*)(lds + (off)), 16, 0, 0)
#define STAGE(kt, b) do { const int _k = (kt) * 64; \
        GLDS(ap0 + _k, (b) * 32768 + dst);          GLDS(ap1 + _k, (b) * 32768 + dst + 4096); \
        GLDS(ap2 + _k, (b) * 32768 + dst + 8192);   GLDS(ap3 + _k, (b) * 32768 + dst + 12288); \
        GLDS(bp0 + _k, (b) * 32768 + 16384 + dst);  GLDS(bp1 + _k, (b) * 32768 + 16384 + dst + 4096); \
        GLDS(bp2 + _k, (b) * 32768 + 16384 + dst + 8192); GLDS(bp3 + _k, (b) * 32768 + 16384 + dst + 12288); } while (0)
    STAGE(0, 0);
    for (int kt = 0; kt < nk; ++kt) {
        VM_WAIT();
        __syncthreads();
        const int b = kt & 1;
        if (SSQ && kt == ssq_steps) {
            const float* rsl = (const float*)(lds + RS_OFF);
#pragma unroll
            for (int m = 0; m < 4; ++m) { const float r = rsl[wr * 64 + m * 16 + fr];
#pragma unroll
                for (int n = 0; n < 4; ++n) acc[m][n] = acc[m][n] * r; }
        }
        if (kt + 1 < nk) { if (b) STAGE(kt + 1, 0); else STAGE(kt + 1, 1); }
        const unsigned char* base = lds + b * 32768;
#pragma unroll
        for (int ks = 0; ks < 2; ++ks) {
            bf16x8 af[4], bf[4];
#pragma unroll
            for (int m = 0; m < 4; ++m) af[m] = *(const bf16x8*)(base + a_off + m * 2048 + (ks ? lo1 : lo0));
#pragma unroll
            for (int n = 0; n < 4; ++n) bf[n] = *(const bf16x8*)(base + b_off + n * 2048 + (ks ? lo1 : lo0));
            if (FP8) {
#pragma unroll
                for (int m = 0; m < 4; ++m) { const i64x2 a2 = __builtin_bit_cast(i64x2, af[m]);
#pragma unroll
                    for (int n = 0; n < 4; ++n) { const i64x2 b2 = __builtin_bit_cast(i64x2, bf[n]);
                        acc[m][n] = __builtin_amdgcn_mfma_f32_16x16x32_fp8_fp8(b2[0], a2[0], acc[m][n], 0, 0, 0);
                        acc[m][n] = __builtin_amdgcn_mfma_f32_16x16x32_fp8_fp8(b2[1], a2[1], acc[m][n], 0, 0, 0); } }
            } else {
#pragma unroll
            for (int m = 0; m < 4; ++m)
#pragma unroll
                for (int n = 0; n < 4; ++n) acc[m][n] = __builtin_amdgcn_mfma_f32_16x16x32_bf16(bf[n], af[m], acc[m][n], 0, 0, 0);
            }
        }
        if (SSQ && kt < ssq_steps) {
            const int row = tid >> 1, hf = tid & 1;
            const int rb = row * 128, sw = (row >> 1) & 7;
#pragma unroll
            for (int j = 0; j < 4; ++j) {
                const u32x4 w = *(const u32x4*)(base + rb + (((hf * 4 + j) ^ sw) << 4));
#pragma unroll
                for (int q = 0; q < 4; ++q) { const float a = bflo(w[q]), bb = bfhi(w[q]); ssq += a * a + bb * bb; }
            }
            if (kt == ssq_steps - 1) {
                const float tot = ssq + __shfl_xor(ssq, 1);
                if (hf == 0) ((float*)(lds + RS_OFF))[row] = rsqrt_(tot * ssq_inv_dim + EPS);
            }
        }
    }
    if (SSQ && ssq_steps == nk) {
        __syncthreads();
        const float* rsl = (const float*)(lds + RS_OFF);
#pragma unroll
        for (int m = 0; m < 4; ++m) { const float r = rsl[wr * 64 + m * 16 + fr];
#pragma unroll
            for (int n = 0; n < 4; ++n) acc[m][n] = acc[m][n] * r; }
    }
#undef STAGE
#undef GLDS
}

DEV void phase1(const Ctx& c) {
    const bf16_t* h0 = (const bf16_t*)(c.ws + WS_H0); const bf16_t* WinT = (const bf16_t*)(c.ws + WS_WIN);
    bf16_t* U = (bf16_t*)(c.ws + WS_U); bf16_t* CQ = (bf16_t*)(c.ws + WS_CQ); bf16_t* CKV = (bf16_t*)(c.ws + WS_CKV); bf16_t* KR = (bf16_t*)(c.ws + WS_KR);
    const float* rc = (const float*)(c.ws + WS_ROPE); const float* rs = rc + L * 16;
    const StageGeo g = stage_geo(c.tid);
    const int lane = c.lane, wr = c.wid >> 1, wc = c.wid & 1, fr = lane & 15, fq = lane >> 4;
    constexpr int NT = 14, NU = (T / 128) * NT;
    for (int u = c.vcu; u < NU; u += c.G) {
        const int mt = u / NT, nt = u - mt * NT;
        const bf16_t* A = h0 + (size_t)(mt * 128) * D + g.c; const bf16_t* B = WinT + (size_t)(nt * 128) * D + g.c;
        f32x4 acc[4][4];
        gemm_mainloop<false>(acc, A + (size_t)g.r[0] * D, A + (size_t)g.r[1] * D, A + (size_t)g.r[2] * D, A + (size_t)g.r[3] * D,
                             B + (size_t)g.r[0] * D, B + (size_t)g.r[1] * D, B + (size_t)g.r[2] * D, B + (size_t)g.r[3] * D, 16, c.lds, 0, 0.f);
        const int row0 = mt * 128 + wr * 64 + fr;
        if (nt < 8) {
#pragma unroll
            for (int m = 0; m < 4; ++m) { const size_t row = row0 + m * 16;
#pragma unroll
                for (int i = 0; i < 2; ++i) {
                    f32x4 a = acc[m][2 * i], gt = acc[m][2 * i + 1], o;
#pragma unroll
                    for (int j = 0; j < 4; ++j) o[j] = a[j] * sigmoidf_(gt[j]);
                    st_bf4(U + row * CC + nt * 64 + wc * 32 + i * 16 + fq * 4, o);
                } }
        } else if (nt < 11) {
#pragma unroll
            for (int m = 0; m < 4; ++m) { const size_t row = row0 + m * 16;
#pragma unroll
                for (int n = 0; n < 4; ++n) st_bf4(CQ + row * QL + (nt - 8) * 128 + wc * 64 + n * 16 + fq * 4, acc[m][n]); }
        } else if (nt < 13) {
#pragma unroll
            for (int m = 0; m < 4; ++m) { const size_t row = row0 + m * 16;
#pragma unroll
                for (int n = 0; n < 4; ++n) st_bf4(CKV + row * KVL + (nt - 11) * 128 + wc * 64 + n * 16 + fq * 4, acc[m][n]); }
        } else if (wc == 0) {
#pragma unroll
            for (int m = 0; m < 4; ++m) { const int row = row0 + m * 16; const int p = row % L;
                const f32x4 cs = *(const f32x4*)(rc + p * 16 + fq * 4), sn = *(const f32x4*)(rs + p * 16 + fq * 4);
                const f32x4 x1 = acc[m][0], x2 = acc[m][1];
                st_bf4(KR + (size_t)row * 32 + fq * 4, x1 * cs - x2 * sn);
                st_bf4(KR + (size_t)row * 32 + 16 + fq * 4, x1 * sn + x2 * cs); }
        }
    }
}

DEV void conv_unit(const Ctx& c, int b, int j) {
    const bf16_t* U = (const bf16_t*)(c.ws + WS_U);
    bf16_t* MG = (bf16_t*)(c.ws + WS_MG);
    const float* cw = c.in[I_CONVW]; const float* cb = c.in[I_CONVB];
    const int p0 = j * 32;
    float* ytile = (float*)c.lds;
    __syncthreads();
#pragma unroll 1
    for (int pass = 0; pass < 2; ++pass) {
        const int ch = c.tid + 256 * pass;
        float win[62]; unsigned raw[62];
        const bf16_t* ub = U + (size_t)b * L * CC + ch;
#pragma unroll
        for (int rep = 0; rep < CONV_REPA; ++rep) {
        asm volatile("" : "+v"(ub) :: "memory");
#pragma unroll
        for (int i = 0; i < 62; ++i) { const int p = p0 - 30 + i; const int pc = p < 0 ? 0 : (p >= L ? L - 1 : p); raw[i] = ub[(size_t)pc * CC]; }
        if (rep + 1 < CONV_REPA) {
#pragma unroll
            for (int i = 0; i < 62; ++i) asm volatile("" :: "v"(raw[i]));
        }
        }
        float w[31];
#pragma unroll
        for (int k = 0; k < 31; ++k) w[k] = cw[k * CC + ch];
        float bias = cb[ch];
        __builtin_amdgcn_sched_barrier(0);
#pragma unroll
        for (int i = 0; i < 62; ++i) { const int p = p0 - 30 + i; win[i] = (p >= 0 && p < L) ? __uint_as_float(raw[i] << 16) : 0.f; }
#pragma unroll
        for (int rep = 0; rep < CONV_REPB; ++rep) {
        asm volatile("" : "+v"(bias) :: "memory");
#pragma unroll
        for (int tt = 0; tt < 32; ++tt) {
            float a0 = bias;
#pragma unroll
            for (int k = 0; k < 31; ++k) a0 += w[k] * win[tt + k];
            ytile[tt * 512 + ch] = a0;
        }
        }
    }
    __syncthreads();
    const float* g1 = c.in[I_CLN_G]; const float* b1 = c.in[I_CLN_B]; const float* g2 = c.in[I_COUT_G];
    float G1[8], B1[8], G2[8];
    { const f32x4 a = *(const f32x4*)(g1 + c.lane * 8), bq = *(const f32x4*)(g1 + c.lane * 8 + 4); G1[0]=a.x;G1[1]=a.y;G1[2]=a.z;G1[3]=a.w;G1[4]=bq.x;G1[5]=bq.y;G1[6]=bq.z;G1[7]=bq.w; }
    { const f32x4 a = *(const f32x4*)(b1 + c.lane * 8), bq = *(const f32x4*)(b1 + c.lane * 8 + 4); B1[0]=a.x;B1[1]=a.y;B1[2]=a.z;B1[3]=a.w;B1[4]=bq.x;B1[5]=bq.y;B1[6]=bq.z;B1[7]=bq.w; }
    { const f32x4 a = *(const f32x4*)(g2 + c.lane * 8), bq = *(const f32x4*)(g2 + c.lane * 8 + 4); G2[0]=a.x;G2[1]=a.y;G2[2]=a.z;G2[3]=a.w;G2[4]=bq.x;G2[5]=bq.y;G2[6]=bq.z;G2[7]=bq.w; }
#pragma unroll
    for (int rep = 0; rep < CONV_REPC; ++rep) {
    asm volatile("" : "+v"(ytile) :: "memory");
    float v[8][8]; float st[8];
#pragma unroll
    for (int i = 0; i < 8; ++i) { const int tt = c.wid * 8 + i;
        const f32x4 ya = *(const f32x4*)(ytile + tt * 512 + c.lane * 8), yb = *(const f32x4*)(ytile + tt * 512 + c.lane * 8 + 4);
        v[i][0]=ya.x;v[i][1]=ya.y;v[i][2]=ya.z;v[i][3]=ya.w;v[i][4]=yb.x;v[i][5]=yb.y;v[i][6]=yb.z;v[i][7]=yb.w;
        st[i] = ((v[i][0] + v[i][1]) + (v[i][2] + v[i][3])) + ((v[i][4] + v[i][5]) + (v[i][6] + v[i][7])); }
    wave_sum_n<8>(st);
#pragma unroll
    for (int i = 0; i < 8; ++i) { const float mean = st[i] * (1.f / 512.f); float a = 0.f;
#pragma unroll
        for (int q = 0; q < 8; ++q) { v[i][q] -= mean; a += v[i][q] * v[i][q]; }
        st[i] = a; }
    wave_sum_n<8>(st);
#pragma unroll
    for (int i = 0; i < 8; ++i) { const float rstd = rsqrt_(st[i] * (1.f / 512.f) + EPS); float a = 0.f;
#pragma unroll
        for (int q = 0; q < 8; ++q) { const float x = v[i][q] * rstd * G1[q] + B1[q]; const float y = x * sigmoidf_(x); v[i][q] = y; a += y * y; }
        st[i] = a; }
    wave_sum_n<8>(st);
#pragma unroll
    for (int i = 0; i < 8; ++i) {
        const int p = p0 + c.wid * 8 + i;
        {
            const float r2 = rsqrt_(st[i] * (1.f / 512.f) + EPS);
            u32x4 o;
            o.x = cvtpk(v[i][0] * r2 * G2[0], v[i][1] * r2 * G2[1]); o.y = cvtpk(v[i][2] * r2 * G2[2], v[i][3] * r2 * G2[3]);
            o.z = cvtpk(v[i][4] * r2 * G2[4], v[i][5] * r2 * G2[5]); o.w = cvtpk(v[i][6] * r2 * G2[6], v[i][7] * r2 * G2[7]);
            const size_t tok = (size_t)b * SEQ + (p - NMETA);
            bf16_t* dstp = (p >= NMETA && p < L) ? MG + tok * D + 512 + c.lane * 8 : (bf16_t*)(c.ws + WS_DUMMY) + c.lane * 8;
            *(u32x4*)dstp = o;
        }
    }
    }
}
DEV void rope4(f32x4& x1, f32x4& x2, const float* rc, const float* rs, int p, int fq) {
    const f32x4 cs = *(const f32x4*)(rc + p * 16 + fq * 4), sn = *(const f32x4*)(rs + p * 16 + fq * 4);
    const f32x4 a = x1 * cs - x2 * sn, bb = x1 * sn + x2 * cs; x1 = a; x2 = bb;
}
template <int SEL> DEV void phase2_t(const Ctx& c) {
    const bf16_t* CQ = (const bf16_t*)(c.ws + WS_CQ); const bf16_t* CKV = (const bf16_t*)(c.ws + WS_CKV);
    const bf16_t* WuqT = (const bf16_t*)(c.ws + WS_WUQ); const bf16_t* WukvT = (const bf16_t*)(c.ws + WS_WUKV);
    bf16_t* Q = (bf16_t*)(c.ws + WS_Q); bf16_t* KV = (bf16_t*)(c.ws + WS_KV);
    const float* rc = (const float*)(c.ws + WS_ROPE); const float* rs = rc + L * 16;
    const StageGeo g = stage_geo(c.tid);
    const int lane = c.lane, wr = c.wid >> 1, wc = c.wid & 1, fr = lane & 15, fq = lane >> 4;
    constexpr int MT = T / 128, NUQ = MT * 6, NUKV = MT * 8, NUC = NB * 65, NU = NUQ + NUKV + NUC;
    const int li = c.vcu & 63, rev = ((li >> 5) ^ li) & 1;
    const int nmine = (NU - c.vcu + c.G - 1) / c.G;
    for (int it = 0; it < nmine; ++it) {
        const int u = c.vcu + (rev ? (nmine - 1 - it) : it) * c.G;
        if (SEL == 1 && u >= NUKV + NUQ) continue;
        if (SEL == 2 && u < NUKV + NUQ) continue;
        if (u < NUKV) {
            const int mt = u >> 3, nt = u & 7;
            const bf16_t* A = CKV + (size_t)(mt * 128) * KVL + g.c; const bf16_t* B = WukvT + (size_t)(nt * 128) * KVL + g.c;
            f32x4 acc[4][4];
            gemm_mainloop<true>(acc, A + (size_t)g.r[0] * KVL, A + (size_t)g.r[1] * KVL, A + (size_t)g.r[2] * KVL, A + (size_t)g.r[3] * KVL,
                                B + (size_t)g.r[0] * KVL, B + (size_t)g.r[1] * KVL, B + (size_t)g.r[2] * KVL, B + (size_t)g.r[3] * KVL, 4, c.lds, 4, 1.f / 256.f);
            const int row0 = mt * 128 + wr * 64 + fr;
#pragma unroll
            for (int m = 0; m < 4; ++m) { const size_t row = row0 + m * 16;
#pragma unroll
                for (int n = 0; n < 4; ++n) st_bf4(KV + row * NKV + nt * 128 + wc * 64 + n * 16 + fq * 4, acc[m][n]); }
        } else if (u < NUKV + NUQ) {
            const int v = u - NUKV, mt = v / 6, nt = v - mt * 6;
            const bf16_t* A = CQ + (size_t)(mt * 128) * QL + g.c; const bf16_t* B = WuqT + (size_t)(nt * 128) * QL + g.c;
            f32x4 acc[4][4];
            gemm_mainloop<true>(acc, A + (size_t)g.r[0] * QL, A + (size_t)g.r[1] * QL, A + (size_t)g.r[2] * QL, A + (size_t)g.r[3] * QL,
                                B + (size_t)g.r[0] * QL, B + (size_t)g.r[1] * QL, B + (size_t)g.r[2] * QL, B + (size_t)g.r[3] * QL, 6, c.lds, 6, 1.f / 384.f);
            const int row0 = mt * 128 + wr * 64 + fr;
            const int t16 = (nt * 8 + wc * 4) % 6;
#pragma unroll
            for (int m = 0; m < 4; ++m) { const int row = row0 + m * 16; const int p = row % L;
#pragma unroll
                for (int n = 0; n < 4; ++n) acc[m][n] = acc[m][n] * QSCALE;
                if (t16 == 4) rope4(acc[m][0], acc[m][1], rc, rs, p, fq);
                if (t16 == 2) rope4(acc[m][2], acc[m][3], rc, rs, p, fq);
#pragma unroll
                for (int n = 0; n < 4; ++n) st_bf4(Q + (size_t)row * NQ + nt * 128 + wc * 64 + n * 16 + fq * 4, acc[m][n]); }
        } else {
            const int v = u - NUKV - NUQ; conv_unit(c, v / 65, v % 65);
        }
    }
}

DEV void phase2(const Ctx& c) { phase2_t<0>(c); }
DEV void phase2g(const Ctx& c) { phase2_t<1>(c); }
DEV void phase2c(const Ctx& c) { phase2_t<2>(c); }
DEV int crow(int r, int hi) { return (r & 3) + 8 * (r >> 2) + 4 * hi; }
#define KSWZ(row, colB) ((row) * 256 + ((colB) ^ (((row) & 7) << 4)))
#define SBAR() __builtin_amdgcn_sched_barrier(0)
DEV int v_st(int k, int cc) { const int kk = (k & ~0xC) | ((k & 4) << 1) | ((k & 8) >> 1); return ((kk >> 3) * 4 + (cc >> 5)) * 512 + ((kk & 7) * 32 + (cc & 31)) * 2; }
DEV int v_rd_base(int lane) { return ((lane & 3) << 3) | (((lane >> 2) & 3) << 6) | (((lane >> 4) & 1) << 5) | (((lane >> 5) & 1) << 8); }
constexpr int v_rd_off(int d0, int ks, int half) { return d0 * 512 + ks * 4096 + half * 2048; }
template <int OFF> DEV s16x4 tr_read(int vb) { s16x4 r; asm volatile("ds_read_b64_tr_b16 %0, %1 offset:%2" : "=&v"(r) : "v"(vb), "i"(OFF) : "memory"); return r; }
template <int D0> DEV void pv_one(f32x16& od, int vb, bf16x8 pa0, bf16x8 pa1, bf16x8 pa2, bf16x8 pa3) {
    const s16x4 l0 = tr_read<v_rd_off(D0, 0, 0)>(vb), h0 = tr_read<v_rd_off(D0, 0, 1)>(vb), l1 = tr_read<v_rd_off(D0, 1, 0)>(vb), h1 = tr_read<v_rd_off(D0, 1, 1)>(vb);
    const s16x4 l2 = tr_read<v_rd_off(D0, 2, 0)>(vb), h2 = tr_read<v_rd_off(D0, 2, 1)>(vb), l3 = tr_read<v_rd_off(D0, 3, 0)>(vb), h3 = tr_read<v_rd_off(D0, 3, 1)>(vb);
    asm volatile("s_waitcnt lgkmcnt(0)" ::: "memory"); SBAR();
#define PK(Lo, Hi) (bf16x8){Lo[0], Lo[1], Lo[2], Lo[3], Hi[0], Hi[1], Hi[2], Hi[3]}
    od = __builtin_amdgcn_mfma_f32_32x32x16_bf16(pa0, PK(l0, h0), od, 0, 0, 0);
    od = __builtin_amdgcn_mfma_f32_32x32x16_bf16(pa1, PK(l1, h1), od, 0, 0, 0);
    od = __builtin_amdgcn_mfma_f32_32x32x16_bf16(pa2, PK(l2, h2), od, 0, 0, 0);
    od = __builtin_amdgcn_mfma_f32_32x32x16_bf16(pa3, PK(l3, h3), od, 0, 0, 0);
#undef PK
}
constexpr int AT_V = 0, AT_K = 32768, AT_WS = 65536;
DEV void attn_unit(const Ctx& c, int b, int h, int qb) {
    const bf16_t* Q = (const bf16_t*)(c.ws + WS_Q); const bf16_t* KV = (const bf16_t*)(c.ws + WS_KV); const bf16_t* KR = (const bf16_t*)(c.ws + WS_KR);
    bf16_t* MG = (bf16_t*)(c.ws + WS_MG);
    unsigned char* lds = c.lds;
    const int tid = c.tid, wid = c.wid, lane = c.lane, r32 = lane & 31, hi = lane >> 5;
    float* wsf = (float*)(lds + AT_WS) + wid * 64; float* li_l = wsf; float* al_l = wsf + 32;
    const int NT = 2 * qb + 3;
    const int my_last = 2 * qb + (wid >> 1) + 1;
    bf16x8 qr[6];
    { const size_t t = (size_t)b * L + NMETA + qb * 128 + wid * 32 + r32;
      const bf16_t* Qw = Q + t * NQ + h * DQK + hi * 8;
#pragma unroll
      for (int d0 = 0; d0 < 6; ++d0) qr[d0] = *(const bf16x8*)(Qw + d0 * 16); }
    const int srow = tid >> 2, sq = tid & 3;
    const int vst0 = v_st(srow, sq * 16), vst1 = v_st(srow, sq * 16 + 8);
    const int kst0 = KSWZ(srow, sq * 32), kst1 = KSWZ(srow, sq * 32 + 16), kst2 = KSWZ(srow, 128 + sq * 16);
    const int vb0 = (int)(uintptr_t)(lds + AT_V) + v_rd_base(lane);
    u32x4 sk0, sk1, sk2, sv0, sv1;
#define SLOAD(j) do { int pos = (j) * 64 + srow - 48; pos = pos < 0 ? 0 : pos; const size_t tk = (size_t)b * L + pos; \
        const bf16_t* kvp = KV + tk * NKV + h * 128 + sq * 16; \
        sk0 = *(const u32x4*)(kvp); sk1 = *(const u32x4*)(kvp + 8); sv0 = *(const u32x4*)(kvp + 64); sv1 = *(const u32x4*)(kvp + 72); \
        sk2 = *(const u32x4*)(KR + tk * 32 + sq * 8); } while (0)
#define SWRITE(bb) do { unsigned char* kb = lds + AT_K + (bb) * 16384; unsigned char* vbp = lds + AT_V + (bb) * 16384; \
        *(u32x4*)(kb + kst0) = sk0; *(u32x4*)(kb + kst1) = sk1; *(u32x4*)(kb + kst2) = sk2; *(u32x4*)(vbp + vst0) = sv0; *(u32x4*)(vbp + vst1) = sv1; } while (0)
    float m_reg = -1e30f, l_reg = 0.f; f32x16 o[2] = {};
    __syncthreads();
    SLOAD(0); SWRITE(0); __syncthreads();
    for (int j = 0; j < NT; ++j) {
        const int bsel = j & 1;
        if (j + 1 < NT) SLOAD(j + 1);
        if (j <= my_last) {
            const unsigned char* Ks = lds + AT_K + bsel * 16384;
            f32x16 p0 = {}, p1 = {};
#pragma unroll
            for (int d0 = 0; d0 < 6; ++d0) { const int cb = (d0 * 16 + hi * 8) * 2;
                const bf16x8 k0 = *(const bf16x8*)(Ks + KSWZ(r32, cb)); const bf16x8 k1 = *(const bf16x8*)(Ks + KSWZ(32 + r32, cb));
                p0 = __builtin_amdgcn_mfma_f32_32x32x16_bf16(k0, qr[d0], p0, 0, 0, 0);
                p1 = __builtin_amdgcn_mfma_f32_32x32x16_bf16(k1, qr[d0], p1, 0, 0, 0); }
            if (j == 0) {
#pragma unroll
                for (int r = 0; r < 16; ++r) p0[r] = -1e30f;
#pragma unroll
                for (int r = 0; r < 8; ++r) p1[r] = -1e30f;
            }
            float pmax = p0[0];
#pragma unroll
            for (int r = 1; r < 16; ++r) pmax = fmaxf(pmax, p0[r]);
#pragma unroll
            for (int r = 0; r < 16; ++r) pmax = fmaxf(pmax, p1[r]);
            { auto rr = __builtin_amdgcn_permlane32_swap(__float_as_uint(pmax), __float_as_uint(pmax), false, false);
              pmax = fmaxf(__uint_as_float(rr[0]), __uint_as_float(rr[1])); }
            const float mn = fmaxf(m_reg, pmax);
            const float alpha = fast_exp2(m_reg - mn); m_reg = mn;
            float ps = 0.f;
#pragma unroll
            for (int r = 0; r < 16; ++r) { p0[r] = fast_exp2(p0[r] - mn); ps += p0[r]; }
#pragma unroll
            for (int r = 0; r < 16; ++r) { p1[r] = fast_exp2(p1[r] - mn); ps += p1[r]; }
            { auto rr = __builtin_amdgcn_permlane32_swap(__float_as_uint(ps), __float_as_uint(ps), false, false);
              ps = __uint_as_float(rr[0]) + __uint_as_float(rr[1]); }
            l_reg = l_reg * alpha + ps;
            bf16x8 pa0, pa1, pa2, pa3;
#define PK4(P, BASE, OUT) do { unsigned a0 = cvtpk(P[BASE + 0], P[BASE + 1]), a1 = cvtpk(P[BASE + 2], P[BASE + 3]);   \
    unsigned b0 = cvtpk(P[BASE + 4], P[BASE + 5]), b1 = cvtpk(P[BASE + 6], P[BASE + 7]);                              \
    auto r0 = __builtin_amdgcn_permlane32_swap(a0, b0, false, false); auto r1 = __builtin_amdgcn_permlane32_swap(a1, b1, false, false); \
    u32x4 w = {r0[0], r1[0], r0[1], r1[1]}; OUT = *reinterpret_cast<bf16x8*>(&w); } while (0)
            PK4(p0, 0, pa0); PK4(p0, 8, pa1); PK4(p1, 0, pa2); PK4(p1, 8, pa3);
#undef PK4
            if (__any(alpha < 1.f)) {
                if (hi == 0) al_l[r32] = alpha;
                asm volatile("s_waitcnt lgkmcnt(0)" ::: "memory");
#pragma unroll
                for (int r = 0; r < 16; ++r) { const float a = al_l[crow(r, hi)]; o[0][r] *= a; o[1][r] *= a; }
            }
            const int vb = vb0 + bsel * 16384;
            pv_one<0>(o[0], vb, pa0, pa1, pa2, pa3); pv_one<1>(o[1], vb, pa0, pa1, pa2, pa3);
        }
        if (j + 1 < NT) { if (bsel) SWRITE(0); else SWRITE(1); }
        __syncthreads();
    }
    if (hi == 0) li_l[r32] = l_reg;
    asm volatile("s_waitcnt lgkmcnt(0)" ::: "memory");
    const size_t tok0 = (size_t)b * SEQ + qb * 128 + wid * 32;
#pragma unroll
    for (int r = 0; r < 16; ++r) {
        const int orow = crow(r, hi); const float rl = fast_rcp(li_l[orow]);
        bf16_t* dst = MG + (tok0 + orow) * D + h * DV + r32;
        dst[0]  = (bf16_t)(cvtpk(o[0][r] * rl, 0.f) & 0xffffu);
        dst[32] = (bf16_t)(cvtpk(o[1][r] * rl, 0.f) & 0xffffu);
    }
#undef SLOAD
#undef SWRITE
}
DEV void phase3(const Ctx& c) {
    const int nslots = NB * NH * 4;
    float* scr = (float*)(c.lds + c.wid * 8448);
    const int gw = c.vcu * 4 + c.wid, NGW = c.G * 4;
    constexpr int NWI = 3 * 4096;
    int wi = gw;
#define EW_ITEMS(n) do { __syncthreads(); for (int _q = 0; _q < (n) && wi < NWI; ++_q, wi += NGW) expert_weight_item(c, wi, scr); } while (0)
    for (int v = c.vcu; v < nslots; v += c.G) {
        const int bh = v >> 2, s = v & 3, b = bh >> 3, h = bh & 7;
        attn_unit(c, b, h, 15 - s); EW_ITEMS(2); attn_unit(c, b, h, s); EW_ITEMS(1); attn_unit(c, b, h, 11 - s); EW_ITEMS(2); attn_unit(c, b, h, 4 + s); EW_ITEMS(1);
    }
    __syncthreads();
    for (; wi < NWI; wi += NGW) expert_weight_item(c, wi, scr);
#undef EW_ITEMS
}

DEV void phase4(const Ctx& c) {
    const bf16_t* MG = (const bf16_t*)(c.ws + WS_MG); const bf16_t* WoT = (const bf16_t*)(c.ws + WS_WO); const bf16_t* h0 = (const bf16_t*)(c.ws + WS_H0);
    bf16_t* R1 = (bf16_t*)(c.ws + WS_R1);
    const StageGeo g = stage_geo(c.tid);
    const int lane = c.lane, wr = c.wid >> 1, wc = c.wid & 1, fr = lane & 15, fq = lane >> 4;
    constexpr int NU = (TR / 128) * 8;
    for (int u = c.vcu; u < NU; u += c.G) {
        const int mt = u >> 3, nt = u & 7;
        const bf16_t* A = MG + (size_t)(mt * 128) * D + g.c; const bf16_t* B = WoT + (size_t)(nt * 128) * D + g.c;
        f32x4 acc[4][4];
        gemm_mainloop<true>(acc, A + (size_t)g.r[0] * D, A + (size_t)g.r[1] * D, A + (size_t)g.r[2] * D, A + (size_t)g.r[3] * D,
                            B + (size_t)g.r[0] * D, B + (size_t)g.r[1] * D, B + (size_t)g.r[2] * D, B + (size_t)g.r[3] * D, 16, c.lds, 8, 1.f / 512.f);
#pragma unroll
        for (int m = 0; m < 4; ++m) {
            const int tok = mt * 128 + wr * 64 + m * 16 + fr;
            const size_t t = (size_t)(tok >> 11) * L + NMETA + (tok & 2047);
#pragma unroll
            for (int n = 0; n < 4; ++n) {
                const int col = nt * 128 + wc * 64 + n * 16 + fq * 4;
                const u32x2 hw = *(const u32x2*)(h0 + t * D + col);
                f32x4 o; o[0] = ALPHA * bflo(hw.x) + acc[m][n][0]; o[1] = ALPHA * bfhi(hw.x) + acc[m][n][1];
                o[2] = ALPHA * bflo(hw.y) + acc[m][n][2]; o[3] = ALPHA * bfhi(hw.y) + acc[m][n][3];
                st_bf4(R1 + (size_t)tok * D + col, o);
            }
        }
    }
}

constexpr int P5_ROWB = 2064, P5_PART = 33280, P5_LG = 45568, P5_BIAS = 48128, P5_AGG = 48384;
DEV void phase5(const Ctx& c, int ALT = 0) {
    const bf16_t* R1 = (const bf16_t*)(c.ws + WS_R1); bf16_t* H1 = (bf16_t*)(c.ws + WS_H0);
    const bf16_t* WrT = (const bf16_t*)(c.ws + WS_WR);
    unsigned* cnt = (unsigned*)(c.ws + WS_CTL) + CW_CNT + ALT * 32; unsigned* list = (unsigned*)(c.ws + (ALT ? 404 * MiB : WS_LIST)); float* combw = (float*)(c.ws + WS_COMBW);
    const int lane = c.lane, wid = c.wid, fr = lane & 15, fq = lane >> 4;
    float* part = (float*)(c.lds + P5_PART); float* lgs = (float*)(c.lds + P5_LG); float* biasl = (float*)(c.lds + P5_BIAS);
    __syncthreads();
    if (c.tid < 36) biasl[c.tid] = (c.tid < 4) ? c.in[I_BRG][c.tid] : c.in[I_BRE][c.tid - 4];
    bf16x8 wf[8][3];
#pragma unroll
    for (int ks = 0; ks < 8; ++ks)
#pragma unroll
        for (int n = 0; n < 3; ++n) wf[ks][n] = *(const bf16x8*)(WrT + (size_t)(n * 16 + fr) * D + wid * 256 + ks * 32 + fq * 8);
    unsigned* lcnt = (unsigned*)(c.lds + P5_AGG); unsigned* lbase = lcnt + 32; unsigned* ent = lcnt + 64;
    if (c.tid < 32) lcnt[c.tid] = 0u;
    int nent = 0;
    for (int u = c.vcu; u < TR / 16; u += c.G) {
        const int tok0 = u * 16;
        { const float* src[4]; bf16_t* dst[4]; unsigned char* ldsn[4]; unsigned char* f8n[4];
#pragma unroll
          for (int i = 0; i < 4; ++i) { const int tl = wid * 4 + i; const size_t tok = tok0 + tl; src[i] = (const float*)(R1 + tok * D); dst[i] = H1 + tok * D; ldsn[i] = c.lds + tl * P5_ROWB; f8n[i] = c.ws + WS_H1F8 + tok * D; }
          ln_rows_bf16<4, true, true>(src, c.in[I_LN1G], c.in[I_LN1B], dst, ldsn, lane, f8n); }
        __syncthreads();
        f32x4 acc[3] = {};
#pragma unroll
        for (int ks = 0; ks < 8; ++ks) {
            const int k = wid * 256 + ks * 32 + fq * 8;
            const bf16x8 a = *(const bf16x8*)(c.lds + fr * P5_ROWB + k * 2);
#pragma unroll
            for (int n = 0; n < 3; ++n) acc[n] = __builtin_amdgcn_mfma_f32_16x16x32_bf16(wf[ks][n], a, acc[n], 0, 0, 0);
        }
#pragma unroll
        for (int n = 0; n < 3; ++n) *(f32x4*)(part + (wid * 16 + fr) * 48 + n * 16 + fq * 4) = acc[n];
        __syncthreads();
#pragma unroll
        for (int i = 0; i < 3; ++i) { const int idx = c.tid + 256 * i;
            if (idx < 576) { const int tk = idx / 36, l = idx - tk * 36;
                lgs[tk * 40 + l] = ((part[tk * 48 + l] + part[(16 + tk) * 48 + l]) + (part[(32 + tk) * 48 + l] + part[(48 + tk) * 48 + l])) + biasl[l]; } }
        __syncthreads();
        if (c.tid < 16) {
            const float* lg = lgs + c.tid * 40;
            int gi = 0; float gm = lg[0];
#pragma unroll
            for (int i = 1; i < 4; ++i) { const float v = lg[i]; if (v > gm) { gm = v; gi = i; } }
            float gs = 0.f;
#pragma unroll
            for (int i = 0; i < 4; ++i) gs += __expf(lg[i] - gm);
            const float gw = 1.f / gs;
            const float* le = lg + 4 + gi * 8;
            float v0 = le[0], v1 = -3.0e38f; int i0 = 0, i1 = 0;
#pragma unroll
            for (int i = 1; i < 8; ++i) { const float v = le[i];
                if (v > v0) { v1 = v0; i1 = i0; v0 = v; i0 = i; } else if (v > v1) { v1 = v; i1 = i; } }
            const float ex = __expf(v1 - v0), inv = 1.f / (1.f + ex);
            const int tok = tok0 + c.tid; const unsigned e0 = gi * 8 + i0, e1 = gi * 8 + i1;
            combw[tok * 2] = gw * inv; combw[tok * 2 + 1] = gw * ex * inv;
            const unsigned r0 = atomicAdd(&lcnt[e0], 1u), r1 = atomicAdd(&lcnt[e1], 1u);
            const int ei = nent * 32 + c.tid * 2;
            ent[2 * ei] = (unsigned)(tok * 2);         ent[2 * ei + 1] = (e0 << 16) | r0;
            ent[2 * ei + 2] = (unsigned)(tok * 2 + 1); ent[2 * ei + 3] = (e1 << 16) | r1;
        }
        ++nent;
    }
    __syncthreads();
    if (c.tid < 32) { const unsigned n = lcnt[c.tid]; lbase[c.tid] = n ? atomicAdd(&cnt[c.tid * CNT_STRIDE], n) : 0u; }
    __syncthreads();
    for (int i = c.tid; i < nent * 32; i += 256) { const unsigned t2 = ent[2 * i], er = ent[2 * i + 1]; const unsigned e = er >> 16;
        list[(size_t)e * TR + lbase[e] + (er & 0xffffu)] = t2; }
}
DEV void bar20(const Ctx& c) {}
DEV void moe_tiles(const Ctx& c) {
    const unsigned* cnt = (const unsigned*)(c.ws + WS_CTL) + CW_CNT; int* ts = (int*)(c.lds + EXP_OFF);
    __syncthreads();
    if (c.tid == 0) { int s = 0; for (int e = 0; e < NE; ++e) { ts[e] = s; s += (int)((__hip_atomic_load(&cnt[e * CNT_STRIDE], __ATOMIC_RELAXED, __HIP_MEMORY_SCOPE_AGENT) + 127u) >> 7); } ts[NE] = s; }
    __syncthreads();
}
DEV int moe_find(const int* ts, int rt) { int e = 0;
#pragma unroll 1
    for (int i = 1; i < NE; ++i) if (ts[i] <= rt) e = i;
    return e; }
DEV void phase6a(const Ctx& c) {
    const bf16_t* H18 = (const bf16_t*)(c.ws + WS_H1F8); const bf16_t* Wgu8 = (const bf16_t*)(c.ws + WS_WGU); unsigned char* ACT8 = c.ws + WS_ACT;
    const unsigned* cnt = (const unsigned*)(c.ws + WS_CTL) + CW_CNT; const unsigned* list = (const unsigned*)(c.ws + WS_LIST);
    moe_tiles(c);
    const int* ts = (const int*)(c.lds + EXP_OFF); unsigned* tbl = (unsigned*)(c.lds + TBL_OFF);
    const StageGeo g = stage_geo(c.tid);
    const int lane = c.lane, wr = c.wid >> 1, wc = c.wid & 1, fr = lane & 15, fq = lane >> 4;
    const int NU = ts[NE] * 4;
    for (int u = c.vcu; u < NU; u += c.G) {
        const int rt = u >> 2, nt = u & 3; const int e = moe_find(ts, rt);
        const int j0 = (rt - ts[e]) * 128; const int ne = (int)cnt[e * CNT_STRIDE];
        __syncthreads();
        if (c.tid < 128) { const int j = j0 + c.tid; tbl[c.tid] = (j < ne) ? list[(size_t)e * TR + j] : 0xffffffffu; }
        __syncthreads();
        size_t ro[4];
#pragma unroll
        for (int i = 0; i < 4; ++i) { const unsigned en = tbl[g.r[i]]; ro[i] = (en == 0xffffffffu) ? 0 : (size_t)(en >> 1) * (D / 2); }
        const bf16_t* A = H18 + g.c; const bf16_t* B = Wgu8 + ((size_t)e * 512 + nt * 128) * (D / 2) + g.c;
        f32x4 acc[4][4];
        gemm_mainloop<false, true>(acc, A + ro[0], A + ro[1], A + ro[2], A + ro[3],
                             B + (size_t)g.r[0] * (D / 2), B + (size_t)g.r[1] * (D / 2), B + (size_t)g.r[2] * (D / 2), B + (size_t)g.r[3] * (D / 2), 8, c.lds, 0, 0.f);
#pragma unroll
        for (int m = 0; m < 4; ++m) { const size_t row = (size_t)rt * 128 + wr * 64 + m * 16 + fr;
#pragma unroll
            for (int i = 0; i < 2; ++i) {
                const f32x4 gt = acc[m][2 * i], up = acc[m][2 * i + 1]; f32x4 o;
#pragma unroll
                for (int j = 0; j < 4; ++j) { const float gv = gt[j] * WUNSCALE; o[j] = gv * sigmoidf_(gv) * (up[j] * WUNSCALE); }
                *(unsigned*)(ACT8 + row * DE + nt * 64 + wc * 32 + i * 16 + fq * 4) = pk_fp8x4(o[0], o[1], o[2], o[3]);
            } }
    }
}
DEV void phase6b(const Ctx& c) {
    const bf16_t* ACT8 = (const bf16_t*)(c.ws + WS_ACT); const bf16_t* Wd8 = (const bf16_t*)(c.ws + WS_WD); unsigned char* Y8 = c.ws + WS_Y;
    const unsigned* cnt = (const unsigned*)(c.ws + WS_CTL) + CW_CNT; const unsigned* list = (const unsigned*)(c.ws + WS_LIST); const float* combw = (const float*)(c.ws + WS_COMBW);
    moe_tiles(c);
    const int* ts = (const int*)(c.lds + EXP_OFF); unsigned* tbl = (unsigned*)(c.lds + TBL_OFF);
    const StageGeo g = stage_geo(c.tid);
    const int lane = c.lane, wr = c.wid >> 1, wc = c.wid & 1, fr = lane & 15, fq = lane >> 4;
    const int NU = ts[NE] * 8;
    for (int u = c.vcu; u < NU; u += c.G) {
        const int rt = u >> 3, nt = u & 7; const int e = moe_find(ts, rt);
        const int j0 = (rt - ts[e]) * 128; const int ne = (int)cnt[e * CNT_STRIDE];
        __syncthreads();
        if (c.tid < 128) { const int j = j0 + c.tid; tbl[c.tid] = (j < ne) ? list[(size_t)e * TR + j] : 0xffffffffu; }
        const bf16_t* A = ACT8 + (size_t)(rt * 128) * (DE / 2) + g.c; const bf16_t* B = Wd8 + ((size_t)e * 1024 + nt * 128) * (DE / 2) + g.c;
        f32x4 acc[4][4];
        gemm_mainloop<false, true>(acc, A + (size_t)g.r[0] * (DE / 2), A + (size_t)g.r[1] * (DE / 2), A + (size_t)g.r[2] * (DE / 2), A + (size_t)g.r[3] * (DE / 2),
                             B + (size_t)g.r[0] * (DE / 2), B + (size_t)g.r[1] * (DE / 2), B + (size_t)g.r[2] * (DE / 2), B + (size_t)g.r[3] * (DE / 2), 2, c.lds, 0, 0.f);
#pragma unroll
        for (int m = 0; m < 4; ++m) {
            const unsigned en = tbl[wr * 64 + m * 16 + fr];
            if (en != 0xffffffffu) {
                const float w = combw[en] * (WUNSCALE * YSCALE); unsigned char* dst = Y8 + ((size_t)(en & 1u) * TR + (en >> 1)) * D + nt * 128 + wc * 64 + fq * 4;
#pragma unroll
                for (int n = 0; n < 4; ++n) { const f32x4 o = acc[m][n] * w; *(unsigned*)(dst + n * 16) = pk_fp8x4(o[0], o[1], o[2], o[3]); }
            }
        }
    }
}

DEV void phase7(const Ctx& c) {
    const bf16_t* H1 = (const bf16_t*)(c.ws + WS_H0); const unsigned char* Y8 = c.ws + WS_Y;
    const float* g = c.in[I_LN2G]; const float* bt = c.in[I_LN2B];
    const int gw = c.vcu * 4 + c.wid, NGW = c.G * 4, lane = c.lane;
    for (int tok0 = gw; tok0 < TR; tok0 += 2 * NGW) {
        float v[2][16]; float st[2]; int tk[2];
#pragma unroll
        for (int r = 0; r < 2; ++r) {
            int tok = tok0 + r * NGW; if (tok >= TR) tok = tok0; tk[r] = tok;
#pragma unroll
            for (int i = 0; i < 2; ++i) {
                const u32x4 hw = *(const u32x4*)(H1 + (size_t)tok * D + i * 512 + lane * 8);
                const u32x2 y0 = *(const u32x2*)(Y8 + (size_t)tok * D + i * 512 + lane * 8);
                const u32x2 y1 = *(const u32x2*)(Y8 + ((size_t)TR + tok) * D + i * 512 + lane * 8);
#pragma unroll
                for (int q2 = 0; q2 < 2; ++q2) {
                    const auto a0 = __builtin_amdgcn_cvt_pk_f32_fp8((int)y0[q2], false), a1 = __builtin_amdgcn_cvt_pk_f32_fp8((int)y0[q2], true);
                    const auto b0 = __builtin_amdgcn_cvt_pk_f32_fp8((int)y1[q2], false), b1 = __builtin_amdgcn_cvt_pk_f32_fp8((int)y1[q2], true);
                    v[r][i * 8 + 4 * q2]     = ALPHA * bflo(hw[2 * q2]) + (a0[0] + b0[0]) * YUNSCALE;
                    v[r][i * 8 + 4 * q2 + 1] = ALPHA * bfhi(hw[2 * q2]) + (a0[1] + b0[1]) * YUNSCALE;
                    v[r][i * 8 + 4 * q2 + 2] = ALPHA * bflo(hw[2 * q2 + 1]) + (a1[0] + b1[0]) * YUNSCALE;
                    v[r][i * 8 + 4 * q2 + 3] = ALPHA * bfhi(hw[2 * q2 + 1]) + (a1[1] + b1[1]) * YUNSCALE;
                }
            }
        }
#pragma unroll
        for (int r = 0; r < 2; ++r) { float a = 0.f;
#pragma unroll
            for (int q = 0; q < 16; ++q) a += v[r][q];
            st[r] = a; }
        wave_sum_n<2>(st);
#pragma unroll
        for (int r = 0; r < 2; ++r) { const float mean = st[r] * (1.f / 1024.f); float a = 0.f;
#pragma unroll
            for (int q = 0; q < 16; ++q) { v[r][q] -= mean; a += v[r][q] * v[r][q]; }
            st[r] = a; }
        wave_sum_n<2>(st);
#pragma unroll
        for (int i = 0; i < 2; ++i)
#pragma unroll
            for (int q = 0; q < 2; ++q) {
                const int col = i * 512 + lane * 8 + q * 4;
                const f32x4 gg = *(const f32x4*)(g + col), bb = *(const f32x4*)(bt + col);
#pragma unroll
                for (int r = 0; r < 2; ++r) {
                    if (r == 1 && tok0 + NGW >= TR) continue;
                    const float rstd = rsqrt_(st[r] * (1.f / 1024.f) + EPS);
                    f32x4 o; o[0] = v[r][i * 8 + q * 4] * rstd * gg[0] + bb[0]; o[1] = v[r][i * 8 + q * 4 + 1] * rstd * gg[1] + bb[1];
                    o[2] = v[r][i * 8 + q * 4 + 2] * rstd * gg[2] + bb[2]; o[3] = v[r][i * 8 + q * 4 + 3] * rstd * gg[3] + bb[3];
                    *(f32x4*)(c.out + (size_t)tk[r] * D + col) = o;
                }
            }
    }
}

__global__ void __launch_bounds__(256, 2) fwd_kernel(Args a) {
    extern __shared__ __attribute__((aligned(16))) unsigned char lds[];
    Ctx c; c.in = a.in; c.out = a.out; c.ws = a.ws; c.lds = lds;
    c.tid = threadIdx.x; c.lane = c.tid & 63; c.wid = __builtin_amdgcn_readfirstlane(c.tid >> 6);
    c.G = gridDim.x; { const int bx = blockIdx.x; c.vcu = (c.G % 8 == 0) ? (bx % 8) * (c.G / 8) + bx / 8 : bx; }
    if (c.tid < 64) ((unsigned*)(lds + MISC_OFF))[c.tid] = 0u;
    __syncthreads();
    unsigned* ctl = (unsigned*)(a.ws + WS_CTL);
    XcdBarrier bar = xcd_barrier_post(ctl + CW_BAR, (volatile LAS unsigned*)(lds + MISC_OFF));
#ifdef ONLY_PH
#define PH_ON(k) ((k) == ONLY_PH)
#else
#define PH_ON(k) 1
#endif
    const int lo = a.ph_lo, hi = a.ph_hi;
#define RUN_PHASE(k, fn) if (PH_ON(k) && lo <= (k) && (k) < hi) { \
        for (int _rep = 0; _rep < ((REPEAT_PH == (k)) ? 2 : 1); ++_rep) { \
            int _t = threadIdx.x; asm volatile("" : "+v"(_t)); c.tid = _t; c.lane = _t & 63; c.wid = __builtin_amdgcn_readfirstlane(_t >> 6); \
            if ((k) == 5) phase5(c, _rep); else fn(c); \
            if (_rep == 0 && REPEAT_PH == (k)) xcd_barrier(bar); } \
        if ((k) + 1 < hi) xcd_barrier(bar); }
    RUN_PHASE(0, phase0)
    RUN_PHASE(1, phase1)
    RUN_PHASE(2, phase2)
    RUN_PHASE(3, phase3)
    RUN_PHASE(4, phase4)
    RUN_PHASE(5, phase0)
    RUN_PHASE(6, phase6a)
    RUN_PHASE(7, phase6b)
    RUN_PHASE(8, phase7)
}

extern "C" void kernel_launch(void* const* d_in, const int* in_sizes, int n_in, void* d_out, int out_size, void* d_ws, size_t ws_size, hipStream_t stream) {
    static int grid = 0;
    if (grid == 0) {
        if (n_in != 27 || in_sizes[0] != NB * SEQ * D || out_size != TR * D || ws_size < WS_END) {
            fprintf(stderr, "kernel_launch: shape mismatch n_in %d in0 %d out %d ws %zu\n", n_in, n_in > 0 ? in_sizes[0] : -1, out_size, ws_size); grid = -1; return; }
        int dev = 0, cus = 0, per_cu = 0;
        if (hipGetDevice(&dev) != hipSuccess || hipDeviceGetAttribute(&cus, hipDeviceAttributeMultiprocessorCount, dev) != hipSuccess) { grid = -1; return; }
        if (hipFuncSetAttribute((const void*)fwd_kernel, hipFuncAttributeMaxDynamicSharedMemorySize, LDS_BYTES) != hipSuccess) { grid = -1; return; }
        if (hipOccupancyMaxActiveBlocksPerMultiprocessor(&per_cu, (const void*)fwd_kernel, 256, LDS_BYTES) != hipSuccess || per_cu < 1) per_cu = 1;
        (void)hipGetLastError();
        if (per_cu > 2) per_cu = 2;
        grid = cus * per_cu;
        fprintf(stderr, "kernel_launch: grid %d (%d per CU)\n", grid, per_cu);
    }
    if (grid < 0) return;
    (void)hipMemsetAsync((char*)d_ws + WS_CTL, 0, CTL_ZERO_BYTES, stream);
    Args a{};
    for (int i = 0; i < 27; ++i) a.in[i] = (const float*)d_in[i];
    a.out = (float*)d_out; a.ws = (unsigned char*)d_ws;
    if (MK_N_LAUNCHES == 1) {
        a.ph_lo = 0; a.ph_hi = NPH;
        hipLaunchKernelGGL(fwd_kernel, dim3(grid), dim3(256), LDS_BYTES, stream, a);
    } else {
        for (int ph = 0; ph < NPH; ++ph) { a.ph_lo = ph; a.ph_hi = ph + 1; hipLaunchKernelGGL(fwd_kernel, dim3(grid), dim3(256), LDS_BYTES, stream, a); }
    }
}
```

```cpp
#include <hip/hip_runtime.h>
#include <cstdio>
#include <cstdint>

#ifndef REPEAT_PH
#define REPEAT_PH -1
#endif
#ifndef CONV_REPB
#define CONV_REPB 1
#endif
#ifndef CONV_REPC
#define CONV_REPC 1
#endif
#ifndef CONV_REPA
#define CONV_REPA 1
#endif
#ifndef MK_N_LAUNCHES
#define MK_N_LAUNCHES 1
#endif

#define DEV __device__ __forceinline__
#define LAS __attribute__((address_space(3)))
#define GAS __attribute__((address_space(1)))
typedef unsigned short bf16_t;
typedef short bf16x8 __attribute__((ext_vector_type(8)));
typedef short s16x4 __attribute__((ext_vector_type(4)));
typedef float f32x4 __attribute__((ext_vector_type(4)));
typedef float f32x16 __attribute__((ext_vector_type(16)));
typedef unsigned u32x4 __attribute__((ext_vector_type(4)));
typedef unsigned u32x2 __attribute__((ext_vector_type(2)));
typedef long i64x2 __attribute__((ext_vector_type(2)));
typedef int v8i __attribute__((ext_vector_type(8)));

constexpr int NB = 16, SEQ = 2048, NMETA = 16, L = SEQ + NMETA;
constexpr int T = NB * L;
constexpr int TR = NB * SEQ;
constexpr int D = 1024, NIN = 1696, CC = 512, QL = 384, KVL = 256, NH = 8, DQK = 96, DV = 64;
constexpr int NQ = NH * DQK;
constexpr int NKV = NH * (64 + DV);
constexpr int NE = 32, DE = 256, CONVK = 31;
constexpr float EPS = 1e-5f;
constexpr float ALPHA = 1.189207115002721f;
constexpr float QSCALE = 0.10206207261596577f * 1.4426950408889634f;
constexpr int NPH = 9;
constexpr float WSCALE = 16.f, WUNSCALE = 1.f / 16.f;
constexpr float YSCALE = 64.f, YUNSCALE = 1.f / 64.f;

constexpr size_t MiB = 1u << 20;
constexpr size_t WS_CTL = 0, CTL_ZERO_BYTES = 64 * 1024;
constexpr int CW_CNT = 1024, CNT_STRIDE = 64;
constexpr int CW_BAR = 4096;
constexpr size_t WS_LIST = 1 * MiB;
constexpr size_t WS_COMBW = 5 * MiB;
constexpr size_t WS_ROPE = 5 * MiB + 512 * 1024;
constexpr size_t WS_WIN = 6 * MiB;
constexpr size_t WS_WUQ = 10 * MiB;
constexpr size_t WS_WUKV = 11 * MiB;
constexpr size_t WS_WO = 12 * MiB;
constexpr size_t WS_WR = 14 * MiB;
constexpr size_t WS_RI = 14 * MiB + 512 * 1024;
constexpr size_t WS_WGU = 16 * MiB;
constexpr size_t WS_WD = 48 * MiB;
constexpr size_t WS_H1F8 = 130 * MiB;
constexpr size_t WS_H0 = 64 * MiB;
constexpr size_t WS_U = 130 * MiB;
constexpr size_t WS_CQ = 163 * MiB;
constexpr size_t WS_CKV = 188 * MiB;
constexpr size_t WS_KR = 205 * MiB;
constexpr size_t WS_Q = 208 * MiB;
constexpr size_t WS_KV = 257 * MiB;
constexpr size_t WS_R1 = 208 * MiB;
constexpr size_t WS_Y = 208 * MiB;
constexpr size_t WS_MG = 336 * MiB;
constexpr size_t WS_ACT = 336 * MiB;
constexpr size_t WS_DUMMY = 400 * MiB;
constexpr size_t WS_END = 401 * MiB;

constexpr int LDS_BYTES = 73728;
constexpr int MISC_OFF = LDS_BYTES - 256;
constexpr int RS_OFF = 65536;
constexpr int TBL_OFF = 66048;
constexpr int EXP_OFF = 67584;

DEV unsigned cvtpk(float lo, float hi) { unsigned r; asm("v_cvt_pk_bf16_f32 %0, %1, %2" : "=v"(r) : "v"(lo), "v"(hi)); return r; }
DEV float bflo(unsigned w) { return __uint_as_float(w << 16); }
DEV float bfhi(unsigned w) { return __uint_as_float(w & 0xffff0000u); }
DEV float dpp_add_qp(float v, int) { return v; }
template <int CTRL> DEV float dpp_mov(float v) { return __builtin_bit_cast(float, __builtin_amdgcn_update_dpp(0, __builtin_bit_cast(int, v), CTRL, 0xf, 0xf, false)); }
DEV float wave_sum(float v) {
    v += dpp_mov<0xB1>(v);
    v += dpp_mov<0x4E>(v);
    v += dpp_mov<0x141>(v);
    v += dpp_mov<0x140>(v);
    const int iv = __builtin_bit_cast(int, v);
    const float a = __builtin_bit_cast(float, __builtin_amdgcn_readlane(iv, 0)), b = __builtin_bit_cast(float, __builtin_amdgcn_readlane(iv, 16));
    const float c = __builtin_bit_cast(float, __builtin_amdgcn_readlane(iv, 32)), d = __builtin_bit_cast(float, __builtin_amdgcn_readlane(iv, 48));
    return (a + b) + (c + d);
}
DEV float rsqrt_(float x) { return __builtin_amdgcn_rsqf(x); }
DEV void st_bf4(bf16_t* p, f32x4 v) { u32x2 w = {cvtpk(v[0], v[1]), cvtpk(v[2], v[3])}; *(u32x2*)p = w; }
DEV unsigned pk_fp8x4(float a, float b, float c, float d) {
    int w = __builtin_amdgcn_cvt_pk_fp8_f32(a, b, 0, false); w = __builtin_amdgcn_cvt_pk_fp8_f32(c, d, w, true); return (unsigned)w; }
DEV float fast_exp2(float x) { return __builtin_amdgcn_exp2f(x); }
DEV float fast_rcp(float x) { return __builtin_amdgcn_rcpf(x); }
DEV float sigmoidf_(float g) { return fast_rcp(1.f + fast_exp2(-1.4426950408889634f * g)); }
#define LDS_WAIT() asm volatile("s_waitcnt lgkmcnt(0)" ::: "memory")
#define VM_WAIT() asm volatile("s_waitcnt vmcnt(0)" ::: "memory")

#define XB_TMO      128
#define XB_XCNT(j)  (256  + 64 * (j))
#define XB_XSUB(j)  (1280 + 64 * (j))
#define XB_XGEN(j)  (2304 + 64 * (j))
#define XB_TOP      3328
#define XB_TOPGEN   3392
#define XCD_BAR_WORDS 3456
#define XB_SPIN_CAP (1u << 22)
DEV unsigned xb_ld(unsigned* p)              { return __hip_atomic_load(p, __ATOMIC_RELAXED, __HIP_MEMORY_SCOPE_AGENT); }
DEV unsigned xb_add(unsigned* p, unsigned v) { return __hip_atomic_fetch_add(p, v, __ATOMIC_RELAXED, __HIP_MEMORY_SCOPE_AGENT); }
DEV unsigned xb_xcc_id() { return (unsigned)__builtin_amdgcn_s_getreg((3 << 11) | 20) & 0xFu; }
#define XB_SPIN(cond, bar) do { unsigned _sp = 0; while (cond) { __builtin_amdgcn_s_sleep(1); \
    if ((++_sp & 255u) == 0u) { if (xb_ld(&(bar)[XB_TMO])) break; if (_sp > XB_SPIN_CAP) { atomicAdd(&(bar)[XB_TMO], 1u); break; } } } } while (0)
struct XcdBarrier { unsigned* bar; unsigned x; volatile LAS unsigned* st; };
DEV XcdBarrier xcd_barrier_post(unsigned* bar, volatile LAS unsigned* st) {
    XcdBarrier b; b.bar = bar; b.x = xb_xcc_id(); b.st = st;
    if (threadIdx.x == 0) (void)xb_add(&bar[XB_XCNT(b.x)], 1u);
    return b;
}
DEV void xcd_barrier_complete(unsigned* bar, unsigned x, unsigned& nloc, unsigned& nx) {
    const unsigned G = gridDim.x * gridDim.y * gridDim.z;
    unsigned sum, cnt, mine, sp = 0u;
    for (;;) {
        sum = 0u; cnt = 0u; mine = 0u;
#pragma unroll
        for (unsigned j = 0; j < 16; ++j) { const unsigned c = xb_ld(&bar[XB_XCNT(j)]); sum += c; cnt += (c > 0u) ? 1u : 0u; mine = (j == x) ? c : mine; }
        if (sum == G) break;
        __builtin_amdgcn_s_sleep(1);
        if ((++sp & 255u) == 0u) { if (xb_ld(&bar[XB_TMO])) break; if (sp > XB_SPIN_CAP) { atomicAdd(&bar[XB_TMO], 1u); break; } }
    }
    nloc = mine > 0u ? mine : 1u; nx = cnt > 0u ? cnt : 1u;
}
DEV void xcd_barrier(const XcdBarrier& b) {
    asm volatile("s_waitcnt vmcnt(0)" ::: "memory");
    __syncthreads();
    if (threadIdx.x == 0) {
        unsigned* bar = b.bar;
        __builtin_amdgcn_s_waitcnt(0);
        unsigned nloc = b.st[0], nx = b.st[1];
        if (nloc == 0u) { xcd_barrier_complete(bar, b.x, nloc, nx); b.st[0] = nloc; b.st[1] = nx; }
        const unsigned old = xb_add(&bar[XB_XSUB(b.x)], 1u);
        const unsigned gen = old / nloc;
        if (old + 1u == (gen + 1u) * nloc) {
            __builtin_amdgcn_fence(__ATOMIC_RELEASE, "agent");
            asm volatile("s_waitcnt vmcnt(0)" ::: "memory");
            const unsigned og = xb_add(&bar[XB_TOP], 1u);
            const unsigned tg = og / nx;
            if (og + 1u == (tg + 1u) * nx) xb_add(&bar[XB_TOPGEN], 1u);
            else XB_SPIN(xb_ld(&bar[XB_TOPGEN]) == tg, bar);
            __builtin_amdgcn_fence(__ATOMIC_ACQUIRE, "agent");
            xb_add(&bar[XB_XGEN(b.x)], 1u);
            asm volatile("s_waitcnt vmcnt(0)" ::: "memory");
        } else {
            XB_SPIN(xb_ld(&bar[XB_XGEN(b.x)]) == gen, bar);
            __builtin_amdgcn_fence(__ATOMIC_ACQUIRE, "agent");
            asm volatile("s_waitcnt vmcnt(0)" ::: "memory");
        }
    }
    __syncthreads();
}

struct Args { const float* in[27]; float* out; unsigned char* ws; int ph_lo, ph_hi; };
struct Ctx {
    const float* const* in; float* out; unsigned char* ws; unsigned char* lds;
    int tid, lane, wid, vcu, G;
};
enum { I_X = 0, I_META, I_LNIN_G, I_LNIN_B, I_WIN, I_CONVW, I_CONVB, I_CLN_G, I_CLN_B, I_QNG, I_WUQ, I_KVNG, I_WUKV, I_COUT_G, I_AOUT_G, I_WO,
       I_LN1G, I_LN1B, I_WRG, I_BRG, I_WRE, I_BRE, I_WGATE, I_WUP, I_WDOWN, I_LN2G, I_LN2B };

DEV int nmap(int mode, int n) {
    if (mode == 1) { if (n < 512) return ((n >> 4) << 5) + (n & 15); if (n < 1024) return (((n - 512) >> 4) << 5) + 16 + (n & 15); return n; }
    if (mode == 2) return ((n >> 4) << 5) + (n & 15);
    if (mode == 3) return ((n >> 4) << 5) + 16 + (n & 15);
    return n;
}
DEV void p0_transpose_item(const float* __restrict__ W, int N, int k0, int n0, const float* __restrict__ kscale, bf16_t* WT, int ldt, int kout0, int mode,
                           float* scr, int lane) {
#pragma unroll 8
    for (int i = 0; i < 32; ++i) {
        const int kk = 2 * i + (lane >> 5);
        float v = W[(size_t)(k0 + kk) * N + n0 + (lane & 31)];
        if (kscale) v *= kscale[k0 + kk];
        scr[kk * 33 + (lane & 31)] = v;
    }
    LDS_WAIT(); asm volatile("" ::: "memory");
    const int c = lane & 7;
#pragma unroll
    for (int j = 0; j < 4; ++j) {
        const int n = (lane >> 3) + 8 * j; const float* s = scr + (8 * c) * 33 + n;
        u32x4 o; o.x = cvtpk(s[0 * 33], s[1 * 33]); o.y = cvtpk(s[2 * 33], s[3 * 33]); o.z = cvtpk(s[4 * 33], s[5 * 33]); o.w = cvtpk(s[6 * 33], s[7 * 33]);
        *(u32x4*)(WT + (size_t)nmap(mode, n0 + n) * ldt + kout0 + 8 * c) = o;
    }
    LDS_WAIT(); asm volatile("" ::: "memory");
}
DEV void p0_transpose_item_f8(const float* __restrict__ W, int N, int k0, int n0, float scale, unsigned char* W8, int ldt, int kout0, int mode, float* scr, int lane) {
#pragma unroll 8
    for (int i = 0; i < 32; ++i) { const int kk = 2 * i + (lane >> 5); scr[kk * 33 + (lane & 31)] = W[(size_t)(k0 + kk) * N + n0 + (lane & 31)] * scale; }
    LDS_WAIT(); asm volatile("" ::: "memory");
    const int c = lane & 7;
#pragma unroll
    for (int j = 0; j < 4; ++j) {
        const int n = (lane >> 3) + 8 * j; const float* sp = scr + (8 * c) * 33 + n;
        u32x2 o; o.x = pk_fp8x4(sp[0 * 33], sp[1 * 33], sp[2 * 33], sp[3 * 33]); o.y = pk_fp8x4(sp[4 * 33], sp[5 * 33], sp[6 * 33], sp[7 * 33]);
        *(u32x2*)(W8 + (size_t)nmap(mode, n0 + n) * ldt + kout0 + 8 * c) = o;
    }
    LDS_WAIT(); asm volatile("" ::: "memory");
}
template <int N> DEV void wave_sum_n(float (&v)[N]) {
#pragma unroll
    for (int i = 0; i < N; ++i) v[i] = wave_sum(v[i]);
}
template <int NR, bool F8 = false, bool BFIN = false> DEV void ln_rows_bf16(const float* const (&xrow)[NR], const float* g, const float* bta, bf16_t* const (&orow)[NR], unsigned char* const (&ldsrow)[NR], int lane, unsigned char* const* f8row = nullptr) {
    f32x4 v[NR][4]; float s[NR];
#pragma unroll
    for (int r = 0; r < NR; ++r)
#pragma unroll
        for (int j = 0; j < 4; ++j) {
            if (BFIN) { const u32x2 w = ((const u32x2*)xrow[r])[64 * j + lane]; v[r][j] = (f32x4){bflo(w.x), bfhi(w.x), bflo(w.y), bfhi(w.y)}; }
            else v[r][j] = ((const f32x4*)xrow[r])[64 * j + lane]; }
#pragma unroll
    for (int r = 0; r < NR; ++r) { s[r] = 0.f;
#pragma unroll
        for (int j = 0; j < 4; ++j) s[r] += (v[r][j].x + v[r][j].y) + (v[r][j].z + v[r][j].w); }
    wave_sum_n<NR>(s);
    float s2[NR];
#pragma unroll
    for (int r = 0; r < NR; ++r) { const float mean = s[r] * (1.f / 1024.f); s2[r] = 0.f;
#pragma unroll
        for (int j = 0; j < 4; ++j) { v[r][j] = v[r][j] - mean; s2[r] += (v[r][j].x * v[r][j].x + v[r][j].y * v[r][j].y) + (v[r][j].z * v[r][j].z + v[r][j].w * v[r][j].w); } }
    wave_sum_n<NR>(s2);
#pragma unroll
    for (int j = 0; j < 4; ++j) {
        const f32x4 gg = ((const f32x4*)g)[64 * j + lane], bb = ((const f32x4*)bta)[64 * j + lane];
#pragma unroll
        for (int r = 0; r < NR; ++r) {
            const float rstd = rsqrt_(s2[r] * (1.f / 1024.f) + EPS);
            const f32x4 o = v[r][j] * rstd * gg + bb;
            const u32x2 w = {cvtpk(o.x, o.y), cvtpk(o.z, o.w)};
            ((u32x2*)orow[r])[64 * j + lane] = w;
            if (ldsrow[r]) ((u32x2*)ldsrow[r])[64 * j + lane] = w;
            if (F8) ((unsigned*)f8row[r])[64 * j + lane] = pk_fp8x4(o.x, o.y, o.z, o.w);
        }
    }
}
__device__ const float INVF[16] = {1.0f, 0.5623413251903491f, 0.31622776601683794f, 0.1778279410038923f, 0.1f, 0.05623413251903491f, 0.031622776601683794f,
    0.01778279410038923f, 0.01f, 0.005623413251903491f, 0.0031622776601683794f, 0.001778279410038923f, 0.001f, 0.0005623413251903491f, 0.00031622776601683794f, 0.0001778279410038923f};
DEV void sincos_d(double a, float& sn, float& cs) {
    const double TWO_PI = 6.283185307179586476925286766559;
    const double k = __builtin_rint(a / TWO_PI);
    const double r = a - k * TWO_PI;
    const double r2 = r * r;
    double st = r, ct = 1.0, ssum = r, csum = 1.0;
#pragma unroll 1
    for (int i = 1; i <= 14; ++i) {
        ct = -ct * r2 / (double)((2 * i - 1) * (2 * i));  csum += ct;
        st = -st * r2 / (double)((2 * i) * (2 * i + 1));  ssum += st;
    }
    sn = (float)ssum; cs = (float)csum;
}
DEV void expert_weight_item(const Ctx& c, int r, float* scr) {
    constexpr int I_G = 32 * 128;
    unsigned char* Wgu8 = c.ws + WS_WGU; unsigned char* Wd8 = c.ws + WS_WD;
    if (r < I_G) { const int e = r >> 7, q = r & 127, kb = q >> 3, nb = q & 7;
        p0_transpose_item_f8(c.in[I_WGATE] + (size_t)e * D * DE, DE, 64 * kb, 32 * nb, WSCALE, Wgu8 + (size_t)e * 512 * 1024, 1024, 64 * kb, 2, scr, c.lane); return; } r -= I_G;
    if (r < I_G) { const int e = r >> 7, q = r & 127, kb = q >> 3, nb = q & 7;
        p0_transpose_item_f8(c.in[I_WUP] + (size_t)e * D * DE, DE, 64 * kb, 32 * nb, WSCALE, Wgu8 + (size_t)e * 512 * 1024, 1024, 64 * kb, 3, scr, c.lane); return; } r -= I_G;
    { const int e = r >> 7, q = r & 127, kb = q >> 5, nb = q & 31;
        p0_transpose_item_f8(c.in[I_WDOWN] + (size_t)e * DE * D, D, 64 * kb, 32 * nb, WSCALE, Wd8 + (size_t)e * 1024 * 256, 256, 64 * kb, 0, scr, c.lane); }
}
DEV void phase0(const Ctx& c) {
    float* scr = (float*)(c.lds + c.wid * 8448);
    const int gw = c.vcu * 4 + c.wid, NGW = c.G * 4;
    constexpr int I_IN = 16 * 53, I_UQ = 6 * 24, I_UKV = 4 * 32, I_O = 16 * 32;
    bf16_t* WinT = (bf16_t*)(c.ws + WS_WIN); bf16_t* WuqT = (bf16_t*)(c.ws + WS_WUQ); bf16_t* WukvT = (bf16_t*)(c.ws + WS_WUKV);
    bf16_t* WoT = (bf16_t*)(c.ws + WS_WO);
    constexpr int NITEMS0 = I_IN + I_UQ + I_UKV + I_O;
    for (int it = gw; it < NITEMS0; it += NGW) {
        int r = it;
        if (r < I_IN) { const int kb = r / 53, nb = r % 53; p0_transpose_item(c.in[I_WIN], NIN, 64 * kb, 32 * nb, nullptr, WinT, 1024, 64 * kb, 1, scr, c.lane); continue; } r -= I_IN;
        if (r < I_UQ) { const int kb = r / 24, nb = r % 24; p0_transpose_item(c.in[I_WUQ], NQ, 64 * kb, 32 * nb, c.in[I_QNG], WuqT, QL, 64 * kb, 0, scr, c.lane); continue; } r -= I_UQ;
        if (r < I_UKV) { const int kb = r / 32, nb = r % 32; p0_transpose_item(c.in[I_WUKV], NKV, 64 * kb, 32 * nb, c.in[I_KVNG], WukvT, KVL, 64 * kb, 0, scr, c.lane); continue; } r -= I_UKV;
        { const int kb = r / 32, nb = r % 32;
            if (kb < 8) p0_transpose_item(c.in[I_WO], D, 64 * kb, 32 * nb, nullptr, WoT, 1024, 64 * kb + 512, 0, scr, c.lane);
            else        p0_transpose_item(c.in[I_WO], D, 64 * kb, 32 * nb, c.in[I_AOUT_G] - 512, WoT, 1024, 64 * kb - 512, 0, scr, c.lane); }
    }
    const int gt = c.vcu * 256 + c.tid, NGT = c.G * 256;
    bf16_t* WrT = (bf16_t*)(c.ws + WS_WR);
    for (int i = gt; i < 48 * 1024; i += NGT) {
        const int n = i >> 10, k = i & 1023; float v = 0.f;
        if (n < 4) v = c.in[I_WRG][k * 4 + n]; else if (n < 36) v = c.in[I_WRE][k * 32 + (n - 4)];
        WrT[i] = (bf16_t)(cvtpk(v, 0.f) & 0xffffu);
    }
    float* rc = (float*)(c.ws + WS_ROPE); float* rs = rc + L * 16;
    for (int i = gt; i < L * 16; i += NGT) {
        const int p = i >> 4, f = i & 15; const float ang = (float)p * INVF[f];
        float sn, cs; sincos_d((double)ang, sn, cs); rc[i] = cs; rs[i] = sn;
    }
    bf16_t* h0 = (bf16_t*)(c.ws + WS_H0);
    for (int t = gw; t < T; t += 2 * NGW) {
        const float* src[2]; bf16_t* dst[2]; unsigned char* ldsn[2] = {nullptr, nullptr};
#pragma unroll
        for (int r = 0; r < 2; ++r) { int tt = t + r * NGW; if (tt >= T) tt = t;
            const int b = tt / L, p = tt - b * L;
            src[r] = (p < NMETA) ? c.in[I_META] + (size_t)p * D : c.in[I_X] + ((size_t)b * SEQ + (p - NMETA)) * D;
            dst[r] = h0 + (size_t)tt * D; }
        ln_rows_bf16<2>(src, c.in[I_LNIN_G], c.in[I_LNIN_B], dst, ldsn, c.lane);
    }
}

struct StageGeo { int r[4]; int c; };
DEV StageGeo stage_geo(int tid) {
    const int lane = tid & 63, wid = tid >> 6; StageGeo g;
    const int f = ((wid & 1) << 2) | (lane >> 4);
#pragma unroll
    for (int i = 0; i < 4; ++i) g.r[i] = (wid + 4 * i) * 8 + (lane >> 3);
    g.c = ((lane & 7) ^ f) * 8;
    return g;
}
template <bool SSQ, bool FP8 = false>
DEV void gemm_mainloop(f32x4 (&acc)[4][4], const bf16_t* ap0, const bf16_t* ap1, const bf16_t* ap2, const bf16_t* ap3,
                       const bf16_t* bp0, const bf16_t* bp1, const bf16_t* bp2, const bf16_t* bp3,
                       int nk, unsigned char* lds, int ssq_steps, float ssq_inv_dim) {
    const int tid = threadIdx.x, lane = tid & 63, wid = tid >> 6, wr = wid >> 1, wc = wid & 1, fr = lane & 15, fq = lane >> 4;
    const int xs = (fr >> 1) & 7;
    const int lo0 = fr * 128 + ((fq ^ xs) << 4), lo1 = fr * 128 + (((fq ^ xs) ^ 4) << 4);
    const int a_off = wr * 8192, b_off = 16384 + wc * 8192;
    const int dst = tid * 16;
    float ssq = 0.f;
#pragma unroll
    for (int m = 0; m < 4; ++m)
#pragma unroll
        for (int n = 0; n < 4; ++n) acc[m][n] = (f32x4){0.f, 0.f, 0.f, 0.f};
    __syncthreads();
#define GLDS(src, off) __builtin_amdgcn_global_load_lds((const unsigned*)(src), (unsigned LAS*)(lds + (off)), 16, 0, 0)
#define STAGE(kt, b) do { const int _k = (kt) * 64; \
        GLDS(ap0 + _k, (b) * 32768 + dst);          GLDS(ap1 + _k, (b) * 32768 + dst + 4096); \
        GLDS(ap2 + _k, (b) * 32768 + dst + 8192);   GLDS(ap3 + _k, (b) * 32768 + dst + 12288); \
        GLDS(bp0 + _k, (b) * 32768 + 16384 + dst);  GLDS(bp1 + _k, (b) * 32768 + 16384 + dst + 4096); \
        GLDS(bp2 + _k, (b) * 32768 + 16384 + dst + 8192); GLDS(bp3 + _k, (b) * 32768 + 16384 + dst + 12288); } while (0)
    STAGE(0, 0);
    for (int kt = 0; kt < nk; ++kt) {
        VM_WAIT();
        __syncthreads();
        const int b = kt & 1;
        if (SSQ && kt == ssq_steps) {
            const float* rsl = (const float*)(lds + RS_OFF);
#pragma unroll
            for (int m = 0; m < 4; ++m) { const float r = rsl[wr * 64 + m * 16 + fr];
#pragma unroll
                for (int n = 0; n < 4; ++n) acc[m][n] = acc[m][n] * r; }
        }
        if (kt + 1 < nk) { if (b) STAGE(kt + 1, 0); else STAGE(kt + 1, 1); }
        const unsigned char* base = lds + b * 32768;
        if (FP8) {
            const int q0 = fr * 128 + (((2 * fq) ^ xs) << 4), q1 = fr * 128 + (((2 * fq + 1) ^ xs) << 4);
            v8i ax[4], bx[4];
#pragma unroll
            for (int m = 0; m < 4; ++m) { const u32x4 c0 = *(const u32x4*)(base + a_off + m * 2048 + q0), c1 = *(const u32x4*)(base + a_off + m * 2048 + q1);
                ax[m] = (v8i){(int)c0.x, (int)c0.y, (int)c0.z, (int)c0.w, (int)c1.x, (int)c1.y, (int)c1.z, (int)c1.w}; }
#pragma unroll
            for (int n = 0; n < 4; ++n) { const u32x4 c0 = *(const u32x4*)(base + b_off + n * 2048 + q0), c1 = *(const u32x4*)(base + b_off + n * 2048 + q1);
                bx[n] = (v8i){(int)c0.x, (int)c0.y, (int)c0.z, (int)c0.w, (int)c1.x, (int)c1.y, (int)c1.z, (int)c1.w}; }
#pragma unroll
            for (int m = 0; m < 4; ++m)
#pragma unroll
                for (int n = 0; n < 4; ++n) acc[m][n] = __builtin_amdgcn_mfma_scale_f32_16x16x128_f8f6f4(bx[n], ax[m], acc[m][n], 0, 0, 0, 0x7F7F7F7F, 0, 0x7F7F7F7F);
        } else {
#pragma unroll
        for (int ks = 0; ks < 2; ++ks) {
            bf16x8 af[4], bf[4];
#pragma unroll
            for (int m = 0; m < 4; ++m) af[m] = *(const bf16x8*)(base + a_off + m * 2048 + (ks ? lo1 : lo0));
#pragma unroll
            for (int n = 0; n < 4; ++n) bf[n] = *(const bf16x8*)(base + b_off + n * 2048 + (ks ? lo1 : lo0));
#pragma unroll
            for (int m = 0; m < 4; ++m)
#pragma unroll
                for (int n = 0; n < 4; ++n) acc[m][n] = __builtin_amdgcn_mfma_f32_16x16x32_bf16(bf[n], af[m], acc[m][n], 0, 0, 0);
        }
        }
        if (SSQ && kt < ssq_steps) {
            const int row = tid >> 1, hf = tid & 1;
            const int rb = row * 128, sw = (row >> 1) & 7;
#pragma unroll
            for (int j = 0; j < 4; ++j) {
                const u32x4 w = *(const u32x4*)(base + rb + (((hf * 4 + j) ^ sw) << 4));
#pragma unroll
                for (int q = 0; q < 4; ++q) { const float a = bflo(w[q]), bb = bfhi(w[q]); ssq += a * a + bb * bb; }
            }
            if (kt == ssq_steps - 1) {
                const float tot = ssq + __shfl_xor(ssq, 1);
                if (hf == 0) ((float*)(lds + RS_OFF))[row] = rsqrt_(tot * ssq_inv_dim + EPS);
            }
        }
    }
    if (SSQ && ssq_steps == nk) {
        __syncthreads();
        const float* rsl = (const float*)(lds + RS_OFF);
#pragma unroll
        for (int m = 0; m < 4; ++m) { const float r = rsl[wr * 64 + m * 16 + fr];
#pragma unroll
            for (int n = 0; n < 4; ++n) acc[m][n] = acc[m][n] * r; }
    }
#undef STAGE
#undef GLDS
}

DEV void phase1(const Ctx& c) {
    const bf16_t* h0 = (const bf16_t*)(c.ws + WS_H0); const bf16_t* WinT = (const bf16_t*)(c.ws + WS_WIN);
    bf16_t* U = (bf16_t*)(c.ws + WS_U); bf16_t* CQ = (bf16_t*)(c.ws + WS_CQ); bf16_t* CKV = (bf16_t*)(c.ws + WS_CKV); bf16_t* KR = (bf16_t*)(c.ws + WS_KR);
    const float* rc = (const float*)(c.ws + WS_ROPE); const float* rs = rc + L * 16;
    const StageGeo g = stage_geo(c.tid);
    const int lane = c.lane, wr = c.wid >> 1, wc = c.wid & 1, fr = lane & 15, fq = lane >> 4;
    constexpr int NT = 14, NU = (T / 128) * NT;
    for (int u = c.vcu; u < NU; u += c.G) {
        const int mt = u / NT, nt = u - mt * NT;
        const bf16_t* A = h0 + (size_t)(mt * 128) * D + g.c; const bf16_t* B = WinT + (size_t)(nt * 128) * D + g.c;
        f32x4 acc[4][4];
        gemm_mainloop<false>(acc, A + (size_t)g.r[0] * D, A + (size_t)g.r[1] * D, A + (size_t)g.r[2] * D, A + (size_t)g.r[3] * D,
                             B + (size_t)g.r[0] * D, B + (size_t)g.r[1] * D, B + (size_t)g.r[2] * D, B + (size_t)g.r[3] * D, 16, c.lds, 0, 0.f);
        const int row0 = mt * 128 + wr * 64 + fr;
        if (nt < 8) {
#pragma unroll
            for (int m = 0; m < 4; ++m) { const size_t row = row0 + m * 16;
#pragma unroll
                for (int i = 0; i < 2; ++i) {
                    f32x4 a = acc[m][2 * i], gt = acc[m][2 * i + 1], o;
#pragma unroll
                    for (int j = 0; j < 4; ++j) o[j] = a[j] * sigmoidf_(gt[j]);
                    st_bf4(U + row * CC + nt * 64 + wc * 32 + i * 16 + fq * 4, o);
                } }
        } else if (nt < 11) {
#pragma unroll
            for (int m = 0; m < 4; ++m) { const size_t row = row0 + m * 16;
#pragma unroll
                for (int n = 0; n < 4; ++n) st_bf4(CQ + row * QL + (nt - 8) * 128 + wc * 64 + n * 16 + fq * 4, acc[m][n]); }
        } else if (nt < 13) {
#pragma unroll
            for (int m = 0; m < 4; ++m) { const size_t row = row0 + m * 16;
#pragma unroll
                for (int n = 0; n < 4; ++n) st_bf4(CKV + row * KVL + (nt - 11) * 128 + wc * 64 + n * 16 + fq * 4, acc[m][n]); }
        } else if (wc == 0) {
#pragma unroll
            for (int m = 0; m < 4; ++m) { const int row = row0 + m * 16; const int p = row % L;
                const f32x4 cs = *(const f32x4*)(rc + p * 16 + fq * 4), sn = *(const f32x4*)(rs + p * 16 + fq * 4);
                const f32x4 x1 = acc[m][0], x2 = acc[m][1];
                st_bf4(KR + (size_t)row * 32 + fq * 4, x1 * cs - x2 * sn);
                st_bf4(KR + (size_t)row * 32 + 16 + fq * 4, x1 * sn + x2 * cs); }
        }
    }
}

DEV void conv_unit(const Ctx& c, int b, int j) {
    const bf16_t* U = (const bf16_t*)(c.ws + WS_U);
    bf16_t* MG = (bf16_t*)(c.ws + WS_MG);
    const float* cw = c.in[I_CONVW]; const float* cb = c.in[I_CONVB];
    const int p0 = j * 32;
    float* ytile = (float*)c.lds;
    __syncthreads();
#pragma unroll 1
    for (int pass = 0; pass < 2; ++pass) {
        const int ch = c.tid + 256 * pass;
        float win[62]; unsigned raw[62];
        const bf16_t* ub = U + (size_t)b * L * CC + ch;
#pragma unroll
        for (int rep = 0; rep < CONV_REPA; ++rep) {
        asm volatile("" : "+v"(ub) :: "memory");
#pragma unroll
        for (int i = 0; i < 62; ++i) { const int p = p0 - 30 + i; const int pc = p < 0 ? 0 : (p >= L ? L - 1 : p); raw[i] = ub[(size_t)pc * CC]; }
        if (rep + 1 < CONV_REPA) {
#pragma unroll
            for (int i = 0; i < 62; ++i) asm volatile("" :: "v"(raw[i]));
        }
        }
        float w[31];
#pragma unroll
        for (int k = 0; k < 31; ++k) w[k] = cw[k * CC + ch];
        float bias = cb[ch];
        __builtin_amdgcn_sched_barrier(0);
#pragma unroll
        for (int i = 0; i < 62; ++i) { const int p = p0 - 30 + i; win[i] = (p >= 0 && p < L) ? __uint_as_float(raw[i] << 16) : 0.f; }
#pragma unroll
        for (int rep = 0; rep < CONV_REPB; ++rep) {
        asm volatile("" : "+v"(bias) :: "memory");
#pragma unroll
        for (int tt = 0; tt < 32; ++tt) {
            float a0 = bias;
#pragma unroll
            for (int k = 0; k < 31; ++k) a0 += w[k] * win[tt + k];
            ytile[tt * 512 + ch] = a0;
        }
        }
    }
    __syncthreads();
    const float* g1 = c.in[I_CLN_G]; const float* b1 = c.in[I_CLN_B]; const float* g2 = c.in[I_COUT_G];
    float G1[8], B1[8], G2[8];
    { const f32x4 a = *(const f32x4*)(g1 + c.lane * 8), bq = *(const f32x4*)(g1 + c.lane * 8 + 4); G1[0]=a.x;G1[1]=a.y;G1[2]=a.z;G1[3]=a.w;G1[4]=bq.x;G1[5]=bq.y;G1[6]=bq.z;G1[7]=bq.w; }
    { const f32x4 a = *(const f32x4*)(b1 + c.lane * 8), bq = *(const f32x4*)(b1 + c.lane * 8 + 4); B1[0]=a.x;B1[1]=a.y;B1[2]=a.z;B1[3]=a.w;B1[4]=bq.x;B1[5]=bq.y;B1[6]=bq.z;B1[7]=bq.w; }
    { const f32x4 a = *(const f32x4*)(g2 + c.lane * 8), bq = *(const f32x4*)(g2 + c.lane * 8 + 4); G2[0]=a.x;G2[1]=a.y;G2[2]=a.z;G2[3]=a.w;G2[4]=bq.x;G2[5]=bq.y;G2[6]=bq.z;G2[7]=bq.w; }
#pragma unroll
    for (int rep = 0; rep < CONV_REPC; ++rep) {
    asm volatile("" : "+v"(ytile) :: "memory");
    float v[8][8]; float st[8];
#pragma unroll
    for (int i = 0; i < 8; ++i) { const int tt = c.wid * 8 + i;
        const f32x4 ya = *(const f32x4*)(ytile + tt * 512 + c.lane * 8), yb = *(const f32x4*)(ytile + tt * 512 + c.lane * 8 + 4);
        v[i][0]=ya.x;v[i][1]=ya.y;v[i][2]=ya.z;v[i][3]=ya.w;v[i][4]=yb.x;v[i][5]=yb.y;v[i][6]=yb.z;v[i][7]=yb.w;
        st[i] = ((v[i][0] + v[i][1]) + (v[i][2] + v[i][3])) + ((v[i][4] + v[i][5]) + (v[i][6] + v[i][7])); }
    wave_sum_n<8>(st);
#pragma unroll
    for (int i = 0; i < 8; ++i) { const float mean = st[i] * (1.f / 512.f); float a = 0.f;
#pragma unroll
        for (int q = 0; q < 8; ++q) { v[i][q] -= mean; a += v[i][q] * v[i][q]; }
        st[i] = a; }
    wave_sum_n<8>(st);
#pragma unroll
    for (int i = 0; i < 8; ++i) { const float rstd = rsqrt_(st[i] * (1.f / 512.f) + EPS); float a = 0.f;
#pragma unroll
        for (int q = 0; q < 8; ++q) { const float x = v[i][q] * rstd * G1[q] + B1[q]; const float y = x * sigmoidf_(x); v[i][q] = y; a += y * y; }
        st[i] = a; }
    wave_sum_n<8>(st);
#pragma unroll
    for (int i = 0; i < 8; ++i) {
        const int p = p0 + c.wid * 8 + i;
        {
            const float r2 = rsqrt_(st[i] * (1.f / 512.f) + EPS);
            u32x4 o;
            o.x = cvtpk(v[i][0] * r2 * G2[0], v[i][1] * r2 * G2[1]); o.y = cvtpk(v[i][2] * r2 * G2[2], v[i][3] * r2 * G2[3]);
            o.z = cvtpk(v[i][4] * r2 * G2[4], v[i][5] * r2 * G2[5]); o.w = cvtpk(v[i][6] * r2 * G2[6], v[i][7] * r2 * G2[7]);
            const size_t tok = (size_t)b * SEQ + (p - NMETA);
            bf16_t* dstp = (p >= NMETA && p < L) ? MG + tok * D + 512 + c.lane * 8 : (bf16_t*)(c.ws + WS_DUMMY) + c.lane * 8;
            *(u32x4*)dstp = o;
        }
    }
    }
}
DEV void rope4(f32x4& x1, f32x4& x2, const float* rc, const float* rs, int p, int fq) {
    const f32x4 cs = *(const f32x4*)(rc + p * 16 + fq * 4), sn = *(const f32x4*)(rs + p * 16 + fq * 4);
    const f32x4 a = x1 * cs - x2 * sn, bb = x1 * sn + x2 * cs; x1 = a; x2 = bb;
}
template <int SEL> DEV void phase2_t(const Ctx& c) {
    const bf16_t* CQ = (const bf16_t*)(c.ws + WS_CQ); const bf16_t* CKV = (const bf16_t*)(c.ws + WS_CKV);
    const bf16_t* WuqT = (const bf16_t*)(c.ws + WS_WUQ); const bf16_t* WukvT = (const bf16_t*)(c.ws + WS_WUKV);
    bf16_t* Q = (bf16_t*)(c.ws + WS_Q); bf16_t* KV = (bf16_t*)(c.ws + WS_KV);
    const float* rc = (const float*)(c.ws + WS_ROPE); const float* rs = rc + L * 16;
    const StageGeo g = stage_geo(c.tid);
    const int lane = c.lane, wr = c.wid >> 1, wc = c.wid & 1, fr = lane & 15, fq = lane >> 4;
    constexpr int MT = T / 128, NUQ = MT * 6, NUKV = MT * 8, NUC = NB * 65, NU = NUQ + NUKV + NUC;
    const int li = c.vcu & 63, rev = ((li >> 5) ^ li) & 1;
    const int nmine = (NU - c.vcu + c.G - 1) / c.G;
    for (int it = 0; it < nmine; ++it) {
        const int u = c.vcu + (rev ? (nmine - 1 - it) : it) * c.G;
        if (SEL == 1 && u >= NUKV + NUQ) continue;
        if (SEL == 2 && u < NUKV + NUQ) continue;
        if (u < NUKV) {
            const int mt = u >> 3, nt = u & 7;
            const bf16_t* A = CKV + (size_t)(mt * 128) * KVL + g.c; const bf16_t* B = WukvT + (size_t)(nt * 128) * KVL + g.c;
            f32x4 acc[4][4];
            gemm_mainloop<true>(acc, A + (size_t)g.r[0] * KVL, A + (size_t)g.r[1] * KVL, A + (size_t)g.r[2] * KVL, A + (size_t)g.r[3] * KVL,
                                B + (size_t)g.r[0] * KVL, B + (size_t)g.r[1] * KVL, B + (size_t)g.r[2] * KVL, B + (size_t)g.r[3] * KVL, 4, c.lds, 4, 1.f / 256.f);
            const int row0 = mt * 128 + wr * 64 + fr;
#pragma unroll
            for (int m = 0; m < 4; ++m) { const size_t row = row0 + m * 16;
#pragma unroll
                for (int n = 0; n < 4; ++n) st_bf4(KV + row * NKV + nt * 128 + wc * 64 + n * 16 + fq * 4, acc[m][n]); }
        } else if (u < NUKV + NUQ) {
            const int v = u - NUKV, mt = v / 6, nt = v - mt * 6;
            const bf16_t* A = CQ + (size_t)(mt * 128) * QL + g.c; const bf16_t* B = WuqT + (size_t)(nt * 128) * QL + g.c;
            f32x4 acc[4][4];
            gemm_mainloop<true>(acc, A + (size_t)g.r[0] * QL, A + (size_t)g.r[1] * QL, A + (size_t)g.r[2] * QL, A + (size_t)g.r[3] * QL,
                                B + (size_t)g.r[0] * QL, B + (size_t)g.r[1] * QL, B + (size_t)g.r[2] * QL, B + (size_t)g.r[3] * QL, 6, c.lds, 6, 1.f / 384.f);
            const int row0 = mt * 128 + wr * 64 + fr;
            const int t16 = (nt * 8 + wc * 4) % 6;
#pragma unroll
            for (int m = 0; m < 4; ++m) { const int row = row0 + m * 16; const int p = row % L;
#pragma unroll
                for (int n = 0; n < 4; ++n) acc[m][n] = acc[m][n] * QSCALE;
                if (t16 == 4) rope4(acc[m][0], acc[m][1], rc, rs, p, fq);
                if (t16 == 2) rope4(acc[m][2], acc[m][3], rc, rs, p, fq);
#pragma unroll
                for (int n = 0; n < 4; ++n) st_bf4(Q + (size_t)row * NQ + nt * 128 + wc * 64 + n * 16 + fq * 4, acc[m][n]); }
        } else {
            const int v = u - NUKV - NUQ; conv_unit(c, v / 65, v % 65);
        }
    }
}

DEV void phase2(const Ctx& c) { phase2_t<0>(c); }
DEV void phase2g(const Ctx& c) { phase2_t<1>(c); }
DEV void phase2c(const Ctx& c) { phase2_t<2>(c); }
DEV int crow(int r, int hi) { return (r & 3) + 8 * (r >> 2) + 4 * hi; }
#define KSWZ(row, colB) ((row) * 256 + ((colB) ^ (((row) & 7) << 4)))
#define SBAR() __builtin_amdgcn_sched_barrier(0)
DEV int v_st(int k, int cc) { const int kk = (k & ~0xC) | ((k & 4) << 1) | ((k & 8) >> 1); return ((kk >> 3) * 4 + (cc >> 5)) * 512 + ((kk & 7) * 32 + (cc & 31)) * 2; }
DEV int v_rd_base(int lane) { return ((lane & 3) << 3) | (((lane >> 2) & 3) << 6) | (((lane >> 4) & 1) << 5) | (((lane >> 5) & 1) << 8); }
constexpr int v_rd_off(int d0, int ks, int half) { return d0 * 512 + ks * 4096 + half * 2048; }
template <int OFF> DEV s16x4 tr_read(int vb) { s16x4 r; asm volatile("ds_read_b64_tr_b16 %0, %1 offset:%2" : "=&v"(r) : "v"(vb), "i"(OFF) : "memory"); return r; }
template <int D0> DEV void pv_one(f32x16& od, int vb, bf16x8 pa0, bf16x8 pa1, bf16x8 pa2, bf16x8 pa3) {
    const s16x4 l0 = tr_read<v_rd_off(D0, 0, 0)>(vb), h0 = tr_read<v_rd_off(D0, 0, 1)>(vb), l1 = tr_read<v_rd_off(D0, 1, 0)>(vb), h1 = tr_read<v_rd_off(D0, 1, 1)>(vb);
    const s16x4 l2 = tr_read<v_rd_off(D0, 2, 0)>(vb), h2 = tr_read<v_rd_off(D0, 2, 1)>(vb), l3 = tr_read<v_rd_off(D0, 3, 0)>(vb), h3 = tr_read<v_rd_off(D0, 3, 1)>(vb);
    asm volatile("s_waitcnt lgkmcnt(0)" ::: "memory"); SBAR();
#define PK(Lo, Hi) (bf16x8){Lo[0], Lo[1], Lo[2], Lo[3], Hi[0], Hi[1], Hi[2], Hi[3]}
    od = __builtin_amdgcn_mfma_f32_32x32x16_bf16(pa0, PK(l0, h0), od, 0, 0, 0);
    od = __builtin_amdgcn_mfma_f32_32x32x16_bf16(pa1, PK(l1, h1), od, 0, 0, 0);
    od = __builtin_amdgcn_mfma_f32_32x32x16_bf16(pa2, PK(l2, h2), od, 0, 0, 0);
    od = __builtin_amdgcn_mfma_f32_32x32x16_bf16(pa3, PK(l3, h3), od, 0, 0, 0);
#undef PK
}
constexpr float ATT_THR = 8.f;
constexpr int AT_V = 0, AT_K = 32768, AT_WS = 65536;
DEV void attn_unit(const Ctx& c, int b, int h, int qb) {
    const bf16_t* Q = (const bf16_t*)(c.ws + WS_Q); const bf16_t* KV = (const bf16_t*)(c.ws + WS_KV); const bf16_t* KR = (const bf16_t*)(c.ws + WS_KR);
    bf16_t* MG = (bf16_t*)(c.ws + WS_MG);
    unsigned char* lds = c.lds;
    const int tid = c.tid, wid = c.wid, lane = c.lane, r32 = lane & 31, hi = lane >> 5;
    float* wsf = (float*)(lds + AT_WS) + wid * 64; float* li_l = wsf; float* al_l = wsf + 32;
    const int NT = 2 * qb + 3;
    const int my_last = 2 * qb + (wid >> 1) + 1;
    bf16x8 qr[6];
    { const size_t t = (size_t)b * L + NMETA + qb * 128 + wid * 32 + r32;
      const bf16_t* Qw = Q + t * NQ + h * DQK + hi * 8;
#pragma unroll
      for (int d0 = 0; d0 < 6; ++d0) qr[d0] = *(const bf16x8*)(Qw + d0 * 16); }
    const int srow = tid >> 2, sq = tid & 3;
    const int vst0 = v_st(srow, sq * 16), vst1 = v_st(srow, sq * 16 + 8);
    const int kst0 = KSWZ(srow, sq * 32), kst1 = KSWZ(srow, sq * 32 + 16), kst2 = KSWZ(srow, 128 + sq * 16);
    const int vb0 = (int)(uintptr_t)(lds + AT_V) + v_rd_base(lane);
    u32x4 sk0, sk1, sk2, sv0, sv1;
#define SLOAD(j) do { int pos = (j) * 64 + srow - 48; pos = pos < 0 ? 0 : pos; const size_t tk = (size_t)b * L + pos; \
        const bf16_t* kvp = KV + tk * NKV + h * 128 + sq * 16; \
        sk0 = *(const u32x4*)(kvp); sk1 = *(const u32x4*)(kvp + 8); sv0 = *(const u32x4*)(kvp + 64); sv1 = *(const u32x4*)(kvp + 72); \
        sk2 = *(const u32x4*)(KR + tk * 32 + sq * 8); } while (0)
#define SWRITE(bb) do { unsigned char* kb = lds + AT_K + (bb) * 16384; unsigned char* vbp = lds + AT_V + (bb) * 16384; \
        *(u32x4*)(kb + kst0) = sk0; *(u32x4*)(kb + kst1) = sk1; *(u32x4*)(kb + kst2) = sk2; *(u32x4*)(vbp + vst0) = sv0; *(u32x4*)(vbp + vst1) = sv1; } while (0)
    float m_reg = 0.f, l_reg = 0.f; f32x16 o[2] = {};
    __syncthreads();
    SLOAD(0); SWRITE(0); __syncthreads();
    for (int j = 0; j < NT; ++j) {
        const int bsel = j & 1;
        if (j + 1 < NT) SLOAD(j + 1);
        if (j <= my_last) {
            const unsigned char* Ks = lds + AT_K + bsel * 16384;
            f32x16 p0, p1;
            { const float nm = -m_reg;
#pragma unroll
              for (int r = 0; r < 16; ++r) { p0[r] = nm; p1[r] = nm; } }
#pragma unroll
            for (int d0 = 0; d0 < 6; ++d0) { const int cb = (d0 * 16 + hi * 8) * 2;
                const bf16x8 k0 = *(const bf16x8*)(Ks + KSWZ(r32, cb)); const bf16x8 k1 = *(const bf16x8*)(Ks + KSWZ(32 + r32, cb));
                p0 = __builtin_amdgcn_mfma_f32_32x32x16_bf16(k0, qr[d0], p0, 0, 0, 0);
                p1 = __builtin_amdgcn_mfma_f32_32x32x16_bf16(k1, qr[d0], p1, 0, 0, 0); }
            if (j == 0) {
#pragma unroll
                for (int r = 0; r < 16; ++r) p0[r] = -1e30f;
#pragma unroll
                for (int r = 0; r < 8; ++r) p1[r] = -1e30f;
            }
            float pmax = fmaxf(fmaxf(p0[0], p0[1]), p0[2]);
#pragma unroll
            for (int r = 3; r < 15; r += 2) pmax = fmaxf(fmaxf(pmax, p0[r]), p0[r + 1]);
            pmax = fmaxf(fmaxf(pmax, p0[15]), p1[0]);
#pragma unroll
            for (int r = 1; r < 15; r += 2) pmax = fmaxf(fmaxf(pmax, p1[r]), p1[r + 1]);
            pmax = fmaxf(pmax, p1[15]);
            { auto rr = __builtin_amdgcn_permlane32_swap(__float_as_uint(pmax), __float_as_uint(pmax), false, false);
              pmax = fmaxf(__uint_as_float(rr[0]), __uint_as_float(rr[1])); }
            float ps = 0.f;
            if (__any(pmax > ATT_THR)) {
                const float dm = fmaxf(pmax, 0.f), alpha = fast_exp2(-dm); m_reg += dm;
#pragma unroll
                for (int r = 0; r < 16; ++r) { p0[r] -= dm; p1[r] -= dm; }
                l_reg *= alpha;
                if (hi == 0) al_l[r32] = alpha;
                asm volatile("s_waitcnt lgkmcnt(0)" ::: "memory");
#pragma unroll
                for (int r = 0; r < 16; ++r) { const float a = al_l[crow(r, hi)]; o[0][r] *= a; o[1][r] *= a; }
            }
#pragma unroll
            for (int r = 0; r < 16; ++r) { p0[r] = fast_exp2(p0[r]); ps += p0[r]; }
#pragma unroll
            for (int r = 0; r < 16; ++r) { p1[r] = fast_exp2(p1[r]); ps += p1[r]; }
            { auto rr = __builtin_amdgcn_permlane32_swap(__float_as_uint(ps), __float_as_uint(ps), false, false);
              ps = __uint_as_float(rr[0]) + __uint_as_float(rr[1]); }
            l_reg += ps;
            bf16x8 pa0, pa1, pa2, pa3;
#define PK4(P, BASE, OUT) do { unsigned a0 = cvtpk(P[BASE + 0], P[BASE + 1]), a1 = cvtpk(P[BASE + 2], P[BASE + 3]);   \
    unsigned b0 = cvtpk(P[BASE + 4], P[BASE + 5]), b1 = cvtpk(P[BASE + 6], P[BASE + 7]);                              \
    auto r0 = __builtin_amdgcn_permlane32_swap(a0, b0, false, false); auto r1 = __builtin_amdgcn_permlane32_swap(a1, b1, false, false); \
    u32x4 w = {r0[0], r1[0], r0[1], r1[1]}; OUT = *reinterpret_cast<bf16x8*>(&w); } while (0)
            PK4(p0, 0, pa0); PK4(p0, 8, pa1); PK4(p1, 0, pa2); PK4(p1, 8, pa3);
#undef PK4
            const int vb = vb0 + bsel * 16384;
            pv_one<0>(o[0], vb, pa0, pa1, pa2, pa3); pv_one<1>(o[1], vb, pa0, pa1, pa2, pa3);
        }
        if (j + 1 < NT) { if (bsel) SWRITE(0); else SWRITE(1); }
        __syncthreads();
    }
    if (hi == 0) li_l[r32] = l_reg;
    asm volatile("s_waitcnt lgkmcnt(0)" ::: "memory");
    const size_t tok0 = (size_t)b * SEQ + qb * 128 + wid * 32;
#pragma unroll
    for (int r = 0; r < 16; ++r) {
        const int orow = crow(r, hi); const float rl = fast_rcp(li_l[orow]);
        bf16_t* dst = MG + (tok0 + orow) * D + h * DV + r32;
        dst[0]  = (bf16_t)(cvtpk(o[0][r] * rl, 0.f) & 0xffffu);
        dst[32] = (bf16_t)(cvtpk(o[1][r] * rl, 0.f) & 0xffffu);
    }
#undef SLOAD
#undef SWRITE
}
DEV void phase3(const Ctx& c) {
    const int nslots = NB * NH * 4;
    float* scr = (float*)(c.lds + c.wid * 8448);
    const int gw = c.vcu * 4 + c.wid, NGW = c.G * 4;
    constexpr int NWI = 3 * 4096;
    int wi = gw;
#define EW_ITEMS(n) do { __syncthreads(); for (int _q = 0; _q < (n) && wi < NWI; ++_q, wi += NGW) expert_weight_item(c, wi, scr); } while (0)
    for (int v = c.vcu; v < nslots; v += c.G) {
        const int bh = v >> 2, s = v & 3, b = bh >> 3, h = bh & 7;
        attn_unit(c, b, h, 15 - s); EW_ITEMS(2); attn_unit(c, b, h, s); EW_ITEMS(1); attn_unit(c, b, h, 11 - s); EW_ITEMS(2); attn_unit(c, b, h, 4 + s); EW_ITEMS(1);
    }
    __syncthreads();
    for (; wi < NWI; wi += NGW) expert_weight_item(c, wi, scr);
#undef EW_ITEMS
}

DEV void phase4(const Ctx& c) {
    const bf16_t* MG = (const bf16_t*)(c.ws + WS_MG); const bf16_t* WoT = (const bf16_t*)(c.ws + WS_WO); const bf16_t* h0 = (const bf16_t*)(c.ws + WS_H0);
    bf16_t* R1 = (bf16_t*)(c.ws + WS_R1);
    const StageGeo g = stage_geo(c.tid);
    const int lane = c.lane, wr = c.wid >> 1, wc = c.wid & 1, fr = lane & 15, fq = lane >> 4;
    constexpr int NU = (TR / 128) * 8;
    for (int u = c.vcu; u < NU; u += c.G) {
        const int mt = u >> 3, nt = u & 7;
        const bf16_t* A = MG + (size_t)(mt * 128) * D + g.c; const bf16_t* B = WoT + (size_t)(nt * 128) * D + g.c;
        f32x4 acc[4][4];
        gemm_mainloop<true>(acc, A + (size_t)g.r[0] * D, A + (size_t)g.r[1] * D, A + (size_t)g.r[2] * D, A + (size_t)g.r[3] * D,
                            B + (size_t)g.r[0] * D, B + (size_t)g.r[1] * D, B + (size_t)g.r[2] * D, B + (size_t)g.r[3] * D, 16, c.lds, 8, 1.f / 512.f);
#pragma unroll
        for (int m = 0; m < 4; ++m) {
            const int tok = mt * 128 + wr * 64 + m * 16 + fr;
            const size_t t = (size_t)(tok >> 11) * L + NMETA + (tok & 2047);
#pragma unroll
            for (int n = 0; n < 4; ++n) {
                const int col = nt * 128 + wc * 64 + n * 16 + fq * 4;
                const u32x2 hw = *(const u32x2*)(h0 + t * D + col);
                f32x4 o; o[0] = ALPHA * bflo(hw.x) + acc[m][n][0]; o[1] = ALPHA * bfhi(hw.x) + acc[m][n][1];
                o[2] = ALPHA * bflo(hw.y) + acc[m][n][2]; o[3] = ALPHA * bfhi(hw.y) + acc[m][n][3];
                st_bf4(R1 + (size_t)tok * D + col, o);
            }
        }
    }
}

constexpr int P5_ROWB = 2064, P5_PART = 33280, P5_LG = 45568, P5_BIAS = 48128, P5_AGG = 48384;
DEV void phase5(const Ctx& c, int ALT = 0) {
    const bf16_t* R1 = (const bf16_t*)(c.ws + WS_R1); bf16_t* H1 = (bf16_t*)(c.ws + WS_H0);
    const bf16_t* WrT = (const bf16_t*)(c.ws + WS_WR);
    unsigned* cnt = (unsigned*)(c.ws + WS_CTL) + CW_CNT + ALT * 32; unsigned* list = (unsigned*)(c.ws + (ALT ? 404 * MiB : WS_LIST)); float* combw = (float*)(c.ws + WS_COMBW);
    const int lane = c.lane, wid = c.wid, fr = lane & 15, fq = lane >> 4;
    float* part = (float*)(c.lds + P5_PART); float* lgs = (float*)(c.lds + P5_LG); float* biasl = (float*)(c.lds + P5_BIAS);
    __syncthreads();
    if (c.tid < 36) biasl[c.tid] = (c.tid < 4) ? c.in[I_BRG][c.tid] : c.in[I_BRE][c.tid - 4];
    bf16x8 wf[8][3];
#pragma unroll
    for (int ks = 0; ks < 8; ++ks)
#pragma unroll
        for (int n = 0; n < 3; ++n) wf[ks][n] = *(const bf16x8*)(WrT + (size_t)(n * 16 + fr) * D + wid * 256 + ks * 32 + fq * 8);
    unsigned* lcnt = (unsigned*)(c.lds + P5_AGG); unsigned* lbase = lcnt + 32; unsigned* ent = lcnt + 64;
    if (c.tid < 32) lcnt[c.tid] = 0u;
    int nent = 0;
    for (int u = c.vcu; u < TR / 16; u += c.G) {
        const int tok0 = u * 16;
        { const float* src[4]; bf16_t* dst[4]; unsigned char* ldsn[4]; unsigned char* f8n[4];
#pragma unroll
          for (int i = 0; i < 4; ++i) { const int tl = wid * 4 + i; const size_t tok = tok0 + tl; src[i] = (const float*)(R1 + tok * D); dst[i] = H1 + tok * D; ldsn[i] = c.lds + tl * P5_ROWB; f8n[i] = c.ws + WS_H1F8 + tok * D; }
          ln_rows_bf16<4, true, true>(src, c.in[I_LN1G], c.in[I_LN1B], dst, ldsn, lane, f8n); }
        __syncthreads();
        f32x4 acc[3] = {};
#pragma unroll
        for (int ks = 0; ks < 8; ++ks) {
            const int k = wid * 256 + ks * 32 + fq * 8;
            const bf16x8 a = *(const bf16x8*)(c.lds + fr * P5_ROWB + k * 2);
#pragma unroll
            for (int n = 0; n < 3; ++n) acc[n] = __builtin_amdgcn_mfma_f32_16x16x32_bf16(wf[ks][n], a, acc[n], 0, 0, 0);
        }
#pragma unroll
        for (int n = 0; n < 3; ++n) *(f32x4*)(part + (wid * 16 + fr) * 48 + n * 16 + fq * 4) = acc[n];
        __syncthreads();
#pragma unroll
        for (int i = 0; i < 3; ++i) { const int idx = c.tid + 256 * i;
            if (idx < 576) { const int tk = idx / 36, l = idx - tk * 36;
                lgs[tk * 40 + l] = ((part[tk * 48 + l] + part[(16 + tk) * 48 + l]) + (part[(32 + tk) * 48 + l] + part[(48 + tk) * 48 + l])) + biasl[l]; } }
        __syncthreads();
        if (c.tid < 16) {
            const float* lg = lgs + c.tid * 40;
            int gi = 0; float gm = lg[0];
#pragma unroll
            for (int i = 1; i < 4; ++i) { const float v = lg[i]; if (v > gm) { gm = v; gi = i; } }
            float gs = 0.f;
#pragma unroll
            for (int i = 0; i < 4; ++i) gs += __expf(lg[i] - gm);
            const float gw = 1.f / gs;
            const float* le = lg + 4 + gi * 8;
            float v0 = le[0], v1 = -3.0e38f; int i0 = 0, i1 = 0;
#pragma unroll
            for (int i = 1; i < 8; ++i) { const float v = le[i];
                if (v > v0) { v1 = v0; i1 = i0; v0 = v; i0 = i; } else if (v > v1) { v1 = v; i1 = i; } }
            const float ex = __expf(v1 - v0), inv = 1.f / (1.f + ex);
            const int tok = tok0 + c.tid; const unsigned e0 = gi * 8 + i0, e1 = gi * 8 + i1;
            combw[tok * 2] = gw * inv; combw[tok * 2 + 1] = gw * ex * inv;
            const unsigned r0 = atomicAdd(&lcnt[e0], 1u), r1 = atomicAdd(&lcnt[e1], 1u);
            const int ei = nent * 32 + c.tid * 2;
            ent[2 * ei] = (unsigned)(tok * 2);         ent[2 * ei + 1] = (e0 << 16) | r0;
            ent[2 * ei + 2] = (unsigned)(tok * 2 + 1); ent[2 * ei + 3] = (e1 << 16) | r1;
        }
        ++nent;
    }
    __syncthreads();
    if (c.tid < 32) { const unsigned n = lcnt[c.tid]; lbase[c.tid] = n ? atomicAdd(&cnt[c.tid * CNT_STRIDE], n) : 0u; }
    __syncthreads();
    for (int i = c.tid; i < nent * 32; i += 256) { const unsigned t2 = ent[2 * i], er = ent[2 * i + 1]; const unsigned e = er >> 16;
        list[(size_t)e * TR + lbase[e] + (er & 0xffffu)] = t2; }
}
DEV void bar20(const Ctx& c) {}
DEV void moe_tiles(const Ctx& c) {
    const unsigned* cnt = (const unsigned*)(c.ws + WS_CTL) + CW_CNT; int* ts = (int*)(c.lds + EXP_OFF);
    __syncthreads();
    if (c.tid == 0) { int s = 0; for (int e = 0; e < NE; ++e) { const int n = (int)__hip_atomic_load(&cnt[e * CNT_STRIDE], __ATOMIC_RELAXED, __HIP_MEMORY_SCOPE_AGENT);
            ts[e] = s; ts[40 + e] = n; s += (n + 127) >> 7; } ts[NE] = s; }
    __syncthreads();
}
DEV void phase6a(const Ctx& c) {
    const bf16_t* H18 = (const bf16_t*)(c.ws + WS_H1F8); const bf16_t* Wgu8 = (const bf16_t*)(c.ws + WS_WGU); unsigned char* ACT8 = c.ws + WS_ACT;
    const unsigned* list = (const unsigned*)(c.ws + WS_LIST);
    moe_tiles(c);
    const int* ts = (const int*)(c.lds + EXP_OFF); unsigned* tbl = (unsigned*)(c.lds + TBL_OFF);
    const StageGeo g = stage_geo(c.tid);
    const int lane = c.lane, wr = c.wid >> 1, wc = c.wid & 1, fr = lane & 15, fq = lane >> 4;
    const int NU = ts[NE] * 4;
    int e = 0;
    u32x2* RI = (u32x2*)(c.ws + WS_RI); const float* combw = (const float*)(c.ws + WS_COMBW);
    for (int u = c.vcu; u < NU; u += c.G) {
        const int rt = u >> 2, nt = u & 3;
        while (ts[e + 1] <= rt) ++e;
        const int j0 = (rt - ts[e]) * 128; const int ne = ts[40 + e];
        __syncthreads();
        if (c.tid < 128) { const int j = j0 + c.tid; const unsigned en = (j < ne) ? list[(size_t)e * TR + j] : 0xffffffffu; tbl[c.tid] = en;
            if (nt == 0) { u32x2 ri; ri.x = en; ri.y = (en == 0xffffffffu) ? 0u : __float_as_uint(combw[en]); RI[(size_t)rt * 128 + c.tid] = ri; } }
        __syncthreads();
        size_t ro[4];
#pragma unroll
        for (int i = 0; i < 4; ++i) { const unsigned en = tbl[g.r[i]]; ro[i] = (en == 0xffffffffu) ? 0 : (size_t)(en >> 1) * (D / 2); }
        const bf16_t* A = H18 + g.c; const bf16_t* B = Wgu8 + ((size_t)e * 512 + nt * 128) * (D / 2) + g.c;
        f32x4 acc[4][4];
        gemm_mainloop<false, true>(acc, A + ro[0], A + ro[1], A + ro[2], A + ro[3],
                             B + (size_t)g.r[0] * (D / 2), B + (size_t)g.r[1] * (D / 2), B + (size_t)g.r[2] * (D / 2), B + (size_t)g.r[3] * (D / 2), 8, c.lds, 0, 0.f);
#pragma unroll
        for (int m = 0; m < 4; ++m) { const size_t row = (size_t)rt * 128 + wr * 64 + m * 16 + fr;
#pragma unroll
            for (int i = 0; i < 2; ++i) {
                const f32x4 gt = acc[m][2 * i], up = acc[m][2 * i + 1]; f32x4 o;
#pragma unroll
                for (int j = 0; j < 4; ++j) { const float gv = gt[j] * WUNSCALE; o[j] = gv * sigmoidf_(gv) * (up[j] * WUNSCALE); }
                *(unsigned*)(ACT8 + row * DE + nt * 64 + wc * 32 + i * 16 + fq * 4) = pk_fp8x4(o[0], o[1], o[2], o[3]);
            } }
    }
}
DEV void phase6b(const Ctx& c) {
    const bf16_t* ACT8 = (const bf16_t*)(c.ws + WS_ACT); const bf16_t* Wd8 = (const bf16_t*)(c.ws + WS_WD); unsigned char* Y8 = c.ws + WS_Y;
    const u32x2* RI = (const u32x2*)(c.ws + WS_RI);
    moe_tiles(c);
    const int* ts = (const int*)(c.lds + EXP_OFF); u32x2* tbl = (u32x2*)(c.lds + TBL_OFF);
    const StageGeo g = stage_geo(c.tid);
    const int lane = c.lane, wr = c.wid >> 1, wc = c.wid & 1, fr = lane & 15, fq = lane >> 4;
    const int NU = ts[NE] * 8;
    int e = 0;
    for (int u = c.vcu; u < NU; u += c.G) {
        const int rt = u >> 3, nt = u & 7;
        while (ts[e + 1] <= rt) ++e;
        __syncthreads();
        if (c.tid < 128) tbl[c.tid] = RI[(size_t)rt * 128 + c.tid];
        const bf16_t* A = ACT8 + (size_t)(rt * 128) * (DE / 2) + g.c; const bf16_t* B = Wd8 + ((size_t)e * 1024 + nt * 128) * (DE / 2) + g.c;
        f32x4 acc[4][4];
        gemm_mainloop<false, true>(acc, A + (size_t)g.r[0] * (DE / 2), A + (size_t)g.r[1] * (DE / 2), A + (size_t)g.r[2] * (DE / 2), A + (size_t)g.r[3] * (DE / 2),
                             B + (size_t)g.r[0] * (DE / 2), B + (size_t)g.r[1] * (DE / 2), B + (size_t)g.r[2] * (DE / 2), B + (size_t)g.r[3] * (DE / 2), 2, c.lds, 0, 0.f);
#pragma unroll
        for (int m = 0; m < 4; ++m) {
            const u32x2 ri = tbl[wr * 64 + m * 16 + fr]; const unsigned en = ri.x;
            if (en != 0xffffffffu) {
                const float w = __uint_as_float(ri.y) * (WUNSCALE * YSCALE); unsigned char* dst = Y8 + ((size_t)(en & 1u) * TR + (en >> 1)) * D + nt * 128 + wc * 64 + fq * 4;
#pragma unroll
                for (int n = 0; n < 4; ++n) { const f32x4 o = acc[m][n] * w; *(unsigned*)(dst + n * 16) = pk_fp8x4(o[0], o[1], o[2], o[3]); }
            }
        }
    }
}

DEV void phase7(const Ctx& c) {
    const bf16_t* H1 = (const bf16_t*)(c.ws + WS_H0); const unsigned char* Y8 = c.ws + WS_Y;
    const float* g = c.in[I_LN2G]; const float* bt = c.in[I_LN2B];
    const int gw = c.vcu * 4 + c.wid, NGW = c.G * 4, lane = c.lane;
    for (int tok0 = gw; tok0 < TR; tok0 += 2 * NGW) {
        float v[2][16]; float st[2]; int tk[2];
#pragma unroll
        for (int r = 0; r < 2; ++r) {
            int tok = tok0 + r * NGW; if (tok >= TR) tok = tok0; tk[r] = tok;
#pragma unroll
            for (int i = 0; i < 2; ++i) {
                const u32x4 hw = *(const u32x4*)(H1 + (size_t)tok * D + i * 512 + lane * 8);
                const u32x2 y0 = *(const u32x2*)(Y8 + (size_t)tok * D + i * 512 + lane * 8);
                const u32x2 y1 = *(const u32x2*)(Y8 + ((size_t)TR + tok) * D + i * 512 + lane * 8);
#pragma unroll
                for (int q2 = 0; q2 < 2; ++q2) {
                    const auto a0 = __builtin_amdgcn_cvt_pk_f32_fp8((int)y0[q2], false), a1 = __builtin_amdgcn_cvt_pk_f32_fp8((int)y0[q2], true);
                    const auto b0 = __builtin_amdgcn_cvt_pk_f32_fp8((int)y1[q2], false), b1 = __builtin_amdgcn_cvt_pk_f32_fp8((int)y1[q2], true);
                    v[r][i * 8 + 4 * q2]     = ALPHA * bflo(hw[2 * q2]) + (a0[0] + b0[0]) * YUNSCALE;
                    v[r][i * 8 + 4 * q2 + 1] = ALPHA * bfhi(hw[2 * q2]) + (a0[1] + b0[1]) * YUNSCALE;
                    v[r][i * 8 + 4 * q2 + 2] = ALPHA * bflo(hw[2 * q2 + 1]) + (a1[0] + b1[0]) * YUNSCALE;
                    v[r][i * 8 + 4 * q2 + 3] = ALPHA * bfhi(hw[2 * q2 + 1]) + (a1[1] + b1[1]) * YUNSCALE;
                }
            }
        }
#pragma unroll
        for (int r = 0; r < 2; ++r) { float a = 0.f;
#pragma unroll
            for (int q = 0; q < 16; ++q) a += v[r][q];
            st[r] = a; }
        wave_sum_n<2>(st);
#pragma unroll
        for (int r = 0; r < 2; ++r) { const float mean = st[r] * (1.f / 1024.f); float a = 0.f;
#pragma unroll
            for (int q = 0; q < 16; ++q) { v[r][q] -= mean; a += v[r][q] * v[r][q]; }
            st[r] = a; }
        wave_sum_n<2>(st);
#pragma unroll
        for (int i = 0; i < 2; ++i)
#pragma unroll
            for (int q = 0; q < 2; ++q) {
                const int col = i * 512 + lane * 8 + q * 4;
                const f32x4 gg = *(const f32x4*)(g + col), bb = *(const f32x4*)(bt + col);
#pragma unroll
                for (int r = 0; r < 2; ++r) {
                    if (r == 1 && tok0 + NGW >= TR) continue;
                    const float rstd = rsqrt_(st[r] * (1.f / 1024.f) + EPS);
                    f32x4 o; o[0] = v[r][i * 8 + q * 4] * rstd * gg[0] + bb[0]; o[1] = v[r][i * 8 + q * 4 + 1] * rstd * gg[1] + bb[1];
                    o[2] = v[r][i * 8 + q * 4 + 2] * rstd * gg[2] + bb[2]; o[3] = v[r][i * 8 + q * 4 + 3] * rstd * gg[3] + bb[3];
                    *(f32x4*)(c.out + (size_t)tk[r] * D + col) = o;
                }
            }
    }
}

__global__ void __launch_bounds__(256, 2) fwd_kernel(Args a) {
    extern __shared__ __attribute__((aligned(16))) unsigned char lds[];
    Ctx c; c.in = a.in; c.out = a.out; c.ws = a.ws; c.lds = lds;
    c.tid = threadIdx.x; c.lane = c.tid & 63; c.wid = __builtin_amdgcn_readfirstlane(c.tid >> 6);
    c.G = gridDim.x; { const int bx = blockIdx.x; c.vcu = (c.G % 8 == 0) ? (bx % 8) * (c.G / 8) + bx / 8 : bx; }
    if (c.tid < 64) ((unsigned*)(lds + MISC_OFF))[c.tid] = 0u;
    __syncthreads();
    unsigned* ctl = (unsigned*)(a.ws + WS_CTL);
    XcdBarrier bar = xcd_barrier_post(ctl + CW_BAR, (volatile LAS unsigned*)(lds + MISC_OFF));
#ifdef ONLY_PH
#define PH_ON(k) ((k) == ONLY_PH)
#else
#define PH_ON(k) 1
#endif
    const int lo = a.ph_lo, hi = a.ph_hi;
#define RUN_PHASE(k, fn) if (PH_ON(k) && lo <= (k) && (k) < hi) { \
        for (int _rep = 0; _rep < ((REPEAT_PH == (k)) ? 2 : 1); ++_rep) { \
            int _t = threadIdx.x; asm volatile("" : "+v"(_t)); c.tid = _t; c.lane = _t & 63; c.wid = __builtin_amdgcn_readfirstlane(_t >> 6); \
            if ((k) == 5) phase5(c, _rep); else fn(c); \
            if (_rep == 0 && REPEAT_PH == (k)) xcd_barrier(bar); } \
        if ((k) + 1 < hi) xcd_barrier(bar); }
    RUN_PHASE(0, phase0)
    RUN_PHASE(1, phase1)
    RUN_PHASE(2, phase2)
    RUN_PHASE(3, phase3)
    RUN_PHASE(4, phase4)
    RUN_PHASE(5, phase0)
    RUN_PHASE(6, phase6a)
    RUN_PHASE(7, phase6b)
    RUN_PHASE(8, phase7)
}

extern "C" void kernel_launch(void* const* d_in, const int* in_sizes, int n_in, void* d_out, int out_size, void* d_ws, size_t ws_size, hipStream_t stream) {
    static int grid = 0;
    if (grid == 0) {
        if (n_in != 27 || in_sizes[0] != NB * SEQ * D || out_size != TR * D || ws_size < WS_END) {
            fprintf(stderr, "kernel_launch: shape mismatch n_in %d in0 %d out %d ws %zu\n", n_in, n_in > 0 ? in_sizes[0] : -1, out_size, ws_size); grid = -1; return; }
        int dev = 0, cus = 0, per_cu = 0;
        if (hipGetDevice(&dev) != hipSuccess || hipDeviceGetAttribute(&cus, hipDeviceAttributeMultiprocessorCount, dev) != hipSuccess) { grid = -1; return; }
        if (hipFuncSetAttribute((const void*)fwd_kernel, hipFuncAttributeMaxDynamicSharedMemorySize, LDS_BYTES) != hipSuccess) { grid = -1; return; }
        if (hipOccupancyMaxActiveBlocksPerMultiprocessor(&per_cu, (const void*)fwd_kernel, 256, LDS_BYTES) != hipSuccess || per_cu < 1) per_cu = 1;
        (void)hipGetLastError();
        if (per_cu > 2) per_cu = 2;
        grid = cus * per_cu;
        fprintf(stderr, "kernel_launch: grid %d (%d per CU)\n", grid, per_cu);
    }
    if (grid < 0) return;
    (void)hipMemsetAsync((char*)d_ws + WS_CTL, 0, CTL_ZERO_BYTES, stream);
    Args a{};
    for (int i = 0; i < 27; ++i) a.in[i] = (const float*)d_in[i];
    a.out = (float*)d_out; a.ws = (unsigned char*)d_ws;
    if (MK_N_LAUNCHES == 1) {
        a.ph_lo = 0; a.ph_hi = NPH;
        hipLaunchKernelGGL(fwd_kernel, dim3(grid), dim3(256), LDS_BYTES, stream, a);
    } else {
        for (int ph = 0; ph < NPH; ++ph) { a.ph_lo = ph; a.ph_hi = ph + 1; hipLaunchKernelGGL(fwd_kernel, dim3(grid), dim3(256), LDS_BYTES, stream, a); }
    }
}
```

```cpp
#include <hip/hip_runtime.h>
#include <cstdio>
#include <cstdint>

#ifndef REPEAT_PH
#define REPEAT_PH -1
#endif
#ifndef CONV_REPB
#define CONV_REPB 1
#endif
#ifndef CONV_REPC
#define CONV_REPC 1
#endif
#ifndef CONV_REPA
#define CONV_REPA 1
#endif
#ifndef MK_N_LAUNCHES
#define MK_N_LAUNCHES 1
#endif

#define DEV __device__ __forceinline__
#define LAS __attribute__((address_space(3)))
#define GAS __attribute__((address_space(1)))
typedef unsigned short bf16_t;
typedef short bf16x8 __attribute__((ext_vector_type(8)));
typedef short s16x4 __attribute__((ext_vector_type(4)));
typedef float f32x4 __attribute__((ext_vector_type(4)));
typedef float f32x16 __attribute__((ext_vector_type(16)));
typedef unsigned u32x4 __attribute__((ext_vector_type(4)));
typedef unsigned u32x2 __attribute__((ext_vector_type(2)));
typedef long i64x2 __attribute__((ext_vector_type(2)));
typedef int v8i __attribute__((ext_vector_type(8)));

constexpr int NB = 16, SEQ = 2048, NMETA = 16, L = SEQ + NMETA;
constexpr int T = NB * L;
constexpr int TR = NB * SEQ;
constexpr int D = 1024, NIN = 1696, CC = 512, QL = 384, KVL = 256, NH = 8, DQK = 96, DV = 64;
constexpr int NQ = NH * DQK;
constexpr int NKV = NH * (64 + DV);
constexpr int NE = 32, DE = 256, CONVK = 31;
constexpr float EPS = 1e-5f;
constexpr float ALPHA = 1.189207115002721f;
constexpr float QSCALE = 0.10206207261596577f * 1.4426950408889634f;
constexpr int NPH = 9;
constexpr float WSCALE = 16.f, WUNSCALE = 1.f / 16.f;
constexpr float YSCALE = 64.f, YUNSCALE = 1.f / 64.f;

constexpr size_t MiB = 1u << 20;
constexpr size_t WS_CTL = 0, CTL_ZERO_BYTES = 64 * 1024;
constexpr int CW_CNT = 1024, CNT_STRIDE = 64;
constexpr int CW_BAR = 4096;
constexpr size_t WS_LIST = 1 * MiB;
constexpr size_t WS_COMBW = 5 * MiB;
constexpr size_t WS_ROPE = 5 * MiB + 512 * 1024;
constexpr size_t WS_WIN = 6 * MiB;
constexpr size_t WS_WUQ = 10 * MiB;
constexpr size_t WS_WUKV = 11 * MiB;
constexpr size_t WS_WO = 12 * MiB;
constexpr size_t WS_WR = 14 * MiB;
constexpr size_t WS_RI = 14 * MiB + 512 * 1024;
constexpr size_t WS_SSQ_CQ = 404 * MiB + 512 * 1024;
constexpr size_t WS_SSQ_CKV = 402 * MiB;
constexpr size_t WS_SSQ_O = 403 * MiB;
constexpr size_t WS_WGU = 16 * MiB;
constexpr size_t WS_WD = 48 * MiB;
constexpr size_t WS_H1F8 = 130 * MiB;
constexpr size_t WS_H0 = 64 * MiB;
constexpr size_t WS_U = 130 * MiB;
constexpr size_t WS_CQ = 163 * MiB;
constexpr size_t WS_CKV = 188 * MiB;
constexpr size_t WS_KR = 205 * MiB;
constexpr size_t WS_Q = 208 * MiB;
constexpr size_t WS_KV = 257 * MiB;
constexpr size_t WS_R1 = 208 * MiB;
constexpr size_t WS_Y = 208 * MiB;
constexpr size_t WS_MG = 336 * MiB;
constexpr size_t WS_ACT = 336 * MiB;
constexpr size_t WS_DUMMY = 400 * MiB;
constexpr size_t WS_END = 406 * MiB;

constexpr int LDS_BYTES = 73728;
constexpr int MISC_OFF = LDS_BYTES - 256;
constexpr int RS_OFF = 65536;
constexpr int TBL_OFF = 66048;
constexpr int EXP_OFF = 67584;

DEV unsigned cvtpk(float lo, float hi) { unsigned r; asm("v_cvt_pk_bf16_f32 %0, %1, %2" : "=v"(r) : "v"(lo), "v"(hi)); return r; }
DEV float bflo(unsigned w) { return __uint_as_float(w << 16); }
DEV float bfhi(unsigned w) { return __uint_as_float(w & 0xffff0000u); }
DEV float dpp_add_qp(float v, int) { return v; }
template <int CTRL> DEV float dpp_mov(float v) { return __builtin_bit_cast(float, __builtin_amdgcn_update_dpp(0, __builtin_bit_cast(int, v), CTRL, 0xf, 0xf, false)); }
DEV float wave_sum(float v) {
    v += dpp_mov<0xB1>(v);
    v += dpp_mov<0x4E>(v);
    v += dpp_mov<0x141>(v);
    v += dpp_mov<0x140>(v);
    const int iv = __builtin_bit_cast(int, v);
    const float a = __builtin_bit_cast(float, __builtin_amdgcn_readlane(iv, 0)), b = __builtin_bit_cast(float, __builtin_amdgcn_readlane(iv, 16));
    const float c = __builtin_bit_cast(float, __builtin_amdgcn_readlane(iv, 32)), d = __builtin_bit_cast(float, __builtin_amdgcn_readlane(iv, 48));
    return (a + b) + (c + d);
}
DEV float rsqrt_(float x) { return __builtin_amdgcn_rsqf(x); }
DEV void st_bf4(bf16_t* p, f32x4 v) { u32x2 w = {cvtpk(v[0], v[1]), cvtpk(v[2], v[3])}; *(u32x2*)p = w; }
DEV unsigned pk_fp8x4(float a, float b, float c, float d) {
    int w = __builtin_amdgcn_cvt_pk_fp8_f32(a, b, 0, false); w = __builtin_amdgcn_cvt_pk_fp8_f32(c, d, w, true); return (unsigned)w; }
DEV float fast_exp2(float x) { return __builtin_amdgcn_exp2f(x); }
DEV float fast_rcp(float x) { return __builtin_amdgcn_rcpf(x); }
DEV float sigmoidf_(float g) { return fast_rcp(1.f + fast_exp2(-1.4426950408889634f * g)); }
#define LDS_WAIT() asm volatile("s_waitcnt lgkmcnt(0)" ::: "memory")
#define VM_WAIT() asm volatile("s_waitcnt vmcnt(0)" ::: "memory")

#define XB_TMO      128
#define XB_XCNT(j)  (256  + 64 * (j))
#define XB_XSUB(j)  (1280 + 64 * (j))
#define XB_XGEN(j)  (2304 + 64 * (j))
#define XB_TOP      3328
#define XB_TOPGEN   3392
#define XCD_BAR_WORDS 3456
#define XB_SPIN_CAP (1u << 22)
DEV unsigned xb_ld(unsigned* p)              { return __hip_atomic_load(p, __ATOMIC_RELAXED, __HIP_MEMORY_SCOPE_AGENT); }
DEV unsigned xb_add(unsigned* p, unsigned v) { return __hip_atomic_fetch_add(p, v, __ATOMIC_RELAXED, __HIP_MEMORY_SCOPE_AGENT); }
DEV unsigned xb_xcc_id() { return (unsigned)__builtin_amdgcn_s_getreg((3 << 11) | 20) & 0xFu; }
#define XB_SPIN(cond, bar) do { unsigned _sp = 0; while (cond) { __builtin_amdgcn_s_sleep(1); \
    if ((++_sp & 255u) == 0u) { if (xb_ld(&(bar)[XB_TMO])) break; if (_sp > XB_SPIN_CAP) { atomicAdd(&(bar)[XB_TMO], 1u); break; } } } } while (0)
struct XcdBarrier { unsigned* bar; unsigned x; volatile LAS unsigned* st; };
DEV XcdBarrier xcd_barrier_post(unsigned* bar, volatile LAS unsigned* st) {
    XcdBarrier b; b.bar = bar; b.x = xb_xcc_id(); b.st = st;
    if (threadIdx.x == 0) (void)xb_add(&bar[XB_XCNT(b.x)], 1u);
    return b;
}
DEV void xcd_barrier_complete(unsigned* bar, unsigned x, unsigned& nloc, unsigned& nx) {
    const unsigned G = gridDim.x * gridDim.y * gridDim.z;
    unsigned sum, cnt, mine, sp = 0u;
    for (;;) {
        sum = 0u; cnt = 0u; mine = 0u;
#pragma unroll
        for (unsigned j = 0; j < 16; ++j) { const unsigned c = xb_ld(&bar[XB_XCNT(j)]); sum += c; cnt += (c > 0u) ? 1u : 0u; mine = (j == x) ? c : mine; }
        if (sum == G) break;
        __builtin_amdgcn_s_sleep(1);
        if ((++sp & 255u) == 0u) { if (xb_ld(&bar[XB_TMO])) break; if (sp > XB_SPIN_CAP) { atomicAdd(&bar[XB_TMO], 1u); break; } }
    }
    nloc = mine > 0u ? mine : 1u; nx = cnt > 0u ? cnt : 1u;
}
DEV void xcd_barrier(const XcdBarrier& b) {
    asm volatile("s_waitcnt vmcnt(0)" ::: "memory");
    __syncthreads();
    if (threadIdx.x == 0) {
        unsigned* bar = b.bar;
        __builtin_amdgcn_s_waitcnt(0);
        unsigned nloc = b.st[0], nx = b.st[1];
        if (nloc == 0u) { xcd_barrier_complete(bar, b.x, nloc, nx); b.st[0] = nloc; b.st[1] = nx; }
        const unsigned old = xb_add(&bar[XB_XSUB(b.x)], 1u);
        const unsigned gen = old / nloc;
        if (old + 1u == (gen + 1u) * nloc) {
            __builtin_amdgcn_fence(__ATOMIC_RELEASE, "agent");
            asm volatile("s_waitcnt vmcnt(0)" ::: "memory");
            const unsigned og = xb_add(&bar[XB_TOP], 1u);
            const unsigned tg = og / nx;
            if (og + 1u == (tg + 1u) * nx) xb_add(&bar[XB_TOPGEN], 1u);
            else XB_SPIN(xb_ld(&bar[XB_TOPGEN]) == tg, bar);
            __builtin_amdgcn_fence(__ATOMIC_ACQUIRE, "agent");
            xb_add(&bar[XB_XGEN(b.x)], 1u);
            asm volatile("s_waitcnt vmcnt(0)" ::: "memory");
        } else {
            XB_SPIN(xb_ld(&bar[XB_XGEN(b.x)]) == gen, bar);
            __builtin_amdgcn_fence(__ATOMIC_ACQUIRE, "agent");
            asm volatile("s_waitcnt vmcnt(0)" ::: "memory");
        }
    }
    __syncthreads();
}

struct Args { const float* in[27]; float* out; unsigned char* ws; int ph_lo, ph_hi; };
struct Ctx {
    const float* const* in; float* out; unsigned char* ws; unsigned char* lds;
    int tid, lane, wid, vcu, G;
};
enum { I_X = 0, I_META, I_LNIN_G, I_LNIN_B, I_WIN, I_CONVW, I_CONVB, I_CLN_G, I_CLN_B, I_QNG, I_WUQ, I_KVNG, I_WUKV, I_COUT_G, I_AOUT_G, I_WO,
       I_LN1G, I_LN1B, I_WRG, I_BRG, I_WRE, I_BRE, I_WGATE, I_WUP, I_WDOWN, I_LN2G, I_LN2B };

DEV int nmap(int mode, int n) {
    if (mode == 1) { if (n < 512) return ((n >> 4) << 5) + (n & 15); if (n < 1024) return (((n - 512) >> 4) << 5) + 16 + (n & 15); return n; }
    if (mode == 2) return ((n >> 4) << 5) + (n & 15);
    if (mode == 3) return ((n >> 4) << 5) + 16 + (n & 15);
    return n;
}
DEV void p0_transpose_item(const float* __restrict__ W, int N, int k0, int n0, const float* __restrict__ kscale, bf16_t* WT, int ldt, int kout0, int mode,
                           float* scr, int lane) {
#pragma unroll 8
    for (int i = 0; i < 32; ++i) {
        const int kk = 2 * i + (lane >> 5);
        float v = W[(size_t)(k0 + kk) * N + n0 + (lane & 31)];
        if (kscale) v *= kscale[k0 + kk];
        scr[kk * 33 + (lane & 31)] = v;
    }
    LDS_WAIT(); asm volatile("" ::: "memory");
    const int c = lane & 7;
#pragma unroll
    for (int j = 0; j < 4; ++j) {
        const int n = (lane >> 3) + 8 * j; const float* s = scr + (8 * c) * 33 + n;
        u32x4 o; o.x = cvtpk(s[0 * 33], s[1 * 33]); o.y = cvtpk(s[2 * 33], s[3 * 33]); o.z = cvtpk(s[4 * 33], s[5 * 33]); o.w = cvtpk(s[6 * 33], s[7 * 33]);
        *(u32x4*)(WT + (size_t)nmap(mode, n0 + n) * ldt + kout0 + 8 * c) = o;
    }
    LDS_WAIT(); asm volatile("" ::: "memory");
}
DEV void p0_transpose_item_f8(const float* __restrict__ W, int N, int k0, int n0, float scale, unsigned char* W8, int ldt, int kout0, int mode, float* scr, int lane) {
#pragma unroll 8
    for (int i = 0; i < 32; ++i) { const int kk = 2 * i + (lane >> 5); scr[kk * 33 + (lane & 31)] = W[(size_t)(k0 + kk) * N + n0 + (lane & 31)] * scale; }
    LDS_WAIT(); asm volatile("" ::: "memory");
    const int c = lane & 7;
#pragma unroll
    for (int j = 0; j < 4; ++j) {
        const int n = (lane >> 3) + 8 * j; const float* sp = scr + (8 * c) * 33 + n;
        u32x2 o; o.x = pk_fp8x4(sp[0 * 33], sp[1 * 33], sp[2 * 33], sp[3 * 33]); o.y = pk_fp8x4(sp[4 * 33], sp[5 * 33], sp[6 * 33], sp[7 * 33]);
        *(u32x2*)(W8 + (size_t)nmap(mode, n0 + n) * ldt + kout0 + 8 * c) = o;
    }
    LDS_WAIT(); asm volatile("" ::: "memory");
}
template <int N> DEV void wave_sum_n(float (&v)[N]) {
#pragma unroll
    for (int i = 0; i < N; ++i) v[i] = wave_sum(v[i]);
}
template <int NR, bool F8 = false, bool BFIN = false> DEV void ln_rows_bf16(const float* const (&xrow)[NR], const float* g, const float* bta, bf16_t* const (&orow)[NR], unsigned char* const (&ldsrow)[NR], int lane, unsigned char* const* f8row = nullptr) {
    f32x4 v[NR][4]; float s[NR];
#pragma unroll
    for (int r = 0; r < NR; ++r)
#pragma unroll
        for (int j = 0; j < 4; ++j) {
            if (BFIN) { const u32x2 w = ((const u32x2*)xrow[r])[64 * j + lane]; v[r][j] = (f32x4){bflo(w.x), bfhi(w.x), bflo(w.y), bfhi(w.y)}; }
            else v[r][j] = ((const f32x4*)xrow[r])[64 * j + lane]; }
#pragma unroll
    for (int r = 0; r < NR; ++r) { s[r] = 0.f;
#pragma unroll
        for (int j = 0; j < 4; ++j) s[r] += (v[r][j].x + v[r][j].y) + (v[r][j].z + v[r][j].w); }
    wave_sum_n<NR>(s);
    float s2[NR];
#pragma unroll
    for (int r = 0; r < NR; ++r) { const float mean = s[r] * (1.f / 1024.f); s2[r] = 0.f;
#pragma unroll
        for (int j = 0; j < 4; ++j) { v[r][j] = v[r][j] - mean; s2[r] += (v[r][j].x * v[r][j].x + v[r][j].y * v[r][j].y) + (v[r][j].z * v[r][j].z + v[r][j].w * v[r][j].w); } }
    wave_sum_n<NR>(s2);
#pragma unroll
    for (int j = 0; j < 4; ++j) {
        const f32x4 gg = ((const f32x4*)g)[64 * j + lane], bb = ((const f32x4*)bta)[64 * j + lane];
#pragma unroll
        for (int r = 0; r < NR; ++r) {
            const float rstd = rsqrt_(s2[r] * (1.f / 1024.f) + EPS);
            const f32x4 o = v[r][j] * rstd * gg + bb;
            const u32x2 w = {cvtpk(o.x, o.y), cvtpk(o.z, o.w)};
            ((u32x2*)orow[r])[64 * j + lane] = w;
            if (ldsrow[r]) ((u32x2*)ldsrow[r])[64 * j + lane] = w;
            if (F8) ((unsigned*)f8row[r])[64 * j + lane] = pk_fp8x4(o.x, o.y, o.z, o.w);
        }
    }
}
__device__ const float INVF[16] = {1.0f, 0.5623413251903491f, 0.31622776601683794f, 0.1778279410038923f, 0.1f, 0.05623413251903491f, 0.031622776601683794f,
    0.01778279410038923f, 0.01f, 0.005623413251903491f, 0.0031622776601683794f, 0.001778279410038923f, 0.001f, 0.0005623413251903491f, 0.00031622776601683794f, 0.0001778279410038923f};
DEV void sincos_d(double a, float& sn, float& cs) {
    const double TWO_PI = 6.283185307179586476925286766559;
    const double k = __builtin_rint(a / TWO_PI);
    const double r = a - k * TWO_PI;
    const double r2 = r * r;
    double st = r, ct = 1.0, ssum = r, csum = 1.0;
#pragma unroll 1
    for (int i = 1; i <= 14; ++i) {
        ct = -ct * r2 / (double)((2 * i - 1) * (2 * i));  csum += ct;
        st = -st * r2 / (double)((2 * i) * (2 * i + 1));  ssum += st;
    }
    sn = (float)ssum; cs = (float)csum;
}
DEV void ew_block(const float* __restrict__ W, int N, int k0, int n0, unsigned char* W8, int ldt, int mode, int lane) {
    const int q = lane & 15, kq = lane >> 4;
    const float* src = W + (size_t)(k0 + 16 * kq) * N + n0 + 4 * q;
    f32x4 v[16];
#pragma unroll
    for (int i = 0; i < 16; ++i) v[i] = *(const f32x4*)(src + (size_t)i * N);
#pragma unroll
    for (int j = 0; j < 4; ++j) {
        u32x4 o;
        o.x = pk_fp8x4(v[0][j] * WSCALE, v[1][j] * WSCALE, v[2][j] * WSCALE, v[3][j] * WSCALE);
        o.y = pk_fp8x4(v[4][j] * WSCALE, v[5][j] * WSCALE, v[6][j] * WSCALE, v[7][j] * WSCALE);
        o.z = pk_fp8x4(v[8][j] * WSCALE, v[9][j] * WSCALE, v[10][j] * WSCALE, v[11][j] * WSCALE);
        o.w = pk_fp8x4(v[12][j] * WSCALE, v[13][j] * WSCALE, v[14][j] * WSCALE, v[15][j] * WSCALE);
        *(u32x4*)(W8 + (size_t)nmap(mode, n0 + 4 * q + j) * ldt + k0 + 16 * kq) = o;
    }
}
DEV void expert_weight_item(const Ctx& c, int r, float*  ) {
    unsigned char* Wgu8 = c.ws + WS_WGU; unsigned char* Wd8 = c.ws + WS_WD;
    if (r < 2048) { const int e = r >> 6, qq = r & 63, kb = qq >> 2, nb = qq & 3;
        ew_block(c.in[I_WGATE] + (size_t)e * D * DE, DE, 64 * kb, 64 * nb, Wgu8 + (size_t)e * 512 * 1024, 1024, 2, c.lane); return; } r -= 2048;
    if (r < 2048) { const int e = r >> 6, qq = r & 63, kb = qq >> 2, nb = qq & 3;
        ew_block(c.in[I_WUP] + (size_t)e * D * DE, DE, 64 * kb, 64 * nb, Wgu8 + (size_t)e * 512 * 1024, 1024, 3, c.lane); return; } r -= 2048;
    { const int e = r >> 6, qq = r & 63, kb = qq >> 4, nb = qq & 15;
        ew_block(c.in[I_WDOWN] + (size_t)e * DE * D, D, 64 * kb, 64 * nb, Wd8 + (size_t)e * 1024 * 256, 256, 0, c.lane); }
}
DEV void phase0(const Ctx& c) {
    float* scr = (float*)(c.lds + c.wid * 8448);
    const int gw = c.vcu * 4 + c.wid, NGW = c.G * 4;
    constexpr int I_IN = 16 * 53, I_UQ = 6 * 24, I_UKV = 4 * 32, I_O = 16 * 32;
    bf16_t* WinT = (bf16_t*)(c.ws + WS_WIN); bf16_t* WuqT = (bf16_t*)(c.ws + WS_WUQ); bf16_t* WukvT = (bf16_t*)(c.ws + WS_WUKV);
    bf16_t* WoT = (bf16_t*)(c.ws + WS_WO);
    constexpr int NITEMS0 = I_IN + I_UQ + I_UKV + I_O;
    for (int it = gw; it < NITEMS0; it += NGW) {
        int r = it;
        if (r < I_IN) { const int kb = r / 53, nb = r % 53; p0_transpose_item(c.in[I_WIN], NIN, 64 * kb, 32 * nb, nullptr, WinT, 1024, 64 * kb, 1, scr, c.lane); continue; } r -= I_IN;
        if (r < I_UQ) { const int kb = r / 24, nb = r % 24; p0_transpose_item(c.in[I_WUQ], NQ, 64 * kb, 32 * nb, c.in[I_QNG], WuqT, QL, 64 * kb, 0, scr, c.lane); continue; } r -= I_UQ;
        if (r < I_UKV) { const int kb = r / 32, nb = r % 32; p0_transpose_item(c.in[I_WUKV], NKV, 64 * kb, 32 * nb, c.in[I_KVNG], WukvT, KVL, 64 * kb, 0, scr, c.lane); continue; } r -= I_UKV;
        { const int kb = r / 32, nb = r % 32;
            if (kb < 8) p0_transpose_item(c.in[I_WO], D, 64 * kb, 32 * nb, nullptr, WoT, 1024, 64 * kb + 512, 0, scr, c.lane);
            else        p0_transpose_item(c.in[I_WO], D, 64 * kb, 32 * nb, c.in[I_AOUT_G] - 512, WoT, 1024, 64 * kb - 512, 0, scr, c.lane); }
    }
    const int gt = c.vcu * 256 + c.tid, NGT = c.G * 256;
    bf16_t* WrT = (bf16_t*)(c.ws + WS_WR);
    for (int i = gt; i < 48 * 1024; i += NGT) {
        const int n = i >> 10, k = i & 1023; float v = 0.f;
        if (n < 4) v = c.in[I_WRG][k * 4 + n]; else if (n < 36) v = c.in[I_WRE][k * 32 + (n - 4)];
        WrT[i] = (bf16_t)(cvtpk(v, 0.f) & 0xffffu);
    }
    float* rc = (float*)(c.ws + WS_ROPE); float* rs = rc + L * 16;
    for (int i = gt; i < L * 16; i += NGT) {
        const int p = i >> 4, f = i & 15; const float ang = (float)p * INVF[f];
        float sn, cs; sincos_d((double)ang, sn, cs); rc[i] = cs; rs[i] = sn;
    }
    bf16_t* h0 = (bf16_t*)(c.ws + WS_H0);
    for (int t = gw; t < T; t += 2 * NGW) {
        const float* src[2]; bf16_t* dst[2]; unsigned char* ldsn[2] = {nullptr, nullptr};
#pragma unroll
        for (int r = 0; r < 2; ++r) { int tt = t + r * NGW; if (tt >= T) tt = t;
            const int b = tt / L, p = tt - b * L;
            src[r] = (p < NMETA) ? c.in[I_META] + (size_t)p * D : c.in[I_X] + ((size_t)b * SEQ + (p - NMETA)) * D;
            dst[r] = h0 + (size_t)tt * D; }
        ln_rows_bf16<2>(src, c.in[I_LNIN_G], c.in[I_LNIN_B], dst, ldsn, c.lane);
    }
}

struct StageGeo { int r[4]; int c; };
DEV StageGeo stage_geo(int tid) {
    const int lane = tid & 63, wid = tid >> 6; StageGeo g;
    const int rl = lane >> 2, cl = ((lane & 3) * 8) ^ ((lane >> 5) << 4);
#pragma unroll
    for (int i = 0; i < 4; ++i) g.r[i] = (((wid + 4 * i) >> 1) << 4) + rl;
    g.c = ((wid & 1) << 5) + cl;
    return g;
}
template <bool SSQ, bool FP8 = false>
DEV void gemm_mainloop(f32x4 (&acc)[4][4], const bf16_t* ap0, const bf16_t* ap1, const bf16_t* ap2, const bf16_t* ap3,
                       const bf16_t* bp0, const bf16_t* bp1, const bf16_t* bp2, const bf16_t* bp3,
                       int nk, unsigned char* lds, int ssq_steps, float ssq_inv_dim, bool skip_wc1 = false) {
    const int tid = threadIdx.x, lane = tid & 63, wid = tid >> 6, wr = wid >> 1, wc = wid & 1, fr = lane & 15, fq = lane >> 4;
    const int xs = (fr >> 1) & 7;
    const int lo = ((fr * 64 + fq * 16) ^ ((fr >> 3) << 5));
    const int lo0 = lo, lo1 = lo + 1024;
    const int a_off = wr * 8192, b_off = 16384 + wc * 8192;
    const int dst = tid * 16;
#pragma unroll
    for (int m = 0; m < 4; ++m)
#pragma unroll
        for (int n = 0; n < 4; ++n) acc[m][n] = (f32x4){0.f, 0.f, 0.f, 0.f};
    __syncthreads();
#define GLDS(src, off) __builtin_amdgcn_global_load_lds((const unsigned*)(src), (unsigned LAS*)(lds + (off)), 16, 0, 0)
#define STAGE(kt, b) do { const int _k = (kt) * 64; \
        GLDS(ap0 + _k, (b) * 32768 + dst);          GLDS(ap1 + _k, (b) * 32768 + dst + 4096); \
        GLDS(ap2 + _k, (b) * 32768 + dst + 8192);   GLDS(ap3 + _k, (b) * 32768 + dst + 12288); \
        GLDS(bp0 + _k, (b) * 32768 + 16384 + dst);  GLDS(bp1 + _k, (b) * 32768 + 16384 + dst + 4096); \
        GLDS(bp2 + _k, (b) * 32768 + 16384 + dst + 8192); GLDS(bp3 + _k, (b) * 32768 + 16384 + dst + 12288); } while (0)
    STAGE(0, 0);
    for (int kt = 0; kt < nk; ++kt) {
        VM_WAIT();
        __syncthreads();
        const int b = kt & 1;
        if (SSQ && kt == ssq_steps) {
            const float* rsl = (const float*)(lds + RS_OFF);
#pragma unroll
            for (int m = 0; m < 4; ++m) { const float r = rsl[wr * 64 + m * 16 + fr];
#pragma unroll
                for (int n = 0; n < 4; ++n) acc[m][n] = acc[m][n] * r; }
        }
        if (kt + 1 < nk) { if (b) STAGE(kt + 1, 0); else STAGE(kt + 1, 1); }
        const unsigned char* base = lds + b * 32768;
        if (skip_wc1 && wc == 1) {
        } else if (FP8) {
            const int cb0 = fq * 32, cb1 = fq * 32 + 16;
            const int q0 = (cb0 >> 6) * 1024 + ((fr * 64 + (cb0 & 63)) ^ ((fr >> 3) << 5)), q1 = (cb1 >> 6) * 1024 + ((fr * 64 + (cb1 & 63)) ^ ((fr >> 3) << 5));
            v8i ax[4], bx[4];
#pragma unroll
            for (int m = 0; m < 4; ++m) { const u32x4 c0 = *(const u32x4*)(base + a_off + m * 2048 + q0), c1 = *(const u32x4*)(base + a_off + m * 2048 + q1);
                ax[m] = (v8i){(int)c0.x, (int)c0.y, (int)c0.z, (int)c0.w, (int)c1.x, (int)c1.y, (int)c1.z, (int)c1.w}; }
#pragma unroll
            for (int n = 0; n < 4; ++n) { const u32x4 c0 = *(const u32x4*)(base + b_off + n * 2048 + q0), c1 = *(const u32x4*)(base + b_off + n * 2048 + q1);
                bx[n] = (v8i){(int)c0.x, (int)c0.y, (int)c0.z, (int)c0.w, (int)c1.x, (int)c1.y, (int)c1.z, (int)c1.w}; }
#pragma unroll
            for (int m = 0; m < 4; ++m)
#pragma unroll
                for (int n = 0; n < 4; ++n) acc[m][n] = __builtin_amdgcn_mfma_scale_f32_16x16x128_f8f6f4(bx[n], ax[m], acc[m][n], 0, 0, 0, 0x7F7F7F7F, 0, 0x7F7F7F7F);
        } else {
#pragma unroll
        for (int ks = 0; ks < 2; ++ks) {
            bf16x8 af[4], bf[4];
#pragma unroll
            for (int m = 0; m < 4; ++m) af[m] = *(const bf16x8*)(base + a_off + m * 2048 + (ks ? lo1 : lo0));
#pragma unroll
            for (int n = 0; n < 4; ++n) bf[n] = *(const bf16x8*)(base + b_off + n * 2048 + (ks ? lo1 : lo0));
#pragma unroll
            for (int m = 0; m < 4; ++m)
#pragma unroll
                for (int n = 0; n < 4; ++n) acc[m][n] = __builtin_amdgcn_mfma_f32_16x16x32_bf16(bf[n], af[m], acc[m][n], 0, 0, 0);
        }
        }
    }
    if (SSQ && ssq_steps == nk) {
        __syncthreads();
        const float* rsl = (const float*)(lds + RS_OFF);
#pragma unroll
        for (int m = 0; m < 4; ++m) { const float r = rsl[wr * 64 + m * 16 + fr];
#pragma unroll
            for (int n = 0; n < 4; ++n) acc[m][n] = acc[m][n] * r; }
    }
#undef STAGE
#undef GLDS
}

DEV void phase1(const Ctx& c) {
    const bf16_t* h0 = (const bf16_t*)(c.ws + WS_H0); const bf16_t* WinT = (const bf16_t*)(c.ws + WS_WIN);
    bf16_t* U = (bf16_t*)(c.ws + WS_U); bf16_t* CQ = (bf16_t*)(c.ws + WS_CQ); bf16_t* CKV = (bf16_t*)(c.ws + WS_CKV); bf16_t* KR = (bf16_t*)(c.ws + WS_KR);
    const float* rc = (const float*)(c.ws + WS_ROPE); const float* rs = rc + L * 16;
    const StageGeo g = stage_geo(c.tid);
    const int lane = c.lane, wr = c.wid >> 1, wc = c.wid & 1, fr = lane & 15, fq = lane >> 4;
    constexpr int NT = 14, NU = (T / 128) * NT;
    for (int u = c.vcu; u < NU; u += c.G) {
        const int mt = u / NT, nt = u - mt * NT;
        const bf16_t* A = h0 + (size_t)(mt * 128) * D + g.c; const bf16_t* B = WinT + (size_t)(nt * 128) * D + g.c;
        f32x4 acc[4][4];
        gemm_mainloop<false>(acc, A + (size_t)g.r[0] * D, A + (size_t)g.r[1] * D, A + (size_t)g.r[2] * D, A + (size_t)g.r[3] * D,
                             B + (size_t)g.r[0] * D, B + (size_t)g.r[1] * D, B + (size_t)g.r[2] * D, B + (size_t)g.r[3] * D, 16, c.lds, 0, 0.f, nt == 13);
        const int row0 = mt * 128 + wr * 64 + fr;
        if (nt < 8) {
#pragma unroll
            for (int m = 0; m < 4; ++m) { const size_t row = row0 + m * 16;
#pragma unroll
                for (int i = 0; i < 2; ++i) {
                    f32x4 a = acc[m][2 * i], gt = acc[m][2 * i + 1], o;
#pragma unroll
                    for (int j = 0; j < 4; ++j) o[j] = a[j] * sigmoidf_(gt[j]);
                    st_bf4(U + row * CC + nt * 64 + wc * 32 + i * 16 + fq * 4, o);
                } }
        } else if (nt < 13) {
            const bool isq = nt < 11;
            bf16_t* dstb = isq ? CQ + (nt - 8) * 128 + wc * 64 + fq * 4 : CKV + (nt - 11) * 128 + wc * 64 + fq * 4;
            const int ldd = isq ? QL : KVL;
            float* ssb = isq ? (float*)(c.ws + WS_SSQ_CQ) + (nt - 8) * 2 + wc : (float*)(c.ws + WS_SSQ_CKV) + (nt - 11) * 2 + wc;
            const int lds_ = isq ? 8 : 4;
#pragma unroll
            for (int m = 0; m < 4; ++m) { const size_t row = row0 + m * 16; float sq = 0.f;
#pragma unroll
                for (int n = 0; n < 4; ++n) { st_bf4(dstb + row * ldd + n * 16, acc[m][n]);
                    sq += (acc[m][n][0] * acc[m][n][0] + acc[m][n][1] * acc[m][n][1]) + (acc[m][n][2] * acc[m][n][2] + acc[m][n][3] * acc[m][n][3]); }
                sq += __shfl_xor(sq, 16); sq += __shfl_xor(sq, 32);
                if (fq == 0) ssb[row * lds_] = sq; }
        } else if (wc == 0) {
#pragma unroll
            for (int m = 0; m < 4; ++m) { const int row = row0 + m * 16; const int p = row % L;
                const f32x4 cs = *(const f32x4*)(rc + p * 16 + fq * 4), sn = *(const f32x4*)(rs + p * 16 + fq * 4);
                const f32x4 x1 = acc[m][0], x2 = acc[m][1];
                st_bf4(KR + (size_t)row * 32 + fq * 4, x1 * cs - x2 * sn);
                st_bf4(KR + (size_t)row * 32 + 16 + fq * 4, x1 * sn + x2 * cs); }
        }
    }
}

DEV void conv_unit(const Ctx& c, int b, int j) {
    const bf16_t* U = (const bf16_t*)(c.ws + WS_U);
    bf16_t* MG = (bf16_t*)(c.ws + WS_MG);
    const float* cw = c.in[I_CONVW]; const float* cb = c.in[I_CONVB];
    const int p0 = j * 32;
    float* ytile = (float*)c.lds;
    __syncthreads();
#pragma unroll 1
    for (int pass = 0; pass < 2; ++pass) {
        const int ch = c.tid + 256 * pass;
        float win[62]; unsigned raw[62];
        const bf16_t* ub = U + (size_t)b * L * CC + ch;
#pragma unroll
        for (int rep = 0; rep < CONV_REPA; ++rep) {
        asm volatile("" : "+v"(ub) :: "memory");
#pragma unroll
        for (int i = 0; i < 62; ++i) { const int p = p0 - 30 + i; const int pc = p < 0 ? 0 : (p >= L ? L - 1 : p); raw[i] = ub[(size_t)pc * CC]; }
        if (rep + 1 < CONV_REPA) {
#pragma unroll
            for (int i = 0; i < 62; ++i) asm volatile("" :: "v"(raw[i]));
        }
        }
        float w[31];
#pragma unroll
        for (int k = 0; k < 31; ++k) w[k] = cw[k * CC + ch];
        float bias = cb[ch];
        __builtin_amdgcn_sched_barrier(0);
#pragma unroll
        for (int i = 0; i < 62; ++i) { const int p = p0 - 30 + i; win[i] = (p >= 0 && p < L) ? __uint_as_float(raw[i] << 16) : 0.f; }
#pragma unroll
        for (int rep = 0; rep < CONV_REPB; ++rep) {
        asm volatile("" : "+v"(bias) :: "memory");
#pragma unroll
        for (int tt = 0; tt < 32; ++tt) {
            float a0 = bias;
#pragma unroll
            for (int k = 0; k < 31; ++k) a0 += w[k] * win[tt + k];
            ytile[tt * 512 + ch] = a0;
        }
        }
    }
    __syncthreads();
    const float* g1 = c.in[I_CLN_G]; const float* b1 = c.in[I_CLN_B]; const float* g2 = c.in[I_COUT_G];
    float G1[8], B1[8], G2[8];
    { const f32x4 a = *(const f32x4*)(g1 + c.lane * 8), bq = *(const f32x4*)(g1 + c.lane * 8 + 4); G1[0]=a.x;G1[1]=a.y;G1[2]=a.z;G1[3]=a.w;G1[4]=bq.x;G1[5]=bq.y;G1[6]=bq.z;G1[7]=bq.w; }
    { const f32x4 a = *(const f32x4*)(b1 + c.lane * 8), bq = *(const f32x4*)(b1 + c.lane * 8 + 4); B1[0]=a.x;B1[1]=a.y;B1[2]=a.z;B1[3]=a.w;B1[4]=bq.x;B1[5]=bq.y;B1[6]=bq.z;B1[7]=bq.w; }
    { const f32x4 a = *(const f32x4*)(g2 + c.lane * 8), bq = *(const f32x4*)(g2 + c.lane * 8 + 4); G2[0]=a.x;G2[1]=a.y;G2[2]=a.z;G2[3]=a.w;G2[4]=bq.x;G2[5]=bq.y;G2[6]=bq.z;G2[7]=bq.w; }
#pragma unroll
    for (int rep = 0; rep < CONV_REPC; ++rep) {
    asm volatile("" : "+v"(ytile) :: "memory");
    float v[8][8]; float st[8];
#pragma unroll
    for (int i = 0; i < 8; ++i) { const int tt = c.wid * 8 + i;
        const f32x4 ya = *(const f32x4*)(ytile + tt * 512 + c.lane * 8), yb = *(const f32x4*)(ytile + tt * 512 + c.lane * 8 + 4);
        v[i][0]=ya.x;v[i][1]=ya.y;v[i][2]=ya.z;v[i][3]=ya.w;v[i][4]=yb.x;v[i][5]=yb.y;v[i][6]=yb.z;v[i][7]=yb.w;
        st[i] = ((v[i][0] + v[i][1]) + (v[i][2] + v[i][3])) + ((v[i][4] + v[i][5]) + (v[i][6] + v[i][7])); }
    wave_sum_n<8>(st);
#pragma unroll
    for (int i = 0; i < 8; ++i) { const float mean = st[i] * (1.f / 512.f); float a = 0.f;
#pragma unroll
        for (int q = 0; q < 8; ++q) { v[i][q] -= mean; a += v[i][q] * v[i][q]; }
        st[i] = a; }
    wave_sum_n<8>(st);
#pragma unroll
    for (int i = 0; i < 8; ++i) { const float rstd = rsqrt_(st[i] * (1.f / 512.f) + EPS); float a = 0.f;
#pragma unroll
        for (int q = 0; q < 8; ++q) { const float x = v[i][q] * rstd * G1[q] + B1[q]; const float y = x * sigmoidf_(x); v[i][q] = y; a += y * y; }
        st[i] = a; }
    wave_sum_n<8>(st);
#pragma unroll
    for (int i = 0; i < 8; ++i) {
        const int p = p0 + c.wid * 8 + i;
        {
            const float r2 = rsqrt_(st[i] * (1.f / 512.f) + EPS);
            u32x4 o;
            o.x = cvtpk(v[i][0] * r2 * G2[0], v[i][1] * r2 * G2[1]); o.y = cvtpk(v[i][2] * r2 * G2[2], v[i][3] * r2 * G2[3]);
            o.z = cvtpk(v[i][4] * r2 * G2[4], v[i][5] * r2 * G2[5]); o.w = cvtpk(v[i][6] * r2 * G2[6], v[i][7] * r2 * G2[7]);
            const size_t tok = (size_t)b * SEQ + (p - NMETA);
            bf16_t* dstp = (p >= NMETA && p < L) ? MG + tok * D + 512 + c.lane * 8 : (bf16_t*)(c.ws + WS_DUMMY) + c.lane * 8;
            *(u32x4*)dstp = o;
        }
    }
    }
}
DEV void rope4(f32x4& x1, f32x4& x2, const float* rc, const float* rs, int p, int fq) {
    const f32x4 cs = *(const f32x4*)(rc + p * 16 + fq * 4), sn = *(const f32x4*)(rs + p * 16 + fq * 4);
    const f32x4 a = x1 * cs - x2 * sn, bb = x1 * sn + x2 * cs; x1 = a; x2 = bb;
}
template <int SEL> DEV void phase2_t(const Ctx& c) {
    const bf16_t* CQ = (const bf16_t*)(c.ws + WS_CQ); const bf16_t* CKV = (const bf16_t*)(c.ws + WS_CKV);
    const bf16_t* WuqT = (const bf16_t*)(c.ws + WS_WUQ); const bf16_t* WukvT = (const bf16_t*)(c.ws + WS_WUKV);
    bf16_t* Q = (bf16_t*)(c.ws + WS_Q); bf16_t* KV = (bf16_t*)(c.ws + WS_KV);
    const float* rc = (const float*)(c.ws + WS_ROPE); const float* rs = rc + L * 16;
    const StageGeo g = stage_geo(c.tid);
    const int lane = c.lane, wr = c.wid >> 1, wc = c.wid & 1, fr = lane & 15, fq = lane >> 4;
    constexpr int MT = T / 128, NUQ = MT * 6, NUKV = MT * 8, NUC = NB * 65, NU = NUQ + NUKV + NUC;
    const int li = c.vcu & 63, rev = ((li >> 5) ^ li) & 1;
    const int nmine = (NU - c.vcu + c.G - 1) / c.G;
    for (int it = 0; it < nmine; ++it) {
        const int u = c.vcu + (rev ? (nmine - 1 - it) : it) * c.G;
        if (SEL == 1 && u >= NUKV + NUQ) continue;
        if (SEL == 2 && u < NUKV + NUQ) continue;
        if (u < NUKV) {
            const int mt = u >> 3, nt = u & 7;
            const bf16_t* A = CKV + (size_t)(mt * 128) * KVL + g.c; const bf16_t* B = WukvT + (size_t)(nt * 128) * KVL + g.c;
            f32x4 acc[4][4];
            __syncthreads();
            if (c.tid < 128) { const f32x4 p4 = *(const f32x4*)((const float*)(c.ws + WS_SSQ_CKV) + (size_t)(mt * 128 + c.tid) * 4);
                ((float*)(c.lds + RS_OFF))[c.tid] = rsqrt_(((p4.x + p4.y) + (p4.z + p4.w)) * (1.f / 256.f) + EPS); }
            gemm_mainloop<true>(acc, A + (size_t)g.r[0] * KVL, A + (size_t)g.r[1] * KVL, A + (size_t)g.r[2] * KVL, A + (size_t)g.r[3] * KVL,
                                B + (size_t)g.r[0] * KVL, B + (size_t)g.r[1] * KVL, B + (size_t)g.r[2] * KVL, B + (size_t)g.r[3] * KVL, 4, c.lds, 4, 1.f / 256.f);
            const int row0 = mt * 128 + wr * 64 + fr;
#pragma unroll
            for (int m = 0; m < 4; ++m) { const size_t row = row0 + m * 16;
#pragma unroll
                for (int n = 0; n < 4; ++n) st_bf4(KV + row * NKV + nt * 128 + wc * 64 + n * 16 + fq * 4, acc[m][n]); }
        } else if (u < NUKV + NUQ) {
            const int v = u - NUKV, mt = v / 6, nt = v - mt * 6;
            const bf16_t* A = CQ + (size_t)(mt * 128) * QL + g.c; const bf16_t* B = WuqT + (size_t)(nt * 128) * QL + g.c;
            f32x4 acc[4][4];
            __syncthreads();
            if (c.tid < 128) { const float* pp = (const float*)(c.ws + WS_SSQ_CQ) + (size_t)(mt * 128 + c.tid) * 8; const f32x4 p4 = *(const f32x4*)pp; const float2 p2 = *(const float2*)(pp + 4);
                ((float*)(c.lds + RS_OFF))[c.tid] = rsqrt_((((p4.x + p4.y) + (p4.z + p4.w)) + (p2.x + p2.y)) * (1.f / 384.f) + EPS); }
            gemm_mainloop<true>(acc, A + (size_t)g.r[0] * QL, A + (size_t)g.r[1] * QL, A + (size_t)g.r[2] * QL, A + (size_t)g.r[3] * QL,
                                B + (size_t)g.r[0] * QL, B + (size_t)g.r[1] * QL, B + (size_t)g.r[2] * QL, B + (size_t)g.r[3] * QL, 6, c.lds, 6, 1.f / 384.f);
            const int row0 = mt * 128 + wr * 64 + fr;
            const int t16 = (nt * 8 + wc * 4) % 6;
#pragma unroll
            for (int m = 0; m < 4; ++m) { const int row = row0 + m * 16; const int p = row % L;
#pragma unroll
                for (int n = 0; n < 4; ++n) acc[m][n] = acc[m][n] * QSCALE;
                if (t16 == 4) rope4(acc[m][0], acc[m][1], rc, rs, p, fq);
                if (t16 == 2) rope4(acc[m][2], acc[m][3], rc, rs, p, fq);
#pragma unroll
                for (int n = 0; n < 4; ++n) st_bf4(Q + (size_t)row * NQ + nt * 128 + wc * 64 + n * 16 + fq * 4, acc[m][n]); }
        } else {
            const int v = u - NUKV - NUQ; conv_unit(c, v / 65, v % 65);
        }
    }
}

DEV void phase2(const Ctx& c) { phase2_t<0>(c); }
DEV void phase2g(const Ctx& c) { phase2_t<1>(c); }
DEV void phase2c(const Ctx& c) { phase2_t<2>(c); }
DEV int crow(int r, int hi) { return (r & 3) + 8 * (r >> 2) + 4 * hi; }
#define KSWZ(row, colB) ((row) * 256 + ((colB) ^ (((row) & 7) << 4)))
#define SBAR() __builtin_amdgcn_sched_barrier(0)
DEV int v_st(int k, int cc) { const int kk = (k & ~0xC) | ((k & 4) << 1) | ((k & 8) >> 1); return ((kk >> 3) * 4 + (cc >> 5)) * 512 + ((kk & 7) * 32 + (cc & 31)) * 2; }
DEV int v_rd_base(int lane) { return ((lane & 3) << 3) | (((lane >> 2) & 3) << 6) | (((lane >> 4) & 1) << 5) | (((lane >> 5) & 1) << 8); }
constexpr int v_rd_off(int d0, int ks, int half) { return d0 * 512 + ks * 4096 + half * 2048; }
template <int OFF> DEV s16x4 tr_read(int vb) { s16x4 r; asm volatile("ds_read_b64_tr_b16 %0, %1 offset:%2" : "=&v"(r) : "v"(vb), "i"(OFF) : "memory"); return r; }
template <int D0> DEV void pv_one(f32x16& od, int vb, bf16x8 pa0, bf16x8 pa1, bf16x8 pa2, bf16x8 pa3) {
    const s16x4 l0 = tr_read<v_rd_off(D0, 0, 0)>(vb), h0 = tr_read<v_rd_off(D0, 0, 1)>(vb), l1 = tr_read<v_rd_off(D0, 1, 0)>(vb), h1 = tr_read<v_rd_off(D0, 1, 1)>(vb);
    const s16x4 l2 = tr_read<v_rd_off(D0, 2, 0)>(vb), h2 = tr_read<v_rd_off(D0, 2, 1)>(vb), l3 = tr_read<v_rd_off(D0, 3, 0)>(vb), h3 = tr_read<v_rd_off(D0, 3, 1)>(vb);
    asm volatile("s_waitcnt lgkmcnt(0)" ::: "memory"); SBAR();
#define PK(Lo, Hi) (bf16x8){Lo[0], Lo[1], Lo[2], Lo[3], Hi[0], Hi[1], Hi[2], Hi[3]}
    od = __builtin_amdgcn_mfma_f32_32x32x16_bf16(pa0, PK(l0, h0), od, 0, 0, 0);
    od = __builtin_amdgcn_mfma_f32_32x32x16_bf16(pa1, PK(l1, h1), od, 0, 0, 0);
    od = __builtin_amdgcn_mfma_f32_32x32x16_bf16(pa2, PK(l2, h2), od, 0, 0, 0);
    od = __builtin_amdgcn_mfma_f32_32x32x16_bf16(pa3, PK(l3, h3), od, 0, 0, 0);
#undef PK
}
constexpr float ATT_THR = 8.f;
constexpr int AT_V = 0, AT_K = 32768, AT_WS = 65536;
DEV void attn_unit(const Ctx& c, int b, int h, int qb) {
    const bf16_t* Q = (const bf16_t*)(c.ws + WS_Q); const bf16_t* KV = (const bf16_t*)(c.ws + WS_KV); const bf16_t* KR = (const bf16_t*)(c.ws + WS_KR);
    bf16_t* MG = (bf16_t*)(c.ws + WS_MG);
    unsigned char* lds = c.lds;
    const int tid = c.tid, wid = c.wid, lane = c.lane, r32 = lane & 31, hi = lane >> 5;
    float* wsf = (float*)(lds + AT_WS) + wid * 64; float* li_l = wsf; float* al_l = wsf + 32;
    const int NT = 2 * qb + 3;
    const int my_last = 2 * qb + (wid >> 1) + 1;
    bf16x8 qr[6];
    { const size_t t = (size_t)b * L + NMETA + qb * 128 + wid * 32 + r32;
      const bf16_t* Qw = Q + t * NQ + h * DQK + hi * 8;
#pragma unroll
      for (int d0 = 0; d0 < 6; ++d0) qr[d0] = *(const bf16x8*)(Qw + d0 * 16); }
    const int srow = tid >> 2, sq = tid & 3;
    const int vst0 = v_st(srow, sq * 16), vst1 = v_st(srow, sq * 16 + 8);
    const int kst0 = KSWZ(srow, sq * 32), kst1 = KSWZ(srow, sq * 32 + 16), kst2 = KSWZ(srow, 128 + sq * 16);
    const int vb0 = (int)(uintptr_t)(lds + AT_V) + v_rd_base(lane);
    u32x4 sk0, sk1, sk2, sv0, sv1;
#define SLOAD(j) do { int pos = (j) * 64 + srow - 48; pos = pos < 0 ? 0 : pos; const size_t tk = (size_t)b * L + pos; \
        const bf16_t* kvp = KV + tk * NKV + h * 128 + sq * 16; \
        sk0 = *(const u32x4*)(kvp); sk1 = *(const u32x4*)(kvp + 8); sv0 = *(const u32x4*)(kvp + 64); sv1 = *(const u32x4*)(kvp + 72); \
        sk2 = *(const u32x4*)(KR + tk * 32 + sq * 8); } while (0)
#define SWRITE(bb) do { unsigned char* kb = lds + AT_K + (bb) * 16384; unsigned char* vbp = lds + AT_V + (bb) * 16384; \
        *(u32x4*)(kb + kst0) = sk0; *(u32x4*)(kb + kst1) = sk1; *(u32x4*)(kb + kst2) = sk2; *(u32x4*)(vbp + vst0) = sv0; *(u32x4*)(vbp + vst1) = sv1; } while (0)
    float m_reg = 0.f, l_reg = 0.f; f32x16 o[2] = {};
    __syncthreads();
    SLOAD(0); SWRITE(0); __syncthreads();
    for (int j = 0; j < NT; ++j) {
        const int bsel = j & 1;
        if (j + 1 < NT) SLOAD(j + 1);
        if (j <= my_last) {
            const unsigned char* Ks = lds + AT_K + bsel * 16384;
            f32x16 p0, p1;
            { const float nm = -m_reg;
#pragma unroll
              for (int r = 0; r < 16; ++r) { p0[r] = nm; p1[r] = nm; } }
#pragma unroll
            for (int d0 = 0; d0 < 6; ++d0) { const int cb = (d0 * 16 + hi * 8) * 2;
                const bf16x8 k0 = *(const bf16x8*)(Ks + KSWZ(r32, cb)); const bf16x8 k1 = *(const bf16x8*)(Ks + KSWZ(32 + r32, cb));
                p0 = __builtin_amdgcn_mfma_f32_32x32x16_bf16(k0, qr[d0], p0, 0, 0, 0);
                p1 = __builtin_amdgcn_mfma_f32_32x32x16_bf16(k1, qr[d0], p1, 0, 0, 0); }
            if (j == 0) {
#pragma unroll
                for (int r = 0; r < 16; ++r) p0[r] = -1e30f;
#pragma unroll
                for (int r = 0; r < 8; ++r) p1[r] = -1e30f;
            }
            float pmax = fmaxf(fmaxf(p0[0], p0[1]), p0[2]);
#pragma unroll
            for (int r = 3; r < 15; r += 2) pmax = fmaxf(fmaxf(pmax, p0[r]), p0[r + 1]);
            pmax = fmaxf(fmaxf(pmax, p0[15]), p1[0]);
#pragma unroll
            for (int r = 1; r < 15; r += 2) pmax = fmaxf(fmaxf(pmax, p1[r]), p1[r + 1]);
            pmax = fmaxf(pmax, p1[15]);
            { auto rr = __builtin_amdgcn_permlane32_swap(__float_as_uint(pmax), __float_as_uint(pmax), false, false);
              pmax = fmaxf(__uint_as_float(rr[0]), __uint_as_float(rr[1])); }
            float ps = 0.f;
            if (__any(pmax > ATT_THR)) {
                const float dm = fmaxf(pmax, 0.f), alpha = fast_exp2(-dm); m_reg += dm;
#pragma unroll
                for (int r = 0; r < 16; ++r) { p0[r] -= dm; p1[r] -= dm; }
                l_reg *= alpha;
                if (hi == 0) al_l[r32] = alpha;
                asm volatile("s_waitcnt lgkmcnt(0)" ::: "memory");
#pragma unroll
                for (int r = 0; r < 16; ++r) { const float a = al_l[crow(r, hi)]; o[0][r] *= a; o[1][r] *= a; }
            }
#pragma unroll
            for (int r = 0; r < 16; ++r) { p0[r] = fast_exp2(p0[r]); ps += p0[r]; }
#pragma unroll
            for (int r = 0; r < 16; ++r) { p1[r] = fast_exp2(p1[r]); ps += p1[r]; }
            { auto rr = __builtin_amdgcn_permlane32_swap(__float_as_uint(ps), __float_as_uint(ps), false, false);
              ps = __uint_as_float(rr[0]) + __uint_as_float(rr[1]); }
            l_reg += ps;
            bf16x8 pa0, pa1, pa2, pa3;
#define PK4(P, BASE, OUT) do { unsigned a0 = cvtpk(P[BASE + 0], P[BASE + 1]), a1 = cvtpk(P[BASE + 2], P[BASE + 3]);   \
    unsigned b0 = cvtpk(P[BASE + 4], P[BASE + 5]), b1 = cvtpk(P[BASE + 6], P[BASE + 7]);                              \
    auto r0 = __builtin_amdgcn_permlane32_swap(a0, b0, false, false); auto r1 = __builtin_amdgcn_permlane32_swap(a1, b1, false, false); \
    u32x4 w = {r0[0], r1[0], r0[1], r1[1]}; OUT = *reinterpret_cast<bf16x8*>(&w); } while (0)
            PK4(p0, 0, pa0); PK4(p0, 8, pa1); PK4(p1, 0, pa2); PK4(p1, 8, pa3);
#undef PK4
            const int vb = vb0 + bsel * 16384;
            pv_one<0>(o[0], vb, pa0, pa1, pa2, pa3); pv_one<1>(o[1], vb, pa0, pa1, pa2, pa3);
        }
        if (j + 1 < NT) { if (bsel) SWRITE(0); else SWRITE(1); }
        __syncthreads();
    }
    if (hi == 0) li_l[r32] = l_reg;
    asm volatile("s_waitcnt lgkmcnt(0)" ::: "memory");
    const size_t tok0 = (size_t)b * SEQ + qb * 128 + wid * 32;
    float* SSO = (float*)(c.ws + WS_SSQ_O);
#pragma unroll
    for (int r = 0; r < 16; ++r) {
        const int orow = crow(r, hi); const float rl = fast_rcp(li_l[orow]);
        bf16_t* dst = MG + (tok0 + orow) * D + h * DV + r32;
        const float a0 = o[0][r] * rl, a1 = o[1][r] * rl;
        dst[0]  = (bf16_t)(cvtpk(a0, 0.f) & 0xffffu);
        dst[32] = (bf16_t)(cvtpk(a1, 0.f) & 0xffffu);
        float sq = a0 * a0 + a1 * a1;
        sq += dpp_mov<0xB1>(sq); sq += dpp_mov<0x4E>(sq); sq += dpp_mov<0x141>(sq); sq += dpp_mov<0x140>(sq);
        sq += __shfl_xor(sq, 16);
        if (r32 == 0) SSO[(tok0 + orow) * 8 + h] = sq;
    }
#undef SLOAD
#undef SWRITE
}
DEV void phase3(const Ctx& c) {
    const int nslots = NB * NH * 4;
    float* scr = (float*)(c.lds + c.wid * 8448);
    const int gw = c.vcu * 4 + c.wid, NGW = c.G * 4;
    constexpr int NWI = 6144;
    int wi = gw;
#define EW_ITEMS(n) do { __syncthreads(); for (int _q = 0; _q < (n) && wi < NWI; ++_q, wi += NGW) expert_weight_item(c, wi, scr); } while (0)
    for (int v = c.vcu; v < nslots; v += c.G) {
        const int bh = v >> 2, s = v & 3, b = bh >> 3, h = bh & 7;
        attn_unit(c, b, h, 15 - s); EW_ITEMS(1); attn_unit(c, b, h, s); EW_ITEMS(1); attn_unit(c, b, h, 11 - s); EW_ITEMS(1); attn_unit(c, b, h, 4 + s);
    }
    __syncthreads();
    for (; wi < NWI; wi += NGW) expert_weight_item(c, wi, scr);
#undef EW_ITEMS
}

DEV void phase4(const Ctx& c) {
    const bf16_t* MG = (const bf16_t*)(c.ws + WS_MG); const bf16_t* WoT = (const bf16_t*)(c.ws + WS_WO); const bf16_t* h0 = (const bf16_t*)(c.ws + WS_H0);
    bf16_t* R1 = (bf16_t*)(c.ws + WS_R1);
    const StageGeo g = stage_geo(c.tid);
    const int lane = c.lane, wr = c.wid >> 1, wc = c.wid & 1, fr = lane & 15, fq = lane >> 4;
    constexpr int NU = (TR / 128) * 8;
    for (int u = c.vcu; u < NU; u += c.G) {
        const int mt = u >> 3, nt = u & 7;
        const bf16_t* A = MG + (size_t)(mt * 128) * D + g.c; const bf16_t* B = WoT + (size_t)(nt * 128) * D + g.c;
        f32x4 acc[4][4];
        __syncthreads();
        if (c.tid < 128) { const float* pp = (const float*)(c.ws + WS_SSQ_O) + (size_t)(mt * 128 + c.tid) * 8; const f32x4 pa = *(const f32x4*)pp, pb = *(const f32x4*)(pp + 4);
            ((float*)(c.lds + RS_OFF))[c.tid] = rsqrt_((((pa.x + pa.y) + (pa.z + pa.w)) + ((pb.x + pb.y) + (pb.z + pb.w))) * (1.f / 512.f) + EPS); }
        gemm_mainloop<true>(acc, A + (size_t)g.r[0] * D, A + (size_t)g.r[1] * D, A + (size_t)g.r[2] * D, A + (size_t)g.r[3] * D,
                            B + (size_t)g.r[0] * D, B + (size_t)g.r[1] * D, B + (size_t)g.r[2] * D, B + (size_t)g.r[3] * D, 16, c.lds, 8, 1.f / 512.f);
#pragma unroll
        for (int m = 0; m < 4; ++m) {
            const int tok = mt * 128 + wr * 64 + m * 16 + fr;
            const size_t t = (size_t)(tok >> 11) * L + NMETA + (tok & 2047);
#pragma unroll
            for (int n = 0; n < 4; ++n) {
                const int col = nt * 128 + wc * 64 + n * 16 + fq * 4;
                const u32x2 hw = *(const u32x2*)(h0 + t * D + col);
                f32x4 o; o[0] = ALPHA * bflo(hw.x) + acc[m][n][0]; o[1] = ALPHA * bfhi(hw.x) + acc[m][n][1];
                o[2] = ALPHA * bflo(hw.y) + acc[m][n][2]; o[3] = ALPHA * bfhi(hw.y) + acc[m][n][3];
                st_bf4(R1 + (size_t)tok * D + col, o);
            }
        }
    }
}

constexpr int P5_ROWB = 2064, P5_PART = 33280, P5_LG = 45568, P5_BIAS = 48128, P5_AGG = 48384;
DEV void phase5(const Ctx& c, int ALT = 0) {
    const bf16_t* R1 = (const bf16_t*)(c.ws + WS_R1); bf16_t* H1 = (bf16_t*)(c.ws + WS_H0);
    const bf16_t* WrT = (const bf16_t*)(c.ws + WS_WR);
    unsigned* cnt = (unsigned*)(c.ws + WS_CTL) + CW_CNT + ALT * 32; unsigned* list = (unsigned*)(c.ws + (ALT ? 404 * MiB : WS_LIST)); float* combw = (float*)(c.ws + WS_COMBW);
    const int lane = c.lane, wid = c.wid, fr = lane & 15, fq = lane >> 4;
    float* part = (float*)(c.lds + P5_PART); float* lgs = (float*)(c.lds + P5_LG); float* biasl = (float*)(c.lds + P5_BIAS);
    __syncthreads();
    if (c.tid < 36) biasl[c.tid] = (c.tid < 4) ? c.in[I_BRG][c.tid] : c.in[I_BRE][c.tid - 4];
    bf16x8 wf[8][3];
#pragma unroll
    for (int ks = 0; ks < 8; ++ks)
#pragma unroll
        for (int n = 0; n < 3; ++n) wf[ks][n] = *(const bf16x8*)(WrT + (size_t)(n * 16 + fr) * D + wid * 256 + ks * 32 + fq * 8);
    unsigned* lcnt = (unsigned*)(c.lds + P5_AGG); unsigned* lbase = lcnt + 32; unsigned* ent = lcnt + 64;
    if (c.tid < 32) lcnt[c.tid] = 0u;
    int nent = 0;
    for (int u = c.vcu; u < TR / 16; u += c.G) {
        const int tok0 = u * 16;
        { const float* src[4]; bf16_t* dst[4]; unsigned char* ldsn[4]; unsigned char* f8n[4];
#pragma unroll
          for (int i = 0; i < 4; ++i) { const int tl = wid * 4 + i; const size_t tok = tok0 + tl; src[i] = (const float*)(R1 + tok * D); dst[i] = H1 + tok * D; ldsn[i] = c.lds + tl * P5_ROWB; f8n[i] = c.ws + WS_H1F8 + tok * D; }
          ln_rows_bf16<4, true, true>(src, c.in[I_LN1G], c.in[I_LN1B], dst, ldsn, lane, f8n); }
        __syncthreads();
        f32x4 acc[3] = {};
#pragma unroll
        for (int ks = 0; ks < 8; ++ks) {
            const int k = wid * 256 + ks * 32 + fq * 8;
            const bf16x8 a = *(const bf16x8*)(c.lds + fr * P5_ROWB + k * 2);
#pragma unroll
            for (int n = 0; n < 3; ++n) acc[n] = __builtin_amdgcn_mfma_f32_16x16x32_bf16(wf[ks][n], a, acc[n], 0, 0, 0);
        }
#pragma unroll
        for (int n = 0; n < 3; ++n) *(f32x4*)(part + (wid * 16 + fr) * 48 + n * 16 + fq * 4) = acc[n];
        __syncthreads();
#pragma unroll
        for (int i = 0; i < 3; ++i) { const int idx = c.tid + 256 * i;
            if (idx < 576) { const int tk = idx / 36, l = idx - tk * 36;
                lgs[tk * 40 + l] = ((part[tk * 48 + l] + part[(16 + tk) * 48 + l]) + (part[(32 + tk) * 48 + l] + part[(48 + tk) * 48 + l])) + biasl[l]; } }
        __syncthreads();
        if (c.tid < 16) {
            const float* lg = lgs + c.tid * 40;
            int gi = 0; float gm = lg[0];
#pragma unroll
            for (int i = 1; i < 4; ++i) { const float v = lg[i]; if (v > gm) { gm = v; gi = i; } }
            float gs = 0.f;
#pragma unroll
            for (int i = 0; i < 4; ++i) gs += __expf(lg[i] - gm);
            const float gw = 1.f / gs;
            const float* le = lg + 4 + gi * 8;
            float v0 = le[0], v1 = -3.0e38f; int i0 = 0, i1 = 0;
#pragma unroll
            for (int i = 1; i < 8; ++i) { const float v = le[i];
                if (v > v0) { v1 = v0; i1 = i0; v0 = v; i0 = i; } else if (v > v1) { v1 = v; i1 = i; } }
            const float ex = __expf(v1 - v0), inv = 1.f / (1.f + ex);
            const int tok = tok0 + c.tid; const unsigned e0 = gi * 8 + i0, e1 = gi * 8 + i1;
            combw[tok * 2] = gw * inv; combw[tok * 2 + 1] = gw * ex * inv;
            const unsigned r0 = atomicAdd(&lcnt[e0], 1u), r1 = atomicAdd(&lcnt[e1], 1u);
            const int ei = nent * 32 + c.tid * 2;
            ent[2 * ei] = (unsigned)(tok * 2);         ent[2 * ei + 1] = (e0 << 16) | r0;
            ent[2 * ei + 2] = (unsigned)(tok * 2 + 1); ent[2 * ei + 3] = (e1 << 16) | r1;
        }
        ++nent;
    }
    __syncthreads();
    if (c.tid < 32) { const unsigned n = lcnt[c.tid]; lbase[c.tid] = n ? atomicAdd(&cnt[c.tid * CNT_STRIDE], n) : 0u; }
    __syncthreads();
    for (int i = c.tid; i < nent * 32; i += 256) { const unsigned t2 = ent[2 * i], er = ent[2 * i + 1]; const unsigned e = er >> 16;
        list[(size_t)e * TR + lbase[e] + (er & 0xffffu)] = t2; }
}
DEV void bar20(const Ctx& c) {}
DEV void moe_tiles(const Ctx& c) {
    const unsigned* cnt = (const unsigned*)(c.ws + WS_CTL) + CW_CNT; int* ts = (int*)(c.lds + EXP_OFF);
    __syncthreads();
    if (c.tid == 0) { int s = 0; for (int e = 0; e < NE; ++e) { const int n = (int)__hip_atomic_load(&cnt[e * CNT_STRIDE], __ATOMIC_RELAXED, __HIP_MEMORY_SCOPE_AGENT);
            ts[e] = s; ts[40 + e] = n; s += (n + 127) >> 7; } ts[NE] = s; }
    __syncthreads();
}
DEV void phase6a(const Ctx& c) {
    const bf16_t* H18 = (const bf16_t*)(c.ws + WS_H1F8); const bf16_t* Wgu8 = (const bf16_t*)(c.ws + WS_WGU); unsigned char* ACT8 = c.ws + WS_ACT;
    const unsigned* list = (const unsigned*)(c.ws + WS_LIST);
    moe_tiles(c);
    const int* ts = (const int*)(c.lds + EXP_OFF); unsigned* tbl = (unsigned*)(c.lds + TBL_OFF);
    const StageGeo g = stage_geo(c.tid);
    const int lane = c.lane, wr = c.wid >> 1, wc = c.wid & 1, fr = lane & 15, fq = lane >> 4;
    const int NU = ts[NE] * 4;
    int e = 0;
    u32x2* RI = (u32x2*)(c.ws + WS_RI); const float* combw = (const float*)(c.ws + WS_COMBW);
    for (int u = c.vcu; u < NU; u += c.G) {
        const int rt = u >> 2, nt = u & 3;
        while (ts[e + 1] <= rt) ++e;
        const int j0 = (rt - ts[e]) * 128; const int ne = ts[40 + e];
        __syncthreads();
        if (c.tid < 128) { const int j = j0 + c.tid; const unsigned en = (j < ne) ? list[(size_t)e * TR + j] : 0xffffffffu; tbl[c.tid] = en;
            if (nt == 0) { u32x2 ri; ri.x = en; ri.y = (en == 0xffffffffu) ? 0u : __float_as_uint(combw[en]); RI[(size_t)rt * 128 + c.tid] = ri; } }
        __syncthreads();
        size_t ro[4];
#pragma unroll
        for (int i = 0; i < 4; ++i) { const unsigned en = tbl[g.r[i]]; ro[i] = (en == 0xffffffffu) ? 0 : (size_t)(en >> 1) * (D / 2); }
        const bf16_t* A = H18 + g.c; const bf16_t* B = Wgu8 + ((size_t)e * 512 + nt * 128) * (D / 2) + g.c;
        f32x4 acc[4][4];
        gemm_mainloop<false, true>(acc, A + ro[0], A + ro[1], A + ro[2], A + ro[3],
                             B + (size_t)g.r[0] * (D / 2), B + (size_t)g.r[1] * (D / 2), B + (size_t)g.r[2] * (D / 2), B + (size_t)g.r[3] * (D / 2), 8, c.lds, 0, 0.f);
#pragma unroll
        for (int m = 0; m < 4; ++m) { const size_t row = (size_t)rt * 128 + wr * 64 + m * 16 + fr;
#pragma unroll
            for (int i = 0; i < 2; ++i) {
                const f32x4 gt = acc[m][2 * i], up = acc[m][2 * i + 1]; f32x4 o;
#pragma unroll
                for (int j = 0; j < 4; ++j) { const float gv = gt[j] * WUNSCALE; o[j] = gv * sigmoidf_(gv) * (up[j] * WUNSCALE); }
                *(unsigned*)(ACT8 + row * DE + nt * 64 + wc * 32 + i * 16 + fq * 4) = pk_fp8x4(o[0], o[1], o[2], o[3]);
            } }
    }
}
DEV void phase6b(const Ctx& c) {
    const bf16_t* ACT8 = (const bf16_t*)(c.ws + WS_ACT); const bf16_t* Wd8 = (const bf16_t*)(c.ws + WS_WD); unsigned char* Y8 = c.ws + WS_Y;
    const u32x2* RI = (const u32x2*)(c.ws + WS_RI);
    moe_tiles(c);
    const int* ts = (const int*)(c.lds + EXP_OFF); u32x2* tbl = (u32x2*)(c.lds + TBL_OFF);
    const StageGeo g = stage_geo(c.tid);
    const int lane = c.lane, wr = c.wid >> 1, wc = c.wid & 1, fr = lane & 15, fq = lane >> 4;
    const int NU = ts[NE] * 8;
    int e = 0;
    for (int u = c.vcu; u < NU; u += c.G) {
        const int rt = u >> 3, nt = u & 7;
        while (ts[e + 1] <= rt) ++e;
        __syncthreads();
        if (c.tid < 128) tbl[c.tid] = RI[(size_t)rt * 128 + c.tid];
        const bf16_t* A = ACT8 + (size_t)(rt * 128) * (DE / 2) + g.c; const bf16_t* B = Wd8 + ((size_t)e * 1024 + nt * 128) * (DE / 2) + g.c;
        f32x4 acc[4][4];
        gemm_mainloop<false, true>(acc, A + (size_t)g.r[0] * (DE / 2), A + (size_t)g.r[1] * (DE / 2), A + (size_t)g.r[2] * (DE / 2), A + (size_t)g.r[3] * (DE / 2),
                             B + (size_t)g.r[0] * (DE / 2), B + (size_t)g.r[1] * (DE / 2), B + (size_t)g.r[2] * (DE / 2), B + (size_t)g.r[3] * (DE / 2), 2, c.lds, 0, 0.f);
#pragma unroll
        for (int m = 0; m < 4; ++m) {
            const u32x2 ri = tbl[wr * 64 + m * 16 + fr]; const unsigned en = ri.x;
            if (en != 0xffffffffu) {
                const float w = __uint_as_float(ri.y) * (WUNSCALE * YSCALE); unsigned char* dst = Y8 + ((size_t)(en & 1u) * TR + (en >> 1)) * D + nt * 128 + wc * 64 + fq * 4;
#pragma unroll
                for (int n = 0; n < 4; ++n) { const f32x4 o = acc[m][n] * w; *(unsigned*)(dst + n * 16) = pk_fp8x4(o[0], o[1], o[2], o[3]); }
            }
        }
    }
}

DEV void phase7(const Ctx& c) {
    const bf16_t* H1 = (const bf16_t*)(c.ws + WS_H0); const unsigned char* Y8 = c.ws + WS_Y;
    const float* g = c.in[I_LN2G]; const float* bt = c.in[I_LN2B];
    const int gw = c.vcu * 4 + c.wid, NGW = c.G * 4, lane = c.lane;
    for (int tok0 = gw; tok0 < TR; tok0 += 2 * NGW) {
        float v[2][16]; float st[2]; int tk[2];
#pragma unroll
        for (int r = 0; r < 2; ++r) {
            int tok = tok0 + r * NGW; if (tok >= TR) tok = tok0; tk[r] = tok;
#pragma unroll
            for (int i = 0; i < 2; ++i) {
                const u32x4 hw = *(const u32x4*)(H1 + (size_t)tok * D + i * 512 + lane * 8);
                const u32x2 y0 = *(const u32x2*)(Y8 + (size_t)tok * D + i * 512 + lane * 8);
                const u32x2 y1 = *(const u32x2*)(Y8 + ((size_t)TR + tok) * D + i * 512 + lane * 8);
#pragma unroll
                for (int q2 = 0; q2 < 2; ++q2) {
                    const auto a0 = __builtin_amdgcn_cvt_pk_f32_fp8((int)y0[q2], false), a1 = __builtin_amdgcn_cvt_pk_f32_fp8((int)y0[q2], true);
                    const auto b0 = __builtin_amdgcn_cvt_pk_f32_fp8((int)y1[q2], false), b1 = __builtin_amdgcn_cvt_pk_f32_fp8((int)y1[q2], true);
                    v[r][i * 8 + 4 * q2]     = ALPHA * bflo(hw[2 * q2]) + (a0[0] + b0[0]) * YUNSCALE;
                    v[r][i * 8 + 4 * q2 + 1] = ALPHA * bfhi(hw[2 * q2]) + (a0[1] + b0[1]) * YUNSCALE;
                    v[r][i * 8 + 4 * q2 + 2] = ALPHA * bflo(hw[2 * q2 + 1]) + (a1[0] + b1[0]) * YUNSCALE;
                    v[r][i * 8 + 4 * q2 + 3] = ALPHA * bfhi(hw[2 * q2 + 1]) + (a1[1] + b1[1]) * YUNSCALE;
                }
            }
        }
#pragma unroll
        for (int r = 0; r < 2; ++r) { float a = 0.f;
#pragma unroll
            for (int q = 0; q < 16; ++q) a += v[r][q];
            st[r] = a; }
        wave_sum_n<2>(st);
#pragma unroll
        for (int r = 0; r < 2; ++r) { const float mean = st[r] * (1.f / 1024.f); float a = 0.f;
#pragma unroll
            for (int q = 0; q < 16; ++q) { v[r][q] -= mean; a += v[r][q] * v[r][q]; }
            st[r] = a; }
        wave_sum_n<2>(st);
#pragma unroll
        for (int i = 0; i < 2; ++i)
#pragma unroll
            for (int q = 0; q < 2; ++q) {
                const int col = i * 512 + lane * 8 + q * 4;
                const f32x4 gg = *(const f32x4*)(g + col), bb = *(const f32x4*)(bt + col);
#pragma unroll
                for (int r = 0; r < 2; ++r) {
                    if (r == 1 && tok0 + NGW >= TR) continue;
                    const float rstd = rsqrt_(st[r] * (1.f / 1024.f) + EPS);
                    f32x4 o; o[0] = v[r][i * 8 + q * 4] * rstd * gg[0] + bb[0]; o[1] = v[r][i * 8 + q * 4 + 1] * rstd * gg[1] + bb[1];
                    o[2] = v[r][i * 8 + q * 4 + 2] * rstd * gg[2] + bb[2]; o[3] = v[r][i * 8 + q * 4 + 3] * rstd * gg[3] + bb[3];
                    *(f32x4*)(c.out + (size_t)tk[r] * D + col) = o;
                }
            }
    }
}

__global__ void __launch_bounds__(256, 2) fwd_kernel(Args a) {
    extern __shared__ __attribute__((aligned(16))) unsigned char lds[];
    Ctx c; c.in = a.in; c.out = a.out; c.ws = a.ws; c.lds = lds;
    c.tid = threadIdx.x; c.lane = c.tid & 63; c.wid = __builtin_amdgcn_readfirstlane(c.tid >> 6);
    c.G = gridDim.x; { const int bx = blockIdx.x; c.vcu = (c.G % 8 == 0) ? (bx % 8) * (c.G / 8) + bx / 8 : bx; }
    if (c.tid < 64) ((unsigned*)(lds + MISC_OFF))[c.tid] = 0u;
    __syncthreads();
    unsigned* ctl = (unsigned*)(a.ws + WS_CTL);
    XcdBarrier bar = xcd_barrier_post(ctl + CW_BAR, (volatile LAS unsigned*)(lds + MISC_OFF));
#ifdef ONLY_PH
#define PH_ON(k) ((k) == ONLY_PH)
#else
#define PH_ON(k) 1
#endif
    const int lo = a.ph_lo, hi = a.ph_hi;
#define RUN_PHASE(k, fn) if (PH_ON(k) && lo <= (k) && (k) < hi) { \
        for (int _rep = 0; _rep < ((REPEAT_PH == (k)) ? 2 : 1); ++_rep) { \
            int _t = threadIdx.x; asm volatile("" : "+v"(_t)); c.tid = _t; c.lane = _t & 63; c.wid = __builtin_amdgcn_readfirstlane(_t >> 6); \
            if ((k) == 5) phase5(c, _rep); else fn(c); \
            if (_rep == 0 && REPEAT_PH == (k)) xcd_barrier(bar); } \
        if ((k) + 1 < hi) xcd_barrier(bar); }
    RUN_PHASE(0, phase0)
    RUN_PHASE(1, phase1)
    RUN_PHASE(2, phase2)
    RUN_PHASE(3, phase3)
    RUN_PHASE(4, phase4)
    RUN_PHASE(5, phase0)
    RUN_PHASE(6, phase6a)
    RUN_PHASE(7, phase6b)
    RUN_PHASE(8, phase7)
}

extern "C" void kernel_launch(void* const* d_in, const int* in_sizes, int n_in, void* d_out, int out_size, void* d_ws, size_t ws_size, hipStream_t stream) {
    static int grid = 0;
    if (grid == 0) {
        if (n_in != 27 || in_sizes[0] != NB * SEQ * D || out_size != TR * D || ws_size < WS_END) {
            fprintf(stderr, "kernel_launch: shape mismatch n_in %d in0 %d out %d ws %zu\n", n_in, n_in > 0 ? in_sizes[0] : -1, out_size, ws_size); grid = -1; return; }
        int dev = 0, cus = 0, per_cu = 0;
        if (hipGetDevice(&dev) != hipSuccess || hipDeviceGetAttribute(&cus, hipDeviceAttributeMultiprocessorCount, dev) != hipSuccess) { grid = -1; return; }
        if (hipFuncSetAttribute((const void*)fwd_kernel, hipFuncAttributeMaxDynamicSharedMemorySize, LDS_BYTES) != hipSuccess) { grid = -1; return; }
        if (hipOccupancyMaxActiveBlocksPerMultiprocessor(&per_cu, (const void*)fwd_kernel, 256, LDS_BYTES) != hipSuccess || per_cu < 1) per_cu = 1;
        (void)hipGetLastError();
        if (per_cu > 2) per_cu = 2;
        grid = cus * per_cu;
        fprintf(stderr, "kernel_launch: grid %d (%d per CU)\n", grid, per_cu);
    }
    if (grid < 0) return;
    (void)hipMemsetAsync((char*)d_ws + WS_CTL, 0, CTL_ZERO_BYTES, stream);
    Args a{};
    for (int i = 0; i < 27; ++i) a.in[i] = (const float*)d_in[i];
    a.out = (float*)d_out; a.ws = (unsigned char*)d_ws;
    if (MK_N_LAUNCHES == 1) {
        a.ph_lo = 0; a.ph_hi = NPH;
        hipLaunchKernelGGL(fwd_kernel, dim3(grid), dim3(256), LDS_BYTES, stream, a);
    } else {
        for (int ph = 0; ph < NPH; ++ph) { a.ph_lo = ph; a.ph_hi = ph + 1; hipLaunchKernelGGL(fwd_kernel, dim3(grid), dim3(256), LDS_BYTES, stream, a); }
    }
}
```

```cpp
#include <hip/hip_runtime.h>
#include <cstdio>
#include <cstdint>

#ifndef REPEAT_PH
#define REPEAT_PH -1
#endif
#ifndef CONV_REPB
#define CONV_REPB 1
#endif
#ifndef CONV_REPC
#define CONV_REPC 1
#endif
#ifndef CONV_REPA
#define CONV_REPA 1
#endif
#ifndef MK_N_LAUNCHES
#define MK_N_LAUNCHES 1
#endif

#define DEV __device__ __forceinline__
#define LAS __attribute__((address_space(3)))
#define GAS __attribute__((address_space(1)))
typedef unsigned short bf16_t;
typedef short bf16x8 __attribute__((ext_vector_type(8)));
typedef short s16x4 __attribute__((ext_vector_type(4)));
typedef float f32x4 __attribute__((ext_vector_type(4)));
typedef float f32x16 __attribute__((ext_vector_type(16)));
typedef unsigned u32x4 __attribute__((ext_vector_type(4)));
typedef unsigned u32x2 __attribute__((ext_vector_type(2)));
typedef long i64x2 __attribute__((ext_vector_type(2)));
typedef int v8i __attribute__((ext_vector_type(8)));

constexpr int NB = 16, SEQ = 2048, NMETA = 16, L = SEQ + NMETA;
constexpr int T = NB * L;
constexpr int TR = NB * SEQ;
constexpr int D = 1024, NIN = 1696, CC = 512, QL = 384, KVL = 256, NH = 8, DQK = 96, DV = 64;
constexpr int NQ = NH * DQK;
constexpr int NKV = NH * (64 + DV);
constexpr int NE = 32, DE = 256, CONVK = 31;
constexpr float EPS = 1e-5f;
constexpr float ALPHA = 1.189207115002721f;
constexpr float QSCALE = 0.10206207261596577f * 1.4426950408889634f;
constexpr int NPH = 9;
constexpr float WSCALE = 16.f, WUNSCALE = 1.f / 16.f;
constexpr float YSCALE = 64.f, YUNSCALE = 1.f / 64.f;

constexpr size_t MiB = 1u << 20;
constexpr size_t WS_CTL = 0, CTL_ZERO_BYTES = 64 * 1024;
constexpr int CW_CNT = 1024, CNT_STRIDE = 64;
constexpr int CW_BAR = 4096;
constexpr size_t WS_LIST = 1 * MiB;
constexpr size_t WS_COMBW = 5 * MiB;
constexpr size_t WS_ROPE = 5 * MiB + 512 * 1024;
constexpr size_t WS_WIN = 6 * MiB;
constexpr size_t WS_WUQ = 10 * MiB;
constexpr size_t WS_WUKV = 11 * MiB;
constexpr size_t WS_WO = 12 * MiB;
constexpr size_t WS_WR = 14 * MiB;
constexpr size_t WS_RI = 14 * MiB + 512 * 1024;
constexpr size_t WS_SSQ_CQ = 404 * MiB + 512 * 1024;
constexpr size_t WS_SSQ_CKV = 402 * MiB;
constexpr size_t WS_SSQ_O = 403 * MiB;
constexpr size_t WS_WGU = 16 * MiB;
constexpr size_t WS_WD = 48 * MiB;
constexpr size_t WS_H1F8 = 130 * MiB;
constexpr size_t WS_H0 = 64 * MiB;
constexpr size_t WS_U = 130 * MiB;
constexpr size_t WS_CQ = 163 * MiB;
constexpr size_t WS_CKV = 188 * MiB;
constexpr size_t WS_KR = 205 * MiB;
constexpr size_t WS_Q = 208 * MiB;
constexpr size_t WS_KV = 257 * MiB;
constexpr size_t WS_R1 = 208 * MiB;
constexpr size_t WS_Y = 208 * MiB;
constexpr size_t WS_MG = 336 * MiB;
constexpr size_t WS_ACT = 336 * MiB;
constexpr size_t WS_DUMMY = 400 * MiB;
constexpr size_t WS_END = 406 * MiB;

constexpr int LDS_BYTES = 73728;
constexpr int MISC_OFF = LDS_BYTES - 256;
constexpr int RS_OFF = 65536;
constexpr int TBL_OFF = 66048;
constexpr int EXP_OFF = 67584;

DEV unsigned cvtpk(float lo, float hi) { unsigned r; asm("v_cvt_pk_bf16_f32 %0, %1, %2" : "=v"(r) : "v"(lo), "v"(hi)); return r; }
DEV float bflo(unsigned w) { return __uint_as_float(w << 16); }
DEV float bfhi(unsigned w) { return __uint_as_float(w & 0xffff0000u); }
DEV float dpp_add_qp(float v, int) { return v; }
template <int CTRL> DEV float dpp_mov(float v) { return __builtin_bit_cast(float, __builtin_amdgcn_update_dpp(0, __builtin_bit_cast(int, v), CTRL, 0xf, 0xf, false)); }
DEV float wave_sum(float v) {
    v += dpp_mov<0xB1>(v);
    v += dpp_mov<0x4E>(v);
    v += dpp_mov<0x141>(v);
    v += dpp_mov<0x140>(v);
    const int iv = __builtin_bit_cast(int, v);
    const float a = __builtin_bit_cast(float, __builtin_amdgcn_readlane(iv, 0)), b = __builtin_bit_cast(float, __builtin_amdgcn_readlane(iv, 16));
    const float c = __builtin_bit_cast(float, __builtin_amdgcn_readlane(iv, 32)), d = __builtin_bit_cast(float, __builtin_amdgcn_readlane(iv, 48));
    return (a + b) + (c + d);
}
DEV float rsqrt_(float x) { return __builtin_amdgcn_rsqf(x); }
DEV void st_bf4(bf16_t* p, f32x4 v) { u32x2 w = {cvtpk(v[0], v[1]), cvtpk(v[2], v[3])}; *(u32x2*)p = w; }
DEV unsigned pk_fp8x4(float a, float b, float c, float d) {
    int w = __builtin_amdgcn_cvt_pk_fp8_f32(a, b, 0, false); w = __builtin_amdgcn_cvt_pk_fp8_f32(c, d, w, true); return (unsigned)w; }
DEV float fast_exp2(float x) { return __builtin_amdgcn_exp2f(x); }
DEV float fast_rcp(float x) { return __builtin_amdgcn_rcpf(x); }
DEV float sigmoidf_(float g) { return fast_rcp(1.f + fast_exp2(-1.4426950408889634f * g)); }
#define LDS_WAIT() asm volatile("s_waitcnt lgkmcnt(0)" ::: "memory")
#define VM_WAIT() asm volatile("s_waitcnt vmcnt(0)" ::: "memory")

#define XB_TMO      128
#define XB_XCNT(j)  (256  + 64 * (j))
#define XB_XSUB(j)  (1280 + 64 * (j))
#define XB_XGEN(j)  (2304 + 64 * (j))
#define XB_TOP      3328
#define XB_TOPGEN   3392
#define XCD_BAR_WORDS 3456
#define XB_SPIN_CAP (1u << 22)
DEV unsigned xb_ld(unsigned* p)              { return __hip_atomic_load(p, __ATOMIC_RELAXED, __HIP_MEMORY_SCOPE_AGENT); }
DEV unsigned xb_add(unsigned* p, unsigned v) { return __hip_atomic_fetch_add(p, v, __ATOMIC_RELAXED, __HIP_MEMORY_SCOPE_AGENT); }
DEV unsigned xb_xcc_id() { return (unsigned)__builtin_amdgcn_s_getreg((3 << 11) | 20) & 0xFu; }
#define XB_SPIN(cond, bar) do { unsigned _sp = 0; while (cond) { __builtin_amdgcn_s_sleep(1); \
    if ((++_sp & 255u) == 0u) { if (xb_ld(&(bar)[XB_TMO])) break; if (_sp > XB_SPIN_CAP) { atomicAdd(&(bar)[XB_TMO], 1u); break; } } } } while (0)
struct XcdBarrier { unsigned* bar; unsigned x; volatile LAS unsigned* st; };
DEV XcdBarrier xcd_barrier_post(unsigned* bar, volatile LAS unsigned* st) {
    XcdBarrier b; b.bar = bar; b.x = xb_xcc_id(); b.st = st;
    if (threadIdx.x == 0) (void)xb_add(&bar[XB_XCNT(b.x)], 1u);
    return b;
}
DEV void xcd_barrier_complete(unsigned* bar, unsigned x, unsigned& nloc, unsigned& nx) {
    const unsigned G = gridDim.x * gridDim.y * gridDim.z;
    unsigned sum, cnt, mine, sp = 0u;
    for (;;) {
        sum = 0u; cnt = 0u; mine = 0u;
#pragma unroll
        for (unsigned j = 0; j < 16; ++j) { const unsigned c = xb_ld(&bar[XB_XCNT(j)]); sum += c; cnt += (c > 0u) ? 1u : 0u; mine = (j == x) ? c : mine; }
        if (sum == G) break;
        __builtin_amdgcn_s_sleep(1);
        if ((++sp & 255u) == 0u) { if (xb_ld(&bar[XB_TMO])) break; if (sp > XB_SPIN_CAP) { atomicAdd(&bar[XB_TMO], 1u); break; } }
    }
    nloc = mine > 0u ? mine : 1u; nx = cnt > 0u ? cnt : 1u;
}
DEV void xcd_barrier(const XcdBarrier& b) {
    asm volatile("s_waitcnt vmcnt(0)" ::: "memory");
    __syncthreads();
    if (threadIdx.x == 0) {
        unsigned* bar = b.bar;
        __builtin_amdgcn_s_waitcnt(0);
        unsigned nloc = b.st[0], nx = b.st[1];
        if (nloc == 0u) { xcd_barrier_complete(bar, b.x, nloc, nx); b.st[0] = nloc; b.st[1] = nx; }
        const unsigned old = xb_add(&bar[XB_XSUB(b.x)], 1u);
        const unsigned gen = old / nloc;
        if (old + 1u == (gen + 1u) * nloc) {
            __builtin_amdgcn_fence(__ATOMIC_RELEASE, "agent");
            asm volatile("s_waitcnt vmcnt(0)" ::: "memory");
            const unsigned og = xb_add(&bar[XB_TOP], 1u);
            const unsigned tg = og / nx;
            if (og + 1u == (tg + 1u) * nx) xb_add(&bar[XB_TOPGEN], 1u);
            else XB_SPIN(xb_ld(&bar[XB_TOPGEN]) == tg, bar);
            __builtin_amdgcn_fence(__ATOMIC_ACQUIRE, "agent");
            xb_add(&bar[XB_XGEN(b.x)], 1u);
            asm volatile("s_waitcnt vmcnt(0)" ::: "memory");
        } else {
            XB_SPIN(xb_ld(&bar[XB_XGEN(b.x)]) == gen, bar);
            __builtin_amdgcn_fence(__ATOMIC_ACQUIRE, "agent");
            asm volatile("s_waitcnt vmcnt(0)" ::: "memory");
        }
    }
    __syncthreads();
}

struct Args { const float* in[27]; float* out; unsigned char* ws; int ph_lo, ph_hi; };
struct Ctx {
    const float* const* in; float* out; unsigned char* ws; unsigned char* lds;
    int tid, lane, wid, vcu, G;
};
enum { I_X = 0, I_META, I_LNIN_G, I_LNIN_B, I_WIN, I_CONVW, I_CONVB, I_CLN_G, I_CLN_B, I_QNG, I_WUQ, I_KVNG, I_WUKV, I_COUT_G, I_AOUT_G, I_WO,
       I_LN1G, I_LN1B, I_WRG, I_BRG, I_WRE, I_BRE, I_WGATE, I_WUP, I_WDOWN, I_LN2G, I_LN2B };

DEV int nmap(int mode, int n) {
    if (mode == 1) { if (n < 512) return ((n >> 4) << 5) + (n & 15); if (n < 1024) return (((n - 512) >> 4) << 5) + 16 + (n & 15); return n; }
    if (mode == 2) return ((n >> 4) << 5) + (n & 15);
    if (mode == 3) return ((n >> 4) << 5) + 16 + (n & 15);
    return n;
}
DEV void p0_transpose_item(const float* __restrict__ W, int N, int k0, int n0, const float* __restrict__ kscale, bf16_t* WT, int ldt, int kout0, int mode,
                           float* scr, int lane) {
#pragma unroll 8
    for (int i = 0; i < 32; ++i) {
        const int kk = 2 * i + (lane >> 5);
        float v = W[(size_t)(k0 + kk) * N + n0 + (lane & 31)];
        if (kscale) v *= kscale[k0 + kk];
        scr[kk * 33 + (lane & 31)] = v;
    }
    LDS_WAIT(); asm volatile("" ::: "memory");
    const int c = lane & 7;
#pragma unroll
    for (int j = 0; j < 4; ++j) {
        const int n = (lane >> 3) + 8 * j; const float* s = scr + (8 * c) * 33 + n;
        u32x4 o; o.x = cvtpk(s[0 * 33], s[1 * 33]); o.y = cvtpk(s[2 * 33], s[3 * 33]); o.z = cvtpk(s[4 * 33], s[5 * 33]); o.w = cvtpk(s[6 * 33], s[7 * 33]);
        *(u32x4*)(WT + (size_t)nmap(mode, n0 + n) * ldt + kout0 + 8 * c) = o;
    }
    LDS_WAIT(); asm volatile("" ::: "memory");
}
DEV void p0_transpose_item_f8(const float* __restrict__ W, int N, int k0, int n0, float scale, unsigned char* W8, int ldt, int kout0, int mode, float* scr, int lane) {
#pragma unroll 8
    for (int i = 0; i < 32; ++i) { const int kk = 2 * i + (lane >> 5); scr[kk * 33 + (lane & 31)] = W[(size_t)(k0 + kk) * N + n0 + (lane & 31)] * scale; }
    LDS_WAIT(); asm volatile("" ::: "memory");
    const int c = lane & 7;
#pragma unroll
    for (int j = 0; j < 4; ++j) {
        const int n = (lane >> 3) + 8 * j; const float* sp = scr + (8 * c) * 33 + n;
        u32x2 o; o.x = pk_fp8x4(sp[0 * 33], sp[1 * 33], sp[2 * 33], sp[3 * 33]); o.y = pk_fp8x4(sp[4 * 33], sp[5 * 33], sp[6 * 33], sp[7 * 33]);
        *(u32x2*)(W8 + (size_t)nmap(mode, n0 + n) * ldt + kout0 + 8 * c) = o;
    }
    LDS_WAIT(); asm volatile("" ::: "memory");
}
template <int N> DEV void wave_sum_n(float (&v)[N]) {
#pragma unroll
    for (int i = 0; i < N; ++i) v[i] = wave_sum(v[i]);
}
template <int NR, bool F8 = false, bool BFIN = false> DEV void ln_rows_bf16(const float* const (&xrow)[NR], const float* g, const float* bta, bf16_t* const (&orow)[NR], unsigned char* const (&ldsrow)[NR], int lane, unsigned char* const* f8row = nullptr) {
    f32x4 v[NR][4]; float s[NR];
#pragma unroll
    for (int r = 0; r < NR; ++r)
#pragma unroll
        for (int j = 0; j < 4; ++j) {
            if (BFIN) { const u32x2 w = ((const u32x2*)xrow[r])[64 * j + lane]; v[r][j] = (f32x4){bflo(w.x), bfhi(w.x), bflo(w.y), bfhi(w.y)}; }
            else v[r][j] = ((const f32x4*)xrow[r])[64 * j + lane]; }
#pragma unroll
    for (int r = 0; r < NR; ++r) { s[r] = 0.f;
#pragma unroll
        for (int j = 0; j < 4; ++j) s[r] += (v[r][j].x + v[r][j].y) + (v[r][j].z + v[r][j].w); }
    wave_sum_n<NR>(s);
    float s2[NR];
#pragma unroll
    for (int r = 0; r < NR; ++r) { const float mean = s[r] * (1.f / 1024.f); s2[r] = 0.f;
#pragma unroll
        for (int j = 0; j < 4; ++j) { v[r][j] = v[r][j] - mean; s2[r] += (v[r][j].x * v[r][j].x + v[r][j].y * v[r][j].y) + (v[r][j].z * v[r][j].z + v[r][j].w * v[r][j].w); } }
    wave_sum_n<NR>(s2);
#pragma unroll
    for (int j = 0; j < 4; ++j) {
        const f32x4 gg = ((const f32x4*)g)[64 * j + lane], bb = ((const f32x4*)bta)[64 * j + lane];
#pragma unroll
        for (int r = 0; r < NR; ++r) {
            const float rstd = rsqrt_(s2[r] * (1.f / 1024.f) + EPS);
            const f32x4 o = v[r][j] * rstd * gg + bb;
            const u32x2 w = {cvtpk(o.x, o.y), cvtpk(o.z, o.w)};
            ((u32x2*)orow[r])[64 * j + lane] = w;
            if (ldsrow[r]) ((u32x2*)ldsrow[r])[64 * j + lane] = w;
            if (F8) ((unsigned*)f8row[r])[64 * j + lane] = pk_fp8x4(o.x, o.y, o.z, o.w);
        }
    }
}
__device__ const float INVF[16] = {1.0f, 0.5623413251903491f, 0.31622776601683794f, 0.1778279410038923f, 0.1f, 0.05623413251903491f, 0.031622776601683794f,
    0.01778279410038923f, 0.01f, 0.005623413251903491f, 0.0031622776601683794f, 0.001778279410038923f, 0.001f, 0.0005623413251903491f, 0.00031622776601683794f, 0.0001778279410038923f};
DEV void sincos_d(double a, float& sn, float& cs) {
    const double TWO_PI = 6.283185307179586476925286766559;
    const double k = __builtin_rint(a / TWO_PI);
    const double r = a - k * TWO_PI;
    const double r2 = r * r;
    double st = r, ct = 1.0, ssum = r, csum = 1.0;
#pragma unroll 1
    for (int i = 1; i <= 14; ++i) {
        ct = -ct * r2 / (double)((2 * i - 1) * (2 * i));  csum += ct;
        st = -st * r2 / (double)((2 * i) * (2 * i + 1));  ssum += st;
    }
    sn = (float)ssum; cs = (float)csum;
}
DEV void ew_block(const float* __restrict__ W, int N, int k0, int n0, unsigned char* W8, int ldt, int mode, int lane) {
    const int q = lane & 15, kq = lane >> 4;
    const float* src = W + (size_t)(k0 + 16 * kq) * N + n0 + 4 * q;
    f32x4 v[16];
#pragma unroll
    for (int i = 0; i < 16; ++i) v[i] = *(const f32x4*)(src + (size_t)i * N);
#pragma unroll
    for (int j = 0; j < 4; ++j) {
        u32x4 o;
        o.x = pk_fp8x4(v[0][j] * WSCALE, v[1][j] * WSCALE, v[2][j] * WSCALE, v[3][j] * WSCALE);
        o.y = pk_fp8x4(v[4][j] * WSCALE, v[5][j] * WSCALE, v[6][j] * WSCALE, v[7][j] * WSCALE);
        o.z = pk_fp8x4(v[8][j] * WSCALE, v[9][j] * WSCALE, v[10][j] * WSCALE, v[11][j] * WSCALE);
        o.w = pk_fp8x4(v[12][j] * WSCALE, v[13][j] * WSCALE, v[14][j] * WSCALE, v[15][j] * WSCALE);
        *(u32x4*)(W8 + (size_t)nmap(mode, n0 + 4 * q + j) * ldt + k0 + 16 * kq) = o;
    }
}
DEV void expert_weight_item(const Ctx& c, int r, float*  ) {
    unsigned char* Wgu8 = c.ws + WS_WGU; unsigned char* Wd8 = c.ws + WS_WD;
    if (r < 2048) { const int e = r >> 6, qq = r & 63, kb = qq >> 2, nb = qq & 3;
        ew_block(c.in[I_WGATE] + (size_t)e * D * DE, DE, 64 * kb, 64 * nb, Wgu8 + (size_t)e * 512 * 1024, 1024, 2, c.lane); return; } r -= 2048;
    if (r < 2048) { const int e = r >> 6, qq = r & 63, kb = qq >> 2, nb = qq & 3;
        ew_block(c.in[I_WUP] + (size_t)e * D * DE, DE, 64 * kb, 64 * nb, Wgu8 + (size_t)e * 512 * 1024, 1024, 3, c.lane); return; } r -= 2048;
    { const int e = r >> 6, qq = r & 63, kb = qq >> 4, nb = qq & 15;
        ew_block(c.in[I_WDOWN] + (size_t)e * DE * D, D, 64 * kb, 64 * nb, Wd8 + (size_t)e * 1024 * 256, 256, 0, c.lane); }
}
DEV void phase0(const Ctx& c) {
    float* scr = (float*)(c.lds + c.wid * 8448);
    const int gw = c.vcu * 4 + c.wid, NGW = c.G * 4;
    constexpr int I_IN = 16 * 53, I_UQ = 6 * 24, I_UKV = 4 * 32, I_O = 16 * 32;
    bf16_t* WinT = (bf16_t*)(c.ws + WS_WIN); bf16_t* WuqT = (bf16_t*)(c.ws + WS_WUQ); bf16_t* WukvT = (bf16_t*)(c.ws + WS_WUKV);
    bf16_t* WoT = (bf16_t*)(c.ws + WS_WO);
    constexpr int NITEMS0 = I_IN + I_UQ + I_UKV + I_O;
    for (int it = gw; it < NITEMS0; it += NGW) {
        int r = it;
        if (r < I_IN) { const int kb = r / 53, nb = r % 53; p0_transpose_item(c.in[I_WIN], NIN, 64 * kb, 32 * nb, nullptr, WinT, 1024, 64 * kb, 1, scr, c.lane); continue; } r -= I_IN;
        if (r < I_UQ) { const int kb = r / 24, nb = r % 24; p0_transpose_item(c.in[I_WUQ], NQ, 64 * kb, 32 * nb, c.in[I_QNG], WuqT, QL, 64 * kb, 0, scr, c.lane); continue; } r -= I_UQ;
        if (r < I_UKV) { const int kb = r / 32, nb = r % 32; p0_transpose_item(c.in[I_WUKV], NKV, 64 * kb, 32 * nb, c.in[I_KVNG], WukvT, KVL, 64 * kb, 0, scr, c.lane); continue; } r -= I_UKV;
        { const int kb = r / 32, nb = r % 32;
            if (kb < 8) p0_transpose_item(c.in[I_WO], D, 64 * kb, 32 * nb, nullptr, WoT, 1024, 64 * kb + 512, 0, scr, c.lane);
            else        p0_transpose_item(c.in[I_WO], D, 64 * kb, 32 * nb, c.in[I_AOUT_G] - 512, WoT, 1024, 64 * kb - 512, 0, scr, c.lane); }
    }
    const int gt = c.vcu * 256 + c.tid, NGT = c.G * 256;
    bf16_t* WrT = (bf16_t*)(c.ws + WS_WR);
    for (int i = gt; i < 48 * 1024; i += NGT) {
        const int n = i >> 10, k = i & 1023; float v = 0.f;
        if (n < 4) v = c.in[I_WRG][k * 4 + n]; else if (n < 36) v = c.in[I_WRE][k * 32 + (n - 4)];
        WrT[i] = (bf16_t)(cvtpk(v, 0.f) & 0xffffu);
    }
    float* rc = (float*)(c.ws + WS_ROPE); float* rs = rc + L * 16;
    for (int i = gt; i < L * 16; i += NGT) {
        const int p = i >> 4, f = i & 15; const float ang = (float)p * INVF[f];
        float sn, cs; sincos_d((double)ang, sn, cs); rc[i] = cs; rs[i] = sn;
    }
    bf16_t* h0 = (bf16_t*)(c.ws + WS_H0);
    for (int t = gw; t < T; t += 2 * NGW) {
        const float* src[2]; bf16_t* dst[2]; unsigned char* ldsn[2] = {nullptr, nullptr};
#pragma unroll
        for (int r = 0; r < 2; ++r) { int tt = t + r * NGW; if (tt >= T) tt = t;
            const int b = tt / L, p = tt - b * L;
            src[r] = (p < NMETA) ? c.in[I_META] + (size_t)p * D : c.in[I_X] + ((size_t)b * SEQ + (p - NMETA)) * D;
            dst[r] = h0 + (size_t)tt * D; }
        ln_rows_bf16<2>(src, c.in[I_LNIN_G], c.in[I_LNIN_B], dst, ldsn, c.lane);
    }
}

struct StageGeo { int r[4]; int c; };
DEV StageGeo stage_geo(int tid) {
    const int lane = tid & 63, wid = tid >> 6; StageGeo g;
    const int rl = lane >> 2, cl = ((lane & 3) * 8) ^ ((lane >> 5) << 4);
#pragma unroll
    for (int i = 0; i < 4; ++i) g.r[i] = (((wid + 4 * i) >> 1) << 4) + rl;
    g.c = ((wid & 1) << 5) + cl;
    return g;
}
template <bool SSQ, bool FP8 = false>
DEV void gemm_mainloop(f32x4 (&acc)[4][4], const bf16_t* ap0, const bf16_t* ap1, const bf16_t* ap2, const bf16_t* ap3,
                       const bf16_t* bp0, const bf16_t* bp1, const bf16_t* bp2, const bf16_t* bp3,
                       int nk, unsigned char* lds, int ssq_steps, float ssq_inv_dim, bool skip_wc1 = false) {
    const int tid = threadIdx.x, lane = tid & 63, wid = tid >> 6, wr = wid >> 1, wc = wid & 1, fr = lane & 15, fq = lane >> 4;
    const int xs = (fr >> 1) & 7;
    const int lo = ((fr * 64 + fq * 16) ^ ((fr >> 3) << 5));
    const int lo0 = lo, lo1 = lo + 1024;
    const int a_off = wr * 8192, b_off = 16384 + wc * 8192;
    const int dst = tid * 16;
#pragma unroll
    for (int m = 0; m < 4; ++m)
#pragma unroll
        for (int n = 0; n < 4; ++n) acc[m][n] = (f32x4){0.f, 0.f, 0.f, 0.f};
    __syncthreads();
#define GLDS(src, off) __builtin_amdgcn_global_load_lds((const unsigned*)(src), (unsigned LAS*)(lds + (off)), 16, 0, 0)
#define STAGE(kt, b) do { const int _k = (kt) * 64; \
        GLDS(ap0 + _k, (b) * 32768 + dst);          GLDS(ap1 + _k, (b) * 32768 + dst + 4096); \
        GLDS(ap2 + _k, (b) * 32768 + dst + 8192);   GLDS(ap3 + _k, (b) * 32768 + dst + 12288); \
        GLDS(bp0 + _k, (b) * 32768 + 16384 + dst);  GLDS(bp1 + _k, (b) * 32768 + 16384 + dst + 4096); \
        GLDS(bp2 + _k, (b) * 32768 + 16384 + dst + 8192); GLDS(bp3 + _k, (b) * 32768 + 16384 + dst + 12288); } while (0)
    STAGE(0, 0);
    for (int kt = 0; kt < nk; ++kt) {
        VM_WAIT();
        __syncthreads();
        const int b = kt & 1;
        if (SSQ && kt == ssq_steps) {
            const float* rsl = (const float*)(lds + RS_OFF);
#pragma unroll
            for (int m = 0; m < 4; ++m) { const float r = rsl[wr * 64 + m * 16 + fr];
#pragma unroll
                for (int n = 0; n < 4; ++n) acc[m][n] = acc[m][n] * r; }
        }
        if (kt + 1 < nk) { if (b) STAGE(kt + 1, 0); else STAGE(kt + 1, 1); }
        const unsigned char* base = lds + b * 32768;
        if (skip_wc1 && wc == 1) {
        } else if (FP8) {
            const int cb0 = fq * 32, cb1 = fq * 32 + 16;
            const int q0 = (cb0 >> 6) * 1024 + ((fr * 64 + (cb0 & 63)) ^ ((fr >> 3) << 5)), q1 = (cb1 >> 6) * 1024 + ((fr * 64 + (cb1 & 63)) ^ ((fr >> 3) << 5));
            v8i ax[4], bx[4];
#pragma unroll
            for (int m = 0; m < 4; ++m) { const u32x4 c0 = *(const u32x4*)(base + a_off + m * 2048 + q0), c1 = *(const u32x4*)(base + a_off + m * 2048 + q1);
                ax[m] = (v8i){(int)c0.x, (int)c0.y, (int)c0.z, (int)c0.w, (int)c1.x, (int)c1.y, (int)c1.z, (int)c1.w}; }
#pragma unroll
            for (int n = 0; n < 4; ++n) { const u32x4 c0 = *(const u32x4*)(base + b_off + n * 2048 + q0), c1 = *(const u32x4*)(base + b_off + n * 2048 + q1);
                bx[n] = (v8i){(int)c0.x, (int)c0.y, (int)c0.z, (int)c0.w, (int)c1.x, (int)c1.y, (int)c1.z, (int)c1.w}; }
#pragma unroll
            for (int m = 0; m < 4; ++m)
#pragma unroll
                for (int n = 0; n < 4; ++n) acc[m][n] = __builtin_amdgcn_mfma_scale_f32_16x16x128_f8f6f4(bx[n], ax[m], acc[m][n], 0, 0, 0, 0x7F7F7F7F, 0, 0x7F7F7F7F);
        } else {
#pragma unroll
        for (int ks = 0; ks < 2; ++ks) {
            bf16x8 af[4], bf[4];
#pragma unroll
            for (int m = 0; m < 4; ++m) af[m] = *(const bf16x8*)(base + a_off + m * 2048 + (ks ? lo1 : lo0));
#pragma unroll
            for (int n = 0; n < 4; ++n) bf[n] = *(const bf16x8*)(base + b_off + n * 2048 + (ks ? lo1 : lo0));
#pragma unroll
            for (int m = 0; m < 4; ++m)
#pragma unroll
                for (int n = 0; n < 4; ++n) acc[m][n] = __builtin_amdgcn_mfma_f32_16x16x32_bf16(bf[n], af[m], acc[m][n], 0, 0, 0);
        }
        }
    }
    if (SSQ && ssq_steps == nk) {
        __syncthreads();
        const float* rsl = (const float*)(lds + RS_OFF);
#pragma unroll
        for (int m = 0; m < 4; ++m) { const float r = rsl[wr * 64 + m * 16 + fr];
#pragma unroll
            for (int n = 0; n < 4; ++n) acc[m][n] = acc[m][n] * r; }
    }
#undef STAGE
#undef GLDS
}

DEV void phase1(const Ctx& c) {
    const bf16_t* h0 = (const bf16_t*)(c.ws + WS_H0); const bf16_t* WinT = (const bf16_t*)(c.ws + WS_WIN);
    bf16_t* U = (bf16_t*)(c.ws + WS_U); bf16_t* CQ = (bf16_t*)(c.ws + WS_CQ); bf16_t* CKV = (bf16_t*)(c.ws + WS_CKV); bf16_t* KR = (bf16_t*)(c.ws + WS_KR);
    const float* rc = (const float*)(c.ws + WS_ROPE); const float* rs = rc + L * 16;
    const StageGeo g = stage_geo(c.tid);
    const int lane = c.lane, wr = c.wid >> 1, wc = c.wid & 1, fr = lane & 15, fq = lane >> 4;
    constexpr int NT = 14, NU = (T / 128) * NT;
    for (int u = c.vcu; u < NU; u += c.G) {
        const int mt = u / NT, nt = u - mt * NT;
        const bf16_t* A = h0 + (size_t)(mt * 128) * D + g.c; const bf16_t* B = WinT + (size_t)(nt * 128) * D + g.c;
        f32x4 acc[4][4];
        gemm_mainloop<false>(acc, A + (size_t)g.r[0] * D, A + (size_t)g.r[1] * D, A + (size_t)g.r[2] * D, A + (size_t)g.r[3] * D,
                             B + (size_t)g.r[0] * D, B + (size_t)g.r[1] * D, B + (size_t)g.r[2] * D, B + (size_t)g.r[3] * D, 16, c.lds, 0, 0.f, nt == 13);
        const int row0 = mt * 128 + wr * 64 + fr;
        if (nt < 8) {
#pragma unroll
            for (int m = 0; m < 4; ++m) { const size_t row = row0 + m * 16;
#pragma unroll
                for (int i = 0; i < 2; ++i) {
                    f32x4 a = acc[m][2 * i], gt = acc[m][2 * i + 1], o;
#pragma unroll
                    for (int j = 0; j < 4; ++j) o[j] = a[j] * sigmoidf_(gt[j]);
                    st_bf4(U + row * CC + nt * 64 + wc * 32 + i * 16 + fq * 4, o);
                } }
        } else if (nt < 13) {
            const bool isq = nt < 11;
            bf16_t* dstb = isq ? CQ + (nt - 8) * 128 + wc * 64 + fq * 4 : CKV + (nt - 11) * 128 + wc * 64 + fq * 4;
            const int ldd = isq ? QL : KVL;
            float* ssb = isq ? (float*)(c.ws + WS_SSQ_CQ) + (nt - 8) * 2 + wc : (float*)(c.ws + WS_SSQ_CKV) + (nt - 11) * 2 + wc;
            const int lds_ = isq ? 8 : 4;
#pragma unroll
            for (int m = 0; m < 4; ++m) { const size_t row = row0 + m * 16; float sq = 0.f;
#pragma unroll
                for (int n = 0; n < 4; ++n) { st_bf4(dstb + row * ldd + n * 16, acc[m][n]);
                    sq += (acc[m][n][0] * acc[m][n][0] + acc[m][n][1] * acc[m][n][1]) + (acc[m][n][2] * acc[m][n][2] + acc[m][n][3] * acc[m][n][3]); }
                sq += __shfl_xor(sq, 16); sq += __shfl_xor(sq, 32);
                if (fq == 0) ssb[row * lds_] = sq; }
        } else if (wc == 0) {
#pragma unroll
            for (int m = 0; m < 4; ++m) { const int row = row0 + m * 16; const int p = row % L;
                const f32x4 cs = *(const f32x4*)(rc + p * 16 + fq * 4), sn = *(const f32x4*)(rs + p * 16 + fq * 4);
                const f32x4 x1 = acc[m][0], x2 = acc[m][1];
                st_bf4(KR + (size_t)row * 32 + fq * 4, x1 * cs - x2 * sn);
                st_bf4(KR + (size_t)row * 32 + 16 + fq * 4, x1 * sn + x2 * cs); }
        }
    }
}

DEV void conv_unit(const Ctx& c, int b, int j) {
    const bf16_t* U = (const bf16_t*)(c.ws + WS_U);
    bf16_t* MG = (bf16_t*)(c.ws + WS_MG);
    const float* cw = c.in[I_CONVW]; const float* cb = c.in[I_CONVB];
    const int p0 = j * 32;
    float* ytile = (float*)c.lds;
    __syncthreads();
#pragma unroll 1
    for (int pass = 0; pass < 2; ++pass) {
        const int ch = c.tid + 256 * pass;
        float win[62]; unsigned raw[62];
        const bf16_t* ub = U + (size_t)b * L * CC + ch;
#pragma unroll
        for (int rep = 0; rep < CONV_REPA; ++rep) {
        asm volatile("" : "+v"(ub) :: "memory");
#pragma unroll
        for (int i = 0; i < 62; ++i) { const int p = p0 - 30 + i; const int pc = p < 0 ? 0 : (p >= L ? L - 1 : p); raw[i] = ub[(size_t)pc * CC]; }
        if (rep + 1 < CONV_REPA) {
#pragma unroll
            for (int i = 0; i < 62; ++i) asm volatile("" :: "v"(raw[i]));
        }
        }
        float w[31];
#pragma unroll
        for (int k = 0; k < 31; ++k) w[k] = cw[k * CC + ch];
        float bias = cb[ch];
        __builtin_amdgcn_sched_barrier(0);
#pragma unroll
        for (int i = 0; i < 62; ++i) { const int p = p0 - 30 + i; win[i] = (p >= 0 && p < L) ? __uint_as_float(raw[i] << 16) : 0.f; }
#pragma unroll
        for (int rep = 0; rep < CONV_REPB; ++rep) {
        asm volatile("" : "+v"(bias) :: "memory");
#pragma unroll
        for (int tt = 0; tt < 32; ++tt) {
            float a0 = bias;
#pragma unroll
            for (int k = 0; k < 31; ++k) a0 += w[k] * win[tt + k];
            ytile[tt * 512 + ch] = a0;
        }
        }
    }
    __syncthreads();
    const float* g1 = c.in[I_CLN_G]; const float* b1 = c.in[I_CLN_B]; const float* g2 = c.in[I_COUT_G];
    float G1[8], B1[8], G2[8];
    { const f32x4 a = *(const f32x4*)(g1 + c.lane * 8), bq = *(const f32x4*)(g1 + c.lane * 8 + 4); G1[0]=a.x;G1[1]=a.y;G1[2]=a.z;G1[3]=a.w;G1[4]=bq.x;G1[5]=bq.y;G1[6]=bq.z;G1[7]=bq.w; }
    { const f32x4 a = *(const f32x4*)(b1 + c.lane * 8), bq = *(const f32x4*)(b1 + c.lane * 8 + 4); B1[0]=a.x;B1[1]=a.y;B1[2]=a.z;B1[3]=a.w;B1[4]=bq.x;B1[5]=bq.y;B1[6]=bq.z;B1[7]=bq.w; }
    { const f32x4 a = *(const f32x4*)(g2 + c.lane * 8), bq = *(const f32x4*)(g2 + c.lane * 8 + 4); G2[0]=a.x;G2[1]=a.y;G2[2]=a.z;G2[3]=a.w;G2[4]=bq.x;G2[5]=bq.y;G2[6]=bq.z;G2[7]=bq.w; }
#pragma unroll
    for (int rep = 0; rep < CONV_REPC; ++rep) {
    asm volatile("" : "+v"(ytile) :: "memory");
    float v[8][8]; float st[8];
#pragma unroll
    for (int i = 0; i < 8; ++i) { const int tt = c.wid * 8 + i;
        const f32x4 ya = *(const f32x4*)(ytile + tt * 512 + c.lane * 8), yb = *(const f32x4*)(ytile + tt * 512 + c.lane * 8 + 4);
        v[i][0]=ya.x;v[i][1]=ya.y;v[i][2]=ya.z;v[i][3]=ya.w;v[i][4]=yb.x;v[i][5]=yb.y;v[i][6]=yb.z;v[i][7]=yb.w;
        st[i] = ((v[i][0] + v[i][1]) + (v[i][2] + v[i][3])) + ((v[i][4] + v[i][5]) + (v[i][6] + v[i][7])); }
    wave_sum_n<8>(st);
#pragma unroll
    for (int i = 0; i < 8; ++i) { const float mean = st[i] * (1.f / 512.f); float a = 0.f;
#pragma unroll
        for (int q = 0; q < 8; ++q) { v[i][q] -= mean; a += v[i][q] * v[i][q]; }
        st[i] = a; }
    wave_sum_n<8>(st);
#pragma unroll
    for (int i = 0; i < 8; ++i) { const float rstd = rsqrt_(st[i] * (1.f / 512.f) + EPS); float a = 0.f;
#pragma unroll
        for (int q = 0; q < 8; ++q) { const float x = v[i][q] * rstd * G1[q] + B1[q]; const float y = x * sigmoidf_(x); v[i][q] = y; a += y * y; }
        st[i] = a; }
    wave_sum_n<8>(st);
#pragma unroll
    for (int i = 0; i < 8; ++i) {
        const int p = p0 + c.wid * 8 + i;
        {
            const float r2 = rsqrt_(st[i] * (1.f / 512.f) + EPS);
            u32x4 o;
            o.x = cvtpk(v[i][0] * r2 * G2[0], v[i][1] * r2 * G2[1]); o.y = cvtpk(v[i][2] * r2 * G2[2], v[i][3] * r2 * G2[3]);
            o.z = cvtpk(v[i][4] * r2 * G2[4], v[i][5] * r2 * G2[5]); o.w = cvtpk(v[i][6] * r2 * G2[6], v[i][7] * r2 * G2[7]);
            const size_t tok = (size_t)b * SEQ + (p - NMETA);
            bf16_t* dstp = (p >= NMETA && p < L) ? MG + tok * D + 512 + c.lane * 8 : (bf16_t*)(c.ws + WS_DUMMY) + c.lane * 8;
            *(u32x4*)dstp = o;
        }
    }
    }
}
DEV void rope4(f32x4& x1, f32x4& x2, const float* rc, const float* rs, int p, int fq) {
    const f32x4 cs = *(const f32x4*)(rc + p * 16 + fq * 4), sn = *(const f32x4*)(rs + p * 16 + fq * 4);
    const f32x4 a = x1 * cs - x2 * sn, bb = x1 * sn + x2 * cs; x1 = a; x2 = bb;
}
template <int SEL> DEV void phase2_t(const Ctx& c) {
    const bf16_t* CQ = (const bf16_t*)(c.ws + WS_CQ); const bf16_t* CKV = (const bf16_t*)(c.ws + WS_CKV);
    const bf16_t* WuqT = (const bf16_t*)(c.ws + WS_WUQ); const bf16_t* WukvT = (const bf16_t*)(c.ws + WS_WUKV);
    bf16_t* Q = (bf16_t*)(c.ws + WS_Q); bf16_t* KV = (bf16_t*)(c.ws + WS_KV);
    const float* rc = (const float*)(c.ws + WS_ROPE); const float* rs = rc + L * 16;
    const StageGeo g = stage_geo(c.tid);
    const int lane = c.lane, wr = c.wid >> 1, wc = c.wid & 1, fr = lane & 15, fq = lane >> 4;
    constexpr int MT = T / 128, NUQ = MT * 6, NUKV = MT * 8, NUC = NB * 65, NU = NUQ + NUKV + NUC;
    const int li = c.vcu & 63, rev = ((li >> 5) ^ li) & 1;
    const int nmine = (NU - c.vcu + c.G - 1) / c.G;
    for (int it = 0; it < nmine; ++it) {
        const int u = c.vcu + (rev ? (nmine - 1 - it) : it) * c.G;
        if (SEL == 1 && u >= NUKV + NUQ) continue;
        if (SEL == 2 && u < NUKV + NUQ) continue;
        if (u < NUKV) {
            const int mt = u >> 3, nt = u & 7;
            const bf16_t* A = CKV + (size_t)(mt * 128) * KVL + g.c; const bf16_t* B = WukvT + (size_t)(nt * 128) * KVL + g.c;
            f32x4 acc[4][4];
            __syncthreads();
            if (c.tid < 128) { const f32x4 p4 = *(const f32x4*)((const float*)(c.ws + WS_SSQ_CKV) + (size_t)(mt * 128 + c.tid) * 4);
                ((float*)(c.lds + RS_OFF))[c.tid] = rsqrt_(((p4.x + p4.y) + (p4.z + p4.w)) * (1.f / 256.f) + EPS); }
            gemm_mainloop<true>(acc, A + (size_t)g.r[0] * KVL, A + (size_t)g.r[1] * KVL, A + (size_t)g.r[2] * KVL, A + (size_t)g.r[3] * KVL,
                                B + (size_t)g.r[0] * KVL, B + (size_t)g.r[1] * KVL, B + (size_t)g.r[2] * KVL, B + (size_t)g.r[3] * KVL, 4, c.lds, 4, 1.f / 256.f);
            const int row0 = mt * 128 + wr * 64 + fr;
#pragma unroll
            for (int m = 0; m < 4; ++m) { const size_t row = row0 + m * 16;
#pragma unroll
                for (int n = 0; n < 4; ++n) st_bf4(KV + row * NKV + nt * 128 + wc * 64 + n * 16 + fq * 4, acc[m][n]); }
        } else if (u < NUKV + NUQ) {
            const int v = u - NUKV, mt = v / 6, nt = v - mt * 6;
            const bf16_t* A = CQ + (size_t)(mt * 128) * QL + g.c; const bf16_t* B = WuqT + (size_t)(nt * 128) * QL + g.c;
            f32x4 acc[4][4];
            __syncthreads();
            if (c.tid < 128) { const float* pp = (const float*)(c.ws + WS_SSQ_CQ) + (size_t)(mt * 128 + c.tid) * 8; const f32x4 p4 = *(const f32x4*)pp; const float2 p2 = *(const float2*)(pp + 4);
                ((float*)(c.lds + RS_OFF))[c.tid] = rsqrt_((((p4.x + p4.y) + (p4.z + p4.w)) + (p2.x + p2.y)) * (1.f / 384.f) + EPS); }
            gemm_mainloop<true>(acc, A + (size_t)g.r[0] * QL, A + (size_t)g.r[1] * QL, A + (size_t)g.r[2] * QL, A + (size_t)g.r[3] * QL,
                                B + (size_t)g.r[0] * QL, B + (size_t)g.r[1] * QL, B + (size_t)g.r[2] * QL, B + (size_t)g.r[3] * QL, 6, c.lds, 6, 1.f / 384.f);
            const int row0 = mt * 128 + wr * 64 + fr;
            const int t16 = (nt * 8 + wc * 4) % 6;
#pragma unroll
            for (int m = 0; m < 4; ++m) { const int row = row0 + m * 16; const int p = row % L;
#pragma unroll
                for (int n = 0; n < 4; ++n) acc[m][n] = acc[m][n] * QSCALE;
                if (t16 == 4) rope4(acc[m][0], acc[m][1], rc, rs, p, fq);
                if (t16 == 2) rope4(acc[m][2], acc[m][3], rc, rs, p, fq);
#pragma unroll
                for (int n = 0; n < 4; ++n) st_bf4(Q + (size_t)row * NQ + nt * 128 + wc * 64 + n * 16 + fq * 4, acc[m][n]); }
        } else {
            const int v = u - NUKV - NUQ; conv_unit(c, v / 65, v % 65);
        }
    }
}

DEV void phase2(const Ctx& c) { phase2_t<0>(c); }
DEV void phase2g(const Ctx& c) { phase2_t<1>(c); }
DEV void phase2c(const Ctx& c) { phase2_t<2>(c); }
DEV int crow(int r, int hi) { return (r & 3) + 8 * (r >> 2) + 4 * hi; }
#define KSWZ(row, colB) ((row) * 256 + ((colB) ^ (((row) & 7) << 4)))
#define SBAR() __builtin_amdgcn_sched_barrier(0)
DEV int v_st(int k, int cc) { const int kk = (k & ~0xC) | ((k & 4) << 1) | ((k & 8) >> 1); return ((kk >> 3) * 4 + (cc >> 5)) * 512 + ((kk & 7) * 32 + (cc & 31)) * 2; }
DEV int v_rd_base(int lane) { return ((lane & 3) << 3) | (((lane >> 2) & 3) << 6) | (((lane >> 4) & 1) << 5) | (((lane >> 5) & 1) << 8); }
constexpr int v_rd_off(int d0, int ks, int half) { return d0 * 512 + ks * 4096 + half * 2048; }
template <int OFF> DEV s16x4 tr_read(int vb) { s16x4 r; asm volatile("ds_read_b64_tr_b16 %0, %1 offset:%2" : "=&v"(r) : "v"(vb), "i"(OFF) : "memory"); return r; }
template <int D0> DEV void pv_one(f32x16& od, int vb, bf16x8 pa0, bf16x8 pa1, bf16x8 pa2, bf16x8 pa3) {
    const s16x4 l0 = tr_read<v_rd_off(D0, 0, 0)>(vb), h0 = tr_read<v_rd_off(D0, 0, 1)>(vb), l1 = tr_read<v_rd_off(D0, 1, 0)>(vb), h1 = tr_read<v_rd_off(D0, 1, 1)>(vb);
    const s16x4 l2 = tr_read<v_rd_off(D0, 2, 0)>(vb), h2 = tr_read<v_rd_off(D0, 2, 1)>(vb), l3 = tr_read<v_rd_off(D0, 3, 0)>(vb), h3 = tr_read<v_rd_off(D0, 3, 1)>(vb);
    asm volatile("s_waitcnt lgkmcnt(0)" ::: "memory"); SBAR();
#define PK(Lo, Hi) (bf16x8){Lo[0], Lo[1], Lo[2], Lo[3], Hi[0], Hi[1], Hi[2], Hi[3]}
    od = __builtin_amdgcn_mfma_f32_32x32x16_bf16(pa0, PK(l0, h0), od, 0, 0, 0);
    od = __builtin_amdgcn_mfma_f32_32x32x16_bf16(pa1, PK(l1, h1), od, 0, 0, 0);
    od = __builtin_amdgcn_mfma_f32_32x32x16_bf16(pa2, PK(l2, h2), od, 0, 0, 0);
    od = __builtin_amdgcn_mfma_f32_32x32x16_bf16(pa3, PK(l3, h3), od, 0, 0, 0);
#undef PK
}
constexpr float ATT_THR = 8.f;
constexpr int AT_V = 0, AT_K = 32768, AT_WS = 65536;
DEV void attn_unit(const Ctx& c, int b, int h, int qb) {
    const bf16_t* Q = (const bf16_t*)(c.ws + WS_Q); const bf16_t* KV = (const bf16_t*)(c.ws + WS_KV); const bf16_t* KR = (const bf16_t*)(c.ws + WS_KR);
    bf16_t* MG = (bf16_t*)(c.ws + WS_MG);
    unsigned char* lds = c.lds;
    const int tid = c.tid, wid = c.wid, lane = c.lane, r32 = lane & 31, hi = lane >> 5;
    float* wsf = (float*)(lds + AT_WS) + wid * 64; float* li_l = wsf; float* al_l = wsf + 32;
    const int NT = 2 * qb + 3;
    const int my_last = 2 * qb + (wid >> 1) + 1;
    bf16x8 qr[6];
    { const size_t t = (size_t)b * L + NMETA + qb * 128 + wid * 32 + r32;
      const bf16_t* Qw = Q + t * NQ + h * DQK + hi * 8;
#pragma unroll
      for (int d0 = 0; d0 < 6; ++d0) qr[d0] = *(const bf16x8*)(Qw + d0 * 16); }
    const int srow = tid >> 2, sq = tid & 3;
    const int vst0 = v_st(srow, sq * 16), vst1 = v_st(srow, sq * 16 + 8);
    const int kst0 = KSWZ(srow, sq * 32), kst1 = KSWZ(srow, sq * 32 + 16), kst2 = KSWZ(srow, 128 + sq * 16);
    const int vb0 = (int)(uintptr_t)(lds + AT_V) + v_rd_base(lane);
    u32x4 sk0, sk1, sk2, sv0, sv1;
#define SLOAD(j) do { int pos = (j) * 64 + srow - 48; pos = pos < 0 ? 0 : pos; const size_t tk = (size_t)b * L + pos; \
        const bf16_t* kvp = KV + tk * NKV + h * 128 + sq * 16; \
        sk0 = *(const u32x4*)(kvp); sk1 = *(const u32x4*)(kvp + 8); sv0 = *(const u32x4*)(kvp + 64); sv1 = *(const u32x4*)(kvp + 72); \
        sk2 = *(const u32x4*)(KR + tk * 32 + sq * 8); } while (0)
#define SWRITE(bb) do { unsigned char* kb = lds + AT_K + (bb) * 16384; unsigned char* vbp = lds + AT_V + (bb) * 16384; \
        *(u32x4*)(kb + kst0) = sk0; *(u32x4*)(kb + kst1) = sk1; *(u32x4*)(kb + kst2) = sk2; *(u32x4*)(vbp + vst0) = sv0; *(u32x4*)(vbp + vst1) = sv1; } while (0)
    float m_reg = 0.f, l_reg = 0.f; f32x16 o[2] = {};
    __syncthreads();
    SLOAD(0); SWRITE(0); __syncthreads();
    for (int j = 0; j < NT; ++j) {
        const int bsel = j & 1;
        if (j + 1 < NT) SLOAD(j + 1);
        if (j <= my_last) {
            const unsigned char* Ks = lds + AT_K + bsel * 16384;
            f32x16 p0, p1;
            { const float nm = -m_reg;
#pragma unroll
              for (int r = 0; r < 16; ++r) { p0[r] = nm; p1[r] = nm; } }
#pragma unroll
            for (int d0 = 0; d0 < 6; ++d0) { const int cb = (d0 * 16 + hi * 8) * 2;
                const bf16x8 k0 = *(const bf16x8*)(Ks + KSWZ(r32, cb)); const bf16x8 k1 = *(const bf16x8*)(Ks + KSWZ(32 + r32, cb));
                p0 = __builtin_amdgcn_mfma_f32_32x32x16_bf16(k0, qr[d0], p0, 0, 0, 0);
                p1 = __builtin_amdgcn_mfma_f32_32x32x16_bf16(k1, qr[d0], p1, 0, 0, 0); }
            if (j == 0) {
#pragma unroll
                for (int r = 0; r < 16; ++r) p0[r] = -1e30f;
#pragma unroll
                for (int r = 0; r < 8; ++r) p1[r] = -1e30f;
            }
            float pmax = fmaxf(fmaxf(p0[0], p0[1]), p0[2]);
#pragma unroll
            for (int r = 3; r < 15; r += 2) pmax = fmaxf(fmaxf(pmax, p0[r]), p0[r + 1]);
            pmax = fmaxf(fmaxf(pmax, p0[15]), p1[0]);
#pragma unroll
            for (int r = 1; r < 15; r += 2) pmax = fmaxf(fmaxf(pmax, p1[r]), p1[r + 1]);
            pmax = fmaxf(pmax, p1[15]);
            { auto rr = __builtin_amdgcn_permlane32_swap(__float_as_uint(pmax), __float_as_uint(pmax), false, false);
              pmax = fmaxf(__uint_as_float(rr[0]), __uint_as_float(rr[1])); }
            float ps = 0.f;
            if (__any(pmax > ATT_THR)) {
                const float dm = fmaxf(pmax, 0.f), alpha = fast_exp2(-dm); m_reg += dm;
#pragma unroll
                for (int r = 0; r < 16; ++r) { p0[r] -= dm; p1[r] -= dm; }
                l_reg *= alpha;
                if (hi == 0) al_l[r32] = alpha;
                asm volatile("s_waitcnt lgkmcnt(0)" ::: "memory");
#pragma unroll
                for (int r = 0; r < 16; ++r) { const float a = al_l[crow(r, hi)]; o[0][r] *= a; o[1][r] *= a; }
            }
#pragma unroll
            for (int r = 0; r < 16; ++r) { p0[r] = fast_exp2(p0[r]); ps += p0[r]; }
#pragma unroll
            for (int r = 0; r < 16; ++r) { p1[r] = fast_exp2(p1[r]); ps += p1[r]; }
            { auto rr = __builtin_amdgcn_permlane32_swap(__float_as_uint(ps), __float_as_uint(ps), false, false);
              ps = __uint_as_float(rr[0]) + __uint_as_float(rr[1]); }
            l_reg += ps;
            bf16x8 pa0, pa1, pa2, pa3;
#define PK4(P, BASE, OUT) do { unsigned a0 = cvtpk(P[BASE + 0], P[BASE + 1]), a1 = cvtpk(P[BASE + 2], P[BASE + 3]);   \
    unsigned b0 = cvtpk(P[BASE + 4], P[BASE + 5]), b1 = cvtpk(P[BASE + 6], P[BASE + 7]);                              \
    auto r0 = __builtin_amdgcn_permlane32_swap(a0, b0, false, false); auto r1 = __builtin_amdgcn_permlane32_swap(a1, b1, false, false); \
    u32x4 w = {r0[0], r1[0], r0[1], r1[1]}; OUT = *reinterpret_cast<bf16x8*>(&w); } while (0)
            PK4(p0, 0, pa0); PK4(p0, 8, pa1); PK4(p1, 0, pa2); PK4(p1, 8, pa3);
#undef PK4
            const int vb = vb0 + bsel * 16384;
            pv_one<0>(o[0], vb, pa0, pa1, pa2, pa3); pv_one<1>(o[1], vb, pa0, pa1, pa2, pa3);
        }
        if (j + 1 < NT) { if (bsel) SWRITE(0); else SWRITE(1); }
        __syncthreads();
    }
    if (hi == 0) li_l[r32] = l_reg;
    asm volatile("s_waitcnt lgkmcnt(0)" ::: "memory");
    const size_t tok0 = (size_t)b * SEQ + qb * 128 + wid * 32;
    float* SSO = (float*)(c.ws + WS_SSQ_O);
#pragma unroll
    for (int r = 0; r < 16; ++r) {
        const int orow = crow(r, hi); const float rl = fast_rcp(li_l[orow]);
        bf16_t* dst = MG + (tok0 + orow) * D + h * DV + r32;
        const float a0 = o[0][r] * rl, a1 = o[1][r] * rl;
        dst[0]  = (bf16_t)(cvtpk(a0, 0.f) & 0xffffu);
        dst[32] = (bf16_t)(cvtpk(a1, 0.f) & 0xffffu);
        float sq = a0 * a0 + a1 * a1;
        sq += dpp_mov<0xB1>(sq); sq += dpp_mov<0x4E>(sq); sq += dpp_mov<0x141>(sq); sq += dpp_mov<0x140>(sq);
        sq += __shfl_xor(sq, 16);
        if (r32 == 0) SSO[(tok0 + orow) * 8 + h] = sq;
    }
#undef SLOAD
#undef SWRITE
}
DEV void phase3(const Ctx& c) {
    const int nslots = NB * NH * 4;
    float* scr = (float*)(c.lds + c.wid * 8448);
    const int gw = c.vcu * 4 + c.wid, NGW = c.G * 4;
    constexpr int NWI = 6144;
    int wi = gw;
#define EW_ITEMS(n) do { __syncthreads(); for (int _q = 0; _q < (n) && wi < NWI; ++_q, wi += NGW) expert_weight_item(c, wi, scr); } while (0)
    for (int v = c.vcu; v < nslots; v += c.G) {
        const int bh = v >> 2, s = v & 3, b = bh >> 3, h = bh & 7;
        attn_unit(c, b, h, 15 - s); EW_ITEMS(1); attn_unit(c, b, h, s); EW_ITEMS(1); attn_unit(c, b, h, 11 - s); EW_ITEMS(1); attn_unit(c, b, h, 4 + s);
    }
    __syncthreads();
    for (; wi < NWI; wi += NGW) expert_weight_item(c, wi, scr);
#undef EW_ITEMS
}

DEV void phase4(const Ctx& c) {
    const bf16_t* MG = (const bf16_t*)(c.ws + WS_MG); const bf16_t* WoT = (const bf16_t*)(c.ws + WS_WO); const bf16_t* h0 = (const bf16_t*)(c.ws + WS_H0);
    bf16_t* R1 = (bf16_t*)(c.ws + WS_R1);
    const StageGeo g = stage_geo(c.tid);
    const int lane = c.lane, wr = c.wid >> 1, wc = c.wid & 1, fr = lane & 15, fq = lane >> 4;
    constexpr int NU = (TR / 128) * 8;
    for (int u = c.vcu; u < NU; u += c.G) {
        const int mt = u >> 3, nt = u & 7;
        const bf16_t* A = MG + (size_t)(mt * 128) * D + g.c; const bf16_t* B = WoT + (size_t)(nt * 128) * D + g.c;
        f32x4 acc[4][4];
        __syncthreads();
        if (c.tid < 128) { const float* pp = (const float*)(c.ws + WS_SSQ_O) + (size_t)(mt * 128 + c.tid) * 8; const f32x4 pa = *(const f32x4*)pp, pb = *(const f32x4*)(pp + 4);
            ((float*)(c.lds + RS_OFF))[c.tid] = rsqrt_((((pa.x + pa.y) + (pa.z + pa.w)) + ((pb.x + pb.y) + (pb.z + pb.w))) * (1.f / 512.f) + EPS); }
        gemm_mainloop<true>(acc, A + (size_t)g.r[0] * D, A + (size_t)g.r[1] * D, A + (size_t)g.r[2] * D, A + (size_t)g.r[3] * D,
                            B + (size_t)g.r[0] * D, B + (size_t)g.r[1] * D, B + (size_t)g.r[2] * D, B + (size_t)g.r[3] * D, 16, c.lds, 8, 1.f / 512.f);
#pragma unroll
        for (int m = 0; m < 4; ++m) {
            const int tok = mt * 128 + wr * 64 + m * 16 + fr;
            const size_t t = (size_t)(tok >> 11) * L + NMETA + (tok & 2047);
#pragma unroll
            for (int n = 0; n < 4; ++n) {
                const int col = nt * 128 + wc * 64 + n * 16 + fq * 4;
                const u32x2 hw = *(const u32x2*)(h0 + t * D + col);
                f32x4 o; o[0] = ALPHA * bflo(hw.x) + acc[m][n][0]; o[1] = ALPHA * bfhi(hw.x) + acc[m][n][1];
                o[2] = ALPHA * bflo(hw.y) + acc[m][n][2]; o[3] = ALPHA * bfhi(hw.y) + acc[m][n][3];
                st_bf4(R1 + (size_t)tok * D + col, o);
            }
        }
    }
}

constexpr int P5_ROWB = 2064, P5_PART = 33280, P5_LG = 45568, P5_BIAS = 48128, P5_AGG = 48384;
DEV void phase5(const Ctx& c, int ALT = 0) {
    const bf16_t* R1 = (const bf16_t*)(c.ws + WS_R1); bf16_t* H1 = (bf16_t*)(c.ws + WS_H0);
    const bf16_t* WrT = (const bf16_t*)(c.ws + WS_WR);
    unsigned* cnt = (unsigned*)(c.ws + WS_CTL) + CW_CNT + ALT * 32; unsigned* list = (unsigned*)(c.ws + (ALT ? 404 * MiB : WS_LIST)); float* combw = (float*)(c.ws + WS_COMBW);
    const int lane = c.lane, wid = c.wid, fr = lane & 15, fq = lane >> 4;
    float* part = (float*)(c.lds + P5_PART); float* lgs = (float*)(c.lds + P5_LG); float* biasl = (float*)(c.lds + P5_BIAS);
    __syncthreads();
    if (c.tid < 36) biasl[c.tid] = (c.tid < 4) ? c.in[I_BRG][c.tid] : c.in[I_BRE][c.tid - 4];
    bf16x8 wf[8][3];
#pragma unroll
    for (int ks = 0; ks < 8; ++ks)
#pragma unroll
        for (int n = 0; n < 3; ++n) wf[ks][n] = *(const bf16x8*)(WrT + (size_t)(n * 16 + fr) * D + wid * 256 + ks * 32 + fq * 8);
    unsigned* lcnt = (unsigned*)(c.lds + P5_AGG); unsigned* lbase = lcnt + 32; unsigned* ent = lcnt + 64;
    if (c.tid < 32) lcnt[c.tid] = 0u;
    int nent = 0;
    for (int u = c.vcu; u < TR / 16; u += c.G) {
        const int tok0 = u * 16;
        { const float* src[4]; bf16_t* dst[4]; unsigned char* ldsn[4]; unsigned char* f8n[4];
#pragma unroll
          for (int i = 0; i < 4; ++i) { const int tl = wid * 4 + i; const size_t tok = tok0 + tl; src[i] = (const float*)(R1 + tok * D); dst[i] = H1 + tok * D; ldsn[i] = c.lds + tl * P5_ROWB; f8n[i] = c.ws + WS_H1F8 + tok * D; }
          ln_rows_bf16<4, true, true>(src, c.in[I_LN1G], c.in[I_LN1B], dst, ldsn, lane, f8n); }
        __syncthreads();
        f32x4 acc[3] = {};
#pragma unroll
        for (int ks = 0; ks < 8; ++ks) {
            const int k = wid * 256 + ks * 32 + fq * 8;
            const bf16x8 a = *(const bf16x8*)(c.lds + fr * P5_ROWB + k * 2);
#pragma unroll
            for (int n = 0; n < 3; ++n) acc[n] = __builtin_amdgcn_mfma_f32_16x16x32_bf16(wf[ks][n], a, acc[n], 0, 0, 0);
        }
#pragma unroll
        for (int n = 0; n < 3; ++n) *(f32x4*)(part + (wid * 16 + fr) * 48 + n * 16 + fq * 4) = acc[n];
        __syncthreads();
#pragma unroll
        for (int i = 0; i < 3; ++i) { const int idx = c.tid + 256 * i;
            if (idx < 576) { const int tk = idx / 36, l = idx - tk * 36;
                lgs[tk * 40 + l] = ((part[tk * 48 + l] + part[(16 + tk) * 48 + l]) + (part[(32 + tk) * 48 + l] + part[(48 + tk) * 48 + l])) + biasl[l]; } }
        __syncthreads();
        if (c.tid < 16) {
            const float* lg = lgs + c.tid * 40;
            int gi = 0; float gm = lg[0];
#pragma unroll
            for (int i = 1; i < 4; ++i) { const float v = lg[i]; if (v > gm) { gm = v; gi = i; } }
            float gs = 0.f;
#pragma unroll
            for (int i = 0; i < 4; ++i) gs += __expf(lg[i] - gm);
            const float gw = 1.f / gs;
            const float* le = lg + 4 + gi * 8;
            float v0 = le[0], v1 = -3.0e38f; int i0 = 0, i1 = 0;
#pragma unroll
            for (int i = 1; i < 8; ++i) { const float v = le[i];
                if (v > v0) { v1 = v0; i1 = i0; v0 = v; i0 = i; } else if (v > v1) { v1 = v; i1 = i; } }
            const float ex = __expf(v1 - v0), inv = 1.f / (1.f + ex);
            const int tok = tok0 + c.tid; const unsigned e0 = gi * 8 + i0, e1 = gi * 8 + i1;
            combw[tok * 2] = gw * inv; combw[tok * 2 + 1] = gw * ex * inv;
            const unsigned r0 = atomicAdd(&lcnt[e0], 1u), r1 = atomicAdd(&lcnt[e1], 1u);
            const int ei = nent * 32 + c.tid * 2;
            ent[2 * ei] = (unsigned)(tok * 2);         ent[2 * ei + 1] = (e0 << 16) | r0;
            ent[2 * ei + 2] = (unsigned)(tok * 2 + 1); ent[2 * ei + 3] = (e1 << 16) | r1;
        }
        ++nent;
    }
    __syncthreads();
    if (c.tid < 32) { const unsigned n = lcnt[c.tid]; lbase[c.tid] = n ? atomicAdd(&cnt[c.tid * CNT_STRIDE], n) : 0u; }
    __syncthreads();
    for (int i = c.tid; i < nent * 32; i += 256) { const unsigned t2 = ent[2 * i], er = ent[2 * i + 1]; const unsigned e = er >> 16;
        list[(size_t)e * TR + lbase[e] + (er & 0xffffu)] = t2; }
}
DEV void bar20(const Ctx& c) {}
DEV void moe_tiles(const Ctx& c) {
    const unsigned* cnt = (const unsigned*)(c.ws + WS_CTL) + CW_CNT; int* ts = (int*)(c.lds + EXP_OFF);
    __syncthreads();
    if (c.tid < NE) ts[40 + c.tid] = (int)__hip_atomic_load(&cnt[c.tid * CNT_STRIDE], __ATOMIC_RELAXED, __HIP_MEMORY_SCOPE_AGENT);
    __syncthreads();
    if (c.tid == 0) { int s = 0; for (int e = 0; e < NE; ++e) { ts[e] = s; s += (ts[40 + e] + 127) >> 7; } ts[NE] = s; }
    __syncthreads();
}
DEV void phase6a(const Ctx& c) {
    const bf16_t* H18 = (const bf16_t*)(c.ws + WS_H1F8); const bf16_t* Wgu8 = (const bf16_t*)(c.ws + WS_WGU); unsigned char* ACT8 = c.ws + WS_ACT;
    const unsigned* list = (const unsigned*)(c.ws + WS_LIST);
    moe_tiles(c);
    const int* ts = (const int*)(c.lds + EXP_OFF); unsigned* tbl = (unsigned*)(c.lds + TBL_OFF);
    const StageGeo g = stage_geo(c.tid);
    const int lane = c.lane, wr = c.wid >> 1, wc = c.wid & 1, fr = lane & 15, fq = lane >> 4;
    const int NU = ts[NE] * 4;
    int e = 0;
    u32x2* RI = (u32x2*)(c.ws + WS_RI); const float* combw = (const float*)(c.ws + WS_COMBW);
    for (int u = c.vcu; u < NU; u += c.G) {
        const int rt = u >> 2, nt = u & 3;
        while (ts[e + 1] <= rt) ++e;
        const int j0 = (rt - ts[e]) * 128; const int ne = ts[40 + e];
        __syncthreads();
        if (c.tid < 128) { const int j = j0 + c.tid; const unsigned en = (j < ne) ? list[(size_t)e * TR + j] : 0xffffffffu; tbl[c.tid] = en;
            if (nt == 0) { u32x2 ri; ri.x = en; ri.y = (en == 0xffffffffu) ? 0u : __float_as_uint(combw[en]); RI[(size_t)rt * 128 + c.tid] = ri; } }
        __syncthreads();
        size_t ro[4];
#pragma unroll
        for (int i = 0; i < 4; ++i) { const unsigned en = tbl[g.r[i]]; ro[i] = (en == 0xffffffffu) ? 0 : (size_t)(en >> 1) * (D / 2); }
        const bf16_t* A = H18 + g.c; const bf16_t* B = Wgu8 + ((size_t)e * 512 + nt * 128) * (D / 2) + g.c;
        f32x4 acc[4][4];
        gemm_mainloop<false, true>(acc, A + ro[0], A + ro[1], A + ro[2], A + ro[3],
                             B + (size_t)g.r[0] * (D / 2), B + (size_t)g.r[1] * (D / 2), B + (size_t)g.r[2] * (D / 2), B + (size_t)g.r[3] * (D / 2), 8, c.lds, 0, 0.f);
#pragma unroll
        for (int m = 0; m < 4; ++m) { const size_t row = (size_t)rt * 128 + wr * 64 + m * 16 + fr;
#pragma unroll
            for (int i = 0; i < 2; ++i) {
                const f32x4 gt = acc[m][2 * i], up = acc[m][2 * i + 1]; f32x4 o;
#pragma unroll
                for (int j = 0; j < 4; ++j) { const float gv = gt[j] * WUNSCALE; o[j] = gv * sigmoidf_(gv) * (up[j] * WUNSCALE); }
                *(unsigned*)(ACT8 + row * DE + nt * 64 + wc * 32 + i * 16 + fq * 4) = pk_fp8x4(o[0], o[1], o[2], o[3]);
            } }
    }
}
DEV void phase6b(const Ctx& c) {
    const bf16_t* ACT8 = (const bf16_t*)(c.ws + WS_ACT); const bf16_t* Wd8 = (const bf16_t*)(c.ws + WS_WD); unsigned char* Y8 = c.ws + WS_Y;
    const u32x2* RI = (const u32x2*)(c.ws + WS_RI);
    moe_tiles(c);
    const int* ts = (const int*)(c.lds + EXP_OFF); u32x2* tbl = (u32x2*)(c.lds + TBL_OFF);
    const StageGeo g = stage_geo(c.tid);
    unsigned char* lds = c.lds;
    const int tid = c.tid, lane = c.lane, wr = c.wid >> 1, wc = c.wid & 1, fr = lane & 15, fq = lane >> 4;
    const int cb0 = fq * 32, cb1 = fq * 32 + 16;
    const int q0 = (cb0 >> 6) * 1024 + ((fr * 64 + (cb0 & 63)) ^ ((fr >> 3) << 5)), q1 = (cb1 >> 6) * 1024 + ((fr * 64 + (cb1 & 63)) ^ ((fr >> 3) << 5));
    const int a_off = wr * 8192, b_off = wc * 8192, dst = tid * 16;
    const int NU = ts[NE] * 2;
    int e = 0;
#define GLDS(src, off) __builtin_amdgcn_global_load_lds((const unsigned*)(src), (unsigned LAS*)(lds + (off)), 16, 0, 0)
    for (int u = c.vcu; u < NU; u += c.G) {
        const int rt = u >> 1, nh = u & 1;
        while (ts[e + 1] <= rt) ++e;
        __syncthreads();
        if (tid < 128) tbl[tid] = RI[(size_t)rt * 128 + tid];
        const bf16_t* A = ACT8 + (size_t)(rt * 128) * (DE / 2) + g.c;
        const bf16_t* B = Wd8 + ((size_t)e * 1024 + nh * 512) * (DE / 2) + g.c;
#pragma unroll
        for (int kt = 0; kt < 2; ++kt)
#pragma unroll
            for (int i = 0; i < 4; ++i) GLDS(A + (size_t)g.r[i] * (DE / 2) + kt * 64, kt * 16384 + dst + i * 4096);
#define BSTAGE(s_, buf) do { const bf16_t* _b = B + (size_t)((s_) >> 1) * 128 * (DE / 2) + ((s_) & 1) * 64; \
        GLDS(_b + (size_t)g.r[0] * (DE / 2), 32768 + (buf) * 16384 + dst);        GLDS(_b + (size_t)g.r[1] * (DE / 2), 32768 + (buf) * 16384 + dst + 4096); \
        GLDS(_b + (size_t)g.r[2] * (DE / 2), 32768 + (buf) * 16384 + dst + 8192); GLDS(_b + (size_t)g.r[3] * (DE / 2), 32768 + (buf) * 16384 + dst + 12288); } while (0)
        BSTAGE(0, 0);
        f32x4 acc[4][4];
#pragma unroll
        for (int m = 0; m < 4; ++m)
#pragma unroll
            for (int n = 0; n < 4; ++n) acc[m][n] = (f32x4){0.f, 0.f, 0.f, 0.f};
#pragma unroll 1
        for (int s_ = 0; s_ < 8; ++s_) {
            VM_WAIT();
            __syncthreads();
            const int bsel = s_ & 1;
            if (s_ + 1 < 8) { if (bsel) BSTAGE(s_ + 1, 0); else BSTAGE(s_ + 1, 1); }
            const unsigned char* ab = lds + bsel * 16384 + a_off; const unsigned char* bb = lds + 32768 + bsel * 16384 + b_off;
            v8i ax[4], bx[4];
#pragma unroll
            for (int m = 0; m < 4; ++m) { const u32x4 c0 = *(const u32x4*)(ab + m * 2048 + q0), c1 = *(const u32x4*)(ab + m * 2048 + q1);
                ax[m] = (v8i){(int)c0.x, (int)c0.y, (int)c0.z, (int)c0.w, (int)c1.x, (int)c1.y, (int)c1.z, (int)c1.w}; }
#pragma unroll
            for (int n = 0; n < 4; ++n) { const u32x4 c0 = *(const u32x4*)(bb + n * 2048 + q0), c1 = *(const u32x4*)(bb + n * 2048 + q1);
                bx[n] = (v8i){(int)c0.x, (int)c0.y, (int)c0.z, (int)c0.w, (int)c1.x, (int)c1.y, (int)c1.z, (int)c1.w}; }
#pragma unroll
            for (int m = 0; m < 4; ++m)
#pragma unroll
                for (int n = 0; n < 4; ++n) acc[m][n] = __builtin_amdgcn_mfma_scale_f32_16x16x128_f8f6f4(bx[n], ax[m], acc[m][n], 0, 0, 0, 0x7F7F7F7F, 0, 0x7F7F7F7F);
            if (bsel) {
                const int nt = nh * 4 + (s_ >> 1);
#pragma unroll
                for (int m = 0; m < 4; ++m) {
                    const u32x2 ri = tbl[wr * 64 + m * 16 + fr]; const unsigned en = ri.x;
                    if (en != 0xffffffffu) {
                        const float w = __uint_as_float(ri.y) * (WUNSCALE * YSCALE); unsigned char* dstp = Y8 + ((size_t)(en & 1u) * TR + (en >> 1)) * D + nt * 128 + wc * 64 + fq * 4;
#pragma unroll
                        for (int n = 0; n < 4; ++n) { const f32x4 o = acc[m][n] * w; *(unsigned*)(dstp + n * 16) = pk_fp8x4(o[0], o[1], o[2], o[3]); }
                    }
#pragma unroll
                    for (int n = 0; n < 4; ++n) acc[m][n] = (f32x4){0.f, 0.f, 0.f, 0.f};
                }
            }
        }
#undef BSTAGE
    }
#undef GLDS
}

DEV void phase7(const Ctx& c) {
    const bf16_t* H1 = (const bf16_t*)(c.ws + WS_H0); const unsigned char* Y8 = c.ws + WS_Y;
    const float* g = c.in[I_LN2G]; const float* bt = c.in[I_LN2B];
    const int gw = c.vcu * 4 + c.wid, NGW = c.G * 4, lane = c.lane;
    for (int tok0 = gw; tok0 < TR; tok0 += 2 * NGW) {
        float v[2][16]; float st[2]; int tk[2];
#pragma unroll
        for (int r = 0; r < 2; ++r) {
            int tok = tok0 + r * NGW; if (tok >= TR) tok = tok0; tk[r] = tok;
#pragma unroll
            for (int i = 0; i < 2; ++i) {
                const u32x4 hw = *(const u32x4*)(H1 + (size_t)tok * D + i * 512 + lane * 8);
                const u32x2 y0 = *(const u32x2*)(Y8 + (size_t)tok * D + i * 512 + lane * 8);
                const u32x2 y1 = *(const u32x2*)(Y8 + ((size_t)TR + tok) * D + i * 512 + lane * 8);
#pragma unroll
                for (int q2 = 0; q2 < 2; ++q2) {
                    const auto a0 = __builtin_amdgcn_cvt_pk_f32_fp8((int)y0[q2], false), a1 = __builtin_amdgcn_cvt_pk_f32_fp8((int)y0[q2], true);
                    const auto b0 = __builtin_amdgcn_cvt_pk_f32_fp8((int)y1[q2], false), b1 = __builtin_amdgcn_cvt_pk_f32_fp8((int)y1[q2], true);
                    v[r][i * 8 + 4 * q2]     = ALPHA * bflo(hw[2 * q2]) + (a0[0] + b0[0]) * YUNSCALE;
                    v[r][i * 8 + 4 * q2 + 1] = ALPHA * bfhi(hw[2 * q2]) + (a0[1] + b0[1]) * YUNSCALE;
                    v[r][i * 8 + 4 * q2 + 2] = ALPHA * bflo(hw[2 * q2 + 1]) + (a1[0] + b1[0]) * YUNSCALE;
                    v[r][i * 8 + 4 * q2 + 3] = ALPHA * bfhi(hw[2 * q2 + 1]) + (a1[1] + b1[1]) * YUNSCALE;
                }
            }
        }
#pragma unroll
        for (int r = 0; r < 2; ++r) { float a = 0.f;
#pragma unroll
            for (int q = 0; q < 16; ++q) a += v[r][q];
            st[r] = a; }
        wave_sum_n<2>(st);
#pragma unroll
        for (int r = 0; r < 2; ++r) { const float mean = st[r] * (1.f / 1024.f); float a = 0.f;
#pragma unroll
            for (int q = 0; q < 16; ++q) { v[r][q] -= mean; a += v[r][q] * v[r][q]; }
            st[r] = a; }
        wave_sum_n<2>(st);
#pragma unroll
        for (int i = 0; i < 2; ++i)
#pragma unroll
            for (int q = 0; q < 2; ++q) {
                const int col = i * 512 + lane * 8 + q * 4;
                const f32x4 gg = *(const f32x4*)(g + col), bb = *(const f32x4*)(bt + col);
#pragma unroll
                for (int r = 0; r < 2; ++r) {
                    if (r == 1 && tok0 + NGW >= TR) continue;
                    const float rstd = rsqrt_(st[r] * (1.f / 1024.f) + EPS);
                    f32x4 o; o[0] = v[r][i * 8 + q * 4] * rstd * gg[0] + bb[0]; o[1] = v[r][i * 8 + q * 4 + 1] * rstd * gg[1] + bb[1];
                    o[2] = v[r][i * 8 + q * 4 + 2] * rstd * gg[2] + bb[2]; o[3] = v[r][i * 8 + q * 4 + 3] * rstd * gg[3] + bb[3];
                    *(f32x4*)(c.out + (size_t)tk[r] * D + col) = o;
                }
            }
    }
}

__global__ void __launch_bounds__(256, 2) fwd_kernel(Args a) {
    extern __shared__ __attribute__((aligned(16))) unsigned char lds[];
    Ctx c; c.in = a.in; c.out = a.out; c.ws = a.ws; c.lds = lds;
    c.tid = threadIdx.x; c.lane = c.tid & 63; c.wid = __builtin_amdgcn_readfirstlane(c.tid >> 6);
    c.G = gridDim.x; { const int bx = blockIdx.x; c.vcu = (c.G % 8 == 0) ? (bx % 8) * (c.G / 8) + bx / 8 : bx; }
    if (c.tid < 64) ((unsigned*)(lds + MISC_OFF))[c.tid] = 0u;
    __syncthreads();
    unsigned* ctl = (unsigned*)(a.ws + WS_CTL);
    XcdBarrier bar = xcd_barrier_post(ctl + CW_BAR, (volatile LAS unsigned*)(lds + MISC_OFF));
#ifdef ONLY_PH
#define PH_ON(k) ((k) == ONLY_PH)
#else
#define PH_ON(k) 1
#endif
    const int lo = a.ph_lo, hi = a.ph_hi;
#define RUN_PHASE(k, fn) if (PH_ON(k) && lo <= (k) && (k) < hi) { \
        for (int _rep = 0; _rep < ((REPEAT_PH == (k)) ? 2 : 1); ++_rep) { \
            int _t = threadIdx.x; asm volatile("" : "+v"(_t)); c.tid = _t; c.lane = _t & 63; c.wid = __builtin_amdgcn_readfirstlane(_t >> 6); \
            if ((k) == 5) phase5(c, _rep); else fn(c); \
            if (_rep == 0 && REPEAT_PH == (k)) xcd_barrier(bar); } \
        if ((k) + 1 < hi) xcd_barrier(bar); }
    RUN_PHASE(0, phase0)
    RUN_PHASE(1, phase1)
    RUN_PHASE(2, phase2)
    RUN_PHASE(3, phase3)
    RUN_PHASE(4, phase4)
    RUN_PHASE(5, phase0)
    RUN_PHASE(6, phase6a)
    RUN_PHASE(7, phase6b)
    RUN_PHASE(8, phase7)
}

extern "C" void kernel_launch(void* const* d_in, const int* in_sizes, int n_in, void* d_out, int out_size, void* d_ws, size_t ws_size, hipStream_t stream) {
    static int grid = 0;
    if (grid == 0) {
        if (n_in != 27 || in_sizes[0] != NB * SEQ * D || out_size != TR * D || ws_size < WS_END) {
            fprintf(stderr, "kernel_launch: shape mismatch n_in %d in0 %d out %d ws %zu\n", n_in, n_in > 0 ? in_sizes[0] : -1, out_size, ws_size); grid = -1; return; }
        int dev = 0, cus = 0, per_cu = 0;
        if (hipGetDevice(&dev) != hipSuccess || hipDeviceGetAttribute(&cus, hipDeviceAttributeMultiprocessorCount, dev) != hipSuccess) { grid = -1; return; }
        if (hipFuncSetAttribute((const void*)fwd_kernel, hipFuncAttributeMaxDynamicSharedMemorySize, LDS_BYTES) != hipSuccess) { grid = -1; return; }
        if (hipOccupancyMaxActiveBlocksPerMultiprocessor(&per_cu, (const void*)fwd_kernel, 256, LDS_BYTES) != hipSuccess || per_cu < 1) per_cu = 1;
        (void)hipGetLastError();
        if (per_cu > 2) per_cu = 2;
        grid = cus * per_cu;
        fprintf(stderr, "kernel_launch: grid %d (%d per CU)\n", grid, per_cu);
    }
    if (grid < 0) return;
    (void)hipMemsetAsync((char*)d_ws + WS_CTL, 0, CTL_ZERO_BYTES, stream);
    Args a{};
    for (int i = 0; i < 27; ++i) a.in[i] = (const float*)d_in[i];
    a.out = (float*)d_out; a.ws = (unsigned char*)d_ws;
    if (MK_N_LAUNCHES == 1) {
        a.ph_lo = 0; a.ph_hi = NPH;
        hipLaunchKernelGGL(fwd_kernel, dim3(grid), dim3(256), LDS_BYTES, stream, a);
    } else {
        for (int ph = 0; ph < NPH; ++ph) { a.ph_lo = ph; a.ph_hi = ph + 1; hipLaunchKernelGGL(fwd_kernel, dim3(grid), dim3(256), LDS_BYTES, stream, a); }
    }
}
```

```cpp
#include <hip/hip_runtime.h>
#include <cstdio>
#include <cstdint>

#ifndef REPEAT_PH
#define REPEAT_PH -1
#endif
#ifndef CONV_REPB
#define CONV_REPB 1
#endif
#ifndef CONV_REPC
#define CONV_REPC 1
#endif
#ifndef CONV_REPA
#define CONV_REPA 1
#endif
#ifndef MK_N_LAUNCHES
#define MK_N_LAUNCHES 1
#endif

#define DEV __device__ __forceinline__
#define LAS __attribute__((address_space(3)))
#define GAS __attribute__((address_space(1)))
typedef unsigned short bf16_t;
typedef short bf16x8 __attribute__((ext_vector_type(8)));
typedef short s16x4 __attribute__((ext_vector_type(4)));
typedef float f32x4 __attribute__((ext_vector_type(4)));
typedef float f32x16 __attribute__((ext_vector_type(16)));
typedef unsigned u32x4 __attribute__((ext_vector_type(4)));
typedef unsigned u32x2 __attribute__((ext_vector_type(2)));
typedef long i64x2 __attribute__((ext_vector_type(2)));
typedef int v8i __attribute__((ext_vector_type(8)));

constexpr int NB = 16, SEQ = 2048, NMETA = 16, L = SEQ + NMETA;
constexpr int T = NB * L;
constexpr int TR = NB * SEQ;
constexpr int D = 1024, NIN = 1696, CC = 512, QL = 384, KVL = 256, NH = 8, DQK = 96, DV = 64;
constexpr int NQ = NH * DQK;
constexpr int NKV = NH * (64 + DV);
constexpr int NE = 32, DE = 256, CONVK = 31;
constexpr float EPS = 1e-5f;
constexpr float ALPHA = 1.189207115002721f;
constexpr float QSCALE = 0.10206207261596577f * 1.4426950408889634f;
constexpr int NPH = 9;
constexpr float WSCALE = 16.f, WUNSCALE = 1.f / 16.f;
constexpr float YSCALE = 64.f, YUNSCALE = 1.f / 64.f;

constexpr size_t MiB = 1u << 20;
constexpr size_t WS_CTL = 0, CTL_ZERO_BYTES = 64 * 1024;
constexpr int CW_CNT = 1024, CNT_STRIDE = 64;
constexpr int CW_BAR = 4096;
constexpr size_t WS_LIST = 1 * MiB;
constexpr size_t WS_COMBW = 5 * MiB;
constexpr size_t WS_ROPE = 5 * MiB + 512 * 1024;
constexpr size_t WS_WIN = 6 * MiB;
constexpr size_t WS_WUQ = 10 * MiB;
constexpr size_t WS_WUKV = 11 * MiB;
constexpr size_t WS_WO = 12 * MiB;
constexpr size_t WS_WR = 14 * MiB;
constexpr size_t WS_RI = 14 * MiB + 512 * 1024;
constexpr size_t WS_SSQ_CQ = 404 * MiB + 512 * 1024;
constexpr size_t WS_SSQ_CKV = 402 * MiB;
constexpr size_t WS_SSQ_O = 403 * MiB;
constexpr size_t WS_WGU = 16 * MiB;
constexpr size_t WS_WD = 48 * MiB;
constexpr size_t WS_H1F8 = 130 * MiB;
constexpr size_t WS_H0 = 64 * MiB;
constexpr size_t WS_U = 130 * MiB;
constexpr size_t WS_CQ = 163 * MiB;
constexpr size_t WS_CKV = 188 * MiB;
constexpr size_t WS_KR = 205 * MiB;
constexpr size_t WS_Q = 208 * MiB;
constexpr size_t WS_KV = 257 * MiB;
constexpr size_t WS_R1 = 208 * MiB;
constexpr size_t WS_Y = 208 * MiB;
constexpr size_t WS_MG = 336 * MiB;
constexpr size_t WS_ACT = 336 * MiB;
constexpr size_t WS_DUMMY = 400 * MiB;
constexpr size_t WS_END = 406 * MiB;

constexpr int LDS_BYTES = 73728;
constexpr int MISC_OFF = LDS_BYTES - 256;
constexpr int RS_OFF = 65536;
constexpr int TBL_OFF = 66048;
constexpr int EXP_OFF = 67584;

DEV unsigned cvtpk(float lo, float hi) { unsigned r; asm("v_cvt_pk_bf16_f32 %0, %1, %2" : "=v"(r) : "v"(lo), "v"(hi)); return r; }
DEV float bflo(unsigned w) { return __uint_as_float(w << 16); }
DEV float bfhi(unsigned w) { return __uint_as_float(w & 0xffff0000u); }
DEV float dpp_add_qp(float v, int) { return v; }
template <int CTRL> DEV float dpp_mov(float v) { return __builtin_bit_cast(float, __builtin_amdgcn_update_dpp(0, __builtin_bit_cast(int, v), CTRL, 0xf, 0xf, false)); }
DEV float wave_sum(float v) {
    v += dpp_mov<0xB1>(v);
    v += dpp_mov<0x4E>(v);
    v += dpp_mov<0x141>(v);
    v += dpp_mov<0x140>(v);
    const int iv = __builtin_bit_cast(int, v);
    const float a = __builtin_bit_cast(float, __builtin_amdgcn_readlane(iv, 0)), b = __builtin_bit_cast(float, __builtin_amdgcn_readlane(iv, 16));
    const float c = __builtin_bit_cast(float, __builtin_amdgcn_readlane(iv, 32)), d = __builtin_bit_cast(float, __builtin_amdgcn_readlane(iv, 48));
    return (a + b) + (c + d);
}
DEV float rsqrt_(float x) { return __builtin_amdgcn_rsqf(x); }
DEV void st_bf4(bf16_t* p, f32x4 v) { u32x2 w = {cvtpk(v[0], v[1]), cvtpk(v[2], v[3])}; *(u32x2*)p = w; }
DEV unsigned pk_fp8x4(float a, float b, float c, float d) {
    int w = __builtin_amdgcn_cvt_pk_fp8_f32(a, b, 0, false); w = __builtin_amdgcn_cvt_pk_fp8_f32(c, d, w, true); return (unsigned)w; }
DEV float fast_exp2(float x) { return __builtin_amdgcn_exp2f(x); }
DEV float fast_rcp(float x) { return __builtin_amdgcn_rcpf(x); }
DEV float sigmoidf_(float g) { return fast_rcp(1.f + fast_exp2(-1.4426950408889634f * g)); }
#define LDS_WAIT() asm volatile("s_waitcnt lgkmcnt(0)" ::: "memory")
#define VM_WAIT() asm volatile("s_waitcnt vmcnt(0)" ::: "memory")

#define XB_TMO      128
#define XB_XCNT(j)  (256  + 64 * (j))
#define XB_XSUB(j)  (1280 + 64 * (j))
#define XB_XGEN(j)  (2304 + 64 * (j))
#define XB_TOP      3328
#define XB_TOPGEN   3392
#define XCD_BAR_WORDS 3456
#define XB_SPIN_CAP (1u << 22)
DEV unsigned xb_ld(unsigned* p)              { return __hip_atomic_load(p, __ATOMIC_RELAXED, __HIP_MEMORY_SCOPE_AGENT); }
DEV unsigned xb_add(unsigned* p, unsigned v) { return __hip_atomic_fetch_add(p, v, __ATOMIC_RELAXED, __HIP_MEMORY_SCOPE_AGENT); }
DEV unsigned xb_xcc_id() { return (unsigned)__builtin_amdgcn_s_getreg((3 << 11) | 20) & 0xFu; }
#define XB_SPIN(cond, bar) do { unsigned _sp = 0; while (cond) { __builtin_amdgcn_s_sleep(1); \
    if ((++_sp & 255u) == 0u) { if (xb_ld(&(bar)[XB_TMO])) break; if (_sp > XB_SPIN_CAP) { atomicAdd(&(bar)[XB_TMO], 1u); break; } } } } while (0)
struct XcdBarrier { unsigned* bar; unsigned x; volatile LAS unsigned* st; };
DEV XcdBarrier xcd_barrier_post(unsigned* bar, volatile LAS unsigned* st) {
    XcdBarrier b; b.bar = bar; b.x = xb_xcc_id(); b.st = st;
    if (threadIdx.x == 0) (void)xb_add(&bar[XB_XCNT(b.x)], 1u);
    return b;
}
DEV void xcd_barrier_complete(unsigned* bar, unsigned x, unsigned& nloc, unsigned& nx) {
    const unsigned G = gridDim.x * gridDim.y * gridDim.z;
    unsigned sum, cnt, mine, sp = 0u;
    for (;;) {
        sum = 0u; cnt = 0u; mine = 0u;
#pragma unroll
        for (unsigned j = 0; j < 16; ++j) { const unsigned c = xb_ld(&bar[XB_XCNT(j)]); sum += c; cnt += (c > 0u) ? 1u : 0u; mine = (j == x) ? c : mine; }
        if (sum == G) break;
        __builtin_amdgcn_s_sleep(1);
        if ((++sp & 255u) == 0u) { if (xb_ld(&bar[XB_TMO])) break; if (sp > XB_SPIN_CAP) { atomicAdd(&bar[XB_TMO], 1u); break; } }
    }
    nloc = mine > 0u ? mine : 1u; nx = cnt > 0u ? cnt : 1u;
}
DEV void xcd_barrier(const XcdBarrier& b) {
    asm volatile("s_waitcnt vmcnt(0)" ::: "memory");
    __syncthreads();
    if (threadIdx.x == 0) {
        unsigned* bar = b.bar;
        __builtin_amdgcn_s_waitcnt(0);
        unsigned nloc = b.st[0], nx = b.st[1];
        if (nloc == 0u) { xcd_barrier_complete(bar, b.x, nloc, nx); b.st[0] = nloc; b.st[1] = nx; }
        const unsigned old = xb_add(&bar[XB_XSUB(b.x)], 1u);
        const unsigned gen = old / nloc;
        if (old + 1u == (gen + 1u) * nloc) {
            __builtin_amdgcn_fence(__ATOMIC_RELEASE, "agent");
            asm volatile("s_waitcnt vmcnt(0)" ::: "memory");
            const unsigned og = xb_add(&bar[XB_TOP], 1u);
            const unsigned tg = og / nx;
            if (og + 1u == (tg + 1u) * nx) xb_add(&bar[XB_TOPGEN], 1u);
            else XB_SPIN(xb_ld(&bar[XB_TOPGEN]) == tg, bar);
            __builtin_amdgcn_fence(__ATOMIC_ACQUIRE, "agent");
            xb_add(&bar[XB_XGEN(b.x)], 1u);
            asm volatile("s_waitcnt vmcnt(0)" ::: "memory");
        } else {
            XB_SPIN(xb_ld(&bar[XB_XGEN(b.x)]) == gen, bar);
            __builtin_amdgcn_fence(__ATOMIC_ACQUIRE, "agent");
            asm volatile("s_waitcnt vmcnt(0)" ::: "memory");
        }
    }
    __syncthreads();
}

struct Args { const float* in[27]; float* out; unsigned char* ws; int ph_lo, ph_hi; };
struct Ctx {
    const float* const* in; float* out; unsigned char* ws; unsigned char* lds;
    int tid, lane, wid, vcu, G;
};
enum { I_X = 0, I_META, I_LNIN_G, I_LNIN_B, I_WIN, I_CONVW, I_CONVB, I_CLN_G, I_CLN_B, I_QNG, I_WUQ, I_KVNG, I_WUKV, I_COUT_G, I_AOUT_G, I_WO,
       I_LN1G, I_LN1B, I_WRG, I_BRG, I_WRE, I_BRE, I_WGATE, I_WUP, I_WDOWN, I_LN2G, I_LN2B };

DEV int nmap(int mode, int n) {
    if (mode == 1) { if (n < 512) return ((n >> 4) << 5) + (n & 15); if (n < 1024) return (((n - 512) >> 4) << 5) + 16 + (n & 15); return n; }
    if (mode == 2) return ((n >> 4) << 5) + (n & 15);
    if (mode == 3) return ((n >> 4) << 5) + 16 + (n & 15);
    return n;
}
DEV void p0_transpose_item(const float* __restrict__ W, int N, int k0, int n0, const float* __restrict__ kscale, bf16_t* WT, int ldt, int kout0, int mode,
                           float* scr, int lane) {
#pragma unroll 8
    for (int i = 0; i < 32; ++i) {
        const int kk = 2 * i + (lane >> 5);
        float v = W[(size_t)(k0 + kk) * N + n0 + (lane & 31)];
        if (kscale) v *= kscale[k0 + kk];
        scr[kk * 33 + (lane & 31)] = v;
    }
    LDS_WAIT(); asm volatile("" ::: "memory");
    const int c = lane & 7;
#pragma unroll
    for (int j = 0; j < 4; ++j) {
        const int n = (lane >> 3) + 8 * j; const float* s = scr + (8 * c) * 33 + n;
        u32x4 o; o.x = cvtpk(s[0 * 33], s[1 * 33]); o.y = cvtpk(s[2 * 33], s[3 * 33]); o.z = cvtpk(s[4 * 33], s[5 * 33]); o.w = cvtpk(s[6 * 33], s[7 * 33]);
        *(u32x4*)(WT + (size_t)nmap(mode, n0 + n) * ldt + kout0 + 8 * c) = o;
    }
    LDS_WAIT(); asm volatile("" ::: "memory");
}
DEV void p0_transpose_item_f8(const float* __restrict__ W, int N, int k0, int n0, float scale, unsigned char* W8, int ldt, int kout0, int mode, float* scr, int lane) {
#pragma unroll 8
    for (int i = 0; i < 32; ++i) { const int kk = 2 * i + (lane >> 5); scr[kk * 33 + (lane & 31)] = W[(size_t)(k0 + kk) * N + n0 + (lane & 31)] * scale; }
    LDS_WAIT(); asm volatile("" ::: "memory");
    const int c = lane & 7;
#pragma unroll
    for (int j = 0; j < 4; ++j) {
        const int n = (lane >> 3) + 8 * j; const float* sp = scr + (8 * c) * 33 + n;
        u32x2 o; o.x = pk_fp8x4(sp[0 * 33], sp[1 * 33], sp[2 * 33], sp[3 * 33]); o.y = pk_fp8x4(sp[4 * 33], sp[5 * 33], sp[6 * 33], sp[7 * 33]);
        *(u32x2*)(W8 + (size_t)nmap(mode, n0 + n) * ldt + kout0 + 8 * c) = o;
    }
    LDS_WAIT(); asm volatile("" ::: "memory");
}
template <int N> DEV void wave_sum_n(float (&v)[N]) {
#pragma unroll
    for (int i = 0; i < N; ++i) v[i] = wave_sum(v[i]);
}
template <int NR, bool F8 = false, bool BFIN = false> DEV void ln_rows_bf16(const float* const (&xrow)[NR], const float* g, const float* bta, bf16_t* const (&orow)[NR], unsigned char* const (&ldsrow)[NR], int lane, unsigned char* const* f8row = nullptr) {
    f32x4 v[NR][4]; float s[NR];
#pragma unroll
    for (int r = 0; r < NR; ++r)
#pragma unroll
        for (int j = 0; j < 4; ++j) {
            if (BFIN) { const u32x2 w = ((const u32x2*)xrow[r])[64 * j + lane]; v[r][j] = (f32x4){bflo(w.x), bfhi(w.x), bflo(w.y), bfhi(w.y)}; }
            else v[r][j] = ((const f32x4*)xrow[r])[64 * j + lane]; }
#pragma unroll
    for (int r = 0; r < NR; ++r) { s[r] = 0.f;
#pragma unroll
        for (int j = 0; j < 4; ++j) s[r] += (v[r][j].x + v[r][j].y) + (v[r][j].z + v[r][j].w); }
    wave_sum_n<NR>(s);
    float s2[NR];
#pragma unroll
    for (int r = 0; r < NR; ++r) { const float mean = s[r] * (1.f / 1024.f); s2[r] = 0.f;
#pragma unroll
        for (int j = 0; j < 4; ++j) { v[r][j] = v[r][j] - mean; s2[r] += (v[r][j].x * v[r][j].x + v[r][j].y * v[r][j].y) + (v[r][j].z * v[r][j].z + v[r][j].w * v[r][j].w); } }
    wave_sum_n<NR>(s2);
#pragma unroll
    for (int j = 0; j < 4; ++j) {
        const f32x4 gg = ((const f32x4*)g)[64 * j + lane], bb = ((const f32x4*)bta)[64 * j + lane];
#pragma unroll
        for (int r = 0; r < NR; ++r) {
            const float rstd = rsqrt_(s2[r] * (1.f / 1024.f) + EPS);
            const f32x4 o = v[r][j] * rstd * gg + bb;
            const u32x2 w = {cvtpk(o.x, o.y), cvtpk(o.z, o.w)};
            ((u32x2*)orow[r])[64 * j + lane] = w;
            if (ldsrow[r]) ((u32x2*)ldsrow[r])[64 * j + lane] = w;
            if (F8) ((unsigned*)f8row[r])[64 * j + lane] = pk_fp8x4(o.x, o.y, o.z, o.w);
        }
    }
}
__device__ const float INVF[16] = {1.0f, 0.5623413251903491f, 0.31622776601683794f, 0.1778279410038923f, 0.1f, 0.05623413251903491f, 0.031622776601683794f,
    0.01778279410038923f, 0.01f, 0.005623413251903491f, 0.0031622776601683794f, 0.001778279410038923f, 0.001f, 0.0005623413251903491f, 0.00031622776601683794f, 0.0001778279410038923f};
DEV void sincos_d(double a, float& sn, float& cs) {
    const double TWO_PI = 6.283185307179586476925286766559;
    const double k = __builtin_rint(a / TWO_PI);
    const double r = a - k * TWO_PI;
    const double r2 = r * r;
    double st = r, ct = 1.0, ssum = r, csum = 1.0;
#pragma unroll 1
    for (int i = 1; i <= 14; ++i) {
        ct = -ct * r2 / (double)((2 * i - 1) * (2 * i));  csum += ct;
        st = -st * r2 / (double)((2 * i) * (2 * i + 1));  ssum += st;
    }
    sn = (float)ssum; cs = (float)csum;
}
DEV void ew_block(const float* __restrict__ W, int N, int k0, int n0, unsigned char* W8, int ldt, int mode, int lane) {
    const int q = lane & 15, kq = lane >> 4;
    const float* src = W + (size_t)(k0 + 16 * kq) * N + n0 + 4 * q;
    f32x4 v[16];
#pragma unroll
    for (int i = 0; i < 16; ++i) v[i] = *(const f32x4*)(src + (size_t)i * N);
#pragma unroll
    for (int j = 0; j < 4; ++j) {
        u32x4 o;
        o.x = pk_fp8x4(v[0][j] * WSCALE, v[1][j] * WSCALE, v[2][j] * WSCALE, v[3][j] * WSCALE);
        o.y = pk_fp8x4(v[4][j] * WSCALE, v[5][j] * WSCALE, v[6][j] * WSCALE, v[7][j] * WSCALE);
        o.z = pk_fp8x4(v[8][j] * WSCALE, v[9][j] * WSCALE, v[10][j] * WSCALE, v[11][j] * WSCALE);
        o.w = pk_fp8x4(v[12][j] * WSCALE, v[13][j] * WSCALE, v[14][j] * WSCALE, v[15][j] * WSCALE);
        *(u32x4*)(W8 + (size_t)nmap(mode, n0 + 4 * q + j) * ldt + k0 + 16 * kq) = o;
    }
}
DEV void expert_weight_item(const Ctx& c, int r, float*  ) {
    unsigned char* Wgu8 = c.ws + WS_WGU; unsigned char* Wd8 = c.ws + WS_WD;
    if (r < 2048) { const int e = r >> 6, qq = r & 63, kb = qq >> 2, nb = qq & 3;
        ew_block(c.in[I_WGATE] + (size_t)e * D * DE, DE, 64 * kb, 64 * nb, Wgu8 + (size_t)e * 512 * 1024, 1024, 2, c.lane); return; } r -= 2048;
    if (r < 2048) { const int e = r >> 6, qq = r & 63, kb = qq >> 2, nb = qq & 3;
        ew_block(c.in[I_WUP] + (size_t)e * D * DE, DE, 64 * kb, 64 * nb, Wgu8 + (size_t)e * 512 * 1024, 1024, 3, c.lane); return; } r -= 2048;
    { const int e = r >> 6, qq = r & 63, kb = qq >> 4, nb = qq & 15;
        ew_block(c.in[I_WDOWN] + (size_t)e * DE * D, D, 64 * kb, 64 * nb, Wd8 + (size_t)e * 1024 * 256, 256, 0, c.lane); }
}
DEV void phase0(const Ctx& c) {
    float* scr = (float*)(c.lds + c.wid * 8448);
    const int gw = c.vcu * 4 + c.wid, NGW = c.G * 4;
    constexpr int I_IN = 16 * 53, I_UQ = 6 * 24, I_UKV = 4 * 32, I_O = 16 * 32;
    bf16_t* WinT = (bf16_t*)(c.ws + WS_WIN); bf16_t* WuqT = (bf16_t*)(c.ws + WS_WUQ); bf16_t* WukvT = (bf16_t*)(c.ws + WS_WUKV);
    bf16_t* WoT = (bf16_t*)(c.ws + WS_WO);
    constexpr int NITEMS0 = I_IN + I_UQ + I_UKV + I_O;
    for (int it = gw; it < NITEMS0; it += NGW) {
        int r = it;
        if (r < I_IN) { const int kb = r / 53, nb = r % 53; p0_transpose_item(c.in[I_WIN], NIN, 64 * kb, 32 * nb, nullptr, WinT, 1024, 64 * kb, 1, scr, c.lane); continue; } r -= I_IN;
        if (r < I_UQ) { const int kb = r / 24, nb = r % 24; p0_transpose_item(c.in[I_WUQ], NQ, 64 * kb, 32 * nb, c.in[I_QNG], WuqT, QL, 64 * kb, 0, scr, c.lane); continue; } r -= I_UQ;
        if (r < I_UKV) { const int kb = r / 32, nb = r % 32; p0_transpose_item(c.in[I_WUKV], NKV, 64 * kb, 32 * nb, c.in[I_KVNG], WukvT, KVL, 64 * kb, 0, scr, c.lane); continue; } r -= I_UKV;
        { const int kb = r / 32, nb = r % 32;
            if (kb < 8) p0_transpose_item(c.in[I_WO], D, 64 * kb, 32 * nb, nullptr, WoT, 1024, 64 * kb + 512, 0, scr, c.lane);
            else        p0_transpose_item(c.in[I_WO], D, 64 * kb, 32 * nb, c.in[I_AOUT_G] - 512, WoT, 1024, 64 * kb - 512, 0, scr, c.lane); }
    }
    const int gt = c.vcu * 256 + c.tid, NGT = c.G * 256;
    bf16_t* WrT = (bf16_t*)(c.ws + WS_WR);
    for (int i = gt; i < 48 * 1024; i += NGT) {
        const int n = i >> 10, k = i & 1023; float v = 0.f;
        if (n < 4) v = c.in[I_WRG][k * 4 + n]; else if (n < 36) v = c.in[I_WRE][k * 32 + (n - 4)];
        WrT[i] = (bf16_t)(cvtpk(v, 0.f) & 0xffffu);
    }
    float* rc = (float*)(c.ws + WS_ROPE); float* rs = rc + L * 16;
    for (int i = gt; i < L * 16; i += NGT) {
        const int p = i >> 4, f = i & 15; const float ang = (float)p * INVF[f];
        float sn, cs; sincos_d((double)ang, sn, cs); rc[i] = cs; rs[i] = sn;
    }
    bf16_t* h0 = (bf16_t*)(c.ws + WS_H0);
    for (int t = gw; t < T; t += 2 * NGW) {
        const float* src[2]; bf16_t* dst[2]; unsigned char* ldsn[2] = {nullptr, nullptr};
#pragma unroll
        for (int r = 0; r < 2; ++r) { int tt = t + r * NGW; if (tt >= T) tt = t;
            const int b = tt / L, p = tt - b * L;
            src[r] = (p < NMETA) ? c.in[I_META] + (size_t)p * D : c.in[I_X] + ((size_t)b * SEQ + (p - NMETA)) * D;
            dst[r] = h0 + (size_t)tt * D; }
        ln_rows_bf16<2>(src, c.in[I_LNIN_G], c.in[I_LNIN_B], dst, ldsn, c.lane);
    }
}

struct StageGeo { int r[4]; int c; };
DEV StageGeo stage_geo(int tid) {
    const int lane = tid & 63, wid = tid >> 6; StageGeo g;
    const int rl = lane >> 2, cl = ((lane & 3) * 8) ^ ((lane >> 5) << 4);
#pragma unroll
    for (int i = 0; i < 4; ++i) g.r[i] = (((wid + 4 * i) >> 1) << 4) + rl;
    g.c = ((wid & 1) << 5) + cl;
    return g;
}
template <bool SSQ, bool FP8 = false>
DEV void gemm_mainloop(f32x4 (&acc)[4][4], const bf16_t* ap0, const bf16_t* ap1, const bf16_t* ap2, const bf16_t* ap3,
                       const bf16_t* bp0, const bf16_t* bp1, const bf16_t* bp2, const bf16_t* bp3,
                       int nk, unsigned char* lds, int ssq_steps, float ssq_inv_dim, bool skip_wc1 = false) {
    const int tid = threadIdx.x, lane = tid & 63, wid = tid >> 6, wr = wid >> 1, wc = wid & 1, fr = lane & 15, fq = lane >> 4;
    const int xs = (fr >> 1) & 7;
    const int lo = ((fr * 64 + fq * 16) ^ ((fr >> 3) << 5));
    const int lo0 = lo, lo1 = lo + 1024;
    const int a_off = wr * 8192, b_off = 16384 + wc * 8192;
    const int dst = tid * 16;
#pragma unroll
    for (int m = 0; m < 4; ++m)
#pragma unroll
        for (int n = 0; n < 4; ++n) acc[m][n] = (f32x4){0.f, 0.f, 0.f, 0.f};
    __syncthreads();
#define GLDS(src, off) __builtin_amdgcn_global_load_lds((const unsigned*)(src), (unsigned LAS*)(lds + (off)), 16, 0, 0)
#define STAGE(kt, b) do { const int _k = (kt) * 64; \
        GLDS(ap0 + _k, (b) * 32768 + dst);          GLDS(ap1 + _k, (b) * 32768 + dst + 4096); \
        GLDS(ap2 + _k, (b) * 32768 + dst + 8192);   GLDS(ap3 + _k, (b) * 32768 + dst + 12288); \
        GLDS(bp0 + _k, (b) * 32768 + 16384 + dst);  GLDS(bp1 + _k, (b) * 32768 + 16384 + dst + 4096); \
        GLDS(bp2 + _k, (b) * 32768 + 16384 + dst + 8192); GLDS(bp3 + _k, (b) * 32768 + 16384 + dst + 12288); } while (0)
    STAGE(0, 0);
    for (int kt = 0; kt < nk; ++kt) {
        VM_WAIT();
        __syncthreads();
        const int b = kt & 1;
        if (SSQ && kt == ssq_steps) {
            const float* rsl = (const float*)(lds + RS_OFF);
#pragma unroll
            for (int m = 0; m < 4; ++m) { const float r = rsl[wr * 64 + m * 16 + fr];
#pragma unroll
                for (int n = 0; n < 4; ++n) acc[m][n] = acc[m][n] * r; }
        }
        if (kt + 1 < nk) { if (b) STAGE(kt + 1, 0); else STAGE(kt + 1, 1); }
        const unsigned char* base = lds + b * 32768;
        if (skip_wc1 && wc == 1) {
        } else if (FP8) {
            const int cb0 = fq * 32, cb1 = fq * 32 + 16;
            const int q0 = (cb0 >> 6) * 1024 + ((fr * 64 + (cb0 & 63)) ^ ((fr >> 3) << 5)), q1 = (cb1 >> 6) * 1024 + ((fr * 64 + (cb1 & 63)) ^ ((fr >> 3) << 5));
            v8i ax[4], bx[4];
#pragma unroll
            for (int m = 0; m < 4; ++m) { const u32x4 c0 = *(const u32x4*)(base + a_off + m * 2048 + q0), c1 = *(const u32x4*)(base + a_off + m * 2048 + q1);
                ax[m] = (v8i){(int)c0.x, (int)c0.y, (int)c0.z, (int)c0.w, (int)c1.x, (int)c1.y, (int)c1.z, (int)c1.w}; }
#pragma unroll
            for (int n = 0; n < 4; ++n) { const u32x4 c0 = *(const u32x4*)(base + b_off + n * 2048 + q0), c1 = *(const u32x4*)(base + b_off + n * 2048 + q1);
                bx[n] = (v8i){(int)c0.x, (int)c0.y, (int)c0.z, (int)c0.w, (int)c1.x, (int)c1.y, (int)c1.z, (int)c1.w}; }
#pragma unroll
            for (int m = 0; m < 4; ++m)
#pragma unroll
                for (int n = 0; n < 4; ++n) acc[m][n] = __builtin_amdgcn_mfma_scale_f32_16x16x128_f8f6f4(bx[n], ax[m], acc[m][n], 0, 0, 0, 0x7F7F7F7F, 0, 0x7F7F7F7F);
        } else {
#pragma unroll
        for (int ks = 0; ks < 2; ++ks) {
            bf16x8 af[4], bf[4];
#pragma unroll
            for (int m = 0; m < 4; ++m) af[m] = *(const bf16x8*)(base + a_off + m * 2048 + (ks ? lo1 : lo0));
#pragma unroll
            for (int n = 0; n < 4; ++n) bf[n] = *(const bf16x8*)(base + b_off + n * 2048 + (ks ? lo1 : lo0));
#pragma unroll
            for (int m = 0; m < 4; ++m)
#pragma unroll
                for (int n = 0; n < 4; ++n) acc[m][n] = __builtin_amdgcn_mfma_f32_16x16x32_bf16(bf[n], af[m], acc[m][n], 0, 0, 0);
        }
        }
    }
    if (SSQ && ssq_steps == nk) {
        __syncthreads();
        const float* rsl = (const float*)(lds + RS_OFF);
#pragma unroll
        for (int m = 0; m < 4; ++m) { const float r = rsl[wr * 64 + m * 16 + fr];
#pragma unroll
            for (int n = 0; n < 4; ++n) acc[m][n] = acc[m][n] * r; }
    }
#undef STAGE
#undef GLDS
}

DEV void phase1(const Ctx& c) {
    const bf16_t* h0 = (const bf16_t*)(c.ws + WS_H0); const bf16_t* WinT = (const bf16_t*)(c.ws + WS_WIN);
    bf16_t* U = (bf16_t*)(c.ws + WS_U); bf16_t* CQ = (bf16_t*)(c.ws + WS_CQ); bf16_t* CKV = (bf16_t*)(c.ws + WS_CKV); bf16_t* KR = (bf16_t*)(c.ws + WS_KR);
    const float* rc = (const float*)(c.ws + WS_ROPE); const float* rs = rc + L * 16;
    const StageGeo g = stage_geo(c.tid);
    const int lane = c.lane, wr = c.wid >> 1, wc = c.wid & 1, fr = lane & 15, fq = lane >> 4;
    constexpr int NT = 14, NU = (T / 128) * NT;
    for (int u = c.vcu; u < NU; u += c.G) {
        const int mt = u / NT, nt = u - mt * NT;
        const bf16_t* A = h0 + (size_t)(mt * 128) * D + g.c; const bf16_t* B = WinT + (size_t)(nt * 128) * D + g.c;
        f32x4 acc[4][4];
        gemm_mainloop<false>(acc, A + (size_t)g.r[0] * D, A + (size_t)g.r[1] * D, A + (size_t)g.r[2] * D, A + (size_t)g.r[3] * D,
                             B + (size_t)g.r[0] * D, B + (size_t)g.r[1] * D, B + (size_t)g.r[2] * D, B + (size_t)g.r[3] * D, 16, c.lds, 0, 0.f, nt == 13);
        const int row0 = mt * 128 + wr * 64 + fr;
        if (nt < 8) {
#pragma unroll
            for (int m = 0; m < 4; ++m) { const size_t row = row0 + m * 16;
#pragma unroll
                for (int i = 0; i < 2; ++i) {
                    f32x4 a = acc[m][2 * i], gt = acc[m][2 * i + 1], o;
#pragma unroll
                    for (int j = 0; j < 4; ++j) o[j] = a[j] * sigmoidf_(gt[j]);
                    st_bf4(U + row * CC + nt * 64 + wc * 32 + i * 16 + fq * 4, o);
                } }
        } else if (nt < 13) {
            const bool isq = nt < 11;
            bf16_t* dstb = isq ? CQ + (nt - 8) * 128 + wc * 64 + fq * 4 : CKV + (nt - 11) * 128 + wc * 64 + fq * 4;
            const int ldd = isq ? QL : KVL;
            float* ssb = isq ? (float*)(c.ws + WS_SSQ_CQ) + (nt - 8) * 2 + wc : (float*)(c.ws + WS_SSQ_CKV) + (nt - 11) * 2 + wc;
            const int lds_ = isq ? 8 : 4;
#pragma unroll
            for (int m = 0; m < 4; ++m) { const size_t row = row0 + m * 16; float sq = 0.f;
#pragma unroll
                for (int n = 0; n < 4; ++n) { st_bf4(dstb + row * ldd + n * 16, acc[m][n]);
                    sq += (acc[m][n][0] * acc[m][n][0] + acc[m][n][1] * acc[m][n][1]) + (acc[m][n][2] * acc[m][n][2] + acc[m][n][3] * acc[m][n][3]); }
                sq += __shfl_xor(sq, 16); sq += __shfl_xor(sq, 32);
                if (fq == 0) ssb[row * lds_] = sq; }
        } else if (wc == 0) {
#pragma unroll
            for (int m = 0; m < 4; ++m) { const int row = row0 + m * 16; const int p = row % L;
                const f32x4 cs = *(const f32x4*)(rc + p * 16 + fq * 4), sn = *(const f32x4*)(rs + p * 16 + fq * 4);
                const f32x4 x1 = acc[m][0], x2 = acc[m][1];
                st_bf4(KR + (size_t)row * 32 + fq * 4, x1 * cs - x2 * sn);
                st_bf4(KR + (size_t)row * 32 + 16 + fq * 4, x1 * sn + x2 * cs); }
        }
    }
}

DEV void conv_unit(const Ctx& c, int b, int j) {
    const bf16_t* U = (const bf16_t*)(c.ws + WS_U);
    bf16_t* MG = (bf16_t*)(c.ws + WS_MG);
    const float* cw = c.in[I_CONVW]; const float* cb = c.in[I_CONVB];
    const int p0 = j * 32;
    float* ytile = (float*)c.lds;
    __syncthreads();
#pragma unroll 1
    for (int pass = 0; pass < 2; ++pass) {
        const int ch = c.tid + 256 * pass;
        float win[62]; unsigned raw[62];
        const bf16_t* ub = U + (size_t)b * L * CC + ch;
#pragma unroll
        for (int rep = 0; rep < CONV_REPA; ++rep) {
        asm volatile("" : "+v"(ub) :: "memory");
#pragma unroll
        for (int i = 0; i < 62; ++i) { const int p = p0 - 30 + i; const int pc = p < 0 ? 0 : (p >= L ? L - 1 : p); raw[i] = ub[(size_t)pc * CC]; }
        if (rep + 1 < CONV_REPA) {
#pragma unroll
            for (int i = 0; i < 62; ++i) asm volatile("" :: "v"(raw[i]));
        }
        }
        float w[31];
#pragma unroll
        for (int k = 0; k < 31; ++k) w[k] = cw[k * CC + ch];
        float bias = cb[ch];
        __builtin_amdgcn_sched_barrier(0);
#pragma unroll
        for (int i = 0; i < 62; ++i) { const int p = p0 - 30 + i; win[i] = (p >= 0 && p < L) ? __uint_as_float(raw[i] << 16) : 0.f; }
#pragma unroll
        for (int rep = 0; rep < CONV_REPB; ++rep) {
        asm volatile("" : "+v"(bias) :: "memory");
#pragma unroll
        for (int tt = 0; tt < 32; ++tt) {
            float a0 = bias;
#pragma unroll
            for (int k = 0; k < 31; ++k) a0 += w[k] * win[tt + k];
            ytile[tt * 512 + ch] = a0;
        }
        }
    }
    __syncthreads();
    const float* g1 = c.in[I_CLN_G]; const float* b1 = c.in[I_CLN_B]; const float* g2 = c.in[I_COUT_G];
    float G1[8], B1[8], G2[8];
    { const f32x4 a = *(const f32x4*)(g1 + c.lane * 8), bq = *(const f32x4*)(g1 + c.lane * 8 + 4); G1[0]=a.x;G1[1]=a.y;G1[2]=a.z;G1[3]=a.w;G1[4]=bq.x;G1[5]=bq.y;G1[6]=bq.z;G1[7]=bq.w; }
    { const f32x4 a = *(const f32x4*)(b1 + c.lane * 8), bq = *(const f32x4*)(b1 + c.lane * 8 + 4); B1[0]=a.x;B1[1]=a.y;B1[2]=a.z;B1[3]=a.w;B1[4]=bq.x;B1[5]=bq.y;B1[6]=bq.z;B1[7]=bq.w; }
    { const f32x4 a = *(const f32x4*)(g2 + c.lane * 8), bq = *(const f32x4*)(g2 + c.lane * 8 + 4); G2[0]=a.x;G2[1]=a.y;G2[2]=a.z;G2[3]=a.w;G2[4]=bq.x;G2[5]=bq.y;G2[6]=bq.z;G2[7]=bq.w; }
#pragma unroll
    for (int rep = 0; rep < CONV_REPC; ++rep) {
    asm volatile("" : "+v"(ytile) :: "memory");
    float v[8][8]; float st[8];
#pragma unroll
    for (int i = 0; i < 8; ++i) { const int tt = c.wid * 8 + i;
        const f32x4 ya = *(const f32x4*)(ytile + tt * 512 + c.lane * 8), yb = *(const f32x4*)(ytile + tt * 512 + c.lane * 8 + 4);
        v[i][0]=ya.x;v[i][1]=ya.y;v[i][2]=ya.z;v[i][3]=ya.w;v[i][4]=yb.x;v[i][5]=yb.y;v[i][6]=yb.z;v[i][7]=yb.w;
        st[i] = ((v[i][0] + v[i][1]) + (v[i][2] + v[i][3])) + ((v[i][4] + v[i][5]) + (v[i][6] + v[i][7])); }
    wave_sum_n<8>(st);
#pragma unroll
    for (int i = 0; i < 8; ++i) { const float mean = st[i] * (1.f / 512.f); float a = 0.f;
#pragma unroll
        for (int q = 0; q < 8; ++q) { v[i][q] -= mean; a += v[i][q] * v[i][q]; }
        st[i] = a; }
    wave_sum_n<8>(st);
#pragma unroll
    for (int i = 0; i < 8; ++i) { const float rstd = rsqrt_(st[i] * (1.f / 512.f) + EPS); float a = 0.f;
#pragma unroll
        for (int q = 0; q < 8; ++q) { const float x = v[i][q] * rstd * G1[q] + B1[q]; const float y = x * sigmoidf_(x); v[i][q] = y; a += y * y; }
        st[i] = a; }
    wave_sum_n<8>(st);
#pragma unroll
    for (int i = 0; i < 8; ++i) {
        const int p = p0 + c.wid * 8 + i;
        {
            const float r2 = rsqrt_(st[i] * (1.f / 512.f) + EPS);
            u32x4 o;
            o.x = cvtpk(v[i][0] * r2 * G2[0], v[i][1] * r2 * G2[1]); o.y = cvtpk(v[i][2] * r2 * G2[2], v[i][3] * r2 * G2[3]);
            o.z = cvtpk(v[i][4] * r2 * G2[4], v[i][5] * r2 * G2[5]); o.w = cvtpk(v[i][6] * r2 * G2[6], v[i][7] * r2 * G2[7]);
            const size_t tok = (size_t)b * SEQ + (p - NMETA);
            bf16_t* dstp = (p >= NMETA && p < L) ? MG + tok * D + 512 + c.lane * 8 : (bf16_t*)(c.ws + WS_DUMMY) + c.lane * 8;
            *(u32x4*)dstp = o;
        }
    }
    }
}
DEV void rope4(f32x4& x1, f32x4& x2, const float* rc, const float* rs, int p, int fq) {
    const f32x4 cs = *(const f32x4*)(rc + p * 16 + fq * 4), sn = *(const f32x4*)(rs + p * 16 + fq * 4);
    const f32x4 a = x1 * cs - x2 * sn, bb = x1 * sn + x2 * cs; x1 = a; x2 = bb;
}
template <int SEL> DEV void phase2_t(const Ctx& c) {
    const bf16_t* CQ = (const bf16_t*)(c.ws + WS_CQ); const bf16_t* CKV = (const bf16_t*)(c.ws + WS_CKV);
    const bf16_t* WuqT = (const bf16_t*)(c.ws + WS_WUQ); const bf16_t* WukvT = (const bf16_t*)(c.ws + WS_WUKV);
    bf16_t* Q = (bf16_t*)(c.ws + WS_Q); bf16_t* KV = (bf16_t*)(c.ws + WS_KV);
    const float* rc = (const float*)(c.ws + WS_ROPE); const float* rs = rc + L * 16;
    const StageGeo g = stage_geo(c.tid);
    const int lane = c.lane, wr = c.wid >> 1, wc = c.wid & 1, fr = lane & 15, fq = lane >> 4;
    constexpr int MT = T / 128, NUQ = MT * 6, NUKV = MT * 8, NUC = NB * 65, NU = NUQ + NUKV + NUC;
    const int li = c.vcu & 63, rev = ((li >> 5) ^ li) & 1;
    const int nmine = (NU - c.vcu + c.G - 1) / c.G;
    for (int it = 0; it < nmine; ++it) {
        const int u = c.vcu + (rev ? (nmine - 1 - it) : it) * c.G;
        if (SEL == 1 && u >= NUKV + NUQ) continue;
        if (SEL == 2 && u < NUKV + NUQ) continue;
        if (u < NUKV) {
            const int mt = u >> 3, nt = u & 7;
            const bf16_t* A = CKV + (size_t)(mt * 128) * KVL + g.c; const bf16_t* B = WukvT + (size_t)(nt * 128) * KVL + g.c;
            f32x4 acc[4][4];
            __syncthreads();
            if (c.tid < 128) { const f32x4 p4 = *(const f32x4*)((const float*)(c.ws + WS_SSQ_CKV) + (size_t)(mt * 128 + c.tid) * 4);
                ((float*)(c.lds + RS_OFF))[c.tid] = rsqrt_(((p4.x + p4.y) + (p4.z + p4.w)) * (1.f / 256.f) + EPS); }
            gemm_mainloop<true>(acc, A + (size_t)g.r[0] * KVL, A + (size_t)g.r[1] * KVL, A + (size_t)g.r[2] * KVL, A + (size_t)g.r[3] * KVL,
                                B + (size_t)g.r[0] * KVL, B + (size_t)g.r[1] * KVL, B + (size_t)g.r[2] * KVL, B + (size_t)g.r[3] * KVL, 4, c.lds, 4, 1.f / 256.f);
            const int row0 = mt * 128 + wr * 64 + fr;
#pragma unroll
            for (int m = 0; m < 4; ++m) { const size_t row = row0 + m * 16;
#pragma unroll
                for (int n = 0; n < 4; ++n) st_bf4(KV + row * NKV + nt * 128 + wc * 64 + n * 16 + fq * 4, acc[m][n]); }
        } else if (u < NUKV + NUQ) {
            const int v = u - NUKV, mt = v / 6, nt = v - mt * 6;
            const bf16_t* A = CQ + (size_t)(mt * 128) * QL + g.c; const bf16_t* B = WuqT + (size_t)(nt * 128) * QL + g.c;
            f32x4 acc[4][4];
            __syncthreads();
            if (c.tid < 128) { const float* pp = (const float*)(c.ws + WS_SSQ_CQ) + (size_t)(mt * 128 + c.tid) * 8; const f32x4 p4 = *(const f32x4*)pp; const float2 p2 = *(const float2*)(pp + 4);
                ((float*)(c.lds + RS_OFF))[c.tid] = rsqrt_((((p4.x + p4.y) + (p4.z + p4.w)) + (p2.x + p2.y)) * (1.f / 384.f) + EPS); }
            gemm_mainloop<true>(acc, A + (size_t)g.r[0] * QL, A + (size_t)g.r[1] * QL, A + (size_t)g.r[2] * QL, A + (size_t)g.r[3] * QL,
                                B + (size_t)g.r[0] * QL, B + (size_t)g.r[1] * QL, B + (size_t)g.r[2] * QL, B + (size_t)g.r[3] * QL, 6, c.lds, 6, 1.f / 384.f);
            const int row0 = mt * 128 + wr * 64 + fr;
            const int t16 = (nt * 8 + wc * 4) % 6;
#pragma unroll
            for (int m = 0; m < 4; ++m) { const int row = row0 + m * 16; const int p = row % L;
#pragma unroll
                for (int n = 0; n < 4; ++n) acc[m][n] = acc[m][n] * QSCALE;
                if (t16 == 4) rope4(acc[m][0], acc[m][1], rc, rs, p, fq);
                if (t16 == 2) rope4(acc[m][2], acc[m][3], rc, rs, p, fq);
#pragma unroll
                for (int n = 0; n < 4; ++n) st_bf4(Q + (size_t)row * NQ + nt * 128 + wc * 64 + n * 16 + fq * 4, acc[m][n]); }
        } else {
            const int v = u - NUKV - NUQ; conv_unit(c, v / 65, v % 65);
        }
    }
}

DEV void phase2(const Ctx& c) { phase2_t<0>(c); }
DEV void phase2g(const Ctx& c) { phase2_t<1>(c); }
DEV void phase2c(const Ctx& c) { phase2_t<2>(c); }
DEV int crow(int r, int hi) { return (r & 3) + 8 * (r >> 2) + 4 * hi; }
#define KSWZ(row, colB) ((row) * 256 + ((colB) ^ (((row) & 7) << 4)))
#define SBAR() __builtin_amdgcn_sched_barrier(0)
DEV int v_st(int k, int cc) { const int kk = (k & ~0xC) | ((k & 4) << 1) | ((k & 8) >> 1); return ((kk >> 3) * 4 + (cc >> 5)) * 512 + ((kk & 7) * 32 + (cc & 31)) * 2; }
DEV int v_rd_base(int lane) { return ((lane & 3) << 3) | (((lane >> 2) & 3) << 6) | (((lane >> 4) & 1) << 5) | (((lane >> 5) & 1) << 8); }
constexpr int v_rd_off(int d0, int ks, int half) { return d0 * 512 + ks * 4096 + half * 2048; }
template <int OFF> DEV s16x4 tr_read(int vb) { s16x4 r; asm volatile("ds_read_b64_tr_b16 %0, %1 offset:%2" : "=&v"(r) : "v"(vb), "i"(OFF) : "memory"); return r; }
template <int D0> DEV void pv_one(f32x16& od, int vb, bf16x8 pa0, bf16x8 pa1, bf16x8 pa2, bf16x8 pa3) {
    const s16x4 l0 = tr_read<v_rd_off(D0, 0, 0)>(vb), h0 = tr_read<v_rd_off(D0, 0, 1)>(vb), l1 = tr_read<v_rd_off(D0, 1, 0)>(vb), h1 = tr_read<v_rd_off(D0, 1, 1)>(vb);
    const s16x4 l2 = tr_read<v_rd_off(D0, 2, 0)>(vb), h2 = tr_read<v_rd_off(D0, 2, 1)>(vb), l3 = tr_read<v_rd_off(D0, 3, 0)>(vb), h3 = tr_read<v_rd_off(D0, 3, 1)>(vb);
    asm volatile("s_waitcnt lgkmcnt(0)" ::: "memory"); SBAR();
#define PK(Lo, Hi) (bf16x8){Lo[0], Lo[1], Lo[2], Lo[3], Hi[0], Hi[1], Hi[2], Hi[3]}
    od = __builtin_amdgcn_mfma_f32_32x32x16_bf16(pa0, PK(l0, h0), od, 0, 0, 0);
    od = __builtin_amdgcn_mfma_f32_32x32x16_bf16(pa1, PK(l1, h1), od, 0, 0, 0);
    od = __builtin_amdgcn_mfma_f32_32x32x16_bf16(pa2, PK(l2, h2), od, 0, 0, 0);
    od = __builtin_amdgcn_mfma_f32_32x32x16_bf16(pa3, PK(l3, h3), od, 0, 0, 0);
#undef PK
}
constexpr float ATT_THR = 8.f;
constexpr int AT_V = 0, AT_K = 32768, AT_WS = 65536;
DEV void attn_unit(const Ctx& c, int b, int h, int qb) {
    const bf16_t* Q = (const bf16_t*)(c.ws + WS_Q); const bf16_t* KV = (const bf16_t*)(c.ws + WS_KV); const bf16_t* KR = (const bf16_t*)(c.ws + WS_KR);
    bf16_t* MG = (bf16_t*)(c.ws + WS_MG);
    unsigned char* lds = c.lds;
    const int tid = c.tid, wid = c.wid, lane = c.lane, r32 = lane & 31, hi = lane >> 5;
    float* wsf = (float*)(lds + AT_WS) + wid * 64; float* li_l = wsf; float* al_l = wsf + 32;
    const int NT = 2 * qb + 3;
    const int my_last = 2 * qb + (wid >> 1) + 1;
    bf16x8 qr[6];
    { const size_t t = (size_t)b * L + NMETA + qb * 128 + wid * 32 + r32;
      const bf16_t* Qw = Q + t * NQ + h * DQK + hi * 8;
#pragma unroll
      for (int d0 = 0; d0 < 6; ++d0) qr[d0] = *(const bf16x8*)(Qw + d0 * 16); }
    const int srow = tid >> 2, sq = tid & 3;
    const int vst0 = v_st(srow, sq * 16), vst1 = v_st(srow, sq * 16 + 8);
    const int kst0 = KSWZ(srow, sq * 32), kst1 = KSWZ(srow, sq * 32 + 16), kst2 = KSWZ(srow, 128 + sq * 16);
    const int vb0 = (int)(uintptr_t)(lds + AT_V) + v_rd_base(lane);
    u32x4 sk0, sk1, sk2, sv0, sv1;
#define SLOAD(j) do { int pos = (j) * 64 + srow - 48; pos = pos < 0 ? 0 : pos; const size_t tk = (size_t)b * L + pos; \
        const bf16_t* kvp = KV + tk * NKV + h * 128 + sq * 16; \
        sk0 = *(const u32x4*)(kvp); sk1 = *(const u32x4*)(kvp + 8); sv0 = *(const u32x4*)(kvp + 64); sv1 = *(const u32x4*)(kvp + 72); \
        sk2 = *(const u32x4*)(KR + tk * 32 + sq * 8); } while (0)
#define SWRITE(bb) do { unsigned char* kb = lds + AT_K + (bb) * 16384; unsigned char* vbp = lds + AT_V + (bb) * 16384; \
        *(u32x4*)(kb + kst0) = sk0; *(u32x4*)(kb + kst1) = sk1; *(u32x4*)(kb + kst2) = sk2; *(u32x4*)(vbp + vst0) = sv0; *(u32x4*)(vbp + vst1) = sv1; } while (0)
    float m_reg = 0.f, l_reg = 0.f; f32x16 o[2] = {};
    __syncthreads();
    SLOAD(0); SWRITE(0); __syncthreads();
    for (int j = 0; j < NT; ++j) {
        const int bsel = j & 1;
        if (j + 1 < NT) SLOAD(j + 1);
        if (j <= my_last) {
            const unsigned char* Ks = lds + AT_K + bsel * 16384;
            f32x16 p0, p1;
            { const float nm = -m_reg;
#pragma unroll
              for (int r = 0; r < 16; ++r) { p0[r] = nm; p1[r] = nm; } }
#pragma unroll
            for (int d0 = 0; d0 < 6; ++d0) { const int cb = (d0 * 16 + hi * 8) * 2;
                const bf16x8 k0 = *(const bf16x8*)(Ks + KSWZ(r32, cb)); const bf16x8 k1 = *(const bf16x8*)(Ks + KSWZ(32 + r32, cb));
                p0 = __builtin_amdgcn_mfma_f32_32x32x16_bf16(k0, qr[d0], p0, 0, 0, 0);
                p1 = __builtin_amdgcn_mfma_f32_32x32x16_bf16(k1, qr[d0], p1, 0, 0, 0); }
            if (j == 0) {
#pragma unroll
                for (int r = 0; r < 16; ++r) p0[r] = -1e30f;
#pragma unroll
                for (int r = 0; r < 8; ++r) p1[r] = -1e30f;
            }
            float pmax = fmaxf(fmaxf(p0[0], p0[1]), p0[2]);
#pragma unroll
            for (int r = 3; r < 15; r += 2) pmax = fmaxf(fmaxf(pmax, p0[r]), p0[r + 1]);
            pmax = fmaxf(fmaxf(pmax, p0[15]), p1[0]);
#pragma unroll
            for (int r = 1; r < 15; r += 2) pmax = fmaxf(fmaxf(pmax, p1[r]), p1[r + 1]);
            pmax = fmaxf(pmax, p1[15]);
            { auto rr = __builtin_amdgcn_permlane32_swap(__float_as_uint(pmax), __float_as_uint(pmax), false, false);
              pmax = fmaxf(__uint_as_float(rr[0]), __uint_as_float(rr[1])); }
            float ps = 0.f;
            if (__any(pmax > ATT_THR)) {
                const float dm = fmaxf(pmax, 0.f), alpha = fast_exp2(-dm); m_reg += dm;
#pragma unroll
                for (int r = 0; r < 16; ++r) { p0[r] -= dm; p1[r] -= dm; }
                l_reg *= alpha;
                if (hi == 0) al_l[r32] = alpha;
                asm volatile("s_waitcnt lgkmcnt(0)" ::: "memory");
#pragma unroll
                for (int r = 0; r < 16; ++r) { const float a = al_l[crow(r, hi)]; o[0][r] *= a; o[1][r] *= a; }
            }
#pragma unroll
            for (int r = 0; r < 16; ++r) { p0[r] = fast_exp2(p0[r]); ps += p0[r]; }
#pragma unroll
            for (int r = 0; r < 16; ++r) { p1[r] = fast_exp2(p1[r]); ps += p1[r]; }
            { auto rr = __builtin_amdgcn_permlane32_swap(__float_as_uint(ps), __float_as_uint(ps), false, false);
              ps = __uint_as_float(rr[0]) + __uint_as_float(rr[1]); }
            l_reg += ps;
            bf16x8 pa0, pa1, pa2, pa3;
#define PK4(P, BASE, OUT) do { unsigned a0 = cvtpk(P[BASE + 0], P[BASE + 1]), a1 = cvtpk(P[BASE + 2], P[BASE + 3]);   \
    unsigned b0 = cvtpk(P[BASE + 4], P[BASE + 5]), b1 = cvtpk(P[BASE + 6], P[BASE + 7]);                              \
    auto r0 = __builtin_amdgcn_permlane32_swap(a0, b0, false, false); auto r1 = __builtin_amdgcn_permlane32_swap(a1, b1, false, false); \
    u32x4 w = {r0[0], r1[0], r0[1], r1[1]}; OUT = *reinterpret_cast<bf16x8*>(&w); } while (0)
            PK4(p0, 0, pa0); PK4(p0, 8, pa1); PK4(p1, 0, pa2); PK4(p1, 8, pa3);
#undef PK4
            const int vb = vb0 + bsel * 16384;
            pv_one<0>(o[0], vb, pa0, pa1, pa2, pa3); pv_one<1>(o[1], vb, pa0, pa1, pa2, pa3);
        }
        if (j + 1 < NT) { if (bsel) SWRITE(0); else SWRITE(1); }
        __syncthreads();
    }
    if (hi == 0) li_l[r32] = l_reg;
    asm volatile("s_waitcnt lgkmcnt(0)" ::: "memory");
    const size_t tok0 = (size_t)b * SEQ + qb * 128 + wid * 32;
    float* SSO = (float*)(c.ws + WS_SSQ_O);
#pragma unroll
    for (int r = 0; r < 16; ++r) {
        const int orow = crow(r, hi); const float rl = fast_rcp(li_l[orow]);
        bf16_t* dst = MG + (tok0 + orow) * D + h * DV + r32;
        const float a0 = o[0][r] * rl, a1 = o[1][r] * rl;
        dst[0]  = (bf16_t)(cvtpk(a0, 0.f) & 0xffffu);
        dst[32] = (bf16_t)(cvtpk(a1, 0.f) & 0xffffu);
        float sq = a0 * a0 + a1 * a1;
        sq += dpp_mov<0xB1>(sq); sq += dpp_mov<0x4E>(sq); sq += dpp_mov<0x141>(sq); sq += dpp_mov<0x140>(sq);
        sq += __shfl_xor(sq, 16);
        if (r32 == 0) SSO[(tok0 + orow) * 8 + h] = sq;
    }
#undef SLOAD
#undef SWRITE
}
DEV void phase3(const Ctx& c) {
    const int nslots = NB * NH * 4;
    float* scr = (float*)(c.lds + c.wid * 8448);
    const int gw = c.vcu * 4 + c.wid, NGW = c.G * 4;
    constexpr int NWI = 6144;
    int wi = gw;
#define EW_ITEMS(n) do { __syncthreads(); for (int _q = 0; _q < (n) && wi < NWI; ++_q, wi += NGW) expert_weight_item(c, wi, scr); } while (0)
    for (int v = c.vcu; v < nslots; v += c.G) {
        const int bh = v >> 2, s = v & 3, b = bh >> 3, h = bh & 7;
        attn_unit(c, b, h, 15 - s); EW_ITEMS(1); attn_unit(c, b, h, s); EW_ITEMS(1); attn_unit(c, b, h, 11 - s); EW_ITEMS(1); attn_unit(c, b, h, 4 + s);
    }
    __syncthreads();
    for (; wi < NWI; wi += NGW) expert_weight_item(c, wi, scr);
#undef EW_ITEMS
}

DEV void phase4(const Ctx& c) {
    const bf16_t* MG = (const bf16_t*)(c.ws + WS_MG); const bf16_t* WoT = (const bf16_t*)(c.ws + WS_WO); const bf16_t* h0 = (const bf16_t*)(c.ws + WS_H0);
    bf16_t* R1 = (bf16_t*)(c.ws + WS_R1);
    const StageGeo g = stage_geo(c.tid);
    const int lane = c.lane, wr = c.wid >> 1, wc = c.wid & 1, fr = lane & 15, fq = lane >> 4;
    constexpr int NU = (TR / 128) * 8;
    for (int u = c.vcu; u < NU; u += c.G) {
        const int mt = u >> 3, nt = u & 7;
        const bf16_t* A = MG + (size_t)(mt * 128) * D + g.c; const bf16_t* B = WoT + (size_t)(nt * 128) * D + g.c;
        f32x4 acc[4][4];
        __syncthreads();
        if (c.tid < 128) { const float* pp = (const float*)(c.ws + WS_SSQ_O) + (size_t)(mt * 128 + c.tid) * 8; const f32x4 pa = *(const f32x4*)pp, pb = *(const f32x4*)(pp + 4);
            ((float*)(c.lds + RS_OFF))[c.tid] = rsqrt_((((pa.x + pa.y) + (pa.z + pa.w)) + ((pb.x + pb.y) + (pb.z + pb.w))) * (1.f / 512.f) + EPS); }
        gemm_mainloop<true>(acc, A + (size_t)g.r[0] * D, A + (size_t)g.r[1] * D, A + (size_t)g.r[2] * D, A + (size_t)g.r[3] * D,
                            B + (size_t)g.r[0] * D, B + (size_t)g.r[1] * D, B + (size_t)g.r[2] * D, B + (size_t)g.r[3] * D, 16, c.lds, 8, 1.f / 512.f);
#pragma unroll
        for (int m = 0; m < 4; ++m) {
            const int tok = mt * 128 + wr * 64 + m * 16 + fr;
            const size_t t = (size_t)(tok >> 11) * L + NMETA + (tok & 2047);
#pragma unroll
            for (int n = 0; n < 4; ++n) {
                const int col = nt * 128 + wc * 64 + n * 16 + fq * 4;
                const u32x2 hw = *(const u32x2*)(h0 + t * D + col);
                f32x4 o; o[0] = ALPHA * bflo(hw.x) + acc[m][n][0]; o[1] = ALPHA * bfhi(hw.x) + acc[m][n][1];
                o[2] = ALPHA * bflo(hw.y) + acc[m][n][2]; o[3] = ALPHA * bfhi(hw.y) + acc[m][n][3];
                st_bf4(R1 + (size_t)tok * D + col, o);
            }
        }
    }
}

constexpr int P5_ROWB = 2064, P5_PART = 33280, P5_LG = 45568, P5_BIAS = 48128, P5_AGG = 48384;
DEV void phase5(const Ctx& c, int ALT = 0) {
    const bf16_t* R1 = (const bf16_t*)(c.ws + WS_R1); bf16_t* H1 = (bf16_t*)(c.ws + WS_H0);
    const bf16_t* WrT = (const bf16_t*)(c.ws + WS_WR);
    unsigned* cnt = (unsigned*)(c.ws + WS_CTL) + CW_CNT + ALT * 32; unsigned* list = (unsigned*)(c.ws + (ALT ? 404 * MiB : WS_LIST)); float* combw = (float*)(c.ws + WS_COMBW);
    const int lane = c.lane, wid = c.wid, fr = lane & 15, fq = lane >> 4;
    float* part = (float*)(c.lds + P5_PART); float* lgs = (float*)(c.lds + P5_LG); float* biasl = (float*)(c.lds + P5_BIAS);
    __syncthreads();
    if (c.tid < 36) biasl[c.tid] = (c.tid < 4) ? c.in[I_BRG][c.tid] : c.in[I_BRE][c.tid - 4];
    bf16x8 wf[8][3];
#pragma unroll
    for (int ks = 0; ks < 8; ++ks)
#pragma unroll
        for (int n = 0; n < 3; ++n) wf[ks][n] = *(const bf16x8*)(WrT + (size_t)(n * 16 + fr) * D + wid * 256 + ks * 32 + fq * 8);
    unsigned* lcnt = (unsigned*)(c.lds + P5_AGG); unsigned* lbase = lcnt + 32; unsigned* ent = lcnt + 64;
    if (c.tid < 32) lcnt[c.tid] = 0u;
    int nent = 0;
    for (int u = c.vcu; u < TR / 16; u += c.G) {
        const int tok0 = u * 16;
        { const float* src[4]; bf16_t* dst[4]; unsigned char* ldsn[4]; unsigned char* f8n[4];
#pragma unroll
          for (int i = 0; i < 4; ++i) { const int tl = wid * 4 + i; const size_t tok = tok0 + tl; src[i] = (const float*)(R1 + tok * D); dst[i] = H1 + tok * D; ldsn[i] = c.lds + tl * P5_ROWB; f8n[i] = c.ws + WS_H1F8 + tok * D; }
          ln_rows_bf16<4, true, true>(src, c.in[I_LN1G], c.in[I_LN1B], dst, ldsn, lane, f8n); }
        __syncthreads();
        f32x4 acc[3] = {};
#pragma unroll
        for (int ks = 0; ks < 8; ++ks) {
            const int k = wid * 256 + ks * 32 + fq * 8;
            const bf16x8 a = *(const bf16x8*)(c.lds + fr * P5_ROWB + k * 2);
#pragma unroll
            for (int n = 0; n < 3; ++n) acc[n] = __builtin_amdgcn_mfma_f32_16x16x32_bf16(wf[ks][n], a, acc[n], 0, 0, 0);
        }
#pragma unroll
        for (int n = 0; n < 3; ++n) *(f32x4*)(part + (wid * 16 + fr) * 48 + n * 16 + fq * 4) = acc[n];
        __syncthreads();
#pragma unroll
        for (int i = 0; i < 3; ++i) { const int idx = c.tid + 256 * i;
            if (idx < 576) { const int tk = idx / 36, l = idx - tk * 36;
                lgs[tk * 40 + l] = ((part[tk * 48 + l] + part[(16 + tk) * 48 + l]) + (part[(32 + tk) * 48 + l] + part[(48 + tk) * 48 + l])) + biasl[l]; } }
        __syncthreads();
        if (c.tid < 16) {
            const float* lg = lgs + c.tid * 40;
            int gi = 0; float gm = lg[0];
#pragma unroll
            for (int i = 1; i < 4; ++i) { const float v = lg[i]; if (v > gm) { gm = v; gi = i; } }
            float gs = 0.f;
#pragma unroll
            for (int i = 0; i < 4; ++i) gs += __expf(lg[i] - gm);
            const float gw = 1.f / gs;
            const float* le = lg + 4 + gi * 8;
            float v0 = le[0], v1 = -3.0e38f; int i0 = 0, i1 = 0;
#pragma unroll
            for (int i = 1; i < 8; ++i) { const float v = le[i];
                if (v > v0) { v1 = v0; i1 = i0; v0 = v; i0 = i; } else if (v > v1) { v1 = v; i1 = i; } }
            const float ex = __expf(v1 - v0), inv = 1.f / (1.f + ex);
            const int tok = tok0 + c.tid; const unsigned e0 = gi * 8 + i0, e1 = gi * 8 + i1;
            combw[tok * 2] = gw * inv; combw[tok * 2 + 1] = gw * ex * inv;
            const unsigned r0 = atomicAdd(&lcnt[e0], 1u), r1 = atomicAdd(&lcnt[e1], 1u);
            const int ei = nent * 32 + c.tid * 2;
            ent[2 * ei] = (unsigned)(tok * 2);         ent[2 * ei + 1] = (e0 << 16) | r0;
            ent[2 * ei + 2] = (unsigned)(tok * 2 + 1); ent[2 * ei + 3] = (e1 << 16) | r1;
        }
        ++nent;
    }
    __syncthreads();
    if (c.tid < 32) { const unsigned n = lcnt[c.tid]; lbase[c.tid] = n ? atomicAdd(&cnt[c.tid * CNT_STRIDE], n) : 0u; }
    __syncthreads();
    for (int i = c.tid; i < nent * 32; i += 256) { const unsigned t2 = ent[2 * i], er = ent[2 * i + 1]; const unsigned e = er >> 16;
        list[(size_t)e * TR + lbase[e] + (er & 0xffffu)] = t2; }
}
DEV void bar20(const Ctx& c) {}
DEV void moe_tiles(const Ctx& c) {
    const unsigned* cnt = (const unsigned*)(c.ws + WS_CTL) + CW_CNT; int* ts = (int*)(c.lds + EXP_OFF);
    __syncthreads();
    if (c.tid < NE) ts[40 + c.tid] = (int)__hip_atomic_load(&cnt[c.tid * CNT_STRIDE], __ATOMIC_RELAXED, __HIP_MEMORY_SCOPE_AGENT);
    __syncthreads();
    if (c.tid == 0) { int s = 0; for (int e = 0; e < NE; ++e) { ts[e] = s; s += (ts[40 + e] + 127) >> 7; } ts[NE] = s; }
    __syncthreads();
}
DEV void phase6a(const Ctx& c) {
    const bf16_t* H18 = (const bf16_t*)(c.ws + WS_H1F8); const bf16_t* Wgu8 = (const bf16_t*)(c.ws + WS_WGU); unsigned char* ACT8 = c.ws + WS_ACT;
    const unsigned* list = (const unsigned*)(c.ws + WS_LIST);
    moe_tiles(c);
    const int* ts = (const int*)(c.lds + EXP_OFF); unsigned* tbl = (unsigned*)(c.lds + TBL_OFF);
    const StageGeo g = stage_geo(c.tid);
    const int lane = c.lane, wr = c.wid >> 1, wc = c.wid & 1, fr = lane & 15, fq = lane >> 4;
    const int NU = ts[NE] * 4;
    u32x2* RI = (u32x2*)(c.ws + WS_RI); const float* combw = (const float*)(c.ws + WS_COMBW);
    int e = 0, en_e = 0; unsigned en_cur = 0xffffffffu;
    { const int u0 = c.vcu; if (u0 < NU) { const int rt0 = u0 >> 2; while (ts[en_e + 1] <= rt0) ++en_e;
        if (c.tid < 128) { const int j = (rt0 - ts[en_e]) * 128 + c.tid; en_cur = (j < ts[40 + en_e]) ? list[(size_t)en_e * TR + j] : 0xffffffffu; } } }
    for (int u = c.vcu; u < NU; u += c.G) {
        const int rt = u >> 2, nt = u & 3;
        e = en_e;
        __syncthreads();
        float wri = 0.f;
        if (c.tid < 128) { tbl[c.tid] = en_cur; if (nt == 0 && en_cur != 0xffffffffu) wri = combw[en_cur]; }
        const unsigned en_this = en_cur;
        { const int un = u + c.G; if (un < NU) { const int rtn = un >> 2; while (ts[en_e + 1] <= rtn) ++en_e;
            if (c.tid < 128) { const int j = (rtn - ts[en_e]) * 128 + c.tid; en_cur = (j < ts[40 + en_e]) ? list[(size_t)en_e * TR + j] : 0xffffffffu; } } }
        __syncthreads();
        size_t ro[4];
#pragma unroll
        for (int i = 0; i < 4; ++i) { const unsigned en = tbl[g.r[i]]; ro[i] = (en == 0xffffffffu) ? 0 : (size_t)(en >> 1) * (D / 2); }
        const bf16_t* A = H18 + g.c; const bf16_t* B = Wgu8 + ((size_t)e * 512 + nt * 128) * (D / 2) + g.c;
        f32x4 acc[4][4];
        gemm_mainloop<false, true>(acc, A + ro[0], A + ro[1], A + ro[2], A + ro[3],
                             B + (size_t)g.r[0] * (D / 2), B + (size_t)g.r[1] * (D / 2), B + (size_t)g.r[2] * (D / 2), B + (size_t)g.r[3] * (D / 2), 8, c.lds, 0, 0.f);
#pragma unroll
        for (int m = 0; m < 4; ++m) { const size_t row = (size_t)rt * 128 + wr * 64 + m * 16 + fr;
#pragma unroll
            for (int i = 0; i < 2; ++i) {
                const f32x4 gt = acc[m][2 * i], up = acc[m][2 * i + 1]; f32x4 o;
#pragma unroll
                for (int j = 0; j < 4; ++j) { const float gv = gt[j] * WUNSCALE; o[j] = gv * sigmoidf_(gv) * (up[j] * WUNSCALE); }
                *(unsigned*)(ACT8 + row * DE + nt * 64 + wc * 32 + i * 16 + fq * 4) = pk_fp8x4(o[0], o[1], o[2], o[3]);
            } }
        if (nt == 0 && c.tid < 128) { u32x2 ri; ri.x = en_this; ri.y = __float_as_uint(wri); RI[(size_t)rt * 128 + c.tid] = ri; }
    }
}
DEV void phase6b(const Ctx& c) {
    const bf16_t* ACT8 = (const bf16_t*)(c.ws + WS_ACT); const bf16_t* Wd8 = (const bf16_t*)(c.ws + WS_WD); unsigned char* Y8 = c.ws + WS_Y;
    const u32x2* RI = (const u32x2*)(c.ws + WS_RI);
    moe_tiles(c);
    const int* ts = (const int*)(c.lds + EXP_OFF); u32x2* tbl = (u32x2*)(c.lds + TBL_OFF);
    const StageGeo g = stage_geo(c.tid);
    unsigned char* lds = c.lds;
    const int tid = c.tid, lane = c.lane, wr = c.wid >> 1, wc = c.wid & 1, fr = lane & 15, fq = lane >> 4;
    const int cb0 = fq * 32, cb1 = fq * 32 + 16;
    const int q0 = (cb0 >> 6) * 1024 + ((fr * 64 + (cb0 & 63)) ^ ((fr >> 3) << 5)), q1 = (cb1 >> 6) * 1024 + ((fr * 64 + (cb1 & 63)) ^ ((fr >> 3) << 5));
    const int a_off = wr * 8192, b_off = wc * 8192, dst = tid * 16;
    const int NU = ts[NE] * 2;
    int e = 0;
#define GLDS(src, off) __builtin_amdgcn_global_load_lds((const unsigned*)(src), (unsigned LAS*)(lds + (off)), 16, 0, 0)
    for (int u = c.vcu; u < NU; u += c.G) {
        const int rt = u >> 1, nh = u & 1;
        while (ts[e + 1] <= rt) ++e;
        __syncthreads();
        if (tid < 128) tbl[tid] = RI[(size_t)rt * 128 + tid];
        const bf16_t* A = ACT8 + (size_t)(rt * 128) * (DE / 2) + g.c;
        const bf16_t* B = Wd8 + ((size_t)e * 1024 + nh * 512) * (DE / 2) + g.c;
#pragma unroll
        for (int kt = 0; kt < 2; ++kt)
#pragma unroll
            for (int i = 0; i < 4; ++i) GLDS(A + (size_t)g.r[i] * (DE / 2) + kt * 64, kt * 16384 + dst + i * 4096);
#define BSTAGE(s_, buf) do { const bf16_t* _b = B + (size_t)((s_) >> 1) * 128 * (DE / 2) + ((s_) & 1) * 64; \
        GLDS(_b + (size_t)g.r[0] * (DE / 2), 32768 + (buf) * 16384 + dst);        GLDS(_b + (size_t)g.r[1] * (DE / 2), 32768 + (buf) * 16384 + dst + 4096); \
        GLDS(_b + (size_t)g.r[2] * (DE / 2), 32768 + (buf) * 16384 + dst + 8192); GLDS(_b + (size_t)g.r[3] * (DE / 2), 32768 + (buf) * 16384 + dst + 12288); } while (0)
        BSTAGE(0, 0);
        f32x4 acc[4][4];
#pragma unroll
        for (int m = 0; m < 4; ++m)
#pragma unroll
            for (int n = 0; n < 4; ++n) acc[m][n] = (f32x4){0.f, 0.f, 0.f, 0.f};
#pragma unroll 1
        for (int s_ = 0; s_ < 8; ++s_) {
            VM_WAIT();
            __syncthreads();
            const int bsel = s_ & 1;
            if (s_ + 1 < 8) { if (bsel) BSTAGE(s_ + 1, 0); else BSTAGE(s_ + 1, 1); }
            const unsigned char* ab = lds + bsel * 16384 + a_off; const unsigned char* bb = lds + 32768 + bsel * 16384 + b_off;
            v8i ax[4], bx[4];
#pragma unroll
            for (int m = 0; m < 4; ++m) { const u32x4 c0 = *(const u32x4*)(ab + m * 2048 + q0), c1 = *(const u32x4*)(ab + m * 2048 + q1);
                ax[m] = (v8i){(int)c0.x, (int)c0.y, (int)c0.z, (int)c0.w, (int)c1.x, (int)c1.y, (int)c1.z, (int)c1.w}; }
#pragma unroll
            for (int n = 0; n < 4; ++n) { const u32x4 c0 = *(const u32x4*)(bb + n * 2048 + q0), c1 = *(const u32x4*)(bb + n * 2048 + q1);
                bx[n] = (v8i){(int)c0.x, (int)c0.y, (int)c0.z, (int)c0.w, (int)c1.x, (int)c1.y, (int)c1.z, (int)c1.w}; }
#pragma unroll
            for (int m = 0; m < 4; ++m)
#pragma unroll
                for (int n = 0; n < 4; ++n) acc[m][n] = __builtin_amdgcn_mfma_scale_f32_16x16x128_f8f6f4(bx[n], ax[m], acc[m][n], 0, 0, 0, 0x7F7F7F7F, 0, 0x7F7F7F7F);
            if (bsel) {
                const int nt = nh * 4 + (s_ >> 1);
#pragma unroll
                for (int m = 0; m < 4; ++m) {
                    const u32x2 ri = tbl[wr * 64 + m * 16 + fr]; const unsigned en = ri.x;
                    if (en != 0xffffffffu) {
                        const float w = __uint_as_float(ri.y) * (WUNSCALE * YSCALE); unsigned char* dstp = Y8 + ((size_t)(en & 1u) * TR + (en >> 1)) * D + nt * 128 + wc * 64 + fq * 4;
#pragma unroll
                        for (int n = 0; n < 4; ++n) { const f32x4 o = acc[m][n] * w; *(unsigned*)(dstp + n * 16) = pk_fp8x4(o[0], o[1], o[2], o[3]); }
                    }
#pragma unroll
                    for (int n = 0; n < 4; ++n) acc[m][n] = (f32x4){0.f, 0.f, 0.f, 0.f};
                }
            }
        }
#undef BSTAGE
    }
#undef GLDS
}

DEV void phase7(const Ctx& c) {
    const bf16_t* H1 = (const bf16_t*)(c.ws + WS_H0); const unsigned char* Y8 = c.ws + WS_Y;
    const float* g = c.in[I_LN2G]; const float* bt = c.in[I_LN2B];
    const int gw = c.vcu * 4 + c.wid, NGW = c.G * 4, lane = c.lane;
    for (int tok0 = gw; tok0 < TR; tok0 += 2 * NGW) {
        float v[2][16]; float st[2]; int tk[2];
#pragma unroll
        for (int r = 0; r < 2; ++r) {
            int tok = tok0 + r * NGW; if (tok >= TR) tok = tok0; tk[r] = tok;
#pragma unroll
            for (int i = 0; i < 2; ++i) {
                const u32x4 hw = *(const u32x4*)(H1 + (size_t)tok * D + i * 512 + lane * 8);
                const u32x2 y0 = *(const u32x2*)(Y8 + (size_t)tok * D + i * 512 + lane * 8);
                const u32x2 y1 = *(const u32x2*)(Y8 + ((size_t)TR + tok) * D + i * 512 + lane * 8);
#pragma unroll
                for (int q2 = 0; q2 < 2; ++q2) {
                    const auto a0 = __builtin_amdgcn_cvt_pk_f32_fp8((int)y0[q2], false), a1 = __builtin_amdgcn_cvt_pk_f32_fp8((int)y0[q2], true);
                    const auto b0 = __builtin_amdgcn_cvt_pk_f32_fp8((int)y1[q2], false), b1 = __builtin_amdgcn_cvt_pk_f32_fp8((int)y1[q2], true);
                    v[r][i * 8 + 4 * q2]     = ALPHA * bflo(hw[2 * q2]) + (a0[0] + b0[0]) * YUNSCALE;
                    v[r][i * 8 + 4 * q2 + 1] = ALPHA * bfhi(hw[2 * q2]) + (a0[1] + b0[1]) * YUNSCALE;
                    v[r][i * 8 + 4 * q2 + 2] = ALPHA * bflo(hw[2 * q2 + 1]) + (a1[0] + b1[0]) * YUNSCALE;
                    v[r][i * 8 + 4 * q2 + 3] = ALPHA * bfhi(hw[2 * q2 + 1]) + (a1[1] + b1[1]) * YUNSCALE;
                }
            }
        }
#pragma unroll
        for (int r = 0; r < 2; ++r) { float a = 0.f;
#pragma unroll
            for (int q = 0; q < 16; ++q) a += v[r][q];
            st[r] = a; }
        wave_sum_n<2>(st);
#pragma unroll
        for (int r = 0; r < 2; ++r) { const float mean = st[r] * (1.f / 1024.f); float a = 0.f;
#pragma unroll
            for (int q = 0; q < 16; ++q) { v[r][q] -= mean; a += v[r][q] * v[r][q]; }
            st[r] = a; }
        wave_sum_n<2>(st);
#pragma unroll
        for (int i = 0; i < 2; ++i)
#pragma unroll
            for (int q = 0; q < 2; ++q) {
                const int col = i * 512 + lane * 8 + q * 4;
                const f32x4 gg = *(const f32x4*)(g + col), bb = *(const f32x4*)(bt + col);
#pragma unroll
                for (int r = 0; r < 2; ++r) {
                    if (r == 1 && tok0 + NGW >= TR) continue;
                    const float rstd = rsqrt_(st[r] * (1.f / 1024.f) + EPS);
                    f32x4 o; o[0] = v[r][i * 8 + q * 4] * rstd * gg[0] + bb[0]; o[1] = v[r][i * 8 + q * 4 + 1] * rstd * gg[1] + bb[1];
                    o[2] = v[r][i * 8 + q * 4 + 2] * rstd * gg[2] + bb[2]; o[3] = v[r][i * 8 + q * 4 + 3] * rstd * gg[3] + bb[3];
                    *(f32x4*)(c.out + (size_t)tk[r] * D + col) = o;
                }
            }
    }
}

__global__ void __launch_bounds__(256, 2) fwd_kernel(Args a) {
    extern __shared__ __attribute__((aligned(16))) unsigned char lds[];
    Ctx c; c.in = a.in; c.out = a.out; c.ws = a.ws; c.lds = lds;
    c.tid = threadIdx.x; c.lane = c.tid & 63; c.wid = __builtin_amdgcn_readfirstlane(c.tid >> 6);
    c.G = gridDim.x; { const int bx = blockIdx.x; c.vcu = (c.G % 8 == 0) ? (bx % 8) * (c.G / 8) + bx / 8 : bx; }
    if (c.tid < 64) ((unsigned*)(lds + MISC_OFF))[c.tid] = 0u;
    __syncthreads();
    unsigned* ctl = (unsigned*)(a.ws + WS_CTL);
    XcdBarrier bar = xcd_barrier_post(ctl + CW_BAR, (volatile LAS unsigned*)(lds + MISC_OFF));
#ifdef ONLY_PH
#define PH_ON(k) ((k) == ONLY_PH)
#else
#define PH_ON(k) 1
#endif
    const int lo = a.ph_lo, hi = a.ph_hi;
#define RUN_PHASE(k, fn) if (PH_ON(k) && lo <= (k) && (k) < hi) { \
        for (int _rep = 0; _rep < ((REPEAT_PH == (k)) ? 2 : 1); ++_rep) { \
            int _t = threadIdx.x; asm volatile("" : "+v"(_t)); c.tid = _t; c.lane = _t & 63; c.wid = __builtin_amdgcn_readfirstlane(_t >> 6); \
            if ((k) == 5) phase5(c, _rep); else fn(c); \
            if (_rep == 0 && REPEAT_PH == (k)) xcd_barrier(bar); } \
        if ((k) + 1 < hi) xcd_barrier(bar); }
    RUN_PHASE(0, phase0)
    RUN_PHASE(1, phase1)
    RUN_PHASE(2, phase2)
    RUN_PHASE(3, phase3)
    RUN_PHASE(4, phase4)
    RUN_PHASE(5, phase0)
    RUN_PHASE(6, phase6a)
    RUN_PHASE(7, phase6b)
    RUN_PHASE(8, phase7)
}

extern "C" void kernel_launch(void* const* d_in, const int* in_sizes, int n_in, void* d_out, int out_size, void* d_ws, size_t ws_size, hipStream_t stream) {
    static int grid = 0;
    if (grid == 0) {
        if (n_in != 27 || in_sizes[0] != NB * SEQ * D || out_size != TR * D || ws_size < WS_END) {
            fprintf(stderr, "kernel_launch: shape mismatch n_in %d in0 %d out %d ws %zu\n", n_in, n_in > 0 ? in_sizes[0] : -1, out_size, ws_size); grid = -1; return; }
        int dev = 0, cus = 0, per_cu = 0;
        if (hipGetDevice(&dev) != hipSuccess || hipDeviceGetAttribute(&cus, hipDeviceAttributeMultiprocessorCount, dev) != hipSuccess) { grid = -1; return; }
        if (hipFuncSetAttribute((const void*)fwd_kernel, hipFuncAttributeMaxDynamicSharedMemorySize, LDS_BYTES) != hipSuccess) { grid = -1; return; }
        if (hipOccupancyMaxActiveBlocksPerMultiprocessor(&per_cu, (const void*)fwd_kernel, 256, LDS_BYTES) != hipSuccess || per_cu < 1) per_cu = 1;
        (void)hipGetLastError();
        if (per_cu > 2) per_cu = 2;
        grid = cus * per_cu;
        fprintf(stderr, "kernel_launch: grid %d (%d per CU)\n", grid, per_cu);
    }
    if (grid < 0) return;
    (void)hipMemsetAsync((char*)d_ws + WS_CTL, 0, CTL_ZERO_BYTES, stream);
    Args a{};
    for (int i = 0; i < 27; ++i) a.in[i] = (const float*)d_in[i];
    a.out = (float*)d_out; a.ws = (unsigned char*)d_ws;
    if (MK_N_LAUNCHES == 1) {
        a.ph_lo = 0; a.ph_hi = NPH;
        hipLaunchKernelGGL(fwd_kernel, dim3(grid), dim3(256), LDS_BYTES, stream, a);
    } else {
        for (int ph = 0; ph < NPH; ++ph) { a.ph_lo = ph; a.ph_hi = ph + 1; hipLaunchKernelGGL(fwd_kernel, dim3(grid), dim3(256), LDS_BYTES, stream, a); }
    }
}
```

```cpp
#include <hip/hip_runtime.h>
#include <cstdio>
#include <cstdint>

#ifndef REPEAT_PH
#define REPEAT_PH -1
#endif
#ifndef CONV_REPB
#define CONV_REPB 1
#endif
#ifndef CONV_REPC
#define CONV_REPC 1
#endif
#ifndef CONV_REPA
#define CONV_REPA 1
#endif
#ifndef MK_N_LAUNCHES
#define MK_N_LAUNCHES 1
#endif

#define DEV __device__ __forceinline__
#define LAS __attribute__((address_space(3)))
#define GAS __attribute__((address_space(1)))
typedef unsigned short bf16_t;
typedef short bf16x8 __attribute__((ext_vector_type(8)));
typedef short s16x4 __attribute__((ext_vector_type(4)));
typedef float f32x4 __attribute__((ext_vector_type(4)));
typedef float f32x16 __attribute__((ext_vector_type(16)));
typedef unsigned u32x4 __attribute__((ext_vector_type(4)));
typedef unsigned u32x2 __attribute__((ext_vector_type(2)));
typedef long i64x2 __attribute__((ext_vector_type(2)));
typedef int v8i __attribute__((ext_vector_type(8)));

constexpr int NB = 16, SEQ = 2048, NMETA = 16, L = SEQ + NMETA;
constexpr int T = NB * L;
constexpr int TR = NB * SEQ;
constexpr int D = 1024, NIN = 1696, CC = 512, QL = 384, KVL = 256, NH = 8, DQK = 96, DV = 64;
constexpr int NQ = NH * DQK;
constexpr int NKV = NH * (64 + DV);
constexpr int NE = 32, DE = 256, CONVK = 31;
constexpr float EPS = 1e-5f;
constexpr float ALPHA = 1.189207115002721f;
constexpr float QSCALE = 0.10206207261596577f * 1.4426950408889634f;
constexpr int NPH = 9;
constexpr float WSCALE = 16.f, WUNSCALE = 1.f / 16.f;
constexpr float YSCALE = 64.f, YUNSCALE = 1.f / 64.f;

constexpr size_t MiB = 1u << 20;
constexpr size_t WS_CTL = 0, CTL_ZERO_BYTES = 64 * 1024;
constexpr int CW_CNT = 1024, CNT_STRIDE = 64;
constexpr int CW_BAR = 4096;
constexpr size_t WS_LIST = 1 * MiB;
constexpr size_t WS_COMBW = 5 * MiB;
constexpr size_t WS_ROPE = 5 * MiB + 512 * 1024;
constexpr size_t WS_WIN = 6 * MiB;
constexpr size_t WS_WUQ = 10 * MiB;
constexpr size_t WS_WUKV = 11 * MiB;
constexpr size_t WS_WO = 12 * MiB;
constexpr size_t WS_WR = 14 * MiB;
constexpr size_t WS_RI = 14 * MiB + 512 * 1024;
constexpr size_t WS_SSQ_CQ = 404 * MiB + 512 * 1024;
constexpr size_t WS_SSQ_CKV = 402 * MiB;
constexpr size_t WS_SSQ_O = 403 * MiB;
constexpr size_t WS_WGU = 16 * MiB;
constexpr size_t WS_WD = 48 * MiB;
constexpr size_t WS_H1F8 = 130 * MiB;
constexpr size_t WS_H0 = 64 * MiB;
constexpr size_t WS_U = 130 * MiB;
constexpr size_t WS_CQ = 163 * MiB;
constexpr size_t WS_CKV = 188 * MiB;
constexpr size_t WS_KR = 205 * MiB;
constexpr size_t WS_Q = 208 * MiB;
constexpr size_t WS_KV = 257 * MiB;
constexpr size_t WS_R1 = 208 * MiB;
constexpr size_t WS_Y = 208 * MiB;
constexpr size_t WS_MG = 336 * MiB;
constexpr size_t WS_ACT = 336 * MiB;
constexpr size_t WS_DUMMY = 400 * MiB;
constexpr size_t WS_END = 406 * MiB;

constexpr int LDS_BYTES = 73728;
constexpr int MISC_OFF = LDS_BYTES - 256;
constexpr int RS_OFF = 65536;
constexpr int TBL_OFF = 66048;
constexpr int EXP_OFF = 67584;

DEV unsigned cvtpk(float lo, float hi) { unsigned r; asm("v_cvt_pk_bf16_f32 %0, %1, %2" : "=v"(r) : "v"(lo), "v"(hi)); return r; }
DEV float bflo(unsigned w) { return __uint_as_float(w << 16); }
DEV float bfhi(unsigned w) { return __uint_as_float(w & 0xffff0000u); }
DEV float dpp_add_qp(float v, int) { return v; }
template <int CTRL> DEV float dpp_mov(float v) { return __builtin_bit_cast(float, __builtin_amdgcn_update_dpp(0, __builtin_bit_cast(int, v), CTRL, 0xf, 0xf, false)); }
DEV float wave_sum(float v) {
    v += dpp_mov<0xB1>(v);
    v += dpp_mov<0x4E>(v);
    v += dpp_mov<0x141>(v);
    v += dpp_mov<0x140>(v);
    const int iv = __builtin_bit_cast(int, v);
    const float a = __builtin_bit_cast(float, __builtin_amdgcn_readlane(iv, 0)), b = __builtin_bit_cast(float, __builtin_amdgcn_readlane(iv, 16));
    const float c = __builtin_bit_cast(float, __builtin_amdgcn_readlane(iv, 32)), d = __builtin_bit_cast(float, __builtin_amdgcn_readlane(iv, 48));
    return (a + b) + (c + d);
}
DEV float rsqrt_(float x) { return __builtin_amdgcn_rsqf(x); }
DEV void st_bf4(bf16_t* p, f32x4 v) { u32x2 w = {cvtpk(v[0], v[1]), cvtpk(v[2], v[3])}; *(u32x2*)p = w; }
DEV unsigned pk_fp8x4(float a, float b, float c, float d) {
    int w = __builtin_amdgcn_cvt_pk_fp8_f32(a, b, 0, false); w = __builtin_amdgcn_cvt_pk_fp8_f32(c, d, w, true); return (unsigned)w; }
DEV float fast_exp2(float x) { return __builtin_amdgcn_exp2f(x); }
DEV float fast_rcp(float x) { return __builtin_amdgcn_rcpf(x); }
DEV float sigmoidf_(float g) { return fast_rcp(1.f + fast_exp2(-1.4426950408889634f * g)); }
#define LDS_WAIT() asm volatile("s_waitcnt lgkmcnt(0)" ::: "memory")
#define VM_WAIT() asm volatile("s_waitcnt vmcnt(0)" ::: "memory")

#define XB_TMO      128
#define XB_XCNT(j)  (256  + 64 * (j))
#define XB_XSUB(j)  (1280 + 64 * (j))
#define XB_XGEN(j)  (2304 + 64 * (j))
#define XB_TOP      3328
#define XB_TOPGEN   3392
#define XCD_BAR_WORDS 3456
#define XB_SPIN_CAP (1u << 22)
DEV unsigned xb_ld(unsigned* p)              { return __hip_atomic_load(p, __ATOMIC_RELAXED, __HIP_MEMORY_SCOPE_AGENT); }
DEV unsigned xb_add(unsigned* p, unsigned v) { return __hip_atomic_fetch_add(p, v, __ATOMIC_RELAXED, __HIP_MEMORY_SCOPE_AGENT); }
DEV unsigned xb_xcc_id() { return (unsigned)__builtin_amdgcn_s_getreg((3 << 11) | 20) & 0xFu; }
#define XB_SPIN(cond, bar) do { unsigned _sp = 0; while (cond) { __builtin_amdgcn_s_sleep(1); \
    if ((++_sp & 255u) == 0u) { if (xb_ld(&(bar)[XB_TMO])) break; if (_sp > XB_SPIN_CAP) { atomicAdd(&(bar)[XB_TMO], 1u); break; } } } } while (0)
struct XcdBarrier { unsigned* bar; unsigned x; volatile LAS unsigned* st; };
DEV XcdBarrier xcd_barrier_post(unsigned* bar, volatile LAS unsigned* st) {
    XcdBarrier b; b.bar = bar; b.x = xb_xcc_id(); b.st = st;
    if (threadIdx.x == 0) (void)xb_add(&bar[XB_XCNT(b.x)], 1u);
    return b;
}
DEV void xcd_barrier_complete(unsigned* bar, unsigned x, unsigned& nloc, unsigned& nx) {
    const unsigned G = gridDim.x * gridDim.y * gridDim.z;
    unsigned sum, cnt, mine, sp = 0u;
    for (;;) {
        sum = 0u; cnt = 0u; mine = 0u;
#pragma unroll
        for (unsigned j = 0; j < 16; ++j) { const unsigned c = xb_ld(&bar[XB_XCNT(j)]); sum += c; cnt += (c > 0u) ? 1u : 0u; mine = (j == x) ? c : mine; }
        if (sum == G) break;
        __builtin_amdgcn_s_sleep(1);
        if ((++sp & 255u) == 0u) { if (xb_ld(&bar[XB_TMO])) break; if (sp > XB_SPIN_CAP) { atomicAdd(&bar[XB_TMO], 1u); break; } }
    }
    nloc = mine > 0u ? mine : 1u; nx = cnt > 0u ? cnt : 1u;
}
DEV void xcd_barrier(const XcdBarrier& b) {
    asm volatile("s_waitcnt vmcnt(0)" ::: "memory");
    __syncthreads();
    if (threadIdx.x == 0) {
        unsigned* bar = b.bar;
        __builtin_amdgcn_s_waitcnt(0);
        unsigned nloc = b.st[0], nx = b.st[1];
        if (nloc == 0u) { xcd_barrier_complete(bar, b.x, nloc, nx); b.st[0] = nloc; b.st[1] = nx; }
        const unsigned old = xb_add(&bar[XB_XSUB(b.x)], 1u);
        const unsigned gen = old / nloc;
        if (old + 1u == (gen + 1u) * nloc) {
            __builtin_amdgcn_fence(__ATOMIC_RELEASE, "agent");
            asm volatile("s_waitcnt vmcnt(0)" ::: "memory");
            const unsigned og = xb_add(&bar[XB_TOP], 1u);
            const unsigned tg = og / nx;
            if (og + 1u == (tg + 1u) * nx) xb_add(&bar[XB_TOPGEN], 1u);
            else XB_SPIN(xb_ld(&bar[XB_TOPGEN]) == tg, bar);
            __builtin_amdgcn_fence(__ATOMIC_ACQUIRE, "agent");
            xb_add(&bar[XB_XGEN(b.x)], 1u);
            asm volatile("s_waitcnt vmcnt(0)" ::: "memory");
        } else {
            XB_SPIN(xb_ld(&bar[XB_XGEN(b.x)]) == gen, bar);
            __builtin_amdgcn_fence(__ATOMIC_ACQUIRE, "agent");
            asm volatile("s_waitcnt vmcnt(0)" ::: "memory");
        }
    }
    __syncthreads();
}

struct Args { const float* in[27]; float* out; unsigned char* ws; int ph_lo, ph_hi; };
struct Ctx {
    const float* const* in; float* out; unsigned char* ws; unsigned char* lds;
    int tid, lane, wid, vcu, G;
};
enum { I_X = 0, I_META, I_LNIN_G, I_LNIN_B, I_WIN, I_CONVW, I_CONVB, I_CLN_G, I_CLN_B, I_QNG, I_WUQ, I_KVNG, I_WUKV, I_COUT_G, I_AOUT_G, I_WO,
       I_LN1G, I_LN1B, I_WRG, I_BRG, I_WRE, I_BRE, I_WGATE, I_WUP, I_WDOWN, I_LN2G, I_LN2B };

DEV int nmap(int mode, int n) {
    if (mode == 1) { if (n < 512) return ((n >> 4) << 5) + (n & 15); if (n < 1024) return (((n - 512) >> 4) << 5) + 16 + (n & 15); return n; }
    if (mode == 2) return ((n >> 4) << 5) + (n & 15);
    if (mode == 3) return ((n >> 4) << 5) + 16 + (n & 15);
    return n;
}
DEV void p0_transpose_item(const float* __restrict__ W, int N, int k0, int n0, const float* __restrict__ kscale, bf16_t* WT, int ldt, int kout0, int mode,
                           float* scr, int lane) {
#pragma unroll 8
    for (int i = 0; i < 32; ++i) {
        const int kk = 2 * i + (lane >> 5);
        float v = W[(size_t)(k0 + kk) * N + n0 + (lane & 31)];
        if (kscale) v *= kscale[k0 + kk];
        scr[kk * 33 + (lane & 31)] = v;
    }
    LDS_WAIT(); asm volatile("" ::: "memory");
    const int c = lane & 7;
#pragma unroll
    for (int j = 0; j < 4; ++j) {
        const int n = (lane >> 3) + 8 * j; const float* s = scr + (8 * c) * 33 + n;
        u32x4 o; o.x = cvtpk(s[0 * 33], s[1 * 33]); o.y = cvtpk(s[2 * 33], s[3 * 33]); o.z = cvtpk(s[4 * 33], s[5 * 33]); o.w = cvtpk(s[6 * 33], s[7 * 33]);
        *(u32x4*)(WT + (size_t)nmap(mode, n0 + n) * ldt + kout0 + 8 * c) = o;
    }
    LDS_WAIT(); asm volatile("" ::: "memory");
}
DEV void p0_transpose_item_f8(const float* __restrict__ W, int N, int k0, int n0, float scale, unsigned char* W8, int ldt, int kout0, int mode, float* scr, int lane) {
#pragma unroll 8
    for (int i = 0; i < 32; ++i) { const int kk = 2 * i + (lane >> 5); scr[kk * 33 + (lane & 31)] = W[(size_t)(k0 + kk) * N + n0 + (lane & 31)] * scale; }
    LDS_WAIT(); asm volatile("" ::: "memory");
    const int c = lane & 7;
#pragma unroll
    for (int j = 0; j < 4; ++j) {
        const int n = (lane >> 3) + 8 * j; const float* sp = scr + (8 * c) * 33 + n;
        u32x2 o; o.x = pk_fp8x4(sp[0 * 33], sp[1 * 33], sp[2 * 33], sp[3 * 33]); o.y = pk_fp8x4(sp[4 * 33], sp[5 * 33], sp[6 * 33], sp[7 * 33]);
        *(u32x2*)(W8 + (size_t)nmap(mode, n0 + n) * ldt + kout0 + 8 * c) = o;
    }
    LDS_WAIT(); asm volatile("" ::: "memory");
}
template <int N> DEV void wave_sum_n(float (&v)[N]) {
#pragma unroll
    for (int i = 0; i < N; ++i) v[i] = wave_sum(v[i]);
}
template <int NR, bool F8 = false, bool BFIN = false> DEV void ln_rows_bf16(const float* const (&xrow)[NR], const float* g, const float* bta, bf16_t* const (&orow)[NR], unsigned char* const (&ldsrow)[NR], int lane, unsigned char* const* f8row = nullptr) {
    f32x4 v[NR][4]; float s[NR];
#pragma unroll
    for (int r = 0; r < NR; ++r)
#pragma unroll
        for (int j = 0; j < 4; ++j) {
            if (BFIN) { const u32x2 w = ((const u32x2*)xrow[r])[64 * j + lane]; v[r][j] = (f32x4){bflo(w.x), bfhi(w.x), bflo(w.y), bfhi(w.y)}; }
            else v[r][j] = ((const f32x4*)xrow[r])[64 * j + lane]; }
#pragma unroll
    for (int r = 0; r < NR; ++r) { s[r] = 0.f;
#pragma unroll
        for (int j = 0; j < 4; ++j) s[r] += (v[r][j].x + v[r][j].y) + (v[r][j].z + v[r][j].w); }
    wave_sum_n<NR>(s);
    float s2[NR];
#pragma unroll
    for (int r = 0; r < NR; ++r) { const float mean = s[r] * (1.f / 1024.f); s2[r] = 0.f;
#pragma unroll
        for (int j = 0; j < 4; ++j) { v[r][j] = v[r][j] - mean; s2[r] += (v[r][j].x * v[r][j].x + v[r][j].y * v[r][j].y) + (v[r][j].z * v[r][j].z + v[r][j].w * v[r][j].w); } }
    wave_sum_n<NR>(s2);
#pragma unroll
    for (int j = 0; j < 4; ++j) {
        const f32x4 gg = ((const f32x4*)g)[64 * j + lane], bb = ((const f32x4*)bta)[64 * j + lane];
#pragma unroll
        for (int r = 0; r < NR; ++r) {
            const float rstd = rsqrt_(s2[r] * (1.f / 1024.f) + EPS);
            const f32x4 o = v[r][j] * rstd * gg + bb;
            const u32x2 w = {cvtpk(o.x, o.y), cvtpk(o.z, o.w)};
            ((u32x2*)orow[r])[64 * j + lane] = w;
            if (ldsrow[r]) ((u32x2*)ldsrow[r])[64 * j + lane] = w;
            if (F8) ((unsigned*)f8row[r])[64 * j + lane] = pk_fp8x4(o.x, o.y, o.z, o.w);
        }
    }
}
__device__ const float INVF[16] = {1.0f, 0.5623413251903491f, 0.31622776601683794f, 0.1778279410038923f, 0.1f, 0.05623413251903491f, 0.031622776601683794f,
    0.01778279410038923f, 0.01f, 0.005623413251903491f, 0.0031622776601683794f, 0.001778279410038923f, 0.001f, 0.0005623413251903491f, 0.00031622776601683794f, 0.0001778279410038923f};
DEV void sincos_d(double a, float& sn, float& cs) {
    const double TWO_PI = 6.283185307179586476925286766559;
    const double k = __builtin_rint(a / TWO_PI);
    const double r = a - k * TWO_PI;
    const double r2 = r * r;
    double st = r, ct = 1.0, ssum = r, csum = 1.0;
#pragma unroll 1
    for (int i = 1; i <= 14; ++i) {
        ct = -ct * r2 / (double)((2 * i - 1) * (2 * i));  csum += ct;
        st = -st * r2 / (double)((2 * i) * (2 * i + 1));  ssum += st;
    }
    sn = (float)ssum; cs = (float)csum;
}
DEV void ew_block(const float* __restrict__ W, int N, int k0, int n0, unsigned char* W8, int ldt, int mode, int lane) {
    const int q = lane & 15, kq = lane >> 4;
    const float* src = W + (size_t)(k0 + 16 * kq) * N + n0 + 4 * q;
    f32x4 v[16];
#pragma unroll
    for (int i = 0; i < 16; ++i) v[i] = *(const f32x4*)(src + (size_t)i * N);
#pragma unroll
    for (int j = 0; j < 4; ++j) {
        u32x4 o;
        o.x = pk_fp8x4(v[0][j] * WSCALE, v[1][j] * WSCALE, v[2][j] * WSCALE, v[3][j] * WSCALE);
        o.y = pk_fp8x4(v[4][j] * WSCALE, v[5][j] * WSCALE, v[6][j] * WSCALE, v[7][j] * WSCALE);
        o.z = pk_fp8x4(v[8][j] * WSCALE, v[9][j] * WSCALE, v[10][j] * WSCALE, v[11][j] * WSCALE);
        o.w = pk_fp8x4(v[12][j] * WSCALE, v[13][j] * WSCALE, v[14][j] * WSCALE, v[15][j] * WSCALE);
        *(u32x4*)(W8 + (size_t)nmap(mode, n0 + 4 * q + j) * ldt + k0 + 16 * kq) = o;
    }
}
DEV void expert_weight_item(const Ctx& c, int r, float*  ) {
    unsigned char* Wgu8 = c.ws + WS_WGU; unsigned char* Wd8 = c.ws + WS_WD;
    if (r < 2048) { const int e = r >> 6, qq = r & 63, kb = qq >> 2, nb = qq & 3;
        ew_block(c.in[I_WGATE] + (size_t)e * D * DE, DE, 64 * kb, 64 * nb, Wgu8 + (size_t)e * 512 * 1024, 1024, 2, c.lane); return; } r -= 2048;
    if (r < 2048) { const int e = r >> 6, qq = r & 63, kb = qq >> 2, nb = qq & 3;
        ew_block(c.in[I_WUP] + (size_t)e * D * DE, DE, 64 * kb, 64 * nb, Wgu8 + (size_t)e * 512 * 1024, 1024, 3, c.lane); return; } r -= 2048;
    { const int e = r >> 6, qq = r & 63, kb = qq >> 4, nb = qq & 15;
        ew_block(c.in[I_WDOWN] + (size_t)e * DE * D, D, 64 * kb, 64 * nb, Wd8 + (size_t)e * 1024 * 256, 256, 0, c.lane); }
}
DEV void phase0(const Ctx& c) {
    float* scr = (float*)(c.lds + c.wid * 8448);
    const int gw = c.vcu * 4 + c.wid, NGW = c.G * 4;
    constexpr int I_IN = 16 * 53, I_UQ = 6 * 24, I_UKV = 4 * 32, I_O = 16 * 32;
    bf16_t* WinT = (bf16_t*)(c.ws + WS_WIN); bf16_t* WuqT = (bf16_t*)(c.ws + WS_WUQ); bf16_t* WukvT = (bf16_t*)(c.ws + WS_WUKV);
    bf16_t* WoT = (bf16_t*)(c.ws + WS_WO);
    constexpr int NITEMS0 = I_IN + I_UQ + I_UKV + I_O;
    for (int it = gw; it < NITEMS0; it += NGW) {
        int r = it;
        if (r < I_IN) { const int kb = r / 53, nb = r % 53; p0_transpose_item(c.in[I_WIN], NIN, 64 * kb, 32 * nb, nullptr, WinT, 1024, 64 * kb, 1, scr, c.lane); continue; } r -= I_IN;
        if (r < I_UQ) { const int kb = r / 24, nb = r % 24; p0_transpose_item(c.in[I_WUQ], NQ, 64 * kb, 32 * nb, c.in[I_QNG], WuqT, QL, 64 * kb, 0, scr, c.lane); continue; } r -= I_UQ;
        if (r < I_UKV) { const int kb = r / 32, nb = r % 32; p0_transpose_item(c.in[I_WUKV], NKV, 64 * kb, 32 * nb, c.in[I_KVNG], WukvT, KVL, 64 * kb, 0, scr, c.lane); continue; } r -= I_UKV;
        { const int kb = r / 32, nb = r % 32;
            if (kb < 8) p0_transpose_item(c.in[I_WO], D, 64 * kb, 32 * nb, nullptr, WoT, 1024, 64 * kb + 512, 0, scr, c.lane);
            else        p0_transpose_item(c.in[I_WO], D, 64 * kb, 32 * nb, c.in[I_AOUT_G] - 512, WoT, 1024, 64 * kb - 512, 0, scr, c.lane); }
    }
    const int gt = c.vcu * 256 + c.tid, NGT = c.G * 256;
    bf16_t* WrT = (bf16_t*)(c.ws + WS_WR);
    for (int i = gt; i < 48 * 1024; i += NGT) {
        const int n = i >> 10, k = i & 1023; float v = 0.f;
        if (n < 4) v = c.in[I_WRG][k * 4 + n]; else if (n < 36) v = c.in[I_WRE][k * 32 + (n - 4)];
        WrT[i] = (bf16_t)(cvtpk(v, 0.f) & 0xffffu);
    }
    float* rc = (float*)(c.ws + WS_ROPE); float* rs = rc + L * 16;
    for (int i = gt; i < L * 16; i += NGT) {
        const int p = i >> 4, f = i & 15; const float ang = (float)p * INVF[f];
        float sn, cs; sincos_d((double)ang, sn, cs); rc[i] = cs; rs[i] = sn;
    }
    bf16_t* h0 = (bf16_t*)(c.ws + WS_H0);
    for (int t = gw; t < T; t += 2 * NGW) {
        const float* src[2]; bf16_t* dst[2]; unsigned char* ldsn[2] = {nullptr, nullptr};
#pragma unroll
        for (int r = 0; r < 2; ++r) { int tt = t + r * NGW; if (tt >= T) tt = t;
            const int b = tt / L, p = tt - b * L;
            src[r] = (p < NMETA) ? c.in[I_META] + (size_t)p * D : c.in[I_X] + ((size_t)b * SEQ + (p - NMETA)) * D;
            dst[r] = h0 + (size_t)tt * D; }
        ln_rows_bf16<2>(src, c.in[I_LNIN_G], c.in[I_LNIN_B], dst, ldsn, c.lane);
    }
}

struct StageGeo { int r[4]; int c; };
DEV StageGeo stage_geo(int tid) {
    const int lane = tid & 63, wid = tid >> 6; StageGeo g;
    const int rl = lane >> 2, cl = ((lane & 3) * 8) ^ ((lane >> 5) << 4);
#pragma unroll
    for (int i = 0; i < 4; ++i) g.r[i] = (((wid + 4 * i) >> 1) << 4) + rl;
    g.c = ((wid & 1) << 5) + cl;
    return g;
}
template <bool SSQ, bool FP8 = false>
DEV void gemm_mainloop(f32x4 (&acc)[4][4], const bf16_t* ap0, const bf16_t* ap1, const bf16_t* ap2, const bf16_t* ap3,
                       const bf16_t* bp0, const bf16_t* bp1, const bf16_t* bp2, const bf16_t* bp3,
                       int nk, unsigned char* lds, int ssq_steps, float ssq_inv_dim, bool skip_wc1 = false) {
    const int tid = threadIdx.x, lane = tid & 63, wid = tid >> 6, wr = wid >> 1, wc = wid & 1, fr = lane & 15, fq = lane >> 4;
    const int xs = (fr >> 1) & 7;
    const int lo = ((fr * 64 + fq * 16) ^ ((fr >> 3) << 5));
    const int lo0 = lo, lo1 = lo + 1024;
    const int a_off = wr * 8192, b_off = 16384 + wc * 8192;
    const int dst = tid * 16;
#pragma unroll
    for (int m = 0; m < 4; ++m)
#pragma unroll
        for (int n = 0; n < 4; ++n) acc[m][n] = (f32x4){0.f, 0.f, 0.f, 0.f};
    __syncthreads();
#define GLDS(src, off) __builtin_amdgcn_global_load_lds((const unsigned*)(src), (unsigned LAS*)(lds + (off)), 16, 0, 0)
#define STAGE(kt, b) do { const int _k = (kt) * 64; \
        GLDS(ap0 + _k, (b) * 32768 + dst);          GLDS(ap1 + _k, (b) * 32768 + dst + 4096); \
        GLDS(ap2 + _k, (b) * 32768 + dst + 8192);   GLDS(ap3 + _k, (b) * 32768 + dst + 12288); \
        GLDS(bp0 + _k, (b) * 32768 + 16384 + dst);  GLDS(bp1 + _k, (b) * 32768 + 16384 + dst + 4096); \
        GLDS(bp2 + _k, (b) * 32768 + 16384 + dst + 8192); GLDS(bp3 + _k, (b) * 32768 + 16384 + dst + 12288); } while (0)
    STAGE(0, 0);
    for (int kt = 0; kt < nk; ++kt) {
        VM_WAIT();
        __syncthreads();
        const int b = kt & 1;
        if (SSQ && kt == ssq_steps) {
            const float* rsl = (const float*)(lds + RS_OFF);
#pragma unroll
            for (int m = 0; m < 4; ++m) { const float r = rsl[wr * 64 + m * 16 + fr];
#pragma unroll
                for (int n = 0; n < 4; ++n) acc[m][n] = acc[m][n] * r; }
        }
        if (kt + 1 < nk) { if (b) STAGE(kt + 1, 0); else STAGE(kt + 1, 1); }
        const unsigned char* base = lds + b * 32768;
        if (skip_wc1 && wc == 1) {
        } else if (FP8) {
            const int cb0 = fq * 32, cb1 = fq * 32 + 16;
            const int q0 = (cb0 >> 6) * 1024 + ((fr * 64 + (cb0 & 63)) ^ ((fr >> 3) << 5)), q1 = (cb1 >> 6) * 1024 + ((fr * 64 + (cb1 & 63)) ^ ((fr >> 3) << 5));
            v8i ax[4], bx[4];
#pragma unroll
            for (int m = 0; m < 4; ++m) { const u32x4 c0 = *(const u32x4*)(base + a_off + m * 2048 + q0), c1 = *(const u32x4*)(base + a_off + m * 2048 + q1);
                ax[m] = (v8i){(int)c0.x, (int)c0.y, (int)c0.z, (int)c0.w, (int)c1.x, (int)c1.y, (int)c1.z, (int)c1.w}; }
#pragma unroll
            for (int n = 0; n < 4; ++n) { const u32x4 c0 = *(const u32x4*)(base + b_off + n * 2048 + q0), c1 = *(const u32x4*)(base + b_off + n * 2048 + q1);
                bx[n] = (v8i){(int)c0.x, (int)c0.y, (int)c0.z, (int)c0.w, (int)c1.x, (int)c1.y, (int)c1.z, (int)c1.w}; }
#pragma unroll
            for (int m = 0; m < 4; ++m)
#pragma unroll
                for (int n = 0; n < 4; ++n) acc[m][n] = __builtin_amdgcn_mfma_scale_f32_16x16x128_f8f6f4(bx[n], ax[m], acc[m][n], 0, 0, 0, 0x7F7F7F7F, 0, 0x7F7F7F7F);
        } else {
#pragma unroll
        for (int ks = 0; ks < 2; ++ks) {
            bf16x8 af[4], bf[4];
#pragma unroll
            for (int m = 0; m < 4; ++m) af[m] = *(const bf16x8*)(base + a_off + m * 2048 + (ks ? lo1 : lo0));
#pragma unroll
            for (int n = 0; n < 4; ++n) bf[n] = *(const bf16x8*)(base + b_off + n * 2048 + (ks ? lo1 : lo0));
#pragma unroll
            for (int m = 0; m < 4; ++m)
#pragma unroll
                for (int n = 0; n < 4; ++n) acc[m][n] = __builtin_amdgcn_mfma_f32_16x16x32_bf16(bf[n], af[m], acc[m][n], 0, 0, 0);
        }
        }
    }
    if (SSQ && ssq_steps == nk) {
        __syncthreads();
        const float* rsl = (const float*)(lds + RS_OFF);
#pragma unroll
        for (int m = 0; m < 4; ++m) { const float r = rsl[wr * 64 + m * 16 + fr];
#pragma unroll
            for (int n = 0; n < 4; ++n) acc[m][n] = acc[m][n] * r; }
    }
#undef STAGE
#undef GLDS
}

DEV void phase1(const Ctx& c) {
    const bf16_t* h0 = (const bf16_t*)(c.ws + WS_H0); const bf16_t* WinT = (const bf16_t*)(c.ws + WS_WIN);
    bf16_t* U = (bf16_t*)(c.ws + WS_U); bf16_t* CQ = (bf16_t*)(c.ws + WS_CQ); bf16_t* CKV = (bf16_t*)(c.ws + WS_CKV); bf16_t* KR = (bf16_t*)(c.ws + WS_KR);
    const float* rc = (const float*)(c.ws + WS_ROPE); const float* rs = rc + L * 16;
    const StageGeo g = stage_geo(c.tid);
    const int lane = c.lane, wr = c.wid >> 1, wc = c.wid & 1, fr = lane & 15, fq = lane >> 4;
    constexpr int NT = 14, NU = (T / 128) * NT;
    for (int u = c.vcu; u < NU; u += c.G) {
        const int mt = u / NT, nt = u - mt * NT;
        const bf16_t* A = h0 + (size_t)(mt * 128) * D + g.c; const bf16_t* B = WinT + (size_t)(nt * 128) * D + g.c;
        f32x4 acc[4][4];
        gemm_mainloop<false>(acc, A + (size_t)g.r[0] * D, A + (size_t)g.r[1] * D, A + (size_t)g.r[2] * D, A + (size_t)g.r[3] * D,
                             B + (size_t)g.r[0] * D, B + (size_t)g.r[1] * D, B + (size_t)g.r[2] * D, B + (size_t)g.r[3] * D, 16, c.lds, 0, 0.f, nt == 13);
        const int row0 = mt * 128 + wr * 64 + fr;
        if (nt < 8) {
#pragma unroll
            for (int m = 0; m < 4; ++m) { const size_t row = row0 + m * 16;
#pragma unroll
                for (int i = 0; i < 2; ++i) {
                    f32x4 a = acc[m][2 * i], gt = acc[m][2 * i + 1], o;
#pragma unroll
                    for (int j = 0; j < 4; ++j) o[j] = a[j] * sigmoidf_(gt[j]);
                    st_bf4(U + row * CC + nt * 64 + wc * 32 + i * 16 + fq * 4, o);
                } }
        } else if (nt < 13) {
            const bool isq = nt < 11;
            bf16_t* dstb = isq ? CQ + (nt - 8) * 128 + wc * 64 + fq * 4 : CKV + (nt - 11) * 128 + wc * 64 + fq * 4;
            const int ldd = isq ? QL : KVL;
            float* ssb = isq ? (float*)(c.ws + WS_SSQ_CQ) + (nt - 8) * 2 + wc : (float*)(c.ws + WS_SSQ_CKV) + (nt - 11) * 2 + wc;
            const int lds_ = isq ? 8 : 4;
#pragma unroll
            for (int m = 0; m < 4; ++m) { const size_t row = row0 + m * 16; float sq = 0.f;
#pragma unroll
                for (int n = 0; n < 4; ++n) { st_bf4(dstb + row * ldd + n * 16, acc[m][n]);
                    sq += (acc[m][n][0] * acc[m][n][0] + acc[m][n][1] * acc[m][n][1]) + (acc[m][n][2] * acc[m][n][2] + acc[m][n][3] * acc[m][n][3]); }
                sq += __shfl_xor(sq, 16); sq += __shfl_xor(sq, 32);
                if (fq == 0) ssb[row * lds_] = sq; }
        } else if (wc == 0) {
#pragma unroll
            for (int m = 0; m < 4; ++m) { const int row = row0 + m * 16; const int p = row % L;
                const f32x4 cs = *(const f32x4*)(rc + p * 16 + fq * 4), sn = *(const f32x4*)(rs + p * 16 + fq * 4);
                const f32x4 x1 = acc[m][0], x2 = acc[m][1];
                st_bf4(KR + (size_t)row * 32 + fq * 4, x1 * cs - x2 * sn);
                st_bf4(KR + (size_t)row * 32 + 16 + fq * 4, x1 * sn + x2 * cs); }
        }
    }
}

DEV void conv_unit(const Ctx& c, int b, int j) {
    const bf16_t* U = (const bf16_t*)(c.ws + WS_U);
    bf16_t* MG = (bf16_t*)(c.ws + WS_MG);
    const float* cw = c.in[I_CONVW]; const float* cb = c.in[I_CONVB];
    const int p0 = j * 32;
    float* ytile = (float*)c.lds;
    __syncthreads();
#pragma unroll 1
    for (int pass = 0; pass < 2; ++pass) {
        const int ch = c.tid + 256 * pass;
        float win[62]; unsigned raw[62];
        const bf16_t* ub = U + (size_t)b * L * CC + ch;
#pragma unroll
        for (int rep = 0; rep < CONV_REPA; ++rep) {
        asm volatile("" : "+v"(ub) :: "memory");
#pragma unroll
        for (int i = 0; i < 62; ++i) { const int p = p0 - 30 + i; const int pc = p < 0 ? 0 : (p >= L ? L - 1 : p); raw[i] = ub[(size_t)pc * CC]; }
        if (rep + 1 < CONV_REPA) {
#pragma unroll
            for (int i = 0; i < 62; ++i) asm volatile("" :: "v"(raw[i]));
        }
        }
        float w[31];
#pragma unroll
        for (int k = 0; k < 31; ++k) w[k] = cw[k * CC + ch];
        float bias = cb[ch];
        __builtin_amdgcn_sched_barrier(0);
#pragma unroll
        for (int i = 0; i < 62; ++i) { const int p = p0 - 30 + i; win[i] = (p >= 0 && p < L) ? __uint_as_float(raw[i] << 16) : 0.f; }
#pragma unroll
        for (int rep = 0; rep < CONV_REPB; ++rep) {
        asm volatile("" : "+v"(bias) :: "memory");
#pragma unroll
        for (int tt = 0; tt < 32; ++tt) {
            float a0 = bias;
#pragma unroll
            for (int k = 0; k < 31; ++k) a0 += w[k] * win[tt + k];
            ytile[tt * 512 + ch] = a0;
        }
        }
    }
    __syncthreads();
    const float* g1 = c.in[I_CLN_G]; const float* b1 = c.in[I_CLN_B]; const float* g2 = c.in[I_COUT_G];
    float G1[8], B1[8], G2[8];
    { const f32x4 a = *(const f32x4*)(g1 + c.lane * 8), bq = *(const f32x4*)(g1 + c.lane * 8 + 4); G1[0]=a.x;G1[1]=a.y;G1[2]=a.z;G1[3]=a.w;G1[4]=bq.x;G1[5]=bq.y;G1[6]=bq.z;G1[7]=bq.w; }
    { const f32x4 a = *(const f32x4*)(b1 + c.lane * 8), bq = *(const f32x4*)(b1 + c.lane * 8 + 4); B1[0]=a.x;B1[1]=a.y;B1[2]=a.z;B1[3]=a.w;B1[4]=bq.x;B1[5]=bq.y;B1[6]=bq.z;B1[7]=bq.w; }
    { const f32x4 a = *(const f32x4*)(g2 + c.lane * 8), bq = *(const f32x4*)(g2 + c.lane * 8 + 4); G2[0]=a.x;G2[1]=a.y;G2[2]=a.z;G2[3]=a.w;G2[4]=bq.x;G2[5]=bq.y;G2[6]=bq.z;G2[7]=bq.w; }
#pragma unroll
    for (int rep = 0; rep < CONV_REPC; ++rep) {
    asm volatile("" : "+v"(ytile) :: "memory");
    float v[8][8]; float st[8];
#pragma unroll
    for (int i = 0; i < 8; ++i) { const int tt = c.wid * 8 + i;
        const f32x4 ya = *(const f32x4*)(ytile + tt * 512 + c.lane * 8), yb = *(const f32x4*)(ytile + tt * 512 + c.lane * 8 + 4);
        v[i][0]=ya.x;v[i][1]=ya.y;v[i][2]=ya.z;v[i][3]=ya.w;v[i][4]=yb.x;v[i][5]=yb.y;v[i][6]=yb.z;v[i][7]=yb.w;
        st[i] = ((v[i][0] + v[i][1]) + (v[i][2] + v[i][3])) + ((v[i][4] + v[i][5]) + (v[i][6] + v[i][7])); }
    wave_sum_n<8>(st);
#pragma unroll
    for (int i = 0; i < 8; ++i) { const float mean = st[i] * (1.f / 512.f); float a = 0.f;
#pragma unroll
        for (int q = 0; q < 8; ++q) { v[i][q] -= mean; a += v[i][q] * v[i][q]; }
        st[i] = a; }
    wave_sum_n<8>(st);
#pragma unroll
    for (int i = 0; i < 8; ++i) { const float rstd = rsqrt_(st[i] * (1.f / 512.f) + EPS); float a = 0.f;
#pragma unroll
        for (int q = 0; q < 8; ++q) { const float x = v[i][q] * rstd * G1[q] + B1[q]; const float y = x * sigmoidf_(x); v[i][q] = y; a += y * y; }
        st[i] = a; }
    wave_sum_n<8>(st);
#pragma unroll
    for (int i = 0; i < 8; ++i) {
        const int p = p0 + c.wid * 8 + i;
        {
            const float r2 = rsqrt_(st[i] * (1.f / 512.f) + EPS);
            u32x4 o;
            o.x = cvtpk(v[i][0] * r2 * G2[0], v[i][1] * r2 * G2[1]); o.y = cvtpk(v[i][2] * r2 * G2[2], v[i][3] * r2 * G2[3]);
            o.z = cvtpk(v[i][4] * r2 * G2[4], v[i][5] * r2 * G2[5]); o.w = cvtpk(v[i][6] * r2 * G2[6], v[i][7] * r2 * G2[7]);
            const size_t tok = (size_t)b * SEQ + (p - NMETA);
            bf16_t* dstp = (p >= NMETA && p < L) ? MG + tok * D + 512 + c.lane * 8 : (bf16_t*)(c.ws + WS_DUMMY) + c.lane * 8;
            *(u32x4*)dstp = o;
        }
    }
    }
}
DEV void rope4(f32x4& x1, f32x4& x2, const float* rc, const float* rs, int p, int fq) {
    const f32x4 cs = *(const f32x4*)(rc + p * 16 + fq * 4), sn = *(const f32x4*)(rs + p * 16 + fq * 4);
    const f32x4 a = x1 * cs - x2 * sn, bb = x1 * sn + x2 * cs; x1 = a; x2 = bb;
}
template <int SEL> DEV void phase2_t(const Ctx& c) {
    const bf16_t* CQ = (const bf16_t*)(c.ws + WS_CQ); const bf16_t* CKV = (const bf16_t*)(c.ws + WS_CKV);
    const bf16_t* WuqT = (const bf16_t*)(c.ws + WS_WUQ); const bf16_t* WukvT = (const bf16_t*)(c.ws + WS_WUKV);
    bf16_t* Q = (bf16_t*)(c.ws + WS_Q); bf16_t* KV = (bf16_t*)(c.ws + WS_KV);
    const float* rc = (const float*)(c.ws + WS_ROPE); const float* rs = rc + L * 16;
    const StageGeo g = stage_geo(c.tid);
    const int lane = c.lane, wr = c.wid >> 1, wc = c.wid & 1, fr = lane & 15, fq = lane >> 4;
    constexpr int MT = T / 128, NUQ = MT * 6, NUKV = MT * 8, NUC = NB * 65, NU = NUQ + NUKV + NUC;
    const int li = c.vcu & 63, rev = ((li >> 5) ^ li) & 1;
    const int nmine = (NU - c.vcu + c.G - 1) / c.G;
    for (int it = 0; it < nmine; ++it) {
        const int u = c.vcu + (rev ? (nmine - 1 - it) : it) * c.G;
        if (SEL == 1 && u >= NUKV + NUQ) continue;
        if (SEL == 2 && u < NUKV + NUQ) continue;
        if (u < NUKV) {
            const int mt = u >> 3, nt = u & 7;
            const bf16_t* A = CKV + (size_t)(mt * 128) * KVL + g.c; const bf16_t* B = WukvT + (size_t)(nt * 128) * KVL + g.c;
            f32x4 acc[4][4];
            __syncthreads();
            if (c.tid < 128) { const f32x4 p4 = *(const f32x4*)((const float*)(c.ws + WS_SSQ_CKV) + (size_t)(mt * 128 + c.tid) * 4);
                ((float*)(c.lds + RS_OFF))[c.tid] = rsqrt_(((p4.x + p4.y) + (p4.z + p4.w)) * (1.f / 256.f) + EPS); }
            gemm_mainloop<true>(acc, A + (size_t)g.r[0] * KVL, A + (size_t)g.r[1] * KVL, A + (size_t)g.r[2] * KVL, A + (size_t)g.r[3] * KVL,
                                B + (size_t)g.r[0] * KVL, B + (size_t)g.r[1] * KVL, B + (size_t)g.r[2] * KVL, B + (size_t)g.r[3] * KVL, 4, c.lds, 4, 1.f / 256.f);
            const int row0 = mt * 128 + wr * 64 + fr;
#pragma unroll
            for (int m = 0; m < 4; ++m) { const size_t row = row0 + m * 16;
#pragma unroll
                for (int n = 0; n < 4; ++n) st_bf4(KV + row * NKV + nt * 128 + wc * 64 + n * 16 + fq * 4, acc[m][n]); }
        } else if (u < NUKV + NUQ) {
            const int v = u - NUKV, mt = v / 6, nt = v - mt * 6;
            const bf16_t* A = CQ + (size_t)(mt * 128) * QL + g.c; const bf16_t* B = WuqT + (size_t)(nt * 128) * QL + g.c;
            f32x4 acc[4][4];
            __syncthreads();
            if (c.tid < 128) { const float* pp = (const float*)(c.ws + WS_SSQ_CQ) + (size_t)(mt * 128 + c.tid) * 8; const f32x4 p4 = *(const f32x4*)pp; const float2 p2 = *(const float2*)(pp + 4);
                ((float*)(c.lds + RS_OFF))[c.tid] = rsqrt_((((p4.x + p4.y) + (p4.z + p4.w)) + (p2.x + p2.y)) * (1.f / 384.f) + EPS); }
            gemm_mainloop<true>(acc, A + (size_t)g.r[0] * QL, A + (size_t)g.r[1] * QL, A + (size_t)g.r[2] * QL, A + (size_t)g.r[3] * QL,
                                B + (size_t)g.r[0] * QL, B + (size_t)g.r[1] * QL, B + (size_t)g.r[2] * QL, B + (size_t)g.r[3] * QL, 6, c.lds, 6, 1.f / 384.f);
            const int row0 = mt * 128 + wr * 64 + fr;
            const int t16 = (nt * 8 + wc * 4) % 6;
#pragma unroll
            for (int m = 0; m < 4; ++m) { const int row = row0 + m * 16; const int p = row % L;
#pragma unroll
                for (int n = 0; n < 4; ++n) acc[m][n] = acc[m][n] * QSCALE;
                if (t16 == 4) rope4(acc[m][0], acc[m][1], rc, rs, p, fq);
                if (t16 == 2) rope4(acc[m][2], acc[m][3], rc, rs, p, fq);
#pragma unroll
                for (int n = 0; n < 4; ++n) st_bf4(Q + (size_t)row * NQ + nt * 128 + wc * 64 + n * 16 + fq * 4, acc[m][n]); }
        } else {
            const int v = u - NUKV - NUQ; conv_unit(c, v / 65, v % 65);
        }
    }
}

DEV void phase2(const Ctx& c) { phase2_t<0>(c); }
DEV void phase2g(const Ctx& c) { phase2_t<1>(c); }
DEV void phase2c(const Ctx& c) { phase2_t<2>(c); }
DEV int crow(int r, int hi) { return (r & 3) + 8 * (r >> 2) + 4 * hi; }
#define KSWZ(row, colB) ((row) * 256 + ((colB) ^ (((row) & 7) << 4)))
#define SBAR() __builtin_amdgcn_sched_barrier(0)
DEV int v_st(int k, int cc) { const int kk = (k & ~0xC) | ((k & 4) << 1) | ((k & 8) >> 1); return ((kk >> 3) * 4 + (cc >> 5)) * 512 + ((kk & 7) * 32 + (cc & 31)) * 2; }
DEV int v_rd_base(int lane) { return ((lane & 3) << 3) | (((lane >> 2) & 3) << 6) | (((lane >> 4) & 1) << 5) | (((lane >> 5) & 1) << 8); }
constexpr int v_rd_off(int d0, int ks, int half) { return d0 * 512 + ks * 4096 + half * 2048; }
template <int OFF> DEV s16x4 tr_read(int vb) { s16x4 r; asm volatile("ds_read_b64_tr_b16 %0, %1 offset:%2" : "=&v"(r) : "v"(vb), "i"(OFF) : "memory"); return r; }
template <int D0> DEV void pv_one(f32x16& od, int vb, bf16x8 pa0, bf16x8 pa1, bf16x8 pa2, bf16x8 pa3) {
    const s16x4 l0 = tr_read<v_rd_off(D0, 0, 0)>(vb), h0 = tr_read<v_rd_off(D0, 0, 1)>(vb), l1 = tr_read<v_rd_off(D0, 1, 0)>(vb), h1 = tr_read<v_rd_off(D0, 1, 1)>(vb);
    const s16x4 l2 = tr_read<v_rd_off(D0, 2, 0)>(vb), h2 = tr_read<v_rd_off(D0, 2, 1)>(vb), l3 = tr_read<v_rd_off(D0, 3, 0)>(vb), h3 = tr_read<v_rd_off(D0, 3, 1)>(vb);
    asm volatile("s_waitcnt lgkmcnt(0)" ::: "memory"); SBAR();
#define PK(Lo, Hi) (bf16x8){Lo[0], Lo[1], Lo[2], Lo[3], Hi[0], Hi[1], Hi[2], Hi[3]}
    od = __builtin_amdgcn_mfma_f32_32x32x16_bf16(pa0, PK(l0, h0), od, 0, 0, 0);
    od = __builtin_amdgcn_mfma_f32_32x32x16_bf16(pa1, PK(l1, h1), od, 0, 0, 0);
    od = __builtin_amdgcn_mfma_f32_32x32x16_bf16(pa2, PK(l2, h2), od, 0, 0, 0);
    od = __builtin_amdgcn_mfma_f32_32x32x16_bf16(pa3, PK(l3, h3), od, 0, 0, 0);
#undef PK
}
constexpr float ATT_THR = 8.f;
constexpr int AT_V = 0, AT_K = 32768, AT_WS = 65536;
DEV void attn_unit(const Ctx& c, int b, int h, int qb) {
    const bf16_t* Q = (const bf16_t*)(c.ws + WS_Q); const bf16_t* KV = (const bf16_t*)(c.ws + WS_KV); const bf16_t* KR = (const bf16_t*)(c.ws + WS_KR);
    bf16_t* MG = (bf16_t*)(c.ws + WS_MG);
    unsigned char* lds = c.lds;
    const int tid = c.tid, wid = c.wid, lane = c.lane, r32 = lane & 31, hi = lane >> 5;
    float* wsf = (float*)(lds + AT_WS) + wid * 64; float* li_l = wsf; float* al_l = wsf + 32;
    const int NT = 2 * qb + 3;
    const int my_last = 2 * qb + (wid >> 1) + 1;
    bf16x8 qr[6];
    { const size_t t = (size_t)b * L + NMETA + qb * 128 + wid * 32 + r32;
      const bf16_t* Qw = Q + t * NQ + h * DQK + hi * 8;
#pragma unroll
      for (int d0 = 0; d0 < 6; ++d0) qr[d0] = *(const bf16x8*)(Qw + d0 * 16); }
    const int srow = tid >> 2, sq = tid & 3;
    const int vst0 = v_st(srow, sq * 16), vst1 = v_st(srow, sq * 16 + 8);
    const int kst0 = KSWZ(srow, sq * 32), kst1 = KSWZ(srow, sq * 32 + 16), kst2 = KSWZ(srow, 128 + sq * 16);
    const int vb0 = (int)(uintptr_t)(lds + AT_V) + v_rd_base(lane);
    u32x4 sk0, sk1, sk2, sv0, sv1;
#define SLOAD(j) do { int pos = (j) * 64 + srow - 48; pos = pos < 0 ? 0 : pos; const size_t tk = (size_t)b * L + pos; \
        const bf16_t* kvp = KV + tk * NKV + h * 128 + sq * 16; \
        sk0 = *(const u32x4*)(kvp); sk1 = *(const u32x4*)(kvp + 8); sv0 = *(const u32x4*)(kvp + 64); sv1 = *(const u32x4*)(kvp + 72); \
        sk2 = *(const u32x4*)(KR + tk * 32 + sq * 8); } while (0)
#define SWRITE(bb) do { unsigned char* kb = lds + AT_K + (bb) * 16384; unsigned char* vbp = lds + AT_V + (bb) * 16384; \
        *(u32x4*)(kb + kst0) = sk0; *(u32x4*)(kb + kst1) = sk1; *(u32x4*)(kb + kst2) = sk2; *(u32x4*)(vbp + vst0) = sv0; *(u32x4*)(vbp + vst1) = sv1; } while (0)
    float m_reg = 0.f, l_reg = 0.f; f32x16 o[2] = {};
    __syncthreads();
    SLOAD(0); SWRITE(0); __syncthreads();
    for (int j = 0; j < NT; ++j) {
        const int bsel = j & 1;
        if (j + 1 < NT) SLOAD(j + 1);
        if (j <= my_last) {
            const unsigned char* Ks = lds + AT_K + bsel * 16384;
            f32x16 p0, p1;
            { const float nm = -m_reg;
#pragma unroll
              for (int r = 0; r < 16; ++r) { p0[r] = nm; p1[r] = nm; } }
            __builtin_amdgcn_s_setprio(1);
#pragma unroll
            for (int d0 = 0; d0 < 6; ++d0) { const int cb = (d0 * 16 + hi * 8) * 2;
                const bf16x8 k0 = *(const bf16x8*)(Ks + KSWZ(r32, cb)); const bf16x8 k1 = *(const bf16x8*)(Ks + KSWZ(32 + r32, cb));
                p0 = __builtin_amdgcn_mfma_f32_32x32x16_bf16(k0, qr[d0], p0, 0, 0, 0);
                p1 = __builtin_amdgcn_mfma_f32_32x32x16_bf16(k1, qr[d0], p1, 0, 0, 0); }
            __builtin_amdgcn_s_setprio(0);
            if (j == 0) {
#pragma unroll
                for (int r = 0; r < 16; ++r) p0[r] = -1e30f;
#pragma unroll
                for (int r = 0; r < 8; ++r) p1[r] = -1e30f;
            }
            float pmax = fmaxf(fmaxf(p0[0], p0[1]), p0[2]);
#pragma unroll
            for (int r = 3; r < 15; r += 2) pmax = fmaxf(fmaxf(pmax, p0[r]), p0[r + 1]);
            pmax = fmaxf(fmaxf(pmax, p0[15]), p1[0]);
#pragma unroll
            for (int r = 1; r < 15; r += 2) pmax = fmaxf(fmaxf(pmax, p1[r]), p1[r + 1]);
            pmax = fmaxf(pmax, p1[15]);
            { auto rr = __builtin_amdgcn_permlane32_swap(__float_as_uint(pmax), __float_as_uint(pmax), false, false);
              pmax = fmaxf(__uint_as_float(rr[0]), __uint_as_float(rr[1])); }
            float ps = 0.f;
            if (__any(pmax > ATT_THR)) {
                const float dm = fmaxf(pmax, 0.f), alpha = fast_exp2(-dm); m_reg += dm;
#pragma unroll
                for (int r = 0; r < 16; ++r) { p0[r] -= dm; p1[r] -= dm; }
                l_reg *= alpha;
                if (hi == 0) al_l[r32] = alpha;
                asm volatile("s_waitcnt lgkmcnt(0)" ::: "memory");
#pragma unroll
                for (int r = 0; r < 16; ++r) { const float a = al_l[crow(r, hi)]; o[0][r] *= a; o[1][r] *= a; }
            }
#pragma unroll
            for (int r = 0; r < 16; ++r) { p0[r] = fast_exp2(p0[r]); ps += p0[r]; }
#pragma unroll
            for (int r = 0; r < 16; ++r) { p1[r] = fast_exp2(p1[r]); ps += p1[r]; }
            { auto rr = __builtin_amdgcn_permlane32_swap(__float_as_uint(ps), __float_as_uint(ps), false, false);
              ps = __uint_as_float(rr[0]) + __uint_as_float(rr[1]); }
            l_reg += ps;
            bf16x8 pa0, pa1, pa2, pa3;
#define PK4(P, BASE, OUT) do { unsigned a0 = cvtpk(P[BASE + 0], P[BASE + 1]), a1 = cvtpk(P[BASE + 2], P[BASE + 3]);   \
    unsigned b0 = cvtpk(P[BASE + 4], P[BASE + 5]), b1 = cvtpk(P[BASE + 6], P[BASE + 7]);                              \
    auto r0 = __builtin_amdgcn_permlane32_swap(a0, b0, false, false); auto r1 = __builtin_amdgcn_permlane32_swap(a1, b1, false, false); \
    u32x4 w = {r0[0], r1[0], r0[1], r1[1]}; OUT = *reinterpret_cast<bf16x8*>(&w); } while (0)
            PK4(p0, 0, pa0); PK4(p0, 8, pa1); PK4(p1, 0, pa2); PK4(p1, 8, pa3);
#undef PK4
            const int vb = vb0 + bsel * 16384;
            __builtin_amdgcn_s_setprio(1);
            pv_one<0>(o[0], vb, pa0, pa1, pa2, pa3); pv_one<1>(o[1], vb, pa0, pa1, pa2, pa3);
            __builtin_amdgcn_s_setprio(0);
        }
        if (j + 1 < NT) { if (bsel) SWRITE(0); else SWRITE(1); }
        __syncthreads();
    }
    if (hi == 0) li_l[r32] = l_reg;
    asm volatile("s_waitcnt lgkmcnt(0)" ::: "memory");
    const size_t tok0 = (size_t)b * SEQ + qb * 128 + wid * 32;
    float* SSO = (float*)(c.ws + WS_SSQ_O);
#pragma unroll
    for (int r = 0; r < 16; ++r) {
        const int orow = crow(r, hi); const float rl = fast_rcp(li_l[orow]);
        bf16_t* dst = MG + (tok0 + orow) * D + h * DV + r32;
        const float a0 = o[0][r] * rl, a1 = o[1][r] * rl;
        dst[0]  = (bf16_t)(cvtpk(a0, 0.f) & 0xffffu);
        dst[32] = (bf16_t)(cvtpk(a1, 0.f) & 0xffffu);
        float sq = a0 * a0 + a1 * a1;
        sq += dpp_mov<0xB1>(sq); sq += dpp_mov<0x4E>(sq); sq += dpp_mov<0x141>(sq); sq += dpp_mov<0x140>(sq);
        sq += __shfl_xor(sq, 16);
        if (r32 == 0) SSO[(tok0 + orow) * 8 + h] = sq;
    }
#undef SLOAD
#undef SWRITE
}
DEV void phase3(const Ctx& c) {
    const int nslots = NB * NH * 4;
    float* scr = (float*)(c.lds + c.wid * 8448);
    const int gw = c.vcu * 4 + c.wid, NGW = c.G * 4;
    constexpr int NWI = 6144;
    int wi = gw;
#define EW_ITEMS(n) do { __syncthreads(); for (int _q = 0; _q < (n) && wi < NWI; ++_q, wi += NGW) expert_weight_item(c, wi, scr); } while (0)
    for (int v = c.vcu; v < nslots; v += c.G) {
        const int bh = v >> 2, s = v & 3, b = bh >> 3, h = bh & 7;
        attn_unit(c, b, h, 15 - s); EW_ITEMS(1); attn_unit(c, b, h, s); EW_ITEMS(1); attn_unit(c, b, h, 11 - s); EW_ITEMS(1); attn_unit(c, b, h, 4 + s);
    }
    __syncthreads();
    for (; wi < NWI; wi += NGW) expert_weight_item(c, wi, scr);
#undef EW_ITEMS
}

DEV void phase4(const Ctx& c) {
    const bf16_t* MG = (const bf16_t*)(c.ws + WS_MG); const bf16_t* WoT = (const bf16_t*)(c.ws + WS_WO); const bf16_t* h0 = (const bf16_t*)(c.ws + WS_H0);
    bf16_t* R1 = (bf16_t*)(c.ws + WS_R1);
    const StageGeo g = stage_geo(c.tid);
    const int lane = c.lane, wr = c.wid >> 1, wc = c.wid & 1, fr = lane & 15, fq = lane >> 4;
    constexpr int NU = (TR / 128) * 8;
    const float* SSO = (const float*)(c.ws + WS_SSQ_O);
    f32x4 pa = {1.f, 1.f, 1.f, 1.f}, pb = pa;
    if (c.vcu < NU && c.tid < 128) { const float* pp = SSO + (size_t)((c.vcu >> 3) * 128 + c.tid) * 8; pa = *(const f32x4*)pp; pb = *(const f32x4*)(pp + 4); }
    for (int u = c.vcu; u < NU; u += c.G) {
        const int mt = u >> 3, nt = u & 7;
        const bf16_t* A = MG + (size_t)(mt * 128) * D + g.c; const bf16_t* B = WoT + (size_t)(nt * 128) * D + g.c;
        f32x4 acc[4][4];
        __syncthreads();
        if (c.tid < 128) ((float*)(c.lds + RS_OFF))[c.tid] = rsqrt_((((pa.x + pa.y) + (pa.z + pa.w)) + ((pb.x + pb.y) + (pb.z + pb.w))) * (1.f / 512.f) + EPS);
        { const int un = u + c.G; if (un < NU && c.tid < 128) { const float* pp = SSO + (size_t)((un >> 3) * 128 + c.tid) * 8; pa = *(const f32x4*)pp; pb = *(const f32x4*)(pp + 4); } }
        u32x2 hw[4][4];
#pragma unroll
        for (int m = 0; m < 4; ++m) {
            const int tok = mt * 128 + wr * 64 + m * 16 + fr;
            const size_t t = (size_t)(tok >> 11) * L + NMETA + (tok & 2047);
#pragma unroll
            for (int n = 0; n < 4; ++n) hw[m][n] = *(const u32x2*)(h0 + t * D + nt * 128 + wc * 64 + n * 16 + fq * 4);
        }
        gemm_mainloop<true>(acc, A + (size_t)g.r[0] * D, A + (size_t)g.r[1] * D, A + (size_t)g.r[2] * D, A + (size_t)g.r[3] * D,
                            B + (size_t)g.r[0] * D, B + (size_t)g.r[1] * D, B + (size_t)g.r[2] * D, B + (size_t)g.r[3] * D, 16, c.lds, 8, 1.f / 512.f);
#pragma unroll
        for (int m = 0; m < 4; ++m) {
            const int tok = mt * 128 + wr * 64 + m * 16 + fr;
#pragma unroll
            for (int n = 0; n < 4; ++n) {
                const int col = nt * 128 + wc * 64 + n * 16 + fq * 4;
                f32x4 o; o[0] = ALPHA * bflo(hw[m][n].x) + acc[m][n][0]; o[1] = ALPHA * bfhi(hw[m][n].x) + acc[m][n][1];
                o[2] = ALPHA * bflo(hw[m][n].y) + acc[m][n][2]; o[3] = ALPHA * bfhi(hw[m][n].y) + acc[m][n][3];
                st_bf4(R1 + (size_t)tok * D + col, o);
            }
        }
    }
}

constexpr int P5_ROWB = 2064, P5_PART = 33280, P5_LG = 45568, P5_BIAS = 48128, P5_AGG = 48384;
DEV void phase5(const Ctx& c, int ALT = 0) {
    const bf16_t* R1 = (const bf16_t*)(c.ws + WS_R1); bf16_t* H1 = (bf16_t*)(c.ws + WS_H0);
    const bf16_t* WrT = (const bf16_t*)(c.ws + WS_WR);
    unsigned* cnt = (unsigned*)(c.ws + WS_CTL) + CW_CNT + ALT * 32; unsigned* list = (unsigned*)(c.ws + (ALT ? 404 * MiB : WS_LIST)); float* combw = (float*)(c.ws + WS_COMBW);
    const int lane = c.lane, wid = c.wid, fr = lane & 15, fq = lane >> 4;
    float* part = (float*)(c.lds + P5_PART); float* lgs = (float*)(c.lds + P5_LG); float* biasl = (float*)(c.lds + P5_BIAS);
    __syncthreads();
    if (c.tid < 36) biasl[c.tid] = (c.tid < 4) ? c.in[I_BRG][c.tid] : c.in[I_BRE][c.tid - 4];
    bf16x8 wf[8][3];
#pragma unroll
    for (int ks = 0; ks < 8; ++ks)
#pragma unroll
        for (int n = 0; n < 3; ++n) wf[ks][n] = *(const bf16x8*)(WrT + (size_t)(n * 16 + fr) * D + wid * 256 + ks * 32 + fq * 8);
    unsigned* lcnt = (unsigned*)(c.lds + P5_AGG); unsigned* lbase = lcnt + 32; unsigned* ent = lcnt + 64;
    if (c.tid < 32) lcnt[c.tid] = 0u;
    int nent = 0;
    for (int u = c.vcu; u < TR / 16; u += c.G) {
        const int tok0 = u * 16;
        { const float* src[4]; bf16_t* dst[4]; unsigned char* ldsn[4]; unsigned char* f8n[4];
#pragma unroll
          for (int i = 0; i < 4; ++i) { const int tl = wid * 4 + i; const size_t tok = tok0 + tl; src[i] = (const float*)(R1 + tok * D); dst[i] = H1 + tok * D; ldsn[i] = c.lds + tl * P5_ROWB; f8n[i] = c.ws + WS_H1F8 + tok * D; }
          ln_rows_bf16<4, true, true>(src, c.in[I_LN1G], c.in[I_LN1B], dst, ldsn, lane, f8n); }
        __syncthreads();
        f32x4 acc[3] = {};
#pragma unroll
        for (int ks = 0; ks < 8; ++ks) {
            const int k = wid * 256 + ks * 32 + fq * 8;
            const bf16x8 a = *(const bf16x8*)(c.lds + fr * P5_ROWB + k * 2);
#pragma unroll
            for (int n = 0; n < 3; ++n) acc[n] = __builtin_amdgcn_mfma_f32_16x16x32_bf16(wf[ks][n], a, acc[n], 0, 0, 0);
        }
#pragma unroll
        for (int n = 0; n < 3; ++n) *(f32x4*)(part + (wid * 16 + fr) * 48 + n * 16 + fq * 4) = acc[n];
        __syncthreads();
#pragma unroll
        for (int i = 0; i < 3; ++i) { const int idx = c.tid + 256 * i;
            if (idx < 576) { const int tk = idx / 36, l = idx - tk * 36;
                lgs[tk * 40 + l] = ((part[tk * 48 + l] + part[(16 + tk) * 48 + l]) + (part[(32 + tk) * 48 + l] + part[(48 + tk) * 48 + l])) + biasl[l]; } }
        __syncthreads();
        if (c.tid < 16) {
            const float* lg = lgs + c.tid * 40;
            int gi = 0; float gm = lg[0];
#pragma unroll
            for (int i = 1; i < 4; ++i) { const float v = lg[i]; if (v > gm) { gm = v; gi = i; } }
            float gs = 0.f;
#pragma unroll
            for (int i = 0; i < 4; ++i) gs += __expf(lg[i] - gm);
            const float gw = 1.f / gs;
            const float* le = lg + 4 + gi * 8;
            float v0 = le[0], v1 = -3.0e38f; int i0 = 0, i1 = 0;
#pragma unroll
            for (int i = 1; i < 8; ++i) { const float v = le[i];
                if (v > v0) { v1 = v0; i1 = i0; v0 = v; i0 = i; } else if (v > v1) { v1 = v; i1 = i; } }
            const float ex = __expf(v1 - v0), inv = 1.f / (1.f + ex);
            const int tok = tok0 + c.tid; const unsigned e0 = gi * 8 + i0, e1 = gi * 8 + i1;
            combw[tok * 2] = gw * inv; combw[tok * 2 + 1] = gw * ex * inv;
            const unsigned r0 = atomicAdd(&lcnt[e0], 1u), r1 = atomicAdd(&lcnt[e1], 1u);
            const int ei = nent * 32 + c.tid * 2;
            ent[2 * ei] = (unsigned)(tok * 2);         ent[2 * ei + 1] = (e0 << 16) | r0;
            ent[2 * ei + 2] = (unsigned)(tok * 2 + 1); ent[2 * ei + 3] = (e1 << 16) | r1;
        }
        ++nent;
    }
    __syncthreads();
    if (c.tid < 32) { const unsigned n = lcnt[c.tid]; lbase[c.tid] = n ? atomicAdd(&cnt[c.tid * CNT_STRIDE], n) : 0u; }
    __syncthreads();
    for (int i = c.tid; i < nent * 32; i += 256) { const unsigned t2 = ent[2 * i], er = ent[2 * i + 1]; const unsigned e = er >> 16;
        list[(size_t)e * TR + lbase[e] + (er & 0xffffu)] = t2; }
}
DEV void bar20(const Ctx& c) {}
DEV void moe_tiles(const Ctx& c) {
    const unsigned* cnt = (const unsigned*)(c.ws + WS_CTL) + CW_CNT; int* ts = (int*)(c.lds + EXP_OFF);
    __syncthreads();
    if (c.tid < NE) ts[40 + c.tid] = (int)__hip_atomic_load(&cnt[c.tid * CNT_STRIDE], __ATOMIC_RELAXED, __HIP_MEMORY_SCOPE_AGENT);
    __syncthreads();
    if (c.tid == 0) { int s = 0; for (int e = 0; e < NE; ++e) { ts[e] = s; s += (ts[40 + e] + 127) >> 7; } ts[NE] = s; }
    __syncthreads();
}
DEV void phase6a(const Ctx& c) {
    const bf16_t* H18 = (const bf16_t*)(c.ws + WS_H1F8); const bf16_t* Wgu8 = (const bf16_t*)(c.ws + WS_WGU); unsigned char* ACT8 = c.ws + WS_ACT;
    const unsigned* list = (const unsigned*)(c.ws + WS_LIST);
    moe_tiles(c);
    const int* ts = (const int*)(c.lds + EXP_OFF); unsigned* tbl = (unsigned*)(c.lds + TBL_OFF);
    const StageGeo g = stage_geo(c.tid);
    const int lane = c.lane, wr = c.wid >> 1, wc = c.wid & 1, fr = lane & 15, fq = lane >> 4;
    const int NU = ts[NE] * 4;
    u32x2* RI = (u32x2*)(c.ws + WS_RI); const float* combw = (const float*)(c.ws + WS_COMBW);
    int e = 0, en_e = 0; unsigned en_cur = 0xffffffffu;
    { const int u0 = c.vcu; if (u0 < NU) { const int rt0 = u0 >> 2; while (ts[en_e + 1] <= rt0) ++en_e;
        if (c.tid < 128) { const int j = (rt0 - ts[en_e]) * 128 + c.tid; en_cur = (j < ts[40 + en_e]) ? list[(size_t)en_e * TR + j] : 0xffffffffu; } } }
    for (int u = c.vcu; u < NU; u += c.G) {
        const int rt = u >> 2, nt = u & 3;
        e = en_e;
        __syncthreads();
        float wri = 0.f;
        if (c.tid < 128) { tbl[c.tid] = en_cur; if (nt == 0 && en_cur != 0xffffffffu) wri = combw[en_cur]; }
        const unsigned en_this = en_cur;
        { const int un = u + c.G; if (un < NU) { const int rtn = un >> 2; while (ts[en_e + 1] <= rtn) ++en_e;
            if (c.tid < 128) { const int j = (rtn - ts[en_e]) * 128 + c.tid; en_cur = (j < ts[40 + en_e]) ? list[(size_t)en_e * TR + j] : 0xffffffffu; } } }
        __syncthreads();
        size_t ro[4];
#pragma unroll
        for (int i = 0; i < 4; ++i) { const unsigned en = tbl[g.r[i]]; ro[i] = (en == 0xffffffffu) ? 0 : (size_t)(en >> 1) * (D / 2); }
        const bf16_t* A = H18 + g.c; const bf16_t* B = Wgu8 + ((size_t)e * 512 + nt * 128) * (D / 2) + g.c;
        f32x4 acc[4][4];
        gemm_mainloop<false, true>(acc, A + ro[0], A + ro[1], A + ro[2], A + ro[3],
                             B + (size_t)g.r[0] * (D / 2), B + (size_t)g.r[1] * (D / 2), B + (size_t)g.r[2] * (D / 2), B + (size_t)g.r[3] * (D / 2), 8, c.lds, 0, 0.f);
#pragma unroll
        for (int m = 0; m < 4; ++m) { const size_t row = (size_t)rt * 128 + wr * 64 + m * 16 + fr;
#pragma unroll
            for (int i = 0; i < 2; ++i) {
                const f32x4 gt = acc[m][2 * i], up = acc[m][2 * i + 1]; f32x4 o;
#pragma unroll
                for (int j = 0; j < 4; ++j) { const float gv = gt[j] * WUNSCALE; o[j] = gv * sigmoidf_(gv) * (up[j] * WUNSCALE); }
                *(unsigned*)(ACT8 + row * DE + nt * 64 + wc * 32 + i * 16 + fq * 4) = pk_fp8x4(o[0], o[1], o[2], o[3]);
            } }
        if (nt == 0 && c.tid < 128) { u32x2 ri; ri.x = en_this; ri.y = __float_as_uint(wri); RI[(size_t)rt * 128 + c.tid] = ri; }
    }
}
DEV void phase6b(const Ctx& c) {
    const bf16_t* ACT8 = (const bf16_t*)(c.ws + WS_ACT); const bf16_t* Wd8 = (const bf16_t*)(c.ws + WS_WD); unsigned char* Y8 = c.ws + WS_Y;
    const u32x2* RI = (const u32x2*)(c.ws + WS_RI);
    moe_tiles(c);
    const int* ts = (const int*)(c.lds + EXP_OFF); u32x2* tbl = (u32x2*)(c.lds + TBL_OFF);
    const StageGeo g = stage_geo(c.tid);
    unsigned char* lds = c.lds;
    const int tid = c.tid, lane = c.lane, wr = c.wid >> 1, wc = c.wid & 1, fr = lane & 15, fq = lane >> 4;
    const int cb0 = fq * 32, cb1 = fq * 32 + 16;
    const int q0 = (cb0 >> 6) * 1024 + ((fr * 64 + (cb0 & 63)) ^ ((fr >> 3) << 5)), q1 = (cb1 >> 6) * 1024 + ((fr * 64 + (cb1 & 63)) ^ ((fr >> 3) << 5));
    const int a_off = wr * 8192, b_off = wc * 8192, dst = tid * 16;
    const int NU = ts[NE] * 2;
    int e = 0;
#define GLDS(src, off) __builtin_amdgcn_global_load_lds((const unsigned*)(src), (unsigned LAS*)(lds + (off)), 16, 0, 0)
    for (int u = c.vcu; u < NU; u += c.G) {
        const int rt = u >> 1, nh = u & 1;
        while (ts[e + 1] <= rt) ++e;
        __syncthreads();
        if (tid < 128) tbl[tid] = RI[(size_t)rt * 128 + tid];
        const bf16_t* A = ACT8 + (size_t)(rt * 128) * (DE / 2) + g.c;
        const bf16_t* B = Wd8 + ((size_t)e * 1024 + nh * 512) * (DE / 2) + g.c;
#pragma unroll
        for (int kt = 0; kt < 2; ++kt)
#pragma unroll
            for (int i = 0; i < 4; ++i) GLDS(A + (size_t)g.r[i] * (DE / 2) + kt * 64, kt * 16384 + dst + i * 4096);
#define BSTAGE(s_, buf) do { const bf16_t* _b = B + (size_t)((s_) >> 1) * 128 * (DE / 2) + ((s_) & 1) * 64; \
        GLDS(_b + (size_t)g.r[0] * (DE / 2), 32768 + (buf) * 16384 + dst);        GLDS(_b + (size_t)g.r[1] * (DE / 2), 32768 + (buf) * 16384 + dst + 4096); \
        GLDS(_b + (size_t)g.r[2] * (DE / 2), 32768 + (buf) * 16384 + dst + 8192); GLDS(_b + (size_t)g.r[3] * (DE / 2), 32768 + (buf) * 16384 + dst + 12288); } while (0)
        BSTAGE(0, 0);
        f32x4 acc[4][4];
#pragma unroll
        for (int m = 0; m < 4; ++m)
#pragma unroll
            for (int n = 0; n < 4; ++n) acc[m][n] = (f32x4){0.f, 0.f, 0.f, 0.f};
#pragma unroll 1
        for (int s_ = 0; s_ < 8; ++s_) {
            VM_WAIT();
            __syncthreads();
            const int bsel = s_ & 1;
            if (s_ + 1 < 8) { if (bsel) BSTAGE(s_ + 1, 0); else BSTAGE(s_ + 1, 1); }
            const unsigned char* ab = lds + bsel * 16384 + a_off; const unsigned char* bb = lds + 32768 + bsel * 16384 + b_off;
            v8i ax[4], bx[4];
#pragma unroll
            for (int m = 0; m < 4; ++m) { const u32x4 c0 = *(const u32x4*)(ab + m * 2048 + q0), c1 = *(const u32x4*)(ab + m * 2048 + q1);
                ax[m] = (v8i){(int)c0.x, (int)c0.y, (int)c0.z, (int)c0.w, (int)c1.x, (int)c1.y, (int)c1.z, (int)c1.w}; }
#pragma unroll
            for (int n = 0; n < 4; ++n) { const u32x4 c0 = *(const u32x4*)(bb + n * 2048 + q0), c1 = *(const u32x4*)(bb + n * 2048 + q1);
                bx[n] = (v8i){(int)c0.x, (int)c0.y, (int)c0.z, (int)c0.w, (int)c1.x, (int)c1.y, (int)c1.z, (int)c1.w}; }
#pragma unroll
            for (int m = 0; m < 4; ++m)
#pragma unroll
                for (int n = 0; n < 4; ++n) acc[m][n] = __builtin_amdgcn_mfma_scale_f32_16x16x128_f8f6f4(bx[n], ax[m], acc[m][n], 0, 0, 0, 0x7F7F7F7F, 0, 0x7F7F7F7F);
            if (bsel) {
                const int nt = nh * 4 + (s_ >> 1);
#pragma unroll
                for (int m = 0; m < 4; ++m) {
                    const u32x2 ri = tbl[wr * 64 + m * 16 + fr]; const unsigned en = ri.x;
                    if (en != 0xffffffffu) {
                        const float w = __uint_as_float(ri.y) * (WUNSCALE * YSCALE); unsigned char* dstp = Y8 + ((size_t)(en & 1u) * TR + (en >> 1)) * D + nt * 128 + wc * 64 + fq * 4;
#pragma unroll
                        for (int n = 0; n < 4; ++n) { const f32x4 o = acc[m][n] * w; *(unsigned*)(dstp + n * 16) = pk_fp8x4(o[0], o[1], o[2], o[3]); }
                    }
#pragma unroll
                    for (int n = 0; n < 4; ++n) acc[m][n] = (f32x4){0.f, 0.f, 0.f, 0.f};
                }
            }
        }
#undef BSTAGE
    }
#undef GLDS
}

DEV void phase7(const Ctx& c) {
    const bf16_t* H1 = (const bf16_t*)(c.ws + WS_H0); const unsigned char* Y8 = c.ws + WS_Y;
    const float* g = c.in[I_LN2G]; const float* bt = c.in[I_LN2B];
    const int gw = c.vcu * 4 + c.wid, NGW = c.G * 4, lane = c.lane;
    for (int tok0 = gw; tok0 < TR; tok0 += 2 * NGW) {
        float v[2][16]; float st[2]; int tk[2];
#pragma unroll
        for (int r = 0; r < 2; ++r) {
            int tok = tok0 + r * NGW; if (tok >= TR) tok = tok0; tk[r] = tok;
#pragma unroll
            for (int i = 0; i < 2; ++i) {
                const u32x4 hw = *(const u32x4*)(H1 + (size_t)tok * D + i * 512 + lane * 8);
                const u32x2 y0 = *(const u32x2*)(Y8 + (size_t)tok * D + i * 512 + lane * 8);
                const u32x2 y1 = *(const u32x2*)(Y8 + ((size_t)TR + tok) * D + i * 512 + lane * 8);
#pragma unroll
                for (int q2 = 0; q2 < 2; ++q2) {
                    const auto a0 = __builtin_amdgcn_cvt_pk_f32_fp8((int)y0[q2], false), a1 = __builtin_amdgcn_cvt_pk_f32_fp8((int)y0[q2], true);
                    const auto b0 = __builtin_amdgcn_cvt_pk_f32_fp8((int)y1[q2], false), b1 = __builtin_amdgcn_cvt_pk_f32_fp8((int)y1[q2], true);
                    v[r][i * 8 + 4 * q2]     = ALPHA * bflo(hw[2 * q2]) + (a0[0] + b0[0]) * YUNSCALE;
                    v[r][i * 8 + 4 * q2 + 1] = ALPHA * bfhi(hw[2 * q2]) + (a0[1] + b0[1]) * YUNSCALE;
                    v[r][i * 8 + 4 * q2 + 2] = ALPHA * bflo(hw[2 * q2 + 1]) + (a1[0] + b1[0]) * YUNSCALE;
                    v[r][i * 8 + 4 * q2 + 3] = ALPHA * bfhi(hw[2 * q2 + 1]) + (a1[1] + b1[1]) * YUNSCALE;
                }
            }
        }
#pragma unroll
        for (int r = 0; r < 2; ++r) { float a = 0.f;
#pragma unroll
            for (int q = 0; q < 16; ++q) a += v[r][q];
            st[r] = a; }
        wave_sum_n<2>(st);
#pragma unroll
        for (int r = 0; r < 2; ++r) { const float mean = st[r] * (1.f / 1024.f); float a = 0.f;
#pragma unroll
            for (int q = 0; q < 16; ++q) { v[r][q] -= mean; a += v[r][q] * v[r][q]; }
            st[r] = a; }
        wave_sum_n<2>(st);
#pragma unroll
        for (int i = 0; i < 2; ++i)
#pragma unroll
            for (int q = 0; q < 2; ++q) {
                const int col = i * 512 + lane * 8 + q * 4;
                const f32x4 gg = *(const f32x4*)(g + col), bb = *(const f32x4*)(bt + col);
#pragma unroll
                for (int r = 0; r < 2; ++r) {
                    if (r == 1 && tok0 + NGW >= TR) continue;
                    const float rstd = rsqrt_(st[r] * (1.f / 1024.f) + EPS);
                    f32x4 o; o[0] = v[r][i * 8 + q * 4] * rstd * gg[0] + bb[0]; o[1] = v[r][i * 8 + q * 4 + 1] * rstd * gg[1] + bb[1];
                    o[2] = v[r][i * 8 + q * 4 + 2] * rstd * gg[2] + bb[2]; o[3] = v[r][i * 8 + q * 4 + 3] * rstd * gg[3] + bb[3];
                    *(f32x4*)(c.out + (size_t)tk[r] * D + col) = o;
                }
            }
    }
}

__global__ void __launch_bounds__(256, 2) fwd_kernel(Args a) {
    extern __shared__ __attribute__((aligned(16))) unsigned char lds[];
    Ctx c; c.in = a.in; c.out = a.out; c.ws = a.ws; c.lds = lds;
    c.tid = threadIdx.x; c.lane = c.tid & 63; c.wid = __builtin_amdgcn_readfirstlane(c.tid >> 6);
    c.G = gridDim.x; { const int bx = blockIdx.x; c.vcu = (c.G % 8 == 0) ? (bx % 8) * (c.G / 8) + bx / 8 : bx; }
    if (c.tid < 64) ((unsigned*)(lds + MISC_OFF))[c.tid] = 0u;
    __syncthreads();
    unsigned* ctl = (unsigned*)(a.ws + WS_CTL);
    XcdBarrier bar = xcd_barrier_post(ctl + CW_BAR, (volatile LAS unsigned*)(lds + MISC_OFF));
#ifdef ONLY_PH
#define PH_ON(k) ((k) == ONLY_PH)
#else
#define PH_ON(k) 1
#endif
    const int lo = a.ph_lo, hi = a.ph_hi;
#define RUN_PHASE(k, fn) if (PH_ON(k) && lo <= (k) && (k) < hi) { \
        for (int _rep = 0; _rep < ((REPEAT_PH == (k)) ? 2 : 1); ++_rep) { \
            int _t = threadIdx.x; asm volatile("" : "+v"(_t)); c.tid = _t; c.lane = _t & 63; c.wid = __builtin_amdgcn_readfirstlane(_t >> 6); \
            if ((k) == 5) phase5(c, _rep); else fn(c); \
            if (_rep == 0 && REPEAT_PH == (k)) xcd_barrier(bar); } \
        if ((k) + 1 < hi) xcd_barrier(bar); }
    RUN_PHASE(0, phase0)
    RUN_PHASE(1, phase1)
    RUN_PHASE(2, phase2)
    RUN_PHASE(3, phase3)
    RUN_PHASE(4, phase4)
    RUN_PHASE(5, phase0)
    RUN_PHASE(6, phase6a)
    RUN_PHASE(7, phase6b)
    RUN_PHASE(8, phase7)
}

extern "C" void kernel_launch(void* const* d_in, const int* in_sizes, int n_in, void* d_out, int out_size, void* d_ws, size_t ws_size, hipStream_t stream) {
    static int grid = 0;
    if (grid == 0) {
        if (n_in != 27 || in_sizes[0] != NB * SEQ * D || out_size != TR * D || ws_size < WS_END) {
            fprintf(stderr, "kernel_launch: shape mismatch n_in %d in0 %d out %d ws %zu\n", n_in, n_in > 0 ? in_sizes[0] : -1, out_size, ws_size); grid = -1; return; }
        int dev = 0, cus = 0, per_cu = 0;
        if (hipGetDevice(&dev) != hipSuccess || hipDeviceGetAttribute(&cus, hipDeviceAttributeMultiprocessorCount, dev) != hipSuccess) { grid = -1; return; }
        if (hipFuncSetAttribute((const void*)fwd_kernel, hipFuncAttributeMaxDynamicSharedMemorySize, LDS_BYTES) != hipSuccess) { grid = -1; return; }
        if (hipOccupancyMaxActiveBlocksPerMultiprocessor(&per_cu, (const void*)fwd_kernel, 256, LDS_BYTES) != hipSuccess || per_cu < 1) per_cu = 1;
        (void)hipGetLastError();
        if (per_cu > 2) per_cu = 2;
        grid = cus * per_cu;
        fprintf(stderr, "kernel_launch: grid %d (%d per CU)\n", grid, per_cu);
    }
    if (grid < 0) return;
    (void)hipMemsetAsync((char*)d_ws + WS_CTL, 0, CTL_ZERO_BYTES, stream);
    Args a{};
    for (int i = 0; i < 27; ++i) a.in[i] = (const float*)d_in[i];
    a.out = (float*)d_out; a.ws = (unsigned char*)d_ws;
    if (MK_N_LAUNCHES == 1) {
        a.ph_lo = 0; a.ph_hi = NPH;
        hipLaunchKernelGGL(fwd_kernel, dim3(grid), dim3(256), LDS_BYTES, stream, a);
    } else {
        for (int ph = 0; ph < NPH; ++ph) { a.ph_lo = ph; a.ph_hi = ph + 1; hipLaunchKernelGGL(fwd_kernel, dim3(grid), dim3(256), LDS_BYTES, stream, a); }
    }
}
```

```cpp
#include <hip/hip_runtime.h>
#include <cstdio>
#include <cstdint>

#ifndef REPEAT_PH
#define REPEAT_PH -1
#endif
#ifndef CONV_REPB
#define CONV_REPB 1
#endif
#ifndef CONV_REPC
#define CONV_REPC 1
#endif
#ifndef CONV_REPA
#define CONV_REPA 1
#endif
#ifndef MK_N_LAUNCHES
#define MK_N_LAUNCHES 1
#endif

#define DEV __device__ __forceinline__
#define LAS __attribute__((address_space(3)))
#define GAS __attribute__((address_space(1)))
typedef unsigned short bf16_t;
typedef short bf16x8 __attribute__((ext_vector_type(8)));
typedef short s16x4 __attribute__((ext_vector_type(4)));
typedef float f32x4 __attribute__((ext_vector_type(4)));
typedef float f32x16 __attribute__((ext_vector_type(16)));
typedef unsigned u32x4 __attribute__((ext_vector_type(4)));
typedef unsigned u32x2 __attribute__((ext_vector_type(2)));
typedef long i64x2 __attribute__((ext_vector_type(2)));
typedef int v8i __attribute__((ext_vector_type(8)));

constexpr int NB = 16, SEQ = 2048, NMETA = 16, L = SEQ + NMETA;
constexpr int T = NB * L;
constexpr int TR = NB * SEQ;
constexpr int D = 1024, NIN = 1696, CC = 512, QL = 384, KVL = 256, NH = 8, DQK = 96, DV = 64;
constexpr int NQ = NH * DQK;
constexpr int NKV = NH * (64 + DV);
constexpr int NE = 32, DE = 256, CONVK = 31;
constexpr float EPS = 1e-5f;
constexpr float ALPHA = 1.189207115002721f;
constexpr float QSCALE = 0.10206207261596577f * 1.4426950408889634f;
constexpr int NPH = 9;
constexpr float WSCALE = 16.f, WUNSCALE = 1.f / 16.f;
constexpr float YSCALE = 64.f, YUNSCALE = 1.f / 64.f;

constexpr size_t MiB = 1u << 20;
constexpr size_t WS_CTL = 0, CTL_ZERO_BYTES = 64 * 1024;
constexpr int CW_CNT = 1024, CNT_STRIDE = 64;
constexpr int CW_BAR = 4096;
constexpr size_t WS_LIST = 1 * MiB;
constexpr size_t WS_COMBW = 5 * MiB;
constexpr size_t WS_ROPE = 5 * MiB + 512 * 1024;
constexpr size_t WS_WIN = 6 * MiB;
constexpr size_t WS_WUQ = 10 * MiB;
constexpr size_t WS_WUKV = 11 * MiB;
constexpr size_t WS_WO = 12 * MiB;
constexpr size_t WS_WR = 14 * MiB;
constexpr size_t WS_RI = 14 * MiB + 512 * 1024;
constexpr size_t WS_SSQ_CQ = 404 * MiB + 512 * 1024;
constexpr size_t WS_SSQ_CKV = 402 * MiB;
constexpr size_t WS_SSQ_O = 403 * MiB;
constexpr size_t WS_WGU = 16 * MiB;
constexpr size_t WS_WD = 48 * MiB;
constexpr size_t WS_H1F8 = 130 * MiB;
constexpr size_t WS_H0 = 64 * MiB;
constexpr size_t WS_U = 130 * MiB;
constexpr size_t WS_CQ = 163 * MiB;
constexpr size_t WS_CKV = 188 * MiB;
constexpr size_t WS_KR = 205 * MiB;
constexpr size_t WS_Q = 208 * MiB;
constexpr size_t WS_KV = 257 * MiB;
constexpr size_t WS_R1 = 208 * MiB;
constexpr size_t WS_Y = 208 * MiB;
constexpr size_t WS_MG = 336 * MiB;
constexpr size_t WS_ACT = 336 * MiB;
constexpr size_t WS_DUMMY = 400 * MiB;
constexpr size_t WS_END = 406 * MiB;

constexpr int LDS_BYTES = 73728;
constexpr int MISC_OFF = LDS_BYTES - 256;
constexpr int RS_OFF = 65536;
constexpr int TBL_OFF = 66048;
constexpr int EXP_OFF = 67584;

DEV unsigned cvtpk(float lo, float hi) { unsigned r; asm("v_cvt_pk_bf16_f32 %0, %1, %2" : "=v"(r) : "v"(lo), "v"(hi)); return r; }
DEV float bflo(unsigned w) { return __uint_as_float(w << 16); }
DEV float bfhi(unsigned w) { return __uint_as_float(w & 0xffff0000u); }
DEV float dpp_add_qp(float v, int) { return v; }
template <int CTRL> DEV float dpp_mov(float v) { return __builtin_bit_cast(float, __builtin_amdgcn_update_dpp(0, __builtin_bit_cast(int, v), CTRL, 0xf, 0xf, false)); }
DEV float wave_sum(float v) {
    v += dpp_mov<0xB1>(v);
    v += dpp_mov<0x4E>(v);
    v += dpp_mov<0x141>(v);
    v += dpp_mov<0x140>(v);
    const int iv = __builtin_bit_cast(int, v);
    const float a = __builtin_bit_cast(float, __builtin_amdgcn_readlane(iv, 0)), b = __builtin_bit_cast(float, __builtin_amdgcn_readlane(iv, 16));
    const float c = __builtin_bit_cast(float, __builtin_amdgcn_readlane(iv, 32)), d = __builtin_bit_cast(float, __builtin_amdgcn_readlane(iv, 48));
    return (a + b) + (c + d);
}
DEV float rsqrt_(float x) { return __builtin_amdgcn_rsqf(x); }
DEV void st_bf4(bf16_t* p, f32x4 v) { u32x2 w = {cvtpk(v[0], v[1]), cvtpk(v[2], v[3])}; *(u32x2*)p = w; }
DEV unsigned pk_fp8x4(float a, float b, float c, float d) {
    int w = __builtin_amdgcn_cvt_pk_fp8_f32(a, b, 0, false); w = __builtin_amdgcn_cvt_pk_fp8_f32(c, d, w, true); return (unsigned)w; }
DEV float fast_exp2(float x) { return __builtin_amdgcn_exp2f(x); }
DEV float fast_rcp(float x) { return __builtin_amdgcn_rcpf(x); }
DEV float sigmoidf_(float g) { return fast_rcp(1.f + fast_exp2(-1.4426950408889634f * g)); }
#define LDS_WAIT() asm volatile("s_waitcnt lgkmcnt(0)" ::: "memory")
#define VM_WAIT() asm volatile("s_waitcnt vmcnt(0)" ::: "memory")

#define XB_TMO      128
#define XB_XCNT(j)  (256  + 64 * (j))
#define XB_XSUB(j)  (1280 + 64 * (j))
#define XB_XGEN(j)  (2304 + 64 * (j))
#define XB_TOP      3328
#define XB_TOPGEN   3392
#define XCD_BAR_WORDS 3456
#define XB_SPIN_CAP (1u << 22)
DEV unsigned xb_ld(unsigned* p)              { return __hip_atomic_load(p, __ATOMIC_RELAXED, __HIP_MEMORY_SCOPE_AGENT); }
DEV unsigned xb_add(unsigned* p, unsigned v) { return __hip_atomic_fetch_add(p, v, __ATOMIC_RELAXED, __HIP_MEMORY_SCOPE_AGENT); }
DEV unsigned xb_xcc_id() { return (unsigned)__builtin_amdgcn_s_getreg((3 << 11) | 20) & 0xFu; }
#define XB_SPIN(cond, bar) do { unsigned _sp = 0; while (cond) { __builtin_amdgcn_s_sleep(1); \
    if ((++_sp & 255u) == 0u) { if (xb_ld(&(bar)[XB_TMO])) break; if (_sp > XB_SPIN_CAP) { atomicAdd(&(bar)[XB_TMO], 1u); break; } } } } while (0)
struct XcdBarrier { unsigned* bar; unsigned x; volatile LAS unsigned* st; };
DEV XcdBarrier xcd_barrier_post(unsigned* bar, volatile LAS unsigned* st) {
    XcdBarrier b; b.bar = bar; b.x = xb_xcc_id(); b.st = st;
    if (threadIdx.x == 0) (void)xb_add(&bar[XB_XCNT(b.x)], 1u);
    return b;
}
DEV void xcd_barrier_complete(unsigned* bar, unsigned x, unsigned& nloc, unsigned& nx) {
    const unsigned G = gridDim.x * gridDim.y * gridDim.z;
    unsigned sum, cnt, mine, sp = 0u;
    for (;;) {
        sum = 0u; cnt = 0u; mine = 0u;
#pragma unroll
        for (unsigned j = 0; j < 16; ++j) { const unsigned c = xb_ld(&bar[XB_XCNT(j)]); sum += c; cnt += (c > 0u) ? 1u : 0u; mine = (j == x) ? c : mine; }
        if (sum == G) break;
        __builtin_amdgcn_s_sleep(1);
        if ((++sp & 255u) == 0u) { if (xb_ld(&bar[XB_TMO])) break; if (sp > XB_SPIN_CAP) { atomicAdd(&bar[XB_TMO], 1u); break; } }
    }
    nloc = mine > 0u ? mine : 1u; nx = cnt > 0u ? cnt : 1u;
}
DEV void xcd_barrier(const XcdBarrier& b) {
    asm volatile("s_waitcnt vmcnt(0)" ::: "memory");
    __syncthreads();
    if (threadIdx.x == 0) {
        unsigned* bar = b.bar;
        __builtin_amdgcn_s_waitcnt(0);
        unsigned nloc = b.st[0], nx = b.st[1];
        if (nloc == 0u) { xcd_barrier_complete(bar, b.x, nloc, nx); b.st[0] = nloc; b.st[1] = nx; }
        const unsigned old = xb_add(&bar[XB_XSUB(b.x)], 1u);
        const unsigned gen = old / nloc;
        if (old + 1u == (gen + 1u) * nloc) {
            __builtin_amdgcn_fence(__ATOMIC_RELEASE, "agent");
            asm volatile("s_waitcnt vmcnt(0)" ::: "memory");
            const unsigned og = xb_add(&bar[XB_TOP], 1u);
            const unsigned tg = og / nx;
            if (og + 1u == (tg + 1u) * nx) xb_add(&bar[XB_TOPGEN], 1u);
            else XB_SPIN(xb_ld(&bar[XB_TOPGEN]) == tg, bar);
            __builtin_amdgcn_fence(__ATOMIC_ACQUIRE, "agent");
            xb_add(&bar[XB_XGEN(b.x)], 1u);
            asm volatile("s_waitcnt vmcnt(0)" ::: "memory");
        } else {
            XB_SPIN(xb_ld(&bar[XB_XGEN(b.x)]) == gen, bar);
            __builtin_amdgcn_fence(__ATOMIC_ACQUIRE, "agent");
            asm volatile("s_waitcnt vmcnt(0)" ::: "memory");
        }
    }
    __syncthreads();
}

struct Args { const float* in[27]; float* out; unsigned char* ws; int ph_lo, ph_hi; };
struct Ctx {
    const float* const* in; float* out; unsigned char* ws; unsigned char* lds;
    int tid, lane, wid, vcu, G;
};
enum { I_X = 0, I_META, I_LNIN_G, I_LNIN_B, I_WIN, I_CONVW, I_CONVB, I_CLN_G, I_CLN_B, I_QNG, I_WUQ, I_KVNG, I_WUKV, I_COUT_G, I_AOUT_G, I_WO,
       I_LN1G, I_LN1B, I_WRG, I_BRG, I_WRE, I_BRE, I_WGATE, I_WUP, I_WDOWN, I_LN2G, I_LN2B };

DEV int nmap(int mode, int n) {
    if (mode == 1) { if (n < 512) return ((n >> 4) << 5) + (n & 15); if (n < 1024) return (((n - 512) >> 4) << 5) + 16 + (n & 15); return n; }
    if (mode == 2) return ((n >> 4) << 5) + (n & 15);
    if (mode == 3) return ((n >> 4) << 5) + 16 + (n & 15);
    return n;
}
DEV void p0_transpose_item(const float* __restrict__ W, int N, int k0, int n0, const float* __restrict__ kscale, bf16_t* WT, int ldt, int kout0, int mode,
                           float* scr, int lane) {
#pragma unroll 8
    for (int i = 0; i < 32; ++i) {
        const int kk = 2 * i + (lane >> 5);
        float v = W[(size_t)(k0 + kk) * N + n0 + (lane & 31)];
        if (kscale) v *= kscale[k0 + kk];
        scr[kk * 33 + (lane & 31)] = v;
    }
    LDS_WAIT(); asm volatile("" ::: "memory");
    const int c = lane & 7;
#pragma unroll
    for (int j = 0; j < 4; ++j) {
        const int n = (lane >> 3) + 8 * j; const float* s = scr + (8 * c) * 33 + n;
        u32x4 o; o.x = cvtpk(s[0 * 33], s[1 * 33]); o.y = cvtpk(s[2 * 33], s[3 * 33]); o.z = cvtpk(s[4 * 33], s[5 * 33]); o.w = cvtpk(s[6 * 33], s[7 * 33]);
        *(u32x4*)(WT + (size_t)nmap(mode, n0 + n) * ldt + kout0 + 8 * c) = o;
    }
    LDS_WAIT(); asm volatile("" ::: "memory");
}
DEV void p0_transpose_item_f8(const float* __restrict__ W, int N, int k0, int n0, float scale, unsigned char* W8, int ldt, int kout0, int mode, float* scr, int lane) {
#pragma unroll 8
    for (int i = 0; i < 32; ++i) { const int kk = 2 * i + (lane >> 5); scr[kk * 33 + (lane & 31)] = W[(size_t)(k0 + kk) * N + n0 + (lane & 31)] * scale; }
    LDS_WAIT(); asm volatile("" ::: "memory");
    const int c = lane & 7;
#pragma unroll
    for (int j = 0; j < 4; ++j) {
        const int n = (lane >> 3) + 8 * j; const float* sp = scr + (8 * c) * 33 + n;
        u32x2 o; o.x = pk_fp8x4(sp[0 * 33], sp[1 * 33], sp[2 * 33], sp[3 * 33]); o.y = pk_fp8x4(sp[4 * 33], sp[5 * 33], sp[6 * 33], sp[7 * 33]);
        *(u32x2*)(W8 + (size_t)nmap(mode, n0 + n) * ldt + kout0 + 8 * c) = o;
    }
    LDS_WAIT(); asm volatile("" ::: "memory");
}
template <int N> DEV void wave_sum_n(float (&v)[N]) {
#pragma unroll
    for (int i = 0; i < N; ++i) v[i] = wave_sum(v[i]);
}
template <int NR, bool F8 = false, bool BFIN = false> DEV void ln_rows_bf16(const float* const (&xrow)[NR], const float* g, const float* bta, bf16_t* const (&orow)[NR], unsigned char* const (&ldsrow)[NR], int lane, unsigned char* const* f8row = nullptr) {
    f32x4 v[NR][4]; float s[NR];
#pragma unroll
    for (int r = 0; r < NR; ++r)
#pragma unroll
        for (int j = 0; j < 4; ++j) {
            if (BFIN) { const u32x2 w = ((const u32x2*)xrow[r])[64 * j + lane]; v[r][j] = (f32x4){bflo(w.x), bfhi(w.x), bflo(w.y), bfhi(w.y)}; }
            else v[r][j] = ((const f32x4*)xrow[r])[64 * j + lane]; }
#pragma unroll
    for (int r = 0; r < NR; ++r) { s[r] = 0.f;
#pragma unroll
        for (int j = 0; j < 4; ++j) s[r] += (v[r][j].x + v[r][j].y) + (v[r][j].z + v[r][j].w); }
    wave_sum_n<NR>(s);
    float s2[NR];
#pragma unroll
    for (int r = 0; r < NR; ++r) { const float mean = s[r] * (1.f / 1024.f); s2[r] = 0.f;
#pragma unroll
        for (int j = 0; j < 4; ++j) { v[r][j] = v[r][j] - mean; s2[r] += (v[r][j].x * v[r][j].x + v[r][j].y * v[r][j].y) + (v[r][j].z * v[r][j].z + v[r][j].w * v[r][j].w); } }
    wave_sum_n<NR>(s2);
#pragma unroll
    for (int j = 0; j < 4; ++j) {
        const f32x4 gg = ((const f32x4*)g)[64 * j + lane], bb = ((const f32x4*)bta)[64 * j + lane];
#pragma unroll
        for (int r = 0; r < NR; ++r) {
            const float rstd = rsqrt_(s2[r] * (1.f / 1024.f) + EPS);
            const f32x4 o = v[r][j] * rstd * gg + bb;
            const u32x2 w = {cvtpk(o.x, o.y), cvtpk(o.z, o.w)};
            ((u32x2*)orow[r])[64 * j + lane] = w;
            if (ldsrow[r]) ((u32x2*)ldsrow[r])[64 * j + lane] = w;
            if (F8) ((unsigned*)f8row[r])[64 * j + lane] = pk_fp8x4(o.x, o.y, o.z, o.w);
        }
    }
}
__device__ const float INVF[16] = {1.0f, 0.5623413251903491f, 0.31622776601683794f, 0.1778279410038923f, 0.1f, 0.05623413251903491f, 0.031622776601683794f,
    0.01778279410038923f, 0.01f, 0.005623413251903491f, 0.0031622776601683794f, 0.001778279410038923f, 0.001f, 0.0005623413251903491f, 0.00031622776601683794f, 0.0001778279410038923f};
DEV void sincos_d(double a, float& sn, float& cs) {
    const double TWO_PI = 6.283185307179586476925286766559;
    const double k = __builtin_rint(a / TWO_PI);
    const double r = a - k * TWO_PI;
    const double r2 = r * r;
    double st = r, ct = 1.0, ssum = r, csum = 1.0;
#pragma unroll 1
    for (int i = 1; i <= 14; ++i) {
        ct = -ct * r2 / (double)((2 * i - 1) * (2 * i));  csum += ct;
        st = -st * r2 / (double)((2 * i) * (2 * i + 1));  ssum += st;
    }
    sn = (float)ssum; cs = (float)csum;
}
DEV void ew_block(const float* __restrict__ W, int N, int k0, int n0, unsigned char* W8, int ldt, int mode, int lane) {
    const int q = lane & 15, kq = lane >> 4;
    const float* src = W + (size_t)(k0 + 16 * kq) * N + n0 + 4 * q;
    f32x4 v[16];
#pragma unroll
    for (int i = 0; i < 16; ++i) v[i] = *(const f32x4*)(src + (size_t)i * N);
#pragma unroll
    for (int j = 0; j < 4; ++j) {
        u32x4 o;
        o.x = pk_fp8x4(v[0][j] * WSCALE, v[1][j] * WSCALE, v[2][j] * WSCALE, v[3][j] * WSCALE);
        o.y = pk_fp8x4(v[4][j] * WSCALE, v[5][j] * WSCALE, v[6][j] * WSCALE, v[7][j] * WSCALE);
        o.z = pk_fp8x4(v[8][j] * WSCALE, v[9][j] * WSCALE, v[10][j] * WSCALE, v[11][j] * WSCALE);
        o.w = pk_fp8x4(v[12][j] * WSCALE, v[13][j] * WSCALE, v[14][j] * WSCALE, v[15][j] * WSCALE);
        *(u32x4*)(W8 + (size_t)nmap(mode, n0 + 4 * q + j) * ldt + k0 + 16 * kq) = o;
    }
}
DEV void expert_weight_item(const Ctx& c, int r, float*  ) {
    unsigned char* Wgu8 = c.ws + WS_WGU; unsigned char* Wd8 = c.ws + WS_WD;
    if (r < 2048) { const int e = r >> 6, qq = r & 63, kb = qq >> 2, nb = qq & 3;
        ew_block(c.in[I_WGATE] + (size_t)e * D * DE, DE, 64 * kb, 64 * nb, Wgu8 + (size_t)e * 512 * 1024, 1024, 2, c.lane); return; } r -= 2048;
    if (r < 2048) { const int e = r >> 6, qq = r & 63, kb = qq >> 2, nb = qq & 3;
        ew_block(c.in[I_WUP] + (size_t)e * D * DE, DE, 64 * kb, 64 * nb, Wgu8 + (size_t)e * 512 * 1024, 1024, 3, c.lane); return; } r -= 2048;
    { const int e = r >> 6, qq = r & 63, kb = qq >> 4, nb = qq & 15;
        ew_block(c.in[I_WDOWN] + (size_t)e * DE * D, D, 64 * kb, 64 * nb, Wd8 + (size_t)e * 1024 * 256, 256, 0, c.lane); }
}
DEV void phase0(const Ctx& c) {
    float* scr = (float*)(c.lds + c.wid * 8448);
    const int gw = c.vcu * 4 + c.wid, NGW = c.G * 4;
    constexpr int I_IN = 16 * 53, I_UQ = 6 * 24, I_UKV = 4 * 32, I_O = 16 * 32;
    bf16_t* WinT = (bf16_t*)(c.ws + WS_WIN); bf16_t* WuqT = (bf16_t*)(c.ws + WS_WUQ); bf16_t* WukvT = (bf16_t*)(c.ws + WS_WUKV);
    bf16_t* WoT = (bf16_t*)(c.ws + WS_WO);
    constexpr int NITEMS0 = I_IN + I_UQ + I_UKV + I_O;
    for (int it = gw; it < NITEMS0; it += NGW) {
        int r = it;
        if (r < I_IN) { const int kb = r / 53, nb = r % 53; p0_transpose_item(c.in[I_WIN], NIN, 64 * kb, 32 * nb, nullptr, WinT, 1024, 64 * kb, 1, scr, c.lane); continue; } r -= I_IN;
        if (r < I_UQ) { const int kb = r / 24, nb = r % 24; p0_transpose_item(c.in[I_WUQ], NQ, 64 * kb, 32 * nb, c.in[I_QNG], WuqT, QL, 64 * kb, 0, scr, c.lane); continue; } r -= I_UQ;
        if (r < I_UKV) { const int kb = r / 32, nb = r % 32; p0_transpose_item(c.in[I_WUKV], NKV, 64 * kb, 32 * nb, c.in[I_KVNG], WukvT, KVL, 64 * kb, 0, scr, c.lane); continue; } r -= I_UKV;
        { const int kb = r / 32, nb = r % 32;
            if (kb < 8) p0_transpose_item(c.in[I_WO], D, 64 * kb, 32 * nb, nullptr, WoT, 1024, 64 * kb + 512, 0, scr, c.lane);
            else        p0_transpose_item(c.in[I_WO], D, 64 * kb, 32 * nb, c.in[I_AOUT_G] - 512, WoT, 1024, 64 * kb - 512, 0, scr, c.lane); }
    }
    const int gt = c.vcu * 256 + c.tid, NGT = c.G * 256;
    bf16_t* WrT = (bf16_t*)(c.ws + WS_WR);
    for (int i = gt; i < 48 * 1024; i += NGT) {
        const int n = i >> 10, k = i & 1023; float v = 0.f;
        if (n < 4) v = c.in[I_WRG][k * 4 + n]; else if (n < 36) v = c.in[I_WRE][k * 32 + (n - 4)];
        WrT[i] = (bf16_t)(cvtpk(v, 0.f) & 0xffffu);
    }
    float* rc = (float*)(c.ws + WS_ROPE); float* rs = rc + L * 16;
    for (int i = gt; i < L * 16; i += NGT) {
        const int p = i >> 4, f = i & 15; const float ang = (float)p * INVF[f];
        float sn, cs; sincos_d((double)ang, sn, cs); rc[i] = cs; rs[i] = sn;
    }
    bf16_t* h0 = (bf16_t*)(c.ws + WS_H0);
    for (int t = gw; t < T; t += 2 * NGW) {
        const float* src[2]; bf16_t* dst[2]; unsigned char* ldsn[2] = {nullptr, nullptr};
#pragma unroll
        for (int r = 0; r < 2; ++r) { int tt = t + r * NGW; if (tt >= T) tt = t;
            const int b = tt / L, p = tt - b * L;
            src[r] = (p < NMETA) ? c.in[I_META] + (size_t)p * D : c.in[I_X] + ((size_t)b * SEQ + (p - NMETA)) * D;
            dst[r] = h0 + (size_t)tt * D; }
        ln_rows_bf16<2>(src, c.in[I_LNIN_G], c.in[I_LNIN_B], dst, ldsn, c.lane);
    }
}

struct StageGeo { int r[4]; int c; };
DEV StageGeo stage_geo(int tid) {
    const int lane = tid & 63, wid = tid >> 6; StageGeo g;
    const int rl = lane >> 2, cl = ((lane & 3) * 8) ^ ((lane >> 5) << 4);
#pragma unroll
    for (int i = 0; i < 4; ++i) g.r[i] = (((wid + 4 * i) >> 1) << 4) + rl;
    g.c = ((wid & 1) << 5) + cl;
    return g;
}
template <bool SSQ, bool FP8 = false>
DEV void gemm_mainloop(f32x4 (&acc)[4][4], const bf16_t* ap0, const bf16_t* ap1, const bf16_t* ap2, const bf16_t* ap3,
                       const bf16_t* bp0, const bf16_t* bp1, const bf16_t* bp2, const bf16_t* bp3,
                       int nk, unsigned char* lds, int ssq_steps, float ssq_inv_dim, bool skip_wc1 = false) {
    const int tid = threadIdx.x, lane = tid & 63, wid = tid >> 6, wr = wid >> 1, wc = wid & 1, fr = lane & 15, fq = lane >> 4;
    const int xs = (fr >> 1) & 7;
    const int lo = ((fr * 64 + fq * 16) ^ ((fr >> 3) << 5));
    const int lo0 = lo, lo1 = lo + 1024;
    const int a_off = wr * 8192, b_off = 16384 + wc * 8192;
    const int dst = tid * 16;
#pragma unroll
    for (int m = 0; m < 4; ++m)
#pragma unroll
        for (int n = 0; n < 4; ++n) acc[m][n] = (f32x4){0.f, 0.f, 0.f, 0.f};
    __syncthreads();
#define GLDS(src, off) __builtin_amdgcn_global_load_lds((const unsigned*)(src), (unsigned LAS*)(lds + (off)), 16, 0, 0)
#define STAGE(kt, b) do { const int _k = (kt) * 64; \
        GLDS(ap0 + _k, (b) * 32768 + dst);          GLDS(ap1 + _k, (b) * 32768 + dst + 4096); \
        GLDS(ap2 + _k, (b) * 32768 + dst + 8192);   GLDS(ap3 + _k, (b) * 32768 + dst + 12288); \
        GLDS(bp0 + _k, (b) * 32768 + 16384 + dst);  GLDS(bp1 + _k, (b) * 32768 + 16384 + dst + 4096); \
        GLDS(bp2 + _k, (b) * 32768 + 16384 + dst + 8192); GLDS(bp3 + _k, (b) * 32768 + 16384 + dst + 12288); } while (0)
    STAGE(0, 0);
    for (int kt = 0; kt < nk; ++kt) {
        VM_WAIT();
        __syncthreads();
        const int b = kt & 1;
        if (SSQ && kt == ssq_steps) {
            const float* rsl = (const float*)(lds + RS_OFF);
#pragma unroll
            for (int m = 0; m < 4; ++m) { const float r = rsl[wr * 64 + m * 16 + fr];
#pragma unroll
                for (int n = 0; n < 4; ++n) acc[m][n] = acc[m][n] * r; }
        }
        if (kt + 1 < nk) { if (b) STAGE(kt + 1, 0); else STAGE(kt + 1, 1); }
        const unsigned char* base = lds + b * 32768;
        if (skip_wc1 && wc == 1) {
        } else if (FP8) {
            const int cb0 = fq * 32, cb1 = fq * 32 + 16;
            const int q0 = (cb0 >> 6) * 1024 + ((fr * 64 + (cb0 & 63)) ^ ((fr >> 3) << 5)), q1 = (cb1 >> 6) * 1024 + ((fr * 64 + (cb1 & 63)) ^ ((fr >> 3) << 5));
            v8i ax[4], bx[4];
#pragma unroll
            for (int m = 0; m < 4; ++m) { const u32x4 c0 = *(const u32x4*)(base + a_off + m * 2048 + q0), c1 = *(const u32x4*)(base + a_off + m * 2048 + q1);
                ax[m] = (v8i){(int)c0.x, (int)c0.y, (int)c0.z, (int)c0.w, (int)c1.x, (int)c1.y, (int)c1.z, (int)c1.w}; }
#pragma unroll
            for (int n = 0; n < 4; ++n) { const u32x4 c0 = *(const u32x4*)(base + b_off + n * 2048 + q0), c1 = *(const u32x4*)(base + b_off + n * 2048 + q1);
                bx[n] = (v8i){(int)c0.x, (int)c0.y, (int)c0.z, (int)c0.w, (int)c1.x, (int)c1.y, (int)c1.z, (int)c1.w}; }
#pragma unroll
            for (int m = 0; m < 4; ++m)
#pragma unroll
                for (int n = 0; n < 4; ++n) acc[m][n] = __builtin_amdgcn_mfma_scale_f32_16x16x128_f8f6f4(bx[n], ax[m], acc[m][n], 0, 0, 0, 0x7F7F7F7F, 0, 0x7F7F7F7F);
        } else {
#pragma unroll
        for (int ks = 0; ks < 2; ++ks) {
            bf16x8 af[4], bf[4];
#pragma unroll
            for (int m = 0; m < 4; ++m) af[m] = *(const bf16x8*)(base + a_off + m * 2048 + (ks ? lo1 : lo0));
#pragma unroll
            for (int n = 0; n < 4; ++n) bf[n] = *(const bf16x8*)(base + b_off + n * 2048 + (ks ? lo1 : lo0));
#pragma unroll
            for (int m = 0; m < 4; ++m)
#pragma unroll
                for (int n = 0; n < 4; ++n) acc[m][n] = __builtin_amdgcn_mfma_f32_16x16x32_bf16(bf[n], af[m], acc[m][n], 0, 0, 0);
        }
        }
    }
    if (SSQ && ssq_steps == nk) {
        __syncthreads();
        const float* rsl = (const float*)(lds + RS_OFF);
#pragma unroll
        for (int m = 0; m < 4; ++m) { const float r = rsl[wr * 64 + m * 16 + fr];
#pragma unroll
            for (int n = 0; n < 4; ++n) acc[m][n] = acc[m][n] * r; }
    }
#undef STAGE
#undef GLDS
}

DEV void phase1(const Ctx& c) {
    const bf16_t* h0 = (const bf16_t*)(c.ws + WS_H0); const bf16_t* WinT = (const bf16_t*)(c.ws + WS_WIN);
    bf16_t* U = (bf16_t*)(c.ws + WS_U); bf16_t* CQ = (bf16_t*)(c.ws + WS_CQ); bf16_t* CKV = (bf16_t*)(c.ws + WS_CKV); bf16_t* KR = (bf16_t*)(c.ws + WS_KR);
    const float* rc = (const float*)(c.ws + WS_ROPE); const float* rs = rc + L * 16;
    const StageGeo g = stage_geo(c.tid);
    const int lane = c.lane, wr = c.wid >> 1, wc = c.wid & 1, fr = lane & 15, fq = lane >> 4;
    constexpr int NT = 14, NU = (T / 128) * NT;
    for (int u = c.vcu; u < NU; u += c.G) {
        const int mt = u / NT, nt = u - mt * NT;
        const bf16_t* A = h0 + (size_t)(mt * 128) * D + g.c; const bf16_t* B = WinT + (size_t)(nt * 128) * D + g.c;
        f32x4 acc[4][4];
        gemm_mainloop<false>(acc, A + (size_t)g.r[0] * D, A + (size_t)g.r[1] * D, A + (size_t)g.r[2] * D, A + (size_t)g.r[3] * D,
                             B + (size_t)g.r[0] * D, B + (size_t)g.r[1] * D, B + (size_t)g.r[2] * D, B + (size_t)g.r[3] * D, 16, c.lds, 0, 0.f, nt == 13);
        const int row0 = mt * 128 + wr * 64 + fr;
        if (nt < 8) {
#pragma unroll
            for (int m = 0; m < 4; ++m) { const size_t row = row0 + m * 16;
#pragma unroll
                for (int i = 0; i < 2; ++i) {
                    f32x4 a = acc[m][2 * i], gt = acc[m][2 * i + 1], o;
#pragma unroll
                    for (int j = 0; j < 4; ++j) o[j] = a[j] * sigmoidf_(gt[j]);
                    st_bf4(U + row * CC + nt * 64 + wc * 32 + i * 16 + fq * 4, o);
                } }
        } else if (nt < 13) {
            const bool isq = nt < 11;
            bf16_t* dstb = isq ? CQ + (nt - 8) * 128 + wc * 64 + fq * 4 : CKV + (nt - 11) * 128 + wc * 64 + fq * 4;
            const int ldd = isq ? QL : KVL;
            float* ssb = isq ? (float*)(c.ws + WS_SSQ_CQ) + (nt - 8) * 2 + wc : (float*)(c.ws + WS_SSQ_CKV) + (nt - 11) * 2 + wc;
            const int lds_ = isq ? 8 : 4;
#pragma unroll
            for (int m = 0; m < 4; ++m) { const size_t row = row0 + m * 16; float sq = 0.f;
#pragma unroll
                for (int n = 0; n < 4; ++n) { st_bf4(dstb + row * ldd + n * 16, acc[m][n]);
                    sq += (acc[m][n][0] * acc[m][n][0] + acc[m][n][1] * acc[m][n][1]) + (acc[m][n][2] * acc[m][n][2] + acc[m][n][3] * acc[m][n][3]); }
                sq += __shfl_xor(sq, 16); sq += __shfl_xor(sq, 32);
                if (fq == 0) ssb[row * lds_] = sq; }
        } else if (wc == 0) {
#pragma unroll
            for (int m = 0; m < 4; ++m) { const int row = row0 + m * 16; const int p = row % L;
                const f32x4 cs = *(const f32x4*)(rc + p * 16 + fq * 4), sn = *(const f32x4*)(rs + p * 16 + fq * 4);
                const f32x4 x1 = acc[m][0], x2 = acc[m][1];
                st_bf4(KR + (size_t)row * 32 + fq * 4, x1 * cs - x2 * sn);
                st_bf4(KR + (size_t)row * 32 + 16 + fq * 4, x1 * sn + x2 * cs); }
        }
    }
}

DEV void conv_unit(const Ctx& c, int b, int j) {
    const bf16_t* U = (const bf16_t*)(c.ws + WS_U);
    bf16_t* MG = (bf16_t*)(c.ws + WS_MG);
    const float* cw = c.in[I_CONVW]; const float* cb = c.in[I_CONVB];
    const int p0 = NMETA + j * 32;
    float* ytile = (float*)c.lds;
    __syncthreads();
#pragma unroll 1
    for (int pass = 0; pass < 2; ++pass) {
        const int ch = c.tid + 256 * pass;
        float win[62]; unsigned raw[62];
        const bf16_t* ub = U + (size_t)b * L * CC + ch;
#pragma unroll
        for (int rep = 0; rep < CONV_REPA; ++rep) {
        asm volatile("" : "+v"(ub) :: "memory");
#pragma unroll
        for (int i = 0; i < 62; ++i) { const int p = p0 - 30 + i; const int pc = p < 0 ? 0 : (p >= L ? L - 1 : p); raw[i] = ub[(size_t)pc * CC]; }
        if (rep + 1 < CONV_REPA) {
#pragma unroll
            for (int i = 0; i < 62; ++i) asm volatile("" :: "v"(raw[i]));
        }
        }
        float w[31];
#pragma unroll
        for (int k = 0; k < 31; ++k) w[k] = cw[k * CC + ch];
        float bias = cb[ch];
        __builtin_amdgcn_sched_barrier(0);
#pragma unroll
        for (int i = 0; i < 62; ++i) { const int p = p0 - 30 + i; win[i] = (p >= 0 && p < L) ? __uint_as_float(raw[i] << 16) : 0.f; }
#pragma unroll
        for (int rep = 0; rep < CONV_REPB; ++rep) {
        asm volatile("" : "+v"(bias) :: "memory");
#pragma unroll
        for (int tt = 0; tt < 32; ++tt) {
            float a0 = bias;
#pragma unroll
            for (int k = 0; k < 31; ++k) a0 += w[k] * win[tt + k];
            ytile[tt * 512 + ch] = a0;
        }
        }
    }
    __syncthreads();
    const float* g1 = c.in[I_CLN_G]; const float* b1 = c.in[I_CLN_B]; const float* g2 = c.in[I_COUT_G];
    float G1[8], B1[8], G2[8];
    { const f32x4 a = *(const f32x4*)(g1 + c.lane * 8), bq = *(const f32x4*)(g1 + c.lane * 8 + 4); G1[0]=a.x;G1[1]=a.y;G1[2]=a.z;G1[3]=a.w;G1[4]=bq.x;G1[5]=bq.y;G1[6]=bq.z;G1[7]=bq.w; }
    { const f32x4 a = *(const f32x4*)(b1 + c.lane * 8), bq = *(const f32x4*)(b1 + c.lane * 8 + 4); B1[0]=a.x;B1[1]=a.y;B1[2]=a.z;B1[3]=a.w;B1[4]=bq.x;B1[5]=bq.y;B1[6]=bq.z;B1[7]=bq.w; }
    { const f32x4 a = *(const f32x4*)(g2 + c.lane * 8), bq = *(const f32x4*)(g2 + c.lane * 8 + 4); G2[0]=a.x;G2[1]=a.y;G2[2]=a.z;G2[3]=a.w;G2[4]=bq.x;G2[5]=bq.y;G2[6]=bq.z;G2[7]=bq.w; }
#pragma unroll
    for (int rep = 0; rep < CONV_REPC; ++rep) {
    asm volatile("" : "+v"(ytile) :: "memory");
    float v[8][8]; float st[8];
#pragma unroll
    for (int i = 0; i < 8; ++i) { const int tt = c.wid * 8 + i;
        const f32x4 ya = *(const f32x4*)(ytile + tt * 512 + c.lane * 8), yb = *(const f32x4*)(ytile + tt * 512 + c.lane * 8 + 4);
        v[i][0]=ya.x;v[i][1]=ya.y;v[i][2]=ya.z;v[i][3]=ya.w;v[i][4]=yb.x;v[i][5]=yb.y;v[i][6]=yb.z;v[i][7]=yb.w;
        st[i] = ((v[i][0] + v[i][1]) + (v[i][2] + v[i][3])) + ((v[i][4] + v[i][5]) + (v[i][6] + v[i][7])); }
    wave_sum_n<8>(st);
#pragma unroll
    for (int i = 0; i < 8; ++i) { const float mean = st[i] * (1.f / 512.f); float a = 0.f;
#pragma unroll
        for (int q = 0; q < 8; ++q) { v[i][q] -= mean; a += v[i][q] * v[i][q]; }
        st[i] = a; }
    wave_sum_n<8>(st);
#pragma unroll
    for (int i = 0; i < 8; ++i) { const float rstd = rsqrt_(st[i] * (1.f / 512.f) + EPS); float a = 0.f;
#pragma unroll
        for (int q = 0; q < 8; ++q) { const float x = v[i][q] * rstd * G1[q] + B1[q]; const float y = x * sigmoidf_(x); v[i][q] = y; a += y * y; }
        st[i] = a; }
    wave_sum_n<8>(st);
#pragma unroll
    for (int i = 0; i < 8; ++i) {
        const int p = p0 + c.wid * 8 + i;
        {
            const float r2 = rsqrt_(st[i] * (1.f / 512.f) + EPS);
            u32x4 o;
            o.x = cvtpk(v[i][0] * r2 * G2[0], v[i][1] * r2 * G2[1]); o.y = cvtpk(v[i][2] * r2 * G2[2], v[i][3] * r2 * G2[3]);
            o.z = cvtpk(v[i][4] * r2 * G2[4], v[i][5] * r2 * G2[5]); o.w = cvtpk(v[i][6] * r2 * G2[6], v[i][7] * r2 * G2[7]);
            const size_t tok = (size_t)b * SEQ + (p - NMETA);
            bf16_t* dstp = (p >= NMETA && p < L) ? MG + tok * D + 512 + c.lane * 8 : (bf16_t*)(c.ws + WS_DUMMY) + c.lane * 8;
            *(u32x4*)dstp = o;
        }
    }
    }
}
DEV void rope4(f32x4& x1, f32x4& x2, const float* rc, const float* rs, int p, int fq) {
    const f32x4 cs = *(const f32x4*)(rc + p * 16 + fq * 4), sn = *(const f32x4*)(rs + p * 16 + fq * 4);
    const f32x4 a = x1 * cs - x2 * sn, bb = x1 * sn + x2 * cs; x1 = a; x2 = bb;
}
DEV void phase2(const Ctx& c) {
    const bf16_t* CQ = (const bf16_t*)(c.ws + WS_CQ); const bf16_t* CKV = (const bf16_t*)(c.ws + WS_CKV);
    const bf16_t* WuqT = (const bf16_t*)(c.ws + WS_WUQ); const bf16_t* WukvT = (const bf16_t*)(c.ws + WS_WUKV);
    bf16_t* Q = (bf16_t*)(c.ws + WS_Q); bf16_t* KV = (bf16_t*)(c.ws + WS_KV);
    const float* rc = (const float*)(c.ws + WS_ROPE); const float* rs = rc + L * 16;
    const StageGeo g = stage_geo(c.tid);
    const int lane = c.lane, wr = c.wid >> 1, wc = c.wid & 1, fr = lane & 15, fq = lane >> 4;
    constexpr int NUC = NB * 64, NUQ = (TR / 128) * 6, NUKV = (TR / 128) * 8 + 8, NU = NUC + NUQ + NUKV;
    for (int u = c.vcu; u < NU; u += c.G) {
        if (u < NUC) {
            conv_unit(c, u >> 6, u & 63);
        } else if (u < NUC + NUQ) {
            const int v = u - NUC, mt = v / 6, nt = v - mt * 6;
            const size_t t0 = (size_t)(mt >> 4) * L + NMETA + (mt & 15) * 128;
            const bf16_t* A = CQ + t0 * QL + g.c; const bf16_t* B = WuqT + (size_t)(nt * 128) * QL + g.c;
            f32x4 acc[4][4];
            __syncthreads();
            if (c.tid < 128) { const float* pp = (const float*)(c.ws + WS_SSQ_CQ) + (t0 + c.tid) * 8; const f32x4 p4 = *(const f32x4*)pp; const float2 p2 = *(const float2*)(pp + 4);
                ((float*)(c.lds + RS_OFF))[c.tid] = rsqrt_((((p4.x + p4.y) + (p4.z + p4.w)) + (p2.x + p2.y)) * (1.f / 384.f) + EPS); }
            gemm_mainloop<true>(acc, A + (size_t)g.r[0] * QL, A + (size_t)g.r[1] * QL, A + (size_t)g.r[2] * QL, A + (size_t)g.r[3] * QL,
                                B + (size_t)g.r[0] * QL, B + (size_t)g.r[1] * QL, B + (size_t)g.r[2] * QL, B + (size_t)g.r[3] * QL, 6, c.lds, 6, 1.f / 384.f);
            const int p0 = NMETA + (mt & 15) * 128 + wr * 64 + fr;
            const int t16 = (nt * 8 + wc * 4) % 6;
#pragma unroll
            for (int m = 0; m < 4; ++m) { const size_t row = t0 + wr * 64 + m * 16 + fr; const int p = p0 + m * 16;
#pragma unroll
                for (int n = 0; n < 4; ++n) acc[m][n] = acc[m][n] * QSCALE;
                if (t16 == 4) rope4(acc[m][0], acc[m][1], rc, rs, p, fq);
                if (t16 == 2) rope4(acc[m][2], acc[m][3], rc, rs, p, fq);
#pragma unroll
                for (int n = 0; n < 4; ++n) st_bf4(Q + row * NQ + nt * 128 + wc * 64 + n * 16 + fq * 4, acc[m][n]); }
        } else {
            const int v = u - NUC - NUQ; const bool meta = v >= (TR / 128) * 8;
            const int mt = meta ? 0 : v >> 3, nt = meta ? v - (TR / 128) * 8 : v & 7;
            const size_t t0 = meta ? 0 : (size_t)(mt >> 4) * L + NMETA + (mt & 15) * 128;
            const int rmask = meta ? 15 : 127;
            const bf16_t* A = CKV + t0 * KVL + g.c; const bf16_t* B = WukvT + (size_t)(nt * 128) * KVL + g.c;
            f32x4 acc[4][4];
            __syncthreads();
            if (c.tid < 128) { const f32x4 p4 = *(const f32x4*)((const float*)(c.ws + WS_SSQ_CKV) + (t0 + (c.tid & rmask)) * 4);
                ((float*)(c.lds + RS_OFF))[c.tid] = rsqrt_(((p4.x + p4.y) + (p4.z + p4.w)) * (1.f / 256.f) + EPS); }
            gemm_mainloop<true>(acc, A + (size_t)(g.r[0] & rmask) * KVL, A + (size_t)(g.r[1] & rmask) * KVL, A + (size_t)(g.r[2] & rmask) * KVL, A + (size_t)(g.r[3] & rmask) * KVL,
                                B + (size_t)g.r[0] * KVL, B + (size_t)g.r[1] * KVL, B + (size_t)g.r[2] * KVL, B + (size_t)g.r[3] * KVL, 4, c.lds, 4, 1.f / 256.f);
            if (!meta) {
#pragma unroll
                for (int m = 0; m < 4; ++m) { const size_t row = t0 + wr * 64 + m * 16 + fr;
#pragma unroll
                    for (int n = 0; n < 4; ++n) st_bf4(KV + row * NKV + nt * 128 + wc * 64 + n * 16 + fq * 4, acc[m][n]); }
            } else if (wr == 0) {
#pragma unroll 1
                for (int bb = 0; bb < NB; ++bb) {
#pragma unroll
                    for (int n = 0; n < 4; ++n) st_bf4(KV + ((size_t)bb * L + fr) * NKV + nt * 128 + wc * 64 + n * 16 + fq * 4, acc[0][n]); }
            }
        }
    }
}
DEV int crow(int r, int hi) { return (r & 3) + 8 * (r >> 2) + 4 * hi; }
#define KSWZ(row, colB) ((row) * 256 + ((colB) ^ (((row) & 7) << 4)))
#define SBAR() __builtin_amdgcn_sched_barrier(0)
DEV int v_st(int k, int cc) { const int kk = (k & ~0xC) | ((k & 4) << 1) | ((k & 8) >> 1); return ((kk >> 3) * 4 + (cc >> 5)) * 512 + ((kk & 7) * 32 + (cc & 31)) * 2; }
DEV int v_rd_base(int lane) { return ((lane & 3) << 3) | (((lane >> 2) & 3) << 6) | (((lane >> 4) & 1) << 5) | (((lane >> 5) & 1) << 8); }
constexpr int v_rd_off(int d0, int ks, int half) { return d0 * 512 + ks * 4096 + half * 2048; }
template <int OFF> DEV s16x4 tr_read(int vb) { s16x4 r; asm volatile("ds_read_b64_tr_b16 %0, %1 offset:%2" : "=&v"(r) : "v"(vb), "i"(OFF) : "memory"); return r; }
template <int D0> DEV void pv_one(f32x16& od, int vb, bf16x8 pa0, bf16x8 pa1, bf16x8 pa2, bf16x8 pa3) {
    const s16x4 l0 = tr_read<v_rd_off(D0, 0, 0)>(vb), h0 = tr_read<v_rd_off(D0, 0, 1)>(vb), l1 = tr_read<v_rd_off(D0, 1, 0)>(vb), h1 = tr_read<v_rd_off(D0, 1, 1)>(vb);
    const s16x4 l2 = tr_read<v_rd_off(D0, 2, 0)>(vb), h2 = tr_read<v_rd_off(D0, 2, 1)>(vb), l3 = tr_read<v_rd_off(D0, 3, 0)>(vb), h3 = tr_read<v_rd_off(D0, 3, 1)>(vb);
    asm volatile("s_waitcnt lgkmcnt(0)" ::: "memory"); SBAR();
#define PK(Lo, Hi) (bf16x8){Lo[0], Lo[1], Lo[2], Lo[3], Hi[0], Hi[1], Hi[2], Hi[3]}
    od = __builtin_amdgcn_mfma_f32_32x32x16_bf16(pa0, PK(l0, h0), od, 0, 0, 0);
    od = __builtin_amdgcn_mfma_f32_32x32x16_bf16(pa1, PK(l1, h1), od, 0, 0, 0);
    od = __builtin_amdgcn_mfma_f32_32x32x16_bf16(pa2, PK(l2, h2), od, 0, 0, 0);
    od = __builtin_amdgcn_mfma_f32_32x32x16_bf16(pa3, PK(l3, h3), od, 0, 0, 0);
#undef PK
}
constexpr float ATT_THR = 8.f;
constexpr int AT_V = 0, AT_K = 32768, AT_WS = 65536;
DEV void attn_unit(const Ctx& c, int b, int h, int qb) {
    const bf16_t* Q = (const bf16_t*)(c.ws + WS_Q); const bf16_t* KV = (const bf16_t*)(c.ws + WS_KV); const bf16_t* KR = (const bf16_t*)(c.ws + WS_KR);
    bf16_t* MG = (bf16_t*)(c.ws + WS_MG);
    unsigned char* lds = c.lds;
    const int tid = c.tid, wid = c.wid, lane = c.lane, r32 = lane & 31, hi = lane >> 5;
    float* wsf = (float*)(lds + AT_WS) + wid * 64; float* li_l = wsf; float* al_l = wsf + 32;
    const int NT = 2 * qb + 3;
    const int my_last = 2 * qb + (wid >> 1) + 1;
    bf16x8 qr[6];
    { const size_t t = (size_t)b * L + NMETA + qb * 128 + wid * 32 + r32;
      const bf16_t* Qw = Q + t * NQ + h * DQK + hi * 8;
#pragma unroll
      for (int d0 = 0; d0 < 6; ++d0) qr[d0] = *(const bf16x8*)(Qw + d0 * 16); }
    const int srow = tid >> 2, sq = tid & 3;
    const int vst0 = v_st(srow, sq * 16), vst1 = v_st(srow, sq * 16 + 8);
    const int kst0 = KSWZ(srow, sq * 32), kst1 = KSWZ(srow, sq * 32 + 16), kst2 = KSWZ(srow, 128 + sq * 16);
    const int vb0 = (int)(uintptr_t)(lds + AT_V) + v_rd_base(lane);
    u32x4 sk0, sk1, sk2, sv0, sv1;
#define SLOAD(j) do { int pos = (j) * 64 + srow - 48; pos = pos < 0 ? 0 : pos; const size_t tk = (size_t)b * L + pos; \
        const bf16_t* kvp = KV + tk * NKV + h * 128 + sq * 16; \
        sk0 = *(const u32x4*)(kvp); sk1 = *(const u32x4*)(kvp + 8); sv0 = *(const u32x4*)(kvp + 64); sv1 = *(const u32x4*)(kvp + 72); \
        sk2 = *(const u32x4*)(KR + tk * 32 + sq * 8); } while (0)
#define SWRITE(bb) do { unsigned char* kb = lds + AT_K + (bb) * 16384; unsigned char* vbp = lds + AT_V + (bb) * 16384; \
        *(u32x4*)(kb + kst0) = sk0; *(u32x4*)(kb + kst1) = sk1; *(u32x4*)(kb + kst2) = sk2; *(u32x4*)(vbp + vst0) = sv0; *(u32x4*)(vbp + vst1) = sv1; } while (0)
    float m_reg = 0.f, l_reg = 0.f; f32x16 o[2] = {};
    __syncthreads();
    SLOAD(0); SWRITE(0); __syncthreads();
    for (int j = 0; j < NT; ++j) {
        const int bsel = j & 1;
        if (j + 1 < NT) SLOAD(j + 1);
        if (j <= my_last) {
            const unsigned char* Ks = lds + AT_K + bsel * 16384;
            f32x16 p0, p1;
            { const float nm = -m_reg;
#pragma unroll
              for (int r = 0; r < 16; ++r) { p0[r] = nm; p1[r] = nm; } }
            __builtin_amdgcn_s_setprio(1);
#pragma unroll
            for (int d0 = 0; d0 < 6; ++d0) { const int cb = (d0 * 16 + hi * 8) * 2;
                const bf16x8 k0 = *(const bf16x8*)(Ks + KSWZ(r32, cb)); const bf16x8 k1 = *(const bf16x8*)(Ks + KSWZ(32 + r32, cb));
                p0 = __builtin_amdgcn_mfma_f32_32x32x16_bf16(k0, qr[d0], p0, 0, 0, 0);
                p1 = __builtin_amdgcn_mfma_f32_32x32x16_bf16(k1, qr[d0], p1, 0, 0, 0); }
            __builtin_amdgcn_s_setprio(0);
            if (j == 0) {
#pragma unroll
                for (int r = 0; r < 16; ++r) p0[r] = -1e30f;
#pragma unroll
                for (int r = 0; r < 8; ++r) p1[r] = -1e30f;
            }
            float pmax = fmaxf(fmaxf(p0[0], p0[1]), p0[2]);
#pragma unroll
            for (int r = 3; r < 15; r += 2) pmax = fmaxf(fmaxf(pmax, p0[r]), p0[r + 1]);
            pmax = fmaxf(fmaxf(pmax, p0[15]), p1[0]);
#pragma unroll
            for (int r = 1; r < 15; r += 2) pmax = fmaxf(fmaxf(pmax, p1[r]), p1[r + 1]);
            pmax = fmaxf(pmax, p1[15]);
            { auto rr = __builtin_amdgcn_permlane32_swap(__float_as_uint(pmax), __float_as_uint(pmax), false, false);
              pmax = fmaxf(__uint_as_float(rr[0]), __uint_as_float(rr[1])); }
            float ps = 0.f;
            if (__any(pmax > ATT_THR)) {
                const float dm = fmaxf(pmax, 0.f), alpha = fast_exp2(-dm); m_reg += dm;
#pragma unroll
                for (int r = 0; r < 16; ++r) { p0[r] -= dm; p1[r] -= dm; }
                l_reg *= alpha;
                if (hi == 0) al_l[r32] = alpha;
                asm volatile("s_waitcnt lgkmcnt(0)" ::: "memory");
#pragma unroll
                for (int r = 0; r < 16; ++r) { const float a = al_l[crow(r, hi)]; o[0][r] *= a; o[1][r] *= a; }
            }
#pragma unroll
            for (int r = 0; r < 16; ++r) { p0[r] = fast_exp2(p0[r]); ps += p0[r]; }
#pragma unroll
            for (int r = 0; r < 16; ++r) { p1[r] = fast_exp2(p1[r]); ps += p1[r]; }
            { auto rr = __builtin_amdgcn_permlane32_swap(__float_as_uint(ps), __float_as_uint(ps), false, false);
              ps = __uint_as_float(rr[0]) + __uint_as_float(rr[1]); }
            l_reg += ps;
            bf16x8 pa0, pa1, pa2, pa3;
#define PK4(P, BASE, OUT) do { unsigned a0 = cvtpk(P[BASE + 0], P[BASE + 1]), a1 = cvtpk(P[BASE + 2], P[BASE + 3]);   \
    unsigned b0 = cvtpk(P[BASE + 4], P[BASE + 5]), b1 = cvtpk(P[BASE + 6], P[BASE + 7]);                              \
    auto r0 = __builtin_amdgcn_permlane32_swap(a0, b0, false, false); auto r1 = __builtin_amdgcn_permlane32_swap(a1, b1, false, false); \
    u32x4 w = {r0[0], r1[0], r0[1], r1[1]}; OUT = *reinterpret_cast<bf16x8*>(&w); } while (0)
            PK4(p0, 0, pa0); PK4(p0, 8, pa1); PK4(p1, 0, pa2); PK4(p1, 8, pa3);
#undef PK4
            const int vb = vb0 + bsel * 16384;
            __builtin_amdgcn_s_setprio(1);
            pv_one<0>(o[0], vb, pa0, pa1, pa2, pa3); pv_one<1>(o[1], vb, pa0, pa1, pa2, pa3);
            __builtin_amdgcn_s_setprio(0);
        }
        if (j + 1 < NT) { if (bsel) SWRITE(0); else SWRITE(1); }
        __syncthreads();
    }
    if (hi == 0) li_l[r32] = l_reg;
    asm volatile("s_waitcnt lgkmcnt(0)" ::: "memory");
    const size_t tok0 = (size_t)b * SEQ + qb * 128 + wid * 32;
    float* SSO = (float*)(c.ws + WS_SSQ_O);
#pragma unroll
    for (int r = 0; r < 16; ++r) {
        const int orow = crow(r, hi); const float rl = fast_rcp(li_l[orow]);
        bf16_t* dst = MG + (tok0 + orow) * D + h * DV + r32;
        const float a0 = o[0][r] * rl, a1 = o[1][r] * rl;
        dst[0]  = (bf16_t)(cvtpk(a0, 0.f) & 0xffffu);
        dst[32] = (bf16_t)(cvtpk(a1, 0.f) & 0xffffu);
        float sq = a0 * a0 + a1 * a1;
        sq += dpp_mov<0xB1>(sq); sq += dpp_mov<0x4E>(sq); sq += dpp_mov<0x141>(sq); sq += dpp_mov<0x140>(sq);
        sq += __shfl_xor(sq, 16);
        if (r32 == 0) SSO[(tok0 + orow) * 8 + h] = sq;
    }
#undef SLOAD
#undef SWRITE
}
DEV void phase3(const Ctx& c) {
    const int nslots = NB * NH * 4;
    float* scr = (float*)(c.lds + c.wid * 8448);
    const int gw = c.vcu * 4 + c.wid, NGW = c.G * 4;
    constexpr int NWI = 6144;
    int wi = gw;
#define EW_ITEMS(n) do { __syncthreads(); for (int _q = 0; _q < (n) && wi < NWI; ++_q, wi += NGW) expert_weight_item(c, wi, scr); } while (0)
    for (int v = c.vcu; v < nslots; v += c.G) {
        const int bh = v >> 2, s = v & 3, b = bh >> 3, h = bh & 7;
        attn_unit(c, b, h, 15 - s); EW_ITEMS(1); attn_unit(c, b, h, s); EW_ITEMS(1); attn_unit(c, b, h, 11 - s); EW_ITEMS(1); attn_unit(c, b, h, 4 + s);
    }
    __syncthreads();
    for (; wi < NWI; wi += NGW) expert_weight_item(c, wi, scr);
#undef EW_ITEMS
}

DEV void phase4(const Ctx& c) {
    const bf16_t* MG = (const bf16_t*)(c.ws + WS_MG); const bf16_t* WoT = (const bf16_t*)(c.ws + WS_WO); const bf16_t* h0 = (const bf16_t*)(c.ws + WS_H0);
    bf16_t* R1 = (bf16_t*)(c.ws + WS_R1);
    const StageGeo g = stage_geo(c.tid);
    const int lane = c.lane, wr = c.wid >> 1, wc = c.wid & 1, fr = lane & 15, fq = lane >> 4;
    constexpr int NU = (TR / 128) * 8;
    const float* SSO = (const float*)(c.ws + WS_SSQ_O);
    f32x4 pa = {1.f, 1.f, 1.f, 1.f}, pb = pa;
    if (c.vcu < NU && c.tid < 128) { const float* pp = SSO + (size_t)((c.vcu >> 3) * 128 + c.tid) * 8; pa = *(const f32x4*)pp; pb = *(const f32x4*)(pp + 4); }
    for (int u = c.vcu; u < NU; u += c.G) {
        const int mt = u >> 3, nt = u & 7;
        const bf16_t* A = MG + (size_t)(mt * 128) * D + g.c; const bf16_t* B = WoT + (size_t)(nt * 128) * D + g.c;
        f32x4 acc[4][4];
        __syncthreads();
        if (c.tid < 128) ((float*)(c.lds + RS_OFF))[c.tid] = rsqrt_((((pa.x + pa.y) + (pa.z + pa.w)) + ((pb.x + pb.y) + (pb.z + pb.w))) * (1.f / 512.f) + EPS);
        { const int un = u + c.G; if (un < NU && c.tid < 128) { const float* pp = SSO + (size_t)((un >> 3) * 128 + c.tid) * 8; pa = *(const f32x4*)pp; pb = *(const f32x4*)(pp + 4); } }
        u32x2 hw[4][4];
#pragma unroll
        for (int m = 0; m < 4; ++m) {
            const int tok = mt * 128 + wr * 64 + m * 16 + fr;
            const size_t t = (size_t)(tok >> 11) * L + NMETA + (tok & 2047);
#pragma unroll
            for (int n = 0; n < 4; ++n) hw[m][n] = *(const u32x2*)(h0 + t * D + nt * 128 + wc * 64 + n * 16 + fq * 4);
        }
        gemm_mainloop<true>(acc, A + (size_t)g.r[0] * D, A + (size_t)g.r[1] * D, A + (size_t)g.r[2] * D, A + (size_t)g.r[3] * D,
                            B + (size_t)g.r[0] * D, B + (size_t)g.r[1] * D, B + (size_t)g.r[2] * D, B + (size_t)g.r[3] * D, 16, c.lds, 8, 1.f / 512.f);
#pragma unroll
        for (int m = 0; m < 4; ++m) {
            const int tok = mt * 128 + wr * 64 + m * 16 + fr;
#pragma unroll
            for (int n = 0; n < 4; ++n) {
                const int col = nt * 128 + wc * 64 + n * 16 + fq * 4;
                f32x4 o; o[0] = ALPHA * bflo(hw[m][n].x) + acc[m][n][0]; o[1] = ALPHA * bfhi(hw[m][n].x) + acc[m][n][1];
                o[2] = ALPHA * bflo(hw[m][n].y) + acc[m][n][2]; o[3] = ALPHA * bfhi(hw[m][n].y) + acc[m][n][3];
                st_bf4(R1 + (size_t)tok * D + col, o);
            }
        }
    }
}

constexpr int P5_ROWB = 2064, P5_PART = 33280, P5_LG = 45568, P5_BIAS = 48128, P5_AGG = 48384;
DEV void phase5(const Ctx& c, int ALT = 0) {
    const bf16_t* R1 = (const bf16_t*)(c.ws + WS_R1); bf16_t* H1 = (bf16_t*)(c.ws + WS_H0);
    const bf16_t* WrT = (const bf16_t*)(c.ws + WS_WR);
    unsigned* cnt = (unsigned*)(c.ws + WS_CTL) + CW_CNT + ALT * 32; unsigned* list = (unsigned*)(c.ws + (ALT ? 404 * MiB : WS_LIST)); float* combw = (float*)(c.ws + WS_COMBW);
    const int lane = c.lane, wid = c.wid, fr = lane & 15, fq = lane >> 4;
    float* part = (float*)(c.lds + P5_PART); float* lgs = (float*)(c.lds + P5_LG); float* biasl = (float*)(c.lds + P5_BIAS);
    __syncthreads();
    if (c.tid < 36) biasl[c.tid] = (c.tid < 4) ? c.in[I_BRG][c.tid] : c.in[I_BRE][c.tid - 4];
    bf16x8 wf[8][3];
#pragma unroll
    for (int ks = 0; ks < 8; ++ks)
#pragma unroll
        for (int n = 0; n < 3; ++n) wf[ks][n] = *(const bf16x8*)(WrT + (size_t)(n * 16 + fr) * D + wid * 256 + ks * 32 + fq * 8);
    unsigned* lcnt = (unsigned*)(c.lds + P5_AGG); unsigned* lbase = lcnt + 32; unsigned* ent = lcnt + 64;
    if (c.tid < 32) lcnt[c.tid] = 0u;
    int nent = 0;
    for (int u = c.vcu; u < TR / 16; u += c.G) {
        const int tok0 = u * 16;
        { const float* src[4]; bf16_t* dst[4]; unsigned char* ldsn[4]; unsigned char* f8n[4];
#pragma unroll
          for (int i = 0; i < 4; ++i) { const int tl = wid * 4 + i; const size_t tok = tok0 + tl; src[i] = (const float*)(R1 + tok * D); dst[i] = H1 + tok * D; ldsn[i] = c.lds + tl * P5_ROWB; f8n[i] = c.ws + WS_H1F8 + tok * D; }
          ln_rows_bf16<4, true, true>(src, c.in[I_LN1G], c.in[I_LN1B], dst, ldsn, lane, f8n); }
        __syncthreads();
        f32x4 acc[3] = {};
#pragma unroll
        for (int ks = 0; ks < 8; ++ks) {
            const int k = wid * 256 + ks * 32 + fq * 8;
            const bf16x8 a = *(const bf16x8*)(c.lds + fr * P5_ROWB + k * 2);
#pragma unroll
            for (int n = 0; n < 3; ++n) acc[n] = __builtin_amdgcn_mfma_f32_16x16x32_bf16(wf[ks][n], a, acc[n], 0, 0, 0);
        }
#pragma unroll
        for (int n = 0; n < 3; ++n) *(f32x4*)(part + (wid * 16 + fr) * 48 + n * 16 + fq * 4) = acc[n];
        __syncthreads();
#pragma unroll
        for (int i = 0; i < 3; ++i) { const int idx = c.tid + 256 * i;
            if (idx < 576) { const int tk = idx / 36, l = idx - tk * 36;
                lgs[tk * 40 + l] = ((part[tk * 48 + l] + part[(16 + tk) * 48 + l]) + (part[(32 + tk) * 48 + l] + part[(48 + tk) * 48 + l])) + biasl[l]; } }
        __syncthreads();
        if (c.tid < 16) {
            const float* lg = lgs + c.tid * 40;
            int gi = 0; float gm = lg[0];
#pragma unroll
            for (int i = 1; i < 4; ++i) { const float v = lg[i]; if (v > gm) { gm = v; gi = i; } }
            float gs = 0.f;
#pragma unroll
            for (int i = 0; i < 4; ++i) gs += __expf(lg[i] - gm);
            const float gw = 1.f / gs;
            const float* le = lg + 4 + gi * 8;
            float v0 = le[0], v1 = -3.0e38f; int i0 = 0, i1 = 0;
#pragma unroll
            for (int i = 1; i < 8; ++i) { const float v = le[i];
                if (v > v0) { v1 = v0; i1 = i0; v0 = v; i0 = i; } else if (v > v1) { v1 = v; i1 = i; } }
            const float ex = __expf(v1 - v0), inv = 1.f / (1.f + ex);
            const int tok = tok0 + c.tid; const unsigned e0 = gi * 8 + i0, e1 = gi * 8 + i1;
            combw[tok * 2] = gw * inv; combw[tok * 2 + 1] = gw * ex * inv;
            const unsigned r0 = atomicAdd(&lcnt[e0], 1u), r1 = atomicAdd(&lcnt[e1], 1u);
            const int ei = nent * 32 + c.tid * 2;
            ent[2 * ei] = (unsigned)(tok * 2);         ent[2 * ei + 1] = (e0 << 16) | r0;
            ent[2 * ei + 2] = (unsigned)(tok * 2 + 1); ent[2 * ei + 3] = (e1 << 16) | r1;
        }
        ++nent;
    }
    __syncthreads();
    if (c.tid < 32) { const unsigned n = lcnt[c.tid]; lbase[c.tid] = n ? atomicAdd(&cnt[c.tid * CNT_STRIDE], n) : 0u; }
    __syncthreads();
    for (int i = c.tid; i < nent * 32; i += 256) { const unsigned t2 = ent[2 * i], er = ent[2 * i + 1]; const unsigned e = er >> 16;
        list[(size_t)e * TR + lbase[e] + (er & 0xffffu)] = t2; }
}
DEV void bar20(const Ctx& c) {}
DEV void moe_tiles(const Ctx& c) {
    const unsigned* cnt = (const unsigned*)(c.ws + WS_CTL) + CW_CNT; int* ts = (int*)(c.lds + EXP_OFF);
    __syncthreads();
    if (c.tid < NE) ts[40 + c.tid] = (int)__hip_atomic_load(&cnt[c.tid * CNT_STRIDE], __ATOMIC_RELAXED, __HIP_MEMORY_SCOPE_AGENT);
    __syncthreads();
    if (c.tid == 0) { int s = 0; for (int e = 0; e < NE; ++e) { ts[e] = s; s += (ts[40 + e] + 127) >> 7; } ts[NE] = s; }
    __syncthreads();
}
DEV void phase6a(const Ctx& c) {
    const bf16_t* H18 = (const bf16_t*)(c.ws + WS_H1F8); const bf16_t* Wgu8 = (const bf16_t*)(c.ws + WS_WGU); unsigned char* ACT8 = c.ws + WS_ACT;
    const unsigned* list = (const unsigned*)(c.ws + WS_LIST);
    moe_tiles(c);
    const int* ts = (const int*)(c.lds + EXP_OFF); unsigned* tbl = (unsigned*)(c.lds + TBL_OFF);
    const StageGeo g = stage_geo(c.tid);
    const int lane = c.lane, wr = c.wid >> 1, wc = c.wid & 1, fr = lane & 15, fq = lane >> 4;
    const int NU = ts[NE] * 4;
    u32x2* RI = (u32x2*)(c.ws + WS_RI); const float* combw = (const float*)(c.ws + WS_COMBW);
    int e = 0, en_e = 0; unsigned en_cur = 0xffffffffu;
    { const int u0 = c.vcu; if (u0 < NU) { const int rt0 = u0 >> 2; while (ts[en_e + 1] <= rt0) ++en_e;
        if (c.tid < 128) { const int j = (rt0 - ts[en_e]) * 128 + c.tid; en_cur = (j < ts[40 + en_e]) ? list[(size_t)en_e * TR + j] : 0xffffffffu; } } }
    for (int u = c.vcu; u < NU; u += c.G) {
        const int rt = u >> 2, nt = u & 3;
        e = en_e;
        __syncthreads();
        float wri = 0.f;
        if (c.tid < 128) { tbl[c.tid] = en_cur; if (nt == 0 && en_cur != 0xffffffffu) wri = combw[en_cur]; }
        const unsigned en_this = en_cur;
        { const int un = u + c.G; if (un < NU) { const int rtn = un >> 2; while (ts[en_e + 1] <= rtn) ++en_e;
            if (c.tid < 128) { const int j = (rtn - ts[en_e]) * 128 + c.tid; en_cur = (j < ts[40 + en_e]) ? list[(size_t)en_e * TR + j] : 0xffffffffu; } } }
        __syncthreads();
        size_t ro[4];
#pragma unroll
        for (int i = 0; i < 4; ++i) { const unsigned en = tbl[g.r[i]]; ro[i] = (en == 0xffffffffu) ? 0 : (size_t)(en >> 1) * (D / 2); }
        const bf16_t* A = H18 + g.c; const bf16_t* B = Wgu8 + ((size_t)e * 512 + nt * 128) * (D / 2) + g.c;
        f32x4 acc[4][4];
        gemm_mainloop<false, true>(acc, A + ro[0], A + ro[1], A + ro[2], A + ro[3],
                             B + (size_t)g.r[0] * (D / 2), B + (size_t)g.r[1] * (D / 2), B + (size_t)g.r[2] * (D / 2), B + (size_t)g.r[3] * (D / 2), 8, c.lds, 0, 0.f);
#pragma unroll
        for (int m = 0; m < 4; ++m) { const size_t row = (size_t)rt * 128 + wr * 64 + m * 16 + fr;
#pragma unroll
            for (int i = 0; i < 2; ++i) {
                const f32x4 gt = acc[m][2 * i], up = acc[m][2 * i + 1]; f32x4 o;
#pragma unroll
                for (int j = 0; j < 4; ++j) { const float gv = gt[j] * WUNSCALE; o[j] = gv * sigmoidf_(gv) * (up[j] * WUNSCALE); }
                *(unsigned*)(ACT8 + row * DE + nt * 64 + wc * 32 + i * 16 + fq * 4) = pk_fp8x4(o[0], o[1], o[2], o[3]);
            } }
        if (nt == 0 && c.tid < 128) { u32x2 ri; ri.x = en_this; ri.y = __float_as_uint(wri); RI[(size_t)rt * 128 + c.tid] = ri; }
    }
}
DEV void phase6b(const Ctx& c) {
    const bf16_t* ACT8 = (const bf16_t*)(c.ws + WS_ACT); const bf16_t* Wd8 = (const bf16_t*)(c.ws + WS_WD); unsigned char* Y8 = c.ws + WS_Y;
    const u32x2* RI = (const u32x2*)(c.ws + WS_RI);
    moe_tiles(c);
    const int* ts = (const int*)(c.lds + EXP_OFF); u32x2* tbl = (u32x2*)(c.lds + TBL_OFF);
    const StageGeo g = stage_geo(c.tid);
    unsigned char* lds = c.lds;
    const int tid = c.tid, lane = c.lane, wr = c.wid >> 1, wc = c.wid & 1, fr = lane & 15, fq = lane >> 4;
    const int cb0 = fq * 32, cb1 = fq * 32 + 16;
    const int q0 = (cb0 >> 6) * 1024 + ((fr * 64 + (cb0 & 63)) ^ ((fr >> 3) << 5)), q1 = (cb1 >> 6) * 1024 + ((fr * 64 + (cb1 & 63)) ^ ((fr >> 3) << 5));
    const int a_off = wr * 8192, b_off = wc * 8192, dst = tid * 16;
    const int NU = ts[NE] * 2;
    int e = 0;
#define GLDS(src, off) __builtin_amdgcn_global_load_lds((const unsigned*)(src), (unsigned LAS*)(lds + (off)), 16, 0, 0)
    for (int u = c.vcu; u < NU; u += c.G) {
        const int rt = u >> 1, nh = u & 1;
        while (ts[e + 1] <= rt) ++e;
        __syncthreads();
        if (tid < 128) tbl[tid] = RI[(size_t)rt * 128 + tid];
        const bf16_t* A = ACT8 + (size_t)(rt * 128) * (DE / 2) + g.c;
        const bf16_t* B = Wd8 + ((size_t)e * 1024 + nh * 512) * (DE / 2) + g.c;
#pragma unroll
        for (int kt = 0; kt < 2; ++kt)
#pragma unroll
            for (int i = 0; i < 4; ++i) GLDS(A + (size_t)g.r[i] * (DE / 2) + kt * 64, kt * 16384 + dst + i * 4096);
#define BSTAGE(s_, buf) do { const bf16_t* _b = B + (size_t)((s_) >> 1) * 128 * (DE / 2) + ((s_) & 1) * 64; \
        GLDS(_b + (size_t)g.r[0] * (DE / 2), 32768 + (buf) * 16384 + dst);        GLDS(_b + (size_t)g.r[1] * (DE / 2), 32768 + (buf) * 16384 + dst + 4096); \
        GLDS(_b + (size_t)g.r[2] * (DE / 2), 32768 + (buf) * 16384 + dst + 8192); GLDS(_b + (size_t)g.r[3] * (DE / 2), 32768 + (buf) * 16384 + dst + 12288); } while (0)
        BSTAGE(0, 0);
        f32x4 acc[4][4];
#pragma unroll
        for (int m = 0; m < 4; ++m)
#pragma unroll
            for (int n = 0; n < 4; ++n) acc[m][n] = (f32x4){0.f, 0.f, 0.f, 0.f};
#pragma unroll 1
        for (int s_ = 0; s_ < 8; ++s_) {
            VM_WAIT();
            __syncthreads();
            const int bsel = s_ & 1;
            if (s_ + 1 < 8) { if (bsel) BSTAGE(s_ + 1, 0); else BSTAGE(s_ + 1, 1); }
            const unsigned char* ab = lds + bsel * 16384 + a_off; const unsigned char* bb = lds + 32768 + bsel * 16384 + b_off;
            v8i ax[4], bx[4];
#pragma unroll
            for (int m = 0; m < 4; ++m) { const u32x4 c0 = *(const u32x4*)(ab + m * 2048 + q0), c1 = *(const u32x4*)(ab + m * 2048 + q1);
                ax[m] = (v8i){(int)c0.x, (int)c0.y, (int)c0.z, (int)c0.w, (int)c1.x, (int)c1.y, (int)c1.z, (int)c1.w}; }
#pragma unroll
            for (int n = 0; n < 4; ++n) { const u32x4 c0 = *(const u32x4*)(bb + n * 2048 + q0), c1 = *(const u32x4*)(bb + n * 2048 + q1);
                bx[n] = (v8i){(int)c0.x, (int)c0.y, (int)c0.z, (int)c0.w, (int)c1.x, (int)c1.y, (int)c1.z, (int)c1.w}; }
#pragma unroll
            for (int m = 0; m < 4; ++m)
#pragma unroll
                for (int n = 0; n < 4; ++n) acc[m][n] = __builtin_amdgcn_mfma_scale_f32_16x16x128_f8f6f4(bx[n], ax[m], acc[m][n], 0, 0, 0, 0x7F7F7F7F, 0, 0x7F7F7F7F);
            if (bsel) {
                const int nt = nh * 4 + (s_ >> 1);
#pragma unroll
                for (int m = 0; m < 4; ++m) {
                    const u32x2 ri = tbl[wr * 64 + m * 16 + fr]; const unsigned en = ri.x;
                    if (en != 0xffffffffu) {
                        const float w = __uint_as_float(ri.y) * (WUNSCALE * YSCALE); unsigned char* dstp = Y8 + ((size_t)(en & 1u) * TR + (en >> 1)) * D + nt * 128 + wc * 64 + fq * 4;
#pragma unroll
                        for (int n = 0; n < 4; ++n) { const f32x4 o = acc[m][n] * w; *(unsigned*)(dstp + n * 16) = pk_fp8x4(o[0], o[1], o[2], o[3]); }
                    }
#pragma unroll
                    for (int n = 0; n < 4; ++n) acc[m][n] = (f32x4){0.f, 0.f, 0.f, 0.f};
                }
            }
        }
#undef BSTAGE
    }
#undef GLDS
}

DEV void phase7(const Ctx& c) {
    const bf16_t* H1 = (const bf16_t*)(c.ws + WS_H0); const unsigned char* Y8 = c.ws + WS_Y;
    const float* g = c.in[I_LN2G]; const float* bt = c.in[I_LN2B];
    const int gw = c.vcu * 4 + c.wid, NGW = c.G * 4, lane = c.lane;
    for (int tok0 = gw; tok0 < TR; tok0 += 2 * NGW) {
        float v[2][16]; float st[2]; int tk[2];
#pragma unroll
        for (int r = 0; r < 2; ++r) {
            int tok = tok0 + r * NGW; if (tok >= TR) tok = tok0; tk[r] = tok;
#pragma unroll
            for (int i = 0; i < 2; ++i) {
                const u32x4 hw = *(const u32x4*)(H1 + (size_t)tok * D + i * 512 + lane * 8);
                const u32x2 y0 = *(const u32x2*)(Y8 + (size_t)tok * D + i * 512 + lane * 8);
                const u32x2 y1 = *(const u32x2*)(Y8 + ((size_t)TR + tok) * D + i * 512 + lane * 8);
#pragma unroll
                for (int q2 = 0; q2 < 2; ++q2) {
                    const auto a0 = __builtin_amdgcn_cvt_pk_f32_fp8((int)y0[q2], false), a1 = __builtin_amdgcn_cvt_pk_f32_fp8((int)y0[q2], true);
                    const auto b0 = __builtin_amdgcn_cvt_pk_f32_fp8((int)y1[q2], false), b1 = __builtin_amdgcn_cvt_pk_f32_fp8((int)y1[q2], true);
                    v[r][i * 8 + 4 * q2]     = ALPHA * bflo(hw[2 * q2]) + (a0[0] + b0[0]) * YUNSCALE;
                    v[r][i * 8 + 4 * q2 + 1] = ALPHA * bfhi(hw[2 * q2]) + (a0[1] + b0[1]) * YUNSCALE;
                    v[r][i * 8 + 4 * q2 + 2] = ALPHA * bflo(hw[2 * q2 + 1]) + (a1[0] + b1[0]) * YUNSCALE;
                    v[r][i * 8 + 4 * q2 + 3] = ALPHA * bfhi(hw[2 * q2 + 1]) + (a1[1] + b1[1]) * YUNSCALE;
                }
            }
        }
#pragma unroll
        for (int r = 0; r < 2; ++r) { float a = 0.f;
#pragma unroll
            for (int q = 0; q < 16; ++q) a += v[r][q];
            st[r] = a; }
        wave_sum_n<2>(st);
#pragma unroll
        for (int r = 0; r < 2; ++r) { const float mean = st[r] * (1.f / 1024.f); float a = 0.f;
#pragma unroll
            for (int q = 0; q < 16; ++q) { v[r][q] -= mean; a += v[r][q] * v[r][q]; }
            st[r] = a; }
        wave_sum_n<2>(st);
#pragma unroll
        for (int i = 0; i < 2; ++i)
#pragma unroll
            for (int q = 0; q < 2; ++q) {
                const int col = i * 512 + lane * 8 + q * 4;
                const f32x4 gg = *(const f32x4*)(g + col), bb = *(const f32x4*)(bt + col);
#pragma unroll
                for (int r = 0; r < 2; ++r) {
                    if (r == 1 && tok0 + NGW >= TR) continue;
                    const float rstd = rsqrt_(st[r] * (1.f / 1024.f) + EPS);
                    f32x4 o; o[0] = v[r][i * 8 + q * 4] * rstd * gg[0] + bb[0]; o[1] = v[r][i * 8 + q * 4 + 1] * rstd * gg[1] + bb[1];
                    o[2] = v[r][i * 8 + q * 4 + 2] * rstd * gg[2] + bb[2]; o[3] = v[r][i * 8 + q * 4 + 3] * rstd * gg[3] + bb[3];
                    *(f32x4*)(c.out + (size_t)tk[r] * D + col) = o;
                }
            }
    }
}

__global__ void __launch_bounds__(256, 2) fwd_kernel(Args a) {
    extern __shared__ __attribute__((aligned(16))) unsigned char lds[];
    Ctx c; c.in = a.in; c.out = a.out; c.ws = a.ws; c.lds = lds;
    c.tid = threadIdx.x; c.lane = c.tid & 63; c.wid = __builtin_amdgcn_readfirstlane(c.tid >> 6);
    c.G = gridDim.x; { const int bx = blockIdx.x; c.vcu = (c.G % 8 == 0) ? (bx % 8) * (c.G / 8) + bx / 8 : bx; }
    if (c.tid < 64) ((unsigned*)(lds + MISC_OFF))[c.tid] = 0u;
    __syncthreads();
    unsigned* ctl = (unsigned*)(a.ws + WS_CTL);
    XcdBarrier bar = xcd_barrier_post(ctl + CW_BAR, (volatile LAS unsigned*)(lds + MISC_OFF));
#ifdef ONLY_PH
#define PH_ON(k) ((k) == ONLY_PH)
#else
#define PH_ON(k) 1
#endif
    const int lo = a.ph_lo, hi = a.ph_hi;
#define RUN_PHASE(k, fn) if (PH_ON(k) && lo <= (k) && (k) < hi) { \
        for (int _rep = 0; _rep < ((REPEAT_PH == (k)) ? 2 : 1); ++_rep) { \
            int _t = threadIdx.x; asm volatile("" : "+v"(_t)); c.tid = _t; c.lane = _t & 63; c.wid = __builtin_amdgcn_readfirstlane(_t >> 6); \
            if ((k) == 5) phase5(c, _rep); else fn(c); \
            if (_rep == 0 && REPEAT_PH == (k)) xcd_barrier(bar); } \
        if ((k) + 1 < hi) xcd_barrier(bar); }
    RUN_PHASE(0, phase0)
    RUN_PHASE(1, phase1)
    RUN_PHASE(2, phase2)
    RUN_PHASE(3, phase3)
    RUN_PHASE(4, phase4)
    RUN_PHASE(5, phase0)
    RUN_PHASE(6, phase6a)
    RUN_PHASE(7, phase6b)
    RUN_PHASE(8, phase7)
}

extern "C" void kernel_launch(void* const* d_in, const int* in_sizes, int n_in, void* d_out, int out_size, void* d_ws, size_t ws_size, hipStream_t stream) {
    static int grid = 0;
    if (grid == 0) {
        if (n_in != 27 || in_sizes[0] != NB * SEQ * D || out_size != TR * D || ws_size < WS_END) {
            fprintf(stderr, "kernel_launch: shape mismatch n_in %d in0 %d out %d ws %zu\n", n_in, n_in > 0 ? in_sizes[0] : -1, out_size, ws_size); grid = -1; return; }
        int dev = 0, cus = 0, per_cu = 0;
        if (hipGetDevice(&dev) != hipSuccess || hipDeviceGetAttribute(&cus, hipDeviceAttributeMultiprocessorCount, dev) != hipSuccess) { grid = -1; return; }
        if (hipFuncSetAttribute((const void*)fwd_kernel, hipFuncAttributeMaxDynamicSharedMemorySize, LDS_BYTES) != hipSuccess) { grid = -1; return; }
        if (hipOccupancyMaxActiveBlocksPerMultiprocessor(&per_cu, (const void*)fwd_kernel, 256, LDS_BYTES) != hipSuccess || per_cu < 1) per_cu = 1;
        (void)hipGetLastError();
        if (per_cu > 2) per_cu = 2;
        grid = cus * per_cu;
        fprintf(stderr, "kernel_launch: grid %d (%d per CU)\n", grid, per_cu);
    }
    if (grid < 0) return;
    (void)hipMemsetAsync((char*)d_ws + WS_CTL, 0, CTL_ZERO_BYTES, stream);
    Args a{};
    for (int i = 0; i < 27; ++i) a.in[i] = (const float*)d_in[i];
    a.out = (float*)d_out; a.ws = (unsigned char*)d_ws;
    if (MK_N_LAUNCHES == 1) {
        a.ph_lo = 0; a.ph_hi = NPH;
        hipLaunchKernelGGL(fwd_kernel, dim3(grid), dim3(256), LDS_BYTES, stream, a);
    } else {
        for (int ph = 0; ph < NPH; ++ph) { a.ph_lo = ph; a.ph_hi = ph + 1; hipLaunchKernelGGL(fwd_kernel, dim3(grid), dim3(256), LDS_BYTES, stream, a); }
    }
}
```

```cpp
#include <hip/hip_runtime.h>
#include <cstdio>
#include <cstdint>

#ifndef REPEAT_PH
#define REPEAT_PH -1
#endif
#ifndef CONV_REPB
#define CONV_REPB 1
#endif
#ifndef CONV_REPC
#define CONV_REPC 1
#endif
#ifndef CONV_REPA
#define CONV_REPA 1
#endif
#ifndef MK_N_LAUNCHES
#define MK_N_LAUNCHES 1
#endif

#define DEV __device__ __forceinline__
#define LAS __attribute__((address_space(3)))
#define GAS __attribute__((address_space(1)))
typedef unsigned short bf16_t;
typedef short bf16x8 __attribute__((ext_vector_type(8)));
typedef short s16x4 __attribute__((ext_vector_type(4)));
typedef float f32x4 __attribute__((ext_vector_type(4)));
typedef float f32x16 __attribute__((ext_vector_type(16)));
typedef unsigned u32x4 __attribute__((ext_vector_type(4)));
typedef unsigned u32x2 __attribute__((ext_vector_type(2)));
typedef long i64x2 __attribute__((ext_vector_type(2)));
typedef int v8i __attribute__((ext_vector_type(8)));

constexpr int NB = 16, SEQ = 2048, NMETA = 16, L = SEQ + NMETA;
constexpr int T = NB * L;
constexpr int TR = NB * SEQ;
constexpr int D = 1024, NIN = 1696, CC = 512, QL = 384, KVL = 256, NH = 8, DQK = 96, DV = 64;
constexpr int NQ = NH * DQK;
constexpr int NKV = NH * (64 + DV);
constexpr int NE = 32, DE = 256, CONVK = 31;
constexpr float EPS = 1e-5f;
constexpr float ALPHA = 1.189207115002721f;
constexpr float QSCALE = 0.10206207261596577f * 1.4426950408889634f;
constexpr int NPH = 9;
constexpr float WSCALE = 16.f, WUNSCALE = 1.f / 16.f;
constexpr float YSCALE = 64.f, YUNSCALE = 1.f / 64.f;

constexpr size_t MiB = 1u << 20;
constexpr size_t WS_CTL = 0, CTL_ZERO_BYTES = 64 * 1024;
constexpr int CW_CNT = 1024, CNT_STRIDE = 64;
constexpr int CW_BAR = 4096;
constexpr size_t WS_LIST = 1 * MiB;
constexpr size_t WS_COMBW = 5 * MiB;
constexpr size_t WS_ST1 = 5 * MiB + 256 * 1024;
constexpr size_t WS_ROPE = 5 * MiB + 512 * 1024;
constexpr size_t WS_WIN = 6 * MiB;
constexpr size_t WS_WUQ = 10 * MiB;
constexpr size_t WS_WUKV = 11 * MiB;
constexpr size_t WS_WO = 12 * MiB;
constexpr size_t WS_WR = 14 * MiB;
constexpr size_t WS_RI = 14 * MiB + 512 * 1024;
constexpr size_t WS_SSQ_CQ = 404 * MiB + 512 * 1024;
constexpr size_t WS_SSQ_CKV = 402 * MiB;
constexpr size_t WS_SSQ_O = 403 * MiB;
constexpr size_t WS_WGU = 16 * MiB;
constexpr size_t WS_WD = 48 * MiB;
constexpr size_t WS_H1F8 = 130 * MiB;
constexpr size_t WS_H0 = 64 * MiB;
constexpr size_t WS_U = 130 * MiB;
constexpr size_t WS_CQ = 163 * MiB;
constexpr size_t WS_CKV = 188 * MiB;
constexpr size_t WS_KR = 205 * MiB;
constexpr size_t WS_Q = 208 * MiB;
constexpr size_t WS_KV = 257 * MiB;
constexpr size_t WS_R1 = 208 * MiB;
constexpr size_t WS_Y = 272 * MiB;
constexpr size_t WS_MG = 336 * MiB;
constexpr size_t WS_ACT = 336 * MiB;
constexpr size_t WS_DUMMY = 400 * MiB;
constexpr size_t WS_END = 406 * MiB;

constexpr int LDS_BYTES = 73728;
constexpr int MISC_OFF = LDS_BYTES - 256;
constexpr int RS_OFF = 65536;
constexpr int TBL_OFF = 66048;
constexpr int EXP_OFF = 67584;

DEV unsigned cvtpk(float lo, float hi) { unsigned r; asm("v_cvt_pk_bf16_f32 %0, %1, %2" : "=v"(r) : "v"(lo), "v"(hi)); return r; }
DEV float bflo(unsigned w) { return __uint_as_float(w << 16); }
DEV float bfhi(unsigned w) { return __uint_as_float(w & 0xffff0000u); }
DEV float dpp_add_qp(float v, int) { return v; }
template <int CTRL> DEV float dpp_mov(float v) { return __builtin_bit_cast(float, __builtin_amdgcn_update_dpp(0, __builtin_bit_cast(int, v), CTRL, 0xf, 0xf, false)); }
DEV float wave_sum(float v) {
    v += dpp_mov<0xB1>(v);
    v += dpp_mov<0x4E>(v);
    v += dpp_mov<0x141>(v);
    v += dpp_mov<0x140>(v);
    const int iv = __builtin_bit_cast(int, v);
    const float a = __builtin_bit_cast(float, __builtin_amdgcn_readlane(iv, 0)), b = __builtin_bit_cast(float, __builtin_amdgcn_readlane(iv, 16));
    const float c = __builtin_bit_cast(float, __builtin_amdgcn_readlane(iv, 32)), d = __builtin_bit_cast(float, __builtin_amdgcn_readlane(iv, 48));
    return (a + b) + (c + d);
}
DEV float rsqrt_(float x) { return __builtin_amdgcn_rsqf(x); }
DEV void st_bf4(bf16_t* p, f32x4 v) { u32x2 w = {cvtpk(v[0], v[1]), cvtpk(v[2], v[3])}; *(u32x2*)p = w; }
DEV unsigned pk_fp8x4(float a, float b, float c, float d) {
    int w = __builtin_amdgcn_cvt_pk_fp8_f32(a, b, 0, false); w = __builtin_amdgcn_cvt_pk_fp8_f32(c, d, w, true); return (unsigned)w; }
DEV float fast_exp2(float x) { return __builtin_amdgcn_exp2f(x); }
DEV float fast_rcp(float x) { return __builtin_amdgcn_rcpf(x); }
DEV float sigmoidf_(float g) { return fast_rcp(1.f + fast_exp2(-1.4426950408889634f * g)); }
#define LDS_WAIT() asm volatile("s_waitcnt lgkmcnt(0)" ::: "memory")
#define VM_WAIT() asm volatile("s_waitcnt vmcnt(0)" ::: "memory")

#define XB_TMO      128
#define XB_XCNT(j)  (256  + 64 * (j))
#define XB_XSUB(j)  (1280 + 64 * (j))
#define XB_XGEN(j)  (2304 + 64 * (j))
#define XB_TOP      3328
#define XB_TOPGEN   3392
#define XCD_BAR_WORDS 3456
#define XB_SPIN_CAP (1u << 22)
DEV unsigned xb_ld(unsigned* p)              { return __hip_atomic_load(p, __ATOMIC_RELAXED, __HIP_MEMORY_SCOPE_AGENT); }
DEV unsigned xb_add(unsigned* p, unsigned v) { return __hip_atomic_fetch_add(p, v, __ATOMIC_RELAXED, __HIP_MEMORY_SCOPE_AGENT); }
DEV unsigned xb_xcc_id() { return (unsigned)__builtin_amdgcn_s_getreg((3 << 11) | 20) & 0xFu; }
#define XB_SPIN(cond, bar) do { unsigned _sp = 0; while (cond) { __builtin_amdgcn_s_sleep(1); \
    if ((++_sp & 255u) == 0u) { if (xb_ld(&(bar)[XB_TMO])) break; if (_sp > XB_SPIN_CAP) { atomicAdd(&(bar)[XB_TMO], 1u); break; } } } } while (0)
struct XcdBarrier { unsigned* bar; unsigned x; volatile LAS unsigned* st; };
DEV XcdBarrier xcd_barrier_post(unsigned* bar, volatile LAS unsigned* st) {
    XcdBarrier b; b.bar = bar; b.x = xb_xcc_id(); b.st = st;
    if (threadIdx.x == 0) (void)xb_add(&bar[XB_XCNT(b.x)], 1u);
    return b;
}
DEV void xcd_barrier_complete(unsigned* bar, unsigned x, unsigned& nloc, unsigned& nx) {
    const unsigned G = gridDim.x * gridDim.y * gridDim.z;
    unsigned sum, cnt, mine, sp = 0u;
    for (;;) {
        sum = 0u; cnt = 0u; mine = 0u;
#pragma unroll
        for (unsigned j = 0; j < 16; ++j) { const unsigned c = xb_ld(&bar[XB_XCNT(j)]); sum += c; cnt += (c > 0u) ? 1u : 0u; mine = (j == x) ? c : mine; }
        if (sum == G) break;
        __builtin_amdgcn_s_sleep(1);
        if ((++sp & 255u) == 0u) { if (xb_ld(&bar[XB_TMO])) break; if (sp > XB_SPIN_CAP) { atomicAdd(&bar[XB_TMO], 1u); break; } }
    }
    nloc = mine > 0u ? mine : 1u; nx = cnt > 0u ? cnt : 1u;
}
DEV void xcd_barrier(const XcdBarrier& b) {
    asm volatile("s_waitcnt vmcnt(0)" ::: "memory");
    __syncthreads();
    if (threadIdx.x == 0) {
        unsigned* bar = b.bar;
        __builtin_amdgcn_s_waitcnt(0);
        unsigned nloc = b.st[0], nx = b.st[1];
        if (nloc == 0u) { xcd_barrier_complete(bar, b.x, nloc, nx); b.st[0] = nloc; b.st[1] = nx; }
        const unsigned old = xb_add(&bar[XB_XSUB(b.x)], 1u);
        const unsigned gen = old / nloc;
        if (old + 1u == (gen + 1u) * nloc) {
            __builtin_amdgcn_fence(__ATOMIC_RELEASE, "agent");
            asm volatile("s_waitcnt vmcnt(0)" ::: "memory");
            const unsigned og = xb_add(&bar[XB_TOP], 1u);
            const unsigned tg = og / nx;
            if (og + 1u == (tg + 1u) * nx) xb_add(&bar[XB_TOPGEN], 1u);
            else XB_SPIN(xb_ld(&bar[XB_TOPGEN]) == tg, bar);
            __builtin_amdgcn_fence(__ATOMIC_ACQUIRE, "agent");
            xb_add(&bar[XB_XGEN(b.x)], 1u);
            asm volatile("s_waitcnt vmcnt(0)" ::: "memory");
        } else {
            XB_SPIN(xb_ld(&bar[XB_XGEN(b.x)]) == gen, bar);
            __builtin_amdgcn_fence(__ATOMIC_ACQUIRE, "agent");
            asm volatile("s_waitcnt vmcnt(0)" ::: "memory");
        }
    }
    __syncthreads();
}

struct Args { const float* in[27]; float* out; unsigned char* ws; int ph_lo, ph_hi; };
struct Ctx {
    const float* const* in; float* out; unsigned char* ws; unsigned char* lds;
    int tid, lane, wid, vcu, G;
};
enum { I_X = 0, I_META, I_LNIN_G, I_LNIN_B, I_WIN, I_CONVW, I_CONVB, I_CLN_G, I_CLN_B, I_QNG, I_WUQ, I_KVNG, I_WUKV, I_COUT_G, I_AOUT_G, I_WO,
       I_LN1G, I_LN1B, I_WRG, I_BRG, I_WRE, I_BRE, I_WGATE, I_WUP, I_WDOWN, I_LN2G, I_LN2B };

DEV int nmap(int mode, int n) {
    if (mode == 1) { if (n < 512) return ((n >> 4) << 5) + (n & 15); if (n < 1024) return (((n - 512) >> 4) << 5) + 16 + (n & 15); return n; }
    if (mode == 2) return ((n >> 4) << 5) + (n & 15);
    if (mode == 3) return ((n >> 4) << 5) + 16 + (n & 15);
    return n;
}
DEV void p0_transpose_item(const float* __restrict__ W, int N, int k0, int n0, const float* __restrict__ kscale, bf16_t* WT, int ldt, int kout0, int mode,
                           float* scr, int lane) {
#pragma unroll 8
    for (int i = 0; i < 32; ++i) {
        const int kk = 2 * i + (lane >> 5);
        float v = W[(size_t)(k0 + kk) * N + n0 + (lane & 31)];
        if (kscale) v *= kscale[k0 + kk];
        scr[kk * 33 + (lane & 31)] = v;
    }
    LDS_WAIT(); asm volatile("" ::: "memory");
    const int c = lane & 7;
#pragma unroll
    for (int j = 0; j < 4; ++j) {
        const int n = (lane >> 3) + 8 * j; const float* s = scr + (8 * c) * 33 + n;
        u32x4 o; o.x = cvtpk(s[0 * 33], s[1 * 33]); o.y = cvtpk(s[2 * 33], s[3 * 33]); o.z = cvtpk(s[4 * 33], s[5 * 33]); o.w = cvtpk(s[6 * 33], s[7 * 33]);
        *(u32x4*)(WT + (size_t)nmap(mode, n0 + n) * ldt + kout0 + 8 * c) = o;
    }
    LDS_WAIT(); asm volatile("" ::: "memory");
}
DEV void p0_transpose_item_f8(const float* __restrict__ W, int N, int k0, int n0, float scale, unsigned char* W8, int ldt, int kout0, int mode, float* scr, int lane) {
#pragma unroll 8
    for (int i = 0; i < 32; ++i) { const int kk = 2 * i + (lane >> 5); scr[kk * 33 + (lane & 31)] = W[(size_t)(k0 + kk) * N + n0 + (lane & 31)] * scale; }
    LDS_WAIT(); asm volatile("" ::: "memory");
    const int c = lane & 7;
#pragma unroll
    for (int j = 0; j < 4; ++j) {
        const int n = (lane >> 3) + 8 * j; const float* sp = scr + (8 * c) * 33 + n;
        u32x2 o; o.x = pk_fp8x4(sp[0 * 33], sp[1 * 33], sp[2 * 33], sp[3 * 33]); o.y = pk_fp8x4(sp[4 * 33], sp[5 * 33], sp[6 * 33], sp[7 * 33]);
        *(u32x2*)(W8 + (size_t)nmap(mode, n0 + n) * ldt + kout0 + 8 * c) = o;
    }
    LDS_WAIT(); asm volatile("" ::: "memory");
}
template <int N> DEV void wave_sum_n(float (&v)[N]) {
#pragma unroll
    for (int i = 0; i < N; ++i) v[i] = wave_sum(v[i]);
}
template <int NR, bool F8 = false, bool BFIN = false, bool NOBF = false> DEV void ln_rows_bf16(const float* const (&xrow)[NR], const float* g, const float* bta, bf16_t* const (&orow)[NR], unsigned char* const (&ldsrow)[NR], int lane, unsigned char* const* f8row = nullptr, float* const* strow = nullptr) {
    f32x4 v[NR][4]; float s[NR];
#pragma unroll
    for (int r = 0; r < NR; ++r)
#pragma unroll
        for (int j = 0; j < 4; ++j) {
            if (BFIN) { const u32x2 w = ((const u32x2*)xrow[r])[64 * j + lane]; v[r][j] = (f32x4){bflo(w.x), bfhi(w.x), bflo(w.y), bfhi(w.y)}; }
            else v[r][j] = ((const f32x4*)xrow[r])[64 * j + lane]; }
#pragma unroll
    for (int r = 0; r < NR; ++r) { s[r] = 0.f;
#pragma unroll
        for (int j = 0; j < 4; ++j) s[r] += (v[r][j].x + v[r][j].y) + (v[r][j].z + v[r][j].w); }
    wave_sum_n<NR>(s);
    float s2[NR];
#pragma unroll
    for (int r = 0; r < NR; ++r) { const float mean = s[r] * (1.f / 1024.f); s2[r] = 0.f;
#pragma unroll
        for (int j = 0; j < 4; ++j) { v[r][j] = v[r][j] - mean; s2[r] += (v[r][j].x * v[r][j].x + v[r][j].y * v[r][j].y) + (v[r][j].z * v[r][j].z + v[r][j].w * v[r][j].w); } }
    wave_sum_n<NR>(s2);
    if (strow) {
#pragma unroll
        for (int r = 0; r < NR; ++r) if (lane == 0) { strow[r][0] = s[r] * (1.f / 1024.f); strow[r][1] = rsqrt_(s2[r] * (1.f / 1024.f) + EPS); }
    }
#pragma unroll
    for (int j = 0; j < 4; ++j) {
        const f32x4 gg = ((const f32x4*)g)[64 * j + lane], bb = ((const f32x4*)bta)[64 * j + lane];
#pragma unroll
        for (int r = 0; r < NR; ++r) {
            const float rstd = rsqrt_(s2[r] * (1.f / 1024.f) + EPS);
            const f32x4 o = v[r][j] * rstd * gg + bb;
            const u32x2 w = {cvtpk(o.x, o.y), cvtpk(o.z, o.w)};
            if (!NOBF) ((u32x2*)orow[r])[64 * j + lane] = w;
            if (ldsrow[r]) ((u32x2*)ldsrow[r])[64 * j + lane] = w;
            if (F8) ((unsigned*)f8row[r])[64 * j + lane] = pk_fp8x4(o.x, o.y, o.z, o.w);
        }
    }
}
__device__ const float INVF[16] = {1.0f, 0.5623413251903491f, 0.31622776601683794f, 0.1778279410038923f, 0.1f, 0.05623413251903491f, 0.031622776601683794f,
    0.01778279410038923f, 0.01f, 0.005623413251903491f, 0.0031622776601683794f, 0.001778279410038923f, 0.001f, 0.0005623413251903491f, 0.00031622776601683794f, 0.0001778279410038923f};
DEV void sincos_d(double a, float& sn, float& cs) {
    const double TWO_PI = 6.283185307179586476925286766559;
    const double k = __builtin_rint(a / TWO_PI);
    const double r = a - k * TWO_PI;
    const double r2 = r * r;
    double st = r, ct = 1.0, ssum = r, csum = 1.0;
#pragma unroll 1
    for (int i = 1; i <= 14; ++i) {
        ct = -ct * r2 / (double)((2 * i - 1) * (2 * i));  csum += ct;
        st = -st * r2 / (double)((2 * i) * (2 * i + 1));  ssum += st;
    }
    sn = (float)ssum; cs = (float)csum;
}
DEV void ew_block(const float* __restrict__ W, int N, int k0, int n0, unsigned char* W8, int ldt, int mode, int lane) {
    const int q = lane & 15, kq = lane >> 4;
    const float* src = W + (size_t)(k0 + 16 * kq) * N + n0 + 4 * q;
    f32x4 v[16];
#pragma unroll
    for (int i = 0; i < 16; ++i) v[i] = *(const f32x4*)(src + (size_t)i * N);
#pragma unroll
    for (int j = 0; j < 4; ++j) {
        u32x4 o;
        o.x = pk_fp8x4(v[0][j] * WSCALE, v[1][j] * WSCALE, v[2][j] * WSCALE, v[3][j] * WSCALE);
        o.y = pk_fp8x4(v[4][j] * WSCALE, v[5][j] * WSCALE, v[6][j] * WSCALE, v[7][j] * WSCALE);
        o.z = pk_fp8x4(v[8][j] * WSCALE, v[9][j] * WSCALE, v[10][j] * WSCALE, v[11][j] * WSCALE);
        o.w = pk_fp8x4(v[12][j] * WSCALE, v[13][j] * WSCALE, v[14][j] * WSCALE, v[15][j] * WSCALE);
        *(u32x4*)(W8 + (size_t)nmap(mode, n0 + 4 * q + j) * ldt + k0 + 16 * kq) = o;
    }
}
DEV void expert_weight_item(const Ctx& c, int r, float*  ) {
    unsigned char* Wgu8 = c.ws + WS_WGU; unsigned char* Wd8 = c.ws + WS_WD;
    if (r < 2048) { const int e = r >> 6, qq = r & 63, kb = qq >> 2, nb = qq & 3;
        ew_block(c.in[I_WGATE] + (size_t)e * D * DE, DE, 64 * kb, 64 * nb, Wgu8 + (size_t)e * 512 * 1024, 1024, 2, c.lane); return; } r -= 2048;
    if (r < 2048) { const int e = r >> 6, qq = r & 63, kb = qq >> 2, nb = qq & 3;
        ew_block(c.in[I_WUP] + (size_t)e * D * DE, DE, 64 * kb, 64 * nb, Wgu8 + (size_t)e * 512 * 1024, 1024, 3, c.lane); return; } r -= 2048;
    { const int e = r >> 6, qq = r & 63, kb = qq >> 4, nb = qq & 15;
        ew_block(c.in[I_WDOWN] + (size_t)e * DE * D, D, 64 * kb, 64 * nb, Wd8 + (size_t)e * 1024 * 256, 256, 0, c.lane); }
}
DEV void phase0(const Ctx& c) {
    float* scr = (float*)(c.lds + c.wid * 8448);
    const int gw = c.vcu * 4 + c.wid, NGW = c.G * 4;
    constexpr int I_IN = 16 * 53, I_UQ = 6 * 24, I_UKV = 4 * 32, I_O = 16 * 32;
    bf16_t* WinT = (bf16_t*)(c.ws + WS_WIN); bf16_t* WuqT = (bf16_t*)(c.ws + WS_WUQ); bf16_t* WukvT = (bf16_t*)(c.ws + WS_WUKV);
    bf16_t* WoT = (bf16_t*)(c.ws + WS_WO);
    constexpr int NITEMS0 = I_IN + I_UQ + I_UKV + I_O;
    for (int it = gw; it < NITEMS0; it += NGW) {
        int r = it;
        if (r < I_IN) { const int kb = r / 53, nb = r % 53; p0_transpose_item(c.in[I_WIN], NIN, 64 * kb, 32 * nb, nullptr, WinT, 1024, 64 * kb, 1, scr, c.lane); continue; } r -= I_IN;
        if (r < I_UQ) { const int kb = r / 24, nb = r % 24; p0_transpose_item(c.in[I_WUQ], NQ, 64 * kb, 32 * nb, c.in[I_QNG], WuqT, QL, 64 * kb, 0, scr, c.lane); continue; } r -= I_UQ;
        if (r < I_UKV) { const int kb = r / 32, nb = r % 32; p0_transpose_item(c.in[I_WUKV], NKV, 64 * kb, 32 * nb, c.in[I_KVNG], WukvT, KVL, 64 * kb, 0, scr, c.lane); continue; } r -= I_UKV;
        { const int kb = r / 32, nb = r % 32;
            if (kb < 8) p0_transpose_item(c.in[I_WO], D, 64 * kb, 32 * nb, nullptr, WoT, 1024, 64 * kb + 512, 0, scr, c.lane);
            else        p0_transpose_item(c.in[I_WO], D, 64 * kb, 32 * nb, c.in[I_AOUT_G] - 512, WoT, 1024, 64 * kb - 512, 0, scr, c.lane); }
    }
    const int gt = c.vcu * 256 + c.tid, NGT = c.G * 256;
    bf16_t* WrT = (bf16_t*)(c.ws + WS_WR);
    for (int i = gt; i < 48 * 1024; i += NGT) {
        const int n = i >> 10, k = i & 1023; float v = 0.f;
        if (n < 4) v = c.in[I_WRG][k * 4 + n]; else if (n < 36) v = c.in[I_WRE][k * 32 + (n - 4)];
        WrT[i] = (bf16_t)(cvtpk(v, 0.f) & 0xffffu);
    }
    float* rc = (float*)(c.ws + WS_ROPE); float* rs = rc + L * 16;
    for (int i = gt; i < L * 16; i += NGT) {
        const int p = i >> 4, f = i & 15; const float ang = (float)p * INVF[f];
        float sn, cs; sincos_d((double)ang, sn, cs); rc[i] = cs; rs[i] = sn;
    }
    bf16_t* h0 = (bf16_t*)(c.ws + WS_H0);
    for (int t = gw; t < T; t += 2 * NGW) {
        const float* src[2]; bf16_t* dst[2]; unsigned char* ldsn[2] = {nullptr, nullptr};
#pragma unroll
        for (int r = 0; r < 2; ++r) { int tt = t + r * NGW; if (tt >= T) tt = t;
            const int b = tt / L, p = tt - b * L;
            src[r] = (p < NMETA) ? c.in[I_META] + (size_t)p * D : c.in[I_X] + ((size_t)b * SEQ + (p - NMETA)) * D;
            dst[r] = h0 + (size_t)tt * D; }
        ln_rows_bf16<2>(src, c.in[I_LNIN_G], c.in[I_LNIN_B], dst, ldsn, c.lane);
    }
}

struct StageGeo { int r[4]; int c; };
DEV StageGeo stage_geo(int tid) {
    const int lane = tid & 63, wid = tid >> 6; StageGeo g;
    const int rl = lane >> 2, cl = ((lane & 3) * 8) ^ ((lane >> 5) << 4);
#pragma unroll
    for (int i = 0; i < 4; ++i) g.r[i] = (((wid + 4 * i) >> 1) << 4) + rl;
    g.c = ((wid & 1) << 5) + cl;
    return g;
}
template <bool SSQ, bool FP8 = false>
DEV void gemm_mainloop(f32x4 (&acc)[4][4], const bf16_t* ap0, const bf16_t* ap1, const bf16_t* ap2, const bf16_t* ap3,
                       const bf16_t* bp0, const bf16_t* bp1, const bf16_t* bp2, const bf16_t* bp3,
                       int nk, unsigned char* lds, int ssq_steps, float ssq_inv_dim, bool skip_wc1 = false) {
    const int tid = threadIdx.x, lane = tid & 63, wid = tid >> 6, wr = wid >> 1, wc = wid & 1, fr = lane & 15, fq = lane >> 4;
    const int xs = (fr >> 1) & 7;
    const int lo = ((fr * 64 + fq * 16) ^ ((fr >> 3) << 5));
    const int lo0 = lo, lo1 = lo + 1024;
    const int a_off = wr * 8192, b_off = 16384 + wc * 8192;
    const int dst = tid * 16;
#pragma unroll
    for (int m = 0; m < 4; ++m)
#pragma unroll
        for (int n = 0; n < 4; ++n) acc[m][n] = (f32x4){0.f, 0.f, 0.f, 0.f};
    __syncthreads();
#define GLDS(src, off) __builtin_amdgcn_global_load_lds((const unsigned*)(src), (unsigned LAS*)(lds + (off)), 16, 0, 0)
#define STAGE(kt, b) do { const int _k = (kt) * 64; \
        GLDS(ap0 + _k, (b) * 32768 + dst);          GLDS(ap1 + _k, (b) * 32768 + dst + 4096); \
        GLDS(ap2 + _k, (b) * 32768 + dst + 8192);   GLDS(ap3 + _k, (b) * 32768 + dst + 12288); \
        GLDS(bp0 + _k, (b) * 32768 + 16384 + dst);  GLDS(bp1 + _k, (b) * 32768 + 16384 + dst + 4096); \
        GLDS(bp2 + _k, (b) * 32768 + 16384 + dst + 8192); GLDS(bp3 + _k, (b) * 32768 + 16384 + dst + 12288); } while (0)
    STAGE(0, 0);
    for (int kt = 0; kt < nk; ++kt) {
        VM_WAIT();
        __syncthreads();
        const int b = kt & 1;
        if (SSQ && kt == ssq_steps) {
            const float* rsl = (const float*)(lds + RS_OFF);
#pragma unroll
            for (int m = 0; m < 4; ++m) { const float r = rsl[wr * 64 + m * 16 + fr];
#pragma unroll
                for (int n = 0; n < 4; ++n) acc[m][n] = acc[m][n] * r; }
        }
        if (kt + 1 < nk) { if (b) STAGE(kt + 1, 0); else STAGE(kt + 1, 1); }
        const unsigned char* base = lds + b * 32768;
        if (skip_wc1 && wc == 1) {
        } else if (FP8) {
            const int cb0 = fq * 32, cb1 = fq * 32 + 16;
            const int q0 = (cb0 >> 6) * 1024 + ((fr * 64 + (cb0 & 63)) ^ ((fr >> 3) << 5)), q1 = (cb1 >> 6) * 1024 + ((fr * 64 + (cb1 & 63)) ^ ((fr >> 3) << 5));
            v8i ax[4], bx[4];
#pragma unroll
            for (int m = 0; m < 4; ++m) { const u32x4 c0 = *(const u32x4*)(base + a_off + m * 2048 + q0), c1 = *(const u32x4*)(base + a_off + m * 2048 + q1);
                ax[m] = (v8i){(int)c0.x, (int)c0.y, (int)c0.z, (int)c0.w, (int)c1.x, (int)c1.y, (int)c1.z, (int)c1.w}; }
#pragma unroll
            for (int n = 0; n < 4; ++n) { const u32x4 c0 = *(const u32x4*)(base + b_off + n * 2048 + q0), c1 = *(const u32x4*)(base + b_off + n * 2048 + q1);
                bx[n] = (v8i){(int)c0.x, (int)c0.y, (int)c0.z, (int)c0.w, (int)c1.x, (int)c1.y, (int)c1.z, (int)c1.w}; }
#pragma unroll
            for (int m = 0; m < 4; ++m)
#pragma unroll
                for (int n = 0; n < 4; ++n) acc[m][n] = __builtin_amdgcn_mfma_scale_f32_16x16x128_f8f6f4(bx[n], ax[m], acc[m][n], 0, 0, 0, 0x7F7F7F7F, 0, 0x7F7F7F7F);
        } else {
#pragma unroll
        for (int ks = 0; ks < 2; ++ks) {
            bf16x8 af[4], bf[4];
#pragma unroll
            for (int m = 0; m < 4; ++m) af[m] = *(const bf16x8*)(base + a_off + m * 2048 + (ks ? lo1 : lo0));
#pragma unroll
            for (int n = 0; n < 4; ++n) bf[n] = *(const bf16x8*)(base + b_off + n * 2048 + (ks ? lo1 : lo0));
#pragma unroll
            for (int m = 0; m < 4; ++m)
#pragma unroll
                for (int n = 0; n < 4; ++n) acc[m][n] = __builtin_amdgcn_mfma_f32_16x16x32_bf16(bf[n], af[m], acc[m][n], 0, 0, 0);
        }
        }
    }
    if (SSQ && ssq_steps == nk) {
        __syncthreads();
        const float* rsl = (const float*)(lds + RS_OFF);
#pragma unroll
        for (int m = 0; m < 4; ++m) { const float r = rsl[wr * 64 + m * 16 + fr];
#pragma unroll
            for (int n = 0; n < 4; ++n) acc[m][n] = acc[m][n] * r; }
    }
#undef STAGE
#undef GLDS
}

DEV void phase1(const Ctx& c) {
    const bf16_t* h0 = (const bf16_t*)(c.ws + WS_H0); const bf16_t* WinT = (const bf16_t*)(c.ws + WS_WIN);
    bf16_t* U = (bf16_t*)(c.ws + WS_U); bf16_t* CQ = (bf16_t*)(c.ws + WS_CQ); bf16_t* CKV = (bf16_t*)(c.ws + WS_CKV); bf16_t* KR = (bf16_t*)(c.ws + WS_KR);
    const float* rc = (const float*)(c.ws + WS_ROPE); const float* rs = rc + L * 16;
    const StageGeo g = stage_geo(c.tid);
    const int lane = c.lane, wr = c.wid >> 1, wc = c.wid & 1, fr = lane & 15, fq = lane >> 4;
    constexpr int NT = 14, NU = (T / 128) * NT;
    for (int u = c.vcu; u < NU; u += c.G) {
        const int mt = u / NT, nt = u - mt * NT;
        const bf16_t* A = h0 + (size_t)(mt * 128) * D + g.c; const bf16_t* B = WinT + (size_t)(nt * 128) * D + g.c;
        f32x4 acc[4][4];
        gemm_mainloop<false>(acc, A + (size_t)g.r[0] * D, A + (size_t)g.r[1] * D, A + (size_t)g.r[2] * D, A + (size_t)g.r[3] * D,
                             B + (size_t)g.r[0] * D, B + (size_t)g.r[1] * D, B + (size_t)g.r[2] * D, B + (size_t)g.r[3] * D, 16, c.lds, 0, 0.f, nt == 13);
        const int row0 = mt * 128 + wr * 64 + fr;
        if (nt < 8) {
#pragma unroll
            for (int m = 0; m < 4; ++m) { const size_t row = row0 + m * 16;
#pragma unroll
                for (int i = 0; i < 2; ++i) {
                    f32x4 a = acc[m][2 * i], gt = acc[m][2 * i + 1], o;
#pragma unroll
                    for (int j = 0; j < 4; ++j) o[j] = a[j] * sigmoidf_(gt[j]);
                    st_bf4(U + row * CC + nt * 64 + wc * 32 + i * 16 + fq * 4, o);
                } }
        } else if (nt < 13) {
            const bool isq = nt < 11;
            bf16_t* dstb = isq ? CQ + (nt - 8) * 128 + wc * 64 + fq * 4 : CKV + (nt - 11) * 128 + wc * 64 + fq * 4;
            const int ldd = isq ? QL : KVL;
            float* ssb = isq ? (float*)(c.ws + WS_SSQ_CQ) + (nt - 8) * 2 + wc : (float*)(c.ws + WS_SSQ_CKV) + (nt - 11) * 2 + wc;
            const int lds_ = isq ? 8 : 4;
#pragma unroll
            for (int m = 0; m < 4; ++m) { const size_t row = row0 + m * 16; float sq = 0.f;
#pragma unroll
                for (int n = 0; n < 4; ++n) { st_bf4(dstb + row * ldd + n * 16, acc[m][n]);
                    sq += (acc[m][n][0] * acc[m][n][0] + acc[m][n][1] * acc[m][n][1]) + (acc[m][n][2] * acc[m][n][2] + acc[m][n][3] * acc[m][n][3]); }
                sq += __shfl_xor(sq, 16); sq += __shfl_xor(sq, 32);
                if (fq == 0) ssb[row * lds_] = sq; }
        } else if (wc == 0) {
#pragma unroll
            for (int m = 0; m < 4; ++m) { const int row = row0 + m * 16; const int p = row % L;
                const f32x4 cs = *(const f32x4*)(rc + p * 16 + fq * 4), sn = *(const f32x4*)(rs + p * 16 + fq * 4);
                const f32x4 x1 = acc[m][0], x2 = acc[m][1];
                st_bf4(KR + (size_t)row * 32 + fq * 4, x1 * cs - x2 * sn);
                st_bf4(KR + (size_t)row * 32 + 16 + fq * 4, x1 * sn + x2 * cs); }
        }
    }
}

DEV void conv_unit(const Ctx& c, int b, int j) {
    const bf16_t* U = (const bf16_t*)(c.ws + WS_U);
    bf16_t* MG = (bf16_t*)(c.ws + WS_MG);
    const float* cw = c.in[I_CONVW]; const float* cb = c.in[I_CONVB];
    const int p0 = NMETA + j * 32;
    float* ytile = (float*)c.lds;
    __syncthreads();
#pragma unroll 1
    for (int pass = 0; pass < 2; ++pass) {
        const int ch = c.tid + 256 * pass;
        float win[62]; unsigned raw[62];
        const bf16_t* ub = U + (size_t)b * L * CC + ch;
#pragma unroll
        for (int rep = 0; rep < CONV_REPA; ++rep) {
        asm volatile("" : "+v"(ub) :: "memory");
#pragma unroll
        for (int i = 0; i < 62; ++i) { const int p = p0 - 30 + i; const int pc = p < 0 ? 0 : (p >= L ? L - 1 : p); raw[i] = ub[(size_t)pc * CC]; }
        if (rep + 1 < CONV_REPA) {
#pragma unroll
            for (int i = 0; i < 62; ++i) asm volatile("" :: "v"(raw[i]));
        }
        }
        float w[31];
#pragma unroll
        for (int k = 0; k < 31; ++k) w[k] = cw[k * CC + ch];
        float bias = cb[ch];
        __builtin_amdgcn_sched_barrier(0);
#pragma unroll
        for (int i = 0; i < 62; ++i) { const int p = p0 - 30 + i; win[i] = (p >= 0 && p < L) ? __uint_as_float(raw[i] << 16) : 0.f; }
#pragma unroll
        for (int rep = 0; rep < CONV_REPB; ++rep) {
        asm volatile("" : "+v"(bias) :: "memory");
#pragma unroll
        for (int tt = 0; tt < 32; ++tt) {
            float a0 = bias;
#pragma unroll
            for (int k = 0; k < 31; ++k) a0 += w[k] * win[tt + k];
            ytile[tt * 512 + ch] = a0;
        }
        }
    }
    __syncthreads();
    const float* g1 = c.in[I_CLN_G]; const float* b1 = c.in[I_CLN_B]; const float* g2 = c.in[I_COUT_G];
    float G1[8], B1[8], G2[8];
    { const f32x4 a = *(const f32x4*)(g1 + c.lane * 8), bq = *(const f32x4*)(g1 + c.lane * 8 + 4); G1[0]=a.x;G1[1]=a.y;G1[2]=a.z;G1[3]=a.w;G1[4]=bq.x;G1[5]=bq.y;G1[6]=bq.z;G1[7]=bq.w; }
    { const f32x4 a = *(const f32x4*)(b1 + c.lane * 8), bq = *(const f32x4*)(b1 + c.lane * 8 + 4); B1[0]=a.x;B1[1]=a.y;B1[2]=a.z;B1[3]=a.w;B1[4]=bq.x;B1[5]=bq.y;B1[6]=bq.z;B1[7]=bq.w; }
    { const f32x4 a = *(const f32x4*)(g2 + c.lane * 8), bq = *(const f32x4*)(g2 + c.lane * 8 + 4); G2[0]=a.x;G2[1]=a.y;G2[2]=a.z;G2[3]=a.w;G2[4]=bq.x;G2[5]=bq.y;G2[6]=bq.z;G2[7]=bq.w; }
#pragma unroll
    for (int rep = 0; rep < CONV_REPC; ++rep) {
    asm volatile("" : "+v"(ytile) :: "memory");
    float v[8][8]; float st[8];
#pragma unroll
    for (int i = 0; i < 8; ++i) { const int tt = c.wid * 8 + i;
        const f32x4 ya = *(const f32x4*)(ytile + tt * 512 + c.lane * 8), yb = *(const f32x4*)(ytile + tt * 512 + c.lane * 8 + 4);
        v[i][0]=ya.x;v[i][1]=ya.y;v[i][2]=ya.z;v[i][3]=ya.w;v[i][4]=yb.x;v[i][5]=yb.y;v[i][6]=yb.z;v[i][7]=yb.w;
        st[i] = ((v[i][0] + v[i][1]) + (v[i][2] + v[i][3])) + ((v[i][4] + v[i][5]) + (v[i][6] + v[i][7])); }
    wave_sum_n<8>(st);
#pragma unroll
    for (int i = 0; i < 8; ++i) { const float mean = st[i] * (1.f / 512.f); float a = 0.f;
#pragma unroll
        for (int q = 0; q < 8; ++q) { v[i][q] -= mean; a += v[i][q] * v[i][q]; }
        st[i] = a; }
    wave_sum_n<8>(st);
#pragma unroll
    for (int i = 0; i < 8; ++i) { const float rstd = rsqrt_(st[i] * (1.f / 512.f) + EPS); float a = 0.f;
#pragma unroll
        for (int q = 0; q < 8; ++q) { const float x = v[i][q] * rstd * G1[q] + B1[q]; const float y = x * sigmoidf_(x); v[i][q] = y; a += y * y; }
        st[i] = a; }
    wave_sum_n<8>(st);
#pragma unroll
    for (int i = 0; i < 8; ++i) {
        const int p = p0 + c.wid * 8 + i;
        {
            const float r2 = rsqrt_(st[i] * (1.f / 512.f) + EPS);
            u32x4 o;
            o.x = cvtpk(v[i][0] * r2 * G2[0], v[i][1] * r2 * G2[1]); o.y = cvtpk(v[i][2] * r2 * G2[2], v[i][3] * r2 * G2[3]);
            o.z = cvtpk(v[i][4] * r2 * G2[4], v[i][5] * r2 * G2[5]); o.w = cvtpk(v[i][6] * r2 * G2[6], v[i][7] * r2 * G2[7]);
            const size_t tok = (size_t)b * SEQ + (p - NMETA);
            bf16_t* dstp = (p >= NMETA && p < L) ? MG + tok * D + 512 + c.lane * 8 : (bf16_t*)(c.ws + WS_DUMMY) + c.lane * 8;
            *(u32x4*)dstp = o;
        }
    }
    }
}
DEV void rope4(f32x4& x1, f32x4& x2, const float* rc, const float* rs, int p, int fq) {
    const f32x4 cs = *(const f32x4*)(rc + p * 16 + fq * 4), sn = *(const f32x4*)(rs + p * 16 + fq * 4);
    const f32x4 a = x1 * cs - x2 * sn, bb = x1 * sn + x2 * cs; x1 = a; x2 = bb;
}
DEV void phase2(const Ctx& c) {
    const bf16_t* CQ = (const bf16_t*)(c.ws + WS_CQ); const bf16_t* CKV = (const bf16_t*)(c.ws + WS_CKV);
    const bf16_t* WuqT = (const bf16_t*)(c.ws + WS_WUQ); const bf16_t* WukvT = (const bf16_t*)(c.ws + WS_WUKV);
    bf16_t* Q = (bf16_t*)(c.ws + WS_Q); bf16_t* KV = (bf16_t*)(c.ws + WS_KV);
    const float* rc = (const float*)(c.ws + WS_ROPE); const float* rs = rc + L * 16;
    const StageGeo g = stage_geo(c.tid);
    const int lane = c.lane, wr = c.wid >> 1, wc = c.wid & 1, fr = lane & 15, fq = lane >> 4;
    constexpr int NUC = NB * 64, NUQ = (TR / 128) * 6, NUKV = (TR / 128) * 8 + 8, NU = NUC + NUQ + NUKV;
    for (int u = c.vcu; u < NU; u += c.G) {
        if (u < NUC) {
            conv_unit(c, u >> 6, u & 63);
        } else if (u < NUC + NUQ) {
            const int v = u - NUC, mt = v / 6, nt = v - mt * 6;
            const size_t t0 = (size_t)(mt >> 4) * L + NMETA + (mt & 15) * 128;
            const bf16_t* A = CQ + t0 * QL + g.c; const bf16_t* B = WuqT + (size_t)(nt * 128) * QL + g.c;
            f32x4 acc[4][4];
            __syncthreads();
            if (c.tid < 128) { const float* pp = (const float*)(c.ws + WS_SSQ_CQ) + (t0 + c.tid) * 8; const f32x4 p4 = *(const f32x4*)pp; const float2 p2 = *(const float2*)(pp + 4);
                ((float*)(c.lds + RS_OFF))[c.tid] = rsqrt_((((p4.x + p4.y) + (p4.z + p4.w)) + (p2.x + p2.y)) * (1.f / 384.f) + EPS); }
            gemm_mainloop<true>(acc, A + (size_t)g.r[0] * QL, A + (size_t)g.r[1] * QL, A + (size_t)g.r[2] * QL, A + (size_t)g.r[3] * QL,
                                B + (size_t)g.r[0] * QL, B + (size_t)g.r[1] * QL, B + (size_t)g.r[2] * QL, B + (size_t)g.r[3] * QL, 6, c.lds, 6, 1.f / 384.f);
            const int p0 = NMETA + (mt & 15) * 128 + wr * 64 + fr;
            const int t16 = (nt * 8 + wc * 4) % 6;
#pragma unroll
            for (int m = 0; m < 4; ++m) { const size_t row = t0 + wr * 64 + m * 16 + fr; const int p = p0 + m * 16;
#pragma unroll
                for (int n = 0; n < 4; ++n) acc[m][n] = acc[m][n] * QSCALE;
                if (t16 == 4) rope4(acc[m][0], acc[m][1], rc, rs, p, fq);
                if (t16 == 2) rope4(acc[m][2], acc[m][3], rc, rs, p, fq);
#pragma unroll
                for (int n = 0; n < 4; ++n) st_bf4(Q + row * NQ + nt * 128 + wc * 64 + n * 16 + fq * 4, acc[m][n]); }
        } else {
            const int v = u - NUC - NUQ; const bool meta = v >= (TR / 128) * 8;
            const int mt = meta ? 0 : v >> 3, nt = meta ? v - (TR / 128) * 8 : v & 7;
            const size_t t0 = meta ? 0 : (size_t)(mt >> 4) * L + NMETA + (mt & 15) * 128;
            const int rmask = meta ? 15 : 127;
            const bf16_t* A = CKV + t0 * KVL + g.c; const bf16_t* B = WukvT + (size_t)(nt * 128) * KVL + g.c;
            f32x4 acc[4][4];
            __syncthreads();
            if (c.tid < 128) { const f32x4 p4 = *(const f32x4*)((const float*)(c.ws + WS_SSQ_CKV) + (t0 + (c.tid & rmask)) * 4);
                ((float*)(c.lds + RS_OFF))[c.tid] = rsqrt_(((p4.x + p4.y) + (p4.z + p4.w)) * (1.f / 256.f) + EPS); }
            gemm_mainloop<true>(acc, A + (size_t)(g.r[0] & rmask) * KVL, A + (size_t)(g.r[1] & rmask) * KVL, A + (size_t)(g.r[2] & rmask) * KVL, A + (size_t)(g.r[3] & rmask) * KVL,
                                B + (size_t)g.r[0] * KVL, B + (size_t)g.r[1] * KVL, B + (size_t)g.r[2] * KVL, B + (size_t)g.r[3] * KVL, 4, c.lds, 4, 1.f / 256.f);
            if (!meta) {
#pragma unroll
                for (int m = 0; m < 4; ++m) { const size_t row = t0 + wr * 64 + m * 16 + fr;
#pragma unroll
                    for (int n = 0; n < 4; ++n) st_bf4(KV + row * NKV + nt * 128 + wc * 64 + n * 16 + fq * 4, acc[m][n]); }
            } else if (wr == 0) {
#pragma unroll 1
                for (int bb = 0; bb < NB; ++bb) {
#pragma unroll
                    for (int n = 0; n < 4; ++n) st_bf4(KV + ((size_t)bb * L + fr) * NKV + nt * 128 + wc * 64 + n * 16 + fq * 4, acc[0][n]); }
            }
        }
    }
}
DEV int crow(int r, int hi) { return (r & 3) + 8 * (r >> 2) + 4 * hi; }
#define KSWZ(row, colB) ((row) * 256 + ((colB) ^ (((row) & 7) << 4)))
#define SBAR() __builtin_amdgcn_sched_barrier(0)
DEV int v_st(int k, int cc) { const int kk = (k & ~0xC) | ((k & 4) << 1) | ((k & 8) >> 1); return ((kk >> 3) * 4 + (cc >> 5)) * 512 + ((kk & 7) * 32 + (cc & 31)) * 2; }
DEV int v_rd_base(int lane) { return ((lane & 3) << 3) | (((lane >> 2) & 3) << 6) | (((lane >> 4) & 1) << 5) | (((lane >> 5) & 1) << 8); }
constexpr int v_rd_off(int d0, int ks, int half) { return d0 * 512 + ks * 4096 + half * 2048; }
template <int OFF> DEV s16x4 tr_read(int vb) { s16x4 r; asm volatile("ds_read_b64_tr_b16 %0, %1 offset:%2" : "=&v"(r) : "v"(vb), "i"(OFF) : "memory"); return r; }
template <int D0> DEV void pv_one(f32x16& od, int vb, bf16x8 pa0, bf16x8 pa1, bf16x8 pa2, bf16x8 pa3) {
    const s16x4 l0 = tr_read<v_rd_off(D0, 0, 0)>(vb), h0 = tr_read<v_rd_off(D0, 0, 1)>(vb), l1 = tr_read<v_rd_off(D0, 1, 0)>(vb), h1 = tr_read<v_rd_off(D0, 1, 1)>(vb);
    const s16x4 l2 = tr_read<v_rd_off(D0, 2, 0)>(vb), h2 = tr_read<v_rd_off(D0, 2, 1)>(vb), l3 = tr_read<v_rd_off(D0, 3, 0)>(vb), h3 = tr_read<v_rd_off(D0, 3, 1)>(vb);
    asm volatile("s_waitcnt lgkmcnt(0)" ::: "memory"); SBAR();
#define PK(Lo, Hi) (bf16x8){Lo[0], Lo[1], Lo[2], Lo[3], Hi[0], Hi[1], Hi[2], Hi[3]}
    od = __builtin_amdgcn_mfma_f32_32x32x16_bf16(pa0, PK(l0, h0), od, 0, 0, 0);
    od = __builtin_amdgcn_mfma_f32_32x32x16_bf16(pa1, PK(l1, h1), od, 0, 0, 0);
    od = __builtin_amdgcn_mfma_f32_32x32x16_bf16(pa2, PK(l2, h2), od, 0, 0, 0);
    od = __builtin_amdgcn_mfma_f32_32x32x16_bf16(pa3, PK(l3, h3), od, 0, 0, 0);
#undef PK
}
constexpr float ATT_THR = 8.f;
constexpr int AT_V = 0, AT_K = 32768, AT_WS = 65536;
DEV void attn_unit(const Ctx& c, int b, int h, int qb) {
    const bf16_t* Q = (const bf16_t*)(c.ws + WS_Q); const bf16_t* KV = (const bf16_t*)(c.ws + WS_KV); const bf16_t* KR = (const bf16_t*)(c.ws + WS_KR);
    bf16_t* MG = (bf16_t*)(c.ws + WS_MG);
    unsigned char* lds = c.lds;
    const int tid = c.tid, wid = c.wid, lane = c.lane, r32 = lane & 31, hi = lane >> 5;
    float* wsf = (float*)(lds + AT_WS) + wid * 64; float* li_l = wsf; float* al_l = wsf + 32;
    const int NT = 2 * qb + 3;
    const int my_last = 2 * qb + (wid >> 1) + 1;
    bf16x8 qr[6];
    { const size_t t = (size_t)b * L + NMETA + qb * 128 + wid * 32 + r32;
      const bf16_t* Qw = Q + t * NQ + h * DQK + hi * 8;
#pragma unroll
      for (int d0 = 0; d0 < 6; ++d0) qr[d0] = *(const bf16x8*)(Qw + d0 * 16); }
    const int srow = tid >> 2, sq = tid & 3;
    const int vst0 = v_st(srow, sq * 16), vst1 = v_st(srow, sq * 16 + 8);
    const int kst0 = KSWZ(srow, sq * 32), kst1 = KSWZ(srow, sq * 32 + 16), kst2 = KSWZ(srow, 128 + sq * 16);
    const int vb0 = (int)(uintptr_t)(lds + AT_V) + v_rd_base(lane);
    u32x4 sk0, sk1, sk2, sv0, sv1;
#define SLOAD(j) do { int pos = (j) * 64 + srow - 48; pos = pos < 0 ? 0 : pos; const size_t tk = (size_t)b * L + pos; \
        const bf16_t* kvp = KV + tk * NKV + h * 128 + sq * 16; \
        sk0 = *(const u32x4*)(kvp); sk1 = *(const u32x4*)(kvp + 8); sv0 = *(const u32x4*)(kvp + 64); sv1 = *(const u32x4*)(kvp + 72); \
        sk2 = *(const u32x4*)(KR + tk * 32 + sq * 8); } while (0)
#define SWRITE(bb) do { unsigned char* kb = lds + AT_K + (bb) * 16384; unsigned char* vbp = lds + AT_V + (bb) * 16384; \
        *(u32x4*)(kb + kst0) = sk0; *(u32x4*)(kb + kst1) = sk1; *(u32x4*)(kb + kst2) = sk2; *(u32x4*)(vbp + vst0) = sv0; *(u32x4*)(vbp + vst1) = sv1; } while (0)
    float m_reg = 0.f, l_reg = 0.f; f32x16 o[2] = {};
    __syncthreads();
    SLOAD(0); SWRITE(0); __syncthreads();
    for (int j = 0; j < NT; ++j) {
        const int bsel = j & 1;
        if (j + 1 < NT) SLOAD(j + 1);
        if (j <= my_last) {
            const unsigned char* Ks = lds + AT_K + bsel * 16384;
            f32x16 p0, p1;
            { const float nm = -m_reg;
#pragma unroll
              for (int r = 0; r < 16; ++r) { p0[r] = nm; p1[r] = nm; } }
            __builtin_amdgcn_s_setprio(1);
#pragma unroll
            for (int d0 = 0; d0 < 6; ++d0) { const int cb = (d0 * 16 + hi * 8) * 2;
                const bf16x8 k0 = *(const bf16x8*)(Ks + KSWZ(r32, cb)); const bf16x8 k1 = *(const bf16x8*)(Ks + KSWZ(32 + r32, cb));
                p0 = __builtin_amdgcn_mfma_f32_32x32x16_bf16(k0, qr[d0], p0, 0, 0, 0);
                p1 = __builtin_amdgcn_mfma_f32_32x32x16_bf16(k1, qr[d0], p1, 0, 0, 0); }
            __builtin_amdgcn_s_setprio(0);
            if (j == 0) {
#pragma unroll
                for (int r = 0; r < 16; ++r) p0[r] = -1e30f;
#pragma unroll
                for (int r = 0; r < 8; ++r) p1[r] = -1e30f;
            }
            float pmax = fmaxf(fmaxf(p0[0], p0[1]), p0[2]);
#pragma unroll
            for (int r = 3; r < 15; r += 2) pmax = fmaxf(fmaxf(pmax, p0[r]), p0[r + 1]);
            pmax = fmaxf(fmaxf(pmax, p0[15]), p1[0]);
#pragma unroll
            for (int r = 1; r < 15; r += 2) pmax = fmaxf(fmaxf(pmax, p1[r]), p1[r + 1]);
            pmax = fmaxf(pmax, p1[15]);
            { auto rr = __builtin_amdgcn_permlane32_swap(__float_as_uint(pmax), __float_as_uint(pmax), false, false);
              pmax = fmaxf(__uint_as_float(rr[0]), __uint_as_float(rr[1])); }
            float ps = 0.f;
            if (__any(pmax > ATT_THR)) {
                const float dm = fmaxf(pmax, 0.f), alpha = fast_exp2(-dm); m_reg += dm;
#pragma unroll
                for (int r = 0; r < 16; ++r) { p0[r] -= dm; p1[r] -= dm; }
                l_reg *= alpha;
                if (hi == 0) al_l[r32] = alpha;
                asm volatile("s_waitcnt lgkmcnt(0)" ::: "memory");
#pragma unroll
                for (int r = 0; r < 16; ++r) { const float a = al_l[crow(r, hi)]; o[0][r] *= a; o[1][r] *= a; }
            }
#pragma unroll
            for (int r = 0; r < 16; ++r) { p0[r] = fast_exp2(p0[r]); ps += p0[r]; }
#pragma unroll
            for (int r = 0; r < 16; ++r) { p1[r] = fast_exp2(p1[r]); ps += p1[r]; }
            { auto rr = __builtin_amdgcn_permlane32_swap(__float_as_uint(ps), __float_as_uint(ps), false, false);
              ps = __uint_as_float(rr[0]) + __uint_as_float(rr[1]); }
            l_reg += ps;
            bf16x8 pa0, pa1, pa2, pa3;
#define PK4(P, BASE, OUT) do { unsigned a0 = cvtpk(P[BASE + 0], P[BASE + 1]), a1 = cvtpk(P[BASE + 2], P[BASE + 3]);   \
    unsigned b0 = cvtpk(P[BASE + 4], P[BASE + 5]), b1 = cvtpk(P[BASE + 6], P[BASE + 7]);                              \
    auto r0 = __builtin_amdgcn_permlane32_swap(a0, b0, false, false); auto r1 = __builtin_amdgcn_permlane32_swap(a1, b1, false, false); \
    u32x4 w = {r0[0], r1[0], r0[1], r1[1]}; OUT = *reinterpret_cast<bf16x8*>(&w); } while (0)
            PK4(p0, 0, pa0); PK4(p0, 8, pa1); PK4(p1, 0, pa2); PK4(p1, 8, pa3);
#undef PK4
            const int vb = vb0 + bsel * 16384;
            __builtin_amdgcn_s_setprio(1);
            pv_one<0>(o[0], vb, pa0, pa1, pa2, pa3); pv_one<1>(o[1], vb, pa0, pa1, pa2, pa3);
            __builtin_amdgcn_s_setprio(0);
        }
        if (j + 1 < NT) { if (bsel) SWRITE(0); else SWRITE(1); }
        __syncthreads();
    }
    if (hi == 0) li_l[r32] = l_reg;
    asm volatile("s_waitcnt lgkmcnt(0)" ::: "memory");
    const size_t tok0 = (size_t)b * SEQ + qb * 128 + wid * 32;
    float* SSO = (float*)(c.ws + WS_SSQ_O);
#pragma unroll
    for (int r = 0; r < 16; ++r) {
        const int orow = crow(r, hi); const float rl = fast_rcp(li_l[orow]);
        bf16_t* dst = MG + (tok0 + orow) * D + h * DV + r32;
        const float a0 = o[0][r] * rl, a1 = o[1][r] * rl;
        dst[0]  = (bf16_t)(cvtpk(a0, 0.f) & 0xffffu);
        dst[32] = (bf16_t)(cvtpk(a1, 0.f) & 0xffffu);
        float sq = a0 * a0 + a1 * a1;
        sq += dpp_mov<0xB1>(sq); sq += dpp_mov<0x4E>(sq); sq += dpp_mov<0x141>(sq); sq += dpp_mov<0x140>(sq);
        sq += __shfl_xor(sq, 16);
        if (r32 == 0) SSO[(tok0 + orow) * 8 + h] = sq;
    }
#undef SLOAD
#undef SWRITE
}
DEV void phase3(const Ctx& c) {
    const int nslots = NB * NH * 4;
    float* scr = (float*)(c.lds + c.wid * 8448);
    const int gw = c.vcu * 4 + c.wid, NGW = c.G * 4;
    constexpr int NWI = 6144;
    int wi = gw;
#define EW_ITEMS(n) do { __syncthreads(); for (int _q = 0; _q < (n) && wi < NWI; ++_q, wi += NGW) expert_weight_item(c, wi, scr); } while (0)
    for (int v = c.vcu; v < nslots; v += c.G) {
        const int bh = v >> 2, s = v & 3, b = bh >> 3, h = bh & 7;
        attn_unit(c, b, h, 15 - s); EW_ITEMS(1); attn_unit(c, b, h, s); EW_ITEMS(1); attn_unit(c, b, h, 11 - s); EW_ITEMS(1); attn_unit(c, b, h, 4 + s);
    }
    __syncthreads();
    for (; wi < NWI; wi += NGW) expert_weight_item(c, wi, scr);
#undef EW_ITEMS
}

DEV void phase4(const Ctx& c) {
    const bf16_t* MG = (const bf16_t*)(c.ws + WS_MG); const bf16_t* WoT = (const bf16_t*)(c.ws + WS_WO); const bf16_t* h0 = (const bf16_t*)(c.ws + WS_H0);
    bf16_t* R1 = (bf16_t*)(c.ws + WS_R1);
    const StageGeo g = stage_geo(c.tid);
    const int lane = c.lane, wr = c.wid >> 1, wc = c.wid & 1, fr = lane & 15, fq = lane >> 4;
    constexpr int NU = (TR / 128) * 8;
    const float* SSO = (const float*)(c.ws + WS_SSQ_O);
    f32x4 pa = {1.f, 1.f, 1.f, 1.f}, pb = pa;
    if (c.vcu < NU && c.tid < 128) { const float* pp = SSO + (size_t)((c.vcu >> 3) * 128 + c.tid) * 8; pa = *(const f32x4*)pp; pb = *(const f32x4*)(pp + 4); }
    for (int u = c.vcu; u < NU; u += c.G) {
        const int mt = u >> 3, nt = u & 7;
        const bf16_t* A = MG + (size_t)(mt * 128) * D + g.c; const bf16_t* B = WoT + (size_t)(nt * 128) * D + g.c;
        f32x4 acc[4][4];
        __syncthreads();
        if (c.tid < 128) ((float*)(c.lds + RS_OFF))[c.tid] = rsqrt_((((pa.x + pa.y) + (pa.z + pa.w)) + ((pb.x + pb.y) + (pb.z + pb.w))) * (1.f / 512.f) + EPS);
        { const int un = u + c.G; if (un < NU && c.tid < 128) { const float* pp = SSO + (size_t)((un >> 3) * 128 + c.tid) * 8; pa = *(const f32x4*)pp; pb = *(const f32x4*)(pp + 4); } }
        u32x2 hw[4][4];
#pragma unroll
        for (int m = 0; m < 4; ++m) {
            const int tok = mt * 128 + wr * 64 + m * 16 + fr;
            const size_t t = (size_t)(tok >> 11) * L + NMETA + (tok & 2047);
#pragma unroll
            for (int n = 0; n < 4; ++n) hw[m][n] = *(const u32x2*)(h0 + t * D + nt * 128 + wc * 64 + n * 16 + fq * 4);
        }
        gemm_mainloop<true>(acc, A + (size_t)g.r[0] * D, A + (size_t)g.r[1] * D, A + (size_t)g.r[2] * D, A + (size_t)g.r[3] * D,
                            B + (size_t)g.r[0] * D, B + (size_t)g.r[1] * D, B + (size_t)g.r[2] * D, B + (size_t)g.r[3] * D, 16, c.lds, 8, 1.f / 512.f);
#pragma unroll
        for (int m = 0; m < 4; ++m) {
            const int tok = mt * 128 + wr * 64 + m * 16 + fr;
#pragma unroll
            for (int n = 0; n < 4; ++n) {
                const int col = nt * 128 + wc * 64 + n * 16 + fq * 4;
                f32x4 o; o[0] = ALPHA * bflo(hw[m][n].x) + acc[m][n][0]; o[1] = ALPHA * bfhi(hw[m][n].x) + acc[m][n][1];
                o[2] = ALPHA * bflo(hw[m][n].y) + acc[m][n][2]; o[3] = ALPHA * bfhi(hw[m][n].y) + acc[m][n][3];
                st_bf4(R1 + (size_t)tok * D + col, o);
            }
        }
    }
}

constexpr int P5_ROWB = 2064, P5_PART = 33280, P5_LG = 45568, P5_BIAS = 48128, P5_AGG = 48384;
DEV void phase5(const Ctx& c, int ALT = 0) {
    const bf16_t* R1 = (const bf16_t*)(c.ws + WS_R1);
    const bf16_t* WrT = (const bf16_t*)(c.ws + WS_WR);
    unsigned* cnt = (unsigned*)(c.ws + WS_CTL) + CW_CNT + ALT * 32; unsigned* list = (unsigned*)(c.ws + (ALT ? 404 * MiB : WS_LIST)); float* combw = (float*)(c.ws + WS_COMBW);
    const int lane = c.lane, wid = c.wid, fr = lane & 15, fq = lane >> 4;
    float* part = (float*)(c.lds + P5_PART); float* lgs = (float*)(c.lds + P5_LG); float* biasl = (float*)(c.lds + P5_BIAS);
    __syncthreads();
    if (c.tid < 36) biasl[c.tid] = (c.tid < 4) ? c.in[I_BRG][c.tid] : c.in[I_BRE][c.tid - 4];
    bf16x8 wf[8][3];
#pragma unroll
    for (int ks = 0; ks < 8; ++ks)
#pragma unroll
        for (int n = 0; n < 3; ++n) wf[ks][n] = *(const bf16x8*)(WrT + (size_t)(n * 16 + fr) * D + wid * 256 + ks * 32 + fq * 8);
    unsigned* lcnt = (unsigned*)(c.lds + P5_AGG); unsigned* lbase = lcnt + 32; unsigned* ent = lcnt + 64;
    if (c.tid < 32) lcnt[c.tid] = 0u;
    int nent = 0;
    for (int u = c.vcu; u < TR / 16; u += c.G) {
        const int tok0 = u * 16;
        { const float* src[4]; bf16_t* dst[4]; unsigned char* ldsn[4]; unsigned char* f8n[4]; float* stn[4];
#pragma unroll
          for (int i = 0; i < 4; ++i) { const int tl = wid * 4 + i; const size_t tok = tok0 + tl; src[i] = (const float*)(R1 + tok * D); dst[i] = nullptr; ldsn[i] = c.lds + tl * P5_ROWB; f8n[i] = c.ws + WS_H1F8 + tok * D;
              stn[i] = (float*)(c.ws + WS_ST1) + tok * 2; }
          ln_rows_bf16<4, true, true, true>(src, c.in[I_LN1G], c.in[I_LN1B], dst, ldsn, lane, f8n, stn); }
        __syncthreads();
        f32x4 acc[3] = {};
#pragma unroll
        for (int ks = 0; ks < 8; ++ks) {
            const int k = wid * 256 + ks * 32 + fq * 8;
            const bf16x8 a = *(const bf16x8*)(c.lds + fr * P5_ROWB + k * 2);
#pragma unroll
            for (int n = 0; n < 3; ++n) acc[n] = __builtin_amdgcn_mfma_f32_16x16x32_bf16(wf[ks][n], a, acc[n], 0, 0, 0);
        }
#pragma unroll
        for (int n = 0; n < 3; ++n) *(f32x4*)(part + (wid * 16 + fr) * 48 + n * 16 + fq * 4) = acc[n];
        __syncthreads();
#pragma unroll
        for (int i = 0; i < 3; ++i) { const int idx = c.tid + 256 * i;
            if (idx < 576) { const int tk = idx / 36, l = idx - tk * 36;
                lgs[tk * 40 + l] = ((part[tk * 48 + l] + part[(16 + tk) * 48 + l]) + (part[(32 + tk) * 48 + l] + part[(48 + tk) * 48 + l])) + biasl[l]; } }
        __syncthreads();
        if (c.tid < 16) {
            const float* lg = lgs + c.tid * 40;
            int gi = 0; float gm = lg[0];
#pragma unroll
            for (int i = 1; i < 4; ++i) { const float v = lg[i]; if (v > gm) { gm = v; gi = i; } }
            float gs = 0.f;
#pragma unroll
            for (int i = 0; i < 4; ++i) gs += __expf(lg[i] - gm);
            const float gw = 1.f / gs;
            const float* le = lg + 4 + gi * 8;
            float v0 = le[0], v1 = -3.0e38f; int i0 = 0, i1 = 0;
#pragma unroll
            for (int i = 1; i < 8; ++i) { const float v = le[i];
                if (v > v0) { v1 = v0; i1 = i0; v0 = v; i0 = i; } else if (v > v1) { v1 = v; i1 = i; } }
            const float ex = __expf(v1 - v0), inv = 1.f / (1.f + ex);
            const int tok = tok0 + c.tid; const unsigned e0 = gi * 8 + i0, e1 = gi * 8 + i1;
            combw[tok * 2] = gw * inv; combw[tok * 2 + 1] = gw * ex * inv;
            const unsigned r0 = atomicAdd(&lcnt[e0], 1u), r1 = atomicAdd(&lcnt[e1], 1u);
            const int ei = nent * 32 + c.tid * 2;
            ent[2 * ei] = (unsigned)(tok * 2);         ent[2 * ei + 1] = (e0 << 16) | r0;
            ent[2 * ei + 2] = (unsigned)(tok * 2 + 1); ent[2 * ei + 3] = (e1 << 16) | r1;
        }
        ++nent;
    }
    __syncthreads();
    if (c.tid < 32) { const unsigned n = lcnt[c.tid]; lbase[c.tid] = n ? atomicAdd(&cnt[c.tid * CNT_STRIDE], n) : 0u; }
    __syncthreads();
    for (int i = c.tid; i < nent * 32; i += 256) { const unsigned t2 = ent[2 * i], er = ent[2 * i + 1]; const unsigned e = er >> 16;
        list[(size_t)e * TR + lbase[e] + (er & 0xffffu)] = t2; }
}
DEV void bar20(const Ctx& c) {}
DEV void moe_tiles(const Ctx& c) {
    const unsigned* cnt = (const unsigned*)(c.ws + WS_CTL) + CW_CNT; int* ts = (int*)(c.lds + EXP_OFF);
    __syncthreads();
    if (c.tid < NE) ts[40 + c.tid] = (int)__hip_atomic_load(&cnt[c.tid * CNT_STRIDE], __ATOMIC_RELAXED, __HIP_MEMORY_SCOPE_AGENT);
    __syncthreads();
    if (c.tid == 0) { int s = 0; for (int e = 0; e < NE; ++e) { ts[e] = s; s += (ts[40 + e] + 127) >> 7; } ts[NE] = s; }
    __syncthreads();
}
DEV void phase6a(const Ctx& c) {
    const bf16_t* H18 = (const bf16_t*)(c.ws + WS_H1F8); const bf16_t* Wgu8 = (const bf16_t*)(c.ws + WS_WGU); unsigned char* ACT8 = c.ws + WS_ACT;
    const unsigned* list = (const unsigned*)(c.ws + WS_LIST);
    moe_tiles(c);
    const int* ts = (const int*)(c.lds + EXP_OFF); unsigned* tbl = (unsigned*)(c.lds + TBL_OFF);
    const StageGeo g = stage_geo(c.tid);
    const int lane = c.lane, wr = c.wid >> 1, wc = c.wid & 1, fr = lane & 15, fq = lane >> 4;
    const int NU = ts[NE] * 4;
    u32x2* RI = (u32x2*)(c.ws + WS_RI); const float* combw = (const float*)(c.ws + WS_COMBW);
    int e = 0, en_e = 0; unsigned en_cur = 0xffffffffu;
    { const int u0 = c.vcu; if (u0 < NU) { const int rt0 = u0 >> 2; while (ts[en_e + 1] <= rt0) ++en_e;
        if (c.tid < 128) { const int j = (rt0 - ts[en_e]) * 128 + c.tid; en_cur = (j < ts[40 + en_e]) ? list[(size_t)en_e * TR + j] : 0xffffffffu; } } }
    for (int u = c.vcu; u < NU; u += c.G) {
        const int rt = u >> 2, nt = u & 3;
        e = en_e;
        __syncthreads();
        float wri = 0.f;
        if (c.tid < 128) { tbl[c.tid] = en_cur; if (nt == 0 && en_cur != 0xffffffffu) wri = combw[en_cur]; }
        const unsigned en_this = en_cur;
        { const int un = u + c.G; if (un < NU) { const int rtn = un >> 2; while (ts[en_e + 1] <= rtn) ++en_e;
            if (c.tid < 128) { const int j = (rtn - ts[en_e]) * 128 + c.tid; en_cur = (j < ts[40 + en_e]) ? list[(size_t)en_e * TR + j] : 0xffffffffu; } } }
        __syncthreads();
        size_t ro[4];
#pragma unroll
        for (int i = 0; i < 4; ++i) { const unsigned en = tbl[g.r[i]]; ro[i] = (en == 0xffffffffu) ? 0 : (size_t)(en >> 1) * (D / 2); }
        const bf16_t* A = H18 + g.c; const bf16_t* B = Wgu8 + ((size_t)e * 512 + nt * 128) * (D / 2) + g.c;
        f32x4 acc[4][4];
        gemm_mainloop<false, true>(acc, A + ro[0], A + ro[1], A + ro[2], A + ro[3],
                             B + (size_t)g.r[0] * (D / 2), B + (size_t)g.r[1] * (D / 2), B + (size_t)g.r[2] * (D / 2), B + (size_t)g.r[3] * (D / 2), 8, c.lds, 0, 0.f);
#pragma unroll
        for (int m = 0; m < 4; ++m) { const size_t row = (size_t)rt * 128 + wr * 64 + m * 16 + fr;
#pragma unroll
            for (int i = 0; i < 2; ++i) {
                const f32x4 gt = acc[m][2 * i], up = acc[m][2 * i + 1]; f32x4 o;
#pragma unroll
                for (int j = 0; j < 4; ++j) { const float gv = gt[j] * WUNSCALE; o[j] = gv * sigmoidf_(gv) * (up[j] * WUNSCALE); }
                *(unsigned*)(ACT8 + row * DE + nt * 64 + wc * 32 + i * 16 + fq * 4) = pk_fp8x4(o[0], o[1], o[2], o[3]);
            } }
        if (nt == 0 && c.tid < 128) { u32x2 ri; ri.x = en_this; ri.y = __float_as_uint(wri); RI[(size_t)rt * 128 + c.tid] = ri; }
    }
}
DEV void phase6b(const Ctx& c) {
    const bf16_t* ACT8 = (const bf16_t*)(c.ws + WS_ACT); const bf16_t* Wd8 = (const bf16_t*)(c.ws + WS_WD); unsigned char* Y8 = c.ws + WS_Y;
    const u32x2* RI = (const u32x2*)(c.ws + WS_RI);
    moe_tiles(c);
    const int* ts = (const int*)(c.lds + EXP_OFF); u32x2* tbl = (u32x2*)(c.lds + TBL_OFF);
    const StageGeo g = stage_geo(c.tid);
    unsigned char* lds = c.lds;
    const int tid = c.tid, lane = c.lane, wr = c.wid >> 1, wc = c.wid & 1, fr = lane & 15, fq = lane >> 4;
    const int cb0 = fq * 32, cb1 = fq * 32 + 16;
    const int q0 = (cb0 >> 6) * 1024 + ((fr * 64 + (cb0 & 63)) ^ ((fr >> 3) << 5)), q1 = (cb1 >> 6) * 1024 + ((fr * 64 + (cb1 & 63)) ^ ((fr >> 3) << 5));
    const int a_off = wr * 8192, b_off = wc * 8192, dst = tid * 16;
    const int NU = ts[NE] * 2;
    int e = 0;
#define GLDS(src, off) __builtin_amdgcn_global_load_lds((const unsigned*)(src), (unsigned LAS*)(lds + (off)), 16, 0, 0)
    for (int u = c.vcu; u < NU; u += c.G) {
        const int rt = u >> 1, nh = u & 1;
        while (ts[e + 1] <= rt) ++e;
        __syncthreads();
        if (tid < 128) tbl[tid] = RI[(size_t)rt * 128 + tid];
        const bf16_t* A = ACT8 + (size_t)(rt * 128) * (DE / 2) + g.c;
        const bf16_t* B = Wd8 + ((size_t)e * 1024 + nh * 512) * (DE / 2) + g.c;
#pragma unroll
        for (int kt = 0; kt < 2; ++kt)
#pragma unroll
            for (int i = 0; i < 4; ++i) GLDS(A + (size_t)g.r[i] * (DE / 2) + kt * 64, kt * 16384 + dst + i * 4096);
#define BSTAGE(s_, buf) do { const bf16_t* _b = B + (size_t)((s_) >> 1) * 128 * (DE / 2) + ((s_) & 1) * 64; \
        GLDS(_b + (size_t)g.r[0] * (DE / 2), 32768 + (buf) * 16384 + dst);        GLDS(_b + (size_t)g.r[1] * (DE / 2), 32768 + (buf) * 16384 + dst + 4096); \
        GLDS(_b + (size_t)g.r[2] * (DE / 2), 32768 + (buf) * 16384 + dst + 8192); GLDS(_b + (size_t)g.r[3] * (DE / 2), 32768 + (buf) * 16384 + dst + 12288); } while (0)
        BSTAGE(0, 0);
        f32x4 acc[4][4];
#pragma unroll
        for (int m = 0; m < 4; ++m)
#pragma unroll
            for (int n = 0; n < 4; ++n) acc[m][n] = (f32x4){0.f, 0.f, 0.f, 0.f};
#pragma unroll 1
        for (int s_ = 0; s_ < 8; ++s_) {
            VM_WAIT();
            __syncthreads();
            const int bsel = s_ & 1;
            if (s_ + 1 < 8) { if (bsel) BSTAGE(s_ + 1, 0); else BSTAGE(s_ + 1, 1); }
            const unsigned char* ab = lds + bsel * 16384 + a_off; const unsigned char* bb = lds + 32768 + bsel * 16384 + b_off;
            v8i ax[4], bx[4];
#pragma unroll
            for (int m = 0; m < 4; ++m) { const u32x4 c0 = *(const u32x4*)(ab + m * 2048 + q0), c1 = *(const u32x4*)(ab + m * 2048 + q1);
                ax[m] = (v8i){(int)c0.x, (int)c0.y, (int)c0.z, (int)c0.w, (int)c1.x, (int)c1.y, (int)c1.z, (int)c1.w}; }
#pragma unroll
            for (int n = 0; n < 4; ++n) { const u32x4 c0 = *(const u32x4*)(bb + n * 2048 + q0), c1 = *(const u32x4*)(bb + n * 2048 + q1);
                bx[n] = (v8i){(int)c0.x, (int)c0.y, (int)c0.z, (int)c0.w, (int)c1.x, (int)c1.y, (int)c1.z, (int)c1.w}; }
#pragma unroll
            for (int m = 0; m < 4; ++m)
#pragma unroll
                for (int n = 0; n < 4; ++n) acc[m][n] = __builtin_amdgcn_mfma_scale_f32_16x16x128_f8f6f4(bx[n], ax[m], acc[m][n], 0, 0, 0, 0x7F7F7F7F, 0, 0x7F7F7F7F);
            if (bsel) {
                const int nt = nh * 4 + (s_ >> 1);
#pragma unroll
                for (int m = 0; m < 4; ++m) {
                    const u32x2 ri = tbl[wr * 64 + m * 16 + fr]; const unsigned en = ri.x;
                    if (en != 0xffffffffu) {
                        const float w = __uint_as_float(ri.y) * (WUNSCALE * YSCALE); unsigned char* dstp = Y8 + ((size_t)(en & 1u) * TR + (en >> 1)) * D + nt * 128 + wc * 64 + fq * 4;
#pragma unroll
                        for (int n = 0; n < 4; ++n) { const f32x4 o = acc[m][n] * w; *(unsigned*)(dstp + n * 16) = pk_fp8x4(o[0], o[1], o[2], o[3]); }
                    }
#pragma unroll
                    for (int n = 0; n < 4; ++n) acc[m][n] = (f32x4){0.f, 0.f, 0.f, 0.f};
                }
            }
        }
#undef BSTAGE
    }
#undef GLDS
}

DEV void phase7(const Ctx& c) {
    const bf16_t* R1 = (const bf16_t*)(c.ws + WS_R1); const unsigned char* Y8 = c.ws + WS_Y; const float2* ST1 = (const float2*)(c.ws + WS_ST1);
    const float* g = c.in[I_LN2G]; const float* bt = c.in[I_LN2B];
    const int gw = c.vcu * 4 + c.wid, NGW = c.G * 4, lane = c.lane;
    float G1[16], B1[16];
#pragma unroll
    for (int i = 0; i < 2; ++i)
#pragma unroll
        for (int q = 0; q < 2; ++q) { const f32x4 a = *(const f32x4*)(c.in[I_LN1G] + i * 512 + lane * 8 + q * 4), bq = *(const f32x4*)(c.in[I_LN1B] + i * 512 + lane * 8 + q * 4);
#pragma unroll
            for (int e = 0; e < 4; ++e) { G1[i * 8 + q * 4 + e] = a[e]; B1[i * 8 + q * 4 + e] = bq[e]; } }
    for (int tok0 = gw; tok0 < TR; tok0 += 2 * NGW) {
        float v[2][16]; float st[2]; int tk[2];
#pragma unroll
        for (int r = 0; r < 2; ++r) {
            int tok = tok0 + r * NGW; if (tok >= TR) tok = tok0; tk[r] = tok;
            const float2 ms = ST1[tok]; const float am = ALPHA * ms.y;
#pragma unroll
            for (int i = 0; i < 2; ++i) {
                const u32x4 hw = *(const u32x4*)(R1 + (size_t)tok * D + i * 512 + lane * 8);
                const u32x2 y0 = *(const u32x2*)(Y8 + (size_t)tok * D + i * 512 + lane * 8);
                const u32x2 y1 = *(const u32x2*)(Y8 + ((size_t)TR + tok) * D + i * 512 + lane * 8);
#pragma unroll
                for (int q2 = 0; q2 < 2; ++q2) {
                    const auto a0 = __builtin_amdgcn_cvt_pk_f32_fp8((int)y0[q2], false), a1 = __builtin_amdgcn_cvt_pk_f32_fp8((int)y0[q2], true);
                    const auto b0 = __builtin_amdgcn_cvt_pk_f32_fp8((int)y1[q2], false), b1 = __builtin_amdgcn_cvt_pk_f32_fp8((int)y1[q2], true);
                    const int e0 = i * 8 + 4 * q2;
                    v[r][e0]     = (bflo(hw[2 * q2]) - ms.x) * (am * G1[e0]) + ALPHA * B1[e0] + (a0[0] + b0[0]) * YUNSCALE;
                    v[r][e0 + 1] = (bfhi(hw[2 * q2]) - ms.x) * (am * G1[e0 + 1]) + ALPHA * B1[e0 + 1] + (a0[1] + b0[1]) * YUNSCALE;
                    v[r][e0 + 2] = (bflo(hw[2 * q2 + 1]) - ms.x) * (am * G1[e0 + 2]) + ALPHA * B1[e0 + 2] + (a1[0] + b1[0]) * YUNSCALE;
                    v[r][e0 + 3] = (bfhi(hw[2 * q2 + 1]) - ms.x) * (am * G1[e0 + 3]) + ALPHA * B1[e0 + 3] + (a1[1] + b1[1]) * YUNSCALE;
                }
            }
        }
#pragma unroll
        for (int r = 0; r < 2; ++r) { float a = 0.f;
#pragma unroll
            for (int q = 0; q < 16; ++q) a += v[r][q];
            st[r] = a; }
        wave_sum_n<2>(st);
#pragma unroll
        for (int r = 0; r < 2; ++r) { const float mean = st[r] * (1.f / 1024.f); float a = 0.f;
#pragma unroll
            for (int q = 0; q < 16; ++q) { v[r][q] -= mean; a += v[r][q] * v[r][q]; }
            st[r] = a; }
        wave_sum_n<2>(st);
#pragma unroll
        for (int i = 0; i < 2; ++i)
#pragma unroll
            for (int q = 0; q < 2; ++q) {
                const int col = i * 512 + lane * 8 + q * 4;
                const f32x4 gg = *(const f32x4*)(g + col), bb = *(const f32x4*)(bt + col);
#pragma unroll
                for (int r = 0; r < 2; ++r) {
                    if (r == 1 && tok0 + NGW >= TR) continue;
                    const float rstd = rsqrt_(st[r] * (1.f / 1024.f) + EPS);
                    f32x4 o; o[0] = v[r][i * 8 + q * 4] * rstd * gg[0] + bb[0]; o[1] = v[r][i * 8 + q * 4 + 1] * rstd * gg[1] + bb[1];
                    o[2] = v[r][i * 8 + q * 4 + 2] * rstd * gg[2] + bb[2]; o[3] = v[r][i * 8 + q * 4 + 3] * rstd * gg[3] + bb[3];
                    *(f32x4*)(c.out + (size_t)tk[r] * D + col) = o;
                }
            }
    }
}

__global__ void __launch_bounds__(256, 2) fwd_kernel(Args a) {
    extern __shared__ __attribute__((aligned(16))) unsigned char lds[];
    Ctx c; c.in = a.in; c.out = a.out; c.ws = a.ws; c.lds = lds;
    c.tid = threadIdx.x; c.lane = c.tid & 63; c.wid = __builtin_amdgcn_readfirstlane(c.tid >> 6);
    c.G = gridDim.x; { const int bx = blockIdx.x; c.vcu = (c.G % 8 == 0) ? (bx % 8) * (c.G / 8) + bx / 8 : bx; }
    if (c.tid < 64) ((unsigned*)(lds + MISC_OFF))[c.tid] = 0u;
    __syncthreads();
    unsigned* ctl = (unsigned*)(a.ws + WS_CTL);
    XcdBarrier bar = xcd_barrier_post(ctl + CW_BAR, (volatile LAS unsigned*)(lds + MISC_OFF));
#ifdef ONLY_PH
#define PH_ON(k) ((k) == ONLY_PH)
#else
#define PH_ON(k) 1
#endif
    const int lo = a.ph_lo, hi = a.ph_hi;
#define RUN_PHASE(k, fn) if (PH_ON(k) && lo <= (k) && (k) < hi) { \
        for (int _rep = 0; _rep < ((REPEAT_PH == (k)) ? 2 : 1); ++_rep) { \
            int _t = threadIdx.x; asm volatile("" : "+v"(_t)); c.tid = _t; c.lane = _t & 63; c.wid = __builtin_amdgcn_readfirstlane(_t >> 6); \
            if ((k) == 5) phase5(c, _rep); else fn(c); \
            if (_rep == 0 && REPEAT_PH == (k)) xcd_barrier(bar); } \
        if ((k) + 1 < hi) xcd_barrier(bar); }
    RUN_PHASE(0, phase0)
    RUN_PHASE(1, phase1)
    RUN_PHASE(2, phase2)
    RUN_PHASE(3, phase3)
    RUN_PHASE(4, phase4)
    RUN_PHASE(5, phase0)
    RUN_PHASE(6, phase6a)
    RUN_PHASE(7, phase6b)
    RUN_PHASE(8, phase7)
}

extern "C" void kernel_launch(void* const* d_in, const int* in_sizes, int n_in, void* d_out, int out_size, void* d_ws, size_t ws_size, hipStream_t stream) {
    static int grid = 0;
    if (grid == 0) {
        if (n_in != 27 || in_sizes[0] != NB * SEQ * D || out_size != TR * D || ws_size < WS_END) {
            fprintf(stderr, "kernel_launch: shape mismatch n_in %d in0 %d out %d ws %zu\n", n_in, n_in > 0 ? in_sizes[0] : -1, out_size, ws_size); grid = -1; return; }
        int dev = 0, cus = 0, per_cu = 0;
        if (hipGetDevice(&dev) != hipSuccess || hipDeviceGetAttribute(&cus, hipDeviceAttributeMultiprocessorCount, dev) != hipSuccess) { grid = -1; return; }
        if (hipFuncSetAttribute((const void*)fwd_kernel, hipFuncAttributeMaxDynamicSharedMemorySize, LDS_BYTES) != hipSuccess) { grid = -1; return; }
        if (hipOccupancyMaxActiveBlocksPerMultiprocessor(&per_cu, (const void*)fwd_kernel, 256, LDS_BYTES) != hipSuccess || per_cu < 1) per_cu = 1;
        (void)hipGetLastError();
        if (per_cu > 2) per_cu = 2;
        grid = cus * per_cu;
        fprintf(stderr, "kernel_launch: grid %d (%d per CU)\n", grid, per_cu);
    }
    if (grid < 0) return;
    (void)hipMemsetAsync((char*)d_ws + WS_CTL, 0, CTL_ZERO_BYTES, stream);
    Args a{};
    for (int i = 0; i < 27; ++i) a.in[i] = (const float*)d_in[i];
    a.out = (float*)d_out; a.ws = (unsigned char*)d_ws;
    if (MK_N_LAUNCHES == 1) {
        a.ph_lo = 0; a.ph_hi = NPH;
        hipLaunchKernelGGL(fwd_kernel, dim3(grid), dim3(256), LDS_BYTES, stream, a);
    } else {
        for (int ph = 0; ph < NPH; ++ph) { a.ph_lo = ph; a.ph_hi = ph + 1; hipLaunchKernelGGL(fwd_kernel, dim3(grid), dim3(256), LDS_BYTES, stream, a); }
    }
}
```

```cpp
#include <hip/hip_runtime.h>
#include <cstdio>
#include <cstdint>

#ifndef REPEAT_PH
#define REPEAT_PH -1
#endif
#ifndef CONV_REPB
#define CONV_REPB 1
#endif
#ifndef CONV_REPC
#define CONV_REPC 1
#endif
#ifndef CONV_REPA
#define CONV_REPA 1
#endif
#ifndef MK_N_LAUNCHES
#define MK_N_LAUNCHES 1
#endif

#define DEV __device__ __forceinline__
#define LAS __attribute__((address_space(3)))
#define GAS __attribute__((address_space(1)))
typedef unsigned short bf16_t;
typedef short bf16x8 __attribute__((ext_vector_type(8)));
typedef short s16x4 __attribute__((ext_vector_type(4)));
typedef float f32x4 __attribute__((ext_vector_type(4)));
typedef float f32x16 __attribute__((ext_vector_type(16)));
typedef unsigned u32x4 __attribute__((ext_vector_type(4)));
typedef unsigned u32x2 __attribute__((ext_vector_type(2)));
typedef long i64x2 __attribute__((ext_vector_type(2)));
typedef int v8i __attribute__((ext_vector_type(8)));

constexpr int NB = 16, SEQ = 2048, NMETA = 16, L = SEQ + NMETA;
constexpr int T = NB * L;
constexpr int TR = NB * SEQ;
constexpr int D = 1024, NIN = 1696, CC = 512, QL = 384, KVL = 256, NH = 8, DQK = 96, DV = 64;
constexpr int NQ = NH * DQK;
constexpr int NKV = NH * (64 + DV);
constexpr int NE = 32, DE = 256, CONVK = 31;
constexpr float EPS = 1e-5f;
constexpr float ALPHA = 1.189207115002721f;
constexpr float QSCALE = 0.10206207261596577f * 1.4426950408889634f;
constexpr int NPH = 9;
constexpr float WSCALE = 16.f, WUNSCALE = 1.f / 16.f;
constexpr float YSCALE = 64.f, YUNSCALE = 1.f / 64.f;

constexpr size_t MiB = 1u << 20;
constexpr size_t WS_CTL = 0, CTL_ZERO_BYTES = 64 * 1024;
constexpr int CW_CNT = 1024, CNT_STRIDE = 64;
constexpr int CW_BAR = 4096;
constexpr size_t WS_LIST = 1 * MiB;
constexpr size_t WS_COMBW = 5 * MiB;
constexpr size_t WS_ST1 = 5 * MiB + 256 * 1024;
constexpr size_t WS_ROPE = 5 * MiB + 512 * 1024;
constexpr size_t WS_WIN = 6 * MiB;
constexpr size_t WS_WUQ = 10 * MiB;
constexpr size_t WS_WUKV = 11 * MiB;
constexpr size_t WS_WO = 12 * MiB;
constexpr size_t WS_WR = 14 * MiB;
constexpr size_t WS_RI = 14 * MiB + 512 * 1024;
constexpr size_t WS_SSQ_CQ = 404 * MiB + 512 * 1024;
constexpr size_t WS_SSQ_CKV = 402 * MiB;
constexpr size_t WS_SSQ_O = 403 * MiB;
constexpr size_t WS_WGU = 16 * MiB;
constexpr size_t WS_WD = 48 * MiB;
constexpr size_t WS_H1F8 = 130 * MiB;
constexpr size_t WS_H0 = 64 * MiB;
constexpr size_t WS_U = 130 * MiB;
constexpr size_t WS_CQ = 163 * MiB;
constexpr size_t WS_CKV = 188 * MiB;
constexpr size_t WS_KR = 205 * MiB;
constexpr size_t WS_Q = 208 * MiB;
constexpr size_t WS_KV = 257 * MiB;
constexpr size_t WS_R1 = 208 * MiB;
constexpr size_t WS_Y = 272 * MiB;
constexpr size_t WS_MG = 336 * MiB;
constexpr size_t WS_ACT = 336 * MiB;
constexpr size_t WS_DUMMY = 400 * MiB;
constexpr size_t WS_END = 406 * MiB;

constexpr int LDS_BYTES = 73728;
constexpr int MISC_OFF = LDS_BYTES - 256;
constexpr int RS_OFF = 65536;
constexpr int TBL_OFF = 66048;
constexpr int EXP_OFF = 67584;

DEV unsigned cvtpk(float lo, float hi) { unsigned r; asm("v_cvt_pk_bf16_f32 %0, %1, %2" : "=v"(r) : "v"(lo), "v"(hi)); return r; }
DEV float bflo(unsigned w) { return __uint_as_float(w << 16); }
DEV float bfhi(unsigned w) { return __uint_as_float(w & 0xffff0000u); }
DEV float dpp_add_qp(float v, int) { return v; }
template <int CTRL> DEV float dpp_mov(float v) { return __builtin_bit_cast(float, __builtin_amdgcn_update_dpp(0, __builtin_bit_cast(int, v), CTRL, 0xf, 0xf, false)); }
DEV float wave_sum(float v) {
    v += dpp_mov<0xB1>(v);
    v += dpp_mov<0x4E>(v);
    v += dpp_mov<0x141>(v);
    v += dpp_mov<0x140>(v);
    const int iv = __builtin_bit_cast(int, v);
    const float a = __builtin_bit_cast(float, __builtin_amdgcn_readlane(iv, 0)), b = __builtin_bit_cast(float, __builtin_amdgcn_readlane(iv, 16));
    const float c = __builtin_bit_cast(float, __builtin_amdgcn_readlane(iv, 32)), d = __builtin_bit_cast(float, __builtin_amdgcn_readlane(iv, 48));
    return (a + b) + (c + d);
}
DEV float rsqrt_(float x) { return __builtin_amdgcn_rsqf(x); }
DEV void st_bf4(bf16_t* p, f32x4 v) { u32x2 w = {cvtpk(v[0], v[1]), cvtpk(v[2], v[3])}; *(u32x2*)p = w; }
DEV unsigned pk_fp8x4(float a, float b, float c, float d) {
    int w = __builtin_amdgcn_cvt_pk_fp8_f32(a, b, 0, false); w = __builtin_amdgcn_cvt_pk_fp8_f32(c, d, w, true); return (unsigned)w; }
DEV float fast_exp2(float x) { return __builtin_amdgcn_exp2f(x); }
DEV float fast_rcp(float x) { return __builtin_amdgcn_rcpf(x); }
DEV float sigmoidf_(float g) { return fast_rcp(1.f + fast_exp2(-1.4426950408889634f * g)); }
#define LDS_WAIT() asm volatile("s_waitcnt lgkmcnt(0)" ::: "memory")
#define VM_WAIT() asm volatile("s_waitcnt vmcnt(0)" ::: "memory")

#define XB_TMO      128
#define XB_XCNT(j)  (256  + 64 * (j))
#define XB_XSUB(j)  (1280 + 64 * (j))
#define XB_XGEN(j)  (2304 + 64 * (j))
#define XB_TOP      3328
#define XB_TOPGEN   3392
#define XCD_BAR_WORDS 3456
#define XB_SPIN_CAP (1u << 22)
DEV unsigned xb_ld(unsigned* p)              { return __hip_atomic_load(p, __ATOMIC_RELAXED, __HIP_MEMORY_SCOPE_AGENT); }
DEV unsigned xb_add(unsigned* p, unsigned v) { return __hip_atomic_fetch_add(p, v, __ATOMIC_RELAXED, __HIP_MEMORY_SCOPE_AGENT); }
DEV unsigned xb_xcc_id() { return (unsigned)__builtin_amdgcn_s_getreg((3 << 11) | 20) & 0xFu; }
#define XB_SPIN(cond, bar) do { unsigned _sp = 0; while (cond) { __builtin_amdgcn_s_sleep(1); \
    if ((++_sp & 255u) == 0u) { if (xb_ld(&(bar)[XB_TMO])) break; if (_sp > XB_SPIN_CAP) { atomicAdd(&(bar)[XB_TMO], 1u); break; } } } } while (0)
struct XcdBarrier { unsigned* bar; unsigned x; volatile LAS unsigned* st; };
DEV XcdBarrier xcd_barrier_post(unsigned* bar, volatile LAS unsigned* st) {
    XcdBarrier b; b.bar = bar; b.x = xb_xcc_id(); b.st = st;
    if (threadIdx.x == 0) (void)xb_add(&bar[XB_XCNT(b.x)], 1u);
    return b;
}
DEV void xcd_barrier_complete(unsigned* bar, unsigned x, unsigned& nloc, unsigned& nx) {
    const unsigned G = gridDim.x * gridDim.y * gridDim.z;
    unsigned sum, cnt, mine, sp = 0u;
    for (;;) {
        sum = 0u; cnt = 0u; mine = 0u;
#pragma unroll
        for (unsigned j = 0; j < 16; ++j) { const unsigned c = xb_ld(&bar[XB_XCNT(j)]); sum += c; cnt += (c > 0u) ? 1u : 0u; mine = (j == x) ? c : mine; }
        if (sum == G) break;
        __builtin_amdgcn_s_sleep(1);
        if ((++sp & 255u) == 0u) { if (xb_ld(&bar[XB_TMO])) break; if (sp > XB_SPIN_CAP) { atomicAdd(&bar[XB_TMO], 1u); break; } }
    }
    nloc = mine > 0u ? mine : 1u; nx = cnt > 0u ? cnt : 1u;
}
DEV void xcd_barrier(const XcdBarrier& b) {
    asm volatile("s_waitcnt vmcnt(0)" ::: "memory");
    __syncthreads();
    if (threadIdx.x == 0) {
        unsigned* bar = b.bar;
        __builtin_amdgcn_s_waitcnt(0);
        unsigned nloc = b.st[0], nx = b.st[1];
        if (nloc == 0u) { xcd_barrier_complete(bar, b.x, nloc, nx); b.st[0] = nloc; b.st[1] = nx; }
        const unsigned old = xb_add(&bar[XB_XSUB(b.x)], 1u);
        const unsigned gen = old / nloc;
        if (old + 1u == (gen + 1u) * nloc) {
            __builtin_amdgcn_fence(__ATOMIC_RELEASE, "agent");
            asm volatile("s_waitcnt vmcnt(0)" ::: "memory");
            const unsigned og = xb_add(&bar[XB_TOP], 1u);
            const unsigned tg = og / nx;
            if (og + 1u == (tg + 1u) * nx) xb_add(&bar[XB_TOPGEN], 1u);
            else XB_SPIN(xb_ld(&bar[XB_TOPGEN]) == tg, bar);
            __builtin_amdgcn_fence(__ATOMIC_ACQUIRE, "agent");
            xb_add(&bar[XB_XGEN(b.x)], 1u);
            asm volatile("s_waitcnt vmcnt(0)" ::: "memory");
        } else {
            XB_SPIN(xb_ld(&bar[XB_XGEN(b.x)]) == gen, bar);
            __builtin_amdgcn_fence(__ATOMIC_ACQUIRE, "agent");
            asm volatile("s_waitcnt vmcnt(0)" ::: "memory");
        }
    }
    __syncthreads();
}

struct Args { const float* in[27]; float* out; unsigned char* ws; int ph_lo, ph_hi; };
struct Ctx {
    const float* const* in; float* out; unsigned char* ws; unsigned char* lds;
    int tid, lane, wid, vcu, G;
};
enum { I_X = 0, I_META, I_LNIN_G, I_LNIN_B, I_WIN, I_CONVW, I_CONVB, I_CLN_G, I_CLN_B, I_QNG, I_WUQ, I_KVNG, I_WUKV, I_COUT_G, I_AOUT_G, I_WO,
       I_LN1G, I_LN1B, I_WRG, I_BRG, I_WRE, I_BRE, I_WGATE, I_WUP, I_WDOWN, I_LN2G, I_LN2B };

DEV int nmap(int mode, int n) {
    if (mode == 1) { if (n < 512) return ((n >> 4) << 5) + (n & 15); if (n < 1024) return (((n - 512) >> 4) << 5) + 16 + (n & 15); return n; }
    if (mode == 2) return ((n >> 4) << 5) + (n & 15);
    if (mode == 3) return ((n >> 4) << 5) + 16 + (n & 15);
    return n;
}
DEV void p0_transpose_item(const float* __restrict__ W, int N, int k0, int n0, const float* __restrict__ kscale, bf16_t* WT, int ldt, int kout0, int mode,
                           float* scr, int lane) {
#pragma unroll 8
    for (int i = 0; i < 32; ++i) {
        const int kk = 2 * i + (lane >> 5);
        float v = W[(size_t)(k0 + kk) * N + n0 + (lane & 31)];
        if (kscale) v *= kscale[k0 + kk];
        scr[kk * 33 + (lane & 31)] = v;
    }
    LDS_WAIT(); asm volatile("" ::: "memory");
    const int c = lane & 7;
#pragma unroll
    for (int j = 0; j < 4; ++j) {
        const int n = (lane >> 3) + 8 * j; const float* s = scr + (8 * c) * 33 + n;
        u32x4 o; o.x = cvtpk(s[0 * 33], s[1 * 33]); o.y = cvtpk(s[2 * 33], s[3 * 33]); o.z = cvtpk(s[4 * 33], s[5 * 33]); o.w = cvtpk(s[6 * 33], s[7 * 33]);
        *(u32x4*)(WT + (size_t)nmap(mode, n0 + n) * ldt + kout0 + 8 * c) = o;
    }
    LDS_WAIT(); asm volatile("" ::: "memory");
}
DEV void p0_transpose_item_f8(const float* __restrict__ W, int N, int k0, int n0, float scale, unsigned char* W8, int ldt, int kout0, int mode, float* scr, int lane) {
#pragma unroll 8
    for (int i = 0; i < 32; ++i) { const int kk = 2 * i + (lane >> 5); scr[kk * 33 + (lane & 31)] = W[(size_t)(k0 + kk) * N + n0 + (lane & 31)] * scale; }
    LDS_WAIT(); asm volatile("" ::: "memory");
    const int c = lane & 7;
#pragma unroll
    for (int j = 0; j < 4; ++j) {
        const int n = (lane >> 3) + 8 * j; const float* sp = scr + (8 * c) * 33 + n;
        u32x2 o; o.x = pk_fp8x4(sp[0 * 33], sp[1 * 33], sp[2 * 33], sp[3 * 33]); o.y = pk_fp8x4(sp[4 * 33], sp[5 * 33], sp[6 * 33], sp[7 * 33]);
        *(u32x2*)(W8 + (size_t)nmap(mode, n0 + n) * ldt + kout0 + 8 * c) = o;
    }
    LDS_WAIT(); asm volatile("" ::: "memory");
}
template <int N> DEV void wave_sum_n(float (&v)[N]) {
#pragma unroll
    for (int i = 0; i < N; ++i) v[i] = wave_sum(v[i]);
}
template <int NR, bool F8 = false, bool BFIN = false, bool NOBF = false> DEV void ln_rows_bf16(const float* const (&xrow)[NR], const float* g, const float* bta, bf16_t* const (&orow)[NR], unsigned char* const (&ldsrow)[NR], int lane, unsigned char* const* f8row = nullptr, float* const* strow = nullptr) {
    f32x4 v[NR][4]; float s[NR];
#pragma unroll
    for (int r = 0; r < NR; ++r)
#pragma unroll
        for (int j = 0; j < 4; ++j) {
            if (BFIN) { const u32x2 w = ((const u32x2*)xrow[r])[64 * j + lane]; v[r][j] = (f32x4){bflo(w.x), bfhi(w.x), bflo(w.y), bfhi(w.y)}; }
            else v[r][j] = ((const f32x4*)xrow[r])[64 * j + lane]; }
#pragma unroll
    for (int r = 0; r < NR; ++r) { s[r] = 0.f;
#pragma unroll
        for (int j = 0; j < 4; ++j) s[r] += (v[r][j].x + v[r][j].y) + (v[r][j].z + v[r][j].w); }
    wave_sum_n<NR>(s);
    float s2[NR];
#pragma unroll
    for (int r = 0; r < NR; ++r) { const float mean = s[r] * (1.f / 1024.f); s2[r] = 0.f;
#pragma unroll
        for (int j = 0; j < 4; ++j) { v[r][j] = v[r][j] - mean; s2[r] += (v[r][j].x * v[r][j].x + v[r][j].y * v[r][j].y) + (v[r][j].z * v[r][j].z + v[r][j].w * v[r][j].w); } }
    wave_sum_n<NR>(s2);
    if (strow) {
#pragma unroll
        for (int r = 0; r < NR; ++r) if (lane == 0) { strow[r][0] = s[r] * (1.f / 1024.f); strow[r][1] = rsqrt_(s2[r] * (1.f / 1024.f) + EPS); }
    }
#pragma unroll
    for (int j = 0; j < 4; ++j) {
        const f32x4 gg = ((const f32x4*)g)[64 * j + lane], bb = ((const f32x4*)bta)[64 * j + lane];
#pragma unroll
        for (int r = 0; r < NR; ++r) {
            const float rstd = rsqrt_(s2[r] * (1.f / 1024.f) + EPS);
            const f32x4 o = v[r][j] * rstd * gg + bb;
            const u32x2 w = {cvtpk(o.x, o.y), cvtpk(o.z, o.w)};
            if (!NOBF) ((u32x2*)orow[r])[64 * j + lane] = w;
            if (ldsrow[r]) ((u32x2*)ldsrow[r])[64 * j + lane] = w;
            if (F8) ((unsigned*)f8row[r])[64 * j + lane] = pk_fp8x4(o.x, o.y, o.z, o.w);
        }
    }
}
__device__ const float INVF[16] = {1.0f, 0.5623413251903491f, 0.31622776601683794f, 0.1778279410038923f, 0.1f, 0.05623413251903491f, 0.031622776601683794f,
    0.01778279410038923f, 0.01f, 0.005623413251903491f, 0.0031622776601683794f, 0.001778279410038923f, 0.001f, 0.0005623413251903491f, 0.00031622776601683794f, 0.0001778279410038923f};
DEV void sincos_d(double a, float& sn, float& cs) {
    const double TWO_PI = 6.283185307179586476925286766559;
    const double k = __builtin_rint(a / TWO_PI);
    const double r = a - k * TWO_PI;
    const double r2 = r * r;
    double st = r, ct = 1.0, ssum = r, csum = 1.0;
#pragma unroll 1
    for (int i = 1; i <= 14; ++i) {
        ct = -ct * r2 / (double)((2 * i - 1) * (2 * i));  csum += ct;
        st = -st * r2 / (double)((2 * i) * (2 * i + 1));  ssum += st;
    }
    sn = (float)ssum; cs = (float)csum;
}
DEV void ew_block(const float* __restrict__ W, int N, int k0, int n0, unsigned char* W8, int ldt, int mode, int lane) {
    const int q = lane & 15, kq = lane >> 4;
    const float* src = W + (size_t)(k0 + 16 * kq) * N + n0 + 4 * q;
    f32x4 v[16];
#pragma unroll
    for (int i = 0; i < 16; ++i) v[i] = *(const f32x4*)(src + (size_t)i * N);
#pragma unroll
    for (int j = 0; j < 4; ++j) {
        u32x4 o;
        o.x = pk_fp8x4(v[0][j] * WSCALE, v[1][j] * WSCALE, v[2][j] * WSCALE, v[3][j] * WSCALE);
        o.y = pk_fp8x4(v[4][j] * WSCALE, v[5][j] * WSCALE, v[6][j] * WSCALE, v[7][j] * WSCALE);
        o.z = pk_fp8x4(v[8][j] * WSCALE, v[9][j] * WSCALE, v[10][j] * WSCALE, v[11][j] * WSCALE);
        o.w = pk_fp8x4(v[12][j] * WSCALE, v[13][j] * WSCALE, v[14][j] * WSCALE, v[15][j] * WSCALE);
        *(u32x4*)(W8 + (size_t)nmap(mode, n0 + 4 * q + j) * ldt + k0 + 16 * kq) = o;
    }
}
DEV void expert_weight_item(const Ctx& c, int r, float*  ) {
    unsigned char* Wgu8 = c.ws + WS_WGU; unsigned char* Wd8 = c.ws + WS_WD;
    if (r < 2048) { const int e = r >> 6, qq = r & 63, kb = qq >> 2, nb = qq & 3;
        ew_block(c.in[I_WGATE] + (size_t)e * D * DE, DE, 64 * kb, 64 * nb, Wgu8 + (size_t)e * 512 * 1024, 1024, 2, c.lane); return; } r -= 2048;
    if (r < 2048) { const int e = r >> 6, qq = r & 63, kb = qq >> 2, nb = qq & 3;
        ew_block(c.in[I_WUP] + (size_t)e * D * DE, DE, 64 * kb, 64 * nb, Wgu8 + (size_t)e * 512 * 1024, 1024, 3, c.lane); return; } r -= 2048;
    { const int e = r >> 6, qq = r & 63, kb = qq >> 4, nb = qq & 15;
        ew_block(c.in[I_WDOWN] + (size_t)e * DE * D, D, 64 * kb, 64 * nb, Wd8 + (size_t)e * 1024 * 256, 256, 0, c.lane); }
}
DEV void phase0(const Ctx& c) {
    float* scr = (float*)(c.lds + c.wid * 8448);
    const int gw = c.vcu * 4 + c.wid, NGW = c.G * 4;
    constexpr int I_IN = 16 * 53, I_UQ = 6 * 24, I_UKV = 4 * 32, I_O = 16 * 32;
    bf16_t* WinT = (bf16_t*)(c.ws + WS_WIN); bf16_t* WuqT = (bf16_t*)(c.ws + WS_WUQ); bf16_t* WukvT = (bf16_t*)(c.ws + WS_WUKV);
    bf16_t* WoT = (bf16_t*)(c.ws + WS_WO);
    constexpr int NITEMS0 = I_IN + I_UQ + I_UKV + I_O;
    for (int it = gw; it < NITEMS0; it += NGW) {
        int r = it;
        if (r < I_IN) { const int kb = r / 53, nb = r % 53; p0_transpose_item(c.in[I_WIN], NIN, 64 * kb, 32 * nb, nullptr, WinT, 1024, 64 * kb, 1, scr, c.lane); continue; } r -= I_IN;
        if (r < I_UQ) { const int kb = r / 24, nb = r % 24; p0_transpose_item(c.in[I_WUQ], NQ, 64 * kb, 32 * nb, c.in[I_QNG], WuqT, QL, 64 * kb, 0, scr, c.lane); continue; } r -= I_UQ;
        if (r < I_UKV) { const int kb = r / 32, nb = r % 32; p0_transpose_item(c.in[I_WUKV], NKV, 64 * kb, 32 * nb, c.in[I_KVNG], WukvT, KVL, 64 * kb, 0, scr, c.lane); continue; } r -= I_UKV;
        { const int kb = r / 32, nb = r % 32;
            if (kb < 8) p0_transpose_item(c.in[I_WO], D, 64 * kb, 32 * nb, nullptr, WoT, 1024, 64 * kb + 512, 0, scr, c.lane);
            else        p0_transpose_item(c.in[I_WO], D, 64 * kb, 32 * nb, c.in[I_AOUT_G] - 512, WoT, 1024, 64 * kb - 512, 0, scr, c.lane); }
    }
    const int gt = c.vcu * 256 + c.tid, NGT = c.G * 256;
    bf16_t* WrT = (bf16_t*)(c.ws + WS_WR);
    for (int i = gt; i < 48 * 1024; i += NGT) {
        const int n = i >> 10, k = i & 1023; float v = 0.f;
        if (n < 4) v = c.in[I_WRG][k * 4 + n]; else if (n < 36) v = c.in[I_WRE][k * 32 + (n - 4)];
        WrT[i] = (bf16_t)(cvtpk(v, 0.f) & 0xffffu);
    }
    float* rc = (float*)(c.ws + WS_ROPE); float* rs = rc + L * 16;
    for (int i = gt; i < L * 16; i += NGT) {
        const int p = i >> 4, f = i & 15; const float ang = (float)p * INVF[f];
        float sn, cs; sincos_d((double)ang, sn, cs); rc[i] = cs; rs[i] = sn;
    }
    bf16_t* h0 = (bf16_t*)(c.ws + WS_H0);
    for (int t = gw; t < T; t += 2 * NGW) {
        const float* src[2]; bf16_t* dst[2]; unsigned char* ldsn[2] = {nullptr, nullptr};
#pragma unroll
        for (int r = 0; r < 2; ++r) { int tt = t + r * NGW; if (tt >= T) tt = t;
            const int b = tt / L, p = tt - b * L;
            src[r] = (p < NMETA) ? c.in[I_META] + (size_t)p * D : c.in[I_X] + ((size_t)b * SEQ + (p - NMETA)) * D;
            dst[r] = h0 + (size_t)tt * D; }
        ln_rows_bf16<2>(src, c.in[I_LNIN_G], c.in[I_LNIN_B], dst, ldsn, c.lane);
    }
}

struct StageGeo { int r[4]; int c; };
DEV StageGeo stage_geo(int tid) {
    const int lane = tid & 63, wid = tid >> 6; StageGeo g;
    const int rl = lane >> 2, cl = ((lane & 3) * 8) ^ ((lane >> 5) << 4);
#pragma unroll
    for (int i = 0; i < 4; ++i) g.r[i] = (((wid + 4 * i) >> 1) << 4) + rl;
    g.c = ((wid & 1) << 5) + cl;
    return g;
}
template <bool SSQ, bool FP8 = false>
DEV void gemm_mainloop(f32x4 (&acc)[4][4], const bf16_t* ap0, const bf16_t* ap1, const bf16_t* ap2, const bf16_t* ap3,
                       const bf16_t* bp0, const bf16_t* bp1, const bf16_t* bp2, const bf16_t* bp3,
                       int nk, unsigned char* lds, int ssq_steps, float ssq_inv_dim, bool skip_wc1 = false) {
    const int tid = threadIdx.x, lane = tid & 63, wid = tid >> 6, wr = wid >> 1, wc = wid & 1, fr = lane & 15, fq = lane >> 4;
    const int xs = (fr >> 1) & 7;
    const int lo = ((fr * 64 + fq * 16) ^ ((fr >> 3) << 5));
    const int lo0 = lo, lo1 = lo + 1024;
    const int a_off = wr * 8192, b_off = 16384 + wc * 8192;
    const int dst = tid * 16;
#pragma unroll
    for (int m = 0; m < 4; ++m)
#pragma unroll
        for (int n = 0; n < 4; ++n) acc[m][n] = (f32x4){0.f, 0.f, 0.f, 0.f};
    __syncthreads();
#define GLDS(src, off) __builtin_amdgcn_global_load_lds((const unsigned*)(src), (unsigned LAS*)(lds + (off)), 16, 0, 0)
#define STAGE(kt, b) do { const int _k = (kt) * 64; \
        GLDS(ap0 + _k, (b) * 32768 + dst);          GLDS(ap1 + _k, (b) * 32768 + dst + 4096); \
        GLDS(ap2 + _k, (b) * 32768 + dst + 8192);   GLDS(ap3 + _k, (b) * 32768 + dst + 12288); \
        GLDS(bp0 + _k, (b) * 32768 + 16384 + dst);  GLDS(bp1 + _k, (b) * 32768 + 16384 + dst + 4096); \
        GLDS(bp2 + _k, (b) * 32768 + 16384 + dst + 8192); GLDS(bp3 + _k, (b) * 32768 + 16384 + dst + 12288); } while (0)
    STAGE(0, 0);
    for (int kt = 0; kt < nk; ++kt) {
        VM_WAIT();
        __syncthreads();
        const int b = kt & 1;
        if (SSQ && kt == ssq_steps) {
            const float* rsl = (const float*)(lds + RS_OFF);
#pragma unroll
            for (int m = 0; m < 4; ++m) { const float r = rsl[wr * 64 + m * 16 + fr];
#pragma unroll
                for (int n = 0; n < 4; ++n) acc[m][n] = acc[m][n] * r; }
        }
        if (kt + 1 < nk) { if (b) STAGE(kt + 1, 0); else STAGE(kt + 1, 1); }
        const unsigned char* base = lds + b * 32768;
        if (skip_wc1 && wc == 1) {
        } else if (FP8) {
            const int cb0 = fq * 32, cb1 = fq * 32 + 16;
            const int q0 = (cb0 >> 6) * 1024 + ((fr * 64 + (cb0 & 63)) ^ ((fr >> 3) << 5)), q1 = (cb1 >> 6) * 1024 + ((fr * 64 + (cb1 & 63)) ^ ((fr >> 3) << 5));
            v8i ax[4], bx[4];
#pragma unroll
            for (int m = 0; m < 4; ++m) { const u32x4 c0 = *(const u32x4*)(base + a_off + m * 2048 + q0), c1 = *(const u32x4*)(base + a_off + m * 2048 + q1);
                ax[m] = (v8i){(int)c0.x, (int)c0.y, (int)c0.z, (int)c0.w, (int)c1.x, (int)c1.y, (int)c1.z, (int)c1.w}; }
#pragma unroll
            for (int n = 0; n < 4; ++n) { const u32x4 c0 = *(const u32x4*)(base + b_off + n * 2048 + q0), c1 = *(const u32x4*)(base + b_off + n * 2048 + q1);
                bx[n] = (v8i){(int)c0.x, (int)c0.y, (int)c0.z, (int)c0.w, (int)c1.x, (int)c1.y, (int)c1.z, (int)c1.w}; }
#pragma unroll
            for (int m = 0; m < 4; ++m)
#pragma unroll
                for (int n = 0; n < 4; ++n) acc[m][n] = __builtin_amdgcn_mfma_scale_f32_16x16x128_f8f6f4(bx[n], ax[m], acc[m][n], 0, 0, 0, 0x7F7F7F7F, 0, 0x7F7F7F7F);
        } else {
#pragma unroll
        for (int ks = 0; ks < 2; ++ks) {
            bf16x8 af[4], bf[4];
#pragma unroll
            for (int m = 0; m < 4; ++m) af[m] = *(const bf16x8*)(base + a_off + m * 2048 + (ks ? lo1 : lo0));
#pragma unroll
            for (int n = 0; n < 4; ++n) bf[n] = *(const bf16x8*)(base + b_off + n * 2048 + (ks ? lo1 : lo0));
#pragma unroll
            for (int m = 0; m < 4; ++m)
#pragma unroll
                for (int n = 0; n < 4; ++n) acc[m][n] = __builtin_amdgcn_mfma_f32_16x16x32_bf16(bf[n], af[m], acc[m][n], 0, 0, 0);
        }
        }
    }
    if (SSQ && ssq_steps == nk) {
        __syncthreads();
        const float* rsl = (const float*)(lds + RS_OFF);
#pragma unroll
        for (int m = 0; m < 4; ++m) { const float r = rsl[wr * 64 + m * 16 + fr];
#pragma unroll
            for (int n = 0; n < 4; ++n) acc[m][n] = acc[m][n] * r; }
    }
#undef STAGE
#undef GLDS
}

DEV void phase1(const Ctx& c) {
    const bf16_t* h0 = (const bf16_t*)(c.ws + WS_H0); const bf16_t* WinT = (const bf16_t*)(c.ws + WS_WIN);
    bf16_t* U = (bf16_t*)(c.ws + WS_U); bf16_t* CQ = (bf16_t*)(c.ws + WS_CQ); bf16_t* CKV = (bf16_t*)(c.ws + WS_CKV); bf16_t* KR = (bf16_t*)(c.ws + WS_KR);
    const float* rc = (const float*)(c.ws + WS_ROPE); const float* rs = rc + L * 16;
    const StageGeo g = stage_geo(c.tid);
    const int lane = c.lane, wr = c.wid >> 1, wc = c.wid & 1, fr = lane & 15, fq = lane >> 4;
    constexpr int NT = 14, NU = (T / 128) * NT;
    for (int u = c.vcu; u < NU; u += c.G) {
        const int mt = u / NT, nt = u - mt * NT;
        const bf16_t* A = h0 + (size_t)(mt * 128) * D + g.c; const bf16_t* B = WinT + (size_t)(nt * 128) * D + g.c;
        f32x4 acc[4][4];
        gemm_mainloop<false>(acc, A + (size_t)g.r[0] * D, A + (size_t)g.r[1] * D, A + (size_t)g.r[2] * D, A + (size_t)g.r[3] * D,
                             B + (size_t)g.r[0] * D, B + (size_t)g.r[1] * D, B + (size_t)g.r[2] * D, B + (size_t)g.r[3] * D, 16, c.lds, 0, 0.f, nt == 13);
        const int row0 = mt * 128 + wr * 64 + fr;
        if (nt < 8) {
#pragma unroll
            for (int m = 0; m < 4; ++m) { const size_t row = row0 + m * 16;
#pragma unroll
                for (int i = 0; i < 2; ++i) {
                    f32x4 a = acc[m][2 * i], gt = acc[m][2 * i + 1], o;
#pragma unroll
                    for (int j = 0; j < 4; ++j) o[j] = a[j] * sigmoidf_(gt[j]);
                    st_bf4(U + row * CC + nt * 64 + wc * 32 + i * 16 + fq * 4, o);
                } }
        } else if (nt < 13) {
            const bool isq = nt < 11;
            bf16_t* dstb = isq ? CQ + (nt - 8) * 128 + wc * 64 + fq * 4 : CKV + (nt - 11) * 128 + wc * 64 + fq * 4;
            const int ldd = isq ? QL : KVL;
            float* ssb = isq ? (float*)(c.ws + WS_SSQ_CQ) + (nt - 8) * 2 + wc : (float*)(c.ws + WS_SSQ_CKV) + (nt - 11) * 2 + wc;
            const int lds_ = isq ? 8 : 4;
#pragma unroll
            for (int m = 0; m < 4; ++m) { const size_t row = row0 + m * 16; float sq = 0.f;
#pragma unroll
                for (int n = 0; n < 4; ++n) { st_bf4(dstb + row * ldd + n * 16, acc[m][n]);
                    sq += (acc[m][n][0] * acc[m][n][0] + acc[m][n][1] * acc[m][n][1]) + (acc[m][n][2] * acc[m][n][2] + acc[m][n][3] * acc[m][n][3]); }
                sq += __shfl_xor(sq, 16); sq += __shfl_xor(sq, 32);
                if (fq == 0) ssb[row * lds_] = sq; }
        } else if (wc == 0) {
#pragma unroll
            for (int m = 0; m < 4; ++m) { const int row = row0 + m * 16; const int p = row % L;
                const f32x4 cs = *(const f32x4*)(rc + p * 16 + fq * 4), sn = *(const f32x4*)(rs + p * 16 + fq * 4);
                const f32x4 x1 = acc[m][0], x2 = acc[m][1];
                st_bf4(KR + (size_t)row * 32 + fq * 4, x1 * cs - x2 * sn);
                st_bf4(KR + (size_t)row * 32 + 16 + fq * 4, x1 * sn + x2 * cs); }
        }
    }
}

DEV void conv_unit(const Ctx& c, int b, int j) {
    const bf16_t* U = (const bf16_t*)(c.ws + WS_U);
    bf16_t* MG = (bf16_t*)(c.ws + WS_MG);
    const float* cw = c.in[I_CONVW]; const float* cb = c.in[I_CONVB];
    const int p0 = NMETA + j * 32;
    float* ytile = (float*)c.lds;
    __syncthreads();
#pragma unroll 1
    for (int pass = 0; pass < 2; ++pass) {
        const int ch = c.tid + 256 * pass;
        float win[62]; unsigned raw[62];
        const bf16_t* ub = U + (size_t)b * L * CC + ch;
#pragma unroll
        for (int rep = 0; rep < CONV_REPA; ++rep) {
        asm volatile("" : "+v"(ub) :: "memory");
#pragma unroll
        for (int i = 0; i < 62; ++i) { const int p = p0 - 30 + i; const int pc = p < 0 ? 0 : (p >= L ? L - 1 : p); raw[i] = ub[(size_t)pc * CC]; }
        if (rep + 1 < CONV_REPA) {
#pragma unroll
            for (int i = 0; i < 62; ++i) asm volatile("" :: "v"(raw[i]));
        }
        }
        float w[31];
#pragma unroll
        for (int k = 0; k < 31; ++k) w[k] = cw[k * CC + ch];
        float bias = cb[ch];
        __builtin_amdgcn_sched_barrier(0);
#pragma unroll
        for (int i = 0; i < 62; ++i) { const int p = p0 - 30 + i; win[i] = (p >= 0 && p < L) ? __uint_as_float(raw[i] << 16) : 0.f; }
#pragma unroll
        for (int rep = 0; rep < CONV_REPB; ++rep) {
        asm volatile("" : "+v"(bias) :: "memory");
#pragma unroll
        for (int tt = 0; tt < 32; ++tt) {
            float a0 = bias;
#pragma unroll
            for (int k = 0; k < 31; ++k) a0 += w[k] * win[tt + k];
            ytile[tt * 512 + ch] = a0;
        }
        }
    }
    __syncthreads();
    const float* g1 = c.in[I_CLN_G]; const float* b1 = c.in[I_CLN_B]; const float* g2 = c.in[I_COUT_G];
    float G1[8], B1[8], G2[8];
    { const f32x4 a = *(const f32x4*)(g1 + c.lane * 8), bq = *(const f32x4*)(g1 + c.lane * 8 + 4); G1[0]=a.x;G1[1]=a.y;G1[2]=a.z;G1[3]=a.w;G1[4]=bq.x;G1[5]=bq.y;G1[6]=bq.z;G1[7]=bq.w; }
    { const f32x4 a = *(const f32x4*)(b1 + c.lane * 8), bq = *(const f32x4*)(b1 + c.lane * 8 + 4); B1[0]=a.x;B1[1]=a.y;B1[2]=a.z;B1[3]=a.w;B1[4]=bq.x;B1[5]=bq.y;B1[6]=bq.z;B1[7]=bq.w; }
    { const f32x4 a = *(const f32x4*)(g2 + c.lane * 8), bq = *(const f32x4*)(g2 + c.lane * 8 + 4); G2[0]=a.x;G2[1]=a.y;G2[2]=a.z;G2[3]=a.w;G2[4]=bq.x;G2[5]=bq.y;G2[6]=bq.z;G2[7]=bq.w; }
#pragma unroll
    for (int rep = 0; rep < CONV_REPC; ++rep) {
    asm volatile("" : "+v"(ytile) :: "memory");
    float v[8][8]; float st[8];
#pragma unroll
    for (int i = 0; i < 8; ++i) { const int tt = c.wid * 8 + i;
        const f32x4 ya = *(const f32x4*)(ytile + tt * 512 + c.lane * 8), yb = *(const f32x4*)(ytile + tt * 512 + c.lane * 8 + 4);
        v[i][0]=ya.x;v[i][1]=ya.y;v[i][2]=ya.z;v[i][3]=ya.w;v[i][4]=yb.x;v[i][5]=yb.y;v[i][6]=yb.z;v[i][7]=yb.w;
        st[i] = ((v[i][0] + v[i][1]) + (v[i][2] + v[i][3])) + ((v[i][4] + v[i][5]) + (v[i][6] + v[i][7])); }
    wave_sum_n<8>(st);
#pragma unroll
    for (int i = 0; i < 8; ++i) { const float mean = st[i] * (1.f / 512.f); float a = 0.f;
#pragma unroll
        for (int q = 0; q < 8; ++q) { v[i][q] -= mean; a += v[i][q] * v[i][q]; }
        st[i] = a; }
    wave_sum_n<8>(st);
#pragma unroll
    for (int i = 0; i < 8; ++i) { const float rstd = rsqrt_(st[i] * (1.f / 512.f) + EPS); float a = 0.f;
#pragma unroll
        for (int q = 0; q < 8; ++q) { const float x = v[i][q] * rstd * G1[q] + B1[q]; const float y = x * sigmoidf_(x); v[i][q] = y; a += y * y; }
        st[i] = a; }
    wave_sum_n<8>(st);
#pragma unroll
    for (int i = 0; i < 8; ++i) {
        const int p = p0 + c.wid * 8 + i;
        {
            const float r2 = rsqrt_(st[i] * (1.f / 512.f) + EPS);
            u32x4 o;
            o.x = cvtpk(v[i][0] * r2 * G2[0], v[i][1] * r2 * G2[1]); o.y = cvtpk(v[i][2] * r2 * G2[2], v[i][3] * r2 * G2[3]);
            o.z = cvtpk(v[i][4] * r2 * G2[4], v[i][5] * r2 * G2[5]); o.w = cvtpk(v[i][6] * r2 * G2[6], v[i][7] * r2 * G2[7]);
            const size_t tok = (size_t)b * SEQ + (p - NMETA);
            bf16_t* dstp = (p >= NMETA && p < L) ? MG + tok * D + 512 + c.lane * 8 : (bf16_t*)(c.ws + WS_DUMMY) + c.lane * 8;
            *(u32x4*)dstp = o;
        }
    }
    }
}
DEV void rope4(f32x4& x1, f32x4& x2, const float* rc, const float* rs, int p, int fq) {
    const f32x4 cs = *(const f32x4*)(rc + p * 16 + fq * 4), sn = *(const f32x4*)(rs + p * 16 + fq * 4);
    const f32x4 a = x1 * cs - x2 * sn, bb = x1 * sn + x2 * cs; x1 = a; x2 = bb;
}
DEV void phase2(const Ctx& c) {
    const bf16_t* CQ = (const bf16_t*)(c.ws + WS_CQ); const bf16_t* CKV = (const bf16_t*)(c.ws + WS_CKV);
    const bf16_t* WuqT = (const bf16_t*)(c.ws + WS_WUQ); const bf16_t* WukvT = (const bf16_t*)(c.ws + WS_WUKV);
    bf16_t* Q = (bf16_t*)(c.ws + WS_Q); bf16_t* KV = (bf16_t*)(c.ws + WS_KV);
    const float* rc = (const float*)(c.ws + WS_ROPE); const float* rs = rc + L * 16;
    const StageGeo g = stage_geo(c.tid);
    const int lane = c.lane, wr = c.wid >> 1, wc = c.wid & 1, fr = lane & 15, fq = lane >> 4;
    constexpr int NUC = NB * 64, NUQ = (TR / 128) * 6, NUKV = (TR / 128) * 8 + 8, NU = NUC + NUQ + NUKV;
    const int li = c.vcu & 63, rev = ((li >> 5) ^ li) & 1;
    const int nmine = (NU - c.vcu + c.G - 1) / c.G;
    for (int it = 0; it < nmine; ++it) {
        const int u = c.vcu + (rev ? (nmine - 1 - it) : it) * c.G;
        if (u < NUC) {
            conv_unit(c, u >> 6, u & 63);
        } else if (u < NUC + NUQ) {
            const int v = u - NUC, mt = v / 6, nt = v - mt * 6;
            const size_t t0 = (size_t)(mt >> 4) * L + NMETA + (mt & 15) * 128;
            const bf16_t* A = CQ + t0 * QL + g.c; const bf16_t* B = WuqT + (size_t)(nt * 128) * QL + g.c;
            f32x4 acc[4][4];
            __syncthreads();
            if (c.tid < 128) { const float* pp = (const float*)(c.ws + WS_SSQ_CQ) + (t0 + c.tid) * 8; const f32x4 p4 = *(const f32x4*)pp; const float2 p2 = *(const float2*)(pp + 4);
                ((float*)(c.lds + RS_OFF))[c.tid] = rsqrt_((((p4.x + p4.y) + (p4.z + p4.w)) + (p2.x + p2.y)) * (1.f / 384.f) + EPS); }
            gemm_mainloop<true>(acc, A + (size_t)g.r[0] * QL, A + (size_t)g.r[1] * QL, A + (size_t)g.r[2] * QL, A + (size_t)g.r[3] * QL,
                                B + (size_t)g.r[0] * QL, B + (size_t)g.r[1] * QL, B + (size_t)g.r[2] * QL, B + (size_t)g.r[3] * QL, 6, c.lds, 6, 1.f / 384.f);
            const int p0 = NMETA + (mt & 15) * 128 + wr * 64 + fr;
            const int t16 = (nt * 8 + wc * 4) % 6;
#pragma unroll
            for (int m = 0; m < 4; ++m) { const size_t row = t0 + wr * 64 + m * 16 + fr; const int p = p0 + m * 16;
#pragma unroll
                for (int n = 0; n < 4; ++n) acc[m][n] = acc[m][n] * QSCALE;
                if (t16 == 4) rope4(acc[m][0], acc[m][1], rc, rs, p, fq);
                if (t16 == 2) rope4(acc[m][2], acc[m][3], rc, rs, p, fq);
#pragma unroll
                for (int n = 0; n < 4; ++n) st_bf4(Q + row * NQ + nt * 128 + wc * 64 + n * 16 + fq * 4, acc[m][n]); }
        } else {
            const int v = u - NUC - NUQ; const bool meta = v >= (TR / 128) * 8;
            const int mt = meta ? 0 : v >> 3, nt = meta ? v - (TR / 128) * 8 : v & 7;
            const size_t t0 = meta ? 0 : (size_t)(mt >> 4) * L + NMETA + (mt & 15) * 128;
            const int rmask = meta ? 15 : 127;
            const bf16_t* A = CKV + t0 * KVL + g.c; const bf16_t* B = WukvT + (size_t)(nt * 128) * KVL + g.c;
            f32x4 acc[4][4];
            __syncthreads();
            if (c.tid < 128) { const f32x4 p4 = *(const f32x4*)((const float*)(c.ws + WS_SSQ_CKV) + (t0 + (c.tid & rmask)) * 4);
                ((float*)(c.lds + RS_OFF))[c.tid] = rsqrt_(((p4.x + p4.y) + (p4.z + p4.w)) * (1.f / 256.f) + EPS); }
            gemm_mainloop<true>(acc, A + (size_t)(g.r[0] & rmask) * KVL, A + (size_t)(g.r[1] & rmask) * KVL, A + (size_t)(g.r[2] & rmask) * KVL, A + (size_t)(g.r[3] & rmask) * KVL,
                                B + (size_t)g.r[0] * KVL, B + (size_t)g.r[1] * KVL, B + (size_t)g.r[2] * KVL, B + (size_t)g.r[3] * KVL, 4, c.lds, 4, 1.f / 256.f);
            if (!meta) {
#pragma unroll
                for (int m = 0; m < 4; ++m) { const size_t row = t0 + wr * 64 + m * 16 + fr;
#pragma unroll
                    for (int n = 0; n < 4; ++n) st_bf4(KV + row * NKV + nt * 128 + wc * 64 + n * 16 + fq * 4, acc[m][n]); }
            } else if (wr == 0) {
#pragma unroll 1
                for (int bb = 0; bb < NB; ++bb) {
#pragma unroll
                    for (int n = 0; n < 4; ++n) st_bf4(KV + ((size_t)bb * L + fr) * NKV + nt * 128 + wc * 64 + n * 16 + fq * 4, acc[0][n]); }
            }
        }
    }
}
DEV int crow(int r, int hi) { return (r & 3) + 8 * (r >> 2) + 4 * hi; }
#define KSWZ(row, colB) ((row) * 256 + ((colB) ^ (((row) & 7) << 4)))
#define SBAR() __builtin_amdgcn_sched_barrier(0)
DEV int v_st(int k, int cc) { const int kk = (k & ~0xC) | ((k & 4) << 1) | ((k & 8) >> 1); return ((kk >> 3) * 4 + (cc >> 5)) * 512 + ((kk & 7) * 32 + (cc & 31)) * 2; }
DEV int v_rd_base(int lane) { return ((lane & 3) << 3) | (((lane >> 2) & 3) << 6) | (((lane >> 4) & 1) << 5) | (((lane >> 5) & 1) << 8); }
constexpr int v_rd_off(int d0, int ks, int half) { return d0 * 512 + ks * 4096 + half * 2048; }
template <int OFF> DEV s16x4 tr_read(int vb) { s16x4 r; asm volatile("ds_read_b64_tr_b16 %0, %1 offset:%2" : "=&v"(r) : "v"(vb), "i"(OFF) : "memory"); return r; }
template <int D0> DEV void pv_one(f32x16& od, int vb, bf16x8 pa0, bf16x8 pa1, bf16x8 pa2, bf16x8 pa3) {
    const s16x4 l0 = tr_read<v_rd_off(D0, 0, 0)>(vb), h0 = tr_read<v_rd_off(D0, 0, 1)>(vb), l1 = tr_read<v_rd_off(D0, 1, 0)>(vb), h1 = tr_read<v_rd_off(D0, 1, 1)>(vb);
    const s16x4 l2 = tr_read<v_rd_off(D0, 2, 0)>(vb), h2 = tr_read<v_rd_off(D0, 2, 1)>(vb), l3 = tr_read<v_rd_off(D0, 3, 0)>(vb), h3 = tr_read<v_rd_off(D0, 3, 1)>(vb);
    asm volatile("s_waitcnt lgkmcnt(0)" ::: "memory"); SBAR();
#define PK(Lo, Hi) (bf16x8){Lo[0], Lo[1], Lo[2], Lo[3], Hi[0], Hi[1], Hi[2], Hi[3]}
    od = __builtin_amdgcn_mfma_f32_32x32x16_bf16(pa0, PK(l0, h0), od, 0, 0, 0);
    od = __builtin_amdgcn_mfma_f32_32x32x16_bf16(pa1, PK(l1, h1), od, 0, 0, 0);
    od = __builtin_amdgcn_mfma_f32_32x32x16_bf16(pa2, PK(l2, h2), od, 0, 0, 0);
    od = __builtin_amdgcn_mfma_f32_32x32x16_bf16(pa3, PK(l3, h3), od, 0, 0, 0);
#undef PK
}
constexpr float ATT_THR = 8.f;
constexpr int AT_V = 0, AT_K = 32768, AT_WS = 65536;
DEV void attn_unit(const Ctx& c, int b, int h, int qb) {
    const bf16_t* Q = (const bf16_t*)(c.ws + WS_Q); const bf16_t* KV = (const bf16_t*)(c.ws + WS_KV); const bf16_t* KR = (const bf16_t*)(c.ws + WS_KR);
    bf16_t* MG = (bf16_t*)(c.ws + WS_MG);
    unsigned char* lds = c.lds;
    const int tid = c.tid, wid = c.wid, lane = c.lane, r32 = lane & 31, hi = lane >> 5;
    float* wsf = (float*)(lds + AT_WS) + wid * 64; float* li_l = wsf; float* al_l = wsf + 32;
    const int NT = 2 * qb + 3;
    const int my_last = 2 * qb + (wid >> 1) + 1;
    bf16x8 qr[6];
    { const size_t t = (size_t)b * L + NMETA + qb * 128 + wid * 32 + r32;
      const bf16_t* Qw = Q + t * NQ + h * DQK + hi * 8;
#pragma unroll
      for (int d0 = 0; d0 < 6; ++d0) qr[d0] = *(const bf16x8*)(Qw + d0 * 16); }
    const int srow = tid >> 2, sq = tid & 3;
    const int vst0 = v_st(srow, sq * 16), vst1 = v_st(srow, sq * 16 + 8);
    const int kst0 = KSWZ(srow, sq * 32), kst1 = KSWZ(srow, sq * 32 + 16), kst2 = KSWZ(srow, 128 + sq * 16);
    const int vb0 = (int)(uintptr_t)(lds + AT_V) + v_rd_base(lane);
    u32x4 sk0, sk1, sk2, sv0, sv1;
#define SLOAD(j) do { int pos = (j) * 64 + srow - 48; pos = pos < 0 ? 0 : pos; const size_t tk = (size_t)b * L + pos; \
        const bf16_t* kvp = KV + tk * NKV + h * 128 + sq * 16; \
        sk0 = *(const u32x4*)(kvp); sk1 = *(const u32x4*)(kvp + 8); sv0 = *(const u32x4*)(kvp + 64); sv1 = *(const u32x4*)(kvp + 72); \
        sk2 = *(const u32x4*)(KR + tk * 32 + sq * 8); } while (0)
#define SWRITE(bb) do { unsigned char* kb = lds + AT_K + (bb) * 16384; unsigned char* vbp = lds + AT_V + (bb) * 16384; \
        *(u32x4*)(kb + kst0) = sk0; *(u32x4*)(kb + kst1) = sk1; *(u32x4*)(kb + kst2) = sk2; *(u32x4*)(vbp + vst0) = sv0; *(u32x4*)(vbp + vst1) = sv1; } while (0)
    float m_reg = 0.f, l_reg = 0.f; f32x16 o[2] = {};
    __syncthreads();
    SLOAD(0); SWRITE(0); __syncthreads();
    for (int j = 0; j < NT; ++j) {
        const int bsel = j & 1;
        if (j + 1 < NT) SLOAD(j + 1);
        if (j <= my_last) {
            const unsigned char* Ks = lds + AT_K + bsel * 16384;
            f32x16 p0, p1;
            { const float nm = -m_reg;
#pragma unroll
              for (int r = 0; r < 16; ++r) { p0[r] = nm; p1[r] = nm; } }
            __builtin_amdgcn_s_setprio(1);
#pragma unroll
            for (int d0 = 0; d0 < 6; ++d0) { const int cb = (d0 * 16 + hi * 8) * 2;
                const bf16x8 k0 = *(const bf16x8*)(Ks + KSWZ(r32, cb)); const bf16x8 k1 = *(const bf16x8*)(Ks + KSWZ(32 + r32, cb));
                p0 = __builtin_amdgcn_mfma_f32_32x32x16_bf16(k0, qr[d0], p0, 0, 0, 0);
                p1 = __builtin_amdgcn_mfma_f32_32x32x16_bf16(k1, qr[d0], p1, 0, 0, 0); }
            __builtin_amdgcn_s_setprio(0);
            if (j == 0) {
#pragma unroll
                for (int r = 0; r < 16; ++r) p0[r] = -1e30f;
#pragma unroll
                for (int r = 0; r < 8; ++r) p1[r] = -1e30f;
            }
            float pmax = fmaxf(fmaxf(p0[0], p0[1]), p0[2]);
#pragma unroll
            for (int r = 3; r < 15; r += 2) pmax = fmaxf(fmaxf(pmax, p0[r]), p0[r + 1]);
            pmax = fmaxf(fmaxf(pmax, p0[15]), p1[0]);
#pragma unroll
            for (int r = 1; r < 15; r += 2) pmax = fmaxf(fmaxf(pmax, p1[r]), p1[r + 1]);
            pmax = fmaxf(pmax, p1[15]);
            { auto rr = __builtin_amdgcn_permlane32_swap(__float_as_uint(pmax), __float_as_uint(pmax), false, false);
              pmax = fmaxf(__uint_as_float(rr[0]), __uint_as_float(rr[1])); }
            float ps = 0.f;
            if (__any(pmax > ATT_THR)) {
                const float dm = fmaxf(pmax, 0.f), alpha = fast_exp2(-dm); m_reg += dm;
#pragma unroll
                for (int r = 0; r < 16; ++r) { p0[r] -= dm; p1[r] -= dm; }
                l_reg *= alpha;
                if (hi == 0) al_l[r32] = alpha;
                asm volatile("s_waitcnt lgkmcnt(0)" ::: "memory");
#pragma unroll
                for (int r = 0; r < 16; ++r) { const float a = al_l[crow(r, hi)]; o[0][r] *= a; o[1][r] *= a; }
            }
#pragma unroll
            for (int r = 0; r < 16; ++r) { p0[r] = fast_exp2(p0[r]); ps += p0[r]; }
#pragma unroll
            for (int r = 0; r < 16; ++r) { p1[r] = fast_exp2(p1[r]); ps += p1[r]; }
            { auto rr = __builtin_amdgcn_permlane32_swap(__float_as_uint(ps), __float_as_uint(ps), false, false);
              ps = __uint_as_float(rr[0]) + __uint_as_float(rr[1]); }
            l_reg += ps;
            bf16x8 pa0, pa1, pa2, pa3;
#define PK4(P, BASE, OUT) do { unsigned a0 = cvtpk(P[BASE + 0], P[BASE + 1]), a1 = cvtpk(P[BASE + 2], P[BASE + 3]);   \
    unsigned b0 = cvtpk(P[BASE + 4], P[BASE + 5]), b1 = cvtpk(P[BASE + 6], P[BASE + 7]);                              \
    auto r0 = __builtin_amdgcn_permlane32_swap(a0, b0, false, false); auto r1 = __builtin_amdgcn_permlane32_swap(a1, b1, false, false); \
    u32x4 w = {r0[0], r1[0], r0[1], r1[1]}; OUT = *reinterpret_cast<bf16x8*>(&w); } while (0)
            PK4(p0, 0, pa0); PK4(p0, 8, pa1); PK4(p1, 0, pa2); PK4(p1, 8, pa3);
#undef PK4
            const int vb = vb0 + bsel * 16384;
            __builtin_amdgcn_s_setprio(1);
            pv_one<0>(o[0], vb, pa0, pa1, pa2, pa3); pv_one<1>(o[1], vb, pa0, pa1, pa2, pa3);
            __builtin_amdgcn_s_setprio(0);
        }
        if (j + 1 < NT) { if (bsel) SWRITE(0); else SWRITE(1); }
        __syncthreads();
    }
    if (hi == 0) li_l[r32] = l_reg;
    asm volatile("s_waitcnt lgkmcnt(0)" ::: "memory");
    const size_t tok0 = (size_t)b * SEQ + qb * 128 + wid * 32;
    float* SSO = (float*)(c.ws + WS_SSQ_O);
#pragma unroll
    for (int r = 0; r < 16; ++r) {
        const int orow = crow(r, hi); const float rl = fast_rcp(li_l[orow]);
        bf16_t* dst = MG + (tok0 + orow) * D + h * DV + r32;
        const float a0 = o[0][r] * rl, a1 = o[1][r] * rl;
        dst[0]  = (bf16_t)(cvtpk(a0, 0.f) & 0xffffu);
        dst[32] = (bf16_t)(cvtpk(a1, 0.f) & 0xffffu);
        float sq = a0 * a0 + a1 * a1;
        sq += dpp_mov<0xB1>(sq); sq += dpp_mov<0x4E>(sq); sq += dpp_mov<0x141>(sq); sq += dpp_mov<0x140>(sq);
        sq += __shfl_xor(sq, 16);
        if (r32 == 0) SSO[(tok0 + orow) * 8 + h] = sq;
    }
#undef SLOAD
#undef SWRITE
}
DEV void phase3(const Ctx& c) {
    const int nslots = NB * NH * 4;
    float* scr = (float*)(c.lds + c.wid * 8448);
    const int gw = c.vcu * 4 + c.wid, NGW = c.G * 4;
    constexpr int NWI = 6144;
    int wi = gw;
#define EW_ITEMS(n) do { __syncthreads(); for (int _q = 0; _q < (n) && wi < NWI; ++_q, wi += NGW) expert_weight_item(c, wi, scr); } while (0)
    for (int v = c.vcu; v < nslots; v += c.G) {
        const int bh = v >> 2, s = v & 3, b = bh >> 3, h = bh & 7;
        attn_unit(c, b, h, 15 - s); EW_ITEMS(1); attn_unit(c, b, h, s); EW_ITEMS(1); attn_unit(c, b, h, 11 - s); EW_ITEMS(1); attn_unit(c, b, h, 4 + s);
    }
    __syncthreads();
    for (; wi < NWI; wi += NGW) expert_weight_item(c, wi, scr);
#undef EW_ITEMS
}

DEV void phase4(const Ctx& c) {
    const bf16_t* MG = (const bf16_t*)(c.ws + WS_MG); const bf16_t* WoT = (const bf16_t*)(c.ws + WS_WO); const bf16_t* h0 = (const bf16_t*)(c.ws + WS_H0);
    bf16_t* R1 = (bf16_t*)(c.ws + WS_R1);
    const StageGeo g = stage_geo(c.tid);
    const int lane = c.lane, wr = c.wid >> 1, wc = c.wid & 1, fr = lane & 15, fq = lane >> 4;
    constexpr int NU = (TR / 128) * 8;
    const float* SSO = (const float*)(c.ws + WS_SSQ_O);
    f32x4 pa = {1.f, 1.f, 1.f, 1.f}, pb = pa;
    if (c.vcu < NU && c.tid < 128) { const float* pp = SSO + (size_t)((c.vcu >> 3) * 128 + c.tid) * 8; pa = *(const f32x4*)pp; pb = *(const f32x4*)(pp + 4); }
    for (int u = c.vcu; u < NU; u += c.G) {
        const int mt = u >> 3, nt = u & 7;
        const bf16_t* A = MG + (size_t)(mt * 128) * D + g.c; const bf16_t* B = WoT + (size_t)(nt * 128) * D + g.c;
        f32x4 acc[4][4];
        __syncthreads();
        if (c.tid < 128) ((float*)(c.lds + RS_OFF))[c.tid] = rsqrt_((((pa.x + pa.y) + (pa.z + pa.w)) + ((pb.x + pb.y) + (pb.z + pb.w))) * (1.f / 512.f) + EPS);
        { const int un = u + c.G; if (un < NU && c.tid < 128) { const float* pp = SSO + (size_t)((un >> 3) * 128 + c.tid) * 8; pa = *(const f32x4*)pp; pb = *(const f32x4*)(pp + 4); } }
        u32x2 hw[4][4];
#pragma unroll
        for (int m = 0; m < 4; ++m) {
            const int tok = mt * 128 + wr * 64 + m * 16 + fr;
            const size_t t = (size_t)(tok >> 11) * L + NMETA + (tok & 2047);
#pragma unroll
            for (int n = 0; n < 4; ++n) hw[m][n] = *(const u32x2*)(h0 + t * D + nt * 128 + wc * 64 + n * 16 + fq * 4);
        }
        gemm_mainloop<true>(acc, A + (size_t)g.r[0] * D, A + (size_t)g.r[1] * D, A + (size_t)g.r[2] * D, A + (size_t)g.r[3] * D,
                            B + (size_t)g.r[0] * D, B + (size_t)g.r[1] * D, B + (size_t)g.r[2] * D, B + (size_t)g.r[3] * D, 16, c.lds, 8, 1.f / 512.f);
#pragma unroll
        for (int m = 0; m < 4; ++m) {
            const int tok = mt * 128 + wr * 64 + m * 16 + fr;
#pragma unroll
            for (int n = 0; n < 4; ++n) {
                const int col = nt * 128 + wc * 64 + n * 16 + fq * 4;
                f32x4 o; o[0] = ALPHA * bflo(hw[m][n].x) + acc[m][n][0]; o[1] = ALPHA * bfhi(hw[m][n].x) + acc[m][n][1];
                o[2] = ALPHA * bflo(hw[m][n].y) + acc[m][n][2]; o[3] = ALPHA * bfhi(hw[m][n].y) + acc[m][n][3];
                st_bf4(R1 + (size_t)tok * D + col, o);
            }
        }
    }
}

constexpr int P5_ROWB = 2064, P5_PART = 33280, P5_LG = 45568, P5_BIAS = 48128, P5_AGG = 48384;
DEV void phase5(const Ctx& c, int ALT = 0) {
    const bf16_t* R1 = (const bf16_t*)(c.ws + WS_R1);
    const bf16_t* WrT = (const bf16_t*)(c.ws + WS_WR);
    unsigned* cnt = (unsigned*)(c.ws + WS_CTL) + CW_CNT + ALT * 32; unsigned* list = (unsigned*)(c.ws + (ALT ? 404 * MiB : WS_LIST)); float* combw = (float*)(c.ws + WS_COMBW);
    const int lane = c.lane, wid = c.wid, fr = lane & 15, fq = lane >> 4;
    float* part = (float*)(c.lds + P5_PART); float* lgs = (float*)(c.lds + P5_LG); float* biasl = (float*)(c.lds + P5_BIAS);
    __syncthreads();
    if (c.tid < 36) biasl[c.tid] = (c.tid < 4) ? c.in[I_BRG][c.tid] : c.in[I_BRE][c.tid - 4];
    bf16x8 wf[8][3];
#pragma unroll
    for (int ks = 0; ks < 8; ++ks)
#pragma unroll
        for (int n = 0; n < 3; ++n) wf[ks][n] = *(const bf16x8*)(WrT + (size_t)(n * 16 + fr) * D + wid * 256 + ks * 32 + fq * 8);
    unsigned* lcnt = (unsigned*)(c.lds + P5_AGG); unsigned* lbase = lcnt + 32; unsigned* ent = lcnt + 64;
    if (c.tid < 32) lcnt[c.tid] = 0u;
    int nent = 0;
    for (int u = c.vcu; u < TR / 16; u += c.G) {
        const int tok0 = u * 16;
        { const float* src[4]; bf16_t* dst[4]; unsigned char* ldsn[4]; unsigned char* f8n[4]; float* stn[4];
#pragma unroll
          for (int i = 0; i < 4; ++i) { const int tl = wid * 4 + i; const size_t tok = tok0 + tl; src[i] = (const float*)(R1 + tok * D); dst[i] = nullptr; ldsn[i] = c.lds + tl * P5_ROWB; f8n[i] = c.ws + WS_H1F8 + tok * D;
              stn[i] = (float*)(c.ws + WS_ST1) + tok * 2; }
          ln_rows_bf16<4, true, true, true>(src, c.in[I_LN1G], c.in[I_LN1B], dst, ldsn, lane, f8n, stn); }
        __syncthreads();
        f32x4 acc[3] = {};
#pragma unroll
        for (int ks = 0; ks < 8; ++ks) {
            const int k = wid * 256 + ks * 32 + fq * 8;
            const bf16x8 a = *(const bf16x8*)(c.lds + fr * P5_ROWB + k * 2);
#pragma unroll
            for (int n = 0; n < 3; ++n) acc[n] = __builtin_amdgcn_mfma_f32_16x16x32_bf16(wf[ks][n], a, acc[n], 0, 0, 0);
        }
#pragma unroll
        for (int n = 0; n < 3; ++n) *(f32x4*)(part + (wid * 16 + fr) * 48 + n * 16 + fq * 4) = acc[n];
        __syncthreads();
#pragma unroll
        for (int i = 0; i < 3; ++i) { const int idx = c.tid + 256 * i;
            if (idx < 576) { const int tk = idx / 36, l = idx - tk * 36;
                lgs[tk * 40 + l] = ((part[tk * 48 + l] + part[(16 + tk) * 48 + l]) + (part[(32 + tk) * 48 + l] + part[(48 + tk) * 48 + l])) + biasl[l]; } }
        __syncthreads();
        if (c.tid < 16) {
            const float* lg = lgs + c.tid * 40;
            int gi = 0; float gm = lg[0];
#pragma unroll
            for (int i = 1; i < 4; ++i) { const float v = lg[i]; if (v > gm) { gm = v; gi = i; } }
            float gs = 0.f;
#pragma unroll
            for (int i = 0; i < 4; ++i) gs += __expf(lg[i] - gm);
            const float gw = 1.f / gs;
            const float* le = lg + 4 + gi * 8;
            float v0 = le[0], v1 = -3.0e38f; int i0 = 0, i1 = 0;
#pragma unroll
            for (int i = 1; i < 8; ++i) { const float v = le[i];
                if (v > v0) { v1 = v0; i1 = i0; v0 = v; i0 = i; } else if (v > v1) { v1 = v; i1 = i; } }
            const float ex = __expf(v1 - v0), inv = 1.f / (1.f + ex);
            const int tok = tok0 + c.tid; const unsigned e0 = gi * 8 + i0, e1 = gi * 8 + i1;
            combw[tok * 2] = gw * inv; combw[tok * 2 + 1] = gw * ex * inv;
            const unsigned r0 = atomicAdd(&lcnt[e0], 1u), r1 = atomicAdd(&lcnt[e1], 1u);
            const int ei = nent * 32 + c.tid * 2;
            ent[2 * ei] = (unsigned)(tok * 2);         ent[2 * ei + 1] = (e0 << 16) | r0;
            ent[2 * ei + 2] = (unsigned)(tok * 2 + 1); ent[2 * ei + 3] = (e1 << 16) | r1;
        }
        ++nent;
    }
    __syncthreads();
    if (c.tid < 32) { const unsigned n = lcnt[c.tid]; lbase[c.tid] = n ? atomicAdd(&cnt[c.tid * CNT_STRIDE], n) : 0u; }
    __syncthreads();
    for (int i = c.tid; i < nent * 32; i += 256) { const unsigned t2 = ent[2 * i], er = ent[2 * i + 1]; const unsigned e = er >> 16;
        list[(size_t)e * TR + lbase[e] + (er & 0xffffu)] = t2; }
}
DEV void bar20(const Ctx& c) {}
DEV void moe_tiles(const Ctx& c) {
    const unsigned* cnt = (const unsigned*)(c.ws + WS_CTL) + CW_CNT; int* ts = (int*)(c.lds + EXP_OFF);
    __syncthreads();
    if (c.tid < NE) ts[40 + c.tid] = (int)__hip_atomic_load(&cnt[c.tid * CNT_STRIDE], __ATOMIC_RELAXED, __HIP_MEMORY_SCOPE_AGENT);
    __syncthreads();
    if (c.tid == 0) { int s = 0; for (int e = 0; e < NE; ++e) { ts[e] = s; s += (ts[40 + e] + 127) >> 7; } ts[NE] = s; }
    __syncthreads();
}
DEV void phase6a(const Ctx& c) {
    const bf16_t* H18 = (const bf16_t*)(c.ws + WS_H1F8); const bf16_t* Wgu8 = (const bf16_t*)(c.ws + WS_WGU); unsigned char* ACT8 = c.ws + WS_ACT;
    const unsigned* list = (const unsigned*)(c.ws + WS_LIST);
    moe_tiles(c);
    const int* ts = (const int*)(c.lds + EXP_OFF); unsigned* tbl = (unsigned*)(c.lds + TBL_OFF);
    const StageGeo g = stage_geo(c.tid);
    const int lane = c.lane, wr = c.wid >> 1, wc = c.wid & 1, fr = lane & 15, fq = lane >> 4;
    const int NU = ts[NE] * 4;
    u32x2* RI = (u32x2*)(c.ws + WS_RI); const float* combw = (const float*)(c.ws + WS_COMBW);
    int e = 0, en_e = 0; unsigned en_cur = 0xffffffffu;
    { const int u0 = c.vcu; if (u0 < NU) { const int rt0 = u0 >> 2; while (ts[en_e + 1] <= rt0) ++en_e;
        if (c.tid < 128) { const int j = (rt0 - ts[en_e]) * 128 + c.tid; en_cur = (j < ts[40 + en_e]) ? list[(size_t)en_e * TR + j] : 0xffffffffu; } } }
    for (int u = c.vcu; u < NU; u += c.G) {
        const int rt = u >> 2, nt = u & 3;
        e = en_e;
        __syncthreads();
        float wri = 0.f;
        if (c.tid < 128) { tbl[c.tid] = en_cur; if (nt == 0 && en_cur != 0xffffffffu) wri = combw[en_cur]; }
        const unsigned en_this = en_cur;
        { const int un = u + c.G; if (un < NU) { const int rtn = un >> 2; while (ts[en_e + 1] <= rtn) ++en_e;
            if (c.tid < 128) { const int j = (rtn - ts[en_e]) * 128 + c.tid; en_cur = (j < ts[40 + en_e]) ? list[(size_t)en_e * TR + j] : 0xffffffffu; } } }
        __syncthreads();
        size_t ro[4];
#pragma unroll
        for (int i = 0; i < 4; ++i) { const unsigned en = tbl[g.r[i]]; ro[i] = (en == 0xffffffffu) ? 0 : (size_t)(en >> 1) * (D / 2); }
        const bf16_t* A = H18 + g.c; const bf16_t* B = Wgu8 + ((size_t)e * 512 + nt * 128) * (D / 2) + g.c;
        f32x4 acc[4][4];
        gemm_mainloop<false, true>(acc, A + ro[0], A + ro[1], A + ro[2], A + ro[3],
                             B + (size_t)g.r[0] * (D / 2), B + (size_t)g.r[1] * (D / 2), B + (size_t)g.r[2] * (D / 2), B + (size_t)g.r[3] * (D / 2), 8, c.lds, 0, 0.f);
#pragma unroll
        for (int m = 0; m < 4; ++m) { const size_t row = (size_t)rt * 128 + wr * 64 + m * 16 + fr;
#pragma unroll
            for (int i = 0; i < 2; ++i) {
                const f32x4 gt = acc[m][2 * i], up = acc[m][2 * i + 1]; f32x4 o;
#pragma unroll
                for (int j = 0; j < 4; ++j) { const float gv = gt[j] * WUNSCALE; o[j] = gv * sigmoidf_(gv) * (up[j] * WUNSCALE); }
                *(unsigned*)(ACT8 + row * DE + nt * 64 + wc * 32 + i * 16 + fq * 4) = pk_fp8x4(o[0], o[1], o[2], o[3]);
            } }
        if (nt == 0 && c.tid < 128) { u32x2 ri; ri.x = en_this; ri.y = __float_as_uint(wri); RI[(size_t)rt * 128 + c.tid] = ri; }
    }
}
DEV void phase6b(const Ctx& c) {
    const bf16_t* ACT8 = (const bf16_t*)(c.ws + WS_ACT); const bf16_t* Wd8 = (const bf16_t*)(c.ws + WS_WD); unsigned char* Y8 = c.ws + WS_Y;
    const u32x2* RI = (const u32x2*)(c.ws + WS_RI);
    moe_tiles(c);
    const int* ts = (const int*)(c.lds + EXP_OFF); u32x2* tbl = (u32x2*)(c.lds + TBL_OFF);
    const StageGeo g = stage_geo(c.tid);
    unsigned char* lds = c.lds;
    const int tid = c.tid, lane = c.lane, wr = c.wid >> 1, wc = c.wid & 1, fr = lane & 15, fq = lane >> 4;
    const int cb0 = fq * 32, cb1 = fq * 32 + 16;
    const int q0 = (cb0 >> 6) * 1024 + ((fr * 64 + (cb0 & 63)) ^ ((fr >> 3) << 5)), q1 = (cb1 >> 6) * 1024 + ((fr * 64 + (cb1 & 63)) ^ ((fr >> 3) << 5));
    const int a_off = wr * 8192, b_off = wc * 8192, dst = tid * 16;
    const int NU = ts[NE] * 2;
    int e = 0;
#define GLDS(src, off) __builtin_amdgcn_global_load_lds((const unsigned*)(src), (unsigned LAS*)(lds + (off)), 16, 0, 0)
    for (int u = c.vcu; u < NU; u += c.G) {
        const int rt = u >> 1, nh = u & 1;
        while (ts[e + 1] <= rt) ++e;
        __syncthreads();
        if (tid < 128) tbl[tid] = RI[(size_t)rt * 128 + tid];
        const bf16_t* A = ACT8 + (size_t)(rt * 128) * (DE / 2) + g.c;
        const bf16_t* B = Wd8 + ((size_t)e * 1024 + nh * 512) * (DE / 2) + g.c;
#pragma unroll
        for (int kt = 0; kt < 2; ++kt)
#pragma unroll
            for (int i = 0; i < 4; ++i) GLDS(A + (size_t)g.r[i] * (DE / 2) + kt * 64, kt * 16384 + dst + i * 4096);
#define BSTAGE(s_, buf) do { const bf16_t* _b = B + (size_t)((s_) >> 1) * 128 * (DE / 2) + ((s_) & 1) * 64; \
        GLDS(_b + (size_t)g.r[0] * (DE / 2), 32768 + (buf) * 16384 + dst);        GLDS(_b + (size_t)g.r[1] * (DE / 2), 32768 + (buf) * 16384 + dst + 4096); \
        GLDS(_b + (size_t)g.r[2] * (DE / 2), 32768 + (buf) * 16384 + dst + 8192); GLDS(_b + (size_t)g.r[3] * (DE / 2), 32768 + (buf) * 16384 + dst + 12288); } while (0)
        BSTAGE(0, 0);
        f32x4 acc[4][4];
#pragma unroll
        for (int m = 0; m < 4; ++m)
#pragma unroll
            for (int n = 0; n < 4; ++n) acc[m][n] = (f32x4){0.f, 0.f, 0.f, 0.f};
#pragma unroll 1
        for (int s_ = 0; s_ < 8; ++s_) {
            VM_WAIT();
            __syncthreads();
            const int bsel = s_ & 1;
            if (s_ + 1 < 8) { if (bsel) BSTAGE(s_ + 1, 0); else BSTAGE(s_ + 1, 1); }
            const unsigned char* ab = lds + bsel * 16384 + a_off; const unsigned char* bb = lds + 32768 + bsel * 16384 + b_off;
            v8i ax[4], bx[4];
#pragma unroll
            for (int m = 0; m < 4; ++m) { const u32x4 c0 = *(const u32x4*)(ab + m * 2048 + q0), c1 = *(const u32x4*)(ab + m * 2048 + q1);
                ax[m] = (v8i){(int)c0.x, (int)c0.y, (int)c0.z, (int)c0.w, (int)c1.x, (int)c1.y, (int)c1.z, (int)c1.w}; }
#pragma unroll
            for (int n = 0; n < 4; ++n) { const u32x4 c0 = *(const u32x4*)(bb + n * 2048 + q0), c1 = *(const u32x4*)(bb + n * 2048 + q1);
                bx[n] = (v8i){(int)c0.x, (int)c0.y, (int)c0.z, (int)c0.w, (int)c1.x, (int)c1.y, (int)c1.z, (int)c1.w}; }
#pragma unroll
            for (int m = 0; m < 4; ++m)
#pragma unroll
                for (int n = 0; n < 4; ++n) acc[m][n] = __builtin_amdgcn_mfma_scale_f32_16x16x128_f8f6f4(bx[n], ax[m], acc[m][n], 0, 0, 0, 0x7F7F7F7F, 0, 0x7F7F7F7F);
            if (bsel) {
                const int nt = nh * 4 + (s_ >> 1);
#pragma unroll
                for (int m = 0; m < 4; ++m) {
                    const u32x2 ri = tbl[wr * 64 + m * 16 + fr]; const unsigned en = ri.x;
                    if (en != 0xffffffffu) {
                        const float w = __uint_as_float(ri.y) * (WUNSCALE * YSCALE); unsigned char* dstp = Y8 + ((size_t)(en & 1u) * TR + (en >> 1)) * D + nt * 128 + wc * 64 + fq * 4;
#pragma unroll
                        for (int n = 0; n < 4; ++n) { const f32x4 o = acc[m][n] * w; *(unsigned*)(dstp + n * 16) = pk_fp8x4(o[0], o[1], o[2], o[3]); }
                    }
#pragma unroll
                    for (int n = 0; n < 4; ++n) acc[m][n] = (f32x4){0.f, 0.f, 0.f, 0.f};
                }
            }
        }
#undef BSTAGE
    }
#undef GLDS
}

DEV void phase7(const Ctx& c) {
    const bf16_t* R1 = (const bf16_t*)(c.ws + WS_R1); const unsigned char* Y8 = c.ws + WS_Y; const float2* ST1 = (const float2*)(c.ws + WS_ST1);
    const float* g = c.in[I_LN2G]; const float* bt = c.in[I_LN2B];
    const int gw = c.vcu * 4 + c.wid, NGW = c.G * 4, lane = c.lane;
    float G1[16], B1[16];
#pragma unroll
    for (int i = 0; i < 2; ++i)
#pragma unroll
        for (int q = 0; q < 2; ++q) { const f32x4 a = *(const f32x4*)(c.in[I_LN1G] + i * 512 + lane * 8 + q * 4), bq = *(const f32x4*)(c.in[I_LN1B] + i * 512 + lane * 8 + q * 4);
#pragma unroll
            for (int e = 0; e < 4; ++e) { G1[i * 8 + q * 4 + e] = a[e]; B1[i * 8 + q * 4 + e] = bq[e]; } }
    for (int tok0 = gw; tok0 < TR; tok0 += 2 * NGW) {
        float v[2][16]; float st[2]; int tk[2];
#pragma unroll
        for (int r = 0; r < 2; ++r) {
            int tok = tok0 + r * NGW; if (tok >= TR) tok = tok0; tk[r] = tok;
            const float2 ms = ST1[tok]; const float am = ALPHA * ms.y;
#pragma unroll
            for (int i = 0; i < 2; ++i) {
                const u32x4 hw = *(const u32x4*)(R1 + (size_t)tok * D + i * 512 + lane * 8);
                const u32x2 y0 = *(const u32x2*)(Y8 + (size_t)tok * D + i * 512 + lane * 8);
                const u32x2 y1 = *(const u32x2*)(Y8 + ((size_t)TR + tok) * D + i * 512 + lane * 8);
#pragma unroll
                for (int q2 = 0; q2 < 2; ++q2) {
                    const auto a0 = __builtin_amdgcn_cvt_pk_f32_fp8((int)y0[q2], false), a1 = __builtin_amdgcn_cvt_pk_f32_fp8((int)y0[q2], true);
                    const auto b0 = __builtin_amdgcn_cvt_pk_f32_fp8((int)y1[q2], false), b1 = __builtin_amdgcn_cvt_pk_f32_fp8((int)y1[q2], true);
                    const int e0 = i * 8 + 4 * q2;
                    v[r][e0]     = (bflo(hw[2 * q2]) - ms.x) * (am * G1[e0]) + ALPHA * B1[e0] + (a0[0] + b0[0]) * YUNSCALE;
                    v[r][e0 + 1] = (bfhi(hw[2 * q2]) - ms.x) * (am * G1[e0 + 1]) + ALPHA * B1[e0 + 1] + (a0[1] + b0[1]) * YUNSCALE;
                    v[r][e0 + 2] = (bflo(hw[2 * q2 + 1]) - ms.x) * (am * G1[e0 + 2]) + ALPHA * B1[e0 + 2] + (a1[0] + b1[0]) * YUNSCALE;
                    v[r][e0 + 3] = (bfhi(hw[2 * q2 + 1]) - ms.x) * (am * G1[e0 + 3]) + ALPHA * B1[e0 + 3] + (a1[1] + b1[1]) * YUNSCALE;
                }
            }
        }
#pragma unroll
        for (int r = 0; r < 2; ++r) { float a = 0.f;
#pragma unroll
            for (int q = 0; q < 16; ++q) a += v[r][q];
            st[r] = a; }
        wave_sum_n<2>(st);
#pragma unroll
        for (int r = 0; r < 2; ++r) { const float mean = st[r] * (1.f / 1024.f); float a = 0.f;
#pragma unroll
            for (int q = 0; q < 16; ++q) { v[r][q] -= mean; a += v[r][q] * v[r][q]; }
            st[r] = a; }
        wave_sum_n<2>(st);
#pragma unroll
        for (int i = 0; i < 2; ++i)
#pragma unroll
            for (int q = 0; q < 2; ++q) {
                const int col = i * 512 + lane * 8 + q * 4;
                const f32x4 gg = *(const f32x4*)(g + col), bb = *(const f32x4*)(bt + col);
#pragma unroll
                for (int r = 0; r < 2; ++r) {
                    if (r == 1 && tok0 + NGW >= TR) continue;
                    const float rstd = rsqrt_(st[r] * (1.f / 1024.f) + EPS);
                    f32x4 o; o[0] = v[r][i * 8 + q * 4] * rstd * gg[0] + bb[0]; o[1] = v[r][i * 8 + q * 4 + 1] * rstd * gg[1] + bb[1];
                    o[2] = v[r][i * 8 + q * 4 + 2] * rstd * gg[2] + bb[2]; o[3] = v[r][i * 8 + q * 4 + 3] * rstd * gg[3] + bb[3];
                    *(f32x4*)(c.out + (size_t)tk[r] * D + col) = o;
                }
            }
    }
}

__global__ void __launch_bounds__(256, 2) fwd_kernel(Args a) {
    extern __shared__ __attribute__((aligned(16))) unsigned char lds[];
    Ctx c; c.in = a.in; c.out = a.out; c.ws = a.ws; c.lds = lds;
    c.tid = threadIdx.x; c.lane = c.tid & 63; c.wid = __builtin_amdgcn_readfirstlane(c.tid >> 6);
    c.G = gridDim.x; { const int bx = blockIdx.x; c.vcu = (c.G % 8 == 0) ? (bx % 8) * (c.G / 8) + bx / 8 : bx; }
    if (c.tid < 64) ((unsigned*)(lds + MISC_OFF))[c.tid] = 0u;
    __syncthreads();
    unsigned* ctl = (unsigned*)(a.ws + WS_CTL);
    XcdBarrier bar = xcd_barrier_post(ctl + CW_BAR, (volatile LAS unsigned*)(lds + MISC_OFF));
#ifdef ONLY_PH
#define PH_ON(k) ((k) == ONLY_PH)
#else
#define PH_ON(k) 1
#endif
    const int lo = a.ph_lo, hi = a.ph_hi;
#define RUN_PHASE(k, fn) if (PH_ON(k) && lo <= (k) && (k) < hi) { \
        for (int _rep = 0; _rep < ((REPEAT_PH == (k)) ? 2 : 1); ++_rep) { \
            int _t = threadIdx.x; asm volatile("" : "+v"(_t)); c.tid = _t; c.lane = _t & 63; c.wid = __builtin_amdgcn_readfirstlane(_t >> 6); \
            if ((k) == 5) phase5(c, _rep); else fn(c); \
            if (_rep == 0 && REPEAT_PH == (k)) xcd_barrier(bar); } \
        if ((k) + 1 < hi) xcd_barrier(bar); }
    RUN_PHASE(0, phase0)
    RUN_PHASE(1, phase1)
    RUN_PHASE(2, phase2)
    RUN_PHASE(3, phase3)
    RUN_PHASE(4, phase4)
    RUN_PHASE(5, phase0)
    RUN_PHASE(6, phase6a)
    RUN_PHASE(7, phase6b)
    RUN_PHASE(8, phase7)
}

extern "C" void kernel_launch(void* const* d_in, const int* in_sizes, int n_in, void* d_out, int out_size, void* d_ws, size_t ws_size, hipStream_t stream) {
    static int grid = 0;
    if (grid == 0) {
        if (n_in != 27 || in_sizes[0] != NB * SEQ * D || out_size != TR * D || ws_size < WS_END) {
            fprintf(stderr, "kernel_launch: shape mismatch n_in %d in0 %d out %d ws %zu\n", n_in, n_in > 0 ? in_sizes[0] : -1, out_size, ws_size); grid = -1; return; }
        int dev = 0, cus = 0, per_cu = 0;
        if (hipGetDevice(&dev) != hipSuccess || hipDeviceGetAttribute(&cus, hipDeviceAttributeMultiprocessorCount, dev) != hipSuccess) { grid = -1; return; }
        if (hipFuncSetAttribute((const void*)fwd_kernel, hipFuncAttributeMaxDynamicSharedMemorySize, LDS_BYTES) != hipSuccess) { grid = -1; return; }
        if (hipOccupancyMaxActiveBlocksPerMultiprocessor(&per_cu, (const void*)fwd_kernel, 256, LDS_BYTES) != hipSuccess || per_cu < 1) per_cu = 1;
        (void)hipGetLastError();
        if (per_cu > 2) per_cu = 2;
        grid = cus * per_cu;
        fprintf(stderr, "kernel_launch: grid %d (%d per CU)\n", grid, per_cu);
    }
    if (grid < 0) return;
    (void)hipMemsetAsync((char*)d_ws + WS_CTL, 0, CTL_ZERO_BYTES, stream);
    Args a{};
    for (int i = 0; i < 27; ++i) a.in[i] = (const float*)d_in[i];
    a.out = (float*)d_out; a.ws = (unsigned char*)d_ws;
    if (MK_N_LAUNCHES == 1) {
        a.ph_lo = 0; a.ph_hi = NPH;
        hipLaunchKernelGGL(fwd_kernel, dim3(grid), dim3(256), LDS_BYTES, stream, a);
    } else {
        for (int ph = 0; ph < NPH; ++ph) { a.ph_lo = ph; a.ph_hi = ph + 1; hipLaunchKernelGGL(fwd_kernel, dim3(grid), dim3(256), LDS_BYTES, stream, a); }
    }
}
```

```cpp
#include <hip/hip_runtime.h>
#include <cstdio>
#include <cstdint>

#ifndef REPEAT_PH
#define REPEAT_PH -1
#endif
#ifndef CONV_REPB
#define CONV_REPB 1
#endif
#ifndef CONV_REPC
#define CONV_REPC 1
#endif
#ifndef CONV_REPA
#define CONV_REPA 1
#endif
#ifndef MK_N_LAUNCHES
#define MK_N_LAUNCHES 1
#endif

#define DEV __device__ __forceinline__
#define LAS __attribute__((address_space(3)))
#define GAS __attribute__((address_space(1)))
typedef unsigned short bf16_t;
typedef short bf16x8 __attribute__((ext_vector_type(8)));
typedef short s16x4 __attribute__((ext_vector_type(4)));
typedef float f32x4 __attribute__((ext_vector_type(4)));
typedef float f32x16 __attribute__((ext_vector_type(16)));
typedef unsigned u32x4 __attribute__((ext_vector_type(4)));
typedef unsigned u32x2 __attribute__((ext_vector_type(2)));
typedef long i64x2 __attribute__((ext_vector_type(2)));
typedef int v8i __attribute__((ext_vector_type(8)));

constexpr int NB = 16, SEQ = 2048, NMETA = 16, L = SEQ + NMETA;
constexpr int T = NB * L;
constexpr int TR = NB * SEQ;
constexpr int D = 1024, NIN = 1696, CC = 512, QL = 384, KVL = 256, NH = 8, DQK = 96, DV = 64;
constexpr int NQ = NH * DQK;
constexpr int NKV = NH * (64 + DV);
constexpr int NE = 32, DE = 256, CONVK = 31;
constexpr float EPS = 1e-5f;
constexpr float ALPHA = 1.189207115002721f;
constexpr float QSCALE = 0.10206207261596577f * 1.4426950408889634f;
constexpr int NPH = 9;
constexpr float WSCALE = 16.f, WUNSCALE = 1.f / 16.f;
constexpr float YSCALE = 64.f, YUNSCALE = 1.f / 64.f;

constexpr size_t MiB = 1u << 20;
constexpr size_t WS_CTL = 0, CTL_ZERO_BYTES = 64 * 1024;
constexpr int CW_CNT = 1024, CNT_STRIDE = 64;
constexpr int CW_BAR = 4096;
constexpr size_t WS_LIST = 1 * MiB;
constexpr size_t WS_COMBW = 5 * MiB;
constexpr size_t WS_ST1 = 5 * MiB + 256 * 1024;
constexpr size_t WS_ROPE = 5 * MiB + 512 * 1024;
constexpr size_t WS_WIN = 6 * MiB;
constexpr size_t WS_WUQ = 10 * MiB;
constexpr size_t WS_WUKV = 11 * MiB;
constexpr size_t WS_WO = 12 * MiB;
constexpr size_t WS_WR = 14 * MiB;
constexpr size_t WS_RI = 14 * MiB + 512 * 1024;
constexpr size_t WS_SSQ_CQ = 404 * MiB + 512 * 1024;
constexpr size_t WS_SSQ_CKV = 402 * MiB;
constexpr size_t WS_SSQ_O = 403 * MiB;
constexpr size_t WS_WGU = 16 * MiB;
constexpr size_t WS_WD = 48 * MiB;
constexpr size_t WS_H1F8 = 130 * MiB;
constexpr size_t WS_H0 = 64 * MiB;
constexpr size_t WS_U = 130 * MiB;
constexpr size_t WS_CQ = 163 * MiB;
constexpr size_t WS_CKV = 188 * MiB;
constexpr size_t WS_KR = 205 * MiB;
constexpr size_t WS_Q = 208 * MiB;
constexpr size_t WS_KV = 257 * MiB;
constexpr size_t WS_R1 = 208 * MiB;
constexpr size_t WS_Y = 272 * MiB;
constexpr size_t WS_MG = 336 * MiB;
constexpr size_t WS_ACT = 336 * MiB;
constexpr size_t WS_DUMMY = 400 * MiB;
constexpr size_t WS_END = 406 * MiB;

constexpr int LDS_BYTES = 73728;
constexpr int MISC_OFF = LDS_BYTES - 256;
constexpr int RS_OFF = 65536;
constexpr int TBL_OFF = 66048;
constexpr int EXP_OFF = 67584;

DEV unsigned cvtpk(float lo, float hi) { unsigned r; asm("v_cvt_pk_bf16_f32 %0, %1, %2" : "=v"(r) : "v"(lo), "v"(hi)); return r; }
DEV float bflo(unsigned w) { return __uint_as_float(w << 16); }
DEV float bfhi(unsigned w) { return __uint_as_float(w & 0xffff0000u); }
DEV float dpp_add_qp(float v, int) { return v; }
template <int CTRL> DEV float dpp_mov(float v) { return __builtin_bit_cast(float, __builtin_amdgcn_update_dpp(0, __builtin_bit_cast(int, v), CTRL, 0xf, 0xf, false)); }
DEV float wave_sum(float v) {
    v += dpp_mov<0xB1>(v);
    v += dpp_mov<0x4E>(v);
    v += dpp_mov<0x141>(v);
    v += dpp_mov<0x140>(v);
    const int iv = __builtin_bit_cast(int, v);
    const float a = __builtin_bit_cast(float, __builtin_amdgcn_readlane(iv, 0)), b = __builtin_bit_cast(float, __builtin_amdgcn_readlane(iv, 16));
    const float c = __builtin_bit_cast(float, __builtin_amdgcn_readlane(iv, 32)), d = __builtin_bit_cast(float, __builtin_amdgcn_readlane(iv, 48));
    return (a + b) + (c + d);
}
DEV float rsqrt_(float x) { return __builtin_amdgcn_rsqf(x); }
DEV void st_bf4(bf16_t* p, f32x4 v) { u32x2 w = {cvtpk(v[0], v[1]), cvtpk(v[2], v[3])}; *(u32x2*)p = w; }
DEV unsigned pk_fp8x4(float a, float b, float c, float d) {
    int w = __builtin_amdgcn_cvt_pk_fp8_f32(a, b, 0, false); w = __builtin_amdgcn_cvt_pk_fp8_f32(c, d, w, true); return (unsigned)w; }
DEV float fast_exp2(float x) { return __builtin_amdgcn_exp2f(x); }
DEV float fast_rcp(float x) { return __builtin_amdgcn_rcpf(x); }
DEV float sigmoidf_(float g) { return fast_rcp(1.f + fast_exp2(-1.4426950408889634f * g)); }
#define LDS_WAIT() asm volatile("s_waitcnt lgkmcnt(0)" ::: "memory")
#define VM_WAIT() asm volatile("s_waitcnt vmcnt(0)" ::: "memory")

#define XB_TMO      128
#define XB_XCNT(j)  (256  + 64 * (j))
#define XB_XSUB(j)  (1280 + 64 * (j))
#define XB_XGEN(j)  (2304 + 64 * (j))
#define XB_TOP      3328
#define XB_TOPGEN   3392
#define XCD_BAR_WORDS 3456
#define XB_SPIN_CAP (1u << 22)
DEV unsigned xb_ld(unsigned* p)              { return __hip_atomic_load(p, __ATOMIC_RELAXED, __HIP_MEMORY_SCOPE_AGENT); }
DEV unsigned xb_add(unsigned* p, unsigned v) { return __hip_atomic_fetch_add(p, v, __ATOMIC_RELAXED, __HIP_MEMORY_SCOPE_AGENT); }
DEV unsigned xb_xcc_id() { return (unsigned)__builtin_amdgcn_s_getreg((3 << 11) | 20) & 0xFu; }
#define XB_SPIN(cond, bar) do { unsigned _sp = 0; while (cond) { __builtin_amdgcn_s_sleep(1); \
    if ((++_sp & 255u) == 0u) { if (xb_ld(&(bar)[XB_TMO])) break; if (_sp > XB_SPIN_CAP) { atomicAdd(&(bar)[XB_TMO], 1u); break; } } } } while (0)
struct XcdBarrier { unsigned* bar; unsigned x; volatile LAS unsigned* st; };
DEV XcdBarrier xcd_barrier_post(unsigned* bar, volatile LAS unsigned* st) {
    XcdBarrier b; b.bar = bar; b.x = xb_xcc_id(); b.st = st;
    if (threadIdx.x == 0) (void)xb_add(&bar[XB_XCNT(b.x)], 1u);
    return b;
}
DEV void xcd_barrier_complete(unsigned* bar, unsigned x, unsigned& nloc, unsigned& nx) {
    const unsigned G = gridDim.x * gridDim.y * gridDim.z;
    unsigned sum, cnt, mine, sp = 0u;
    for (;;) {
        sum = 0u; cnt = 0u; mine = 0u;
#pragma unroll
        for (unsigned j = 0; j < 16; ++j) { const unsigned c = xb_ld(&bar[XB_XCNT(j)]); sum += c; cnt += (c > 0u) ? 1u : 0u; mine = (j == x) ? c : mine; }
        if (sum == G) break;
        __builtin_amdgcn_s_sleep(1);
        if ((++sp & 255u) == 0u) { if (xb_ld(&bar[XB_TMO])) break; if (sp > XB_SPIN_CAP) { atomicAdd(&bar[XB_TMO], 1u); break; } }
    }
    nloc = mine > 0u ? mine : 1u; nx = cnt > 0u ? cnt : 1u;
}
DEV void xcd_barrier(const XcdBarrier& b) {
    asm volatile("s_waitcnt vmcnt(0)" ::: "memory");
    __syncthreads();
    if (threadIdx.x == 0) {
        unsigned* bar = b.bar;
        __builtin_amdgcn_s_waitcnt(0);
        unsigned nloc = b.st[0], nx = b.st[1];
        if (nloc == 0u) { xcd_barrier_complete(bar, b.x, nloc, nx); b.st[0] = nloc; b.st[1] = nx; }
        const unsigned old = xb_add(&bar[XB_XSUB(b.x)], 1u);
        const unsigned gen = old / nloc;
        if (old + 1u == (gen + 1u) * nloc) {
            __builtin_amdgcn_fence(__ATOMIC_RELEASE, "agent");
            asm volatile("s_waitcnt vmcnt(0)" ::: "memory");
            const unsigned og = xb_add(&bar[XB_TOP], 1u);
            const unsigned tg = og / nx;
            if (og + 1u == (tg + 1u) * nx) xb_add(&bar[XB_TOPGEN], 1u);
            else XB_SPIN(xb_ld(&bar[XB_TOPGEN]) == tg, bar);
            __builtin_amdgcn_fence(__ATOMIC_ACQUIRE, "agent");
            xb_add(&bar[XB_XGEN(b.x)], 1u);
            asm volatile("s_waitcnt vmcnt(0)" ::: "memory");
        } else {
            XB_SPIN(xb_ld(&bar[XB_XGEN(b.x)]) == gen, bar);
            __builtin_amdgcn_fence(__ATOMIC_ACQUIRE, "agent");
            asm volatile("s_waitcnt vmcnt(0)" ::: "memory");
        }
    }
    __syncthreads();
}

struct Args { const float* in[27]; float* out; unsigned char* ws; int ph_lo, ph_hi; };
struct Ctx {
    const float* const* in; float* out; unsigned char* ws; unsigned char* lds;
    int tid, lane, wid, vcu, G;
};
enum { I_X = 0, I_META, I_LNIN_G, I_LNIN_B, I_WIN, I_CONVW, I_CONVB, I_CLN_G, I_CLN_B, I_QNG, I_WUQ, I_KVNG, I_WUKV, I_COUT_G, I_AOUT_G, I_WO,
       I_LN1G, I_LN1B, I_WRG, I_BRG, I_WRE, I_BRE, I_WGATE, I_WUP, I_WDOWN, I_LN2G, I_LN2B };

DEV int nmap(int mode, int n) {
    if (mode == 1) { if (n < 512) return ((n >> 4) << 5) + (n & 15); if (n < 1024) return (((n - 512) >> 4) << 5) + 16 + (n & 15); return n; }
    if (mode == 2) return ((n >> 4) << 5) + (n & 15);
    if (mode == 3) return ((n >> 4) << 5) + 16 + (n & 15);
    return n;
}
DEV void p0_transpose_item(const float* __restrict__ W, int N, int k0, int n0, const float* __restrict__ kscale, bf16_t* WT, int ldt, int kout0, int mode,
                           float* scr, int lane) {
#pragma unroll 8
    for (int i = 0; i < 32; ++i) {
        const int kk = 2 * i + (lane >> 5);
        float v = __builtin_nontemporal_load(&W[(size_t)(k0 + kk) * N + n0 + (lane & 31)]);
        if (kscale) v *= kscale[k0 + kk];
        scr[kk * 33 + (lane & 31)] = v;
    }
    LDS_WAIT(); asm volatile("" ::: "memory");
    const int c = lane & 7;
#pragma unroll
    for (int j = 0; j < 4; ++j) {
        const int n = (lane >> 3) + 8 * j; const float* s = scr + (8 * c) * 33 + n;
        u32x4 o; o.x = cvtpk(s[0 * 33], s[1 * 33]); o.y = cvtpk(s[2 * 33], s[3 * 33]); o.z = cvtpk(s[4 * 33], s[5 * 33]); o.w = cvtpk(s[6 * 33], s[7 * 33]);
        *(u32x4*)(WT + (size_t)nmap(mode, n0 + n) * ldt + kout0 + 8 * c) = o;
    }
    LDS_WAIT(); asm volatile("" ::: "memory");
}
DEV void p0_transpose_item_f8(const float* __restrict__ W, int N, int k0, int n0, float scale, unsigned char* W8, int ldt, int kout0, int mode, float* scr, int lane) {
#pragma unroll 8
    for (int i = 0; i < 32; ++i) { const int kk = 2 * i + (lane >> 5); scr[kk * 33 + (lane & 31)] = W[(size_t)(k0 + kk) * N + n0 + (lane & 31)] * scale; }
    LDS_WAIT(); asm volatile("" ::: "memory");
    const int c = lane & 7;
#pragma unroll
    for (int j = 0; j < 4; ++j) {
        const int n = (lane >> 3) + 8 * j; const float* sp = scr + (8 * c) * 33 + n;
        u32x2 o; o.x = pk_fp8x4(sp[0 * 33], sp[1 * 33], sp[2 * 33], sp[3 * 33]); o.y = pk_fp8x4(sp[4 * 33], sp[5 * 33], sp[6 * 33], sp[7 * 33]);
        *(u32x2*)(W8 + (size_t)nmap(mode, n0 + n) * ldt + kout0 + 8 * c) = o;
    }
    LDS_WAIT(); asm volatile("" ::: "memory");
}
template <int N> DEV void wave_sum_n(float (&v)[N]) {
#pragma unroll
    for (int i = 0; i < N; ++i) v[i] = wave_sum(v[i]);
}
template <int NR, bool F8 = false, bool BFIN = false, bool NOBF = false> DEV void ln_rows_bf16(const float* const (&xrow)[NR], const float* g, const float* bta, bf16_t* const (&orow)[NR], unsigned char* const (&ldsrow)[NR], int lane, unsigned char* const* f8row = nullptr, float* const* strow = nullptr) {
    f32x4 v[NR][4]; float s[NR];
#pragma unroll
    for (int r = 0; r < NR; ++r)
#pragma unroll
        for (int j = 0; j < 4; ++j) {
            if (BFIN) { const u32x2 w = ((const u32x2*)xrow[r])[64 * j + lane]; v[r][j] = (f32x4){bflo(w.x), bfhi(w.x), bflo(w.y), bfhi(w.y)}; }
            else v[r][j] = __builtin_nontemporal_load(&((const f32x4*)xrow[r])[64 * j + lane]); }
#pragma unroll
    for (int r = 0; r < NR; ++r) { s[r] = 0.f;
#pragma unroll
        for (int j = 0; j < 4; ++j) s[r] += (v[r][j].x + v[r][j].y) + (v[r][j].z + v[r][j].w); }
    wave_sum_n<NR>(s);
    float s2[NR];
#pragma unroll
    for (int r = 0; r < NR; ++r) { const float mean = s[r] * (1.f / 1024.f); s2[r] = 0.f;
#pragma unroll
        for (int j = 0; j < 4; ++j) { v[r][j] = v[r][j] - mean; s2[r] += (v[r][j].x * v[r][j].x + v[r][j].y * v[r][j].y) + (v[r][j].z * v[r][j].z + v[r][j].w * v[r][j].w); } }
    wave_sum_n<NR>(s2);
    if (strow) {
#pragma unroll
        for (int r = 0; r < NR; ++r) if (lane == 0) { strow[r][0] = s[r] * (1.f / 1024.f); strow[r][1] = rsqrt_(s2[r] * (1.f / 1024.f) + EPS); }
    }
#pragma unroll
    for (int j = 0; j < 4; ++j) {
        const f32x4 gg = ((const f32x4*)g)[64 * j + lane], bb = ((const f32x4*)bta)[64 * j + lane];
#pragma unroll
        for (int r = 0; r < NR; ++r) {
            const float rstd = rsqrt_(s2[r] * (1.f / 1024.f) + EPS);
            const f32x4 o = v[r][j] * rstd * gg + bb;
            const u32x2 w = {cvtpk(o.x, o.y), cvtpk(o.z, o.w)};
            if (!NOBF) ((u32x2*)orow[r])[64 * j + lane] = w;
            if (ldsrow[r]) ((u32x2*)ldsrow[r])[64 * j + lane] = w;
            if (F8) ((unsigned*)f8row[r])[64 * j + lane] = pk_fp8x4(o.x, o.y, o.z, o.w);
        }
    }
}
__device__ const float INVF[16] = {1.0f, 0.5623413251903491f, 0.31622776601683794f, 0.1778279410038923f, 0.1f, 0.05623413251903491f, 0.031622776601683794f,
    0.01778279410038923f, 0.01f, 0.005623413251903491f, 0.0031622776601683794f, 0.001778279410038923f, 0.001f, 0.0005623413251903491f, 0.00031622776601683794f, 0.0001778279410038923f};
DEV void sincos_d(double a, float& sn, float& cs) {
    const double TWO_PI = 6.283185307179586476925286766559;
    const double k = __builtin_rint(a / TWO_PI);
    const double r = a - k * TWO_PI;
    const double r2 = r * r;
    double st = r, ct = 1.0, ssum = r, csum = 1.0;
#pragma unroll 1
    for (int i = 1; i <= 14; ++i) {
        ct = -ct * r2 / (double)((2 * i - 1) * (2 * i));  csum += ct;
        st = -st * r2 / (double)((2 * i) * (2 * i + 1));  ssum += st;
    }
    sn = (float)ssum; cs = (float)csum;
}
DEV void ew_block(const float* __restrict__ W, int N, int k0, int n0, unsigned char* W8, int ldt, int mode, int lane) {
    const int q = lane & 15, kq = lane >> 4;
    const float* src = W + (size_t)(k0 + 16 * kq) * N + n0 + 4 * q;
    f32x4 v[16];
#pragma unroll
    for (int i = 0; i < 16; ++i) v[i] = __builtin_nontemporal_load((const f32x4*)(src + (size_t)i * N));
#pragma unroll
    for (int j = 0; j < 4; ++j) {
        u32x4 o;
        o.x = pk_fp8x4(v[0][j] * WSCALE, v[1][j] * WSCALE, v[2][j] * WSCALE, v[3][j] * WSCALE);
        o.y = pk_fp8x4(v[4][j] * WSCALE, v[5][j] * WSCALE, v[6][j] * WSCALE, v[7][j] * WSCALE);
        o.z = pk_fp8x4(v[8][j] * WSCALE, v[9][j] * WSCALE, v[10][j] * WSCALE, v[11][j] * WSCALE);
        o.w = pk_fp8x4(v[12][j] * WSCALE, v[13][j] * WSCALE, v[14][j] * WSCALE, v[15][j] * WSCALE);
        *(u32x4*)(W8 + (size_t)nmap(mode, n0 + 4 * q + j) * ldt + k0 + 16 * kq) = o;
    }
}
DEV void expert_weight_item(const Ctx& c, int r, float*  ) {
    unsigned char* Wgu8 = c.ws + WS_WGU; unsigned char* Wd8 = c.ws + WS_WD;
    if (r < 2048) { const int e = r >> 6, qq = r & 63, kb = qq >> 2, nb = qq & 3;
        ew_block(c.in[I_WGATE] + (size_t)e * D * DE, DE, 64 * kb, 64 * nb, Wgu8 + (size_t)e * 512 * 1024, 1024, 2, c.lane); return; } r -= 2048;
    if (r < 2048) { const int e = r >> 6, qq = r & 63, kb = qq >> 2, nb = qq & 3;
        ew_block(c.in[I_WUP] + (size_t)e * D * DE, DE, 64 * kb, 64 * nb, Wgu8 + (size_t)e * 512 * 1024, 1024, 3, c.lane); return; } r -= 2048;
    { const int e = r >> 6, qq = r & 63, kb = qq >> 4, nb = qq & 15;
        ew_block(c.in[I_WDOWN] + (size_t)e * DE * D, D, 64 * kb, 64 * nb, Wd8 + (size_t)e * 1024 * 256, 256, 0, c.lane); }
}
DEV void phase0(const Ctx& c) {
    float* scr = (float*)(c.lds + c.wid * 8448);
    const int gw = c.vcu * 4 + c.wid, NGW = c.G * 4;
    constexpr int I_IN = 16 * 53, I_UQ = 6 * 24, I_UKV = 4 * 32, I_O = 16 * 32;
    bf16_t* WinT = (bf16_t*)(c.ws + WS_WIN); bf16_t* WuqT = (bf16_t*)(c.ws + WS_WUQ); bf16_t* WukvT = (bf16_t*)(c.ws + WS_WUKV);
    bf16_t* WoT = (bf16_t*)(c.ws + WS_WO);
    constexpr int NITEMS0 = I_IN + I_UQ + I_UKV + I_O;
    for (int it = gw; it < NITEMS0; it += NGW) {
        int r = it;
        if (r < I_IN) { const int kb = r / 53, nb = r % 53; p0_transpose_item(c.in[I_WIN], NIN, 64 * kb, 32 * nb, nullptr, WinT, 1024, 64 * kb, 1, scr, c.lane); continue; } r -= I_IN;
        if (r < I_UQ) { const int kb = r / 24, nb = r % 24; p0_transpose_item(c.in[I_WUQ], NQ, 64 * kb, 32 * nb, c.in[I_QNG], WuqT, QL, 64 * kb, 0, scr, c.lane); continue; } r -= I_UQ;
        if (r < I_UKV) { const int kb = r / 32, nb = r % 32; p0_transpose_item(c.in[I_WUKV], NKV, 64 * kb, 32 * nb, c.in[I_KVNG], WukvT, KVL, 64 * kb, 0, scr, c.lane); continue; } r -= I_UKV;
        { const int kb = r / 32, nb = r % 32;
            if (kb < 8) p0_transpose_item(c.in[I_WO], D, 64 * kb, 32 * nb, nullptr, WoT, 1024, 64 * kb + 512, 0, scr, c.lane);
            else        p0_transpose_item(c.in[I_WO], D, 64 * kb, 32 * nb, c.in[I_AOUT_G] - 512, WoT, 1024, 64 * kb - 512, 0, scr, c.lane); }
    }
    const int gt = c.vcu * 256 + c.tid, NGT = c.G * 256;
    bf16_t* WrT = (bf16_t*)(c.ws + WS_WR);
    for (int i = gt; i < 48 * 1024; i += NGT) {
        const int n = i >> 10, k = i & 1023; float v = 0.f;
        if (n < 4) v = c.in[I_WRG][k * 4 + n]; else if (n < 36) v = c.in[I_WRE][k * 32 + (n - 4)];
        WrT[i] = (bf16_t)(cvtpk(v, 0.f) & 0xffffu);
    }
    float* rc = (float*)(c.ws + WS_ROPE); float* rs = rc + L * 16;
    for (int i = gt; i < L * 16; i += NGT) {
        const int p = i >> 4, f = i & 15; const float ang = (float)p * INVF[f];
        float sn, cs; sincos_d((double)ang, sn, cs); rc[i] = cs; rs[i] = sn;
    }
    bf16_t* h0 = (bf16_t*)(c.ws + WS_H0);
    for (int t = gw; t < T; t += 2 * NGW) {
        const float* src[2]; bf16_t* dst[2]; unsigned char* ldsn[2] = {nullptr, nullptr};
#pragma unroll
        for (int r = 0; r < 2; ++r) { int tt = t + r * NGW; if (tt >= T) tt = t;
            const int b = tt / L, p = tt - b * L;
            src[r] = (p < NMETA) ? c.in[I_META] + (size_t)p * D : c.in[I_X] + ((size_t)b * SEQ + (p - NMETA)) * D;
            dst[r] = h0 + (size_t)tt * D; }
        ln_rows_bf16<2>(src, c.in[I_LNIN_G], c.in[I_LNIN_B], dst, ldsn, c.lane);
    }
}

struct StageGeo { int r[4]; int c; };
DEV StageGeo stage_geo(int tid) {
    const int lane = tid & 63, wid = tid >> 6; StageGeo g;
    const int rl = lane >> 2, cl = ((lane & 3) * 8) ^ ((lane >> 5) << 4);
#pragma unroll
    for (int i = 0; i < 4; ++i) g.r[i] = (((wid + 4 * i) >> 1) << 4) + rl;
    g.c = ((wid & 1) << 5) + cl;
    return g;
}
template <bool SSQ, bool FP8 = false>
DEV void gemm_mainloop(f32x4 (&acc)[4][4], const bf16_t* ap0, const bf16_t* ap1, const bf16_t* ap2, const bf16_t* ap3,
                       const bf16_t* bp0, const bf16_t* bp1, const bf16_t* bp2, const bf16_t* bp3,
                       int nk, unsigned char* lds, int ssq_steps, float ssq_inv_dim, bool skip_wc1 = false) {
    const int tid = threadIdx.x, lane = tid & 63, wid = tid >> 6, wr = wid >> 1, wc = wid & 1, fr = lane & 15, fq = lane >> 4;
    const int xs = (fr >> 1) & 7;
    const int lo = ((fr * 64 + fq * 16) ^ ((fr >> 3) << 5));
    const int lo0 = lo, lo1 = lo + 1024;
    const int a_off = wr * 8192, b_off = 16384 + wc * 8192;
    const int dst = tid * 16;
#pragma unroll
    for (int m = 0; m < 4; ++m)
#pragma unroll
        for (int n = 0; n < 4; ++n) acc[m][n] = (f32x4){0.f, 0.f, 0.f, 0.f};
    __syncthreads();
#define GLDS(src, off) __builtin_amdgcn_global_load_lds((const unsigned*)(src), (unsigned LAS*)(lds + (off)), 16, 0, 0)
#define STAGE(kt, b) do { const int _k = (kt) * 64; \
        GLDS(ap0 + _k, (b) * 32768 + dst);          GLDS(ap1 + _k, (b) * 32768 + dst + 4096); \
        GLDS(ap2 + _k, (b) * 32768 + dst + 8192);   GLDS(ap3 + _k, (b) * 32768 + dst + 12288); \
        GLDS(bp0 + _k, (b) * 32768 + 16384 + dst);  GLDS(bp1 + _k, (b) * 32768 + 16384 + dst + 4096); \
        GLDS(bp2 + _k, (b) * 32768 + 16384 + dst + 8192); GLDS(bp3 + _k, (b) * 32768 + 16384 + dst + 12288); } while (0)
    STAGE(0, 0);
    for (int kt = 0; kt < nk; ++kt) {
        VM_WAIT();
        __syncthreads();
        const int b = kt & 1;
        if (SSQ && kt == ssq_steps) {
            const float* rsl = (const float*)(lds + RS_OFF);
#pragma unroll
            for (int m = 0; m < 4; ++m) { const float r = rsl[wr * 64 + m * 16 + fr];
#pragma unroll
                for (int n = 0; n < 4; ++n) acc[m][n] = acc[m][n] * r; }
        }
        if (kt + 1 < nk) { if (b) STAGE(kt + 1, 0); else STAGE(kt + 1, 1); }
        const unsigned char* base = lds + b * 32768;
        if (skip_wc1 && wc == 1) {
        } else if (FP8) {
            const int cb0 = fq * 32, cb1 = fq * 32 + 16;
            const int q0 = (cb0 >> 6) * 1024 + ((fr * 64 + (cb0 & 63)) ^ ((fr >> 3) << 5)), q1 = (cb1 >> 6) * 1024 + ((fr * 64 + (cb1 & 63)) ^ ((fr >> 3) << 5));
            v8i ax[4], bx[4];
#pragma unroll
            for (int m = 0; m < 4; ++m) { const u32x4 c0 = *(const u32x4*)(base + a_off + m * 2048 + q0), c1 = *(const u32x4*)(base + a_off + m * 2048 + q1);
                ax[m] = (v8i){(int)c0.x, (int)c0.y, (int)c0.z, (int)c0.w, (int)c1.x, (int)c1.y, (int)c1.z, (int)c1.w}; }
#pragma unroll
            for (int n = 0; n < 4; ++n) { const u32x4 c0 = *(const u32x4*)(base + b_off + n * 2048 + q0), c1 = *(const u32x4*)(base + b_off + n * 2048 + q1);
                bx[n] = (v8i){(int)c0.x, (int)c0.y, (int)c0.z, (int)c0.w, (int)c1.x, (int)c1.y, (int)c1.z, (int)c1.w}; }
#pragma unroll
            for (int m = 0; m < 4; ++m)
#pragma unroll
                for (int n = 0; n < 4; ++n) acc[m][n] = __builtin_amdgcn_mfma_scale_f32_16x16x128_f8f6f4(bx[n], ax[m], acc[m][n], 0, 0, 0, 0x7F7F7F7F, 0, 0x7F7F7F7F);
        } else {
#pragma unroll
        for (int ks = 0; ks < 2; ++ks) {
            bf16x8 af[4], bf[4];
#pragma unroll
            for (int m = 0; m < 4; ++m) af[m] = *(const bf16x8*)(base + a_off + m * 2048 + (ks ? lo1 : lo0));
#pragma unroll
            for (int n = 0; n < 4; ++n) bf[n] = *(const bf16x8*)(base + b_off + n * 2048 + (ks ? lo1 : lo0));
#pragma unroll
            for (int m = 0; m < 4; ++m)
#pragma unroll
                for (int n = 0; n < 4; ++n) acc[m][n] = __builtin_amdgcn_mfma_f32_16x16x32_bf16(bf[n], af[m], acc[m][n], 0, 0, 0);
        }
        }
    }
    if (SSQ && ssq_steps == nk) {
        __syncthreads();
        const float* rsl = (const float*)(lds + RS_OFF);
#pragma unroll
        for (int m = 0; m < 4; ++m) { const float r = rsl[wr * 64 + m * 16 + fr];
#pragma unroll
            for (int n = 0; n < 4; ++n) acc[m][n] = acc[m][n] * r; }
    }
#undef STAGE
#undef GLDS
}

DEV void phase1(const Ctx& c) {
    const bf16_t* h0 = (const bf16_t*)(c.ws + WS_H0); const bf16_t* WinT = (const bf16_t*)(c.ws + WS_WIN);
    bf16_t* U = (bf16_t*)(c.ws + WS_U); bf16_t* CQ = (bf16_t*)(c.ws + WS_CQ); bf16_t* CKV = (bf16_t*)(c.ws + WS_CKV); bf16_t* KR = (bf16_t*)(c.ws + WS_KR);
    const float* rc = (const float*)(c.ws + WS_ROPE); const float* rs = rc + L * 16;
    const StageGeo g = stage_geo(c.tid);
    const int lane = c.lane, wr = c.wid >> 1, wc = c.wid & 1, fr = lane & 15, fq = lane >> 4;
    constexpr int NT = 14, NU = (T / 128) * NT;
    for (int u = c.vcu; u < NU; u += c.G) {
        const int mt = u / NT, nt = u - mt * NT;
        const bf16_t* A = h0 + (size_t)(mt * 128) * D + g.c; const bf16_t* B = WinT + (size_t)(nt * 128) * D + g.c;
        f32x4 acc[4][4];
        gemm_mainloop<false>(acc, A + (size_t)g.r[0] * D, A + (size_t)g.r[1] * D, A + (size_t)g.r[2] * D, A + (size_t)g.r[3] * D,
                             B + (size_t)g.r[0] * D, B + (size_t)g.r[1] * D, B + (size_t)g.r[2] * D, B + (size_t)g.r[3] * D, 16, c.lds, 0, 0.f, nt == 13);
        const int row0 = mt * 128 + wr * 64 + fr;
        if (nt < 8) {
#pragma unroll
            for (int m = 0; m < 4; ++m) { const size_t row = row0 + m * 16;
#pragma unroll
                for (int i = 0; i < 2; ++i) {
                    f32x4 a = acc[m][2 * i], gt = acc[m][2 * i + 1], o;
#pragma unroll
                    for (int j = 0; j < 4; ++j) o[j] = a[j] * sigmoidf_(gt[j]);
                    st_bf4(U + row * CC + nt * 64 + wc * 32 + i * 16 + fq * 4, o);
                } }
        } else if (nt < 13) {
            const bool isq = nt < 11;
            bf16_t* dstb = isq ? CQ + (nt - 8) * 128 + wc * 64 + fq * 4 : CKV + (nt - 11) * 128 + wc * 64 + fq * 4;
            const int ldd = isq ? QL : KVL;
            float* ssb = isq ? (float*)(c.ws + WS_SSQ_CQ) + (nt - 8) * 2 + wc : (float*)(c.ws + WS_SSQ_CKV) + (nt - 11) * 2 + wc;
            const int lds_ = isq ? 8 : 4;
#pragma unroll
            for (int m = 0; m < 4; ++m) { const size_t row = row0 + m * 16; float sq = 0.f;
#pragma unroll
                for (int n = 0; n < 4; ++n) { st_bf4(dstb + row * ldd + n * 16, acc[m][n]);
                    sq += (acc[m][n][0] * acc[m][n][0] + acc[m][n][1] * acc[m][n][1]) + (acc[m][n][2] * acc[m][n][2] + acc[m][n][3] * acc[m][n][3]); }
                sq += __shfl_xor(sq, 16); sq += __shfl_xor(sq, 32);
                if (fq == 0) ssb[row * lds_] = sq; }
        } else if (wc == 0) {
#pragma unroll
            for (int m = 0; m < 4; ++m) { const int row = row0 + m * 16; const int p = row % L;
                const f32x4 cs = *(const f32x4*)(rc + p * 16 + fq * 4), sn = *(const f32x4*)(rs + p * 16 + fq * 4);
                const f32x4 x1 = acc[m][0], x2 = acc[m][1];
                st_bf4(KR + (size_t)row * 32 + fq * 4, x1 * cs - x2 * sn);
                st_bf4(KR + (size_t)row * 32 + 16 + fq * 4, x1 * sn + x2 * cs); }
        }
    }
}

DEV void conv_unit(const Ctx& c, int b, int j) {
    const bf16_t* U = (const bf16_t*)(c.ws + WS_U);
    bf16_t* MG = (bf16_t*)(c.ws + WS_MG);
    const float* cw = c.in[I_CONVW]; const float* cb = c.in[I_CONVB];
    const int p0 = NMETA + j * 32;
    float* ytile = (float*)c.lds;
    __syncthreads();
#pragma unroll 1
    for (int pass = 0; pass < 2; ++pass) {
        const int ch = c.tid + 256 * pass;
        float win[62]; unsigned raw[62];
        const bf16_t* ub = U + (size_t)b * L * CC + ch;
#pragma unroll
        for (int rep = 0; rep < CONV_REPA; ++rep) {
        asm volatile("" : "+v"(ub) :: "memory");
#pragma unroll
        for (int i = 0; i < 62; ++i) { const int p = p0 - 30 + i; const int pc = p < 0 ? 0 : (p >= L ? L - 1 : p); raw[i] = ub[(size_t)pc * CC]; }
        if (rep + 1 < CONV_REPA) {
#pragma unroll
            for (int i = 0; i < 62; ++i) asm volatile("" :: "v"(raw[i]));
        }
        }
        float w[31];
#pragma unroll
        for (int k = 0; k < 31; ++k) w[k] = cw[k * CC + ch];
        float bias = cb[ch];
        __builtin_amdgcn_sched_barrier(0);
#pragma unroll
        for (int i = 0; i < 62; ++i) { const int p = p0 - 30 + i; win[i] = (p >= 0 && p < L) ? __uint_as_float(raw[i] << 16) : 0.f; }
#pragma unroll
        for (int rep = 0; rep < CONV_REPB; ++rep) {
        asm volatile("" : "+v"(bias) :: "memory");
#pragma unroll
        for (int tt = 0; tt < 32; ++tt) {
            float a0 = bias;
#pragma unroll
            for (int k = 0; k < 31; ++k) a0 += w[k] * win[tt + k];
            ytile[tt * 512 + ch] = a0;
        }
        }
    }
    __syncthreads();
    const float* g1 = c.in[I_CLN_G]; const float* b1 = c.in[I_CLN_B]; const float* g2 = c.in[I_COUT_G];
    float G1[8], B1[8], G2[8];
    { const f32x4 a = *(const f32x4*)(g1 + c.lane * 8), bq = *(const f32x4*)(g1 + c.lane * 8 + 4); G1[0]=a.x;G1[1]=a.y;G1[2]=a.z;G1[3]=a.w;G1[4]=bq.x;G1[5]=bq.y;G1[6]=bq.z;G1[7]=bq.w; }
    { const f32x4 a = *(const f32x4*)(b1 + c.lane * 8), bq = *(const f32x4*)(b1 + c.lane * 8 + 4); B1[0]=a.x;B1[1]=a.y;B1[2]=a.z;B1[3]=a.w;B1[4]=bq.x;B1[5]=bq.y;B1[6]=bq.z;B1[7]=bq.w; }
    { const f32x4 a = *(const f32x4*)(g2 + c.lane * 8), bq = *(const f32x4*)(g2 + c.lane * 8 + 4); G2[0]=a.x;G2[1]=a.y;G2[2]=a.z;G2[3]=a.w;G2[4]=bq.x;G2[5]=bq.y;G2[6]=bq.z;G2[7]=bq.w; }
#pragma unroll
    for (int rep = 0; rep < CONV_REPC; ++rep) {
    asm volatile("" : "+v"(ytile) :: "memory");
    float v[8][8]; float st[8];
#pragma unroll
    for (int i = 0; i < 8; ++i) { const int tt = c.wid * 8 + i;
        const f32x4 ya = *(const f32x4*)(ytile + tt * 512 + c.lane * 8), yb = *(const f32x4*)(ytile + tt * 512 + c.lane * 8 + 4);
        v[i][0]=ya.x;v[i][1]=ya.y;v[i][2]=ya.z;v[i][3]=ya.w;v[i][4]=yb.x;v[i][5]=yb.y;v[i][6]=yb.z;v[i][7]=yb.w;
        st[i] = ((v[i][0] + v[i][1]) + (v[i][2] + v[i][3])) + ((v[i][4] + v[i][5]) + (v[i][6] + v[i][7])); }
    wave_sum_n<8>(st);
#pragma unroll
    for (int i = 0; i < 8; ++i) { const float mean = st[i] * (1.f / 512.f); float a = 0.f;
#pragma unroll
        for (int q = 0; q < 8; ++q) { v[i][q] -= mean; a += v[i][q] * v[i][q]; }
        st[i] = a; }
    wave_sum_n<8>(st);
#pragma unroll
    for (int i = 0; i < 8; ++i) { const float rstd = rsqrt_(st[i] * (1.f / 512.f) + EPS); float a = 0.f;
#pragma unroll
        for (int q = 0; q < 8; ++q) { const float x = v[i][q] * rstd * G1[q] + B1[q]; const float y = x * sigmoidf_(x); v[i][q] = y; a += y * y; }
        st[i] = a; }
    wave_sum_n<8>(st);
#pragma unroll
    for (int i = 0; i < 8; ++i) {
        const int p = p0 + c.wid * 8 + i;
        {
            const float r2 = rsqrt_(st[i] * (1.f / 512.f) + EPS);
            u32x4 o;
            o.x = cvtpk(v[i][0] * r2 * G2[0], v[i][1] * r2 * G2[1]); o.y = cvtpk(v[i][2] * r2 * G2[2], v[i][3] * r2 * G2[3]);
            o.z = cvtpk(v[i][4] * r2 * G2[4], v[i][5] * r2 * G2[5]); o.w = cvtpk(v[i][6] * r2 * G2[6], v[i][7] * r2 * G2[7]);
            const size_t tok = (size_t)b * SEQ + (p - NMETA);
            bf16_t* dstp = (p >= NMETA && p < L) ? MG + tok * D + 512 + c.lane * 8 : (bf16_t*)(c.ws + WS_DUMMY) + c.lane * 8;
            *(u32x4*)dstp = o;
        }
    }
    }
}
DEV void rope4(f32x4& x1, f32x4& x2, const float* rc, const float* rs, int p, int fq) {
    const f32x4 cs = *(const f32x4*)(rc + p * 16 + fq * 4), sn = *(const f32x4*)(rs + p * 16 + fq * 4);
    const f32x4 a = x1 * cs - x2 * sn, bb = x1 * sn + x2 * cs; x1 = a; x2 = bb;
}
DEV void phase2(const Ctx& c) {
    const bf16_t* CQ = (const bf16_t*)(c.ws + WS_CQ); const bf16_t* CKV = (const bf16_t*)(c.ws + WS_CKV);
    const bf16_t* WuqT = (const bf16_t*)(c.ws + WS_WUQ); const bf16_t* WukvT = (const bf16_t*)(c.ws + WS_WUKV);
    bf16_t* Q = (bf16_t*)(c.ws + WS_Q); bf16_t* KV = (bf16_t*)(c.ws + WS_KV);
    const float* rc = (const float*)(c.ws + WS_ROPE); const float* rs = rc + L * 16;
    const StageGeo g = stage_geo(c.tid);
    const int lane = c.lane, wr = c.wid >> 1, wc = c.wid & 1, fr = lane & 15, fq = lane >> 4;
    constexpr int NUC = NB * 64, NUQ = (TR / 128) * 6, NUKV = (TR / 128) * 8 + 8, NU = NUC + NUQ + NUKV;
    const int li = c.vcu & 63, rev = ((li >> 5) ^ li) & 1;
    const int nmine = (NU - c.vcu + c.G - 1) / c.G;
    for (int it = 0; it < nmine; ++it) {
        const int u = c.vcu + (rev ? (nmine - 1 - it) : it) * c.G;
        if (u < NUC) {
            conv_unit(c, u >> 6, u & 63);
        } else if (u < NUC + NUQ) {
            const int v = u - NUC, mt = v / 6, nt = v - mt * 6;
            const size_t t0 = (size_t)(mt >> 4) * L + NMETA + (mt & 15) * 128;
            const bf16_t* A = CQ + t0 * QL + g.c; const bf16_t* B = WuqT + (size_t)(nt * 128) * QL + g.c;
            f32x4 acc[4][4];
            __syncthreads();
            if (c.tid < 128) { const float* pp = (const float*)(c.ws + WS_SSQ_CQ) + (t0 + c.tid) * 8; const f32x4 p4 = *(const f32x4*)pp; const float2 p2 = *(const float2*)(pp + 4);
                ((float*)(c.lds + RS_OFF))[c.tid] = rsqrt_((((p4.x + p4.y) + (p4.z + p4.w)) + (p2.x + p2.y)) * (1.f / 384.f) + EPS); }
            gemm_mainloop<true>(acc, A + (size_t)g.r[0] * QL, A + (size_t)g.r[1] * QL, A + (size_t)g.r[2] * QL, A + (size_t)g.r[3] * QL,
                                B + (size_t)g.r[0] * QL, B + (size_t)g.r[1] * QL, B + (size_t)g.r[2] * QL, B + (size_t)g.r[3] * QL, 6, c.lds, 6, 1.f / 384.f);
            const int p0 = NMETA + (mt & 15) * 128 + wr * 64 + fr;
            const int t16 = (nt * 8 + wc * 4) % 6;
#pragma unroll
            for (int m = 0; m < 4; ++m) { const size_t row = t0 + wr * 64 + m * 16 + fr; const int p = p0 + m * 16;
#pragma unroll
                for (int n = 0; n < 4; ++n) acc[m][n] = acc[m][n] * QSCALE;
                if (t16 == 4) rope4(acc[m][0], acc[m][1], rc, rs, p, fq);
                if (t16 == 2) rope4(acc[m][2], acc[m][3], rc, rs, p, fq);
#pragma unroll
                for (int n = 0; n < 4; ++n) st_bf4(Q + row * NQ + nt * 128 + wc * 64 + n * 16 + fq * 4, acc[m][n]); }
        } else {
            const int v = u - NUC - NUQ; const bool meta = v >= (TR / 128) * 8;
            const int mt = meta ? 0 : v >> 3, nt = meta ? v - (TR / 128) * 8 : v & 7;
            const size_t t0 = meta ? 0 : (size_t)(mt >> 4) * L + NMETA + (mt & 15) * 128;
            const int rmask = meta ? 15 : 127;
            const bf16_t* A = CKV + t0 * KVL + g.c; const bf16_t* B = WukvT + (size_t)(nt * 128) * KVL + g.c;
            f32x4 acc[4][4];
            __syncthreads();
            if (c.tid < 128) { const f32x4 p4 = *(const f32x4*)((const float*)(c.ws + WS_SSQ_CKV) + (t0 + (c.tid & rmask)) * 4);
                ((float*)(c.lds + RS_OFF))[c.tid] = rsqrt_(((p4.x + p4.y) + (p4.z + p4.w)) * (1.f / 256.f) + EPS); }
            gemm_mainloop<true>(acc, A + (size_t)(g.r[0] & rmask) * KVL, A + (size_t)(g.r[1] & rmask) * KVL, A + (size_t)(g.r[2] & rmask) * KVL, A + (size_t)(g.r[3] & rmask) * KVL,
                                B + (size_t)g.r[0] * KVL, B + (size_t)g.r[1] * KVL, B + (size_t)g.r[2] * KVL, B + (size_t)g.r[3] * KVL, 4, c.lds, 4, 1.f / 256.f);
            if (!meta) {
#pragma unroll
                for (int m = 0; m < 4; ++m) { const size_t row = t0 + wr * 64 + m * 16 + fr;
#pragma unroll
                    for (int n = 0; n < 4; ++n) st_bf4(KV + row * NKV + nt * 128 + wc * 64 + n * 16 + fq * 4, acc[m][n]); }
            } else if (wr == 0) {
#pragma unroll 1
                for (int bb = 0; bb < NB; ++bb) {
#pragma unroll
                    for (int n = 0; n < 4; ++n) st_bf4(KV + ((size_t)bb * L + fr) * NKV + nt * 128 + wc * 64 + n * 16 + fq * 4, acc[0][n]); }
            }
        }
    }
}
DEV int crow(int r, int hi) { return (r & 3) + 8 * (r >> 2) + 4 * hi; }
#define KSWZ(row, colB) ((row) * 256 + ((colB) ^ (((row) & 7) << 4)))
#define SBAR() __builtin_amdgcn_sched_barrier(0)
DEV int v_st(int k, int cc) { const int kk = (k & ~0xC) | ((k & 4) << 1) | ((k & 8) >> 1); return ((kk >> 3) * 4 + (cc >> 5)) * 512 + ((kk & 7) * 32 + (cc & 31)) * 2; }
DEV int v_rd_base(int lane) { return ((lane & 3) << 3) | (((lane >> 2) & 3) << 6) | (((lane >> 4) & 1) << 5) | (((lane >> 5) & 1) << 8); }
constexpr int v_rd_off(int d0, int ks, int half) { return d0 * 512 + ks * 4096 + half * 2048; }
template <int OFF> DEV s16x4 tr_read(int vb) { s16x4 r; asm volatile("ds_read_b64_tr_b16 %0, %1 offset:%2" : "=&v"(r) : "v"(vb), "i"(OFF) : "memory"); return r; }
template <int D0> DEV void pv_one(f32x16& od, int vb, bf16x8 pa0, bf16x8 pa1, bf16x8 pa2, bf16x8 pa3) {
    const s16x4 l0 = tr_read<v_rd_off(D0, 0, 0)>(vb), h0 = tr_read<v_rd_off(D0, 0, 1)>(vb), l1 = tr_read<v_rd_off(D0, 1, 0)>(vb), h1 = tr_read<v_rd_off(D0, 1, 1)>(vb);
    const s16x4 l2 = tr_read<v_rd_off(D0, 2, 0)>(vb), h2 = tr_read<v_rd_off(D0, 2, 1)>(vb), l3 = tr_read<v_rd_off(D0, 3, 0)>(vb), h3 = tr_read<v_rd_off(D0, 3, 1)>(vb);
    asm volatile("s_waitcnt lgkmcnt(0)" ::: "memory"); SBAR();
#define PK(Lo, Hi) (bf16x8){Lo[0], Lo[1], Lo[2], Lo[3], Hi[0], Hi[1], Hi[2], Hi[3]}
    od = __builtin_amdgcn_mfma_f32_32x32x16_bf16(pa0, PK(l0, h0), od, 0, 0, 0);
    od = __builtin_amdgcn_mfma_f32_32x32x16_bf16(pa1, PK(l1, h1), od, 0, 0, 0);
    od = __builtin_amdgcn_mfma_f32_32x32x16_bf16(pa2, PK(l2, h2), od, 0, 0, 0);
    od = __builtin_amdgcn_mfma_f32_32x32x16_bf16(pa3, PK(l3, h3), od, 0, 0, 0);
#undef PK
}
constexpr float ATT_THR = 8.f;
constexpr int AT_V = 0, AT_K = 32768, AT_WS = 65536;
DEV void attn_unit(const Ctx& c, int b, int h, int qb) {
    const bf16_t* Q = (const bf16_t*)(c.ws + WS_Q); const bf16_t* KV = (const bf16_t*)(c.ws + WS_KV); const bf16_t* KR = (const bf16_t*)(c.ws + WS_KR);
    bf16_t* MG = (bf16_t*)(c.ws + WS_MG);
    unsigned char* lds = c.lds;
    const int tid = c.tid, wid = c.wid, lane = c.lane, r32 = lane & 31, hi = lane >> 5;
    float* wsf = (float*)(lds + AT_WS) + wid * 64; float* li_l = wsf; float* al_l = wsf + 32;
    const int NT = 2 * qb + 3;
    const int my_last = 2 * qb + (wid >> 1) + 1;
    bf16x8 qr[6];
    { const size_t t = (size_t)b * L + NMETA + qb * 128 + wid * 32 + r32;
      const bf16_t* Qw = Q + t * NQ + h * DQK + hi * 8;
#pragma unroll
      for (int d0 = 0; d0 < 6; ++d0) qr[d0] = *(const bf16x8*)(Qw + d0 * 16); }
    const int srow = tid >> 2, sq = tid & 3;
    const int vst0 = v_st(srow, sq * 16), vst1 = v_st(srow, sq * 16 + 8);
    const int kst0 = KSWZ(srow, sq * 32), kst1 = KSWZ(srow, sq * 32 + 16), kst2 = KSWZ(srow, 128 + sq * 16);
    const int vb0 = (int)(uintptr_t)(lds + AT_V) + v_rd_base(lane);
    u32x4 sk0, sk1, sk2, sv0, sv1;
#define SLOAD(j) do { int pos = (j) * 64 + srow - 48; pos = pos < 0 ? 0 : pos; const size_t tk = (size_t)b * L + pos; \
        const bf16_t* kvp = KV + tk * NKV + h * 128 + sq * 16; \
        sk0 = *(const u32x4*)(kvp); sk1 = *(const u32x4*)(kvp + 8); sv0 = *(const u32x4*)(kvp + 64); sv1 = *(const u32x4*)(kvp + 72); \
        sk2 = *(const u32x4*)(KR + tk * 32 + sq * 8); } while (0)
#define SWRITE(bb) do { unsigned char* kb = lds + AT_K + (bb) * 16384; unsigned char* vbp = lds + AT_V + (bb) * 16384; \
        *(u32x4*)(kb + kst0) = sk0; *(u32x4*)(kb + kst1) = sk1; *(u32x4*)(kb + kst2) = sk2; *(u32x4*)(vbp + vst0) = sv0; *(u32x4*)(vbp + vst1) = sv1; } while (0)
    float m_reg = 0.f, l_reg = 0.f; f32x16 o[2] = {};
    __syncthreads();
    SLOAD(0); SWRITE(0); __syncthreads();
    for (int j = 0; j < NT; ++j) {
        const int bsel = j & 1;
        if (j + 1 < NT) SLOAD(j + 1);
        if (j <= my_last) {
            const unsigned char* Ks = lds + AT_K + bsel * 16384;
            f32x16 p0, p1;
            { const float nm = -m_reg;
#pragma unroll
              for (int r = 0; r < 16; ++r) { p0[r] = nm; p1[r] = nm; } }
            __builtin_amdgcn_s_setprio(1);
#pragma unroll
            for (int d0 = 0; d0 < 6; ++d0) { const int cb = (d0 * 16 + hi * 8) * 2;
                const bf16x8 k0 = *(const bf16x8*)(Ks + KSWZ(r32, cb)); const bf16x8 k1 = *(const bf16x8*)(Ks + KSWZ(32 + r32, cb));
                p0 = __builtin_amdgcn_mfma_f32_32x32x16_bf16(k0, qr[d0], p0, 0, 0, 0);
                p1 = __builtin_amdgcn_mfma_f32_32x32x16_bf16(k1, qr[d0], p1, 0, 0, 0); }
            __builtin_amdgcn_s_setprio(0);
            if (j == 0) {
#pragma unroll
                for (int r = 0; r < 16; ++r) p0[r] = -1e30f;
#pragma unroll
                for (int r = 0; r < 8; ++r) p1[r] = -1e30f;
            }
            float pmax = fmaxf(fmaxf(p0[0], p0[1]), p0[2]);
#pragma unroll
            for (int r = 3; r < 15; r += 2) pmax = fmaxf(fmaxf(pmax, p0[r]), p0[r + 1]);
            pmax = fmaxf(fmaxf(pmax, p0[15]), p1[0]);
#pragma unroll
            for (int r = 1; r < 15; r += 2) pmax = fmaxf(fmaxf(pmax, p1[r]), p1[r + 1]);
            pmax = fmaxf(pmax, p1[15]);
            { auto rr = __builtin_amdgcn_permlane32_swap(__float_as_uint(pmax), __float_as_uint(pmax), false, false);
              pmax = fmaxf(__uint_as_float(rr[0]), __uint_as_float(rr[1])); }
            float ps = 0.f;
            if (__any(pmax > ATT_THR)) {
                const float dm = fmaxf(pmax, 0.f), alpha = fast_exp2(-dm); m_reg += dm;
#pragma unroll
                for (int r = 0; r < 16; ++r) { p0[r] -= dm; p1[r] -= dm; }
                l_reg *= alpha;
                if (hi == 0) al_l[r32] = alpha;
                asm volatile("s_waitcnt lgkmcnt(0)" ::: "memory");
#pragma unroll
                for (int r = 0; r < 16; ++r) { const float a = al_l[crow(r, hi)]; o[0][r] *= a; o[1][r] *= a; }
            }
#pragma unroll
            for (int r = 0; r < 16; ++r) { p0[r] = fast_exp2(p0[r]); ps += p0[r]; }
#pragma unroll
            for (int r = 0; r < 16; ++r) { p1[r] = fast_exp2(p1[r]); ps += p1[r]; }
            { auto rr = __builtin_amdgcn_permlane32_swap(__float_as_uint(ps), __float_as_uint(ps), false, false);
              ps = __uint_as_float(rr[0]) + __uint_as_float(rr[1]); }
            l_reg += ps;
            bf16x8 pa0, pa1, pa2, pa3;
#define PK4(P, BASE, OUT) do { unsigned a0 = cvtpk(P[BASE + 0], P[BASE + 1]), a1 = cvtpk(P[BASE + 2], P[BASE + 3]);   \
    unsigned b0 = cvtpk(P[BASE + 4], P[BASE + 5]), b1 = cvtpk(P[BASE + 6], P[BASE + 7]);                              \
    auto r0 = __builtin_amdgcn_permlane32_swap(a0, b0, false, false); auto r1 = __builtin_amdgcn_permlane32_swap(a1, b1, false, false); \
    u32x4 w = {r0[0], r1[0], r0[1], r1[1]}; OUT = *reinterpret_cast<bf16x8*>(&w); } while (0)
            PK4(p0, 0, pa0); PK4(p0, 8, pa1); PK4(p1, 0, pa2); PK4(p1, 8, pa3);
#undef PK4
            const int vb = vb0 + bsel * 16384;
            __builtin_amdgcn_s_setprio(1);
            pv_one<0>(o[0], vb, pa0, pa1, pa2, pa3); pv_one<1>(o[1], vb, pa0, pa1, pa2, pa3);
            __builtin_amdgcn_s_setprio(0);
        }
        if (j + 1 < NT) { if (bsel) SWRITE(0); else SWRITE(1); }
        __syncthreads();
    }
    if (hi == 0) li_l[r32] = l_reg;
    asm volatile("s_waitcnt lgkmcnt(0)" ::: "memory");
    const size_t tok0 = (size_t)b * SEQ + qb * 128 + wid * 32;
    float* SSO = (float*)(c.ws + WS_SSQ_O);
#pragma unroll
    for (int r = 0; r < 16; ++r) {
        const int orow = crow(r, hi); const float rl = fast_rcp(li_l[orow]);
        bf16_t* dst = MG + (tok0 + orow) * D + h * DV + r32;
        const float a0 = o[0][r] * rl, a1 = o[1][r] * rl;
        dst[0]  = (bf16_t)(cvtpk(a0, 0.f) & 0xffffu);
        dst[32] = (bf16_t)(cvtpk(a1, 0.f) & 0xffffu);
        float sq = a0 * a0 + a1 * a1;
        sq += dpp_mov<0xB1>(sq); sq += dpp_mov<0x4E>(sq); sq += dpp_mov<0x141>(sq); sq += dpp_mov<0x140>(sq);
        sq += __shfl_xor(sq, 16);
        if (r32 == 0) SSO[(tok0 + orow) * 8 + h] = sq;
    }
#undef SLOAD
#undef SWRITE
}
DEV void phase3(const Ctx& c) {
    const int nslots = NB * NH * 4;
    float* scr = (float*)(c.lds + c.wid * 8448);
    const int gw = c.vcu * 4 + c.wid, NGW = c.G * 4;
    constexpr int NWI = 6144;
    int wi = gw;
#define EW_ITEMS(n) do { __syncthreads(); for (int _q = 0; _q < (n) && wi < NWI; ++_q, wi += NGW) expert_weight_item(c, wi, scr); } while (0)
    for (int v = c.vcu; v < nslots; v += c.G) {
        const int bh = v >> 2, s = v & 3, b = bh >> 3, h = bh & 7;
        attn_unit(c, b, h, 15 - s); EW_ITEMS(1); attn_unit(c, b, h, s); EW_ITEMS(1); attn_unit(c, b, h, 11 - s); EW_ITEMS(1); attn_unit(c, b, h, 4 + s);
    }
    __syncthreads();
    for (; wi < NWI; wi += NGW) expert_weight_item(c, wi, scr);
#undef EW_ITEMS
}

DEV void phase4(const Ctx& c) {
    const bf16_t* MG = (const bf16_t*)(c.ws + WS_MG); const bf16_t* WoT = (const bf16_t*)(c.ws + WS_WO); const bf16_t* h0 = (const bf16_t*)(c.ws + WS_H0);
    bf16_t* R1 = (bf16_t*)(c.ws + WS_R1);
    const StageGeo g = stage_geo(c.tid);
    const int lane = c.lane, wr = c.wid >> 1, wc = c.wid & 1, fr = lane & 15, fq = lane >> 4;
    constexpr int NU = (TR / 128) * 8;
    const float* SSO = (const float*)(c.ws + WS_SSQ_O);
    f32x4 pa = {1.f, 1.f, 1.f, 1.f}, pb = pa;
    if (c.vcu < NU && c.tid < 128) { const float* pp = SSO + (size_t)((c.vcu >> 3) * 128 + c.tid) * 8; pa = *(const f32x4*)pp; pb = *(const f32x4*)(pp + 4); }
    for (int u = c.vcu; u < NU; u += c.G) {
        const int mt = u >> 3, nt = u & 7;
        const bf16_t* A = MG + (size_t)(mt * 128) * D + g.c; const bf16_t* B = WoT + (size_t)(nt * 128) * D + g.c;
        f32x4 acc[4][4];
        __syncthreads();
        if (c.tid < 128) ((float*)(c.lds + RS_OFF))[c.tid] = rsqrt_((((pa.x + pa.y) + (pa.z + pa.w)) + ((pb.x + pb.y) + (pb.z + pb.w))) * (1.f / 512.f) + EPS);
        { const int un = u + c.G; if (un < NU && c.tid < 128) { const float* pp = SSO + (size_t)((un >> 3) * 128 + c.tid) * 8; pa = *(const f32x4*)pp; pb = *(const f32x4*)(pp + 4); } }
        u32x2 hw[4][4];
#pragma unroll
        for (int m = 0; m < 4; ++m) {
            const int tok = mt * 128 + wr * 64 + m * 16 + fr;
            const size_t t = (size_t)(tok >> 11) * L + NMETA + (tok & 2047);
#pragma unroll
            for (int n = 0; n < 4; ++n) hw[m][n] = *(const u32x2*)(h0 + t * D + nt * 128 + wc * 64 + n * 16 + fq * 4);
        }
        gemm_mainloop<true>(acc, A + (size_t)g.r[0] * D, A + (size_t)g.r[1] * D, A + (size_t)g.r[2] * D, A + (size_t)g.r[3] * D,
                            B + (size_t)g.r[0] * D, B + (size_t)g.r[1] * D, B + (size_t)g.r[2] * D, B + (size_t)g.r[3] * D, 16, c.lds, 8, 1.f / 512.f);
#pragma unroll
        for (int m = 0; m < 4; ++m) {
            const int tok = mt * 128 + wr * 64 + m * 16 + fr;
#pragma unroll
            for (int n = 0; n < 4; ++n) {
                const int col = nt * 128 + wc * 64 + n * 16 + fq * 4;
                f32x4 o; o[0] = ALPHA * bflo(hw[m][n].x) + acc[m][n][0]; o[1] = ALPHA * bfhi(hw[m][n].x) + acc[m][n][1];
                o[2] = ALPHA * bflo(hw[m][n].y) + acc[m][n][2]; o[3] = ALPHA * bfhi(hw[m][n].y) + acc[m][n][3];
                st_bf4(R1 + (size_t)tok * D + col, o);
            }
        }
    }
}

constexpr int P5_ROWB = 2064, P5_PART = 33280, P5_LG = 45568, P5_BIAS = 48128, P5_AGG = 48384;
DEV void phase5(const Ctx& c, int ALT = 0) {
    const bf16_t* R1 = (const bf16_t*)(c.ws + WS_R1);
    const bf16_t* WrT = (const bf16_t*)(c.ws + WS_WR);
    unsigned* cnt = (unsigned*)(c.ws + WS_CTL) + CW_CNT + ALT * 32; unsigned* list = (unsigned*)(c.ws + (ALT ? 404 * MiB : WS_LIST)); float* combw = (float*)(c.ws + WS_COMBW);
    const int lane = c.lane, wid = c.wid, fr = lane & 15, fq = lane >> 4;
    float* part = (float*)(c.lds + P5_PART); float* lgs = (float*)(c.lds + P5_LG); float* biasl = (float*)(c.lds + P5_BIAS);
    __syncthreads();
    if (c.tid < 36) biasl[c.tid] = (c.tid < 4) ? c.in[I_BRG][c.tid] : c.in[I_BRE][c.tid - 4];
    bf16x8 wf[8][3];
#pragma unroll
    for (int ks = 0; ks < 8; ++ks)
#pragma unroll
        for (int n = 0; n < 3; ++n) wf[ks][n] = *(const bf16x8*)(WrT + (size_t)(n * 16 + fr) * D + wid * 256 + ks * 32 + fq * 8);
    unsigned* lcnt = (unsigned*)(c.lds + P5_AGG); unsigned* lbase = lcnt + 32; unsigned* ent = lcnt + 64;
    if (c.tid < 32) lcnt[c.tid] = 0u;
    int nent = 0;
    for (int u = c.vcu; u < TR / 16; u += c.G) {
        const int tok0 = u * 16;
        { const float* src[4]; bf16_t* dst[4]; unsigned char* ldsn[4]; unsigned char* f8n[4]; float* stn[4];
#pragma unroll
          for (int i = 0; i < 4; ++i) { const int tl = wid * 4 + i; const size_t tok = tok0 + tl; src[i] = (const float*)(R1 + tok * D); dst[i] = nullptr; ldsn[i] = c.lds + tl * P5_ROWB; f8n[i] = c.ws + WS_H1F8 + tok * D;
              stn[i] = (float*)(c.ws + WS_ST1) + tok * 2; }
          ln_rows_bf16<4, true, true, true>(src, c.in[I_LN1G], c.in[I_LN1B], dst, ldsn, lane, f8n, stn); }
        __syncthreads();
        f32x4 acc[3] = {};
#pragma unroll
        for (int ks = 0; ks < 8; ++ks) {
            const int k = wid * 256 + ks * 32 + fq * 8;
            const bf16x8 a = *(const bf16x8*)(c.lds + fr * P5_ROWB + k * 2);
#pragma unroll
            for (int n = 0; n < 3; ++n) acc[n] = __builtin_amdgcn_mfma_f32_16x16x32_bf16(wf[ks][n], a, acc[n], 0, 0, 0);
        }
#pragma unroll
        for (int n = 0; n < 3; ++n) *(f32x4*)(part + (wid * 16 + fr) * 48 + n * 16 + fq * 4) = acc[n];
        __syncthreads();
#pragma unroll
        for (int i = 0; i < 3; ++i) { const int idx = c.tid + 256 * i;
            if (idx < 576) { const int tk = idx / 36, l = idx - tk * 36;
                lgs[tk * 40 + l] = ((part[tk * 48 + l] + part[(16 + tk) * 48 + l]) + (part[(32 + tk) * 48 + l] + part[(48 + tk) * 48 + l])) + biasl[l]; } }
        __syncthreads();
        if (c.tid < 16) {
            const float* lg = lgs + c.tid * 40;
            int gi = 0; float gm = lg[0];
#pragma unroll
            for (int i = 1; i < 4; ++i) { const float v = lg[i]; if (v > gm) { gm = v; gi = i; } }
            float gs = 0.f;
#pragma unroll
            for (int i = 0; i < 4; ++i) gs += __expf(lg[i] - gm);
            const float gw = 1.f / gs;
            const float* le = lg + 4 + gi * 8;
            float v0 = le[0], v1 = -3.0e38f; int i0 = 0, i1 = 0;
#pragma unroll
            for (int i = 1; i < 8; ++i) { const float v = le[i];
                if (v > v0) { v1 = v0; i1 = i0; v0 = v; i0 = i; } else if (v > v1) { v1 = v; i1 = i; } }
            const float ex = __expf(v1 - v0), inv = 1.f / (1.f + ex);
            const int tok = tok0 + c.tid; const unsigned e0 = gi * 8 + i0, e1 = gi * 8 + i1;
            combw[tok * 2] = gw * inv; combw[tok * 2 + 1] = gw * ex * inv;
            const unsigned r0 = atomicAdd(&lcnt[e0], 1u), r1 = atomicAdd(&lcnt[e1], 1u);
            const int ei = nent * 32 + c.tid * 2;
            ent[2 * ei] = (unsigned)(tok * 2);         ent[2 * ei + 1] = (e0 << 16) | r0;
            ent[2 * ei + 2] = (unsigned)(tok * 2 + 1); ent[2 * ei + 3] = (e1 << 16) | r1;
        }
        ++nent;
    }
    __syncthreads();
    if (c.tid < 32) { const unsigned n = lcnt[c.tid]; lbase[c.tid] = n ? atomicAdd(&cnt[c.tid * CNT_STRIDE], n) : 0u; }
    __syncthreads();
    for (int i = c.tid; i < nent * 32; i += 256) { const unsigned t2 = ent[2 * i], er = ent[2 * i + 1]; const unsigned e = er >> 16;
        list[(size_t)e * TR + lbase[e] + (er & 0xffffu)] = t2; }
}
DEV void bar20(const Ctx& c) {}
DEV void moe_tiles(const Ctx& c) {
    const unsigned* cnt = (const unsigned*)(c.ws + WS_CTL) + CW_CNT; int* ts = (int*)(c.lds + EXP_OFF);
    __syncthreads();
    if (c.tid < NE) ts[40 + c.tid] = (int)__hip_atomic_load(&cnt[c.tid * CNT_STRIDE], __ATOMIC_RELAXED, __HIP_MEMORY_SCOPE_AGENT);
    __syncthreads();
    if (c.tid == 0) { int s = 0; for (int e = 0; e < NE; ++e) { ts[e] = s; s += (ts[40 + e] + 127) >> 7; } ts[NE] = s; }
    __syncthreads();
}
DEV void phase6a(const Ctx& c) {
    const bf16_t* H18 = (const bf16_t*)(c.ws + WS_H1F8); const bf16_t* Wgu8 = (const bf16_t*)(c.ws + WS_WGU); unsigned char* ACT8 = c.ws + WS_ACT;
    const unsigned* list = (const unsigned*)(c.ws + WS_LIST);
    moe_tiles(c);
    const int* ts = (const int*)(c.lds + EXP_OFF); unsigned* tbl = (unsigned*)(c.lds + TBL_OFF);
    const StageGeo g = stage_geo(c.tid);
    const int lane = c.lane, wr = c.wid >> 1, wc = c.wid & 1, fr = lane & 15, fq = lane >> 4;
    const int NU = ts[NE] * 4;
    u32x2* RI = (u32x2*)(c.ws + WS_RI); const float* combw = (const float*)(c.ws + WS_COMBW);
    int e = 0, en_e = 0; unsigned en_cur = 0xffffffffu;
    { const int u0 = c.vcu; if (u0 < NU) { const int rt0 = u0 >> 2; while (ts[en_e + 1] <= rt0) ++en_e;
        if (c.tid < 128) { const int j = (rt0 - ts[en_e]) * 128 + c.tid; en_cur = (j < ts[40 + en_e]) ? list[(size_t)en_e * TR + j] : 0xffffffffu; } } }
    for (int u = c.vcu; u < NU; u += c.G) {
        const int rt = u >> 2, nt = u & 3;
        e = en_e;
        __syncthreads();
        float wri = 0.f;
        if (c.tid < 128) { tbl[c.tid] = en_cur; if (nt == 0 && en_cur != 0xffffffffu) wri = combw[en_cur]; }
        const unsigned en_this = en_cur;
        { const int un = u + c.G; if (un < NU) { const int rtn = un >> 2; while (ts[en_e + 1] <= rtn) ++en_e;
            if (c.tid < 128) { const int j = (rtn - ts[en_e]) * 128 + c.tid; en_cur = (j < ts[40 + en_e]) ? list[(size_t)en_e * TR + j] : 0xffffffffu; } } }
        __syncthreads();
        size_t ro[4];
#pragma unroll
        for (int i = 0; i < 4; ++i) { const unsigned en = tbl[g.r[i]]; ro[i] = (en == 0xffffffffu) ? 0 : (size_t)(en >> 1) * (D / 2); }
        const bf16_t* A = H18 + g.c; const bf16_t* B = Wgu8 + ((size_t)e * 512 + nt * 128) * (D / 2) + g.c;
        f32x4 acc[4][4];
        gemm_mainloop<false, true>(acc, A + ro[0], A + ro[1], A + ro[2], A + ro[3],
                             B + (size_t)g.r[0] * (D / 2), B + (size_t)g.r[1] * (D / 2), B + (size_t)g.r[2] * (D / 2), B + (size_t)g.r[3] * (D / 2), 8, c.lds, 0, 0.f);
#pragma unroll
        for (int m = 0; m < 4; ++m) { const size_t row = (size_t)rt * 128 + wr * 64 + m * 16 + fr;
#pragma unroll
            for (int i = 0; i < 2; ++i) {
                const f32x4 gt = acc[m][2 * i], up = acc[m][2 * i + 1]; f32x4 o;
#pragma unroll
                for (int j = 0; j < 4; ++j) { const float gv = gt[j] * WUNSCALE; o[j] = gv * sigmoidf_(gv) * (up[j] * WUNSCALE); }
                *(unsigned*)(ACT8 + row * DE + nt * 64 + wc * 32 + i * 16 + fq * 4) = pk_fp8x4(o[0], o[1], o[2], o[3]);
            } }
        if (nt == 0 && c.tid < 128) { u32x2 ri; ri.x = en_this; ri.y = __float_as_uint(wri); RI[(size_t)rt * 128 + c.tid] = ri; }
    }
}
DEV void phase6b(const Ctx& c) {
    const bf16_t* ACT8 = (const bf16_t*)(c.ws + WS_ACT); const bf16_t* Wd8 = (const bf16_t*)(c.ws + WS_WD); unsigned char* Y8 = c.ws + WS_Y;
    const u32x2* RI = (const u32x2*)(c.ws + WS_RI);
    moe_tiles(c);
    const int* ts = (const int*)(c.lds + EXP_OFF); u32x2* tbl = (u32x2*)(c.lds + TBL_OFF);
    const StageGeo g = stage_geo(c.tid);
    unsigned char* lds = c.lds;
    const int tid = c.tid, lane = c.lane, wr = c.wid >> 1, wc = c.wid & 1, fr = lane & 15, fq = lane >> 4;
    const int cb0 = fq * 32, cb1 = fq * 32 + 16;
    const int q0 = (cb0 >> 6) * 1024 + ((fr * 64 + (cb0 & 63)) ^ ((fr >> 3) << 5)), q1 = (cb1 >> 6) * 1024 + ((fr * 64 + (cb1 & 63)) ^ ((fr >> 3) << 5));
    const int a_off = wr * 8192, b_off = wc * 8192, dst = tid * 16;
    const int NU = ts[NE] * 2;
    int e = 0;
#define GLDS(src, off) __builtin_amdgcn_global_load_lds((const unsigned*)(src), (unsigned LAS*)(lds + (off)), 16, 0, 0)
    for (int u = c.vcu; u < NU; u += c.G) {
        const int rt = u >> 1, nh = u & 1;
        while (ts[e + 1] <= rt) ++e;
        __syncthreads();
        if (tid < 128) tbl[tid] = RI[(size_t)rt * 128 + tid];
        const bf16_t* A = ACT8 + (size_t)(rt * 128) * (DE / 2) + g.c;
        const bf16_t* B = Wd8 + ((size_t)e * 1024 + nh * 512) * (DE / 2) + g.c;
#pragma unroll
        for (int kt = 0; kt < 2; ++kt)
#pragma unroll
            for (int i = 0; i < 4; ++i) GLDS(A + (size_t)g.r[i] * (DE / 2) + kt * 64, kt * 16384 + dst + i * 4096);
#define BSTAGE(s_, buf) do { const bf16_t* _b = B + (size_t)((s_) >> 1) * 128 * (DE / 2) + ((s_) & 1) * 64; \
        GLDS(_b + (size_t)g.r[0] * (DE / 2), 32768 + (buf) * 16384 + dst);        GLDS(_b + (size_t)g.r[1] * (DE / 2), 32768 + (buf) * 16384 + dst + 4096); \
        GLDS(_b + (size_t)g.r[2] * (DE / 2), 32768 + (buf) * 16384 + dst + 8192); GLDS(_b + (size_t)g.r[3] * (DE / 2), 32768 + (buf) * 16384 + dst + 12288); } while (0)
        BSTAGE(0, 0);
        f32x4 acc[4][4];
#pragma unroll
        for (int m = 0; m < 4; ++m)
#pragma unroll
            for (int n = 0; n < 4; ++n) acc[m][n] = (f32x4){0.f, 0.f, 0.f, 0.f};
#pragma unroll 1
        for (int s_ = 0; s_ < 8; ++s_) {
            VM_WAIT();
            __syncthreads();
            const int bsel = s_ & 1;
            if (s_ + 1 < 8) { if (bsel) BSTAGE(s_ + 1, 0); else BSTAGE(s_ + 1, 1); }
            const unsigned char* ab = lds + bsel * 16384 + a_off; const unsigned char* bb = lds + 32768 + bsel * 16384 + b_off;
            v8i ax[4], bx[4];
#pragma unroll
            for (int m = 0; m < 4; ++m) { const u32x4 c0 = *(const u32x4*)(ab + m * 2048 + q0), c1 = *(const u32x4*)(ab + m * 2048 + q1);
                ax[m] = (v8i){(int)c0.x, (int)c0.y, (int)c0.z, (int)c0.w, (int)c1.x, (int)c1.y, (int)c1.z, (int)c1.w}; }
#pragma unroll
            for (int n = 0; n < 4; ++n) { const u32x4 c0 = *(const u32x4*)(bb + n * 2048 + q0), c1 = *(const u32x4*)(bb + n * 2048 + q1);
                bx[n] = (v8i){(int)c0.x, (int)c0.y, (int)c0.z, (int)c0.w, (int)c1.x, (int)c1.y, (int)c1.z, (int)c1.w}; }
#pragma unroll
            for (int m = 0; m < 4; ++m)
#pragma unroll
                for (int n = 0; n < 4; ++n) acc[m][n] = __builtin_amdgcn_mfma_scale_f32_16x16x128_f8f6f4(bx[n], ax[m], acc[m][n], 0, 0, 0, 0x7F7F7F7F, 0, 0x7F7F7F7F);
            if (bsel) {
                const int nt = nh * 4 + (s_ >> 1);
#pragma unroll
                for (int m = 0; m < 4; ++m) {
                    const u32x2 ri = tbl[wr * 64 + m * 16 + fr]; const unsigned en = ri.x;
                    if (en != 0xffffffffu) {
                        const float w = __uint_as_float(ri.y) * (WUNSCALE * YSCALE); unsigned char* dstp = Y8 + ((size_t)(en & 1u) * TR + (en >> 1)) * D + nt * 128 + wc * 64 + fq * 4;
#pragma unroll
                        for (int n = 0; n < 4; ++n) { const f32x4 o = acc[m][n] * w; *(unsigned*)(dstp + n * 16) = pk_fp8x4(o[0], o[1], o[2], o[3]); }
                    }
#pragma unroll
                    for (int n = 0; n < 4; ++n) acc[m][n] = (f32x4){0.f, 0.f, 0.f, 0.f};
                }
            }
        }
#undef BSTAGE
    }
#undef GLDS
}

DEV void phase7(const Ctx& c) {
    const bf16_t* R1 = (const bf16_t*)(c.ws + WS_R1); const unsigned char* Y8 = c.ws + WS_Y; const float2* ST1 = (const float2*)(c.ws + WS_ST1);
    const float* g = c.in[I_LN2G]; const float* bt = c.in[I_LN2B];
    const int gw = c.vcu * 4 + c.wid, NGW = c.G * 4, lane = c.lane;
    float G1[16], B1[16];
#pragma unroll
    for (int i = 0; i < 2; ++i)
#pragma unroll
        for (int q = 0; q < 2; ++q) { const f32x4 a = *(const f32x4*)(c.in[I_LN1G] + i * 512 + lane * 8 + q * 4), bq = *(const f32x4*)(c.in[I_LN1B] + i * 512 + lane * 8 + q * 4);
#pragma unroll
            for (int e = 0; e < 4; ++e) { G1[i * 8 + q * 4 + e] = a[e]; B1[i * 8 + q * 4 + e] = bq[e]; } }
    for (int tok0 = gw; tok0 < TR; tok0 += 2 * NGW) {
        float v[2][16]; float st[2]; int tk[2];
#pragma unroll
        for (int r = 0; r < 2; ++r) {
            int tok = tok0 + r * NGW; if (tok >= TR) tok = tok0; tk[r] = tok;
            const float2 ms = ST1[tok]; const float am = ALPHA * ms.y;
#pragma unroll
            for (int i = 0; i < 2; ++i) {
                const u32x4 hw = __builtin_nontemporal_load((const u32x4*)(R1 + (size_t)tok * D + i * 512 + lane * 8));
                const u32x2 y0 = __builtin_nontemporal_load((const u32x2*)(Y8 + (size_t)tok * D + i * 512 + lane * 8));
                const u32x2 y1 = __builtin_nontemporal_load((const u32x2*)(Y8 + ((size_t)TR + tok) * D + i * 512 + lane * 8));
#pragma unroll
                for (int q2 = 0; q2 < 2; ++q2) {
                    const auto a0 = __builtin_amdgcn_cvt_pk_f32_fp8((int)y0[q2], false), a1 = __builtin_amdgcn_cvt_pk_f32_fp8((int)y0[q2], true);
                    const auto b0 = __builtin_amdgcn_cvt_pk_f32_fp8((int)y1[q2], false), b1 = __builtin_amdgcn_cvt_pk_f32_fp8((int)y1[q2], true);
                    const int e0 = i * 8 + 4 * q2;
                    v[r][e0]     = (bflo(hw[2 * q2]) - ms.x) * (am * G1[e0]) + ALPHA * B1[e0] + (a0[0] + b0[0]) * YUNSCALE;
                    v[r][e0 + 1] = (bfhi(hw[2 * q2]) - ms.x) * (am * G1[e0 + 1]) + ALPHA * B1[e0 + 1] + (a0[1] + b0[1]) * YUNSCALE;
                    v[r][e0 + 2] = (bflo(hw[2 * q2 + 1]) - ms.x) * (am * G1[e0 + 2]) + ALPHA * B1[e0 + 2] + (a1[0] + b1[0]) * YUNSCALE;
                    v[r][e0 + 3] = (bfhi(hw[2 * q2 + 1]) - ms.x) * (am * G1[e0 + 3]) + ALPHA * B1[e0 + 3] + (a1[1] + b1[1]) * YUNSCALE;
                }
            }
        }
#pragma unroll
        for (int r = 0; r < 2; ++r) { float a = 0.f;
#pragma unroll
            for (int q = 0; q < 16; ++q) a += v[r][q];
            st[r] = a; }
        wave_sum_n<2>(st);
#pragma unroll
        for (int r = 0; r < 2; ++r) { const float mean = st[r] * (1.f / 1024.f); float a = 0.f;
#pragma unroll
            for (int q = 0; q < 16; ++q) { v[r][q] -= mean; a += v[r][q] * v[r][q]; }
            st[r] = a; }
        wave_sum_n<2>(st);
#pragma unroll
        for (int i = 0; i < 2; ++i)
#pragma unroll
            for (int q = 0; q < 2; ++q) {
                const int col = i * 512 + lane * 8 + q * 4;
                const f32x4 gg = *(const f32x4*)(g + col), bb = *(const f32x4*)(bt + col);
#pragma unroll
                for (int r = 0; r < 2; ++r) {
                    if (r == 1 && tok0 + NGW >= TR) continue;
                    const float rstd = rsqrt_(st[r] * (1.f / 1024.f) + EPS);
                    f32x4 o; o[0] = v[r][i * 8 + q * 4] * rstd * gg[0] + bb[0]; o[1] = v[r][i * 8 + q * 4 + 1] * rstd * gg[1] + bb[1];
                    o[2] = v[r][i * 8 + q * 4 + 2] * rstd * gg[2] + bb[2]; o[3] = v[r][i * 8 + q * 4 + 3] * rstd * gg[3] + bb[3];
                    *(f32x4*)(c.out + (size_t)tk[r] * D + col) = o;
                }
            }
    }
}

__global__ void __launch_bounds__(256, 2) fwd_kernel(Args a) {
    extern __shared__ __attribute__((aligned(16))) unsigned char lds[];
    Ctx c; c.in = a.in; c.out = a.out; c.ws = a.ws; c.lds = lds;
    c.tid = threadIdx.x; c.lane = c.tid & 63; c.wid = __builtin_amdgcn_readfirstlane(c.tid >> 6);
    c.G = gridDim.x; { const int bx = blockIdx.x; c.vcu = (c.G % 8 == 0) ? (bx % 8) * (c.G / 8) + bx / 8 : bx; }
    if (c.tid < 64) ((unsigned*)(lds + MISC_OFF))[c.tid] = 0u;
    __syncthreads();
    unsigned* ctl = (unsigned*)(a.ws + WS_CTL);
    XcdBarrier bar = xcd_barrier_post(ctl + CW_BAR, (volatile LAS unsigned*)(lds + MISC_OFF));
#ifdef ONLY_PH
#define PH_ON(k) ((k) == ONLY_PH)
#else
#define PH_ON(k) 1
#endif
    const int lo = a.ph_lo, hi = a.ph_hi;
#define RUN_PHASE(k, fn) if (PH_ON(k) && lo <= (k) && (k) < hi) { \
        for (int _rep = 0; _rep < ((REPEAT_PH == (k)) ? 2 : 1); ++_rep) { \
            int _t = threadIdx.x; asm volatile("" : "+v"(_t)); c.tid = _t; c.lane = _t & 63; c.wid = __builtin_amdgcn_readfirstlane(_t >> 6); \
            if ((k) == 5) phase5(c, _rep); else fn(c); \
            if (_rep == 0 && REPEAT_PH == (k)) xcd_barrier(bar); } \
        if ((k) + 1 < hi) xcd_barrier(bar); }
    RUN_PHASE(0, phase0)
    RUN_PHASE(1, phase1)
    RUN_PHASE(2, phase2)
    RUN_PHASE(3, phase3)
    RUN_PHASE(4, phase4)
    RUN_PHASE(5, phase0)
    RUN_PHASE(6, phase6a)
    RUN_PHASE(7, phase6b)
    RUN_PHASE(8, phase7)
}

extern "C" void kernel_launch(void* const* d_in, const int* in_sizes, int n_in, void* d_out, int out_size, void* d_ws, size_t ws_size, hipStream_t stream) {
    static int grid = 0;
    if (grid == 0) {
        if (n_in != 27 || in_sizes[0] != NB * SEQ * D || out_size != TR * D || ws_size < WS_END) {
            fprintf(stderr, "kernel_launch: shape mismatch n_in %d in0 %d out %d ws %zu\n", n_in, n_in > 0 ? in_sizes[0] : -1, out_size, ws_size); grid = -1; return; }
        int dev = 0, cus = 0, per_cu = 0;
        if (hipGetDevice(&dev) != hipSuccess || hipDeviceGetAttribute(&cus, hipDeviceAttributeMultiprocessorCount, dev) != hipSuccess) { grid = -1; return; }
        if (hipFuncSetAttribute((const void*)fwd_kernel, hipFuncAttributeMaxDynamicSharedMemorySize, LDS_BYTES) != hipSuccess) { grid = -1; return; }
        if (hipOccupancyMaxActiveBlocksPerMultiprocessor(&per_cu, (const void*)fwd_kernel, 256, LDS_BYTES) != hipSuccess || per_cu < 1) per_cu = 1;
        (void)hipGetLastError();
        if (per_cu > 2) per_cu = 2;
        grid = cus * per_cu;
        fprintf(stderr, "kernel_launch: grid %d (%d per CU)\n", grid, per_cu);
    }
    if (grid < 0) return;
    (void)hipMemsetAsync((char*)d_ws + WS_CTL, 0, CTL_ZERO_BYTES, stream);
    Args a{};
    for (int i = 0; i < 27; ++i) a.in[i] = (const float*)d_in[i];
    a.out = (float*)d_out; a.ws = (unsigned char*)d_ws;
    if (MK_N_LAUNCHES == 1) {
        a.ph_lo = 0; a.ph_hi = NPH;
        hipLaunchKernelGGL(fwd_kernel, dim3(grid), dim3(256), LDS_BYTES, stream, a);
    } else {
        for (int ph = 0; ph < NPH; ++ph) { a.ph_lo = ph; a.ph_hi = ph + 1; hipLaunchKernelGGL(fwd_kernel, dim3(grid), dim3(256), LDS_BYTES, stream, a); }
    }
}
```

```cpp
#include <hip/hip_runtime.h>
#include <cstdio>
#include <cstdint>

#ifndef REPEAT_PH
#define REPEAT_PH -1
#endif
#ifndef CONV_REPB
#define CONV_REPB 1
#endif
#ifndef CONV_REPC
#define CONV_REPC 1
#endif
#ifndef CONV_REPA
#define CONV_REPA 1
#endif
#ifndef MK_N_LAUNCHES
#define MK_N_LAUNCHES 1
#endif

#define DEV __device__ __forceinline__
#define LAS __attribute__((address_space(3)))
#define GAS __attribute__((address_space(1)))
typedef unsigned short bf16_t;
typedef short bf16x8 __attribute__((ext_vector_type(8)));
typedef short s16x4 __attribute__((ext_vector_type(4)));
typedef float f32x4 __attribute__((ext_vector_type(4)));
typedef float f32x16 __attribute__((ext_vector_type(16)));
typedef unsigned u32x4 __attribute__((ext_vector_type(4)));
typedef unsigned u32x2 __attribute__((ext_vector_type(2)));
typedef long i64x2 __attribute__((ext_vector_type(2)));
typedef int v8i __attribute__((ext_vector_type(8)));

constexpr int NB = 16, SEQ = 2048, NMETA = 16, L = SEQ + NMETA;
constexpr int T = NB * L;
constexpr int TR = NB * SEQ;
constexpr int D = 1024, NIN = 1696, CC = 512, QL = 384, KVL = 256, NH = 8, DQK = 96, DV = 64;
constexpr int NQ = NH * DQK;
constexpr int NKV = NH * (64 + DV);
constexpr int NE = 32, DE = 256, CONVK = 31;
constexpr float EPS = 1e-5f;
constexpr float ALPHA = 1.189207115002721f;
constexpr float QSCALE = 0.10206207261596577f * 1.4426950408889634f;
constexpr int NPH = 9;
constexpr float WSCALE = 16.f, WUNSCALE = 1.f / 16.f;
constexpr float YSCALE = 64.f, YUNSCALE = 1.f / 64.f;

constexpr size_t MiB = 1u << 20;
constexpr size_t WS_CTL = 0, CTL_ZERO_BYTES = 64 * 1024;
constexpr int CW_CNT = 1024, CNT_STRIDE = 64;
constexpr int CW_BAR = 4096;
constexpr size_t WS_LIST = 1 * MiB;
constexpr size_t WS_COMBW = 5 * MiB;
constexpr size_t WS_ST1 = 5 * MiB + 256 * 1024;
constexpr size_t WS_ROPE = 5 * MiB + 512 * 1024;
constexpr size_t WS_WIN = 6 * MiB;
constexpr size_t WS_WUQ = 10 * MiB;
constexpr size_t WS_WUKV = 11 * MiB;
constexpr size_t WS_WO = 12 * MiB;
constexpr size_t WS_WR = 14 * MiB;
constexpr size_t WS_RI = 14 * MiB + 512 * 1024;
constexpr size_t WS_SSQ_CQ = 404 * MiB + 512 * 1024;
constexpr size_t WS_SSQ_CKV = 402 * MiB;
constexpr size_t WS_SSQ_O = 403 * MiB;
constexpr size_t WS_WGU = 16 * MiB;
constexpr size_t WS_WD = 48 * MiB;
constexpr size_t WS_H1F8 = 130 * MiB;
constexpr size_t WS_H0 = 64 * MiB;
constexpr size_t WS_U = 130 * MiB;
constexpr size_t WS_CQ = 163 * MiB;
constexpr size_t WS_CKV = 188 * MiB;
constexpr size_t WS_KR = 205 * MiB;
constexpr size_t WS_Q = 208 * MiB;
constexpr size_t WS_KV = 257 * MiB;
constexpr size_t WS_R1 = 208 * MiB;
constexpr size_t WS_Y = 272 * MiB;
constexpr size_t WS_MG = 336 * MiB;
constexpr size_t WS_ACT = 336 * MiB;
constexpr size_t WS_DUMMY = 400 * MiB;
constexpr size_t WS_END = 406 * MiB;

constexpr int LDS_BYTES = 73728;
constexpr int MISC_OFF = LDS_BYTES - 256;
constexpr int RS_OFF = 65536;
constexpr int TBL_OFF = 66048;
constexpr int EXP_OFF = 67584;

DEV unsigned cvtpk(float lo, float hi) { unsigned r; asm("v_cvt_pk_bf16_f32 %0, %1, %2" : "=v"(r) : "v"(lo), "v"(hi)); return r; }
DEV float bflo(unsigned w) { return __uint_as_float(w << 16); }
DEV float bfhi(unsigned w) { return __uint_as_float(w & 0xffff0000u); }
DEV float dpp_add_qp(float v, int) { return v; }
template <int CTRL> DEV float dpp_mov(float v) { return __builtin_bit_cast(float, __builtin_amdgcn_update_dpp(0, __builtin_bit_cast(int, v), CTRL, 0xf, 0xf, false)); }
DEV float wave_sum(float v) {
    v += dpp_mov<0xB1>(v);
    v += dpp_mov<0x4E>(v);
    v += dpp_mov<0x141>(v);
    v += dpp_mov<0x140>(v);
    const int iv = __builtin_bit_cast(int, v);
    const float a = __builtin_bit_cast(float, __builtin_amdgcn_readlane(iv, 0)), b = __builtin_bit_cast(float, __builtin_amdgcn_readlane(iv, 16));
    const float c = __builtin_bit_cast(float, __builtin_amdgcn_readlane(iv, 32)), d = __builtin_bit_cast(float, __builtin_amdgcn_readlane(iv, 48));
    return (a + b) + (c + d);
}
DEV float rsqrt_(float x) { return __builtin_amdgcn_rsqf(x); }
DEV void st_bf4(bf16_t* p, f32x4 v) { u32x2 w = {cvtpk(v[0], v[1]), cvtpk(v[2], v[3])}; *(u32x2*)p = w; }
DEV unsigned pk_fp8x4(float a, float b, float c, float d) {
    int w = __builtin_amdgcn_cvt_pk_fp8_f32(a, b, 0, false); w = __builtin_amdgcn_cvt_pk_fp8_f32(c, d, w, true); return (unsigned)w; }
DEV float fast_exp2(float x) { return __builtin_amdgcn_exp2f(x); }
DEV float fast_rcp(float x) { return __builtin_amdgcn_rcpf(x); }
DEV float sigmoidf_(float g) { return fast_rcp(1.f + fast_exp2(-1.4426950408889634f * g)); }
#define LDS_WAIT() asm volatile("s_waitcnt lgkmcnt(0)" ::: "memory")
#define VM_WAIT() asm volatile("s_waitcnt vmcnt(0)" ::: "memory")

#define XB_TMO      128
#define XB_XCNT(j)  (256  + 64 * (j))
#define XB_XSUB(j)  (1280 + 64 * (j))
#define XB_XGEN(j)  (2304 + 64 * (j))
#define XB_TOP      3328
#define XB_TOPGEN   3392
#define XCD_BAR_WORDS 3456
#define XB_SPIN_CAP (1u << 22)
DEV unsigned xb_ld(unsigned* p)              { return __hip_atomic_load(p, __ATOMIC_RELAXED, __HIP_MEMORY_SCOPE_AGENT); }
DEV unsigned xb_add(unsigned* p, unsigned v) { return __hip_atomic_fetch_add(p, v, __ATOMIC_RELAXED, __HIP_MEMORY_SCOPE_AGENT); }
DEV unsigned xb_xcc_id() { return (unsigned)__builtin_amdgcn_s_getreg((3 << 11) | 20) & 0xFu; }
#define XB_SPIN(cond, bar) do { unsigned _sp = 0; while (cond) { __builtin_amdgcn_s_sleep(1); \
    if ((++_sp & 255u) == 0u) { if (xb_ld(&(bar)[XB_TMO])) break; if (_sp > XB_SPIN_CAP) { atomicAdd(&(bar)[XB_TMO], 1u); break; } } } } while (0)
struct XcdBarrier { unsigned* bar; unsigned x; volatile LAS unsigned* st; };
DEV XcdBarrier xcd_barrier_post(unsigned* bar, volatile LAS unsigned* st) {
    XcdBarrier b; b.bar = bar; b.x = xb_xcc_id(); b.st = st;
    if (threadIdx.x == 0) (void)xb_add(&bar[XB_XCNT(b.x)], 1u);
    return b;
}
DEV u32x4 quad_transpose(unsigned x0, unsigned x1, unsigned x2, unsigned x3) {
    auto a = __builtin_amdgcn_permlane32_swap(x0, x2, false, false); auto b = __builtin_amdgcn_permlane32_swap(x1, x3, false, false);
    auto z0 = __builtin_amdgcn_permlane16_swap(a[0], b[0], false, false); auto z1 = __builtin_amdgcn_permlane16_swap(a[1], b[1], false, false);
    return (u32x4){z0[0], z0[1], z1[0], z1[1]};
}
DEV void xcd_barrier_complete(unsigned* bar, unsigned x, unsigned& nloc, unsigned& nx) {
    const unsigned G = gridDim.x * gridDim.y * gridDim.z;
    unsigned sum, cnt, mine, sp = 0u;
    for (;;) {
        sum = 0u; cnt = 0u; mine = 0u;
#pragma unroll
        for (unsigned j = 0; j < 16; ++j) { const unsigned c = xb_ld(&bar[XB_XCNT(j)]); sum += c; cnt += (c > 0u) ? 1u : 0u; mine = (j == x) ? c : mine; }
        if (sum == G) break;
        __builtin_amdgcn_s_sleep(1);
        if ((++sp & 255u) == 0u) { if (xb_ld(&bar[XB_TMO])) break; if (sp > XB_SPIN_CAP) { atomicAdd(&bar[XB_TMO], 1u); break; } }
    }
    nloc = mine > 0u ? mine : 1u; nx = cnt > 0u ? cnt : 1u;
}
DEV void xcd_barrier(const XcdBarrier& b) {
    asm volatile("s_waitcnt vmcnt(0)" ::: "memory");
    __syncthreads();
    if (threadIdx.x == 0) {
        unsigned* bar = b.bar;
        __builtin_amdgcn_s_waitcnt(0);
        unsigned nloc = b.st[0], nx = b.st[1];
        if (nloc == 0u) { xcd_barrier_complete(bar, b.x, nloc, nx); b.st[0] = nloc; b.st[1] = nx; }
        const unsigned old = xb_add(&bar[XB_XSUB(b.x)], 1u);
        const unsigned gen = old / nloc;
        if (old + 1u == (gen + 1u) * nloc) {
            __builtin_amdgcn_fence(__ATOMIC_RELEASE, "agent");
            asm volatile("s_waitcnt vmcnt(0)" ::: "memory");
            const unsigned og = xb_add(&bar[XB_TOP], 1u);
            const unsigned tg = og / nx;
            if (og + 1u == (tg + 1u) * nx) xb_add(&bar[XB_TOPGEN], 1u);
            else XB_SPIN(xb_ld(&bar[XB_TOPGEN]) == tg, bar);
            __builtin_amdgcn_fence(__ATOMIC_ACQUIRE, "agent");
            xb_add(&bar[XB_XGEN(b.x)], 1u);
            asm volatile("s_waitcnt vmcnt(0)" ::: "memory");
        } else {
            XB_SPIN(xb_ld(&bar[XB_XGEN(b.x)]) == gen, bar);
            __builtin_amdgcn_fence(__ATOMIC_ACQUIRE, "agent");
            asm volatile("s_waitcnt vmcnt(0)" ::: "memory");
        }
    }
    __syncthreads();
}

struct Args { const float* in[27]; float* out; unsigned char* ws; int ph_lo, ph_hi; };
struct Ctx {
    const float* const* in; float* out; unsigned char* ws; unsigned char* lds;
    int tid, lane, wid, vcu, G;
};
enum { I_X = 0, I_META, I_LNIN_G, I_LNIN_B, I_WIN, I_CONVW, I_CONVB, I_CLN_G, I_CLN_B, I_QNG, I_WUQ, I_KVNG, I_WUKV, I_COUT_G, I_AOUT_G, I_WO,
       I_LN1G, I_LN1B, I_WRG, I_BRG, I_WRE, I_BRE, I_WGATE, I_WUP, I_WDOWN, I_LN2G, I_LN2B };

DEV int nmap(int mode, int n) {
    if (mode == 1) { if (n < 512) return ((n >> 4) << 5) + (n & 15); if (n < 1024) return (((n - 512) >> 4) << 5) + 16 + (n & 15); return n; }
    if (mode == 2) return ((n >> 4) << 5) + (n & 15);
    if (mode == 3) return ((n >> 4) << 5) + 16 + (n & 15);
    return n;
}
DEV void p0_transpose_item(const float* __restrict__ W, int N, int k0, int n0, const float* __restrict__ kscale, bf16_t* WT, int ldt, int kout0, int mode,
                           float* scr, int lane) {
#pragma unroll 8
    for (int i = 0; i < 32; ++i) {
        const int kk = 2 * i + (lane >> 5);
        float v = __builtin_nontemporal_load(&W[(size_t)(k0 + kk) * N + n0 + (lane & 31)]);
        if (kscale) v *= kscale[k0 + kk];
        scr[kk * 33 + (lane & 31)] = v;
    }
    LDS_WAIT(); asm volatile("" ::: "memory");
    const int c = lane & 7;
#pragma unroll
    for (int j = 0; j < 4; ++j) {
        const int n = (lane >> 3) + 8 * j; const float* s = scr + (8 * c) * 33 + n;
        u32x4 o; o.x = cvtpk(s[0 * 33], s[1 * 33]); o.y = cvtpk(s[2 * 33], s[3 * 33]); o.z = cvtpk(s[4 * 33], s[5 * 33]); o.w = cvtpk(s[6 * 33], s[7 * 33]);
        *(u32x4*)(WT + (size_t)nmap(mode, n0 + n) * ldt + kout0 + 8 * c) = o;
    }
    LDS_WAIT(); asm volatile("" ::: "memory");
}
DEV void p0_transpose_item_f8(const float* __restrict__ W, int N, int k0, int n0, float scale, unsigned char* W8, int ldt, int kout0, int mode, float* scr, int lane) {
#pragma unroll 8
    for (int i = 0; i < 32; ++i) { const int kk = 2 * i + (lane >> 5); scr[kk * 33 + (lane & 31)] = W[(size_t)(k0 + kk) * N + n0 + (lane & 31)] * scale; }
    LDS_WAIT(); asm volatile("" ::: "memory");
    const int c = lane & 7;
#pragma unroll
    for (int j = 0; j < 4; ++j) {
        const int n = (lane >> 3) + 8 * j; const float* sp = scr + (8 * c) * 33 + n;
        u32x2 o; o.x = pk_fp8x4(sp[0 * 33], sp[1 * 33], sp[2 * 33], sp[3 * 33]); o.y = pk_fp8x4(sp[4 * 33], sp[5 * 33], sp[6 * 33], sp[7 * 33]);
        *(u32x2*)(W8 + (size_t)nmap(mode, n0 + n) * ldt + kout0 + 8 * c) = o;
    }
    LDS_WAIT(); asm volatile("" ::: "memory");
}
template <int N> DEV void wave_sum_n(float (&v)[N]) {
#pragma unroll
    for (int i = 0; i < N; ++i) v[i] = wave_sum(v[i]);
}
template <int NR, bool F8 = false, bool BFIN = false, bool NOBF = false> DEV void ln_rows_bf16(const float* const (&xrow)[NR], const float* g, const float* bta, bf16_t* const (&orow)[NR], unsigned char* const (&ldsrow)[NR], int lane, unsigned char* const* f8row = nullptr, float* const* strow = nullptr) {
    f32x4 v[NR][4]; float s[NR];
#pragma unroll
    for (int r = 0; r < NR; ++r)
#pragma unroll
        for (int j = 0; j < 4; ++j) {
            if (BFIN) { const u32x2 w = ((const u32x2*)xrow[r])[64 * j + lane]; v[r][j] = (f32x4){bflo(w.x), bfhi(w.x), bflo(w.y), bfhi(w.y)}; }
            else v[r][j] = __builtin_nontemporal_load(&((const f32x4*)xrow[r])[64 * j + lane]); }
#pragma unroll
    for (int r = 0; r < NR; ++r) { s[r] = 0.f;
#pragma unroll
        for (int j = 0; j < 4; ++j) s[r] += (v[r][j].x + v[r][j].y) + (v[r][j].z + v[r][j].w); }
    wave_sum_n<NR>(s);
    float s2[NR];
#pragma unroll
    for (int r = 0; r < NR; ++r) { const float mean = s[r] * (1.f / 1024.f); s2[r] = 0.f;
#pragma unroll
        for (int j = 0; j < 4; ++j) { v[r][j] = v[r][j] - mean; s2[r] += (v[r][j].x * v[r][j].x + v[r][j].y * v[r][j].y) + (v[r][j].z * v[r][j].z + v[r][j].w * v[r][j].w); } }
    wave_sum_n<NR>(s2);
    if (strow) {
#pragma unroll
        for (int r = 0; r < NR; ++r) if (lane == 0) { strow[r][0] = s[r] * (1.f / 1024.f); strow[r][1] = rsqrt_(s2[r] * (1.f / 1024.f) + EPS); }
    }
#pragma unroll
    for (int j = 0; j < 4; ++j) {
        const f32x4 gg = ((const f32x4*)g)[64 * j + lane], bb = ((const f32x4*)bta)[64 * j + lane];
#pragma unroll
        for (int r = 0; r < NR; ++r) {
            const float rstd = rsqrt_(s2[r] * (1.f / 1024.f) + EPS);
            const f32x4 o = v[r][j] * rstd * gg + bb;
            const u32x2 w = {cvtpk(o.x, o.y), cvtpk(o.z, o.w)};
            if (!NOBF) ((u32x2*)orow[r])[64 * j + lane] = w;
            if (ldsrow[r]) ((u32x2*)ldsrow[r])[64 * j + lane] = w;
            if (F8) ((unsigned*)f8row[r])[64 * j + lane] = pk_fp8x4(o.x, o.y, o.z, o.w);
        }
    }
}
__device__ const float INVF[16] = {1.0f, 0.5623413251903491f, 0.31622776601683794f, 0.1778279410038923f, 0.1f, 0.05623413251903491f, 0.031622776601683794f,
    0.01778279410038923f, 0.01f, 0.005623413251903491f, 0.0031622776601683794f, 0.001778279410038923f, 0.001f, 0.0005623413251903491f, 0.00031622776601683794f, 0.0001778279410038923f};
DEV void sincos_d(double a, float& sn, float& cs) {
    const double TWO_PI = 6.283185307179586476925286766559, INV_TWO_PI = 0.15915494309189533576888376337251;
    const double k = __builtin_rint(a * INV_TWO_PI);
    const double r = a - k * TWO_PI;
    const double r2 = r * r;
    double ps = 1.0, pc = 1.0;
#pragma unroll
    for (int i = 14; i >= 1; --i) {
        pc = 1.0 - pc * r2 * (1.0 / (double)((2 * i - 1) * (2 * i)));
        ps = 1.0 - ps * r2 * (1.0 / (double)((2 * i) * (2 * i + 1)));
    }
    sn = (float)(r * ps); cs = (float)pc;
}
DEV void ew_block(const float* __restrict__ W, int N, int k0, int n0, unsigned char* W8, int ldt, int mode, int lane) {
    const int q = lane & 15, kq = lane >> 4;
    const float* src = W + (size_t)(k0 + 16 * kq) * N + n0 + 4 * q;
    f32x4 v[16];
#pragma unroll
    for (int i = 0; i < 16; ++i) v[i] = __builtin_nontemporal_load((const f32x4*)(src + (size_t)i * N));
#pragma unroll
    for (int j = 0; j < 4; ++j) {
        u32x4 o;
        o.x = pk_fp8x4(v[0][j] * WSCALE, v[1][j] * WSCALE, v[2][j] * WSCALE, v[3][j] * WSCALE);
        o.y = pk_fp8x4(v[4][j] * WSCALE, v[5][j] * WSCALE, v[6][j] * WSCALE, v[7][j] * WSCALE);
        o.z = pk_fp8x4(v[8][j] * WSCALE, v[9][j] * WSCALE, v[10][j] * WSCALE, v[11][j] * WSCALE);
        o.w = pk_fp8x4(v[12][j] * WSCALE, v[13][j] * WSCALE, v[14][j] * WSCALE, v[15][j] * WSCALE);
        *(u32x4*)(W8 + (size_t)nmap(mode, n0 + 4 * q + j) * ldt + k0 + 16 * kq) = o;
    }
}
DEV void expert_weight_item(const Ctx& c, int r, float*  ) {
    unsigned char* Wgu8 = c.ws + WS_WGU; unsigned char* Wd8 = c.ws + WS_WD;
    if (r < 2048) { const int e = r >> 6, qq = r & 63, kb = qq >> 2, nb = qq & 3;
        ew_block(c.in[I_WGATE] + (size_t)e * D * DE, DE, 64 * kb, 64 * nb, Wgu8 + (size_t)e * 512 * 1024, 1024, 2, c.lane); return; } r -= 2048;
    if (r < 2048) { const int e = r >> 6, qq = r & 63, kb = qq >> 2, nb = qq & 3;
        ew_block(c.in[I_WUP] + (size_t)e * D * DE, DE, 64 * kb, 64 * nb, Wgu8 + (size_t)e * 512 * 1024, 1024, 3, c.lane); return; } r -= 2048;
    { const int e = r >> 6, qq = r & 63, kb = qq >> 4, nb = qq & 15;
        ew_block(c.in[I_WDOWN] + (size_t)e * DE * D, D, 64 * kb, 64 * nb, Wd8 + (size_t)e * 1024 * 256, 256, 0, c.lane); }
}
DEV void phase0(const Ctx& c) {
    float* scr = (float*)(c.lds + c.wid * 8448);
    const int gw = c.vcu * 4 + c.wid, NGW = c.G * 4;
    constexpr int I_IN = 16 * 53, I_UQ = 6 * 24, I_UKV = 4 * 32, I_O = 16 * 32;
    bf16_t* WinT = (bf16_t*)(c.ws + WS_WIN); bf16_t* WuqT = (bf16_t*)(c.ws + WS_WUQ); bf16_t* WukvT = (bf16_t*)(c.ws + WS_WUKV);
    bf16_t* WoT = (bf16_t*)(c.ws + WS_WO);
    constexpr int NITEMS0 = I_IN + I_UQ + I_UKV + I_O;
    for (int it = gw; it < NITEMS0; it += NGW) {
        int r = it;
        if (r < I_IN) { const int kb = r / 53, nb = r % 53; p0_transpose_item(c.in[I_WIN], NIN, 64 * kb, 32 * nb, nullptr, WinT, 1024, 64 * kb, 1, scr, c.lane); continue; } r -= I_IN;
        if (r < I_UQ) { const int kb = r / 24, nb = r % 24; p0_transpose_item(c.in[I_WUQ], NQ, 64 * kb, 32 * nb, c.in[I_QNG], WuqT, QL, 64 * kb, 0, scr, c.lane); continue; } r -= I_UQ;
        if (r < I_UKV) { const int kb = r / 32, nb = r % 32; p0_transpose_item(c.in[I_WUKV], NKV, 64 * kb, 32 * nb, c.in[I_KVNG], WukvT, KVL, 64 * kb, 0, scr, c.lane); continue; } r -= I_UKV;
        { const int kb = r / 32, nb = r % 32;
            if (kb < 8) p0_transpose_item(c.in[I_WO], D, 64 * kb, 32 * nb, nullptr, WoT, 1024, 64 * kb + 512, 0, scr, c.lane);
            else        p0_transpose_item(c.in[I_WO], D, 64 * kb, 32 * nb, c.in[I_AOUT_G] - 512, WoT, 1024, 64 * kb - 512, 0, scr, c.lane); }
    }
    const int gt = c.vcu * 256 + c.tid, NGT = c.G * 256;
    bf16_t* WrT = (bf16_t*)(c.ws + WS_WR);
    for (int i = gt; i < 48 * 1024; i += NGT) {
        const int n = i >> 10, k = i & 1023; float v = 0.f;
        if (n < 4) v = c.in[I_WRG][k * 4 + n]; else if (n < 36) v = c.in[I_WRE][k * 32 + (n - 4)];
        WrT[i] = (bf16_t)(cvtpk(v, 0.f) & 0xffffu);
    }
    float* rc = (float*)(c.ws + WS_ROPE); float* rs = rc + L * 16;
    for (int i = gt; i < L * 16; i += NGT) {
        const int p = i >> 4, f = i & 15; const float ang = (float)p * INVF[f];
        float sn, cs; sincos_d((double)ang, sn, cs); rc[i] = cs; rs[i] = sn;
    }
    bf16_t* h0 = (bf16_t*)(c.ws + WS_H0);
    for (int t = gw; t < T; t += 2 * NGW) {
        const float* src[2]; bf16_t* dst[2]; unsigned char* ldsn[2] = {nullptr, nullptr};
#pragma unroll
        for (int r = 0; r < 2; ++r) { int tt = t + r * NGW; if (tt >= T) tt = t;
            const int b = tt / L, p = tt - b * L;
            src[r] = (p < NMETA) ? c.in[I_META] + (size_t)p * D : c.in[I_X] + ((size_t)b * SEQ + (p - NMETA)) * D;
            dst[r] = h0 + (size_t)tt * D; }
        ln_rows_bf16<2>(src, c.in[I_LNIN_G], c.in[I_LNIN_B], dst, ldsn, c.lane);
    }
}

struct StageGeo { int r[4]; int c; };
DEV StageGeo stage_geo(int tid) {
    const int lane = tid & 63, wid = tid >> 6; StageGeo g;
    const int rl = lane >> 2, cl = ((lane & 3) * 8) ^ ((lane >> 5) << 4);
#pragma unroll
    for (int i = 0; i < 4; ++i) g.r[i] = (((wid + 4 * i) >> 1) << 4) + rl;
    g.c = ((wid & 1) << 5) + cl;
    return g;
}
template <bool SSQ, bool FP8 = false>
DEV void gemm_mainloop(f32x4 (&acc)[4][4], const bf16_t* ap0, const bf16_t* ap1, const bf16_t* ap2, const bf16_t* ap3,
                       const bf16_t* bp0, const bf16_t* bp1, const bf16_t* bp2, const bf16_t* bp3,
                       int nk, unsigned char* lds, int ssq_steps, float ssq_inv_dim, bool skip_wc1 = false) {
    const int tid = threadIdx.x, lane = tid & 63, wid = tid >> 6, wr = wid >> 1, wc = wid & 1, fr = lane & 15, fq = lane >> 4;
    const int xs = (fr >> 1) & 7;
    const int lo = ((fr * 64 + fq * 16) ^ ((fr >> 3) << 5));
    const int lo0 = lo, lo1 = lo + 1024;
    const int a_off = wr * 8192, b_off = 16384 + wc * 8192;
    const int dst = tid * 16;
#pragma unroll
    for (int m = 0; m < 4; ++m)
#pragma unroll
        for (int n = 0; n < 4; ++n) acc[m][n] = (f32x4){0.f, 0.f, 0.f, 0.f};
    __syncthreads();
#define GLDS(src, off) __builtin_amdgcn_global_load_lds((const unsigned*)(src), (unsigned LAS*)(lds + (off)), 16, 0, 0)
#define STAGE(kt, b) do { const int _k = (kt) * 64; \
        GLDS(ap0 + _k, (b) * 32768 + dst);          GLDS(ap1 + _k, (b) * 32768 + dst + 4096); \
        GLDS(ap2 + _k, (b) * 32768 + dst + 8192);   GLDS(ap3 + _k, (b) * 32768 + dst + 12288); \
        GLDS(bp0 + _k, (b) * 32768 + 16384 + dst);  GLDS(bp1 + _k, (b) * 32768 + 16384 + dst + 4096); \
        GLDS(bp2 + _k, (b) * 32768 + 16384 + dst + 8192); GLDS(bp3 + _k, (b) * 32768 + 16384 + dst + 12288); } while (0)
    STAGE(0, 0);
    for (int kt = 0; kt < nk; ++kt) {
        VM_WAIT();
        __syncthreads();
        const int b = kt & 1;
        if (SSQ && kt == ssq_steps) {
            const float* rsl = (const float*)(lds + RS_OFF);
#pragma unroll
            for (int m = 0; m < 4; ++m) { const float r = rsl[wr * 64 + m * 16 + fr];
#pragma unroll
                for (int n = 0; n < 4; ++n) acc[m][n] = acc[m][n] * r; }
        }
        if (kt + 1 < nk) { if (b) STAGE(kt + 1, 0); else STAGE(kt + 1, 1); }
        const unsigned char* base = lds + b * 32768;
        if (skip_wc1 && wc == 1) {
        } else if (FP8) {
            const int cb0 = fq * 32, cb1 = fq * 32 + 16;
            const int q0 = (cb0 >> 6) * 1024 + ((fr * 64 + (cb0 & 63)) ^ ((fr >> 3) << 5)), q1 = (cb1 >> 6) * 1024 + ((fr * 64 + (cb1 & 63)) ^ ((fr >> 3) << 5));
            v8i ax[4], bx[4];
#pragma unroll
            for (int m = 0; m < 4; ++m) { const u32x4 c0 = *(const u32x4*)(base + a_off + m * 2048 + q0), c1 = *(const u32x4*)(base + a_off + m * 2048 + q1);
                ax[m] = (v8i){(int)c0.x, (int)c0.y, (int)c0.z, (int)c0.w, (int)c1.x, (int)c1.y, (int)c1.z, (int)c1.w}; }
#pragma unroll
            for (int n = 0; n < 4; ++n) { const u32x4 c0 = *(const u32x4*)(base + b_off + n * 2048 + q0), c1 = *(const u32x4*)(base + b_off + n * 2048 + q1);
                bx[n] = (v8i){(int)c0.x, (int)c0.y, (int)c0.z, (int)c0.w, (int)c1.x, (int)c1.y, (int)c1.z, (int)c1.w}; }
#pragma unroll
            for (int m = 0; m < 4; ++m)
#pragma unroll
                for (int n = 0; n < 4; ++n) acc[m][n] = __builtin_amdgcn_mfma_scale_f32_16x16x128_f8f6f4(bx[n], ax[m], acc[m][n], 0, 0, 0, 0x7F7F7F7F, 0, 0x7F7F7F7F);
        } else {
#pragma unroll
        for (int ks = 0; ks < 2; ++ks) {
            bf16x8 af[4], bf[4];
#pragma unroll
            for (int m = 0; m < 4; ++m) af[m] = *(const bf16x8*)(base + a_off + m * 2048 + (ks ? lo1 : lo0));
#pragma unroll
            for (int n = 0; n < 4; ++n) bf[n] = *(const bf16x8*)(base + b_off + n * 2048 + (ks ? lo1 : lo0));
#pragma unroll
            for (int m = 0; m < 4; ++m)
#pragma unroll
                for (int n = 0; n < 4; ++n) acc[m][n] = __builtin_amdgcn_mfma_f32_16x16x32_bf16(bf[n], af[m], acc[m][n], 0, 0, 0);
        }
        }
    }
    if (SSQ && ssq_steps == nk) {
        __syncthreads();
        const float* rsl = (const float*)(lds + RS_OFF);
#pragma unroll
        for (int m = 0; m < 4; ++m) { const float r = rsl[wr * 64 + m * 16 + fr];
#pragma unroll
            for (int n = 0; n < 4; ++n) acc[m][n] = acc[m][n] * r; }
    }
#undef STAGE
#undef GLDS
}

DEV void phase1(const Ctx& c) {
    const bf16_t* h0 = (const bf16_t*)(c.ws + WS_H0); const bf16_t* WinT = (const bf16_t*)(c.ws + WS_WIN);
    bf16_t* U = (bf16_t*)(c.ws + WS_U); bf16_t* CQ = (bf16_t*)(c.ws + WS_CQ); bf16_t* CKV = (bf16_t*)(c.ws + WS_CKV); bf16_t* KR = (bf16_t*)(c.ws + WS_KR);
    const float* rc = (const float*)(c.ws + WS_ROPE); const float* rs = rc + L * 16;
    const StageGeo g = stage_geo(c.tid);
    const int lane = c.lane, wr = c.wid >> 1, wc = c.wid & 1, fr = lane & 15, fq = lane >> 4;
    constexpr int NT = 14, NU = (T / 128) * NT;
    for (int u = c.vcu; u < NU; u += c.G) {
        const int mt = u / NT, nt = u - mt * NT;
        const bf16_t* A = h0 + (size_t)(mt * 128) * D + g.c; const bf16_t* B = WinT + (size_t)(nt * 128) * D + g.c;
        f32x4 acc[4][4];
        gemm_mainloop<false>(acc, A + (size_t)g.r[0] * D, A + (size_t)g.r[1] * D, A + (size_t)g.r[2] * D, A + (size_t)g.r[3] * D,
                             B + (size_t)g.r[0] * D, B + (size_t)g.r[1] * D, B + (size_t)g.r[2] * D, B + (size_t)g.r[3] * D, 16, c.lds, 0, 0.f, nt == 13);
        const int row0 = mt * 128 + wr * 64 + fr;
        if (nt < 8) {
#pragma unroll
            for (int m = 0; m < 4; ++m) { const size_t row = row0 + m * 16;
#pragma unroll
                for (int i = 0; i < 2; ++i) {
                    f32x4 a = acc[m][2 * i], gt = acc[m][2 * i + 1], o;
#pragma unroll
                    for (int j = 0; j < 4; ++j) o[j] = a[j] * sigmoidf_(gt[j]);
                    st_bf4(U + row * CC + nt * 64 + wc * 32 + i * 16 + fq * 4, o);
                } }
        } else if (nt < 13) {
            const bool isq = nt < 11;
            bf16_t* dstb = isq ? CQ + (nt - 8) * 128 + wc * 64 + fq * 4 : CKV + (nt - 11) * 128 + wc * 64 + fq * 4;
            const int ldd = isq ? QL : KVL;
            float* ssb = isq ? (float*)(c.ws + WS_SSQ_CQ) + (nt - 8) * 2 + wc : (float*)(c.ws + WS_SSQ_CKV) + (nt - 11) * 2 + wc;
            const int lds_ = isq ? 8 : 4;
#pragma unroll
            for (int m = 0; m < 4; ++m) { const size_t row = row0 + m * 16; float sq = 0.f;
#pragma unroll
                for (int n = 0; n < 4; ++n) { st_bf4(dstb + row * ldd + n * 16, acc[m][n]);
                    sq += (acc[m][n][0] * acc[m][n][0] + acc[m][n][1] * acc[m][n][1]) + (acc[m][n][2] * acc[m][n][2] + acc[m][n][3] * acc[m][n][3]); }
                sq += __shfl_xor(sq, 16); sq += __shfl_xor(sq, 32);
                if (fq == 0) ssb[row * lds_] = sq; }
        } else if (wc == 0) {
#pragma unroll
            for (int m = 0; m < 4; ++m) { const int row = row0 + m * 16; const int p = row % L;
                const f32x4 cs = *(const f32x4*)(rc + p * 16 + fq * 4), sn = *(const f32x4*)(rs + p * 16 + fq * 4);
                const f32x4 x1 = acc[m][0], x2 = acc[m][1];
                st_bf4(KR + (size_t)row * 32 + fq * 4, x1 * cs - x2 * sn);
                st_bf4(KR + (size_t)row * 32 + 16 + fq * 4, x1 * sn + x2 * cs); }
        }
    }
}

DEV void conv_unit(const Ctx& c, int b, int j) {
    const bf16_t* U = (const bf16_t*)(c.ws + WS_U);
    bf16_t* MG = (bf16_t*)(c.ws + WS_MG);
    const float* cw = c.in[I_CONVW]; const float* cb = c.in[I_CONVB];
    const int p0 = NMETA + j * 32;
    float* ytile = (float*)c.lds;
    __syncthreads();
#pragma unroll 1
    for (int pass = 0; pass < 2; ++pass) {
        const int ch = c.tid + 256 * pass;
        float win[62]; unsigned raw[62];
        const bf16_t* ub = U + (size_t)b * L * CC + ch;
#pragma unroll
        for (int rep = 0; rep < CONV_REPA; ++rep) {
        asm volatile("" : "+v"(ub) :: "memory");
#pragma unroll
        for (int i = 0; i < 62; ++i) { const int p = p0 - 30 + i; const int pc = p < 0 ? 0 : (p >= L ? L - 1 : p); raw[i] = ub[(size_t)pc * CC]; }
        if (rep + 1 < CONV_REPA) {
#pragma unroll
            for (int i = 0; i < 62; ++i) asm volatile("" :: "v"(raw[i]));
        }
        }
        float w[31];
#pragma unroll
        for (int k = 0; k < 31; ++k) w[k] = cw[k * CC + ch];
        float bias = cb[ch];
        __builtin_amdgcn_sched_barrier(0);
#pragma unroll
        for (int i = 0; i < 62; ++i) { const int p = p0 - 30 + i; win[i] = (p >= 0 && p < L) ? __uint_as_float(raw[i] << 16) : 0.f; }
#pragma unroll
        for (int rep = 0; rep < CONV_REPB; ++rep) {
        asm volatile("" : "+v"(bias) :: "memory");
#pragma unroll
        for (int tt = 0; tt < 32; ++tt) {
            float a0 = bias;
#pragma unroll
            for (int k = 0; k < 31; ++k) a0 += w[k] * win[tt + k];
            ytile[tt * 512 + ch] = a0;
        }
        }
    }
    __syncthreads();
    const float* g1 = c.in[I_CLN_G]; const float* b1 = c.in[I_CLN_B]; const float* g2 = c.in[I_COUT_G];
    float G1[8], B1[8], G2[8];
    { const f32x4 a = *(const f32x4*)(g1 + c.lane * 8), bq = *(const f32x4*)(g1 + c.lane * 8 + 4); G1[0]=a.x;G1[1]=a.y;G1[2]=a.z;G1[3]=a.w;G1[4]=bq.x;G1[5]=bq.y;G1[6]=bq.z;G1[7]=bq.w; }
    { const f32x4 a = *(const f32x4*)(b1 + c.lane * 8), bq = *(const f32x4*)(b1 + c.lane * 8 + 4); B1[0]=a.x;B1[1]=a.y;B1[2]=a.z;B1[3]=a.w;B1[4]=bq.x;B1[5]=bq.y;B1[6]=bq.z;B1[7]=bq.w; }
    { const f32x4 a = *(const f32x4*)(g2 + c.lane * 8), bq = *(const f32x4*)(g2 + c.lane * 8 + 4); G2[0]=a.x;G2[1]=a.y;G2[2]=a.z;G2[3]=a.w;G2[4]=bq.x;G2[5]=bq.y;G2[6]=bq.z;G2[7]=bq.w; }
#pragma unroll
    for (int rep = 0; rep < CONV_REPC; ++rep) {
    asm volatile("" : "+v"(ytile) :: "memory");
    float v[8][8]; float st[8];
#pragma unroll
    for (int i = 0; i < 8; ++i) { const int tt = c.wid * 8 + i;
        const f32x4 ya = *(const f32x4*)(ytile + tt * 512 + c.lane * 8), yb = *(const f32x4*)(ytile + tt * 512 + c.lane * 8 + 4);
        v[i][0]=ya.x;v[i][1]=ya.y;v[i][2]=ya.z;v[i][3]=ya.w;v[i][4]=yb.x;v[i][5]=yb.y;v[i][6]=yb.z;v[i][7]=yb.w;
        st[i] = ((v[i][0] + v[i][1]) + (v[i][2] + v[i][3])) + ((v[i][4] + v[i][5]) + (v[i][6] + v[i][7])); }
    wave_sum_n<8>(st);
#pragma unroll
    for (int i = 0; i < 8; ++i) { const float mean = st[i] * (1.f / 512.f); float a = 0.f;
#pragma unroll
        for (int q = 0; q < 8; ++q) { v[i][q] -= mean; a += v[i][q] * v[i][q]; }
        st[i] = a; }
    wave_sum_n<8>(st);
#pragma unroll
    for (int i = 0; i < 8; ++i) { const float rstd = rsqrt_(st[i] * (1.f / 512.f) + EPS); float a = 0.f;
#pragma unroll
        for (int q = 0; q < 8; ++q) { const float x = v[i][q] * rstd * G1[q] + B1[q]; const float y = x * sigmoidf_(x); v[i][q] = y; a += y * y; }
        st[i] = a; }
    wave_sum_n<8>(st);
#pragma unroll
    for (int i = 0; i < 8; ++i) {
        const int p = p0 + c.wid * 8 + i;
        {
            const float r2 = rsqrt_(st[i] * (1.f / 512.f) + EPS);
            u32x4 o;
            o.x = cvtpk(v[i][0] * r2 * G2[0], v[i][1] * r2 * G2[1]); o.y = cvtpk(v[i][2] * r2 * G2[2], v[i][3] * r2 * G2[3]);
            o.z = cvtpk(v[i][4] * r2 * G2[4], v[i][5] * r2 * G2[5]); o.w = cvtpk(v[i][6] * r2 * G2[6], v[i][7] * r2 * G2[7]);
            const size_t tok = (size_t)b * SEQ + (p - NMETA);
            bf16_t* dstp = (p >= NMETA && p < L) ? MG + tok * D + 512 + c.lane * 8 : (bf16_t*)(c.ws + WS_DUMMY) + c.lane * 8;
            *(u32x4*)dstp = o;
        }
    }
    }
}
DEV void rope4(f32x4& x1, f32x4& x2, const float* rc, const float* rs, int p, int fq) {
    const f32x4 cs = *(const f32x4*)(rc + p * 16 + fq * 4), sn = *(const f32x4*)(rs + p * 16 + fq * 4);
    const f32x4 a = x1 * cs - x2 * sn, bb = x1 * sn + x2 * cs; x1 = a; x2 = bb;
}
DEV void phase2(const Ctx& c) {
    const bf16_t* CQ = (const bf16_t*)(c.ws + WS_CQ); const bf16_t* CKV = (const bf16_t*)(c.ws + WS_CKV);
    const bf16_t* WuqT = (const bf16_t*)(c.ws + WS_WUQ); const bf16_t* WukvT = (const bf16_t*)(c.ws + WS_WUKV);
    bf16_t* Q = (bf16_t*)(c.ws + WS_Q); bf16_t* KV = (bf16_t*)(c.ws + WS_KV);
    const float* rc = (const float*)(c.ws + WS_ROPE); const float* rs = rc + L * 16;
    const StageGeo g = stage_geo(c.tid);
    const int lane = c.lane, wr = c.wid >> 1, wc = c.wid & 1, fr = lane & 15, fq = lane >> 4;
    constexpr int NUC = NB * 64, NUQ = (TR / 128) * 6, NUKV = (TR / 128) * 8 + 8, NU = NUC + NUQ + NUKV;
    const int li = c.vcu & 63, rev = ((li >> 5) ^ li) & 1;
    const int nmine = (NU - c.vcu + c.G - 1) / c.G;
    for (int it = 0; it < nmine; ++it) {
        const int u = c.vcu + (rev ? (nmine - 1 - it) : it) * c.G;
        if (u < NUC) {
            conv_unit(c, u >> 6, u & 63);
        } else if (u < NUC + NUQ) {
            const int v = u - NUC, mt = v / 6, nt = v - mt * 6;
            const size_t t0 = (size_t)(mt >> 4) * L + NMETA + (mt & 15) * 128;
            const bf16_t* A = CQ + t0 * QL + g.c; const bf16_t* B = WuqT + (size_t)(nt * 128) * QL + g.c;
            f32x4 acc[4][4];
            __syncthreads();
            if (c.tid < 128) { const float* pp = (const float*)(c.ws + WS_SSQ_CQ) + (t0 + c.tid) * 8; const f32x4 p4 = *(const f32x4*)pp; const float2 p2 = *(const float2*)(pp + 4);
                ((float*)(c.lds + RS_OFF))[c.tid] = rsqrt_((((p4.x + p4.y) + (p4.z + p4.w)) + (p2.x + p2.y)) * (1.f / 384.f) + EPS); }
            gemm_mainloop<true>(acc, A + (size_t)g.r[0] * QL, A + (size_t)g.r[1] * QL, A + (size_t)g.r[2] * QL, A + (size_t)g.r[3] * QL,
                                B + (size_t)g.r[0] * QL, B + (size_t)g.r[1] * QL, B + (size_t)g.r[2] * QL, B + (size_t)g.r[3] * QL, 6, c.lds, 6, 1.f / 384.f);
            const int p0 = NMETA + (mt & 15) * 128 + wr * 64 + fr;
            const int t16 = (nt * 8 + wc * 4) % 6;
#pragma unroll
            for (int m = 0; m < 4; ++m) { const size_t row = t0 + wr * 64 + m * 16 + fr; const int p = p0 + m * 16;
#pragma unroll
                for (int n = 0; n < 4; ++n) acc[m][n] = acc[m][n] * QSCALE;
                if (t16 == 4) rope4(acc[m][0], acc[m][1], rc, rs, p, fq);
                if (t16 == 2) rope4(acc[m][2], acc[m][3], rc, rs, p, fq);
#pragma unroll
                for (int n = 0; n < 4; ++n) st_bf4(Q + row * NQ + nt * 128 + wc * 64 + n * 16 + fq * 4, acc[m][n]); }
        } else {
            const int v = u - NUC - NUQ; const bool meta = v >= (TR / 128) * 8;
            const int mt = meta ? 0 : v >> 3, nt = meta ? v - (TR / 128) * 8 : v & 7;
            const size_t t0 = meta ? 0 : (size_t)(mt >> 4) * L + NMETA + (mt & 15) * 128;
            const int rmask = meta ? 15 : 127;
            const bf16_t* A = CKV + t0 * KVL + g.c; const bf16_t* B = WukvT + (size_t)(nt * 128) * KVL + g.c;
            f32x4 acc[4][4];
            __syncthreads();
            if (c.tid < 128) { const f32x4 p4 = *(const f32x4*)((const float*)(c.ws + WS_SSQ_CKV) + (t0 + (c.tid & rmask)) * 4);
                ((float*)(c.lds + RS_OFF))[c.tid] = rsqrt_(((p4.x + p4.y) + (p4.z + p4.w)) * (1.f / 256.f) + EPS); }
            gemm_mainloop<true>(acc, A + (size_t)(g.r[0] & rmask) * KVL, A + (size_t)(g.r[1] & rmask) * KVL, A + (size_t)(g.r[2] & rmask) * KVL, A + (size_t)(g.r[3] & rmask) * KVL,
                                B + (size_t)g.r[0] * KVL, B + (size_t)g.r[1] * KVL, B + (size_t)g.r[2] * KVL, B + (size_t)g.r[3] * KVL, 4, c.lds, 4, 1.f / 256.f);
            if (!meta) {
#pragma unroll
                for (int m = 0; m < 4; ++m) { const size_t row = t0 + wr * 64 + m * 16 + fr;
#pragma unroll
                    for (int n = 0; n < 4; ++n) st_bf4(KV + row * NKV + nt * 128 + wc * 64 + n * 16 + fq * 4, acc[m][n]); }
            } else if (wr == 0) {
#pragma unroll 1
                for (int bb = 0; bb < NB; ++bb) {
#pragma unroll
                    for (int n = 0; n < 4; ++n) st_bf4(KV + ((size_t)bb * L + fr) * NKV + nt * 128 + wc * 64 + n * 16 + fq * 4, acc[0][n]); }
            }
        }
    }
}
DEV int crow(int r, int hi) { return (r & 3) + 8 * (r >> 2) + 4 * hi; }
#define KSWZ(row, colB) ((row) * 256 + ((colB) ^ (((row) & 7) << 4)))
#define SBAR() __builtin_amdgcn_sched_barrier(0)
DEV int v_st(int k, int cc) { const int kk = (k & ~0xC) | ((k & 4) << 1) | ((k & 8) >> 1); return ((kk >> 3) * 4 + (cc >> 5)) * 512 + ((kk & 7) * 32 + (cc & 31)) * 2; }
DEV int v_rd_base(int lane) { return ((lane & 3) << 3) | (((lane >> 2) & 3) << 6) | (((lane >> 4) & 1) << 5) | (((lane >> 5) & 1) << 8); }
constexpr int v_rd_off(int d0, int ks, int half) { return d0 * 512 + ks * 4096 + half * 2048; }
template <int OFF> DEV s16x4 tr_read(int vb) { s16x4 r; asm volatile("ds_read_b64_tr_b16 %0, %1 offset:%2" : "=&v"(r) : "v"(vb), "i"(OFF) : "memory"); return r; }
template <int D0> DEV void pv_one(f32x16& od, int vb, bf16x8 pa0, bf16x8 pa1, bf16x8 pa2, bf16x8 pa3) {
    const s16x4 l0 = tr_read<v_rd_off(D0, 0, 0)>(vb), h0 = tr_read<v_rd_off(D0, 0, 1)>(vb), l1 = tr_read<v_rd_off(D0, 1, 0)>(vb), h1 = tr_read<v_rd_off(D0, 1, 1)>(vb);
    const s16x4 l2 = tr_read<v_rd_off(D0, 2, 0)>(vb), h2 = tr_read<v_rd_off(D0, 2, 1)>(vb), l3 = tr_read<v_rd_off(D0, 3, 0)>(vb), h3 = tr_read<v_rd_off(D0, 3, 1)>(vb);
    asm volatile("s_waitcnt lgkmcnt(0)" ::: "memory"); SBAR();
#define PK(Lo, Hi) (bf16x8){Lo[0], Lo[1], Lo[2], Lo[3], Hi[0], Hi[1], Hi[2], Hi[3]}
    od = __builtin_amdgcn_mfma_f32_32x32x16_bf16(pa0, PK(l0, h0), od, 0, 0, 0);
    od = __builtin_amdgcn_mfma_f32_32x32x16_bf16(pa1, PK(l1, h1), od, 0, 0, 0);
    od = __builtin_amdgcn_mfma_f32_32x32x16_bf16(pa2, PK(l2, h2), od, 0, 0, 0);
    od = __builtin_amdgcn_mfma_f32_32x32x16_bf16(pa3, PK(l3, h3), od, 0, 0, 0);
#undef PK
}
constexpr float ATT_THR = 8.f;
constexpr int AT_V = 0, AT_K = 32768, AT_WS = 65536;
DEV void attn_unit(const Ctx& c, int b, int h, int qb) {
    const bf16_t* Q = (const bf16_t*)(c.ws + WS_Q); const bf16_t* KV = (const bf16_t*)(c.ws + WS_KV); const bf16_t* KR = (const bf16_t*)(c.ws + WS_KR);
    bf16_t* MG = (bf16_t*)(c.ws + WS_MG);
    unsigned char* lds = c.lds;
    const int tid = c.tid, wid = c.wid, lane = c.lane, r32 = lane & 31, hi = lane >> 5;
    float* wsf = (float*)(lds + AT_WS) + wid * 64; float* li_l = wsf; float* al_l = wsf + 32;
    const int NT = 2 * qb + 3;
    const int my_last = 2 * qb + (wid >> 1) + 1;
    bf16x8 qr[6];
    { const size_t t = (size_t)b * L + NMETA + qb * 128 + wid * 32 + r32;
      const bf16_t* Qw = Q + t * NQ + h * DQK + hi * 8;
#pragma unroll
      for (int d0 = 0; d0 < 6; ++d0) qr[d0] = *(const bf16x8*)(Qw + d0 * 16); }
    const int srow = tid >> 2, sq = tid & 3;
    const int vst0 = v_st(srow, sq * 16), vst1 = v_st(srow, sq * 16 + 8);
    const int kst0 = KSWZ(srow, sq * 32), kst1 = KSWZ(srow, sq * 32 + 16), kst2 = KSWZ(srow, 128 + sq * 16);
    const int vb0 = (int)(uintptr_t)(lds + AT_V) + v_rd_base(lane);
    u32x4 sk0, sk1, sk2, sv0, sv1;
#define SLOAD(j) do { int pos = (j) * 64 + srow - 48; pos = pos < 0 ? 0 : pos; const size_t tk = (size_t)b * L + pos; \
        const bf16_t* kvp = KV + tk * NKV + h * 128 + sq * 16; \
        sk0 = *(const u32x4*)(kvp); sk1 = *(const u32x4*)(kvp + 8); sv0 = *(const u32x4*)(kvp + 64); sv1 = *(const u32x4*)(kvp + 72); \
        sk2 = *(const u32x4*)(KR + tk * 32 + sq * 8); } while (0)
#define SWRITE(bb) do { unsigned char* kb = lds + AT_K + (bb) * 16384; unsigned char* vbp = lds + AT_V + (bb) * 16384; \
        *(u32x4*)(kb + kst0) = sk0; *(u32x4*)(kb + kst1) = sk1; *(u32x4*)(kb + kst2) = sk2; *(u32x4*)(vbp + vst0) = sv0; *(u32x4*)(vbp + vst1) = sv1; } while (0)
    float m_reg = 0.f, l_reg = 0.f; f32x16 o[2] = {};
    __syncthreads();
    SLOAD(0); SWRITE(0); __syncthreads();
    for (int j = 0; j < NT; ++j) {
        const int bsel = j & 1;
        if (j + 1 < NT) SLOAD(j + 1);
        if (j <= my_last) {
            const unsigned char* Ks = lds + AT_K + bsel * 16384;
            f32x16 p0, p1;
            { const float nm = -m_reg;
#pragma unroll
              for (int r = 0; r < 16; ++r) { p0[r] = nm; p1[r] = nm; } }
            __builtin_amdgcn_s_setprio(1);
#pragma unroll
            for (int d0 = 0; d0 < 6; ++d0) { const int cb = (d0 * 16 + hi * 8) * 2;
                const bf16x8 k0 = *(const bf16x8*)(Ks + KSWZ(r32, cb)); const bf16x8 k1 = *(const bf16x8*)(Ks + KSWZ(32 + r32, cb));
                p0 = __builtin_amdgcn_mfma_f32_32x32x16_bf16(k0, qr[d0], p0, 0, 0, 0);
                p1 = __builtin_amdgcn_mfma_f32_32x32x16_bf16(k1, qr[d0], p1, 0, 0, 0); }
            __builtin_amdgcn_s_setprio(0);
            if (j == 0) {
#pragma unroll
                for (int r = 0; r < 16; ++r) p0[r] = -1e30f;
#pragma unroll
                for (int r = 0; r < 8; ++r) p1[r] = -1e30f;
            }
            float pmax = fmaxf(fmaxf(p0[0], p0[1]), p0[2]);
#pragma unroll
            for (int r = 3; r < 15; r += 2) pmax = fmaxf(fmaxf(pmax, p0[r]), p0[r + 1]);
            pmax = fmaxf(fmaxf(pmax, p0[15]), p1[0]);
#pragma unroll
            for (int r = 1; r < 15; r += 2) pmax = fmaxf(fmaxf(pmax, p1[r]), p1[r + 1]);
            pmax = fmaxf(pmax, p1[15]);
            { auto rr = __builtin_amdgcn_permlane32_swap(__float_as_uint(pmax), __float_as_uint(pmax), false, false);
              pmax = fmaxf(__uint_as_float(rr[0]), __uint_as_float(rr[1])); }
            float ps = 0.f;
            if (__any(pmax > ATT_THR)) {
                const float dm = fmaxf(pmax, 0.f), alpha = fast_exp2(-dm); m_reg += dm;
#pragma unroll
                for (int r = 0; r < 16; ++r) { p0[r] -= dm; p1[r] -= dm; }
                l_reg *= alpha;
                if (hi == 0) al_l[r32] = alpha;
                asm volatile("s_waitcnt lgkmcnt(0)" ::: "memory");
#pragma unroll
                for (int r = 0; r < 16; ++r) { const float a = al_l[crow(r, hi)]; o[0][r] *= a; o[1][r] *= a; }
            }
#pragma unroll
            for (int r = 0; r < 16; ++r) { p0[r] = fast_exp2(p0[r]); ps += p0[r]; }
#pragma unroll
            for (int r = 0; r < 16; ++r) { p1[r] = fast_exp2(p1[r]); ps += p1[r]; }
            { auto rr = __builtin_amdgcn_permlane32_swap(__float_as_uint(ps), __float_as_uint(ps), false, false);
              ps = __uint_as_float(rr[0]) + __uint_as_float(rr[1]); }
            l_reg += ps;
            bf16x8 pa0, pa1, pa2, pa3;
#define PK4(P, BASE, OUT) do { unsigned a0 = cvtpk(P[BASE + 0], P[BASE + 1]), a1 = cvtpk(P[BASE + 2], P[BASE + 3]);   \
    unsigned b0 = cvtpk(P[BASE + 4], P[BASE + 5]), b1 = cvtpk(P[BASE + 6], P[BASE + 7]);                              \
    auto r0 = __builtin_amdgcn_permlane32_swap(a0, b0, false, false); auto r1 = __builtin_amdgcn_permlane32_swap(a1, b1, false, false); \
    u32x4 w = {r0[0], r1[0], r0[1], r1[1]}; OUT = *reinterpret_cast<bf16x8*>(&w); } while (0)
            PK4(p0, 0, pa0); PK4(p0, 8, pa1); PK4(p1, 0, pa2); PK4(p1, 8, pa3);
#undef PK4
            const int vb = vb0 + bsel * 16384;
            __builtin_amdgcn_s_setprio(1);
            pv_one<0>(o[0], vb, pa0, pa1, pa2, pa3); pv_one<1>(o[1], vb, pa0, pa1, pa2, pa3);
            __builtin_amdgcn_s_setprio(0);
        }
        if (j + 1 < NT) { if (bsel) SWRITE(0); else SWRITE(1); }
        __syncthreads();
    }
    if (hi == 0) li_l[r32] = l_reg;
    asm volatile("s_waitcnt lgkmcnt(0)" ::: "memory");
    const size_t tok0 = (size_t)b * SEQ + qb * 128 + wid * 32;
    float* SSO = (float*)(c.ws + WS_SSQ_O);
#pragma unroll
    for (int r = 0; r < 16; ++r) {
        const int orow = crow(r, hi); const float rl = fast_rcp(li_l[orow]);
        bf16_t* dst = MG + (tok0 + orow) * D + h * DV + r32;
        const float a0 = o[0][r] * rl, a1 = o[1][r] * rl;
        dst[0]  = (bf16_t)(cvtpk(a0, 0.f) & 0xffffu);
        dst[32] = (bf16_t)(cvtpk(a1, 0.f) & 0xffffu);
        float sq = a0 * a0 + a1 * a1;
        sq += dpp_mov<0xB1>(sq); sq += dpp_mov<0x4E>(sq); sq += dpp_mov<0x141>(sq); sq += dpp_mov<0x140>(sq);
        sq += __shfl_xor(sq, 16);
        if (r32 == 0) SSO[(tok0 + orow) * 8 + h] = sq;
    }
#undef SLOAD
#undef SWRITE
}
DEV void phase3(const Ctx& c) {
    const int nslots = NB * NH * 4;
    float* scr = (float*)(c.lds + c.wid * 8448);
    const int gw = c.vcu * 4 + c.wid, NGW = c.G * 4;
    constexpr int NWI = 6144;
    int wi = gw;
#define EW_ITEMS(n) do { __syncthreads(); for (int _q = 0; _q < (n) && wi < NWI; ++_q, wi += NGW) expert_weight_item(c, wi, scr); } while (0)
    for (int v = c.vcu; v < nslots; v += c.G) {
        const int bh = v >> 2, s = v & 3, b = bh >> 3, h = bh & 7;
        attn_unit(c, b, h, 15 - s); EW_ITEMS(1); attn_unit(c, b, h, s); EW_ITEMS(1); attn_unit(c, b, h, 11 - s); EW_ITEMS(1); attn_unit(c, b, h, 4 + s);
    }
    __syncthreads();
    for (; wi < NWI; wi += NGW) expert_weight_item(c, wi, scr);
#undef EW_ITEMS
}

DEV void phase4(const Ctx& c) {
    const bf16_t* MG = (const bf16_t*)(c.ws + WS_MG); const bf16_t* WoT = (const bf16_t*)(c.ws + WS_WO); const bf16_t* h0 = (const bf16_t*)(c.ws + WS_H0);
    bf16_t* R1 = (bf16_t*)(c.ws + WS_R1);
    const StageGeo g = stage_geo(c.tid);
    const int lane = c.lane, wr = c.wid >> 1, wc = c.wid & 1, fr = lane & 15, fq = lane >> 4;
    constexpr int NU = (TR / 128) * 8;
    const float* SSO = (const float*)(c.ws + WS_SSQ_O);
    f32x4 pa = {1.f, 1.f, 1.f, 1.f}, pb = pa;
    if (c.vcu < NU && c.tid < 128) { const float* pp = SSO + (size_t)((c.vcu >> 3) * 128 + c.tid) * 8; pa = *(const f32x4*)pp; pb = *(const f32x4*)(pp + 4); }
    for (int u = c.vcu; u < NU; u += c.G) {
        const int mt = u >> 3, nt = u & 7;
        const bf16_t* A = MG + (size_t)(mt * 128) * D + g.c; const bf16_t* B = WoT + (size_t)(nt * 128) * D + g.c;
        f32x4 acc[4][4];
        __syncthreads();
        if (c.tid < 128) ((float*)(c.lds + RS_OFF))[c.tid] = rsqrt_((((pa.x + pa.y) + (pa.z + pa.w)) + ((pb.x + pb.y) + (pb.z + pb.w))) * (1.f / 512.f) + EPS);
        { const int un = u + c.G; if (un < NU && c.tid < 128) { const float* pp = SSO + (size_t)((un >> 3) * 128 + c.tid) * 8; pa = *(const f32x4*)pp; pb = *(const f32x4*)(pp + 4); } }
        u32x2 hw[4][4];
#pragma unroll
        for (int m = 0; m < 4; ++m) {
            const int tok = mt * 128 + wr * 64 + m * 16 + fr;
            const size_t t = (size_t)(tok >> 11) * L + NMETA + (tok & 2047);
#pragma unroll
            for (int n = 0; n < 4; ++n) hw[m][n] = *(const u32x2*)(h0 + t * D + nt * 128 + wc * 64 + n * 16 + fq * 4);
        }
        gemm_mainloop<true>(acc, A + (size_t)g.r[0] * D, A + (size_t)g.r[1] * D, A + (size_t)g.r[2] * D, A + (size_t)g.r[3] * D,
                            B + (size_t)g.r[0] * D, B + (size_t)g.r[1] * D, B + (size_t)g.r[2] * D, B + (size_t)g.r[3] * D, 16, c.lds, 8, 1.f / 512.f);
#pragma unroll
        for (int m = 0; m < 4; ++m) {
            const int tok = mt * 128 + wr * 64 + m * 16 + fr;
#pragma unroll
            for (int n = 0; n < 4; ++n) {
                const int col = nt * 128 + wc * 64 + n * 16 + fq * 4;
                f32x4 o; o[0] = ALPHA * bflo(hw[m][n].x) + acc[m][n][0]; o[1] = ALPHA * bfhi(hw[m][n].x) + acc[m][n][1];
                o[2] = ALPHA * bflo(hw[m][n].y) + acc[m][n][2]; o[3] = ALPHA * bfhi(hw[m][n].y) + acc[m][n][3];
                st_bf4(R1 + (size_t)tok * D + col, o);
            }
        }
    }
}

constexpr int P5_ROWB = 2064, P5_PART = 33280, P5_LG = 45568, P5_BIAS = 48128, P5_AGG = 48384;
DEV void phase5(const Ctx& c, int ALT = 0) {
    const bf16_t* R1 = (const bf16_t*)(c.ws + WS_R1);
    const bf16_t* WrT = (const bf16_t*)(c.ws + WS_WR);
    unsigned* cnt = (unsigned*)(c.ws + WS_CTL) + CW_CNT + ALT * 32; unsigned* list = (unsigned*)(c.ws + (ALT ? 404 * MiB : WS_LIST)); float* combw = (float*)(c.ws + WS_COMBW);
    const int lane = c.lane, wid = c.wid, fr = lane & 15, fq = lane >> 4;
    float* part = (float*)(c.lds + P5_PART); float* lgs = (float*)(c.lds + P5_LG); float* biasl = (float*)(c.lds + P5_BIAS);
    __syncthreads();
    if (c.tid < 36) biasl[c.tid] = (c.tid < 4) ? c.in[I_BRG][c.tid] : c.in[I_BRE][c.tid - 4];
    bf16x8 wf[8][3];
#pragma unroll
    for (int ks = 0; ks < 8; ++ks)
#pragma unroll
        for (int n = 0; n < 3; ++n) wf[ks][n] = *(const bf16x8*)(WrT + (size_t)(n * 16 + fr) * D + wid * 256 + ks * 32 + fq * 8);
    unsigned* lcnt = (unsigned*)(c.lds + P5_AGG); unsigned* lbase = lcnt + 32; unsigned* ent = lcnt + 64;
    if (c.tid < 32) lcnt[c.tid] = 0u;
    int nent = 0;
    for (int u = c.vcu; u < TR / 16; u += c.G) {
        const int tok0 = u * 16;
        { const float* src[4]; bf16_t* dst[4]; unsigned char* ldsn[4]; unsigned char* f8n[4]; float* stn[4];
#pragma unroll
          for (int i = 0; i < 4; ++i) { const int tl = wid * 4 + i; const size_t tok = tok0 + tl; src[i] = (const float*)(R1 + tok * D); dst[i] = nullptr; ldsn[i] = c.lds + tl * P5_ROWB; f8n[i] = c.ws + WS_H1F8 + tok * D;
              stn[i] = (float*)(c.ws + WS_ST1) + tok * 2; }
          ln_rows_bf16<4, true, true, true>(src, c.in[I_LN1G], c.in[I_LN1B], dst, ldsn, lane, f8n, stn); }
        __syncthreads();
        f32x4 acc[3] = {};
#pragma unroll
        for (int ks = 0; ks < 8; ++ks) {
            const int k = wid * 256 + ks * 32 + fq * 8;
            const bf16x8 a = *(const bf16x8*)(c.lds + fr * P5_ROWB + k * 2);
#pragma unroll
            for (int n = 0; n < 3; ++n) acc[n] = __builtin_amdgcn_mfma_f32_16x16x32_bf16(wf[ks][n], a, acc[n], 0, 0, 0);
        }
#pragma unroll
        for (int n = 0; n < 3; ++n) *(f32x4*)(part + (wid * 16 + fr) * 48 + n * 16 + fq * 4) = acc[n];
        __syncthreads();
#pragma unroll
        for (int i = 0; i < 3; ++i) { const int idx = c.tid + 256 * i;
            if (idx < 576) { const int tk = idx / 36, l = idx - tk * 36;
                lgs[tk * 40 + l] = ((part[tk * 48 + l] + part[(16 + tk) * 48 + l]) + (part[(32 + tk) * 48 + l] + part[(48 + tk) * 48 + l])) + biasl[l]; } }
        __syncthreads();
        if (c.tid < 16) {
            const float* lg = lgs + c.tid * 40;
            int gi = 0; float gm = lg[0];
#pragma unroll
            for (int i = 1; i < 4; ++i) { const float v = lg[i]; if (v > gm) { gm = v; gi = i; } }
            float gs = 0.f;
#pragma unroll
            for (int i = 0; i < 4; ++i) gs += __expf(lg[i] - gm);
            const float gw = 1.f / gs;
            const float* le = lg + 4 + gi * 8;
            float v0 = le[0], v1 = -3.0e38f; int i0 = 0, i1 = 0;
#pragma unroll
            for (int i = 1; i < 8; ++i) { const float v = le[i];
                if (v > v0) { v1 = v0; i1 = i0; v0 = v; i0 = i; } else if (v > v1) { v1 = v; i1 = i; } }
            const float ex = __expf(v1 - v0), inv = 1.f / (1.f + ex);
            const int tok = tok0 + c.tid; const unsigned e0 = gi * 8 + i0, e1 = gi * 8 + i1;
            combw[tok * 2] = gw * inv; combw[tok * 2 + 1] = gw * ex * inv;
            const unsigned r0 = atomicAdd(&lcnt[e0], 1u), r1 = atomicAdd(&lcnt[e1], 1u);
            const int ei = nent * 32 + c.tid * 2;
            ent[2 * ei] = (unsigned)(tok * 2);         ent[2 * ei + 1] = (e0 << 16) | r0;
            ent[2 * ei + 2] = (unsigned)(tok * 2 + 1); ent[2 * ei + 3] = (e1 << 16) | r1;
        }
        ++nent;
    }
    __syncthreads();
    if (c.tid < 32) { const unsigned n = lcnt[c.tid]; lbase[c.tid] = n ? atomicAdd(&cnt[c.tid * CNT_STRIDE], n) : 0u; }
    __syncthreads();
    for (int i = c.tid; i < nent * 32; i += 256) { const unsigned t2 = ent[2 * i], er = ent[2 * i + 1]; const unsigned e = er >> 16;
        list[(size_t)e * TR + lbase[e] + (er & 0xffffu)] = t2; }
}
DEV void bar20(const Ctx& c) {}
DEV void moe_tiles(const Ctx& c) {
    const unsigned* cnt = (const unsigned*)(c.ws + WS_CTL) + CW_CNT; int* ts = (int*)(c.lds + EXP_OFF);
    __syncthreads();
    if (c.tid < NE) ts[40 + c.tid] = (int)__hip_atomic_load(&cnt[c.tid * CNT_STRIDE], __ATOMIC_RELAXED, __HIP_MEMORY_SCOPE_AGENT);
    __syncthreads();
    if (c.tid == 0) { int s = 0; for (int e = 0; e < NE; ++e) { ts[e] = s; s += (ts[40 + e] + 127) >> 7; } ts[NE] = s; }
    __syncthreads();
}
DEV void phase6a(const Ctx& c) {
    const bf16_t* H18 = (const bf16_t*)(c.ws + WS_H1F8); const bf16_t* Wgu8 = (const bf16_t*)(c.ws + WS_WGU); unsigned char* ACT8 = c.ws + WS_ACT;
    const unsigned* list = (const unsigned*)(c.ws + WS_LIST);
    moe_tiles(c);
    const int* ts = (const int*)(c.lds + EXP_OFF); unsigned* tbl = (unsigned*)(c.lds + TBL_OFF);
    const StageGeo g = stage_geo(c.tid);
    const int lane = c.lane, wr = c.wid >> 1, wc = c.wid & 1, fr = lane & 15, fq = lane >> 4;
    const int NU = ts[NE] * 4;
    u32x2* RI = (u32x2*)(c.ws + WS_RI); const float* combw = (const float*)(c.ws + WS_COMBW);
    int e = 0, en_e = 0; unsigned en_cur = 0xffffffffu;
    { const int u0 = c.vcu; if (u0 < NU) { const int rt0 = u0 >> 2; while (ts[en_e + 1] <= rt0) ++en_e;
        if (c.tid < 128) { const int j = (rt0 - ts[en_e]) * 128 + c.tid; en_cur = (j < ts[40 + en_e]) ? list[(size_t)en_e * TR + j] : 0xffffffffu; } } }
    for (int u = c.vcu; u < NU; u += c.G) {
        const int rt = u >> 2, nt = u & 3;
        e = en_e;
        __syncthreads();
        float wri = 0.f;
        if (c.tid < 128) { tbl[c.tid] = en_cur; if (nt == 0 && en_cur != 0xffffffffu) wri = combw[en_cur]; }
        const unsigned en_this = en_cur;
        { const int un = u + c.G; if (un < NU) { const int rtn = un >> 2; while (ts[en_e + 1] <= rtn) ++en_e;
            if (c.tid < 128) { const int j = (rtn - ts[en_e]) * 128 + c.tid; en_cur = (j < ts[40 + en_e]) ? list[(size_t)en_e * TR + j] : 0xffffffffu; } } }
        __syncthreads();
        size_t ro[4];
#pragma unroll
        for (int i = 0; i < 4; ++i) { const unsigned en = tbl[g.r[i]]; ro[i] = (en == 0xffffffffu) ? 0 : (size_t)(en >> 1) * (D / 2); }
        const bf16_t* A = H18 + g.c; const bf16_t* B = Wgu8 + ((size_t)e * 512 + nt * 128) * (D / 2) + g.c;
        f32x4 acc[4][4];
        gemm_mainloop<false, true>(acc, A + ro[0], A + ro[1], A + ro[2], A + ro[3],
                             B + (size_t)g.r[0] * (D / 2), B + (size_t)g.r[1] * (D / 2), B + (size_t)g.r[2] * (D / 2), B + (size_t)g.r[3] * (D / 2), 8, c.lds, 0, 0.f);
#pragma unroll
        for (int m = 0; m < 4; ++m) { const size_t row = (size_t)rt * 128 + wr * 64 + m * 16 + fr;
#pragma unroll
            for (int i = 0; i < 2; ++i) {
                const f32x4 gt = acc[m][2 * i], up = acc[m][2 * i + 1]; f32x4 o;
#pragma unroll
                for (int j = 0; j < 4; ++j) { const float gv = gt[j] * WUNSCALE; o[j] = gv * sigmoidf_(gv) * (up[j] * WUNSCALE); }
                *(unsigned*)(ACT8 + row * DE + nt * 64 + wc * 32 + i * 16 + fq * 4) = pk_fp8x4(o[0], o[1], o[2], o[3]);
            } }
        if (nt == 0 && c.tid < 128) { u32x2 ri; ri.x = en_this; ri.y = __float_as_uint(wri); RI[(size_t)rt * 128 + c.tid] = ri; }
    }
}
DEV void phase6b(const Ctx& c) {
    const bf16_t* ACT8 = (const bf16_t*)(c.ws + WS_ACT); const bf16_t* Wd8 = (const bf16_t*)(c.ws + WS_WD); unsigned char* Y8 = c.ws + WS_Y;
    const u32x2* RI = (const u32x2*)(c.ws + WS_RI);
    moe_tiles(c);
    const int* ts = (const int*)(c.lds + EXP_OFF); u32x2* tbl = (u32x2*)(c.lds + TBL_OFF);
    const StageGeo g = stage_geo(c.tid);
    unsigned char* lds = c.lds;
    const int tid = c.tid, lane = c.lane, wr = c.wid >> 1, wc = c.wid & 1, fr = lane & 15, fq = lane >> 4;
    const int cb0 = fq * 32, cb1 = fq * 32 + 16;
    const int q0 = (cb0 >> 6) * 1024 + ((fr * 64 + (cb0 & 63)) ^ ((fr >> 3) << 5)), q1 = (cb1 >> 6) * 1024 + ((fr * 64 + (cb1 & 63)) ^ ((fr >> 3) << 5));
    const int a_off = wr * 8192, b_off = wc * 8192, dst = tid * 16;
    const int NU = ts[NE] * 2;
    int e = 0;
#define GLDS(src, off) __builtin_amdgcn_global_load_lds((const unsigned*)(src), (unsigned LAS*)(lds + (off)), 16, 0, 0)
    for (int u = c.vcu; u < NU; u += c.G) {
        const int rt = u >> 1, nh = u & 1;
        while (ts[e + 1] <= rt) ++e;
        __syncthreads();
        if (tid < 128) tbl[tid] = RI[(size_t)rt * 128 + tid];
        const bf16_t* A = ACT8 + (size_t)(rt * 128) * (DE / 2) + g.c;
        const bf16_t* B = Wd8 + ((size_t)e * 1024 + nh * 512) * (DE / 2) + g.c;
#pragma unroll
        for (int kt = 0; kt < 2; ++kt)
#pragma unroll
            for (int i = 0; i < 4; ++i) GLDS(A + (size_t)g.r[i] * (DE / 2) + kt * 64, kt * 16384 + dst + i * 4096);
#define BSTAGE(s_, buf) do { const bf16_t* _b = B + (size_t)((s_) >> 1) * 128 * (DE / 2) + ((s_) & 1) * 64; \
        GLDS(_b + (size_t)g.r[0] * (DE / 2), 32768 + (buf) * 16384 + dst);        GLDS(_b + (size_t)g.r[1] * (DE / 2), 32768 + (buf) * 16384 + dst + 4096); \
        GLDS(_b + (size_t)g.r[2] * (DE / 2), 32768 + (buf) * 16384 + dst + 8192); GLDS(_b + (size_t)g.r[3] * (DE / 2), 32768 + (buf) * 16384 + dst + 12288); } while (0)
        BSTAGE(0, 0);
        f32x4 acc[4][4];
#pragma unroll
        for (int m = 0; m < 4; ++m)
#pragma unroll
            for (int n = 0; n < 4; ++n) acc[m][n] = (f32x4){0.f, 0.f, 0.f, 0.f};
#pragma unroll 1
        for (int s_ = 0; s_ < 8; ++s_) {
            VM_WAIT();
            __syncthreads();
            const int bsel = s_ & 1;
            if (s_ + 1 < 8) { if (bsel) BSTAGE(s_ + 1, 0); else BSTAGE(s_ + 1, 1); }
            const unsigned char* ab = lds + bsel * 16384 + a_off; const unsigned char* bb = lds + 32768 + bsel * 16384 + b_off;
            v8i ax[4], bx[4];
#pragma unroll
            for (int m = 0; m < 4; ++m) { const u32x4 c0 = *(const u32x4*)(ab + m * 2048 + q0), c1 = *(const u32x4*)(ab + m * 2048 + q1);
                ax[m] = (v8i){(int)c0.x, (int)c0.y, (int)c0.z, (int)c0.w, (int)c1.x, (int)c1.y, (int)c1.z, (int)c1.w}; }
#pragma unroll
            for (int n = 0; n < 4; ++n) { const u32x4 c0 = *(const u32x4*)(bb + n * 2048 + q0), c1 = *(const u32x4*)(bb + n * 2048 + q1);
                bx[n] = (v8i){(int)c0.x, (int)c0.y, (int)c0.z, (int)c0.w, (int)c1.x, (int)c1.y, (int)c1.z, (int)c1.w}; }
#pragma unroll
            for (int m = 0; m < 4; ++m)
#pragma unroll
                for (int n = 0; n < 4; ++n) acc[m][n] = __builtin_amdgcn_mfma_scale_f32_16x16x128_f8f6f4(bx[n], ax[m], acc[m][n], 0, 0, 0, 0x7F7F7F7F, 0, 0x7F7F7F7F);
            if (bsel) {
                const int nt = nh * 4 + (s_ >> 1);
#pragma unroll
                for (int m = 0; m < 4; ++m) {
                    const u32x2 ri = tbl[wr * 64 + m * 16 + fr]; const unsigned en = ri.x;
                    const float w = __uint_as_float(ri.y) * (WUNSCALE * YSCALE);
                    unsigned xq[4];
#pragma unroll
                    for (int n = 0; n < 4; ++n) { const f32x4 o = acc[m][n] * w; xq[n] = pk_fp8x4(o[0], o[1], o[2], o[3]); }
                    const u32x4 z = quad_transpose(xq[0], xq[1], xq[2], xq[3]);
                    if (en != 0xffffffffu) *(u32x4*)(Y8 + ((size_t)(en & 1u) * TR + (en >> 1)) * D + nt * 128 + wc * 64 + fq * 16) = z;
#pragma unroll
                    for (int n = 0; n < 4; ++n) acc[m][n] = (f32x4){0.f, 0.f, 0.f, 0.f};
                }
            }
        }
#undef BSTAGE
    }
#undef GLDS
}

DEV void phase7(const Ctx& c) {
    const bf16_t* R1 = (const bf16_t*)(c.ws + WS_R1); const unsigned char* Y8 = c.ws + WS_Y; const float2* ST1 = (const float2*)(c.ws + WS_ST1);
    const float* g = c.in[I_LN2G]; const float* bt = c.in[I_LN2B];
    const int gw = c.vcu * 4 + c.wid, NGW = c.G * 4, lane = c.lane;
    float G1[16], B1[16];
#pragma unroll
    for (int i = 0; i < 2; ++i)
#pragma unroll
        for (int q = 0; q < 2; ++q) { const f32x4 a = *(const f32x4*)(c.in[I_LN1G] + i * 512 + lane * 8 + q * 4), bq = *(const f32x4*)(c.in[I_LN1B] + i * 512 + lane * 8 + q * 4);
#pragma unroll
            for (int e = 0; e < 4; ++e) { G1[i * 8 + q * 4 + e] = a[e]; B1[i * 8 + q * 4 + e] = bq[e]; } }
    for (int tok0 = gw; tok0 < TR; tok0 += 2 * NGW) {
        float v[2][16]; float st[2]; int tk[2];
#pragma unroll
        for (int r = 0; r < 2; ++r) {
            int tok = tok0 + r * NGW; if (tok >= TR) tok = tok0; tk[r] = tok;
            const float2 ms = ST1[tok]; const float am = ALPHA * ms.y;
#pragma unroll
            for (int i = 0; i < 2; ++i) {
                const u32x4 hw = __builtin_nontemporal_load((const u32x4*)(R1 + (size_t)tok * D + i * 512 + lane * 8));
                const u32x2 y0 = __builtin_nontemporal_load((const u32x2*)(Y8 + (size_t)tok * D + i * 512 + lane * 8));
                const u32x2 y1 = __builtin_nontemporal_load((const u32x2*)(Y8 + ((size_t)TR + tok) * D + i * 512 + lane * 8));
#pragma unroll
                for (int q2 = 0; q2 < 2; ++q2) {
                    const auto a0 = __builtin_amdgcn_cvt_pk_f32_fp8((int)y0[q2], false), a1 = __builtin_amdgcn_cvt_pk_f32_fp8((int)y0[q2], true);
                    const auto b0 = __builtin_amdgcn_cvt_pk_f32_fp8((int)y1[q2], false), b1 = __builtin_amdgcn_cvt_pk_f32_fp8((int)y1[q2], true);
                    const int e0 = i * 8 + 4 * q2;
                    v[r][e0]     = (bflo(hw[2 * q2]) - ms.x) * (am * G1[e0]) + ALPHA * B1[e0] + (a0[0] + b0[0]) * YUNSCALE;
                    v[r][e0 + 1] = (bfhi(hw[2 * q2]) - ms.x) * (am * G1[e0 + 1]) + ALPHA * B1[e0 + 1] + (a0[1] + b0[1]) * YUNSCALE;
                    v[r][e0 + 2] = (bflo(hw[2 * q2 + 1]) - ms.x) * (am * G1[e0 + 2]) + ALPHA * B1[e0 + 2] + (a1[0] + b1[0]) * YUNSCALE;
                    v[r][e0 + 3] = (bfhi(hw[2 * q2 + 1]) - ms.x) * (am * G1[e0 + 3]) + ALPHA * B1[e0 + 3] + (a1[1] + b1[1]) * YUNSCALE;
                }
            }
        }
#pragma unroll
        for (int r = 0; r < 2; ++r) { float a = 0.f;
#pragma unroll
            for (int q = 0; q < 16; ++q) a += v[r][q];
            st[r] = a; }
        wave_sum_n<2>(st);
#pragma unroll
        for (int r = 0; r < 2; ++r) { const float mean = st[r] * (1.f / 1024.f); float a = 0.f;
#pragma unroll
            for (int q = 0; q < 16; ++q) { v[r][q] -= mean; a += v[r][q] * v[r][q]; }
            st[r] = a; }
        wave_sum_n<2>(st);
#pragma unroll
        for (int i = 0; i < 2; ++i)
#pragma unroll
            for (int q = 0; q < 2; ++q) {
                const int col = i * 512 + lane * 8 + q * 4;
                const f32x4 gg = *(const f32x4*)(g + col), bb = *(const f32x4*)(bt + col);
#pragma unroll
                for (int r = 0; r < 2; ++r) {
                    if (r == 1 && tok0 + NGW >= TR) continue;
                    const float rstd = rsqrt_(st[r] * (1.f / 1024.f) + EPS);
                    f32x4 o; o[0] = v[r][i * 8 + q * 4] * rstd * gg[0] + bb[0]; o[1] = v[r][i * 8 + q * 4 + 1] * rstd * gg[1] + bb[1];
                    o[2] = v[r][i * 8 + q * 4 + 2] * rstd * gg[2] + bb[2]; o[3] = v[r][i * 8 + q * 4 + 3] * rstd * gg[3] + bb[3];
                    *(f32x4*)(c.out + (size_t)tk[r] * D + col) = o;
                }
            }
    }
}

__global__ void __launch_bounds__(256, 2) fwd_kernel(Args a) {
    extern __shared__ __attribute__((aligned(16))) unsigned char lds[];
    Ctx c; c.in = a.in; c.out = a.out; c.ws = a.ws; c.lds = lds;
    c.tid = threadIdx.x; c.lane = c.tid & 63; c.wid = __builtin_amdgcn_readfirstlane(c.tid >> 6);
    c.G = gridDim.x; { const int bx = blockIdx.x; c.vcu = (c.G % 8 == 0) ? (bx % 8) * (c.G / 8) + bx / 8 : bx; }
    if (c.tid < 64) ((unsigned*)(lds + MISC_OFF))[c.tid] = 0u;
    __syncthreads();
    unsigned* ctl = (unsigned*)(a.ws + WS_CTL);
    XcdBarrier bar = xcd_barrier_post(ctl + CW_BAR, (volatile LAS unsigned*)(lds + MISC_OFF));
#ifdef ONLY_PH
#define PH_ON(k) ((k) == ONLY_PH)
#else
#define PH_ON(k) 1
#endif
    const int lo = a.ph_lo, hi = a.ph_hi;
#define RUN_PHASE(k, fn) if (PH_ON(k) && lo <= (k) && (k) < hi) { \
        for (int _rep = 0; _rep < ((REPEAT_PH == (k)) ? 2 : 1); ++_rep) { \
            int _t = threadIdx.x; asm volatile("" : "+v"(_t)); c.tid = _t; c.lane = _t & 63; c.wid = __builtin_amdgcn_readfirstlane(_t >> 6); \
            if ((k) == 5) phase5(c, _rep); else fn(c); \
            if (_rep == 0 && REPEAT_PH == (k)) xcd_barrier(bar); } \
        if ((k) + 1 < hi) xcd_barrier(bar); }
    RUN_PHASE(0, phase0)
    RUN_PHASE(1, phase1)
    RUN_PHASE(2, phase2)
    RUN_PHASE(3, phase3)
    RUN_PHASE(4, phase4)
    RUN_PHASE(5, phase0)
    RUN_PHASE(6, phase6a)
    RUN_PHASE(7, phase6b)
    RUN_PHASE(8, phase7)
}

extern "C" void kernel_launch(void* const* d_in, const int* in_sizes, int n_in, void* d_out, int out_size, void* d_ws, size_t ws_size, hipStream_t stream) {
    static int grid = 0;
    if (grid == 0) {
        if (n_in != 27 || in_sizes[0] != NB * SEQ * D || out_size != TR * D || ws_size < WS_END) {
            fprintf(stderr, "kernel_launch: shape mismatch n_in %d in0 %d out %d ws %zu\n", n_in, n_in > 0 ? in_sizes[0] : -1, out_size, ws_size); grid = -1; return; }
        int dev = 0, cus = 0, per_cu = 0;
        if (hipGetDevice(&dev) != hipSuccess || hipDeviceGetAttribute(&cus, hipDeviceAttributeMultiprocessorCount, dev) != hipSuccess) { grid = -1; return; }
        if (hipFuncSetAttribute((const void*)fwd_kernel, hipFuncAttributeMaxDynamicSharedMemorySize, LDS_BYTES) != hipSuccess) { grid = -1; return; }
        if (hipOccupancyMaxActiveBlocksPerMultiprocessor(&per_cu, (const void*)fwd_kernel, 256, LDS_BYTES) != hipSuccess || per_cu < 1) per_cu = 1;
        (void)hipGetLastError();
        if (per_cu > 2) per_cu = 2;
        grid = cus * per_cu;
        fprintf(stderr, "kernel_launch: grid %d (%d per CU)\n", grid, per_cu);
    }
    if (grid < 0) return;
    (void)hipMemsetAsync((char*)d_ws + WS_CTL, 0, CTL_ZERO_BYTES, stream);
    Args a{};
    for (int i = 0; i < 27; ++i) a.in[i] = (const float*)d_in[i];
    a.out = (float*)d_out; a.ws = (unsigned char*)d_ws;
    if (MK_N_LAUNCHES == 1) {
        a.ph_lo = 0; a.ph_hi = NPH;
        hipLaunchKernelGGL(fwd_kernel, dim3(grid), dim3(256), LDS_BYTES, stream, a);
    } else {
        for (int ph = 0; ph < NPH; ++ph) { a.ph_lo = ph; a.ph_hi = ph + 1; hipLaunchKernelGGL(fwd_kernel, dim3(grid), dim3(256), LDS_BYTES, stream, a); }
    }
}
```

```cpp
#include <hip/hip_runtime.h>
#include <cstdio>
#include <cstdint>

#ifndef REPEAT_PH
#define REPEAT_PH -1
#endif
#ifndef CONV_REPB
#define CONV_REPB 1
#endif
#ifndef CONV_REPC
#define CONV_REPC 1
#endif
#ifndef CONV_REPA
#define CONV_REPA 1
#endif
#ifndef MK_N_LAUNCHES
#define MK_N_LAUNCHES 1
#endif

#define DEV __device__ __forceinline__
#define LAS __attribute__((address_space(3)))
#define GAS __attribute__((address_space(1)))
typedef unsigned short bf16_t;
typedef short bf16x8 __attribute__((ext_vector_type(8)));
typedef short s16x4 __attribute__((ext_vector_type(4)));
typedef float f32x4 __attribute__((ext_vector_type(4)));
typedef float f32x16 __attribute__((ext_vector_type(16)));
typedef unsigned u32x4 __attribute__((ext_vector_type(4)));
typedef unsigned u32x2 __attribute__((ext_vector_type(2)));
typedef long i64x2 __attribute__((ext_vector_type(2)));
typedef int v8i __attribute__((ext_vector_type(8)));

constexpr int NB = 16, SEQ = 2048, NMETA = 16, L = SEQ + NMETA;
constexpr int T = NB * L;
constexpr int TR = NB * SEQ;
constexpr int D = 1024, NIN = 1696, CC = 512, QL = 384, KVL = 256, NH = 8, DQK = 96, DV = 64;
constexpr int NQ = NH * DQK;
constexpr int NKV = NH * (64 + DV);
constexpr int NE = 32, DE = 256, CONVK = 31;
constexpr float EPS = 1e-5f;
constexpr float ALPHA = 1.189207115002721f;
constexpr float QSCALE = 0.10206207261596577f * 1.4426950408889634f;
constexpr int NPH = 9;
constexpr float WSCALE = 16.f, WUNSCALE = 1.f / 16.f;
constexpr float YSCALE = 64.f, YUNSCALE = 1.f / 64.f;

constexpr size_t MiB = 1u << 20;
constexpr size_t WS_CTL = 0, CTL_ZERO_BYTES = 64 * 1024;
constexpr int CW_CNT = 1024, CNT_STRIDE = 64;
constexpr int CW_BAR = 4096;
constexpr size_t WS_LIST = 1 * MiB;
constexpr size_t WS_COMBW = 5 * MiB;
constexpr size_t WS_ST1 = 5 * MiB + 256 * 1024;
constexpr size_t WS_ROPE = 5 * MiB + 512 * 1024;
constexpr size_t WS_WIN = 6 * MiB;
constexpr size_t WS_WUQ = 10 * MiB;
constexpr size_t WS_WUKV = 11 * MiB;
constexpr size_t WS_WO = 12 * MiB;
constexpr size_t WS_WR = 14 * MiB;
constexpr size_t WS_RI = 14 * MiB + 512 * 1024;
constexpr size_t WS_SSQ_CQ = 404 * MiB + 512 * 1024;
constexpr size_t WS_SSQ_CKV = 402 * MiB;
constexpr size_t WS_SSQ_O = 403 * MiB;
constexpr size_t WS_WGU = 16 * MiB;
constexpr size_t WS_WD = 48 * MiB;
constexpr size_t WS_H1F8 = 130 * MiB;
constexpr size_t WS_H0 = 64 * MiB;
constexpr size_t WS_U = 130 * MiB;
constexpr size_t WS_CQ = 163 * MiB;
constexpr size_t WS_CKV = 188 * MiB;
constexpr size_t WS_KR = 205 * MiB;
constexpr size_t WS_Q = 208 * MiB;
constexpr size_t WS_KV = 257 * MiB;
constexpr size_t WS_R1 = 208 * MiB;
constexpr size_t WS_Y = 272 * MiB;
constexpr size_t WS_MG = 336 * MiB;
constexpr size_t WS_ACT = 336 * MiB;
constexpr size_t WS_DUMMY = 400 * MiB;
constexpr size_t WS_END = 406 * MiB;

constexpr int LDS_BYTES = 73728;
constexpr int MISC_OFF = LDS_BYTES - 256;
constexpr int RS_OFF = 65536;
constexpr int TBL_OFF = 66048;
constexpr int EXP_OFF = 67584;

DEV unsigned cvtpk(float lo, float hi) { unsigned r; asm("v_cvt_pk_bf16_f32 %0, %1, %2" : "=v"(r) : "v"(lo), "v"(hi)); return r; }
DEV float bflo(unsigned w) { return __uint_as_float(w << 16); }
DEV float bfhi(unsigned w) { return __uint_as_float(w & 0xffff0000u); }
DEV float dpp_add_qp(float v, int) { return v; }
template <int CTRL> DEV float dpp_mov(float v) { return __builtin_bit_cast(float, __builtin_amdgcn_update_dpp(0, __builtin_bit_cast(int, v), CTRL, 0xf, 0xf, false)); }
DEV float wave_sum(float v) {
    v += dpp_mov<0xB1>(v);
    v += dpp_mov<0x4E>(v);
    v += dpp_mov<0x141>(v);
    v += dpp_mov<0x140>(v);
    const int iv = __builtin_bit_cast(int, v);
    const float a = __builtin_bit_cast(float, __builtin_amdgcn_readlane(iv, 0)), b = __builtin_bit_cast(float, __builtin_amdgcn_readlane(iv, 16));
    const float c = __builtin_bit_cast(float, __builtin_amdgcn_readlane(iv, 32)), d = __builtin_bit_cast(float, __builtin_amdgcn_readlane(iv, 48));
    return (a + b) + (c + d);
}
DEV float rsqrt_(float x) { return __builtin_amdgcn_rsqf(x); }
DEV void st_bf4(bf16_t* p, f32x4 v) { u32x2 w = {cvtpk(v[0], v[1]), cvtpk(v[2], v[3])}; *(u32x2*)p = w; }
DEV unsigned pk_fp8x4(float a, float b, float c, float d) {
    int w = __builtin_amdgcn_cvt_pk_fp8_f32(a, b, 0, false); w = __builtin_amdgcn_cvt_pk_fp8_f32(c, d, w, true); return (unsigned)w; }
DEV float fast_exp2(float x) { return __builtin_amdgcn_exp2f(x); }
DEV float fast_rcp(float x) { return __builtin_amdgcn_rcpf(x); }
DEV float sigmoidf_(float g) { return fast_rcp(1.f + fast_exp2(-1.4426950408889634f * g)); }
#define LDS_WAIT() asm volatile("s_waitcnt lgkmcnt(0)" ::: "memory")
#define VM_WAIT() asm volatile("s_waitcnt vmcnt(0)" ::: "memory")

#define XB_TMO      128
#define XB_XCNT(j)  (256  + 64 * (j))
#define XB_XSUB(j)  (1280 + 64 * (j))
#define XB_XGEN(j)  (2304 + 64 * (j))
#define XB_TOP      3328
#define XB_TOPGEN   3392
#define XCD_BAR_WORDS 3456
#define XB_SPIN_CAP (1u << 22)
DEV unsigned xb_ld(unsigned* p)              { return __hip_atomic_load(p, __ATOMIC_RELAXED, __HIP_MEMORY_SCOPE_AGENT); }
DEV unsigned xb_add(unsigned* p, unsigned v) { return __hip_atomic_fetch_add(p, v, __ATOMIC_RELAXED, __HIP_MEMORY_SCOPE_AGENT); }
DEV unsigned xb_xcc_id() { return (unsigned)__builtin_amdgcn_s_getreg((3 << 11) | 20) & 0xFu; }
#define XB_SPIN(cond, bar) do { unsigned _sp = 0; while (cond) { __builtin_amdgcn_s_sleep(1); \
    if ((++_sp & 255u) == 0u) { if (xb_ld(&(bar)[XB_TMO])) break; if (_sp > XB_SPIN_CAP) { atomicAdd(&(bar)[XB_TMO], 1u); break; } } } } while (0)
struct XcdBarrier { unsigned* bar; unsigned x; volatile LAS unsigned* st; };
DEV XcdBarrier xcd_barrier_post(unsigned* bar, volatile LAS unsigned* st) {
    XcdBarrier b; b.bar = bar; b.x = xb_xcc_id(); b.st = st;
    if (threadIdx.x == 0) (void)xb_add(&bar[XB_XCNT(b.x)], 1u);
    return b;
}
DEV u32x4 quad_transpose(unsigned x0, unsigned x1, unsigned x2, unsigned x3) {
    auto a = __builtin_amdgcn_permlane32_swap(x0, x2, false, false); auto b = __builtin_amdgcn_permlane32_swap(x1, x3, false, false);
    auto z0 = __builtin_amdgcn_permlane16_swap(a[0], b[0], false, false); auto z1 = __builtin_amdgcn_permlane16_swap(a[1], b[1], false, false);
    return (u32x4){z0[0], z0[1], z1[0], z1[1]};
}
DEV void st_quad_bf16(bf16_t* p, f32x4 v0, f32x4 v1, f32x4 v2, f32x4 v3) {
    const u32x4 lo = quad_transpose(cvtpk(v0[0], v0[1]), cvtpk(v1[0], v1[1]), cvtpk(v2[0], v2[1]), cvtpk(v3[0], v3[1]));
    const u32x4 hi = quad_transpose(cvtpk(v0[2], v0[3]), cvtpk(v1[2], v1[3]), cvtpk(v2[2], v2[3]), cvtpk(v3[2], v3[3]));
    *(u32x4*)p = (u32x4){lo[0], hi[0], lo[1], hi[1]}; *(u32x4*)(p + 8) = (u32x4){lo[2], hi[2], lo[3], hi[3]};
}
DEV void xcd_barrier_complete(unsigned* bar, unsigned x, unsigned& nloc, unsigned& nx) {
    const unsigned G = gridDim.x * gridDim.y * gridDim.z;
    unsigned sum, cnt, mine, sp = 0u;
    for (;;) {
        sum = 0u; cnt = 0u; mine = 0u;
#pragma unroll
        for (unsigned j = 0; j < 16; ++j) { const unsigned c = xb_ld(&bar[XB_XCNT(j)]); sum += c; cnt += (c > 0u) ? 1u : 0u; mine = (j == x) ? c : mine; }
        if (sum == G) break;
        __builtin_amdgcn_s_sleep(1);
        if ((++sp & 255u) == 0u) { if (xb_ld(&bar[XB_TMO])) break; if (sp > XB_SPIN_CAP) { atomicAdd(&bar[XB_TMO], 1u); break; } }
    }
    nloc = mine > 0u ? mine : 1u; nx = cnt > 0u ? cnt : 1u;
}
DEV void xcd_barrier(const XcdBarrier& b) {
    asm volatile("s_waitcnt vmcnt(0)" ::: "memory");
    __syncthreads();
    if (threadIdx.x == 0) {
        unsigned* bar = b.bar;
        __builtin_amdgcn_s_waitcnt(0);
        unsigned nloc = b.st[0], nx = b.st[1];
        if (nloc == 0u) { xcd_barrier_complete(bar, b.x, nloc, nx); b.st[0] = nloc; b.st[1] = nx; }
        const unsigned old = xb_add(&bar[XB_XSUB(b.x)], 1u);
        const unsigned gen = old / nloc;
        if (old + 1u == (gen + 1u) * nloc) {
            __builtin_amdgcn_fence(__ATOMIC_RELEASE, "agent");
            asm volatile("s_waitcnt vmcnt(0)" ::: "memory");
            const unsigned og = xb_add(&bar[XB_TOP], 1u);
            const unsigned tg = og / nx;
            if (og + 1u == (tg + 1u) * nx) xb_add(&bar[XB_TOPGEN], 1u);
            else XB_SPIN(xb_ld(&bar[XB_TOPGEN]) == tg, bar);
            __builtin_amdgcn_fence(__ATOMIC_ACQUIRE, "agent");
            xb_add(&bar[XB_XGEN(b.x)], 1u);
            asm volatile("s_waitcnt vmcnt(0)" ::: "memory");
        } else {
            XB_SPIN(xb_ld(&bar[XB_XGEN(b.x)]) == gen, bar);
            __builtin_amdgcn_fence(__ATOMIC_ACQUIRE, "agent");
            asm volatile("s_waitcnt vmcnt(0)" ::: "memory");
        }
    }
    __syncthreads();
}

struct Args { const float* in[27]; float* out; unsigned char* ws; int ph_lo, ph_hi; };
struct Ctx {
    const float* const* in; float* out; unsigned char* ws; unsigned char* lds;
    int tid, lane, wid, vcu, G;
};
enum { I_X = 0, I_META, I_LNIN_G, I_LNIN_B, I_WIN, I_CONVW, I_CONVB, I_CLN_G, I_CLN_B, I_QNG, I_WUQ, I_KVNG, I_WUKV, I_COUT_G, I_AOUT_G, I_WO,
       I_LN1G, I_LN1B, I_WRG, I_BRG, I_WRE, I_BRE, I_WGATE, I_WUP, I_WDOWN, I_LN2G, I_LN2B };

DEV int nmap(int mode, int n) {
    if (mode == 1) { if (n < 512) return ((n >> 4) << 5) + (n & 15); if (n < 1024) return (((n - 512) >> 4) << 5) + 16 + (n & 15); return n; }
    if (mode == 2) return ((n >> 4) << 5) + (n & 15);
    if (mode == 3) return ((n >> 4) << 5) + 16 + (n & 15);
    return n;
}
DEV void p0_transpose_item(const float* __restrict__ W, int N, int k0, int n0, const float* __restrict__ kscale, bf16_t* WT, int ldt, int kout0, int mode,
                           float* scr, int lane) {
#pragma unroll 8
    for (int i = 0; i < 32; ++i) {
        const int kk = 2 * i + (lane >> 5);
        float v = __builtin_nontemporal_load(&W[(size_t)(k0 + kk) * N + n0 + (lane & 31)]);
        if (kscale) v *= kscale[k0 + kk];
        scr[kk * 33 + (lane & 31)] = v;
    }
    LDS_WAIT(); asm volatile("" ::: "memory");
    const int c = lane & 7;
#pragma unroll
    for (int j = 0; j < 4; ++j) {
        const int n = (lane >> 3) + 8 * j; const float* s = scr + (8 * c) * 33 + n;
        u32x4 o; o.x = cvtpk(s[0 * 33], s[1 * 33]); o.y = cvtpk(s[2 * 33], s[3 * 33]); o.z = cvtpk(s[4 * 33], s[5 * 33]); o.w = cvtpk(s[6 * 33], s[7 * 33]);
        *(u32x4*)(WT + (size_t)nmap(mode, n0 + n) * ldt + kout0 + 8 * c) = o;
    }
    LDS_WAIT(); asm volatile("" ::: "memory");
}
DEV void p0_transpose_item_f8(const float* __restrict__ W, int N, int k0, int n0, float scale, unsigned char* W8, int ldt, int kout0, int mode, float* scr, int lane) {
#pragma unroll 8
    for (int i = 0; i < 32; ++i) { const int kk = 2 * i + (lane >> 5); scr[kk * 33 + (lane & 31)] = W[(size_t)(k0 + kk) * N + n0 + (lane & 31)] * scale; }
    LDS_WAIT(); asm volatile("" ::: "memory");
    const int c = lane & 7;
#pragma unroll
    for (int j = 0; j < 4; ++j) {
        const int n = (lane >> 3) + 8 * j; const float* sp = scr + (8 * c) * 33 + n;
        u32x2 o; o.x = pk_fp8x4(sp[0 * 33], sp[1 * 33], sp[2 * 33], sp[3 * 33]); o.y = pk_fp8x4(sp[4 * 33], sp[5 * 33], sp[6 * 33], sp[7 * 33]);
        *(u32x2*)(W8 + (size_t)nmap(mode, n0 + n) * ldt + kout0 + 8 * c) = o;
    }
    LDS_WAIT(); asm volatile("" ::: "memory");
}
template <int N> DEV void wave_sum_n(float (&v)[N]) {
#pragma unroll
    for (int i = 0; i < N; ++i) v[i] = wave_sum(v[i]);
}
template <int NR, bool F8 = false, bool BFIN = false, bool NOBF = false> DEV void ln_rows_bf16(const float* const (&xrow)[NR], const float* g, const float* bta, bf16_t* const (&orow)[NR], unsigned char* const (&ldsrow)[NR], int lane, unsigned char* const* f8row = nullptr, float* const* strow = nullptr) {
    f32x4 v[NR][4]; float s[NR];
#pragma unroll
    for (int r = 0; r < NR; ++r)
#pragma unroll
        for (int j = 0; j < 4; ++j) {
            if (BFIN) { const u32x2 w = ((const u32x2*)xrow[r])[64 * j + lane]; v[r][j] = (f32x4){bflo(w.x), bfhi(w.x), bflo(w.y), bfhi(w.y)}; }
            else v[r][j] = __builtin_nontemporal_load(&((const f32x4*)xrow[r])[64 * j + lane]); }
#pragma unroll
    for (int r = 0; r < NR; ++r) { s[r] = 0.f;
#pragma unroll
        for (int j = 0; j < 4; ++j) s[r] += (v[r][j].x + v[r][j].y) + (v[r][j].z + v[r][j].w); }
    wave_sum_n<NR>(s);
    float s2[NR];
#pragma unroll
    for (int r = 0; r < NR; ++r) { const float mean = s[r] * (1.f / 1024.f); s2[r] = 0.f;
#pragma unroll
        for (int j = 0; j < 4; ++j) { v[r][j] = v[r][j] - mean; s2[r] += (v[r][j].x * v[r][j].x + v[r][j].y * v[r][j].y) + (v[r][j].z * v[r][j].z + v[r][j].w * v[r][j].w); } }
    wave_sum_n<NR>(s2);
    if (strow) {
#pragma unroll
        for (int r = 0; r < NR; ++r) if (lane == 0) { strow[r][0] = s[r] * (1.f / 1024.f); strow[r][1] = rsqrt_(s2[r] * (1.f / 1024.f) + EPS); }
    }
#pragma unroll
    for (int j = 0; j < 4; ++j) {
        const f32x4 gg = ((const f32x4*)g)[64 * j + lane], bb = ((const f32x4*)bta)[64 * j + lane];
#pragma unroll
        for (int r = 0; r < NR; ++r) {
            const float rstd = rsqrt_(s2[r] * (1.f / 1024.f) + EPS);
            const f32x4 o = v[r][j] * rstd * gg + bb;
            const u32x2 w = {cvtpk(o.x, o.y), cvtpk(o.z, o.w)};
            if (!NOBF) ((u32x2*)orow[r])[64 * j + lane] = w;
            if (ldsrow[r]) ((u32x2*)ldsrow[r])[64 * j + lane] = w;
            if (F8) ((unsigned*)f8row[r])[64 * j + lane] = pk_fp8x4(o.x, o.y, o.z, o.w);
        }
    }
}
__device__ const float INVF[16] = {1.0f, 0.5623413251903491f, 0.31622776601683794f, 0.1778279410038923f, 0.1f, 0.05623413251903491f, 0.031622776601683794f,
    0.01778279410038923f, 0.01f, 0.005623413251903491f, 0.0031622776601683794f, 0.001778279410038923f, 0.001f, 0.0005623413251903491f, 0.00031622776601683794f, 0.0001778279410038923f};
DEV void sincos_d(double a, float& sn, float& cs) {
    const double TWO_PI = 6.283185307179586476925286766559, INV_TWO_PI = 0.15915494309189533576888376337251;
    const double k = __builtin_rint(a * INV_TWO_PI);
    const double r = a - k * TWO_PI;
    const double r2 = r * r;
    double ps = 1.0, pc = 1.0;
#pragma unroll
    for (int i = 14; i >= 1; --i) {
        pc = 1.0 - pc * r2 * (1.0 / (double)((2 * i - 1) * (2 * i)));
        ps = 1.0 - ps * r2 * (1.0 / (double)((2 * i) * (2 * i + 1)));
    }
    sn = (float)(r * ps); cs = (float)pc;
}
DEV void ew_block(const float* __restrict__ W, int N, int k0, int n0, unsigned char* W8, int ldt, int mode, int lane) {
    const int q = lane & 15, kq = lane >> 4;
    const float* src = W + (size_t)(k0 + 16 * kq) * N + n0 + 4 * q;
    f32x4 v[16];
#pragma unroll
    for (int i = 0; i < 16; ++i) v[i] = __builtin_nontemporal_load((const f32x4*)(src + (size_t)i * N));
#pragma unroll
    for (int j = 0; j < 4; ++j) {
        u32x4 o;
        o.x = pk_fp8x4(v[0][j] * WSCALE, v[1][j] * WSCALE, v[2][j] * WSCALE, v[3][j] * WSCALE);
        o.y = pk_fp8x4(v[4][j] * WSCALE, v[5][j] * WSCALE, v[6][j] * WSCALE, v[7][j] * WSCALE);
        o.z = pk_fp8x4(v[8][j] * WSCALE, v[9][j] * WSCALE, v[10][j] * WSCALE, v[11][j] * WSCALE);
        o.w = pk_fp8x4(v[12][j] * WSCALE, v[13][j] * WSCALE, v[14][j] * WSCALE, v[15][j] * WSCALE);
        *(u32x4*)(W8 + (size_t)nmap(mode, n0 + 4 * q + j) * ldt + k0 + 16 * kq) = o;
    }
}
DEV void expert_weight_item(const Ctx& c, int r, float*  ) {
    unsigned char* Wgu8 = c.ws + WS_WGU; unsigned char* Wd8 = c.ws + WS_WD;
    if (r < 2048) { const int e = r >> 6, qq = r & 63, kb = qq >> 2, nb = qq & 3;
        ew_block(c.in[I_WGATE] + (size_t)e * D * DE, DE, 64 * kb, 64 * nb, Wgu8 + (size_t)e * 512 * 1024, 1024, 2, c.lane); return; } r -= 2048;
    if (r < 2048) { const int e = r >> 6, qq = r & 63, kb = qq >> 2, nb = qq & 3;
        ew_block(c.in[I_WUP] + (size_t)e * D * DE, DE, 64 * kb, 64 * nb, Wgu8 + (size_t)e * 512 * 1024, 1024, 3, c.lane); return; } r -= 2048;
    { const int e = r >> 6, qq = r & 63, kb = qq >> 4, nb = qq & 15;
        ew_block(c.in[I_WDOWN] + (size_t)e * DE * D, D, 64 * kb, 64 * nb, Wd8 + (size_t)e * 1024 * 256, 256, 0, c.lane); }
}
DEV void phase0(const Ctx& c) {
    float* scr = (float*)(c.lds + c.wid * 8448);
    const int gw = c.vcu * 4 + c.wid, NGW = c.G * 4;
    constexpr int I_IN = 16 * 53, I_UQ = 6 * 24, I_UKV = 4 * 32, I_O = 16 * 32;
    bf16_t* WinT = (bf16_t*)(c.ws + WS_WIN); bf16_t* WuqT = (bf16_t*)(c.ws + WS_WUQ); bf16_t* WukvT = (bf16_t*)(c.ws + WS_WUKV);
    bf16_t* WoT = (bf16_t*)(c.ws + WS_WO);
    constexpr int NITEMS0 = I_IN + I_UQ + I_UKV + I_O;
    for (int it = gw; it < NITEMS0; it += NGW) {
        int r = it;
        if (r < I_IN) { const int kb = r / 53, nb = r % 53; p0_transpose_item(c.in[I_WIN], NIN, 64 * kb, 32 * nb, nullptr, WinT, 1024, 64 * kb, 1, scr, c.lane); continue; } r -= I_IN;
        if (r < I_UQ) { const int kb = r / 24, nb = r % 24; p0_transpose_item(c.in[I_WUQ], NQ, 64 * kb, 32 * nb, c.in[I_QNG], WuqT, QL, 64 * kb, 0, scr, c.lane); continue; } r -= I_UQ;
        if (r < I_UKV) { const int kb = r / 32, nb = r % 32; p0_transpose_item(c.in[I_WUKV], NKV, 64 * kb, 32 * nb, c.in[I_KVNG], WukvT, KVL, 64 * kb, 0, scr, c.lane); continue; } r -= I_UKV;
        { const int kb = r / 32, nb = r % 32;
            if (kb < 8) p0_transpose_item(c.in[I_WO], D, 64 * kb, 32 * nb, nullptr, WoT, 1024, 64 * kb + 512, 0, scr, c.lane);
            else        p0_transpose_item(c.in[I_WO], D, 64 * kb, 32 * nb, c.in[I_AOUT_G] - 512, WoT, 1024, 64 * kb - 512, 0, scr, c.lane); }
    }
    const int gt = c.vcu * 256 + c.tid, NGT = c.G * 256;
    bf16_t* WrT = (bf16_t*)(c.ws + WS_WR);
    for (int i = gt; i < 48 * 1024; i += NGT) {
        const int n = i >> 10, k = i & 1023; float v = 0.f;
        if (n < 4) v = c.in[I_WRG][k * 4 + n]; else if (n < 36) v = c.in[I_WRE][k * 32 + (n - 4)];
        WrT[i] = (bf16_t)(cvtpk(v, 0.f) & 0xffffu);
    }
    float* rc = (float*)(c.ws + WS_ROPE); float* rs = rc + L * 16;
    for (int i = gt; i < L * 16; i += NGT) {
        const int p = i >> 4, f = i & 15; const float ang = (float)p * INVF[f];
        float sn, cs; sincos_d((double)ang, sn, cs); rc[i] = cs; rs[i] = sn;
    }
    bf16_t* h0 = (bf16_t*)(c.ws + WS_H0);
    for (int t = gw; t < T; t += 2 * NGW) {
        const float* src[2]; bf16_t* dst[2]; unsigned char* ldsn[2] = {nullptr, nullptr};
#pragma unroll
        for (int r = 0; r < 2; ++r) { int tt = t + r * NGW; if (tt >= T) tt = t;
            const int b = tt / L, p = tt - b * L;
            src[r] = (p < NMETA) ? c.in[I_META] + (size_t)p * D : c.in[I_X] + ((size_t)b * SEQ + (p - NMETA)) * D;
            dst[r] = h0 + (size_t)tt * D; }
        ln_rows_bf16<2>(src, c.in[I_LNIN_G], c.in[I_LNIN_B], dst, ldsn, c.lane);
    }
}

struct StageGeo { int r[4]; int c; };
DEV StageGeo stage_geo(int tid) {
    const int lane = tid & 63, wid = tid >> 6; StageGeo g;
    const int rl = lane >> 2, cl = ((lane & 3) * 8) ^ ((lane >> 5) << 4);
#pragma unroll
    for (int i = 0; i < 4; ++i) g.r[i] = (((wid + 4 * i) >> 1) << 4) + rl;
    g.c = ((wid & 1) << 5) + cl;
    return g;
}
template <bool SSQ, bool FP8 = false>
DEV void gemm_mainloop(f32x4 (&acc)[4][4], const bf16_t* ap0, const bf16_t* ap1, const bf16_t* ap2, const bf16_t* ap3,
                       const bf16_t* bp0, const bf16_t* bp1, const bf16_t* bp2, const bf16_t* bp3,
                       int nk, unsigned char* lds, int ssq_steps, float ssq_inv_dim, bool skip_wc1 = false) {
    const int tid = threadIdx.x, lane = tid & 63, wid = tid >> 6, wr = wid >> 1, wc = wid & 1, fr = lane & 15, fq = lane >> 4;
    const int xs = (fr >> 1) & 7;
    const int lo = ((fr * 64 + fq * 16) ^ ((fr >> 3) << 5));
    const int lo0 = lo, lo1 = lo + 1024;
    const int a_off = wr * 8192, b_off = 16384 + wc * 8192;
    const int dst = tid * 16;
#pragma unroll
    for (int m = 0; m < 4; ++m)
#pragma unroll
        for (int n = 0; n < 4; ++n) acc[m][n] = (f32x4){0.f, 0.f, 0.f, 0.f};
    __syncthreads();
#define GLDS(src, off) __builtin_amdgcn_global_load_lds((const unsigned*)(src), (unsigned LAS*)(lds + (off)), 16, 0, 0)
#define STAGE(kt, b) do { const int _k = (kt) * 64; \
        GLDS(ap0 + _k, (b) * 32768 + dst);          GLDS(ap1 + _k, (b) * 32768 + dst + 4096); \
        GLDS(ap2 + _k, (b) * 32768 + dst + 8192);   GLDS(ap3 + _k, (b) * 32768 + dst + 12288); \
        GLDS(bp0 + _k, (b) * 32768 + 16384 + dst);  GLDS(bp1 + _k, (b) * 32768 + 16384 + dst + 4096); \
        GLDS(bp2 + _k, (b) * 32768 + 16384 + dst + 8192); GLDS(bp3 + _k, (b) * 32768 + 16384 + dst + 12288); } while (0)
    STAGE(0, 0);
    for (int kt = 0; kt < nk; ++kt) {
        VM_WAIT();
        __syncthreads();
        const int b = kt & 1;
        if (SSQ && kt == ssq_steps) {
            const float* rsl = (const float*)(lds + RS_OFF);
#pragma unroll
            for (int m = 0; m < 4; ++m) { const float r = rsl[wr * 64 + m * 16 + fr];
#pragma unroll
                for (int n = 0; n < 4; ++n) acc[m][n] = acc[m][n] * r; }
        }
        if (kt + 1 < nk) { if (b) STAGE(kt + 1, 0); else STAGE(kt + 1, 1); }
        const unsigned char* base = lds + b * 32768;
        if (skip_wc1 && wc == 1) {
        } else if (FP8) {
            const int cb0 = fq * 32, cb1 = fq * 32 + 16;
            const int q0 = (cb0 >> 6) * 1024 + ((fr * 64 + (cb0 & 63)) ^ ((fr >> 3) << 5)), q1 = (cb1 >> 6) * 1024 + ((fr * 64 + (cb1 & 63)) ^ ((fr >> 3) << 5));
            v8i ax[4], bx[4];
#pragma unroll
            for (int m = 0; m < 4; ++m) { const u32x4 c0 = *(const u32x4*)(base + a_off + m * 2048 + q0), c1 = *(const u32x4*)(base + a_off + m * 2048 + q1);
                ax[m] = (v8i){(int)c0.x, (int)c0.y, (int)c0.z, (int)c0.w, (int)c1.x, (int)c1.y, (int)c1.z, (int)c1.w}; }
#pragma unroll
            for (int n = 0; n < 4; ++n) { const u32x4 c0 = *(const u32x4*)(base + b_off + n * 2048 + q0), c1 = *(const u32x4*)(base + b_off + n * 2048 + q1);
                bx[n] = (v8i){(int)c0.x, (int)c0.y, (int)c0.z, (int)c0.w, (int)c1.x, (int)c1.y, (int)c1.z, (int)c1.w}; }
#pragma unroll
            for (int m = 0; m < 4; ++m)
#pragma unroll
                for (int n = 0; n < 4; ++n) acc[m][n] = __builtin_amdgcn_mfma_scale_f32_16x16x128_f8f6f4(bx[n], ax[m], acc[m][n], 0, 0, 0, 0x7F7F7F7F, 0, 0x7F7F7F7F);
        } else {
#pragma unroll
        for (int ks = 0; ks < 2; ++ks) {
            bf16x8 af[4], bf[4];
#pragma unroll
            for (int m = 0; m < 4; ++m) af[m] = *(const bf16x8*)(base + a_off + m * 2048 + (ks ? lo1 : lo0));
#pragma unroll
            for (int n = 0; n < 4; ++n) bf[n] = *(const bf16x8*)(base + b_off + n * 2048 + (ks ? lo1 : lo0));
#pragma unroll
            for (int m = 0; m < 4; ++m)
#pragma unroll
                for (int n = 0; n < 4; ++n) acc[m][n] = __builtin_amdgcn_mfma_f32_16x16x32_bf16(bf[n], af[m], acc[m][n], 0, 0, 0);
        }
        }
    }
    if (SSQ && ssq_steps == nk) {
        __syncthreads();
        const float* rsl = (const float*)(lds + RS_OFF);
#pragma unroll
        for (int m = 0; m < 4; ++m) { const float r = rsl[wr * 64 + m * 16 + fr];
#pragma unroll
            for (int n = 0; n < 4; ++n) acc[m][n] = acc[m][n] * r; }
    }
#undef STAGE
#undef GLDS
}

DEV void phase1(const Ctx& c) {
    const bf16_t* h0 = (const bf16_t*)(c.ws + WS_H0); const bf16_t* WinT = (const bf16_t*)(c.ws + WS_WIN);
    bf16_t* U = (bf16_t*)(c.ws + WS_U); bf16_t* CQ = (bf16_t*)(c.ws + WS_CQ); bf16_t* CKV = (bf16_t*)(c.ws + WS_CKV); bf16_t* KR = (bf16_t*)(c.ws + WS_KR);
    const float* rc = (const float*)(c.ws + WS_ROPE); const float* rs = rc + L * 16;
    const StageGeo g = stage_geo(c.tid);
    const int lane = c.lane, wr = c.wid >> 1, wc = c.wid & 1, fr = lane & 15, fq = lane >> 4;
    constexpr int NT = 14, NU = (T / 128) * NT;
    for (int u = c.vcu; u < NU; u += c.G) {
        const int mt = u / NT, nt = u - mt * NT;
        const bf16_t* A = h0 + (size_t)(mt * 128) * D + g.c; const bf16_t* B = WinT + (size_t)(nt * 128) * D + g.c;
        f32x4 acc[4][4];
        gemm_mainloop<false>(acc, A + (size_t)g.r[0] * D, A + (size_t)g.r[1] * D, A + (size_t)g.r[2] * D, A + (size_t)g.r[3] * D,
                             B + (size_t)g.r[0] * D, B + (size_t)g.r[1] * D, B + (size_t)g.r[2] * D, B + (size_t)g.r[3] * D, 16, c.lds, 0, 0.f, nt == 13);
        const int row0 = mt * 128 + wr * 64 + fr;
        if (nt < 8) {
#pragma unroll
            for (int mp = 0; mp < 2; ++mp) {
                f32x4 o[4];
#pragma unroll
                for (int q = 0; q < 4; ++q) { const f32x4 a = acc[2 * mp + (q >> 1)][2 * (q & 1)], gt = acc[2 * mp + (q >> 1)][2 * (q & 1) + 1];
#pragma unroll
                    for (int j = 0; j < 4; ++j) o[q][j] = a[j] * sigmoidf_(gt[j]); }
                const size_t row = row0 + (2 * mp + (fq >> 1)) * 16;
                st_quad_bf16(U + row * CC + nt * 64 + wc * 32 + (fq & 1) * 16, o[0], o[1], o[2], o[3]);
            }
        } else if (nt < 13) {
            const bool isq = nt < 11;
            bf16_t* dstb = isq ? CQ + (nt - 8) * 128 + wc * 64 + fq * 16 : CKV + (nt - 11) * 128 + wc * 64 + fq * 16;
            const int ldd = isq ? QL : KVL;
            float* ssb = isq ? (float*)(c.ws + WS_SSQ_CQ) + (nt - 8) * 2 + wc : (float*)(c.ws + WS_SSQ_CKV) + (nt - 11) * 2 + wc;
            const int lds_ = isq ? 8 : 4;
#pragma unroll
            for (int m = 0; m < 4; ++m) { const size_t row = row0 + m * 16; float sq = 0.f;
#pragma unroll
                for (int n = 0; n < 4; ++n) sq += (acc[m][n][0] * acc[m][n][0] + acc[m][n][1] * acc[m][n][1]) + (acc[m][n][2] * acc[m][n][2] + acc[m][n][3] * acc[m][n][3]);
                st_quad_bf16(dstb + row * ldd, acc[m][0], acc[m][1], acc[m][2], acc[m][3]);
                sq += __shfl_xor(sq, 16); sq += __shfl_xor(sq, 32);
                if (fq == 0) ssb[row * lds_] = sq; }
        } else if (wc == 0) {
#pragma unroll
            for (int mp = 0; mp < 2; ++mp) { f32x4 o[4];
#pragma unroll
                for (int mm = 0; mm < 2; ++mm) { const int m = 2 * mp + mm; const int row = row0 + m * 16; const int p = row % L;
                    const f32x4 cs = *(const f32x4*)(rc + p * 16 + fq * 4), sn = *(const f32x4*)(rs + p * 16 + fq * 4);
                    const f32x4 x1 = acc[m][0], x2 = acc[m][1];
                    o[2 * mm] = x1 * cs - x2 * sn; o[2 * mm + 1] = x1 * sn + x2 * cs; }
                st_quad_bf16(KR + (size_t)(row0 + (2 * mp + (fq >> 1)) * 16) * 32 + (fq & 1) * 16, o[0], o[1], o[2], o[3]); }
        }
    }
}

DEV void conv_unit(const Ctx& c, int b, int j) {
    const bf16_t* U = (const bf16_t*)(c.ws + WS_U);
    bf16_t* MG = (bf16_t*)(c.ws + WS_MG);
    const float* cw = c.in[I_CONVW]; const float* cb = c.in[I_CONVB];
    const int p0 = NMETA + j * 32;
    float* ytile = (float*)c.lds;
    __syncthreads();
#pragma unroll 1
    for (int pass = 0; pass < 2; ++pass) {
        const int ch = c.tid + 256 * pass;
        float win[62]; unsigned raw[62];
        const bf16_t* ub = U + (size_t)b * L * CC + ch;
#pragma unroll
        for (int rep = 0; rep < CONV_REPA; ++rep) {
        asm volatile("" : "+v"(ub) :: "memory");
#pragma unroll
        for (int i = 0; i < 62; ++i) { const int p = p0 - 30 + i; const int pc = p < 0 ? 0 : (p >= L ? L - 1 : p); raw[i] = ub[(size_t)pc * CC]; }
        if (rep + 1 < CONV_REPA) {
#pragma unroll
            for (int i = 0; i < 62; ++i) asm volatile("" :: "v"(raw[i]));
        }
        }
        float w[31];
#pragma unroll
        for (int k = 0; k < 31; ++k) w[k] = cw[k * CC + ch];
        float bias = cb[ch];
        __builtin_amdgcn_sched_barrier(0);
#pragma unroll
        for (int i = 0; i < 62; ++i) { const int p = p0 - 30 + i; win[i] = (p >= 0 && p < L) ? __uint_as_float(raw[i] << 16) : 0.f; }
#pragma unroll
        for (int rep = 0; rep < CONV_REPB; ++rep) {
        asm volatile("" : "+v"(bias) :: "memory");
#pragma unroll
        for (int tt = 0; tt < 32; ++tt) {
            float a0 = bias;
#pragma unroll
            for (int k = 0; k < 31; ++k) a0 += w[k] * win[tt + k];
            ytile[tt * 512 + ch] = a0;
        }
        }
    }
    __syncthreads();
    const float* g1 = c.in[I_CLN_G]; const float* b1 = c.in[I_CLN_B]; const float* g2 = c.in[I_COUT_G];
    float G1[8], B1[8], G2[8];
    { const f32x4 a = *(const f32x4*)(g1 + c.lane * 8), bq = *(const f32x4*)(g1 + c.lane * 8 + 4); G1[0]=a.x;G1[1]=a.y;G1[2]=a.z;G1[3]=a.w;G1[4]=bq.x;G1[5]=bq.y;G1[6]=bq.z;G1[7]=bq.w; }
    { const f32x4 a = *(const f32x4*)(b1 + c.lane * 8), bq = *(const f32x4*)(b1 + c.lane * 8 + 4); B1[0]=a.x;B1[1]=a.y;B1[2]=a.z;B1[3]=a.w;B1[4]=bq.x;B1[5]=bq.y;B1[6]=bq.z;B1[7]=bq.w; }
    { const f32x4 a = *(const f32x4*)(g2 + c.lane * 8), bq = *(const f32x4*)(g2 + c.lane * 8 + 4); G2[0]=a.x;G2[1]=a.y;G2[2]=a.z;G2[3]=a.w;G2[4]=bq.x;G2[5]=bq.y;G2[6]=bq.z;G2[7]=bq.w; }
#pragma unroll
    for (int rep = 0; rep < CONV_REPC; ++rep) {
    asm volatile("" : "+v"(ytile) :: "memory");
    float v[8][8]; float st[8];
#pragma unroll
    for (int i = 0; i < 8; ++i) { const int tt = c.wid * 8 + i;
        const f32x4 ya = *(const f32x4*)(ytile + tt * 512 + c.lane * 8), yb = *(const f32x4*)(ytile + tt * 512 + c.lane * 8 + 4);
        v[i][0]=ya.x;v[i][1]=ya.y;v[i][2]=ya.z;v[i][3]=ya.w;v[i][4]=yb.x;v[i][5]=yb.y;v[i][6]=yb.z;v[i][7]=yb.w;
        st[i] = ((v[i][0] + v[i][1]) + (v[i][2] + v[i][3])) + ((v[i][4] + v[i][5]) + (v[i][6] + v[i][7])); }
    wave_sum_n<8>(st);
#pragma unroll
    for (int i = 0; i < 8; ++i) { const float mean = st[i] * (1.f / 512.f); float a = 0.f;
#pragma unroll
        for (int q = 0; q < 8; ++q) { v[i][q] -= mean; a += v[i][q] * v[i][q]; }
        st[i] = a; }
    wave_sum_n<8>(st);
#pragma unroll
    for (int i = 0; i < 8; ++i) { const float rstd = rsqrt_(st[i] * (1.f / 512.f) + EPS); float a = 0.f;
#pragma unroll
        for (int q = 0; q < 8; ++q) { const float x = v[i][q] * rstd * G1[q] + B1[q]; const float y = x * sigmoidf_(x); v[i][q] = y; a += y * y; }
        st[i] = a; }
    wave_sum_n<8>(st);
#pragma unroll
    for (int i = 0; i < 8; ++i) {
        const int p = p0 + c.wid * 8 + i;
        {
            const float r2 = rsqrt_(st[i] * (1.f / 512.f) + EPS);
            u32x4 o;
            o.x = cvtpk(v[i][0] * r2 * G2[0], v[i][1] * r2 * G2[1]); o.y = cvtpk(v[i][2] * r2 * G2[2], v[i][3] * r2 * G2[3]);
            o.z = cvtpk(v[i][4] * r2 * G2[4], v[i][5] * r2 * G2[5]); o.w = cvtpk(v[i][6] * r2 * G2[6], v[i][7] * r2 * G2[7]);
            const size_t tok = (size_t)b * SEQ + (p - NMETA);
            bf16_t* dstp = (p >= NMETA && p < L) ? MG + tok * D + 512 + c.lane * 8 : (bf16_t*)(c.ws + WS_DUMMY) + c.lane * 8;
            *(u32x4*)dstp = o;
        }
    }
    }
}
DEV void rope4(f32x4& x1, f32x4& x2, const float* rc, const float* rs, int p, int fq) {
    const f32x4 cs = *(const f32x4*)(rc + p * 16 + fq * 4), sn = *(const f32x4*)(rs + p * 16 + fq * 4);
    const f32x4 a = x1 * cs - x2 * sn, bb = x1 * sn + x2 * cs; x1 = a; x2 = bb;
}
DEV void phase2(const Ctx& c) {
    const bf16_t* CQ = (const bf16_t*)(c.ws + WS_CQ); const bf16_t* CKV = (const bf16_t*)(c.ws + WS_CKV);
    const bf16_t* WuqT = (const bf16_t*)(c.ws + WS_WUQ); const bf16_t* WukvT = (const bf16_t*)(c.ws + WS_WUKV);
    bf16_t* Q = (bf16_t*)(c.ws + WS_Q); bf16_t* KV = (bf16_t*)(c.ws + WS_KV);
    const float* rc = (const float*)(c.ws + WS_ROPE); const float* rs = rc + L * 16;
    const StageGeo g = stage_geo(c.tid);
    const int lane = c.lane, wr = c.wid >> 1, wc = c.wid & 1, fr = lane & 15, fq = lane >> 4;
    constexpr int NUC = NB * 64, NUQ = (TR / 128) * 6, NUKV = (TR / 128) * 8 + 8, NU = NUC + NUQ + NUKV;
    const int li = c.vcu & 63, rev = ((li >> 5) ^ li) & 1;
    const int nmine = (NU - c.vcu + c.G - 1) / c.G;
    for (int it = 0; it < nmine; ++it) {
        const int u = c.vcu + (rev ? (nmine - 1 - it) : it) * c.G;
        if (u < NUC) {
            conv_unit(c, u >> 6, u & 63);
        } else if (u < NUC + NUQ) {
            const int v = u - NUC, mt = v / 6, nt = v - mt * 6;
            const size_t t0 = (size_t)(mt >> 4) * L + NMETA + (mt & 15) * 128;
            const bf16_t* A = CQ + t0 * QL + g.c; const bf16_t* B = WuqT + (size_t)(nt * 128) * QL + g.c;
            f32x4 acc[4][4];
            __syncthreads();
            if (c.tid < 128) { const float* pp = (const float*)(c.ws + WS_SSQ_CQ) + (t0 + c.tid) * 8; const f32x4 p4 = *(const f32x4*)pp; const float2 p2 = *(const float2*)(pp + 4);
                ((float*)(c.lds + RS_OFF))[c.tid] = rsqrt_((((p4.x + p4.y) + (p4.z + p4.w)) + (p2.x + p2.y)) * (1.f / 384.f) + EPS); }
            gemm_mainloop<true>(acc, A + (size_t)g.r[0] * QL, A + (size_t)g.r[1] * QL, A + (size_t)g.r[2] * QL, A + (size_t)g.r[3] * QL,
                                B + (size_t)g.r[0] * QL, B + (size_t)g.r[1] * QL, B + (size_t)g.r[2] * QL, B + (size_t)g.r[3] * QL, 6, c.lds, 6, 1.f / 384.f);
            const int p0 = NMETA + (mt & 15) * 128 + wr * 64 + fr;
            const int t16 = (nt * 8 + wc * 4) % 6;
#pragma unroll
            for (int m = 0; m < 4; ++m) { const size_t row = t0 + wr * 64 + m * 16 + fr; const int p = p0 + m * 16;
#pragma unroll
                for (int n = 0; n < 4; ++n) acc[m][n] = acc[m][n] * QSCALE;
                if (t16 == 4) rope4(acc[m][0], acc[m][1], rc, rs, p, fq);
                if (t16 == 2) rope4(acc[m][2], acc[m][3], rc, rs, p, fq);
                st_quad_bf16(Q + row * NQ + nt * 128 + wc * 64 + fq * 16, acc[m][0], acc[m][1], acc[m][2], acc[m][3]); }
        } else {
            const int v = u - NUC - NUQ; const bool meta = v >= (TR / 128) * 8;
            const int mt = meta ? 0 : v >> 3, nt = meta ? v - (TR / 128) * 8 : v & 7;
            const size_t t0 = meta ? 0 : (size_t)(mt >> 4) * L + NMETA + (mt & 15) * 128;
            const int rmask = meta ? 15 : 127;
            const bf16_t* A = CKV + t0 * KVL + g.c; const bf16_t* B = WukvT + (size_t)(nt * 128) * KVL + g.c;
            f32x4 acc[4][4];
            __syncthreads();
            if (c.tid < 128) { const f32x4 p4 = *(const f32x4*)((const float*)(c.ws + WS_SSQ_CKV) + (t0 + (c.tid & rmask)) * 4);
                ((float*)(c.lds + RS_OFF))[c.tid] = rsqrt_(((p4.x + p4.y) + (p4.z + p4.w)) * (1.f / 256.f) + EPS); }
            gemm_mainloop<true>(acc, A + (size_t)(g.r[0] & rmask) * KVL, A + (size_t)(g.r[1] & rmask) * KVL, A + (size_t)(g.r[2] & rmask) * KVL, A + (size_t)(g.r[3] & rmask) * KVL,
                                B + (size_t)g.r[0] * KVL, B + (size_t)g.r[1] * KVL, B + (size_t)g.r[2] * KVL, B + (size_t)g.r[3] * KVL, 4, c.lds, 4, 1.f / 256.f);
            if (!meta) {
#pragma unroll
                for (int m = 0; m < 4; ++m) { const size_t row = t0 + wr * 64 + m * 16 + fr;
                    st_quad_bf16(KV + row * NKV + nt * 128 + wc * 64 + fq * 16, acc[m][0], acc[m][1], acc[m][2], acc[m][3]); }
            } else if (wr == 0) {
#pragma unroll 1
                for (int bb = 0; bb < NB; ++bb) {
#pragma unroll
                    for (int n = 0; n < 4; ++n) st_bf4(KV + ((size_t)bb * L + fr) * NKV + nt * 128 + wc * 64 + n * 16 + fq * 4, acc[0][n]); }
            }
        }
    }
}
DEV int crow(int r, int hi) { return (r & 3) + 8 * (r >> 2) + 4 * hi; }
#define KSWZ(row, colB) ((row) * 256 + ((colB) ^ (((row) & 7) << 4)))
#define SBAR() __builtin_amdgcn_sched_barrier(0)
DEV int v_st(int k, int cc) { const int kk = (k & ~0xC) | ((k & 4) << 1) | ((k & 8) >> 1); return ((kk >> 3) * 4 + (cc >> 5)) * 512 + ((kk & 7) * 32 + (cc & 31)) * 2; }
DEV int v_rd_base(int lane) { return ((lane & 3) << 3) | (((lane >> 2) & 3) << 6) | (((lane >> 4) & 1) << 5) | (((lane >> 5) & 1) << 8); }
constexpr int v_rd_off(int d0, int ks, int half) { return d0 * 512 + ks * 4096 + half * 2048; }
template <int OFF> DEV s16x4 tr_read(int vb) { s16x4 r; asm volatile("ds_read_b64_tr_b16 %0, %1 offset:%2" : "=&v"(r) : "v"(vb), "i"(OFF) : "memory"); return r; }
template <int D0> DEV void pv_one(f32x16& od, int vb, bf16x8 pa0, bf16x8 pa1, bf16x8 pa2, bf16x8 pa3) {
    const s16x4 l0 = tr_read<v_rd_off(D0, 0, 0)>(vb), h0 = tr_read<v_rd_off(D0, 0, 1)>(vb), l1 = tr_read<v_rd_off(D0, 1, 0)>(vb), h1 = tr_read<v_rd_off(D0, 1, 1)>(vb);
    const s16x4 l2 = tr_read<v_rd_off(D0, 2, 0)>(vb), h2 = tr_read<v_rd_off(D0, 2, 1)>(vb), l3 = tr_read<v_rd_off(D0, 3, 0)>(vb), h3 = tr_read<v_rd_off(D0, 3, 1)>(vb);
    asm volatile("s_waitcnt lgkmcnt(0)" ::: "memory"); SBAR();
#define PK(Lo, Hi) (bf16x8){Lo[0], Lo[1], Lo[2], Lo[3], Hi[0], Hi[1], Hi[2], Hi[3]}
    od = __builtin_amdgcn_mfma_f32_32x32x16_bf16(pa0, PK(l0, h0), od, 0, 0, 0);
    od = __builtin_amdgcn_mfma_f32_32x32x16_bf16(pa1, PK(l1, h1), od, 0, 0, 0);
    od = __builtin_amdgcn_mfma_f32_32x32x16_bf16(pa2, PK(l2, h2), od, 0, 0, 0);
    od = __builtin_amdgcn_mfma_f32_32x32x16_bf16(pa3, PK(l3, h3), od, 0, 0, 0);
#undef PK
}
constexpr float ATT_THR = 8.f;
constexpr int AT_V = 0, AT_K = 32768, AT_WS = 65536;
DEV void attn_unit(const Ctx& c, int b, int h, int qb) {
    const bf16_t* Q = (const bf16_t*)(c.ws + WS_Q); const bf16_t* KV = (const bf16_t*)(c.ws + WS_KV); const bf16_t* KR = (const bf16_t*)(c.ws + WS_KR);
    bf16_t* MG = (bf16_t*)(c.ws + WS_MG);
    unsigned char* lds = c.lds;
    const int tid = c.tid, wid = c.wid, lane = c.lane, r32 = lane & 31, hi = lane >> 5;
    float* wsf = (float*)(lds + AT_WS) + wid * 64; float* li_l = wsf; float* al_l = wsf + 32;
    const int NT = 2 * qb + 3;
    const int my_last = 2 * qb + (wid >> 1) + 1;
    bf16x8 qr[6];
    { const size_t t = (size_t)b * L + NMETA + qb * 128 + wid * 32 + r32;
      const bf16_t* Qw = Q + t * NQ + h * DQK + hi * 8;
#pragma unroll
      for (int d0 = 0; d0 < 6; ++d0) qr[d0] = *(const bf16x8*)(Qw + d0 * 16); }
    const int srow = tid >> 2, sq = tid & 3;
    const int vst0 = v_st(srow, sq * 16), vst1 = v_st(srow, sq * 16 + 8);
    const int kst0 = KSWZ(srow, sq * 32), kst1 = KSWZ(srow, sq * 32 + 16), kst2 = KSWZ(srow, 128 + sq * 16);
    const int vb0 = (int)(uintptr_t)(lds + AT_V) + v_rd_base(lane);
    u32x4 sk0, sk1, sk2, sv0, sv1;
#define SLOAD(j) do { int pos = (j) * 64 + srow - 48; pos = pos < 0 ? 0 : pos; const size_t tk = (size_t)b * L + pos; \
        const bf16_t* kvp = KV + tk * NKV + h * 128 + sq * 16; \
        sk0 = *(const u32x4*)(kvp); sk1 = *(const u32x4*)(kvp + 8); sv0 = *(const u32x4*)(kvp + 64); sv1 = *(const u32x4*)(kvp + 72); \
        sk2 = *(const u32x4*)(KR + tk * 32 + sq * 8); } while (0)
#define SWRITE(bb) do { unsigned char* kb = lds + AT_K + (bb) * 16384; unsigned char* vbp = lds + AT_V + (bb) * 16384; \
        *(u32x4*)(kb + kst0) = sk0; *(u32x4*)(kb + kst1) = sk1; *(u32x4*)(kb + kst2) = sk2; *(u32x4*)(vbp + vst0) = sv0; *(u32x4*)(vbp + vst1) = sv1; } while (0)
    float m_reg = 0.f, l_reg = 0.f; f32x16 o[2] = {};
    __syncthreads();
    SLOAD(0); SWRITE(0); __syncthreads();
    for (int j = 0; j < NT; ++j) {
        const int bsel = j & 1;
        if (j + 1 < NT) SLOAD(j + 1);
        if (j <= my_last) {
            const unsigned char* Ks = lds + AT_K + bsel * 16384;
            f32x16 p0, p1;
            { const float nm = -m_reg;
#pragma unroll
              for (int r = 0; r < 16; ++r) { p0[r] = nm; p1[r] = nm; } }
            __builtin_amdgcn_s_setprio(1);
#pragma unroll
            for (int d0 = 0; d0 < 6; ++d0) { const int cb = (d0 * 16 + hi * 8) * 2;
                const bf16x8 k0 = *(const bf16x8*)(Ks + KSWZ(r32, cb)); const bf16x8 k1 = *(const bf16x8*)(Ks + KSWZ(32 + r32, cb));
                p0 = __builtin_amdgcn_mfma_f32_32x32x16_bf16(k0, qr[d0], p0, 0, 0, 0);
                p1 = __builtin_amdgcn_mfma_f32_32x32x16_bf16(k1, qr[d0], p1, 0, 0, 0); }
            __builtin_amdgcn_s_setprio(0);
            if (j == 0) {
#pragma unroll
                for (int r = 0; r < 16; ++r) p0[r] = -1e30f;
#pragma unroll
                for (int r = 0; r < 8; ++r) p1[r] = -1e30f;
            }
            float pmax = fmaxf(fmaxf(p0[0], p0[1]), p0[2]);
#pragma unroll
            for (int r = 3; r < 15; r += 2) pmax = fmaxf(fmaxf(pmax, p0[r]), p0[r + 1]);
            pmax = fmaxf(fmaxf(pmax, p0[15]), p1[0]);
#pragma unroll
            for (int r = 1; r < 15; r += 2) pmax = fmaxf(fmaxf(pmax, p1[r]), p1[r + 1]);
            pmax = fmaxf(pmax, p1[15]);
            { auto rr = __builtin_amdgcn_permlane32_swap(__float_as_uint(pmax), __float_as_uint(pmax), false, false);
              pmax = fmaxf(__uint_as_float(rr[0]), __uint_as_float(rr[1])); }
            float ps = 0.f;
            if (__any(pmax > ATT_THR)) {
                const float dm = fmaxf(pmax, 0.f), alpha = fast_exp2(-dm); m_reg += dm;
#pragma unroll
                for (int r = 0; r < 16; ++r) { p0[r] -= dm; p1[r] -= dm; }
                l_reg *= alpha;
                if (hi == 0) al_l[r32] = alpha;
                asm volatile("s_waitcnt lgkmcnt(0)" ::: "memory");
#pragma unroll
                for (int r = 0; r < 16; ++r) { const float a = al_l[crow(r, hi)]; o[0][r] *= a; o[1][r] *= a; }
            }
#pragma unroll
            for (int r = 0; r < 16; ++r) { p0[r] = fast_exp2(p0[r]); ps += p0[r]; }
#pragma unroll
            for (int r = 0; r < 16; ++r) { p1[r] = fast_exp2(p1[r]); ps += p1[r]; }
            { auto rr = __builtin_amdgcn_permlane32_swap(__float_as_uint(ps), __float_as_uint(ps), false, false);
              ps = __uint_as_float(rr[0]) + __uint_as_float(rr[1]); }
            l_reg += ps;
            bf16x8 pa0, pa1, pa2, pa3;
#define PK4(P, BASE, OUT) do { unsigned a0 = cvtpk(P[BASE + 0], P[BASE + 1]), a1 = cvtpk(P[BASE + 2], P[BASE + 3]);   \
    unsigned b0 = cvtpk(P[BASE + 4], P[BASE + 5]), b1 = cvtpk(P[BASE + 6], P[BASE + 7]);                              \
    auto r0 = __builtin_amdgcn_permlane32_swap(a0, b0, false, false); auto r1 = __builtin_amdgcn_permlane32_swap(a1, b1, false, false); \
    u32x4 w = {r0[0], r1[0], r0[1], r1[1]}; OUT = *reinterpret_cast<bf16x8*>(&w); } while (0)
            PK4(p0, 0, pa0); PK4(p0, 8, pa1); PK4(p1, 0, pa2); PK4(p1, 8, pa3);
#undef PK4
            const int vb = vb0 + bsel * 16384;
            __builtin_amdgcn_s_setprio(1);
            pv_one<0>(o[0], vb, pa0, pa1, pa2, pa3); pv_one<1>(o[1], vb, pa0, pa1, pa2, pa3);
            __builtin_amdgcn_s_setprio(0);
        }
        if (j + 1 < NT) { if (bsel) SWRITE(0); else SWRITE(1); }
        __syncthreads();
    }
    if (hi == 0) li_l[r32] = l_reg;
    asm volatile("s_waitcnt lgkmcnt(0)" ::: "memory");
    const size_t tok0 = (size_t)b * SEQ + qb * 128 + wid * 32;
    float* SSO = (float*)(c.ws + WS_SSQ_O);
#pragma unroll
    for (int r = 0; r < 16; ++r) {
        const int orow = crow(r, hi); const float rl = fast_rcp(li_l[orow]);
        bf16_t* dst = MG + (tok0 + orow) * D + h * DV + r32;
        const float a0 = o[0][r] * rl, a1 = o[1][r] * rl;
        dst[0]  = (bf16_t)(cvtpk(a0, 0.f) & 0xffffu);
        dst[32] = (bf16_t)(cvtpk(a1, 0.f) & 0xffffu);
        float sq = a0 * a0 + a1 * a1;
        sq += dpp_mov<0xB1>(sq); sq += dpp_mov<0x4E>(sq); sq += dpp_mov<0x141>(sq); sq += dpp_mov<0x140>(sq);
        sq += __shfl_xor(sq, 16);
        if (r32 == 0) SSO[(tok0 + orow) * 8 + h] = sq;
    }
#undef SLOAD
#undef SWRITE
}
DEV void phase3(const Ctx& c) {
    const int nslots = NB * NH * 4;
    float* scr = (float*)(c.lds + c.wid * 8448);
    const int gw = c.vcu * 4 + c.wid, NGW = c.G * 4;
    constexpr int NWI = 6144;
    int wi = gw;
#define EW_ITEMS(n) do { __syncthreads(); for (int _q = 0; _q < (n) && wi < NWI; ++_q, wi += NGW) expert_weight_item(c, wi, scr); } while (0)
    for (int v = c.vcu; v < nslots; v += c.G) {
        const int bh = v >> 2, s = v & 3, b = bh >> 3, h = bh & 7;
        attn_unit(c, b, h, 15 - s); EW_ITEMS(1); attn_unit(c, b, h, s); EW_ITEMS(1); attn_unit(c, b, h, 11 - s); EW_ITEMS(1); attn_unit(c, b, h, 4 + s);
    }
    __syncthreads();
    for (; wi < NWI; wi += NGW) expert_weight_item(c, wi, scr);
#undef EW_ITEMS
}

DEV void phase4(const Ctx& c) {
    const bf16_t* MG = (const bf16_t*)(c.ws + WS_MG); const bf16_t* WoT = (const bf16_t*)(c.ws + WS_WO); const bf16_t* h0 = (const bf16_t*)(c.ws + WS_H0);
    bf16_t* R1 = (bf16_t*)(c.ws + WS_R1);
    const StageGeo g = stage_geo(c.tid);
    const int lane = c.lane, wr = c.wid >> 1, wc = c.wid & 1, fr = lane & 15, fq = lane >> 4;
    constexpr int NU = (TR / 128) * 8;
    const float* SSO = (const float*)(c.ws + WS_SSQ_O);
    f32x4 pa = {1.f, 1.f, 1.f, 1.f}, pb = pa;
    if (c.vcu < NU && c.tid < 128) { const float* pp = SSO + (size_t)((c.vcu >> 3) * 128 + c.tid) * 8; pa = *(const f32x4*)pp; pb = *(const f32x4*)(pp + 4); }
    for (int u = c.vcu; u < NU; u += c.G) {
        const int mt = u >> 3, nt = u & 7;
        const bf16_t* A = MG + (size_t)(mt * 128) * D + g.c; const bf16_t* B = WoT + (size_t)(nt * 128) * D + g.c;
        f32x4 acc[4][4];
        __syncthreads();
        if (c.tid < 128) ((float*)(c.lds + RS_OFF))[c.tid] = rsqrt_((((pa.x + pa.y) + (pa.z + pa.w)) + ((pb.x + pb.y) + (pb.z + pb.w))) * (1.f / 512.f) + EPS);
        { const int un = u + c.G; if (un < NU && c.tid < 128) { const float* pp = SSO + (size_t)((un >> 3) * 128 + c.tid) * 8; pa = *(const f32x4*)pp; pb = *(const f32x4*)(pp + 4); } }
        u32x2 hw[4][4];
#pragma unroll
        for (int m = 0; m < 4; ++m) {
            const int tok = mt * 128 + wr * 64 + m * 16 + fr;
            const size_t t = (size_t)(tok >> 11) * L + NMETA + (tok & 2047);
#pragma unroll
            for (int n = 0; n < 4; ++n) hw[m][n] = *(const u32x2*)(h0 + t * D + nt * 128 + wc * 64 + n * 16 + fq * 4);
        }
        gemm_mainloop<true>(acc, A + (size_t)g.r[0] * D, A + (size_t)g.r[1] * D, A + (size_t)g.r[2] * D, A + (size_t)g.r[3] * D,
                            B + (size_t)g.r[0] * D, B + (size_t)g.r[1] * D, B + (size_t)g.r[2] * D, B + (size_t)g.r[3] * D, 16, c.lds, 8, 1.f / 512.f);
#pragma unroll
        for (int m = 0; m < 4; ++m) {
            const int tok = mt * 128 + wr * 64 + m * 16 + fr;
            f32x4 o[4];
#pragma unroll
            for (int n = 0; n < 4; ++n) {
                o[n][0] = ALPHA * bflo(hw[m][n].x) + acc[m][n][0]; o[n][1] = ALPHA * bfhi(hw[m][n].x) + acc[m][n][1];
                o[n][2] = ALPHA * bflo(hw[m][n].y) + acc[m][n][2]; o[n][3] = ALPHA * bfhi(hw[m][n].y) + acc[m][n][3];
            }
            st_quad_bf16(R1 + (size_t)tok * D + nt * 128 + wc * 64 + fq * 16, o[0], o[1], o[2], o[3]);
        }
    }
}

constexpr int P5_ROWB = 2064, P5_PART = 33280, P5_LG = 45568, P5_BIAS = 48128, P5_AGG = 48384;
DEV void phase5(const Ctx& c, int ALT = 0) {
    const bf16_t* R1 = (const bf16_t*)(c.ws + WS_R1);
    const bf16_t* WrT = (const bf16_t*)(c.ws + WS_WR);
    unsigned* cnt = (unsigned*)(c.ws + WS_CTL) + CW_CNT + ALT * 32; unsigned* list = (unsigned*)(c.ws + (ALT ? 404 * MiB : WS_LIST)); float* combw = (float*)(c.ws + WS_COMBW);
    const int lane = c.lane, wid = c.wid, fr = lane & 15, fq = lane >> 4;
    float* part = (float*)(c.lds + P5_PART); float* lgs = (float*)(c.lds + P5_LG); float* biasl = (float*)(c.lds + P5_BIAS);
    __syncthreads();
    if (c.tid < 36) biasl[c.tid] = (c.tid < 4) ? c.in[I_BRG][c.tid] : c.in[I_BRE][c.tid - 4];
    bf16x8 wf[8][3];
#pragma unroll
    for (int ks = 0; ks < 8; ++ks)
#pragma unroll
        for (int n = 0; n < 3; ++n) wf[ks][n] = *(const bf16x8*)(WrT + (size_t)(n * 16 + fr) * D + wid * 256 + ks * 32 + fq * 8);
    unsigned* lcnt = (unsigned*)(c.lds + P5_AGG); unsigned* lbase = lcnt + 32; unsigned* ent = lcnt + 64;
    if (c.tid < 32) lcnt[c.tid] = 0u;
    int nent = 0;
    for (int u = c.vcu; u < TR / 16; u += c.G) {
        const int tok0 = u * 16;
        { const float* src[4]; bf16_t* dst[4]; unsigned char* ldsn[4]; unsigned char* f8n[4]; float* stn[4];
#pragma unroll
          for (int i = 0; i < 4; ++i) { const int tl = wid * 4 + i; const size_t tok = tok0 + tl; src[i] = (const float*)(R1 + tok * D); dst[i] = nullptr; ldsn[i] = c.lds + tl * P5_ROWB; f8n[i] = c.ws + WS_H1F8 + tok * D;
              stn[i] = (float*)(c.ws + WS_ST1) + tok * 2; }
          ln_rows_bf16<4, true, true, true>(src, c.in[I_LN1G], c.in[I_LN1B], dst, ldsn, lane, f8n, stn); }
        __syncthreads();
        f32x4 acc[3] = {};
#pragma unroll
        for (int ks = 0; ks < 8; ++ks) {
            const int k = wid * 256 + ks * 32 + fq * 8;
            const bf16x8 a = *(const bf16x8*)(c.lds + fr * P5_ROWB + k * 2);
#pragma unroll
            for (int n = 0; n < 3; ++n) acc[n] = __builtin_amdgcn_mfma_f32_16x16x32_bf16(wf[ks][n], a, acc[n], 0, 0, 0);
        }
#pragma unroll
        for (int n = 0; n < 3; ++n) *(f32x4*)(part + (wid * 16 + fr) * 48 + n * 16 + fq * 4) = acc[n];
        __syncthreads();
#pragma unroll
        for (int i = 0; i < 3; ++i) { const int idx = c.tid + 256 * i;
            if (idx < 576) { const int tk = idx / 36, l = idx - tk * 36;
                lgs[tk * 40 + l] = ((part[tk * 48 + l] + part[(16 + tk) * 48 + l]) + (part[(32 + tk) * 48 + l] + part[(48 + tk) * 48 + l])) + biasl[l]; } }
        __syncthreads();
        if (c.tid < 16) {
            const float* lg = lgs + c.tid * 40;
            int gi = 0; float gm = lg[0];
#pragma unroll
            for (int i = 1; i < 4; ++i) { const float v = lg[i]; if (v > gm) { gm = v; gi = i; } }
            float gs = 0.f;
#pragma unroll
            for (int i = 0; i < 4; ++i) gs += __expf(lg[i] - gm);
            const float gw = 1.f / gs;
            const float* le = lg + 4 + gi * 8;
            float v0 = le[0], v1 = -3.0e38f; int i0 = 0, i1 = 0;
#pragma unroll
            for (int i = 1; i < 8; ++i) { const float v = le[i];
                if (v > v0) { v1 = v0; i1 = i0; v0 = v; i0 = i; } else if (v > v1) { v1 = v; i1 = i; } }
            const float ex = __expf(v1 - v0), inv = 1.f / (1.f + ex);
            const int tok = tok0 + c.tid; const unsigned e0 = gi * 8 + i0, e1 = gi * 8 + i1;
            combw[tok * 2] = gw * inv; combw[tok * 2 + 1] = gw * ex * inv;
            const unsigned r0 = atomicAdd(&lcnt[e0], 1u), r1 = atomicAdd(&lcnt[e1], 1u);
            const int ei = nent * 32 + c.tid * 2;
            ent[2 * ei] = (unsigned)(tok * 2);         ent[2 * ei + 1] = (e0 << 16) | r0;
            ent[2 * ei + 2] = (unsigned)(tok * 2 + 1); ent[2 * ei + 3] = (e1 << 16) | r1;
        }
        ++nent;
    }
    __syncthreads();
    if (c.tid < 32) { const unsigned n = lcnt[c.tid]; lbase[c.tid] = n ? atomicAdd(&cnt[c.tid * CNT_STRIDE], n) : 0u; }
    __syncthreads();
    for (int i = c.tid; i < nent * 32; i += 256) { const unsigned t2 = ent[2 * i], er = ent[2 * i + 1]; const unsigned e = er >> 16;
        list[(size_t)e * TR + lbase[e] + (er & 0xffffu)] = t2; }
}
DEV void bar20(const Ctx& c) {}
DEV void moe_tiles(const Ctx& c) {
    const unsigned* cnt = (const unsigned*)(c.ws + WS_CTL) + CW_CNT; int* ts = (int*)(c.lds + EXP_OFF);
    __syncthreads();
    if (c.tid < NE) ts[40 + c.tid] = (int)__hip_atomic_load(&cnt[c.tid * CNT_STRIDE], __ATOMIC_RELAXED, __HIP_MEMORY_SCOPE_AGENT);
    __syncthreads();
    if (c.tid == 0) { int s = 0; for (int e = 0; e < NE; ++e) { ts[e] = s; s += (ts[40 + e] + 127) >> 7; } ts[NE] = s; }
    __syncthreads();
}
DEV void phase6a(const Ctx& c) {
    const bf16_t* H18 = (const bf16_t*)(c.ws + WS_H1F8); const bf16_t* Wgu8 = (const bf16_t*)(c.ws + WS_WGU); unsigned char* ACT8 = c.ws + WS_ACT;
    const unsigned* list = (const unsigned*)(c.ws + WS_LIST);
    moe_tiles(c);
    const int* ts = (const int*)(c.lds + EXP_OFF); unsigned* tbl = (unsigned*)(c.lds + TBL_OFF);
    const StageGeo g = stage_geo(c.tid);
    const int lane = c.lane, wr = c.wid >> 1, wc = c.wid & 1, fr = lane & 15, fq = lane >> 4;
    const int NU = ts[NE] * 4;
    u32x2* RI = (u32x2*)(c.ws + WS_RI); const float* combw = (const float*)(c.ws + WS_COMBW);
    int e = 0, en_e = 0; unsigned en_cur = 0xffffffffu;
    { const int u0 = c.vcu; if (u0 < NU) { const int rt0 = u0 >> 2; while (ts[en_e + 1] <= rt0) ++en_e;
        if (c.tid < 128) { const int j = (rt0 - ts[en_e]) * 128 + c.tid; en_cur = (j < ts[40 + en_e]) ? list[(size_t)en_e * TR + j] : 0xffffffffu; } } }
    for (int u = c.vcu; u < NU; u += c.G) {
        const int rt = u >> 2, nt = u & 3;
        e = en_e;
        __syncthreads();
        float wri = 0.f;
        if (c.tid < 128) { tbl[c.tid] = en_cur; if (nt == 0 && en_cur != 0xffffffffu) wri = combw[en_cur]; }
        const unsigned en_this = en_cur;
        { const int un = u + c.G; if (un < NU) { const int rtn = un >> 2; while (ts[en_e + 1] <= rtn) ++en_e;
            if (c.tid < 128) { const int j = (rtn - ts[en_e]) * 128 + c.tid; en_cur = (j < ts[40 + en_e]) ? list[(size_t)en_e * TR + j] : 0xffffffffu; } } }
        __syncthreads();
        size_t ro[4];
#pragma unroll
        for (int i = 0; i < 4; ++i) { const unsigned en = tbl[g.r[i]]; ro[i] = (en == 0xffffffffu) ? 0 : (size_t)(en >> 1) * (D / 2); }
        const bf16_t* A = H18 + g.c; const bf16_t* B = Wgu8 + ((size_t)e * 512 + nt * 128) * (D / 2) + g.c;
        f32x4 acc[4][4];
        gemm_mainloop<false, true>(acc, A + ro[0], A + ro[1], A + ro[2], A + ro[3],
                             B + (size_t)g.r[0] * (D / 2), B + (size_t)g.r[1] * (D / 2), B + (size_t)g.r[2] * (D / 2), B + (size_t)g.r[3] * (D / 2), 8, c.lds, 0, 0.f);
#pragma unroll
        for (int mp = 0; mp < 2; ++mp) {
            unsigned xq[4];
#pragma unroll
            for (int q = 0; q < 4; ++q) { const f32x4 gt = acc[2 * mp + (q >> 1)][2 * (q & 1)], up = acc[2 * mp + (q >> 1)][2 * (q & 1) + 1]; f32x4 o;
#pragma unroll
                for (int j = 0; j < 4; ++j) { const float gv = gt[j] * WUNSCALE; o[j] = gv * sigmoidf_(gv) * (up[j] * WUNSCALE); }
                xq[q] = pk_fp8x4(o[0], o[1], o[2], o[3]); }
            const size_t row = (size_t)rt * 128 + wr * 64 + (2 * mp + (fq >> 1)) * 16 + fr;
            *(u32x4*)(ACT8 + row * DE + nt * 64 + wc * 32 + (fq & 1) * 16) = quad_transpose(xq[0], xq[1], xq[2], xq[3]);
        }
        if (nt == 0 && c.tid < 128) { u32x2 ri; ri.x = en_this; ri.y = __float_as_uint(wri); RI[(size_t)rt * 128 + c.tid] = ri; }
    }
}
DEV void phase6b(const Ctx& c) {
    const bf16_t* ACT8 = (const bf16_t*)(c.ws + WS_ACT); const bf16_t* Wd8 = (const bf16_t*)(c.ws + WS_WD); unsigned char* Y8 = c.ws + WS_Y;
    const u32x2* RI = (const u32x2*)(c.ws + WS_RI);
    moe_tiles(c);
    const int* ts = (const int*)(c.lds + EXP_OFF); u32x2* tbl = (u32x2*)(c.lds + TBL_OFF);
    const StageGeo g = stage_geo(c.tid);
    unsigned char* lds = c.lds;
    const int tid = c.tid, lane = c.lane, wr = c.wid >> 1, wc = c.wid & 1, fr = lane & 15, fq = lane >> 4;
    const int cb0 = fq * 32, cb1 = fq * 32 + 16;
    const int q0 = (cb0 >> 6) * 1024 + ((fr * 64 + (cb0 & 63)) ^ ((fr >> 3) << 5)), q1 = (cb1 >> 6) * 1024 + ((fr * 64 + (cb1 & 63)) ^ ((fr >> 3) << 5));
    const int a_off = wr * 8192, b_off = wc * 8192, dst = tid * 16;
    const int NU = ts[NE] * 2;
    int e = 0;
#define GLDS(src, off) __builtin_amdgcn_global_load_lds((const unsigned*)(src), (unsigned LAS*)(lds + (off)), 16, 0, 0)
    for (int u = c.vcu; u < NU; u += c.G) {
        const int rt = u >> 1, nh = u & 1;
        while (ts[e + 1] <= rt) ++e;
        __syncthreads();
        if (tid < 128) tbl[tid] = RI[(size_t)rt * 128 + tid];
        const bf16_t* A = ACT8 + (size_t)(rt * 128) * (DE / 2) + g.c;
        const bf16_t* B = Wd8 + ((size_t)e * 1024 + nh * 512) * (DE / 2) + g.c;
#pragma unroll
        for (int kt = 0; kt < 2; ++kt)
#pragma unroll
            for (int i = 0; i < 4; ++i) GLDS(A + (size_t)g.r[i] * (DE / 2) + kt * 64, kt * 16384 + dst + i * 4096);
#define BSTAGE(s_, buf) do { const bf16_t* _b = B + (size_t)((s_) >> 1) * 128 * (DE / 2) + ((s_) & 1) * 64; \
        GLDS(_b + (size_t)g.r[0] * (DE / 2), 32768 + (buf) * 16384 + dst);        GLDS(_b + (size_t)g.r[1] * (DE / 2), 32768 + (buf) * 16384 + dst + 4096); \
        GLDS(_b + (size_t)g.r[2] * (DE / 2), 32768 + (buf) * 16384 + dst + 8192); GLDS(_b + (size_t)g.r[3] * (DE / 2), 32768 + (buf) * 16384 + dst + 12288); } while (0)
        BSTAGE(0, 0);
        f32x4 acc[4][4];
#pragma unroll
        for (int m = 0; m < 4; ++m)
#pragma unroll
            for (int n = 0; n < 4; ++n) acc[m][n] = (f32x4){0.f, 0.f, 0.f, 0.f};
#pragma unroll 1
        for (int s_ = 0; s_ < 8; ++s_) {
            VM_WAIT();
            __syncthreads();
            const int bsel = s_ & 1;
            if (s_ + 1 < 8) { if (bsel) BSTAGE(s_ + 1, 0); else BSTAGE(s_ + 1, 1); }
            const unsigned char* ab = lds + bsel * 16384 + a_off; const unsigned char* bb = lds + 32768 + bsel * 16384 + b_off;
            v8i ax[4], bx[4];
#pragma unroll
            for (int m = 0; m < 4; ++m) { const u32x4 c0 = *(const u32x4*)(ab + m * 2048 + q0), c1 = *(const u32x4*)(ab + m * 2048 + q1);
                ax[m] = (v8i){(int)c0.x, (int)c0.y, (int)c0.z, (int)c0.w, (int)c1.x, (int)c1.y, (int)c1.z, (int)c1.w}; }
#pragma unroll
            for (int n = 0; n < 4; ++n) { const u32x4 c0 = *(const u32x4*)(bb + n * 2048 + q0), c1 = *(const u32x4*)(bb + n * 2048 + q1);
                bx[n] = (v8i){(int)c0.x, (int)c0.y, (int)c0.z, (int)c0.w, (int)c1.x, (int)c1.y, (int)c1.z, (int)c1.w}; }
#pragma unroll
            for (int m = 0; m < 4; ++m)
#pragma unroll
                for (int n = 0; n < 4; ++n) acc[m][n] = __builtin_amdgcn_mfma_scale_f32_16x16x128_f8f6f4(bx[n], ax[m], acc[m][n], 0, 0, 0, 0x7F7F7F7F, 0, 0x7F7F7F7F);
            if (bsel) {
                const int nt = nh * 4 + (s_ >> 1);
#pragma unroll
                for (int m = 0; m < 4; ++m) {
                    const u32x2 ri = tbl[wr * 64 + m * 16 + fr]; const unsigned en = ri.x;
                    const float w = __uint_as_float(ri.y) * (WUNSCALE * YSCALE);
                    unsigned xq[4];
#pragma unroll
                    for (int n = 0; n < 4; ++n) { const f32x4 o = acc[m][n] * w; xq[n] = pk_fp8x4(o[0], o[1], o[2], o[3]); }
                    const u32x4 z = quad_transpose(xq[0], xq[1], xq[2], xq[3]);
                    if (en != 0xffffffffu) *(u32x4*)(Y8 + ((size_t)(en & 1u) * TR + (en >> 1)) * D + nt * 128 + wc * 64 + fq * 16) = z;
#pragma unroll
                    for (int n = 0; n < 4; ++n) acc[m][n] = (f32x4){0.f, 0.f, 0.f, 0.f};
                }
            }
        }
#undef BSTAGE
    }
#undef GLDS
}

DEV void phase7(const Ctx& c) {
    const bf16_t* R1 = (const bf16_t*)(c.ws + WS_R1); const unsigned char* Y8 = c.ws + WS_Y; const float2* ST1 = (const float2*)(c.ws + WS_ST1);
    const float* g = c.in[I_LN2G]; const float* bt = c.in[I_LN2B];
    const int gw = c.vcu * 4 + c.wid, NGW = c.G * 4, lane = c.lane;
    float G1[16], B1[16];
#pragma unroll
    for (int i = 0; i < 2; ++i)
#pragma unroll
        for (int q = 0; q < 2; ++q) { const f32x4 a = *(const f32x4*)(c.in[I_LN1G] + i * 512 + lane * 8 + q * 4), bq = *(const f32x4*)(c.in[I_LN1B] + i * 512 + lane * 8 + q * 4);
#pragma unroll
            for (int e = 0; e < 4; ++e) { G1[i * 8 + q * 4 + e] = a[e]; B1[i * 8 + q * 4 + e] = bq[e]; } }
    for (int tok0 = gw; tok0 < TR; tok0 += 2 * NGW) {
        float v[2][16]; float st[2]; int tk[2];
#pragma unroll
        for (int r = 0; r < 2; ++r) {
            int tok = tok0 + r * NGW; if (tok >= TR) tok = tok0; tk[r] = tok;
            const float2 ms = ST1[tok]; const float am = ALPHA * ms.y;
#pragma unroll
            for (int i = 0; i < 2; ++i) {
                const u32x4 hw = __builtin_nontemporal_load((const u32x4*)(R1 + (size_t)tok * D + i * 512 + lane * 8));
                const u32x2 y0 = __builtin_nontemporal_load((const u32x2*)(Y8 + (size_t)tok * D + i * 512 + lane * 8));
                const u32x2 y1 = __builtin_nontemporal_load((const u32x2*)(Y8 + ((size_t)TR + tok) * D + i * 512 + lane * 8));
#pragma unroll
                for (int q2 = 0; q2 < 2; ++q2) {
                    const auto a0 = __builtin_amdgcn_cvt_pk_f32_fp8((int)y0[q2], false), a1 = __builtin_amdgcn_cvt_pk_f32_fp8((int)y0[q2], true);
                    const auto b0 = __builtin_amdgcn_cvt_pk_f32_fp8((int)y1[q2], false), b1 = __builtin_amdgcn_cvt_pk_f32_fp8((int)y1[q2], true);
                    const int e0 = i * 8 + 4 * q2;
                    v[r][e0]     = (bflo(hw[2 * q2]) - ms.x) * (am * G1[e0]) + ALPHA * B1[e0] + (a0[0] + b0[0]) * YUNSCALE;
                    v[r][e0 + 1] = (bfhi(hw[2 * q2]) - ms.x) * (am * G1[e0 + 1]) + ALPHA * B1[e0 + 1] + (a0[1] + b0[1]) * YUNSCALE;
                    v[r][e0 + 2] = (bflo(hw[2 * q2 + 1]) - ms.x) * (am * G1[e0 + 2]) + ALPHA * B1[e0 + 2] + (a1[0] + b1[0]) * YUNSCALE;
                    v[r][e0 + 3] = (bfhi(hw[2 * q2 + 1]) - ms.x) * (am * G1[e0 + 3]) + ALPHA * B1[e0 + 3] + (a1[1] + b1[1]) * YUNSCALE;
                }
            }
        }
#pragma unroll
        for (int r = 0; r < 2; ++r) { float a = 0.f;
#pragma unroll
            for (int q = 0; q < 16; ++q) a += v[r][q];
            st[r] = a; }
        wave_sum_n<2>(st);
#pragma unroll
        for (int r = 0; r < 2; ++r) { const float mean = st[r] * (1.f / 1024.f); float a = 0.f;
#pragma unroll
            for (int q = 0; q < 16; ++q) { v[r][q] -= mean; a += v[r][q] * v[r][q]; }
            st[r] = a; }
        wave_sum_n<2>(st);
#pragma unroll
        for (int i = 0; i < 2; ++i)
#pragma unroll
            for (int q = 0; q < 2; ++q) {
                const int col = i * 512 + lane * 8 + q * 4;
                const f32x4 gg = *(const f32x4*)(g + col), bb = *(const f32x4*)(bt + col);
#pragma unroll
                for (int r = 0; r < 2; ++r) {
                    if (r == 1 && tok0 + NGW >= TR) continue;
                    const float rstd = rsqrt_(st[r] * (1.f / 1024.f) + EPS);
                    f32x4 o; o[0] = v[r][i * 8 + q * 4] * rstd * gg[0] + bb[0]; o[1] = v[r][i * 8 + q * 4 + 1] * rstd * gg[1] + bb[1];
                    o[2] = v[r][i * 8 + q * 4 + 2] * rstd * gg[2] + bb[2]; o[3] = v[r][i * 8 + q * 4 + 3] * rstd * gg[3] + bb[3];
                    *(f32x4*)(c.out + (size_t)tk[r] * D + col) = o;
                }
            }
    }
}

__global__ void __launch_bounds__(256, 2) fwd_kernel(Args a) {
    extern __shared__ __attribute__((aligned(16))) unsigned char lds[];
    Ctx c; c.in = a.in; c.out = a.out; c.ws = a.ws; c.lds = lds;
    c.tid = threadIdx.x; c.lane = c.tid & 63; c.wid = __builtin_amdgcn_readfirstlane(c.tid >> 6);
    c.G = gridDim.x; { const int bx = blockIdx.x; c.vcu = (c.G % 8 == 0) ? (bx % 8) * (c.G / 8) + bx / 8 : bx; }
    if (c.tid < 64) ((unsigned*)(lds + MISC_OFF))[c.tid] = 0u;
    __syncthreads();
    unsigned* ctl = (unsigned*)(a.ws + WS_CTL);
    XcdBarrier bar = xcd_barrier_post(ctl + CW_BAR, (volatile LAS unsigned*)(lds + MISC_OFF));
#ifdef ONLY_PH
#define PH_ON(k) ((k) == ONLY_PH)
#else
#define PH_ON(k) 1
#endif
    const int lo = a.ph_lo, hi = a.ph_hi;
#define RUN_PHASE(k, fn) if (PH_ON(k) && lo <= (k) && (k) < hi) { \
        for (int _rep = 0; _rep < ((REPEAT_PH == (k)) ? 2 : 1); ++_rep) { \
            int _t = threadIdx.x; asm volatile("" : "+v"(_t)); c.tid = _t; c.lane = _t & 63; c.wid = __builtin_amdgcn_readfirstlane(_t >> 6); \
            if ((k) == 5) phase5(c, _rep); else fn(c); \
            if (_rep == 0 && REPEAT_PH == (k)) xcd_barrier(bar); } \
        if ((k) + 1 < hi) xcd_barrier(bar); }
    RUN_PHASE(0, phase0)
    RUN_PHASE(1, phase1)
    RUN_PHASE(2, phase2)
    RUN_PHASE(3, phase3)
    RUN_PHASE(4, phase4)
    RUN_PHASE(5, phase0)
    RUN_PHASE(6, phase6a)
    RUN_PHASE(7, phase6b)
    RUN_PHASE(8, phase7)
}

extern "C" void kernel_launch(void* const* d_in, const int* in_sizes, int n_in, void* d_out, int out_size, void* d_ws, size_t ws_size, hipStream_t stream) {
    static int grid = 0;
    if (grid == 0) {
        if (n_in != 27 || in_sizes[0] != NB * SEQ * D || out_size != TR * D || ws_size < WS_END) {
            fprintf(stderr, "kernel_launch: shape mismatch n_in %d in0 %d out %d ws %zu\n", n_in, n_in > 0 ? in_sizes[0] : -1, out_size, ws_size); grid = -1; return; }
        int dev = 0, cus = 0, per_cu = 0;
        if (hipGetDevice(&dev) != hipSuccess || hipDeviceGetAttribute(&cus, hipDeviceAttributeMultiprocessorCount, dev) != hipSuccess) { grid = -1; return; }
        if (hipFuncSetAttribute((const void*)fwd_kernel, hipFuncAttributeMaxDynamicSharedMemorySize, LDS_BYTES) != hipSuccess) { grid = -1; return; }
        if (hipOccupancyMaxActiveBlocksPerMultiprocessor(&per_cu, (const void*)fwd_kernel, 256, LDS_BYTES) != hipSuccess || per_cu < 1) per_cu = 1;
        (void)hipGetLastError();
        if (per_cu > 2) per_cu = 2;
        grid = cus * per_cu;
        fprintf(stderr, "kernel_launch: grid %d (%d per CU)\n", grid, per_cu);
    }
    if (grid < 0) return;
    (void)hipMemsetAsync((char*)d_ws + WS_CTL, 0, CTL_ZERO_BYTES, stream);
    Args a{};
    for (int i = 0; i < 27; ++i) a.in[i] = (const float*)d_in[i];
    a.out = (float*)d_out; a.ws = (unsigned char*)d_ws;
    if (MK_N_LAUNCHES == 1) {
        a.ph_lo = 0; a.ph_hi = NPH;
        hipLaunchKernelGGL(fwd_kernel, dim3(grid), dim3(256), LDS_BYTES, stream, a);
    } else {
        for (int ph = 0; ph < NPH; ++ph) { a.ph_lo = ph; a.ph_hi = ph + 1; hipLaunchKernelGGL(fwd_kernel, dim3(grid), dim3(256), LDS_BYTES, stream, a); }
    }
}
```

```cpp
#include <hip/hip_runtime.h>
#include <cstdio>
#include <cstdint>

#ifndef REPEAT_PH
#define REPEAT_PH -1
#endif
#ifndef CONV_REPB
#define CONV_REPB 1
#endif
#ifndef CONV_REPC
#define CONV_REPC 1
#endif
#ifndef CONV_REPA
#define CONV_REPA 1
#endif
#ifndef MK_N_LAUNCHES
#define MK_N_LAUNCHES 1
#endif

#define DEV __device__ __forceinline__
#define LAS __attribute__((address_space(3)))
#define GAS __attribute__((address_space(1)))
typedef unsigned short bf16_t;
typedef short bf16x8 __attribute__((ext_vector_type(8)));
typedef short s16x4 __attribute__((ext_vector_type(4)));
typedef float f32x4 __attribute__((ext_vector_type(4)));
typedef float f32x16 __attribute__((ext_vector_type(16)));
typedef unsigned u32x4 __attribute__((ext_vector_type(4)));
typedef unsigned u32x2 __attribute__((ext_vector_type(2)));
typedef long i64x2 __attribute__((ext_vector_type(2)));
typedef int v8i __attribute__((ext_vector_type(8)));

constexpr int NB = 16, SEQ = 2048, NMETA = 16, L = SEQ + NMETA;
constexpr int T = NB * L;
constexpr int TR = NB * SEQ;
constexpr int D = 1024, NIN = 1696, CC = 512, QL = 384, KVL = 256, NH = 8, DQK = 96, DV = 64;
constexpr int NQ = NH * DQK;
constexpr int NKV = NH * (64 + DV);
constexpr int NE = 32, DE = 256, CONVK = 31;
constexpr float EPS = 1e-5f;
constexpr float ALPHA = 1.189207115002721f;
constexpr float QSCALE = 0.10206207261596577f * 1.4426950408889634f;
constexpr int NPH = 9;
constexpr float WSCALE = 16.f, WUNSCALE = 1.f / 16.f;
constexpr float YSCALE = 64.f, YUNSCALE = 1.f / 64.f;

constexpr size_t MiB = 1u << 20;
constexpr size_t WS_CTL = 0, CTL_ZERO_BYTES = 64 * 1024;
constexpr int CW_CNT = 1024, CNT_STRIDE = 64;
constexpr int CW_BAR = 4096;
constexpr size_t WS_LIST = 1 * MiB;
constexpr size_t WS_COMBW = 5 * MiB;
constexpr size_t WS_ST1 = 5 * MiB + 256 * 1024;
constexpr size_t WS_ROPE = 5 * MiB + 512 * 1024;
constexpr size_t WS_WIN = 6 * MiB;
constexpr size_t WS_WUQ = 10 * MiB;
constexpr size_t WS_WUKV = 11 * MiB;
constexpr size_t WS_WO = 12 * MiB;
constexpr size_t WS_WR = 14 * MiB;
constexpr size_t WS_RI = 14 * MiB + 512 * 1024;
constexpr size_t WS_SSQ_CQ = 404 * MiB + 512 * 1024;
constexpr size_t WS_SSQ_CKV = 402 * MiB;
constexpr size_t WS_SSQ_O = 403 * MiB;
constexpr size_t WS_WGU = 16 * MiB;
constexpr size_t WS_WD = 48 * MiB;
constexpr size_t WS_H1F8 = 130 * MiB;
constexpr size_t WS_H0 = 64 * MiB;
constexpr size_t WS_U = 130 * MiB;
constexpr size_t WS_CQ = 163 * MiB;
constexpr size_t WS_CKV = 188 * MiB;
constexpr size_t WS_KR = 205 * MiB;
constexpr size_t WS_Q = 208 * MiB;
constexpr size_t WS_KV = 257 * MiB;
constexpr size_t WS_R1 = 208 * MiB;
constexpr size_t WS_Y = 272 * MiB;
constexpr size_t WS_MG = 336 * MiB;
constexpr size_t WS_ACT = 336 * MiB;
constexpr size_t WS_DUMMY = 400 * MiB;
constexpr size_t WS_END = 406 * MiB;

constexpr int LDS_BYTES = 73728;
constexpr int MISC_OFF = LDS_BYTES - 256;
constexpr int RS_OFF = 65536;
constexpr int TBL_OFF = 66048;
constexpr int EXP_OFF = 67584;

DEV unsigned cvtpk(float lo, float hi) { unsigned r; asm("v_cvt_pk_bf16_f32 %0, %1, %2" : "=v"(r) : "v"(lo), "v"(hi)); return r; }
DEV float bflo(unsigned w) { return __uint_as_float(w << 16); }
DEV float bfhi(unsigned w) { return __uint_as_float(w & 0xffff0000u); }
DEV float dpp_add_qp(float v, int) { return v; }
template <int CTRL> DEV float dpp_mov(float v) { return __builtin_bit_cast(float, __builtin_amdgcn_update_dpp(0, __builtin_bit_cast(int, v), CTRL, 0xf, 0xf, false)); }
DEV float wave_sum(float v) {
    v += dpp_mov<0xB1>(v);
    v += dpp_mov<0x4E>(v);
    v += dpp_mov<0x141>(v);
    v += dpp_mov<0x140>(v);
    const int iv = __builtin_bit_cast(int, v);
    const float a = __builtin_bit_cast(float, __builtin_amdgcn_readlane(iv, 0)), b = __builtin_bit_cast(float, __builtin_amdgcn_readlane(iv, 16));
    const float c = __builtin_bit_cast(float, __builtin_amdgcn_readlane(iv, 32)), d = __builtin_bit_cast(float, __builtin_amdgcn_readlane(iv, 48));
    return (a + b) + (c + d);
}
DEV float rsqrt_(float x) { return __builtin_amdgcn_rsqf(x); }
DEV void st_bf4(bf16_t* p, f32x4 v) { u32x2 w = {cvtpk(v[0], v[1]), cvtpk(v[2], v[3])}; *(u32x2*)p = w; }
DEV unsigned pk_fp8x4(float a, float b, float c, float d) {
    int w = __builtin_amdgcn_cvt_pk_fp8_f32(a, b, 0, false); w = __builtin_amdgcn_cvt_pk_fp8_f32(c, d, w, true); return (unsigned)w; }
DEV float fast_exp2(float x) { return __builtin_amdgcn_exp2f(x); }
DEV float fast_rcp(float x) { return __builtin_amdgcn_rcpf(x); }
DEV float sigmoidf_(float g) { return fast_rcp(1.f + fast_exp2(-1.4426950408889634f * g)); }
#define LDS_WAIT() asm volatile("s_waitcnt lgkmcnt(0)" ::: "memory")
#define VM_WAIT() asm volatile("s_waitcnt vmcnt(0)" ::: "memory")

#define XB_TMO      128
#define XB_XCNT(j)  (256  + 64 * (j))
#define XB_XSUB(j)  (1280 + 64 * (j))
#define XB_XGEN(j)  (2304 + 64 * (j))
#define XB_TOP      3328
#define XB_TOPGEN   3392
#define XCD_BAR_WORDS 3456
#define XB_SPIN_CAP (1u << 22)
DEV unsigned xb_ld(unsigned* p)              { return __hip_atomic_load(p, __ATOMIC_RELAXED, __HIP_MEMORY_SCOPE_AGENT); }
DEV unsigned xb_add(unsigned* p, unsigned v) { return __hip_atomic_fetch_add(p, v, __ATOMIC_RELAXED, __HIP_MEMORY_SCOPE_AGENT); }
DEV unsigned xb_xcc_id() { return (unsigned)__builtin_amdgcn_s_getreg((3 << 11) | 20) & 0xFu; }
#define XB_SPIN(cond, bar) do { unsigned _sp = 0; while (cond) { __builtin_amdgcn_s_sleep(1); \
    if ((++_sp & 255u) == 0u) { if (xb_ld(&(bar)[XB_TMO])) break; if (_sp > XB_SPIN_CAP) { atomicAdd(&(bar)[XB_TMO], 1u); break; } } } } while (0)
struct XcdBarrier { unsigned* bar; unsigned x; volatile LAS unsigned* st; };
DEV XcdBarrier xcd_barrier_post(unsigned* bar, volatile LAS unsigned* st) {
    XcdBarrier b; b.bar = bar; b.x = xb_xcc_id(); b.st = st;
    if (threadIdx.x == 0) (void)xb_add(&bar[XB_XCNT(b.x)], 1u);
    return b;
}
DEV u32x4 quad_transpose(unsigned x0, unsigned x1, unsigned x2, unsigned x3) {
    auto a = __builtin_amdgcn_permlane32_swap(x0, x2, false, false); auto b = __builtin_amdgcn_permlane32_swap(x1, x3, false, false);
    auto z0 = __builtin_amdgcn_permlane16_swap(a[0], b[0], false, false); auto z1 = __builtin_amdgcn_permlane16_swap(a[1], b[1], false, false);
    return (u32x4){z0[0], z0[1], z1[0], z1[1]};
}
DEV void st_quad_bf16(bf16_t* p, f32x4 v0, f32x4 v1, f32x4 v2, f32x4 v3) {
    const u32x4 lo = quad_transpose(cvtpk(v0[0], v0[1]), cvtpk(v1[0], v1[1]), cvtpk(v2[0], v2[1]), cvtpk(v3[0], v3[1]));
    const u32x4 hi = quad_transpose(cvtpk(v0[2], v0[3]), cvtpk(v1[2], v1[3]), cvtpk(v2[2], v2[3]), cvtpk(v3[2], v3[3]));
    *(u32x4*)p = (u32x4){lo[0], hi[0], lo[1], hi[1]}; *(u32x4*)(p + 8) = (u32x4){lo[2], hi[2], lo[3], hi[3]};
}
DEV void xcd_barrier_complete(unsigned* bar, unsigned x, unsigned& nloc, unsigned& nx) {
    const unsigned G = gridDim.x * gridDim.y * gridDim.z;
    unsigned sum, cnt, mine, sp = 0u;
    for (;;) {
        sum = 0u; cnt = 0u; mine = 0u;
#pragma unroll
        for (unsigned j = 0; j < 16; ++j) { const unsigned c = xb_ld(&bar[XB_XCNT(j)]); sum += c; cnt += (c > 0u) ? 1u : 0u; mine = (j == x) ? c : mine; }
        if (sum == G) break;
        __builtin_amdgcn_s_sleep(1);
        if ((++sp & 255u) == 0u) { if (xb_ld(&bar[XB_TMO])) break; if (sp > XB_SPIN_CAP) { atomicAdd(&bar[XB_TMO], 1u); break; } }
    }
    nloc = mine > 0u ? mine : 1u; nx = cnt > 0u ? cnt : 1u;
}
DEV void xcd_barrier(const XcdBarrier& b) {
    asm volatile("s_waitcnt vmcnt(0)" ::: "memory");
    __syncthreads();
    if (threadIdx.x == 0) {
        unsigned* bar = b.bar;
        __builtin_amdgcn_s_waitcnt(0);
        unsigned nloc = b.st[0], nx = b.st[1];
        if (nloc == 0u) { xcd_barrier_complete(bar, b.x, nloc, nx); b.st[0] = nloc; b.st[1] = nx; }
        const unsigned old = xb_add(&bar[XB_XSUB(b.x)], 1u);
        const unsigned gen = old / nloc;
        if (old + 1u == (gen + 1u) * nloc) {
            __builtin_amdgcn_fence(__ATOMIC_RELEASE, "agent");
            asm volatile("s_waitcnt vmcnt(0)" ::: "memory");
            const unsigned og = xb_add(&bar[XB_TOP], 1u);
            const unsigned tg = og / nx;
            if (og + 1u == (tg + 1u) * nx) xb_add(&bar[XB_TOPGEN], 1u);
            else XB_SPIN(xb_ld(&bar[XB_TOPGEN]) == tg, bar);
            __builtin_amdgcn_fence(__ATOMIC_ACQUIRE, "agent");
            xb_add(&bar[XB_XGEN(b.x)], 1u);
            asm volatile("s_waitcnt vmcnt(0)" ::: "memory");
        } else {
            XB_SPIN(xb_ld(&bar[XB_XGEN(b.x)]) == gen, bar);
            __builtin_amdgcn_fence(__ATOMIC_ACQUIRE, "agent");
            asm volatile("s_waitcnt vmcnt(0)" ::: "memory");
        }
    }
    __syncthreads();
}

struct Args { const float* in[27]; float* out; unsigned char* ws; int ph_lo, ph_hi; };
struct Ctx {
    const float* const* in; float* out; unsigned char* ws; unsigned char* lds;
    int tid, lane, wid, vcu, G;
};
enum { I_X = 0, I_META, I_LNIN_G, I_LNIN_B, I_WIN, I_CONVW, I_CONVB, I_CLN_G, I_CLN_B, I_QNG, I_WUQ, I_KVNG, I_WUKV, I_COUT_G, I_AOUT_G, I_WO,
       I_LN1G, I_LN1B, I_WRG, I_BRG, I_WRE, I_BRE, I_WGATE, I_WUP, I_WDOWN, I_LN2G, I_LN2B };

DEV int nmap(int mode, int n) {
    if (mode == 1) { if (n < 512) return ((n >> 4) << 5) + (n & 15); if (n < 1024) return (((n - 512) >> 4) << 5) + 16 + (n & 15); return n; }
    if (mode == 2) return ((n >> 4) << 5) + (n & 15);
    if (mode == 3) return ((n >> 4) << 5) + 16 + (n & 15);
    return n;
}
DEV void p0_transpose_item(const float* __restrict__ W, int N, int k0, int n0, const float* __restrict__ kscale, bf16_t* WT, int ldt, int kout0, int mode,
                           float* scr, int lane) {
#pragma unroll 8
    for (int i = 0; i < 32; ++i) {
        const int kk = 2 * i + (lane >> 5);
        float v = __builtin_nontemporal_load(&W[(size_t)(k0 + kk) * N + n0 + (lane & 31)]);
        if (kscale) v *= kscale[k0 + kk];
        scr[kk * 33 + (lane & 31)] = v;
    }
    LDS_WAIT(); asm volatile("" ::: "memory");
    const int c = lane & 7;
#pragma unroll
    for (int j = 0; j < 4; ++j) {
        const int n = (lane >> 3) + 8 * j; const float* s = scr + (8 * c) * 33 + n;
        u32x4 o; o.x = cvtpk(s[0 * 33], s[1 * 33]); o.y = cvtpk(s[2 * 33], s[3 * 33]); o.z = cvtpk(s[4 * 33], s[5 * 33]); o.w = cvtpk(s[6 * 33], s[7 * 33]);
        *(u32x4*)(WT + (size_t)nmap(mode, n0 + n) * ldt + kout0 + 8 * c) = o;
    }
    LDS_WAIT(); asm volatile("" ::: "memory");
}
DEV void p0_transpose_item_f8(const float* __restrict__ W, int N, int k0, int n0, float scale, unsigned char* W8, int ldt, int kout0, int mode, float* scr, int lane) {
#pragma unroll 8
    for (int i = 0; i < 32; ++i) { const int kk = 2 * i + (lane >> 5); scr[kk * 33 + (lane & 31)] = W[(size_t)(k0 + kk) * N + n0 + (lane & 31)] * scale; }
    LDS_WAIT(); asm volatile("" ::: "memory");
    const int c = lane & 7;
#pragma unroll
    for (int j = 0; j < 4; ++j) {
        const int n = (lane >> 3) + 8 * j; const float* sp = scr + (8 * c) * 33 + n;
        u32x2 o; o.x = pk_fp8x4(sp[0 * 33], sp[1 * 33], sp[2 * 33], sp[3 * 33]); o.y = pk_fp8x4(sp[4 * 33], sp[5 * 33], sp[6 * 33], sp[7 * 33]);
        *(u32x2*)(W8 + (size_t)nmap(mode, n0 + n) * ldt + kout0 + 8 * c) = o;
    }
    LDS_WAIT(); asm volatile("" ::: "memory");
}
template <int N> DEV void wave_sum_n(float (&v)[N]) {
#pragma unroll
    for (int i = 0; i < N; ++i) v[i] = wave_sum(v[i]);
}
template <int NR, bool F8 = false, bool BFIN = false, bool NOBF = false> DEV void ln_rows_bf16(const float* const (&xrow)[NR], const float* g, const float* bta, bf16_t* const (&orow)[NR], unsigned char* const (&ldsrow)[NR], int lane, unsigned char* const* f8row = nullptr, float* const* strow = nullptr) {
    f32x4 v[NR][4]; float s[NR];
#pragma unroll
    for (int r = 0; r < NR; ++r)
#pragma unroll
        for (int j = 0; j < 4; ++j) {
            if (BFIN) { const u32x2 w = ((const u32x2*)xrow[r])[64 * j + lane]; v[r][j] = (f32x4){bflo(w.x), bfhi(w.x), bflo(w.y), bfhi(w.y)}; }
            else v[r][j] = __builtin_nontemporal_load(&((const f32x4*)xrow[r])[64 * j + lane]); }
#pragma unroll
    for (int r = 0; r < NR; ++r) { s[r] = 0.f;
#pragma unroll
        for (int j = 0; j < 4; ++j) s[r] += (v[r][j].x + v[r][j].y) + (v[r][j].z + v[r][j].w); }
    wave_sum_n<NR>(s);
    float s2[NR];
#pragma unroll
    for (int r = 0; r < NR; ++r) { const float mean = s[r] * (1.f / 1024.f); s2[r] = 0.f;
#pragma unroll
        for (int j = 0; j < 4; ++j) { v[r][j] = v[r][j] - mean; s2[r] += (v[r][j].x * v[r][j].x + v[r][j].y * v[r][j].y) + (v[r][j].z * v[r][j].z + v[r][j].w * v[r][j].w); } }
    wave_sum_n<NR>(s2);
    if (strow) {
#pragma unroll
        for (int r = 0; r < NR; ++r) if (lane == 0) { strow[r][0] = s[r] * (1.f / 1024.f); strow[r][1] = rsqrt_(s2[r] * (1.f / 1024.f) + EPS); }
    }
#pragma unroll
    for (int j = 0; j < 4; ++j) {
        const f32x4 gg = ((const f32x4*)g)[64 * j + lane], bb = ((const f32x4*)bta)[64 * j + lane];
#pragma unroll
        for (int r = 0; r < NR; ++r) {
            const float rstd = rsqrt_(s2[r] * (1.f / 1024.f) + EPS);
            const f32x4 o = v[r][j] * rstd * gg + bb;
            const u32x2 w = {cvtpk(o.x, o.y), cvtpk(o.z, o.w)};
            if (!NOBF) ((u32x2*)orow[r])[64 * j + lane] = w;
            if (ldsrow[r]) ((u32x2*)ldsrow[r])[64 * j + lane] = w;
            if (F8) ((unsigned*)f8row[r])[64 * j + lane] = pk_fp8x4(o.x, o.y, o.z, o.w);
        }
    }
}
__device__ const float INVF[16] = {1.0f, 0.5623413251903491f, 0.31622776601683794f, 0.1778279410038923f, 0.1f, 0.05623413251903491f, 0.031622776601683794f,
    0.01778279410038923f, 0.01f, 0.005623413251903491f, 0.0031622776601683794f, 0.001778279410038923f, 0.001f, 0.0005623413251903491f, 0.00031622776601683794f, 0.0001778279410038923f};
DEV void sincos_d(double a, float& sn, float& cs) {
    const double TWO_PI = 6.283185307179586476925286766559, INV_TWO_PI = 0.15915494309189533576888376337251;
    const double k = __builtin_rint(a * INV_TWO_PI);
    const double r = a - k * TWO_PI;
    const double r2 = r * r;
    double ps = 1.0, pc = 1.0;
#pragma unroll
    for (int i = 14; i >= 1; --i) {
        pc = 1.0 - pc * r2 * (1.0 / (double)((2 * i - 1) * (2 * i)));
        ps = 1.0 - ps * r2 * (1.0 / (double)((2 * i) * (2 * i + 1)));
    }
    sn = (float)(r * ps); cs = (float)pc;
}
DEV void ew_block(const float* __restrict__ W, int N, int k0, int n0, unsigned char* W8, int ldt, int mode, int lane) {
    const int q = lane & 15, kq = lane >> 4;
    const float* src = W + (size_t)(k0 + 16 * kq) * N + n0 + 4 * q;
    f32x4 v[16];
#pragma unroll
    for (int i = 0; i < 16; ++i) v[i] = __builtin_nontemporal_load((const f32x4*)(src + (size_t)i * N));
#pragma unroll
    for (int j = 0; j < 4; ++j) {
        u32x4 o;
        o.x = pk_fp8x4(v[0][j] * WSCALE, v[1][j] * WSCALE, v[2][j] * WSCALE, v[3][j] * WSCALE);
        o.y = pk_fp8x4(v[4][j] * WSCALE, v[5][j] * WSCALE, v[6][j] * WSCALE, v[7][j] * WSCALE);
        o.z = pk_fp8x4(v[8][j] * WSCALE, v[9][j] * WSCALE, v[10][j] * WSCALE, v[11][j] * WSCALE);
        o.w = pk_fp8x4(v[12][j] * WSCALE, v[13][j] * WSCALE, v[14][j] * WSCALE, v[15][j] * WSCALE);
        *(u32x4*)(W8 + (size_t)nmap(mode, n0 + 4 * q + j) * ldt + k0 + 16 * kq) = o;
    }
}
DEV void expert_weight_item(const Ctx& c, int r, float*  ) {
    unsigned char* Wgu8 = c.ws + WS_WGU; unsigned char* Wd8 = c.ws + WS_WD;
    if (r < 2048) { const int e = r >> 6, qq = r & 63, kb = qq >> 2, nb = qq & 3;
        ew_block(c.in[I_WGATE] + (size_t)e * D * DE, DE, 64 * kb, 64 * nb, Wgu8 + (size_t)e * 512 * 1024, 1024, 2, c.lane); return; } r -= 2048;
    if (r < 2048) { const int e = r >> 6, qq = r & 63, kb = qq >> 2, nb = qq & 3;
        ew_block(c.in[I_WUP] + (size_t)e * D * DE, DE, 64 * kb, 64 * nb, Wgu8 + (size_t)e * 512 * 1024, 1024, 3, c.lane); return; } r -= 2048;
    { const int e = r >> 6, qq = r & 63, kb = qq >> 4, nb = qq & 15;
        ew_block(c.in[I_WDOWN] + (size_t)e * DE * D, D, 64 * kb, 64 * nb, Wd8 + (size_t)e * 1024 * 256, 256, 0, c.lane); }
}
DEV void phase0(const Ctx& c) {
    float* scr = (float*)(c.lds + c.wid * 8448);
    const int gw = c.vcu * 4 + c.wid, NGW = c.G * 4;
    constexpr int I_IN = 16 * 53, I_UQ = 6 * 24, I_UKV = 4 * 32, I_O = 16 * 32;
    bf16_t* WinT = (bf16_t*)(c.ws + WS_WIN); bf16_t* WuqT = (bf16_t*)(c.ws + WS_WUQ); bf16_t* WukvT = (bf16_t*)(c.ws + WS_WUKV);
    bf16_t* WoT = (bf16_t*)(c.ws + WS_WO);
    constexpr int NITEMS0 = I_IN + I_UQ + I_UKV + I_O;
    for (int it = gw; it < NITEMS0; it += NGW) {
        int r = it;
        if (r < I_IN) { const int kb = r / 53, nb = r % 53; p0_transpose_item(c.in[I_WIN], NIN, 64 * kb, 32 * nb, nullptr, WinT, 1024, 64 * kb, 1, scr, c.lane); continue; } r -= I_IN;
        if (r < I_UQ) { const int kb = r / 24, nb = r % 24; p0_transpose_item(c.in[I_WUQ], NQ, 64 * kb, 32 * nb, c.in[I_QNG], WuqT, QL, 64 * kb, 0, scr, c.lane); continue; } r -= I_UQ;
        if (r < I_UKV) { const int kb = r / 32, nb = r % 32; p0_transpose_item(c.in[I_WUKV], NKV, 64 * kb, 32 * nb, c.in[I_KVNG], WukvT, KVL, 64 * kb, 0, scr, c.lane); continue; } r -= I_UKV;
        { const int kb = r / 32, nb = r % 32;
            if (kb < 8) p0_transpose_item(c.in[I_WO], D, 64 * kb, 32 * nb, nullptr, WoT, 1024, 64 * kb + 512, 0, scr, c.lane);
            else        p0_transpose_item(c.in[I_WO], D, 64 * kb, 32 * nb, c.in[I_AOUT_G] - 512, WoT, 1024, 64 * kb - 512, 0, scr, c.lane); }
    }
    const int gt = c.vcu * 256 + c.tid, NGT = c.G * 256;
    bf16_t* WrT = (bf16_t*)(c.ws + WS_WR);
    for (int i = gt; i < 48 * 1024; i += NGT) {
        const int n = i >> 10, k = i & 1023; float v = 0.f;
        if (n < 4) v = c.in[I_WRG][k * 4 + n]; else if (n < 36) v = c.in[I_WRE][k * 32 + (n - 4)];
        WrT[i] = (bf16_t)(cvtpk(v, 0.f) & 0xffffu);
    }
    float* rc = (float*)(c.ws + WS_ROPE); float* rs = rc + L * 16;
    for (int i = gt; i < L * 16; i += NGT) {
        const int p = i >> 4, f = i & 15; const float ang = (float)p * INVF[f];
        float sn, cs; sincos_d((double)ang, sn, cs); rc[i] = cs; rs[i] = sn;
    }
    bf16_t* h0 = (bf16_t*)(c.ws + WS_H0);
    for (int t = gw; t < T; t += 2 * NGW) {
        const float* src[2]; bf16_t* dst[2]; unsigned char* ldsn[2] = {nullptr, nullptr};
#pragma unroll
        for (int r = 0; r < 2; ++r) { int tt = t + r * NGW; if (tt >= T) tt = t;
            const int b = tt / L, p = tt - b * L;
            src[r] = (p < NMETA) ? c.in[I_META] + (size_t)p * D : c.in[I_X] + ((size_t)b * SEQ + (p - NMETA)) * D;
            dst[r] = h0 + (size_t)tt * D; }
        ln_rows_bf16<2>(src, c.in[I_LNIN_G], c.in[I_LNIN_B], dst, ldsn, c.lane);
    }
}

struct StageGeo { int r[4]; int c; };
DEV StageGeo stage_geo(int tid) {
    const int lane = tid & 63, wid = tid >> 6; StageGeo g;
    const int rl = lane >> 2, cl = ((lane & 3) * 8) ^ ((lane >> 5) << 4);
#pragma unroll
    for (int i = 0; i < 4; ++i) g.r[i] = (((wid + 4 * i) >> 1) << 4) + rl;
    g.c = ((wid & 1) << 5) + cl;
    return g;
}
template <bool SSQ, bool FP8 = false>
DEV void gemm_mainloop(f32x4 (&acc)[4][4], const bf16_t* ap0, const bf16_t* ap1, const bf16_t* ap2, const bf16_t* ap3,
                       const bf16_t* bp0, const bf16_t* bp1, const bf16_t* bp2, const bf16_t* bp3,
                       int nk, unsigned char* lds, int ssq_steps, float ssq_inv_dim, bool skip_wc1 = false) {
    const int tid = threadIdx.x, lane = tid & 63, wid = tid >> 6, wr = wid >> 1, wc = wid & 1, fr = lane & 15, fq = lane >> 4;
    const int xs = (fr >> 1) & 7;
    const int lo = ((fr * 64 + fq * 16) ^ ((fr >> 3) << 5));
    const int lo0 = lo, lo1 = lo + 1024;
    const int a_off = wr * 8192, b_off = 16384 + wc * 8192;
    const int dst = tid * 16;
#pragma unroll
    for (int m = 0; m < 4; ++m)
#pragma unroll
        for (int n = 0; n < 4; ++n) acc[m][n] = (f32x4){0.f, 0.f, 0.f, 0.f};
    __syncthreads();
#define GLDS(src, off) __builtin_amdgcn_global_load_lds((const unsigned*)(src), (unsigned LAS*)(lds + (off)), 16, 0, 0)
#define STAGE(kt, b) do { const int _k = (kt) * 64; \
        GLDS(ap0 + _k, (b) * 32768 + dst);          GLDS(ap1 + _k, (b) * 32768 + dst + 4096); \
        GLDS(ap2 + _k, (b) * 32768 + dst + 8192);   GLDS(ap3 + _k, (b) * 32768 + dst + 12288); \
        GLDS(bp0 + _k, (b) * 32768 + 16384 + dst);  GLDS(bp1 + _k, (b) * 32768 + 16384 + dst + 4096); \
        GLDS(bp2 + _k, (b) * 32768 + 16384 + dst + 8192); GLDS(bp3 + _k, (b) * 32768 + 16384 + dst + 12288); } while (0)
    STAGE(0, 0);
    for (int kt = 0; kt < nk; ++kt) {
        VM_WAIT();
        __syncthreads();
        const int b = kt & 1;
        if (SSQ && kt == ssq_steps) {
            const float* rsl = (const float*)(lds + RS_OFF);
#pragma unroll
            for (int m = 0; m < 4; ++m) { const float r = rsl[wr * 64 + m * 16 + fr];
#pragma unroll
                for (int n = 0; n < 4; ++n) acc[m][n] = acc[m][n] * r; }
        }
        if (kt + 1 < nk) { if (b) STAGE(kt + 1, 0); else STAGE(kt + 1, 1); }
        const unsigned char* base = lds + b * 32768;
        if (skip_wc1 && wc == 1) {
        } else if (FP8) {
            const int cb0 = fq * 32, cb1 = fq * 32 + 16;
            const int q0 = (cb0 >> 6) * 1024 + ((fr * 64 + (cb0 & 63)) ^ ((fr >> 3) << 5)), q1 = (cb1 >> 6) * 1024 + ((fr * 64 + (cb1 & 63)) ^ ((fr >> 3) << 5));
            v8i ax[4], bx[4];
#pragma unroll
            for (int m = 0; m < 4; ++m) { const u32x4 c0 = *(const u32x4*)(base + a_off + m * 2048 + q0), c1 = *(const u32x4*)(base + a_off + m * 2048 + q1);
                ax[m] = (v8i){(int)c0.x, (int)c0.y, (int)c0.z, (int)c0.w, (int)c1.x, (int)c1.y, (int)c1.z, (int)c1.w}; }
#pragma unroll
            for (int n = 0; n < 4; ++n) { const u32x4 c0 = *(const u32x4*)(base + b_off + n * 2048 + q0), c1 = *(const u32x4*)(base + b_off + n * 2048 + q1);
                bx[n] = (v8i){(int)c0.x, (int)c0.y, (int)c0.z, (int)c0.w, (int)c1.x, (int)c1.y, (int)c1.z, (int)c1.w}; }
#pragma unroll
            for (int m = 0; m < 4; ++m)
#pragma unroll
                for (int n = 0; n < 4; ++n) acc[m][n] = __builtin_amdgcn_mfma_scale_f32_16x16x128_f8f6f4(bx[n], ax[m], acc[m][n], 0, 0, 0, 0x7F7F7F7F, 0, 0x7F7F7F7F);
        } else {
#pragma unroll
        for (int ks = 0; ks < 2; ++ks) {
            bf16x8 af[4], bf[4];
#pragma unroll
            for (int m = 0; m < 4; ++m) af[m] = *(const bf16x8*)(base + a_off + m * 2048 + (ks ? lo1 : lo0));
#pragma unroll
            for (int n = 0; n < 4; ++n) bf[n] = *(const bf16x8*)(base + b_off + n * 2048 + (ks ? lo1 : lo0));
#pragma unroll
            for (int m = 0; m < 4; ++m)
#pragma unroll
                for (int n = 0; n < 4; ++n) acc[m][n] = __builtin_amdgcn_mfma_f32_16x16x32_bf16(bf[n], af[m], acc[m][n], 0, 0, 0);
        }
        }
    }
    if (SSQ && ssq_steps == nk) {
        __syncthreads();
        const float* rsl = (const float*)(lds + RS_OFF);
#pragma unroll
        for (int m = 0; m < 4; ++m) { const float r = rsl[wr * 64 + m * 16 + fr];
#pragma unroll
            for (int n = 0; n < 4; ++n) acc[m][n] = acc[m][n] * r; }
    }
#undef STAGE
#undef GLDS
}

DEV void phase1(const Ctx& c) {
    const bf16_t* h0 = (const bf16_t*)(c.ws + WS_H0); const bf16_t* WinT = (const bf16_t*)(c.ws + WS_WIN);
    bf16_t* U = (bf16_t*)(c.ws + WS_U); bf16_t* CQ = (bf16_t*)(c.ws + WS_CQ); bf16_t* CKV = (bf16_t*)(c.ws + WS_CKV); bf16_t* KR = (bf16_t*)(c.ws + WS_KR);
    const float* rc = (const float*)(c.ws + WS_ROPE); const float* rs = rc + L * 16;
    const StageGeo g = stage_geo(c.tid);
    const int lane = c.lane, wr = c.wid >> 1, wc = c.wid & 1, fr = lane & 15, fq = lane >> 4;
    constexpr int NT = 14, NU = (T / 128) * NT;
    for (int u = c.vcu; u < NU; u += c.G) {
        const int mt = u / NT, nt = u - mt * NT;
        const bf16_t* A = h0 + (size_t)(mt * 128) * D + g.c; const bf16_t* B = WinT + (size_t)(nt * 128) * D + g.c;
        f32x4 acc[4][4];
        gemm_mainloop<false>(acc, A + (size_t)g.r[0] * D, A + (size_t)g.r[1] * D, A + (size_t)g.r[2] * D, A + (size_t)g.r[3] * D,
                             B + (size_t)g.r[0] * D, B + (size_t)g.r[1] * D, B + (size_t)g.r[2] * D, B + (size_t)g.r[3] * D, 16, c.lds, 0, 0.f, nt == 13);
        const int row0 = mt * 128 + wr * 64 + fr;
        if (nt < 8) {
#pragma unroll
            for (int mp = 0; mp < 2; ++mp) {
                f32x4 o[4];
#pragma unroll
                for (int q = 0; q < 4; ++q) { const f32x4 a = acc[2 * mp + (q >> 1)][2 * (q & 1)], gt = acc[2 * mp + (q >> 1)][2 * (q & 1) + 1];
#pragma unroll
                    for (int j = 0; j < 4; ++j) o[q][j] = a[j] * sigmoidf_(gt[j]); }
                const size_t row = row0 + (2 * mp + (fq >> 1)) * 16;
                st_quad_bf16(U + row * CC + nt * 64 + wc * 32 + (fq & 1) * 16, o[0], o[1], o[2], o[3]);
            }
        } else if (nt < 13) {
            const bool isq = nt < 11;
            bf16_t* dstb = isq ? CQ + (nt - 8) * 128 + wc * 64 + fq * 16 : CKV + (nt - 11) * 128 + wc * 64 + fq * 16;
            const int ldd = isq ? QL : KVL;
            float* ssb = isq ? (float*)(c.ws + WS_SSQ_CQ) + (nt - 8) * 2 + wc : (float*)(c.ws + WS_SSQ_CKV) + (nt - 11) * 2 + wc;
            const int lds_ = isq ? 8 : 4;
#pragma unroll
            for (int m = 0; m < 4; ++m) { const size_t row = row0 + m * 16; float sq = 0.f;
#pragma unroll
                for (int n = 0; n < 4; ++n) sq += (acc[m][n][0] * acc[m][n][0] + acc[m][n][1] * acc[m][n][1]) + (acc[m][n][2] * acc[m][n][2] + acc[m][n][3] * acc[m][n][3]);
                st_quad_bf16(dstb + row * ldd, acc[m][0], acc[m][1], acc[m][2], acc[m][3]);
                sq += __shfl_xor(sq, 16); sq += __shfl_xor(sq, 32);
                if (fq == 0) ssb[row * lds_] = sq; }
        } else if (wc == 0) {
#pragma unroll
            for (int mp = 0; mp < 2; ++mp) { f32x4 o[4];
#pragma unroll
                for (int mm = 0; mm < 2; ++mm) { const int m = 2 * mp + mm; const int row = row0 + m * 16; const int p = row % L;
                    const f32x4 cs = *(const f32x4*)(rc + p * 16 + fq * 4), sn = *(const f32x4*)(rs + p * 16 + fq * 4);
                    const f32x4 x1 = acc[m][0], x2 = acc[m][1];
                    o[2 * mm] = x1 * cs - x2 * sn; o[2 * mm + 1] = x1 * sn + x2 * cs; }
                st_quad_bf16(KR + (size_t)(row0 + (2 * mp + (fq >> 1)) * 16) * 32 + (fq & 1) * 16, o[0], o[1], o[2], o[3]); }
        }
    }
}

DEV void conv_unit(const Ctx& c, int b, int j) {
    const bf16_t* U = (const bf16_t*)(c.ws + WS_U);
    bf16_t* MG = (bf16_t*)(c.ws + WS_MG);
    const float* cw = c.in[I_CONVW]; const float* cb = c.in[I_CONVB];
    const int p0 = NMETA + j * 32;
    float* ytile = (float*)c.lds;
    __syncthreads();
#pragma unroll 1
    for (int pass = 0; pass < 2; ++pass) {
        const int ch = c.tid + 256 * pass;
        float win[62]; unsigned raw[62];
        const bf16_t* ub = U + (size_t)b * L * CC + ch;
#pragma unroll
        for (int rep = 0; rep < CONV_REPA; ++rep) {
        asm volatile("" : "+v"(ub) :: "memory");
#pragma unroll
        for (int i = 0; i < 62; ++i) { const int p = p0 - 30 + i; const int pc = p < 0 ? 0 : (p >= L ? L - 1 : p); raw[i] = ub[(size_t)pc * CC]; }
        if (rep + 1 < CONV_REPA) {
#pragma unroll
            for (int i = 0; i < 62; ++i) asm volatile("" :: "v"(raw[i]));
        }
        }
        float w[31];
#pragma unroll
        for (int k = 0; k < 31; ++k) w[k] = cw[k * CC + ch];
        float bias = cb[ch];
        __builtin_amdgcn_sched_barrier(0);
#pragma unroll
        for (int i = 0; i < 62; ++i) { const int p = p0 - 30 + i; win[i] = (p >= 0 && p < L) ? __uint_as_float(raw[i] << 16) : 0.f; }
#pragma unroll
        for (int rep = 0; rep < CONV_REPB; ++rep) {
        asm volatile("" : "+v"(bias) :: "memory");
#pragma unroll
        for (int tt = 0; tt < 32; ++tt) {
            float a0 = bias;
#pragma unroll
            for (int k = 0; k < 31; ++k) a0 += w[k] * win[tt + k];
            ytile[tt * 512 + ch] = a0;
        }
        }
    }
    __syncthreads();
    const float* g1 = c.in[I_CLN_G]; const float* b1 = c.in[I_CLN_B]; const float* g2 = c.in[I_COUT_G];
    float G1[8], B1[8], G2[8];
    { const f32x4 a = *(const f32x4*)(g1 + c.lane * 8), bq = *(const f32x4*)(g1 + c.lane * 8 + 4); G1[0]=a.x;G1[1]=a.y;G1[2]=a.z;G1[3]=a.w;G1[4]=bq.x;G1[5]=bq.y;G1[6]=bq.z;G1[7]=bq.w; }
    { const f32x4 a = *(const f32x4*)(b1 + c.lane * 8), bq = *(const f32x4*)(b1 + c.lane * 8 + 4); B1[0]=a.x;B1[1]=a.y;B1[2]=a.z;B1[3]=a.w;B1[4]=bq.x;B1[5]=bq.y;B1[6]=bq.z;B1[7]=bq.w; }
    { const f32x4 a = *(const f32x4*)(g2 + c.lane * 8), bq = *(const f32x4*)(g2 + c.lane * 8 + 4); G2[0]=a.x;G2[1]=a.y;G2[2]=a.z;G2[3]=a.w;G2[4]=bq.x;G2[5]=bq.y;G2[6]=bq.z;G2[7]=bq.w; }
#pragma unroll
    for (int rep = 0; rep < CONV_REPC; ++rep) {
    asm volatile("" : "+v"(ytile) :: "memory");
    float v[8][8]; float st[8];
#pragma unroll
    for (int i = 0; i < 8; ++i) { const int tt = c.wid * 8 + i;
        const f32x4 ya = *(const f32x4*)(ytile + tt * 512 + c.lane * 8), yb = *(const f32x4*)(ytile + tt * 512 + c.lane * 8 + 4);
        v[i][0]=ya.x;v[i][1]=ya.y;v[i][2]=ya.z;v[i][3]=ya.w;v[i][4]=yb.x;v[i][5]=yb.y;v[i][6]=yb.z;v[i][7]=yb.w;
        st[i] = ((v[i][0] + v[i][1]) + (v[i][2] + v[i][3])) + ((v[i][4] + v[i][5]) + (v[i][6] + v[i][7])); }
    wave_sum_n<8>(st);
#pragma unroll
    for (int i = 0; i < 8; ++i) { const float mean = st[i] * (1.f / 512.f); float a = 0.f;
#pragma unroll
        for (int q = 0; q < 8; ++q) { v[i][q] -= mean; a += v[i][q] * v[i][q]; }
        st[i] = a; }
    wave_sum_n<8>(st);
#pragma unroll
    for (int i = 0; i < 8; ++i) { const float rstd = rsqrt_(st[i] * (1.f / 512.f) + EPS); float a = 0.f;
#pragma unroll
        for (int q = 0; q < 8; ++q) { const float x = v[i][q] * rstd * G1[q] + B1[q]; const float y = x * sigmoidf_(x); v[i][q] = y; a += y * y; }
        st[i] = a; }
    wave_sum_n<8>(st);
#pragma unroll
    for (int i = 0; i < 8; ++i) {
        const int p = p0 + c.wid * 8 + i;
        {
            const float r2 = rsqrt_(st[i] * (1.f / 512.f) + EPS);
            u32x4 o;
            o.x = cvtpk(v[i][0] * r2 * G2[0], v[i][1] * r2 * G2[1]); o.y = cvtpk(v[i][2] * r2 * G2[2], v[i][3] * r2 * G2[3]);
            o.z = cvtpk(v[i][4] * r2 * G2[4], v[i][5] * r2 * G2[5]); o.w = cvtpk(v[i][6] * r2 * G2[6], v[i][7] * r2 * G2[7]);
            const size_t tok = (size_t)b * SEQ + (p - NMETA);
            bf16_t* dstp = (p >= NMETA && p < L) ? MG + tok * D + 512 + c.lane * 8 : (bf16_t*)(c.ws + WS_DUMMY) + c.lane * 8;
            *(u32x4*)dstp = o;
        }
    }
    }
}
DEV void rope4(f32x4& x1, f32x4& x2, const float* rc, const float* rs, int p, int fq) {
    const f32x4 cs = *(const f32x4*)(rc + p * 16 + fq * 4), sn = *(const f32x4*)(rs + p * 16 + fq * 4);
    const f32x4 a = x1 * cs - x2 * sn, bb = x1 * sn + x2 * cs; x1 = a; x2 = bb;
}
DEV void phase2(const Ctx& c) {
    const bf16_t* CQ = (const bf16_t*)(c.ws + WS_CQ); const bf16_t* CKV = (const bf16_t*)(c.ws + WS_CKV);
    const bf16_t* WuqT = (const bf16_t*)(c.ws + WS_WUQ); const bf16_t* WukvT = (const bf16_t*)(c.ws + WS_WUKV);
    bf16_t* Q = (bf16_t*)(c.ws + WS_Q); bf16_t* KV = (bf16_t*)(c.ws + WS_KV);
    const float* rc = (const float*)(c.ws + WS_ROPE); const float* rs = rc + L * 16;
    const StageGeo g = stage_geo(c.tid);
    const int lane = c.lane, wr = c.wid >> 1, wc = c.wid & 1, fr = lane & 15, fq = lane >> 4;
    constexpr int NUC = NB * 64, NUQ = (TR / 128) * 6, NUKV = (TR / 128) * 8 + 8, NU = NUC + NUQ + NUKV;
    const int li = c.vcu & 63, rev = ((li >> 5) ^ li) & 1;
    const int nmine = (NU - c.vcu + c.G - 1) / c.G;
    for (int it = 0; it < nmine; ++it) {
        const int u = c.vcu + (rev ? (nmine - 1 - it) : it) * c.G;
        if (u < NUC) {
            conv_unit(c, u >> 6, u & 63);
        } else if (u < NUC + NUQ) {
            const int v = u - NUC, mt = v / 6, nt = v - mt * 6;
            const size_t t0 = (size_t)(mt >> 4) * L + NMETA + (mt & 15) * 128;
            const bf16_t* A = CQ + t0 * QL + g.c; const bf16_t* B = WuqT + (size_t)(nt * 128) * QL + g.c;
            f32x4 acc[4][4];
            __syncthreads();
            if (c.tid < 128) { const float* pp = (const float*)(c.ws + WS_SSQ_CQ) + (t0 + c.tid) * 8; const f32x4 p4 = *(const f32x4*)pp; const float2 p2 = *(const float2*)(pp + 4);
                ((float*)(c.lds + RS_OFF))[c.tid] = rsqrt_((((p4.x + p4.y) + (p4.z + p4.w)) + (p2.x + p2.y)) * (1.f / 384.f) + EPS); }
            gemm_mainloop<true>(acc, A + (size_t)g.r[0] * QL, A + (size_t)g.r[1] * QL, A + (size_t)g.r[2] * QL, A + (size_t)g.r[3] * QL,
                                B + (size_t)g.r[0] * QL, B + (size_t)g.r[1] * QL, B + (size_t)g.r[2] * QL, B + (size_t)g.r[3] * QL, 6, c.lds, 6, 1.f / 384.f);
            const int p0 = NMETA + (mt & 15) * 128 + wr * 64 + fr;
            const int t16 = (nt * 8 + wc * 4) % 6;
#pragma unroll
            for (int m = 0; m < 4; ++m) { const size_t row = t0 + wr * 64 + m * 16 + fr; const int p = p0 + m * 16;
#pragma unroll
                for (int n = 0; n < 4; ++n) acc[m][n] = acc[m][n] * QSCALE;
                if (t16 == 4) rope4(acc[m][0], acc[m][1], rc, rs, p, fq);
                if (t16 == 2) rope4(acc[m][2], acc[m][3], rc, rs, p, fq);
                st_quad_bf16(Q + row * NQ + nt * 128 + wc * 64 + fq * 16, acc[m][0], acc[m][1], acc[m][2], acc[m][3]); }
        } else {
            const int v = u - NUC - NUQ; const bool meta = v >= (TR / 128) * 8;
            const int mt = meta ? 0 : v >> 3, nt = meta ? v - (TR / 128) * 8 : v & 7;
            const size_t t0 = meta ? 0 : (size_t)(mt >> 4) * L + NMETA + (mt & 15) * 128;
            const int rmask = meta ? 15 : 127;
            const bf16_t* A = CKV + t0 * KVL + g.c; const bf16_t* B = WukvT + (size_t)(nt * 128) * KVL + g.c;
            f32x4 acc[4][4];
            __syncthreads();
            if (c.tid < 128) { const f32x4 p4 = *(const f32x4*)((const float*)(c.ws + WS_SSQ_CKV) + (t0 + (c.tid & rmask)) * 4);
                ((float*)(c.lds + RS_OFF))[c.tid] = rsqrt_(((p4.x + p4.y) + (p4.z + p4.w)) * (1.f / 256.f) + EPS); }
            gemm_mainloop<true>(acc, A + (size_t)(g.r[0] & rmask) * KVL, A + (size_t)(g.r[1] & rmask) * KVL, A + (size_t)(g.r[2] & rmask) * KVL, A + (size_t)(g.r[3] & rmask) * KVL,
                                B + (size_t)g.r[0] * KVL, B + (size_t)g.r[1] * KVL, B + (size_t)g.r[2] * KVL, B + (size_t)g.r[3] * KVL, 4, c.lds, 4, 1.f / 256.f);
            if (!meta) {
#pragma unroll
                for (int m = 0; m < 4; ++m) { const size_t row = t0 + wr * 64 + m * 16 + fr;
                    st_quad_bf16(KV + row * NKV + nt * 128 + wc * 64 + fq * 16, acc[m][0], acc[m][1], acc[m][2], acc[m][3]); }
            } else if (wr == 0) {
#pragma unroll 1
                for (int bb = 0; bb < NB; ++bb) {
#pragma unroll
                    for (int n = 0; n < 4; ++n) st_bf4(KV + ((size_t)bb * L + fr) * NKV + nt * 128 + wc * 64 + n * 16 + fq * 4, acc[0][n]); }
            }
        }
    }
}
DEV int crow(int r, int hi) { return (r & 3) + 8 * (r >> 2) + 4 * hi; }
#define KSWZ(row, colB) ((row) * 256 + ((colB) ^ (((row) & 7) << 4)))
#define SBAR() __builtin_amdgcn_sched_barrier(0)
DEV int v_st(int k, int cc) { const int kk = (k & ~0xC) | ((k & 4) << 1) | ((k & 8) >> 1); return ((kk >> 3) * 4 + (cc >> 5)) * 512 + ((kk & 7) * 32 + (cc & 31)) * 2; }
DEV int v_rd_base(int lane) { return ((lane & 3) << 3) | (((lane >> 2) & 3) << 6) | (((lane >> 4) & 1) << 5) | (((lane >> 5) & 1) << 8); }
constexpr int v_rd_off(int d0, int ks, int half) { return d0 * 512 + ks * 4096 + half * 2048; }
template <int OFF> DEV s16x4 tr_read(int vb) { s16x4 r; asm volatile("ds_read_b64_tr_b16 %0, %1 offset:%2" : "=&v"(r) : "v"(vb), "i"(OFF) : "memory"); return r; }
template <int D0> DEV void pv_one(f32x16& od, int vb, bf16x8 pa0, bf16x8 pa1, bf16x8 pa2, bf16x8 pa3) {
    const s16x4 l0 = tr_read<v_rd_off(D0, 0, 0)>(vb), h0 = tr_read<v_rd_off(D0, 0, 1)>(vb), l1 = tr_read<v_rd_off(D0, 1, 0)>(vb), h1 = tr_read<v_rd_off(D0, 1, 1)>(vb);
    const s16x4 l2 = tr_read<v_rd_off(D0, 2, 0)>(vb), h2 = tr_read<v_rd_off(D0, 2, 1)>(vb), l3 = tr_read<v_rd_off(D0, 3, 0)>(vb), h3 = tr_read<v_rd_off(D0, 3, 1)>(vb);
    asm volatile("s_waitcnt lgkmcnt(0)" ::: "memory"); SBAR();
#define PK(Lo, Hi) (bf16x8){Lo[0], Lo[1], Lo[2], Lo[3], Hi[0], Hi[1], Hi[2], Hi[3]}
    od = __builtin_amdgcn_mfma_f32_32x32x16_bf16(pa0, PK(l0, h0), od, 0, 0, 0);
    od = __builtin_amdgcn_mfma_f32_32x32x16_bf16(pa1, PK(l1, h1), od, 0, 0, 0);
    od = __builtin_amdgcn_mfma_f32_32x32x16_bf16(pa2, PK(l2, h2), od, 0, 0, 0);
    od = __builtin_amdgcn_mfma_f32_32x32x16_bf16(pa3, PK(l3, h3), od, 0, 0, 0);
#undef PK
}
constexpr float ATT_THR = 8.f;
constexpr int AT_V = 0, AT_K = 32768, AT_WS = 65536;
DEV void attn_unit(const Ctx& c, int b, int h, int qb) {
    const bf16_t* Q = (const bf16_t*)(c.ws + WS_Q); const bf16_t* KV = (const bf16_t*)(c.ws + WS_KV); const bf16_t* KR = (const bf16_t*)(c.ws + WS_KR);
    bf16_t* MG = (bf16_t*)(c.ws + WS_MG);
    unsigned char* lds = c.lds;
    const int tid = c.tid, wid = c.wid, lane = c.lane, r32 = lane & 31, hi = lane >> 5;
    float* wsf = (float*)(lds + AT_WS) + wid * 64; float* li_l = wsf; float* al_l = wsf + 32;
    const int NT = 2 * qb + 3;
    const int my_last = 2 * qb + (wid >> 1) + 1;
    bf16x8 qr[6];
    { const size_t t = (size_t)b * L + NMETA + qb * 128 + wid * 32 + r32;
      const bf16_t* Qw = Q + t * NQ + h * DQK + hi * 8;
#pragma unroll
      for (int d0 = 0; d0 < 6; ++d0) qr[d0] = *(const bf16x8*)(Qw + d0 * 16); }
    const int srow = tid >> 2, sq = tid & 3;
    const int vst0 = v_st(srow, sq * 16), vst1 = v_st(srow, sq * 16 + 8);
    const int kst0 = KSWZ(srow, sq * 32), kst1 = KSWZ(srow, sq * 32 + 16), kst2 = KSWZ(srow, 128 + sq * 16);
    const int vb0 = (int)(uintptr_t)(lds + AT_V) + v_rd_base(lane);
    u32x4 sk0, sk1, sk2, sv0, sv1;
#define SLOAD(j) do { int pos = (j) * 64 + srow - 48; pos = pos < 0 ? 0 : pos; const size_t tk = (size_t)b * L + pos; \
        const bf16_t* kvp = KV + tk * NKV + h * 128 + sq * 16; \
        sk0 = *(const u32x4*)(kvp); sk1 = *(const u32x4*)(kvp + 8); sv0 = *(const u32x4*)(kvp + 64); sv1 = *(const u32x4*)(kvp + 72); \
        sk2 = *(const u32x4*)(KR + tk * 32 + sq * 8); } while (0)
#define SWRITE(bb) do { unsigned char* kb = lds + AT_K + (bb) * 16384; unsigned char* vbp = lds + AT_V + (bb) * 16384; \
        *(u32x4*)(kb + kst0) = sk0; *(u32x4*)(kb + kst1) = sk1; *(u32x4*)(kb + kst2) = sk2; *(u32x4*)(vbp + vst0) = sv0; *(u32x4*)(vbp + vst1) = sv1; } while (0)
    float m_reg = 0.f, l_reg = 0.f; f32x16 o[2] = {};
    __syncthreads();
    SLOAD(0); SWRITE(0); __syncthreads();
    for (int j = 0; j < NT; ++j) {
        const int bsel = j & 1;
        if (j + 1 < NT) SLOAD(j + 1);
        if (j <= my_last) {
            const unsigned char* Ks = lds + AT_K + bsel * 16384;
            f32x16 p0, p1;
            { const float nm = -m_reg;
#pragma unroll
              for (int r = 0; r < 16; ++r) { p0[r] = nm; p1[r] = nm; } }
            __builtin_amdgcn_s_setprio(1);
#pragma unroll
            for (int d0 = 0; d0 < 6; ++d0) { const int cb = (d0 * 16 + hi * 8) * 2;
                const bf16x8 k0 = *(const bf16x8*)(Ks + KSWZ(r32, cb)); const bf16x8 k1 = *(const bf16x8*)(Ks + KSWZ(32 + r32, cb));
                p0 = __builtin_amdgcn_mfma_f32_32x32x16_bf16(k0, qr[d0], p0, 0, 0, 0);
                p1 = __builtin_amdgcn_mfma_f32_32x32x16_bf16(k1, qr[d0], p1, 0, 0, 0); }
            __builtin_amdgcn_s_setprio(0);
            if (j == 0) {
#pragma unroll
                for (int r = 0; r < 16; ++r) p0[r] = -1e30f;
#pragma unroll
                for (int r = 0; r < 8; ++r) p1[r] = -1e30f;
            }
            float pmax = fmaxf(fmaxf(p0[0], p0[1]), p0[2]);
#pragma unroll
            for (int r = 3; r < 15; r += 2) pmax = fmaxf(fmaxf(pmax, p0[r]), p0[r + 1]);
            pmax = fmaxf(fmaxf(pmax, p0[15]), p1[0]);
#pragma unroll
            for (int r = 1; r < 15; r += 2) pmax = fmaxf(fmaxf(pmax, p1[r]), p1[r + 1]);
            pmax = fmaxf(pmax, p1[15]);
            { auto rr = __builtin_amdgcn_permlane32_swap(__float_as_uint(pmax), __float_as_uint(pmax), false, false);
              pmax = fmaxf(__uint_as_float(rr[0]), __uint_as_float(rr[1])); }
            float ps = 0.f;
            if (__any(pmax > ATT_THR)) {
                const float dm = fmaxf(pmax, 0.f), alpha = fast_exp2(-dm); m_reg += dm;
#pragma unroll
                for (int r = 0; r < 16; ++r) { p0[r] -= dm; p1[r] -= dm; }
                l_reg *= alpha;
                if (hi == 0) al_l[r32] = alpha;
                asm volatile("s_waitcnt lgkmcnt(0)" ::: "memory");
#pragma unroll
                for (int r = 0; r < 16; ++r) { const float a = al_l[crow(r, hi)]; o[0][r] *= a; o[1][r] *= a; }
            }
#pragma unroll
            for (int r = 0; r < 16; ++r) { p0[r] = fast_exp2(p0[r]); ps += p0[r]; }
#pragma unroll
            for (int r = 0; r < 16; ++r) { p1[r] = fast_exp2(p1[r]); ps += p1[r]; }
            { auto rr = __builtin_amdgcn_permlane32_swap(__float_as_uint(ps), __float_as_uint(ps), false, false);
              ps = __uint_as_float(rr[0]) + __uint_as_float(rr[1]); }
            l_reg += ps;
            bf16x8 pa0, pa1, pa2, pa3;
#define PK4(P, BASE, OUT) do { unsigned a0 = cvtpk(P[BASE + 0], P[BASE + 1]), a1 = cvtpk(P[BASE + 2], P[BASE + 3]);   \
    unsigned b0 = cvtpk(P[BASE + 4], P[BASE + 5]), b1 = cvtpk(P[BASE + 6], P[BASE + 7]);                              \
    auto r0 = __builtin_amdgcn_permlane32_swap(a0, b0, false, false); auto r1 = __builtin_amdgcn_permlane32_swap(a1, b1, false, false); \
    u32x4 w = {r0[0], r1[0], r0[1], r1[1]}; OUT = *reinterpret_cast<bf16x8*>(&w); } while (0)
            PK4(p0, 0, pa0); PK4(p0, 8, pa1); PK4(p1, 0, pa2); PK4(p1, 8, pa3);
#undef PK4
            const int vb = vb0 + bsel * 16384;
            __builtin_amdgcn_s_setprio(1);
            pv_one<0>(o[0], vb, pa0, pa1, pa2, pa3); pv_one<1>(o[1], vb, pa0, pa1, pa2, pa3);
            __builtin_amdgcn_s_setprio(0);
        }
        if (j + 1 < NT) { if (bsel) SWRITE(0); else SWRITE(1); }
        __syncthreads();
    }
    if (hi == 0) li_l[r32] = l_reg;
    asm volatile("s_waitcnt lgkmcnt(0)" ::: "memory");
    unsigned char* W = lds + wid * 4608;
#pragma unroll
    for (int r = 0; r < 16; ++r) {
        const int orow = crow(r, hi); const float rl = fast_rcp(li_l[orow]);
        const unsigned w = cvtpk(o[0][r] * rl, o[1][r] * rl);
        bf16_t* p = (bf16_t*)(W + orow * 144) + r32;
        p[0] = (bf16_t)(w & 0xffffu); p[32] = (bf16_t)(w >> 16);
    }
    asm volatile("s_waitcnt lgkmcnt(0)" ::: "memory");
    const size_t tok0 = (size_t)b * SEQ + qb * 128 + wid * 32;
    float* SSO = (float*)(c.ws + WS_SSQ_O);
#pragma unroll
    for (int k = 0; k < 4; ++k) {
        const int row = k * 8 + (lane >> 3), ch = lane & 7;
        const u32x4 v = *(const u32x4*)(W + row * 144 + ch * 16);
        *(u32x4*)(MG + (tok0 + row) * D + h * DV + ch * 8) = v;
        float sq = 0.f;
#pragma unroll
        for (int i = 0; i < 4; ++i) { const float x0 = bflo(v[i]), x1 = bfhi(v[i]); sq += x0 * x0 + x1 * x1; }
        sq += dpp_mov<0xB1>(sq); sq += dpp_mov<0x4E>(sq); sq += dpp_mov<0x141>(sq);
        if (ch == 0) SSO[(tok0 + row) * 8 + h] = sq;
    }
#undef SLOAD
#undef SWRITE
}
DEV void phase3(const Ctx& c) {
    const int nslots = NB * NH * 4;
    float* scr = (float*)(c.lds + c.wid * 8448);
    const int gw = c.vcu * 4 + c.wid, NGW = c.G * 4;
    constexpr int NWI = 6144;
    int wi = gw;
#define EW_ITEMS(n) do { __syncthreads(); for (int _q = 0; _q < (n) && wi < NWI; ++_q, wi += NGW) expert_weight_item(c, wi, scr); } while (0)
    for (int v = c.vcu; v < nslots; v += c.G) {
        const int bh = v >> 2, s = v & 3, b = bh >> 3, h = bh & 7;
        attn_unit(c, b, h, 15 - s); EW_ITEMS(1); attn_unit(c, b, h, s); EW_ITEMS(1); attn_unit(c, b, h, 11 - s); EW_ITEMS(1); attn_unit(c, b, h, 4 + s);
    }
    __syncthreads();
    for (; wi < NWI; wi += NGW) expert_weight_item(c, wi, scr);
#undef EW_ITEMS
}

DEV void phase4(const Ctx& c) {
    const bf16_t* MG = (const bf16_t*)(c.ws + WS_MG); const bf16_t* WoT = (const bf16_t*)(c.ws + WS_WO); const bf16_t* h0 = (const bf16_t*)(c.ws + WS_H0);
    bf16_t* R1 = (bf16_t*)(c.ws + WS_R1);
    const StageGeo g = stage_geo(c.tid);
    const int lane = c.lane, wr = c.wid >> 1, wc = c.wid & 1, fr = lane & 15, fq = lane >> 4;
    constexpr int NU = (TR / 128) * 8;
    const float* SSO = (const float*)(c.ws + WS_SSQ_O);
    f32x4 pa = {1.f, 1.f, 1.f, 1.f}, pb = pa;
    if (c.vcu < NU && c.tid < 128) { const float* pp = SSO + (size_t)((c.vcu >> 3) * 128 + c.tid) * 8; pa = *(const f32x4*)pp; pb = *(const f32x4*)(pp + 4); }
    for (int u = c.vcu; u < NU; u += c.G) {
        const int mt = u >> 3, nt = u & 7;
        const bf16_t* A = MG + (size_t)(mt * 128) * D + g.c; const bf16_t* B = WoT + (size_t)(nt * 128) * D + g.c;
        f32x4 acc[4][4];
        __syncthreads();
        if (c.tid < 128) ((float*)(c.lds + RS_OFF))[c.tid] = rsqrt_((((pa.x + pa.y) + (pa.z + pa.w)) + ((pb.x + pb.y) + (pb.z + pb.w))) * (1.f / 512.f) + EPS);
        { const int un = u + c.G; if (un < NU && c.tid < 128) { const float* pp = SSO + (size_t)((un >> 3) * 128 + c.tid) * 8; pa = *(const f32x4*)pp; pb = *(const f32x4*)(pp + 4); } }
        u32x2 hw[4][4];
#pragma unroll
        for (int m = 0; m < 4; ++m) {
            const int tok = mt * 128 + wr * 64 + m * 16 + fr;
            const size_t t = (size_t)(tok >> 11) * L + NMETA + (tok & 2047);
#pragma unroll
            for (int n = 0; n < 2; ++n) { const u32x4 w = *(const u32x4*)(h0 + t * D + nt * 128 + wc * 64 + fq * 16 + n * 8);
                hw[m][2 * n] = (u32x2){w.x, w.y}; hw[m][2 * n + 1] = (u32x2){w.z, w.w}; }
        }
        gemm_mainloop<true>(acc, A + (size_t)g.r[0] * D, A + (size_t)g.r[1] * D, A + (size_t)g.r[2] * D, A + (size_t)g.r[3] * D,
                            B + (size_t)g.r[0] * D, B + (size_t)g.r[1] * D, B + (size_t)g.r[2] * D, B + (size_t)g.r[3] * D, 16, c.lds, 8, 1.f / 512.f);
#pragma unroll
        for (int m = 0; m < 4; ++m) {
            const int tok = mt * 128 + wr * 64 + m * 16 + fr;
            f32x4 o[4];
            { const u32x4 lo = quad_transpose(hw[m][0].x, hw[m][1].x, hw[m][2].x, hw[m][3].x), hi = quad_transpose(hw[m][0].y, hw[m][1].y, hw[m][2].y, hw[m][3].y);
#pragma unroll
              for (int n = 0; n < 4; ++n) hw[m][n] = (u32x2){lo[n], hi[n]}; }
#pragma unroll
            for (int n = 0; n < 4; ++n) {
                o[n][0] = ALPHA * bflo(hw[m][n].x) + acc[m][n][0]; o[n][1] = ALPHA * bfhi(hw[m][n].x) + acc[m][n][1];
                o[n][2] = ALPHA * bflo(hw[m][n].y) + acc[m][n][2]; o[n][3] = ALPHA * bfhi(hw[m][n].y) + acc[m][n][3];
            }
            st_quad_bf16(R1 + (size_t)tok * D + nt * 128 + wc * 64 + fq * 16, o[0], o[1], o[2], o[3]);
        }
    }
}

constexpr int P5_ROWB = 2064, P5_PART = 33280, P5_LG = 45568, P5_BIAS = 48128, P5_AGG = 48384;
DEV void phase5(const Ctx& c, int ALT = 0) {
    const bf16_t* R1 = (const bf16_t*)(c.ws + WS_R1);
    const bf16_t* WrT = (const bf16_t*)(c.ws + WS_WR);
    unsigned* cnt = (unsigned*)(c.ws + WS_CTL) + CW_CNT + ALT * 32; unsigned* list = (unsigned*)(c.ws + (ALT ? 404 * MiB : WS_LIST)); float* combw = (float*)(c.ws + WS_COMBW);
    const int lane = c.lane, wid = c.wid, fr = lane & 15, fq = lane >> 4;
    float* part = (float*)(c.lds + P5_PART); float* lgs = (float*)(c.lds + P5_LG); float* biasl = (float*)(c.lds + P5_BIAS);
    __syncthreads();
    if (c.tid < 36) biasl[c.tid] = (c.tid < 4) ? c.in[I_BRG][c.tid] : c.in[I_BRE][c.tid - 4];
    bf16x8 wf[8][3];
#pragma unroll
    for (int ks = 0; ks < 8; ++ks)
#pragma unroll
        for (int n = 0; n < 3; ++n) wf[ks][n] = *(const bf16x8*)(WrT + (size_t)(n * 16 + fr) * D + wid * 256 + ks * 32 + fq * 8);
    unsigned* lcnt = (unsigned*)(c.lds + P5_AGG); unsigned* lbase = lcnt + 32; unsigned* ent = lcnt + 64;
    if (c.tid < 32) lcnt[c.tid] = 0u;
    int nent = 0;
    for (int u = c.vcu; u < TR / 16; u += c.G) {
        const int tok0 = u * 16;
        { const float* src[4]; bf16_t* dst[4]; unsigned char* ldsn[4]; unsigned char* f8n[4]; float* stn[4];
#pragma unroll
          for (int i = 0; i < 4; ++i) { const int tl = wid * 4 + i; const size_t tok = tok0 + tl; src[i] = (const float*)(R1 + tok * D); dst[i] = nullptr; ldsn[i] = c.lds + tl * P5_ROWB; f8n[i] = c.ws + WS_H1F8 + tok * D;
              stn[i] = (float*)(c.ws + WS_ST1) + tok * 2; }
          ln_rows_bf16<4, true, true, true>(src, c.in[I_LN1G], c.in[I_LN1B], dst, ldsn, lane, f8n, stn); }
        __syncthreads();
        f32x4 acc[3] = {};
#pragma unroll
        for (int ks = 0; ks < 8; ++ks) {
            const int k = wid * 256 + ks * 32 + fq * 8;
            const bf16x8 a = *(const bf16x8*)(c.lds + fr * P5_ROWB + k * 2);
#pragma unroll
            for (int n = 0; n < 3; ++n) acc[n] = __builtin_amdgcn_mfma_f32_16x16x32_bf16(wf[ks][n], a, acc[n], 0, 0, 0);
        }
#pragma unroll
        for (int n = 0; n < 3; ++n) *(f32x4*)(part + (wid * 16 + fr) * 48 + n * 16 + fq * 4) = acc[n];
        __syncthreads();
#pragma unroll
        for (int i = 0; i < 3; ++i) { const int idx = c.tid + 256 * i;
            if (idx < 576) { const int tk = idx / 36, l = idx - tk * 36;
                lgs[tk * 40 + l] = ((part[tk * 48 + l] + part[(16 + tk) * 48 + l]) + (part[(32 + tk) * 48 + l] + part[(48 + tk) * 48 + l])) + biasl[l]; } }
        __syncthreads();
        if (c.tid < 16) {
            const float* lg = lgs + c.tid * 40;
            int gi = 0; float gm = lg[0];
#pragma unroll
            for (int i = 1; i < 4; ++i) { const float v = lg[i]; if (v > gm) { gm = v; gi = i; } }
            float gs = 0.f;
#pragma unroll
            for (int i = 0; i < 4; ++i) gs += __expf(lg[i] - gm);
            const float gw = 1.f / gs;
            const float* le = lg + 4 + gi * 8;
            float v0 = le[0], v1 = -3.0e38f; int i0 = 0, i1 = 0;
#pragma unroll
            for (int i = 1; i < 8; ++i) { const float v = le[i];
                if (v > v0) { v1 = v0; i1 = i0; v0 = v; i0 = i; } else if (v > v1) { v1 = v; i1 = i; } }
            const float ex = __expf(v1 - v0), inv = 1.f / (1.f + ex);
            const int tok = tok0 + c.tid; const unsigned e0 = gi * 8 + i0, e1 = gi * 8 + i1;
            combw[tok * 2] = gw * inv; combw[tok * 2 + 1] = gw * ex * inv;
            const unsigned r0 = atomicAdd(&lcnt[e0], 1u), r1 = atomicAdd(&lcnt[e1], 1u);
            const int ei = nent * 32 + c.tid * 2;
            ent[2 * ei] = (unsigned)(tok * 2);         ent[2 * ei + 1] = (e0 << 16) | r0;
            ent[2 * ei + 2] = (unsigned)(tok * 2 + 1); ent[2 * ei + 3] = (e1 << 16) | r1;
        }
        ++nent;
    }
    __syncthreads();
    if (c.tid < 32) { const unsigned n = lcnt[c.tid]; lbase[c.tid] = n ? atomicAdd(&cnt[c.tid * CNT_STRIDE], n) : 0u; }
    __syncthreads();
    for (int i = c.tid; i < nent * 32; i += 256) { const unsigned t2 = ent[2 * i], er = ent[2 * i + 1]; const unsigned e = er >> 16;
        list[(size_t)e * TR + lbase[e] + (er & 0xffffu)] = t2; }
}
DEV void bar20(const Ctx& c) {}
DEV void moe_tiles(const Ctx& c) {
    const unsigned* cnt = (const unsigned*)(c.ws + WS_CTL) + CW_CNT; int* ts = (int*)(c.lds + EXP_OFF);
    __syncthreads();
    if (c.tid < NE) ts[40 + c.tid] = (int)__hip_atomic_load(&cnt[c.tid * CNT_STRIDE], __ATOMIC_RELAXED, __HIP_MEMORY_SCOPE_AGENT);
    __syncthreads();
    if (c.tid == 0) { int s = 0; for (int e = 0; e < NE; ++e) { ts[e] = s; s += (ts[40 + e] + 127) >> 7; } ts[NE] = s; }
    __syncthreads();
}
DEV void phase6a(const Ctx& c) {
    const bf16_t* H18 = (const bf16_t*)(c.ws + WS_H1F8); const bf16_t* Wgu8 = (const bf16_t*)(c.ws + WS_WGU); unsigned char* ACT8 = c.ws + WS_ACT;
    const unsigned* list = (const unsigned*)(c.ws + WS_LIST);
    moe_tiles(c);
    const int* ts = (const int*)(c.lds + EXP_OFF); unsigned* tbl = (unsigned*)(c.lds + TBL_OFF);
    const StageGeo g = stage_geo(c.tid);
    const int lane = c.lane, wr = c.wid >> 1, wc = c.wid & 1, fr = lane & 15, fq = lane >> 4;
    const int NU = ts[NE] * 4;
    u32x2* RI = (u32x2*)(c.ws + WS_RI); const float* combw = (const float*)(c.ws + WS_COMBW);
    int e = 0, en_e = 0; unsigned en_cur = 0xffffffffu;
    { const int u0 = c.vcu; if (u0 < NU) { const int rt0 = u0 >> 2; while (ts[en_e + 1] <= rt0) ++en_e;
        if (c.tid < 128) { const int j = (rt0 - ts[en_e]) * 128 + c.tid; en_cur = (j < ts[40 + en_e]) ? list[(size_t)en_e * TR + j] : 0xffffffffu; } } }
    for (int u = c.vcu; u < NU; u += c.G) {
        const int rt = u >> 2, nt = u & 3;
        e = en_e;
        __syncthreads();
        float wri = 0.f;
        if (c.tid < 128) { tbl[c.tid] = en_cur; if (nt == 0 && en_cur != 0xffffffffu) wri = combw[en_cur]; }
        const unsigned en_this = en_cur;
        { const int un = u + c.G; if (un < NU) { const int rtn = un >> 2; while (ts[en_e + 1] <= rtn) ++en_e;
            if (c.tid < 128) { const int j = (rtn - ts[en_e]) * 128 + c.tid; en_cur = (j < ts[40 + en_e]) ? list[(size_t)en_e * TR + j] : 0xffffffffu; } } }
        __syncthreads();
        size_t ro[4];
#pragma unroll
        for (int i = 0; i < 4; ++i) { const unsigned en = tbl[g.r[i]]; ro[i] = (en == 0xffffffffu) ? 0 : (size_t)(en >> 1) * (D / 2); }
        const bf16_t* A = H18 + g.c; const bf16_t* B = Wgu8 + ((size_t)e * 512 + nt * 128) * (D / 2) + g.c;
        f32x4 acc[4][4];
        gemm_mainloop<false, true>(acc, A + ro[0], A + ro[1], A + ro[2], A + ro[3],
                             B + (size_t)g.r[0] * (D / 2), B + (size_t)g.r[1] * (D / 2), B + (size_t)g.r[2] * (D / 2), B + (size_t)g.r[3] * (D / 2), 8, c.lds, 0, 0.f);
#pragma unroll
        for (int mp = 0; mp < 2; ++mp) {
            unsigned xq[4];
#pragma unroll
            for (int q = 0; q < 4; ++q) { const f32x4 gt = acc[2 * mp + (q >> 1)][2 * (q & 1)], up = acc[2 * mp + (q >> 1)][2 * (q & 1) + 1]; f32x4 o;
#pragma unroll
                for (int j = 0; j < 4; ++j) { const float gv = gt[j] * WUNSCALE; o[j] = gv * sigmoidf_(gv) * (up[j] * WUNSCALE); }
                xq[q] = pk_fp8x4(o[0], o[1], o[2], o[3]); }
            const size_t row = (size_t)rt * 128 + wr * 64 + (2 * mp + (fq >> 1)) * 16 + fr;
            *(u32x4*)(ACT8 + row * DE + nt * 64 + wc * 32 + (fq & 1) * 16) = quad_transpose(xq[0], xq[1], xq[2], xq[3]);
        }
        if (nt == 0 && c.tid < 128) { u32x2 ri; ri.x = en_this; ri.y = __float_as_uint(wri); RI[(size_t)rt * 128 + c.tid] = ri; }
    }
}
DEV void phase6b(const Ctx& c) {
    const bf16_t* ACT8 = (const bf16_t*)(c.ws + WS_ACT); const bf16_t* Wd8 = (const bf16_t*)(c.ws + WS_WD); unsigned char* Y8 = c.ws + WS_Y;
    const u32x2* RI = (const u32x2*)(c.ws + WS_RI);
    moe_tiles(c);
    const int* ts = (const int*)(c.lds + EXP_OFF); u32x2* tbl = (u32x2*)(c.lds + TBL_OFF);
    const StageGeo g = stage_geo(c.tid);
    unsigned char* lds = c.lds;
    const int tid = c.tid, lane = c.lane, wr = c.wid >> 1, wc = c.wid & 1, fr = lane & 15, fq = lane >> 4;
    const int cb0 = fq * 32, cb1 = fq * 32 + 16;
    const int q0 = (cb0 >> 6) * 1024 + ((fr * 64 + (cb0 & 63)) ^ ((fr >> 3) << 5)), q1 = (cb1 >> 6) * 1024 + ((fr * 64 + (cb1 & 63)) ^ ((fr >> 3) << 5));
    const int a_off = wr * 8192, b_off = wc * 8192, dst = tid * 16;
    const int NU = ts[NE] * 2;
    int e = 0;
#define GLDS(src, off) __builtin_amdgcn_global_load_lds((const unsigned*)(src), (unsigned LAS*)(lds + (off)), 16, 0, 0)
    for (int u = c.vcu; u < NU; u += c.G) {
        const int rt = u >> 1, nh = u & 1;
        while (ts[e + 1] <= rt) ++e;
        __syncthreads();
        if (tid < 128) tbl[tid] = RI[(size_t)rt * 128 + tid];
        const bf16_t* A = ACT8 + (size_t)(rt * 128) * (DE / 2) + g.c;
        const bf16_t* B = Wd8 + ((size_t)e * 1024 + nh * 512) * (DE / 2) + g.c;
#pragma unroll
        for (int kt = 0; kt < 2; ++kt)
#pragma unroll
            for (int i = 0; i < 4; ++i) GLDS(A + (size_t)g.r[i] * (DE / 2) + kt * 64, kt * 16384 + dst + i * 4096);
#define BSTAGE(s_, buf) do { const bf16_t* _b = B + (size_t)((s_) >> 1) * 128 * (DE / 2) + ((s_) & 1) * 64; \
        GLDS(_b + (size_t)g.r[0] * (DE / 2), 32768 + (buf) * 16384 + dst);        GLDS(_b + (size_t)g.r[1] * (DE / 2), 32768 + (buf) * 16384 + dst + 4096); \
        GLDS(_b + (size_t)g.r[2] * (DE / 2), 32768 + (buf) * 16384 + dst + 8192); GLDS(_b + (size_t)g.r[3] * (DE / 2), 32768 + (buf) * 16384 + dst + 12288); } while (0)
        BSTAGE(0, 0);
        f32x4 acc[4][4];
#pragma unroll
        for (int m = 0; m < 4; ++m)
#pragma unroll
            for (int n = 0; n < 4; ++n) acc[m][n] = (f32x4){0.f, 0.f, 0.f, 0.f};
#pragma unroll 1
        for (int s_ = 0; s_ < 8; ++s_) {
            VM_WAIT();
            __syncthreads();
            const int bsel = s_ & 1;
            if (s_ + 1 < 8) { if (bsel) BSTAGE(s_ + 1, 0); else BSTAGE(s_ + 1, 1); }
            const unsigned char* ab = lds + bsel * 16384 + a_off; const unsigned char* bb = lds + 32768 + bsel * 16384 + b_off;
            v8i ax[4], bx[4];
#pragma unroll
            for (int m = 0; m < 4; ++m) { const u32x4 c0 = *(const u32x4*)(ab + m * 2048 + q0), c1 = *(const u32x4*)(ab + m * 2048 + q1);
                ax[m] = (v8i){(int)c0.x, (int)c0.y, (int)c0.z, (int)c0.w, (int)c1.x, (int)c1.y, (int)c1.z, (int)c1.w}; }
#pragma unroll
            for (int n = 0; n < 4; ++n) { const u32x4 c0 = *(const u32x4*)(bb + n * 2048 + q0), c1 = *(const u32x4*)(bb + n * 2048 + q1);
                bx[n] = (v8i){(int)c0.x, (int)c0.y, (int)c0.z, (int)c0.w, (int)c1.x, (int)c1.y, (int)c1.z, (int)c1.w}; }
#pragma unroll
            for (int m = 0; m < 4; ++m)
#pragma unroll
                for (int n = 0; n < 4; ++n) acc[m][n] = __builtin_amdgcn_mfma_scale_f32_16x16x128_f8f6f4(bx[n], ax[m], acc[m][n], 0, 0, 0, 0x7F7F7F7F, 0, 0x7F7F7F7F);
            if (bsel) {
                const int nt = nh * 4 + (s_ >> 1);
#pragma unroll
                for (int m = 0; m < 4; ++m) {
                    const u32x2 ri = tbl[wr * 64 + m * 16 + fr]; const unsigned en = ri.x;
                    const float w = __uint_as_float(ri.y) * (WUNSCALE * YSCALE);
                    unsigned xq[4];
#pragma unroll
                    for (int n = 0; n < 4; ++n) { const f32x4 o = acc[m][n] * w; xq[n] = pk_fp8x4(o[0], o[1], o[2], o[3]); }
                    const u32x4 z = quad_transpose(xq[0], xq[1], xq[2], xq[3]);
                    if (en != 0xffffffffu) *(u32x4*)(Y8 + ((size_t)(en & 1u) * TR + (en >> 1)) * D + nt * 128 + wc * 64 + fq * 16) = z;
#pragma unroll
                    for (int n = 0; n < 4; ++n) acc[m][n] = (f32x4){0.f, 0.f, 0.f, 0.f};
                }
            }
        }
#undef BSTAGE
    }
#undef GLDS
}

DEV void phase7(const Ctx& c) {
    const bf16_t* R1 = (const bf16_t*)(c.ws + WS_R1); const unsigned char* Y8 = c.ws + WS_Y; const float2* ST1 = (const float2*)(c.ws + WS_ST1);
    const float* g = c.in[I_LN2G]; const float* bt = c.in[I_LN2B];
    const int gw = c.vcu * 4 + c.wid, NGW = c.G * 4, lane = c.lane;
    float G1[16], B1[16];
#pragma unroll
    for (int i = 0; i < 2; ++i)
#pragma unroll
        for (int q = 0; q < 2; ++q) { const f32x4 a = *(const f32x4*)(c.in[I_LN1G] + i * 512 + lane * 8 + q * 4), bq = *(const f32x4*)(c.in[I_LN1B] + i * 512 + lane * 8 + q * 4);
#pragma unroll
            for (int e = 0; e < 4; ++e) { G1[i * 8 + q * 4 + e] = a[e]; B1[i * 8 + q * 4 + e] = bq[e]; } }
    for (int tok0 = gw; tok0 < TR; tok0 += 2 * NGW) {
        float v[2][16]; float st[2]; int tk[2];
#pragma unroll
        for (int r = 0; r < 2; ++r) {
            int tok = tok0 + r * NGW; if (tok >= TR) tok = tok0; tk[r] = tok;
            const float2 ms = ST1[tok]; const float am = ALPHA * ms.y;
#pragma unroll
            for (int i = 0; i < 2; ++i) {
                const u32x4 hw = __builtin_nontemporal_load((const u32x4*)(R1 + (size_t)tok * D + i * 512 + lane * 8));
                const u32x2 y0 = __builtin_nontemporal_load((const u32x2*)(Y8 + (size_t)tok * D + i * 512 + lane * 8));
                const u32x2 y1 = __builtin_nontemporal_load((const u32x2*)(Y8 + ((size_t)TR + tok) * D + i * 512 + lane * 8));
#pragma unroll
                for (int q2 = 0; q2 < 2; ++q2) {
                    const auto a0 = __builtin_amdgcn_cvt_pk_f32_fp8((int)y0[q2], false), a1 = __builtin_amdgcn_cvt_pk_f32_fp8((int)y0[q2], true);
                    const auto b0 = __builtin_amdgcn_cvt_pk_f32_fp8((int)y1[q2], false), b1 = __builtin_amdgcn_cvt_pk_f32_fp8((int)y1[q2], true);
                    const int e0 = i * 8 + 4 * q2;
                    v[r][e0]     = (bflo(hw[2 * q2]) - ms.x) * (am * G1[e0]) + ALPHA * B1[e0] + (a0[0] + b0[0]) * YUNSCALE;
                    v[r][e0 + 1] = (bfhi(hw[2 * q2]) - ms.x) * (am * G1[e0 + 1]) + ALPHA * B1[e0 + 1] + (a0[1] + b0[1]) * YUNSCALE;
                    v[r][e0 + 2] = (bflo(hw[2 * q2 + 1]) - ms.x) * (am * G1[e0 + 2]) + ALPHA * B1[e0 + 2] + (a1[0] + b1[0]) * YUNSCALE;
                    v[r][e0 + 3] = (bfhi(hw[2 * q2 + 1]) - ms.x) * (am * G1[e0 + 3]) + ALPHA * B1[e0 + 3] + (a1[1] + b1[1]) * YUNSCALE;
                }
            }
        }
#pragma unroll
        for (int r = 0; r < 2; ++r) { float a = 0.f;
#pragma unroll
            for (int q = 0; q < 16; ++q) a += v[r][q];
            st[r] = a; }
        wave_sum_n<2>(st);
#pragma unroll
        for (int r = 0; r < 2; ++r) { const float mean = st[r] * (1.f / 1024.f); float a = 0.f;
#pragma unroll
            for (int q = 0; q < 16; ++q) { v[r][q] -= mean; a += v[r][q] * v[r][q]; }
            st[r] = a; }
        wave_sum_n<2>(st);
#pragma unroll
        for (int i = 0; i < 2; ++i)
#pragma unroll
            for (int q = 0; q < 2; ++q) {
                const int col = i * 512 + lane * 8 + q * 4;
                const f32x4 gg = *(const f32x4*)(g + col), bb = *(const f32x4*)(bt + col);
#pragma unroll
                for (int r = 0; r < 2; ++r) {
                    if (r == 1 && tok0 + NGW >= TR) continue;
                    const float rstd = rsqrt_(st[r] * (1.f / 1024.f) + EPS);
                    f32x4 o; o[0] = v[r][i * 8 + q * 4] * rstd * gg[0] + bb[0]; o[1] = v[r][i * 8 + q * 4 + 1] * rstd * gg[1] + bb[1];
                    o[2] = v[r][i * 8 + q * 4 + 2] * rstd * gg[2] + bb[2]; o[3] = v[r][i * 8 + q * 4 + 3] * rstd * gg[3] + bb[3];
                    *(f32x4*)(c.out + (size_t)tk[r] * D + col) = o;
                }
            }
    }
}

__global__ void __launch_bounds__(256, 2) fwd_kernel(Args a) {
    extern __shared__ __attribute__((aligned(16))) unsigned char lds[];
    Ctx c; c.in = a.in; c.out = a.out; c.ws = a.ws; c.lds = lds;
    c.tid = threadIdx.x; c.lane = c.tid & 63; c.wid = __builtin_amdgcn_readfirstlane(c.tid >> 6);
    c.G = gridDim.x; { const int bx = blockIdx.x; c.vcu = (c.G % 8 == 0) ? (bx % 8) * (c.G / 8) + bx / 8 : bx; }
    if (c.tid < 64) ((unsigned*)(lds + MISC_OFF))[c.tid] = 0u;
    __syncthreads();
    unsigned* ctl = (unsigned*)(a.ws + WS_CTL);
    XcdBarrier bar = xcd_barrier_post(ctl + CW_BAR, (volatile LAS unsigned*)(lds + MISC_OFF));
#ifdef ONLY_PH
#define PH_ON(k) ((k) == ONLY_PH)
#else
#define PH_ON(k) 1
#endif
    const int lo = a.ph_lo, hi = a.ph_hi;
#define RUN_PHASE(k, fn) if (PH_ON(k) && lo <= (k) && (k) < hi) { \
        for (int _rep = 0; _rep < ((REPEAT_PH == (k)) ? 2 : 1); ++_rep) { \
            int _t = threadIdx.x; asm volatile("" : "+v"(_t)); c.tid = _t; c.lane = _t & 63; c.wid = __builtin_amdgcn_readfirstlane(_t >> 6); \
            if ((k) == 5) phase5(c, _rep); else fn(c); \
            if (_rep == 0 && REPEAT_PH == (k)) xcd_barrier(bar); } \
        if ((k) + 1 < hi) xcd_barrier(bar); }
    RUN_PHASE(0, phase0)
    RUN_PHASE(1, phase1)
    RUN_PHASE(2, phase2)
    RUN_PHASE(3, phase3)
    RUN_PHASE(4, phase4)
    RUN_PHASE(5, phase0)
    RUN_PHASE(6, phase6a)
    RUN_PHASE(7, phase6b)
    RUN_PHASE(8, phase7)
}

extern "C" void kernel_launch(void* const* d_in, const int* in_sizes, int n_in, void* d_out, int out_size, void* d_ws, size_t ws_size, hipStream_t stream) {
    static int grid = 0;
    if (grid == 0) {
        if (n_in != 27 || in_sizes[0] != NB * SEQ * D || out_size != TR * D || ws_size < WS_END) {
            fprintf(stderr, "kernel_launch: shape mismatch n_in %d in0 %d out %d ws %zu\n", n_in, n_in > 0 ? in_sizes[0] : -1, out_size, ws_size); grid = -1; return; }
        int dev = 0, cus = 0, per_cu = 0;
        if (hipGetDevice(&dev) != hipSuccess || hipDeviceGetAttribute(&cus, hipDeviceAttributeMultiprocessorCount, dev) != hipSuccess) { grid = -1; return; }
        if (hipFuncSetAttribute((const void*)fwd_kernel, hipFuncAttributeMaxDynamicSharedMemorySize, LDS_BYTES) != hipSuccess) { grid = -1; return; }
        if (hipOccupancyMaxActiveBlocksPerMultiprocessor(&per_cu, (const void*)fwd_kernel, 256, LDS_BYTES) != hipSuccess || per_cu < 1) per_cu = 1;
        (void)hipGetLastError();
        if (per_cu > 2) per_cu = 2;
        grid = cus * per_cu;
        fprintf(stderr, "kernel_launch: grid %d (%d per CU)\n", grid, per_cu);
    }
    if (grid < 0) return;
    (void)hipMemsetAsync((char*)d_ws + WS_CTL, 0, CTL_ZERO_BYTES, stream);
    Args a{};
    for (int i = 0; i < 27; ++i) a.in[i] = (const float*)d_in[i];
    a.out = (float*)d_out; a.ws = (unsigned char*)d_ws;
    if (MK_N_LAUNCHES == 1) {
        a.ph_lo = 0; a.ph_hi = NPH;
        hipLaunchKernelGGL(fwd_kernel, dim3(grid), dim3(256), LDS_BYTES, stream, a);
    } else {
        for (int ph = 0; ph < NPH; ++ph) { a.ph_lo = ph; a.ph_hi = ph + 1; hipLaunchKernelGGL(fwd_kernel, dim3(grid), dim3(256), LDS_BYTES, stream, a); }
    }
}
```
